# Optimizing an MI355X kernel written in HIP

```python
import math
import jax
import jax.numpy as jnp
from jax import lax
import numpy as np


D_MODEL = 1024
BATCH = 8
SEQ = 4096
DEPTH = 2

CHUNK = 64
N_BRANCH = 4
BRANCH_W = 512
SGU_BLOCK = 128
SGU_GROUPS = 4
SGU_GW = BRANCH_W // SGU_GROUPS
LRU_W = BRANCH_W
LRU_HEADS = 8
LRU_HD = LRU_W // LRU_HEADS
LRU_CONV = 4
LRU_C = 8.0
GDN_HEADS = 4
GDN_DK = 128
GDN_DV = 128
GDN_CONV = 4
POOL_WINDOWS = (2, 4, 8, 16)
POOL_GROUPS = 4
POOL_GW = BRANCH_W // POOL_GROUPS
D_FF = 2816
EPS = 1e-6
IN_SIZES = (BRANCH_W, BRANCH_W, LRU_W, LRU_W, GDN_HEADS * GDN_DK, GDN_HEADS * GDN_DK,
            GDN_HEADS * GDN_DV, GDN_HEADS * GDN_DV, GDN_HEADS, GDN_HEADS, BRANCH_W,
            N_BRANCH * D_MODEL)
P_IN = sum(IN_SIZES)

kernel_name = 'chunk_causal_hybrid_gated_merge'

F32 = jnp.float32


def rms_norm(x, g):
    xf = x.astype(F32)
    y = xf * lax.rsqrt(jnp.mean(xf * xf, axis=-1, keepdims=True) + EPS)
    return (y * g.astype(F32)).astype(x.dtype)


def swiglu(h, wg, wu, wd):
    a = jnp.einsum('bsd,df->bsf', h, wg)
    b = jnp.einsum('bsd,df->bsf', h, wu)
    return jnp.einsum('bsf,fd->bsd', jax.nn.silu(a) * b, wd)


def causal_dwconv(x, w):
    K = w.shape[0]
    S = x.shape[1]
    xp = jnp.pad(x, ((0, 0), (K - 1, 0), (0, 0)))
    y = xp[:, 0:S] * w[0]
    for k in range(1, K):
        y = y + xp[:, k:k + S] * w[k]
    return y


def l2norm(t):
    return t * lax.rsqrt(jnp.sum(t * t, axis=-1, keepdims=True) + EPS)


def sgu_mixer(u, v, ln_g, ln_b, w_s, b_s):
    B, S, _ = u.shape
    u = jax.nn.gelu(u)
    vf = jax.nn.gelu(v).astype(F32)
    mu = jnp.mean(vf, axis=-1, keepdims=True)
    var = jnp.mean(jnp.square(vf - mu), axis=-1, keepdims=True)
    vn = (vf - mu) * lax.rsqrt(var + EPS) * ln_g.astype(F32) + ln_b.astype(F32)
    n = S // SGU_BLOCK
    vb = vn.reshape(B, n, SGU_BLOCK, SGU_GROUPS, SGU_GW)
    pos_chunk = jnp.arange(SGU_BLOCK) // CHUNK
    mask = pos_chunk[:, None] >= pos_chunk[None, :]
    w = jnp.where(mask[None], w_s.astype(F32), 0.0)
    mixed = jnp.einsum('gij,bnjgc->bnigc', w, vb) + b_s.astype(F32).T[None, None, :, :, None]
    return u * mixed.reshape(B, S, BRANCH_W).astype(u.dtype)


def rglru_mixer(xb, gate, conv_w, conv_b, wa, ba, wx, bx, lam):
    B, S, _ = xb.shape
    xc = (causal_dwconv(xb, conv_w) + conv_b).astype(F32)
    xh = xc.reshape(B, S, LRU_HEADS, LRU_HD)
    r = jax.nn.sigmoid(jnp.einsum('bshi,hij->bshj', xh, wa.astype(F32)).reshape(B, S, LRU_W) + ba.astype(F32))
    i = jax.nn.sigmoid(jnp.einsum('bshi,hij->bshj', xh, wx.astype(F32)).reshape(B, S, LRU_W) + bx.astype(F32))
    log_a = -LRU_C * r * jax.nn.softplus(-lam.astype(F32))
    a = jnp.exp(log_a)
    mult = jnp.sqrt(-jnp.expm1(2.0 * log_a))
    b = mult * (i * xc)

    def combine(left, right):
        a1, b1 = left
        a2, b2 = right
        return a1 * a2, a2 * b1 + b2

    _, h = lax.associative_scan(combine, (a, b), axis=1)
    return (h * jax.nn.gelu(gate.astype(F32))).astype(xb.dtype)


def gated_deltanet_mixer(q, k, v, z, beta_pre, alpha_pre, conv_w, a_log, dt_bias, norm_g):
    B, S, _ = q.shape
    H, C = GDN_HEADS, CHUNK
    n = S // C
    qkv = jax.nn.silu(causal_dwconv(jnp.concatenate([q, k, v], axis=-1), conv_w)).astype(F32)
    q, k, v = jnp.split(qkv, [H * GDN_DK, 2 * H * GDN_DK], axis=-1)
    q = l2norm(q.reshape(B, S, H, GDN_DK)) * (GDN_DK ** -0.5)
    k = l2norm(k.reshape(B, S, H, GDN_DK))
    v = v.reshape(B, S, H, GDN_DV)
    beta = jax.nn.sigmoid(beta_pre.astype(F32))
    g = -jnp.exp(a_log.astype(F32)) * jax.nn.softplus(alpha_pre.astype(F32) + dt_bias.astype(F32))

    def chunks(t):
        t = t.reshape((B, n, C, H) + t.shape[3:])
        return jnp.moveaxis(t, 3, 1)

    qc, kc, vc = chunks(q), chunks(k), chunks(v)
    bc, gc = chunks(beta), chunks(g)
    gcum = jnp.cumsum(gc, axis=-1)
    idx = jnp.arange(C)
    incl = idx[:, None] >= idx[None, :]
    strict = idx[:, None] > idx[None, :]
    decay = jnp.exp(jnp.where(incl, gcum[..., :, None] - gcum[..., None, :], -jnp.inf))
    kb = kc * bc[..., None]
    a_mat = jnp.where(strict, jnp.einsum('bhnid,bhnjd->bhnij', kb, kc) * decay, 0.0)
    eye = jnp.eye(C, dtype=F32)
    t_mat = lax.linalg.triangular_solve(eye + a_mat, jnp.broadcast_to(eye, a_mat.shape),
                                        left_side=True, lower=True, unit_diagonal=True)
    u = jnp.einsum('bhnij,bhnjd->bhnid', t_mat, vc * bc[..., None])
    w = jnp.einsum('bhnij,bhnjd->bhnid', t_mat, kb * jnp.exp(gcum)[..., None])
    attn = jnp.where(incl, jnp.einsum('bhnid,bhnjd->bhnij', qc, kc) * decay, 0.0)

    def step(state, inp):
        q_i, k_i, u_i, w_i, g_i, attn_i = inp
        v_new = u_i - jnp.einsum('bhcd,bhde->bhce', w_i, state)
        o = (jnp.einsum('bhcd,bhde->bhce', q_i * jnp.exp(g_i)[..., None], state)
             + jnp.einsum('bhij,bhje->bhie', attn_i, v_new))
        g_last = g_i[..., -1]
        state = (state * jnp.exp(g_last)[..., None, None]
                 + jnp.einsum('bhcd,bhce->bhde', k_i * jnp.exp(g_last[..., None] - g_i)[..., None], v_new))
        return state, o

    xs = tuple(jnp.moveaxis(t, 2, 0) for t in (qc, kc, u, w, gcum, attn))
    state0 = jnp.zeros((B, H, GDN_DK, GDN_DV), F32)
    _, o = lax.scan(step, state0, xs)
    o = jnp.transpose(o, (1, 0, 3, 2, 4)).reshape(B, S, H, GDN_DV)
    o = o * lax.rsqrt(jnp.mean(o * o, axis=-1, keepdims=True) + EPS) * norm_g.astype(F32)
    o = o * jax.nn.silu(z.astype(F32).reshape(B, S, H, GDN_DV))
    return o.reshape(B, S, H * GDN_DV).astype(z.dtype)


def pool_mixer(xd, w_pool, scale):
    B, S, _ = xd.shape
    xf = xd.astype(F32).reshape(B, S, POOL_GROUPS, POOL_GW)
    cs = jnp.cumsum(xf, axis=1)
    t = jnp.arange(S)
    outs = []
    for gi, win in enumerate(POOL_WINDOWS):
        c = cs[:, :, gi]
        prev = jnp.pad(c, ((0, 0), (win, 0), (0, 0)))[:, :S]
        cnt = jnp.minimum(t + 1, win).astype(F32)[None, :, None]
        outs.append((c - prev) / cnt - xf[:, :, gi])
    pooled = jnp.stack(outs, axis=2)
    y = jnp.einsum('bsgc,gcd->bsgd', pooled, w_pool.astype(F32)).reshape(B, S, BRANCH_W)
    return (y * scale.astype(F32)).astype(xd.dtype)


def setup_inputs(seed: int = 0) -> dict:
    key = jax.random.key(seed)
    ks = iter(jax.random.split(key, 40))
    L, D = DEPTH, D_MODEL

    def nrm(shape, scale):
        return jax.random.normal(next(ks), shape, F32) * scale

    def gain(shape):
        return 1.0 + 0.02 * jax.random.normal(next(ks), shape, F32)

    x = jax.random.normal(next(ks), (BATCH, SEQ, D), F32)
    ff1_norm = gain((L, D))
    ff1_wg = nrm((L, D, D_FF), D ** -0.5)
    ff1_wu = nrm((L, D, D_FF), D ** -0.5)
    ff1_wd = nrm((L, D_FF, D), D_FF ** -0.5)
    mix_norm = gain((L, D))
    w_in = nrm((L, D, P_IN), D ** -0.5)
    sgu_ln_g = gain((L, BRANCH_W))
    sgu_ln_b = nrm((L, BRANCH_W), 0.02)
    sgu_w = nrm((L, SGU_GROUPS, SGU_BLOCK, SGU_BLOCK), 0.5 * SGU_BLOCK ** -0.5)
    sgu_b = 1.0 + nrm((L, SGU_GROUPS, SGU_BLOCK), 0.1)
    lru_conv_w = nrm((L, LRU_CONV, LRU_W), LRU_CONV ** -0.5)
    lru_conv_b = nrm((L, LRU_W), 0.02)
    lru_wa = nrm((L, LRU_HEADS, LRU_HD, LRU_HD), LRU_HD ** -0.5)
    lru_ba = nrm((L, LRU_W), 0.02)
    lru_wx = nrm((L, LRU_HEADS, LRU_HD, LRU_HD), LRU_HD ** -0.5)
    lru_bx = nrm((L, LRU_W), 0.02)
    a_c = jax.random.uniform(next(ks), (L, LRU_W), F32, minval=0.9, maxval=0.999)
    a_base = a_c ** (1.0 / LRU_C)
    lru_lambda = jnp.log(a_base) - jnp.log1p(-a_base)
    gdn_conv_w = nrm((L, GDN_CONV, GDN_HEADS * (2 * GDN_DK + GDN_DV)), GDN_CONV ** -0.5)
    gdn_a_log = jnp.log(jax.random.uniform(next(ks), (L, GDN_HEADS), F32, minval=1.0, maxval=16.0))
    lo, hi = math.log(1e-3), math.log(1e-1)
    dt = jnp.exp(jax.random.uniform(next(ks), (L, GDN_HEADS), F32) * (hi - lo) + lo)
    gdn_dt_bias = dt + jnp.log(-jnp.expm1(-dt))
    gdn_norm_g = gain((L, GDN_DV))
    pool_w = nrm((L, POOL_GROUPS, POOL_GW, POOL_GW), POOL_GW ** -0.5)
    pool_scale = 1.0 + nrm((L, BRANCH_W), 0.1)
    w_branch = nrm((L, N_BRANCH, BRANCH_W, D), BRANCH_W ** -0.5)
    w_out = nrm((L, D, D), D ** -0.5)
    ff2_norm = gain((L, D))
    ff2_wg = nrm((L, D, D_FF), D ** -0.5)
    ff2_wu = nrm((L, D, D_FF), D ** -0.5)
    ff2_wd = nrm((L, D_FF, D), D_FF ** -0.5)
    final_norm = gain((D,))
    return {'x': x, 'ff1_norm': ff1_norm, 'ff1_wg': ff1_wg, 'ff1_wu': ff1_wu, 'ff1_wd': ff1_wd,
            'mix_norm': mix_norm, 'w_in': w_in, 'sgu_ln_g': sgu_ln_g, 'sgu_ln_b': sgu_ln_b,
            'sgu_w': sgu_w, 'sgu_b': sgu_b, 'lru_conv_w': lru_conv_w, 'lru_conv_b': lru_conv_b,
            'lru_wa': lru_wa, 'lru_ba': lru_ba, 'lru_wx': lru_wx, 'lru_bx': lru_bx,
            'lru_lambda': lru_lambda, 'gdn_conv_w': gdn_conv_w, 'gdn_a_log': gdn_a_log,
            'gdn_dt_bias': gdn_dt_bias, 'gdn_norm_g': gdn_norm_g, 'pool_w': pool_w,
            'pool_scale': pool_scale, 'w_branch': w_branch, 'w_out': w_out,
            'ff2_norm': ff2_norm, 'ff2_wg': ff2_wg, 'ff2_wu': ff2_wu, 'ff2_wd': ff2_wd,
            'final_norm': final_norm}


def reference(x, ff1_norm, ff1_wg, ff1_wu, ff1_wd, mix_norm, w_in, sgu_ln_g, sgu_ln_b,
              sgu_w, sgu_b, lru_conv_w, lru_conv_b, lru_wa, lru_ba, lru_wx, lru_bx,
              lru_lambda, gdn_conv_w, gdn_a_log, gdn_dt_bias, gdn_norm_g, pool_w,
              pool_scale, w_branch, w_out, ff2_norm, ff2_wg, ff2_wu, ff2_wd, final_norm):
    B, S, _ = x.shape
    split_at = np.cumsum(IN_SIZES)[:-1].tolist()
    for l in range(DEPTH):
        x = x + 0.5 * swiglu(rms_norm(x, ff1_norm[l]), ff1_wg[l], ff1_wu[l], ff1_wd[l])
        h = rms_norm(x, mix_norm[l])
        proj = jnp.einsum('bsd,dp->bsp', h, w_in[l])
        (a_u, a_v, b_x, b_g, c_q, c_k, c_v, c_z, c_beta, c_alpha, d_x,
         gate_pre) = jnp.split(proj, split_at, axis=-1)
        y_a = sgu_mixer(a_u, a_v, sgu_ln_g[l], sgu_ln_b[l], sgu_w[l], sgu_b[l])
        y_b = rglru_mixer(b_x, b_g, lru_conv_w[l], lru_conv_b[l], lru_wa[l], lru_ba[l],
                          lru_wx[l], lru_bx[l], lru_lambda[l])
        y_c = gated_deltanet_mixer(c_q, c_k, c_v, c_z, c_beta, c_alpha, gdn_conv_w[l],
                                   gdn_a_log[l], gdn_dt_bias[l], gdn_norm_g[l])
        y_d = pool_mixer(d_x, pool_w[l], pool_scale[l])
        ys = jnp.stack([y_a, y_b, y_c, y_d], axis=2)
        br = jnp.einsum('bsgc,gcd->bsgd', ys, w_branch[l])
        gates = jax.nn.sigmoid(gate_pre.astype(F32)).astype(x.dtype).reshape(B, S, N_BRANCH, D_MODEL)
        merged = jnp.sum(gates * br, axis=2)
        x = x + jnp.einsum('bsd,de->bse', merged, w_out[l])
        x = x + 0.5 * swiglu(rms_norm(x, ff2_norm[l]), ff2_wg[l], ff2_wu[l], ff2_wd[l])
    return rms_norm(x, final_norm)
```

```cpp
#include <hip/hip_runtime.h>
#include <hip/hip_cooperative_groups.h>
#include <cstdio>
namespace cg = cooperative_groups;

#ifndef MULTI_LAUNCH
#define MULTI_LAUNCH 0
#endif

#ifndef PH_MASK
#define PH_MASK 0xFFFFF
#endif
#define PHON(k) if constexpr ((PH_MASK >> (k)) & 1)
#define LAS __attribute__((address_space(3)))
typedef unsigned short bf16_t;
typedef short bf16x8 __attribute__((ext_vector_type(8)));
typedef short bf16x4 __attribute__((ext_vector_type(4)));
typedef float f32x4 __attribute__((ext_vector_type(4)));
typedef unsigned u32x4 __attribute__((ext_vector_type(4)));
typedef unsigned u32x2 __attribute__((ext_vector_type(2)));

constexpr int T = 32768, D = 1024, DFF = 2816, NSLAB = 2, TS = T / NSLAB, SEQ = 4096, PW = 8960, PIN = 8712;
constexpr int PC_AU = 0, PC_AV = 512, PC_BX = 1024, PC_BG = 1536, PC_CQ = 2048, PC_CK = 2560, PC_CV = 3072, PC_CZ = 3584, PC_DX = 4096, PC_GATE = 4608, PC_AB = 8704;
constexpr float EPS = 1e-6f;
constexpr int NTHR = 512;
constexpr int LDS_BYTES = 147456;

constexpr size_t WS_WGU1 = 0;
constexpr size_t WS_WD1 = WS_WGU1 + (size_t)5632 * 1024 * 2;
constexpr size_t WS_WIN = WS_WD1 + (size_t)1024 * 2816 * 2;
constexpr size_t WS_WB = WS_WIN + (size_t)PW * 1024 * 2;
constexpr size_t WS_WOUT = WS_WB + (size_t)4 * 1024 * 512 * 2;
constexpr size_t WS_WGU2 = WS_WOUT + (size_t)1024 * 1024 * 2;
constexpr size_t WS_WD2 = WS_WGU2 + (size_t)5632 * 1024 * 2;
constexpr size_t WS_WAXT = WS_WD2 + (size_t)1024 * 2816 * 2;
constexpr size_t WS_PWT = WS_WAXT + 131072;
constexpr size_t WS_PROJ = WS_PWT + 131072;
constexpr size_t WS_H = WS_PROJ + (size_t)TS * PW * 2;
constexpr size_t WS_YS = WS_H + (size_t)T * D * 2;
constexpr size_t WS_AB = WS_YS + (size_t)4 * TS * 512 * 2;
constexpr size_t WS_HALO = WS_AB + (size_t)TS * 8 * 4;
constexpr size_t WS_AEND = WS_HALO + (size_t)(TS / 64) * 3 * 1536 * 2;
constexpr size_t WS_HEND = WS_AEND + (size_t)(TS / 64) * 512 * 4;
constexpr size_t WS_CARRY = WS_HEND + (size_t)(TS / 64) * 512 * 4;
constexpr size_t WS_EDEC = WS_CARRY + (size_t)(TS / 64) * 512 * 4;
constexpr size_t WS_END = WS_EDEC + 4096;

struct Params { const float* in[31]; float* out; unsigned char* ws; int ph_lo, ph_hi; };

__device__ __forceinline__ int ltid() { int t = threadIdx.x; asm volatile("" : "+v"(t)); return t; }
__device__ __forceinline__ int lbid() { int t = blockIdx.x; asm volatile("" : "+s"(t)); return t; }
__device__ __forceinline__ int lgdim() { int t = gridDim.x; asm volatile("" : "+s"(t)); return t; }
__device__ __forceinline__ int zz() { int z; asm volatile("s_mov_b32 %0, 0" : "=s"(z)); return z; }
template <class P> __device__ __forceinline__ P* lptr(P* q) { asm volatile("" : "+s"(q)); return q; }
__device__ __forceinline__ float bf2f(unsigned short b) { return __uint_as_float(((unsigned)b) << 16); }
__device__ __forceinline__ unsigned cvt_pk_bf16(float lo, float hi) { unsigned r; asm("v_cvt_pk_bf16_f32 %0, %1, %2" : "=v"(r) : "v"(lo), "v"(hi)); return r; }
__device__ __forceinline__ unsigned short f2bf(float f) { return (unsigned short)(cvt_pk_bf16(f, 0.f) & 0xffffu); }
__device__ __forceinline__ float lo_bf(unsigned w) { return __uint_as_float(w << 16); }
__device__ __forceinline__ float hi_bf(unsigned w) { return __uint_as_float(w & 0xffff0000u); }
__device__ __forceinline__ float sigmoidf_(float x) { return 1.0f / (1.0f + __expf(-x)); }
__device__ __forceinline__ float siluf_(float x) { return x / (1.0f + __expf(-x)); }
__device__ __forceinline__ float geluf_(float x) { const float u = 1.5957691216057308f * (x + 0.044715f * x * x * x); return x / (1.0f + __expf(-u)); }
__device__ __forceinline__ float softplusf_(float x) { return fmaxf(x, 0.f) + log1pf(__expf(-fabsf(x))); }
__device__ __forceinline__ float wave_sum(float v) {
#pragma unroll
    for (int o = 1; o < 64; o <<= 1) v += __shfl_xor(v, o);
    return v;
}

namespace pg8 {
constexpr int BM = 256, BK = 64, HALF = 128, HTB = HALF * BK * 2, STAGE_BYTES = 8 * HTB, NXCD = 8, WGM = 8;
__host__ __device__ __forceinline__ int lds_byte(int r, int c) { const int st = (r >> 4) * 2 + (c >> 5), rr = r & 15, cc = c & 31, ob = rr * 64 + cc * 2; return st * 1024 + (ob ^ (((ob >> 9) & 1) << 5)); }
__host__ __device__ __forceinline__ void stage_rc(int b, int& R, int& C) { const int st = b / 1024, sb = b % 1024, swz = sb ^ (((sb >> 9) & 1) << 5); R = (st >> 1) * 16 + swz / 64; C = (st & 1) * 32 + (swz % 64) / 2; }
__host__ __device__ __forceinline__ int perm32(int rho) { const int n = rho >> 4, i = rho & 15; return 8 * (i >> 2) + 4 * n + (i & 3); }

struct Unit { int pm, pn, g; };
struct Gemm { const bf16_t* A; const bf16_t* Bt; int M, N, K; size_t gsA, gsB; };

__device__ __forceinline__ void tile_of(int wgid, int nM, int nN, int nwg, Unit& u) {
    { const int q = nwg / NXCD, r = nwg % NXCD, xcd = wgid % NXCD, off = wgid / NXCD; wgid = (xcd < r ? xcd * (q + 1) : r * (q + 1) + (xcd - r) * q) + off; }
    const int nig = WGM * nN, gid = wgid / nig, fm = gid * WGM, gsz = (nM - fm) < WGM ? (nM - fm) : WGM;
    u.pm = fm + ((wgid % nig) % gsz); u.pn = (wgid % nig) / gsz;
}
struct StaticOrder {
    int nM, nN, nwg, G, c;
    __device__ void init(int M, int N, int G_, int c_) { nM = M / BM; nN = N / BM; nwg = nM * nN; G = G_; c = c_; }
    __device__ bool next(int i, Unit& u) const {
        const long L = (long)i * G + c; if (L >= nwg) return false;
        tile_of((int)L, nM, nN, nwg, u); u.g = 0; return true;
    }
};
struct BranchOrder {
    int nM, nN, nwg, G, c;
    __device__ void init(int M, int N, int G_, int c_) { nM = M / BM; nN = N / BM; nwg = nM * nN; G = G_; c = c_; }
    __device__ bool next(int i, Unit& u) const {
        const long L = (long)(i >> 2) * G + c; if (L >= nwg) return false;
        tile_of((int)L, nM, nN, nwg, u); u.g = i & 3; return true;
    }
};

struct EpiSwiGLU {
    static constexpr bool PERM = true;
    bf16_t* O;
    __device__ __forceinline__ bool keep(const Unit&) const { return false; }
    __device__ __forceinline__ void operator()(f32x4 (&acc)[2][2][4][2], const Unit& u, int wr, int wc, int fr, int fq) const {
        const int row0 = u.pm * BM + wr * 64 + fr, col0 = u.pn * 128 + wc * 32 + 8 * fq;
#pragma unroll
        for (int ai = 0; ai < 2; ++ai)
#pragma unroll
            for (int m = 0; m < 4; ++m) {
                bf16_t* rowp = O + (size_t)(row0 + ai * HALF + m * 16) * DFF + col0;
                float v[8];
#pragma unroll
                for (int n = 0; n < 2; ++n)
#pragma unroll
                    for (int j = 0; j < 4; ++j) v[n * 4 + j] = siluf_(acc[ai][0][m][n][j]) * acc[ai][1][m][n][j];
                u32x4 w; w.x = cvt_pk_bf16(v[0], v[1]); w.y = cvt_pk_bf16(v[2], v[3]); w.z = cvt_pk_bf16(v[4], v[5]); w.w = cvt_pk_bf16(v[6], v[7]);
                *(u32x4*)rowp = w;
                __builtin_amdgcn_sched_barrier(0);
            }
    }
};
struct EpiResid {
    static constexpr bool PERM = false;
    const float* Xin; float* Xout; float scale;
    __device__ __forceinline__ bool keep(const Unit&) const { return false; }
    __device__ __forceinline__ void operator()(f32x4 (&acc)[2][2][4][2], const Unit& u, int wr, int wc, int fr, int fq) const {
        const int row0 = u.pm * BM + wr * 64 + fr, col0 = u.pn * BM + wc * 32 + 4 * fq;
#pragma unroll
        for (int ai = 0; ai < 2; ++ai)
#pragma unroll
            for (int m = 0; m < 4; ++m) {
                const size_t ro = (size_t)(row0 + ai * HALF + m * 16) * D + col0;
#pragma unroll
                for (int bj = 0; bj < 2; ++bj)
#pragma unroll
                    for (int n = 0; n < 2; ++n) { const f32x4 xi = *(const f32x4*)(Xin + ro + bj * HALF + n * 16); *(f32x4*)(Xout + ro + bj * HALF + n * 16) = xi + acc[ai][bj][m][n] * scale; }
                __builtin_amdgcn_sched_barrier(0);
            }
    }
};
struct EpiProj {
    static constexpr bool PERM = true;
    bf16_t* O; float* AB;
    __device__ __forceinline__ bool keep(const Unit&) const { return false; }
    __device__ __forceinline__ void operator()(f32x4 (&acc)[2][2][4][2], const Unit& u, int wr, int wc, int fr, int fq) const {
        const int row0 = u.pm * BM + wr * 64 + fr, col0 = u.pn * BM + wc * 32 + 8 * fq;
        const bool ab = (u.pn == PC_AB / BM) && wc == 0 && fq == 0;
#pragma unroll
        for (int ai = 0; ai < 2; ++ai)
#pragma unroll
            for (int m = 0; m < 4; ++m) {
                const int row = row0 + ai * HALF + m * 16;
                bf16_t* rowp = O + (size_t)row * PW + col0;
#pragma unroll
                for (int bj = 0; bj < 2; ++bj) {
                    const f32x4 v0 = acc[ai][bj][m][0], v1 = acc[ai][bj][m][1];
                    u32x4 w; w.x = cvt_pk_bf16(v0[0], v0[1]); w.y = cvt_pk_bf16(v0[2], v0[3]); w.z = cvt_pk_bf16(v1[0], v1[1]); w.w = cvt_pk_bf16(v1[2], v1[3]);
                    *(u32x4*)(rowp + bj * HALF) = w;
                }
                __builtin_amdgcn_sched_barrier(0);
            }
        if (ab) {
#pragma unroll
            for (int ai = 0; ai < 2; ++ai)
#pragma unroll
                for (int m = 0; m < 4; ++m) { const int row = row0 + ai * HALF + m * 16; *(f32x4*)(AB + (size_t)row * 8) = acc[ai][0][m][0]; *(f32x4*)(AB + (size_t)row * 8 + 4) = acc[ai][0][m][1]; }
        }
    }
};
struct EpiBranch {
    static constexpr bool PERM = true;
    const bf16_t* P; bf16_t* O;
    __device__ __forceinline__ bool keep(const Unit& u) const { return u.g < 3; }
    __device__ __forceinline__ void operator()(f32x4 (&acc)[2][2][4][2], const Unit& u, int wr, int wc, int fr, int fq) const {
        const int row0 = u.pm * BM + wr * 64 + fr, col0 = u.pn * BM + wc * 32 + 8 * fq;
        const bool last = (u.g == 3);
#pragma unroll
        for (int ai = 0; ai < 2; ++ai)
#pragma unroll
            for (int m = 0; m < 4; ++m) {
                const int row = row0 + ai * HALF + m * 16;
                const bf16_t* gp = P + (size_t)row * PW + PC_GATE + u.g * D + col0;
#pragma unroll
                for (int bj = 0; bj < 2; ++bj) {
                    const u32x4 g0 = *(const u32x4*)(gp + bj * HALF);
                    float f[8];
                    if (!last) {
                        const u32x4 g1 = *(const u32x4*)(gp + D + bj * HALF);
#pragma unroll
                        for (int q = 0; q < 4; ++q) {
                            f[2 * q] = (1.0f + __expf(-lo_bf(g1[q]))) / (1.0f + __expf(-lo_bf(g0[q])));
                            f[2 * q + 1] = (1.0f + __expf(-hi_bf(g1[q]))) / (1.0f + __expf(-hi_bf(g0[q])));
                        }
                    } else {
#pragma unroll
                        for (int q = 0; q < 4; ++q) { f[2 * q] = 1.0f / (1.0f + __expf(-lo_bf(g0[q]))); f[2 * q + 1] = 1.0f / (1.0f + __expf(-hi_bf(g0[q]))); }
                    }
#pragma unroll
                    for (int n = 0; n < 2; ++n)
#pragma unroll
                        for (int j = 0; j < 4; ++j) acc[ai][bj][m][n][j] *= f[n * 4 + j];
                    if (last) {
                        const f32x4 v0 = acc[ai][bj][m][0], v1 = acc[ai][bj][m][1];
                        u32x4 w; w.x = cvt_pk_bf16(v0[0], v0[1]); w.y = cvt_pk_bf16(v0[2], v0[3]); w.z = cvt_pk_bf16(v1[0], v1[1]); w.w = cvt_pk_bf16(v1[2], v1[3]);
                        *(u32x4*)(O + (size_t)row * D + col0 + bj * HALF) = w;
                    }
                    __builtin_amdgcn_sched_barrier(0);
                }
            }
    }
};

template <class Epi, class Sched>
__device__ __forceinline__ void gemm_phase(LAS unsigned char* lds, const Gemm g, const Sched& S, const Epi& E) {
    const int tid = ltid(), wid = __builtin_amdgcn_readfirstlane(tid >> 6), lane = tid & 63, wr = wid >> 2, wc = wid & 3, fr = lane & 15, fq = lane >> 4;
    const int K = g.K, nt = K / BK;
    unsigned voffA[2], voffB[2];
#pragma unroll
    for (int i = 0; i < 2; ++i) { int R, C; stage_rc(tid * 16 + i * 8192, R, C); const int Rb = Epi::PERM ? ((R & ~31) + perm32(R & 31)) : R;
        voffA[i] = (unsigned)(R * K + C) * 2u; voffB[i] = (unsigned)(Rb * K + C) * 2u; }
    const size_t kstep = (size_t)(BK * 2);
    const size_t hstep = (size_t)HALF * K * 2;
    const size_t tstep = 2 * hstep;
    const unsigned ldsw = (unsigned)wid * 1024u;
    const int aoff = lds_byte(wr * 64 + fr, fq * 8), boff = lds_byte(wc * 32 + fr, fq * 8);
#define PG8_SA(b, h) (((b) * 2 + (h)) * HTB)
#define PG8_SB(b, h) ((4 + (b) * 2 + (h)) * HTB)
#define PG8_STAGE(bufoff, gbase, voff) do { _Pragma("unroll") for (int _i = 0; _i < 2; ++_i) \
        __builtin_amdgcn_global_load_lds((const unsigned*)((const char*)(gbase) + (voff)[_i]), (LAS unsigned*)(lds + (bufoff) + ldsw + _i * 8192), 16, 0, 0); } while (0)
#define PG8_LDA(dst, b, h) do { _Pragma("unroll") for (int m = 0; m < 4; ++m) _Pragma("unroll") for (int k = 0; k < 2; ++k) dst[m][k] = *(const LAS bf16x8*)(lds + PG8_SA(b, h) + aoff + m * 2048 + k * 1024); } while (0)
#define PG8_LDB(dst, b, h) do { _Pragma("unroll") for (int n = 0; n < 2; ++n) _Pragma("unroll") for (int k = 0; k < 2; ++k) dst[n][k] = *(const LAS bf16x8*)(lds + PG8_SB(b, h) + boff + n * 2048 + k * 1024); } while (0)
#define PG8_MMA(ai, bj, At, Bt) do { __builtin_amdgcn_s_setprio(1); _Pragma("unroll") for (int m = 0; m < 4; ++m) _Pragma("unroll") for (int n = 0; n < 2; ++n) _Pragma("unroll") for (int k = 0; k < 2; ++k) \
        acc[ai][bj][m][n] = __builtin_amdgcn_mfma_f32_16x16x32_bf16(Bt[n][k], At[m][k], acc[ai][bj][m][n], 0, 0, 0); __builtin_amdgcn_s_setprio(0); } while (0)
#define PG8_WAIT_V(n) asm volatile("s_waitcnt vmcnt(" #n ")" ::: "memory")
#define PG8_WAIT_L(n) asm volatile("s_waitcnt lgkmcnt(" #n ")" ::: "memory")
#define PG8_BAR __builtin_amdgcn_s_barrier()
#define PG8_SCHED __builtin_amdgcn_sched_barrier(0)
    Unit cur, nxt; int ui = 0;
    if (!S.next(0, cur)) return;
    f32x4 acc[2][2][4][2];
#pragma unroll
    for (int a = 0; a < 2; ++a)
#pragma unroll
        for (int b = 0; b < 2; ++b)
#pragma unroll
            for (int m = 0; m < 4; ++m)
#pragma unroll
                for (int n = 0; n < 2; ++n) acc[a][b][m][n] = (f32x4){0.f, 0.f, 0.f, 0.f};
    bf16x8 At[4][2], B0[2][2], B1[2][2];
    const char* cA = (const char*)g.A + (size_t)cur.g * g.gsA + (size_t)cur.pm * tstep; const char* cB = (const char*)g.Bt + (size_t)cur.g * g.gsB + (size_t)cur.pn * tstep;
    PG8_STAGE(PG8_SB(0, 0), cB, voffB); PG8_STAGE(PG8_SA(0, 0), cA, voffA); PG8_STAGE(PG8_SB(0, 1), cB + hstep, voffB); PG8_STAGE(PG8_SA(0, 1), cA + hstep, voffA);
    if (wr == 1) PG8_BAR;
    PG8_WAIT_V(4); PG8_BAR;
    PG8_STAGE(PG8_SB(1, 0), cB + kstep, voffB); PG8_STAGE(PG8_SA(1, 0), cA + kstep, voffA); PG8_STAGE(PG8_SB(1, 1), cB + hstep + kstep, voffB);
    PG8_WAIT_V(6); PG8_BAR;
    for (;;) {
        const bool has_next = S.next(ui + 1, nxt);
        const char* nA = has_next ? (const char*)g.A + (size_t)nxt.g * g.gsA + (size_t)nxt.pm * tstep : cA; const char* nB = has_next ? (const char*)g.Bt + (size_t)nxt.g * g.gsB + (size_t)nxt.pn * tstep : cB;
        for (int t = 0; t < nt; t += 2) {
            const bool last = (t == nt - 2);
            const char* a1 = cA + (size_t)(t + 1) * kstep;
            const char* a2 = last ? nA : cA + (size_t)(t + 2) * kstep; const char* b2 = last ? nB : cB + (size_t)(t + 2) * kstep;
            const char* a3 = a2 + kstep; const char* b3 = b2 + kstep;
            PG8_LDB(B0, 0, 0); PG8_SCHED; PG8_LDA(At, 0, 0); PG8_STAGE(PG8_SA(1, 1), a1 + hstep, voffA);
            PG8_WAIT_L(8); PG8_BAR; PG8_WAIT_L(0); PG8_MMA(0, 0, At, B0); PG8_BAR; PG8_SCHED;
            PG8_LDB(B1, 0, 1); PG8_STAGE(PG8_SB(0, 0), b2, voffB);
            PG8_BAR; PG8_WAIT_L(0); PG8_MMA(0, 1, At, B1); PG8_BAR;
            PG8_LDA(At, 0, 1); PG8_STAGE(PG8_SA(0, 0), a2, voffA);
            PG8_BAR; PG8_WAIT_L(0); PG8_MMA(1, 0, At, B0); PG8_BAR; PG8_SCHED;
            PG8_STAGE(PG8_SB(0, 1), b2 + hstep, voffB);
            PG8_WAIT_V(6); PG8_BAR; PG8_MMA(1, 1, At, B1); PG8_BAR;
            PG8_LDB(B0, 1, 0); PG8_SCHED; PG8_LDA(At, 1, 0); PG8_STAGE(PG8_SA(0, 1), a2 + hstep, voffA);
            PG8_WAIT_L(8); PG8_BAR; PG8_WAIT_L(0); PG8_MMA(0, 0, At, B0); PG8_BAR; PG8_SCHED;
            PG8_LDB(B1, 1, 1); PG8_STAGE(PG8_SB(1, 0), b3, voffB);
            PG8_BAR; PG8_WAIT_L(0); PG8_MMA(0, 1, At, B1); PG8_BAR;
            PG8_LDA(At, 1, 1); PG8_STAGE(PG8_SA(1, 0), a3, voffA);
            PG8_BAR; PG8_WAIT_L(0); PG8_MMA(1, 0, At, B0); PG8_BAR; PG8_SCHED;
            PG8_STAGE(PG8_SB(1, 1), b3 + hstep, voffB);
            PG8_WAIT_V(6); PG8_BAR; PG8_MMA(1, 1, At, B1); PG8_BAR;
        }
        E(acc, cur, wr, wc, fr, fq);
        if (!has_next) break;
        if (!E.keep(cur)) {
#pragma unroll
            for (int a = 0; a < 2; ++a)
#pragma unroll
                for (int b = 0; b < 2; ++b)
#pragma unroll
                    for (int m = 0; m < 4; ++m)
#pragma unroll
                        for (int n = 0; n < 2; ++n) acc[a][b][m][n] = (f32x4){0.f, 0.f, 0.f, 0.f};
        }
        cur = nxt; cA = nA; cB = nB; ++ui;
    }
    PG8_WAIT_V(0);
    if (wr == 0) PG8_BAR;
    PG8_BAR;
#undef PG8_SA
#undef PG8_SB
#undef PG8_STAGE
#undef PG8_LDA
#undef PG8_LDB
#undef PG8_MMA
#undef PG8_WAIT_V
#undef PG8_WAIT_L
#undef PG8_BAR
#undef PG8_SCHED
}
}


#define NOINL __forceinline__
__device__ NOINL void ph_gemm_swiglu(LAS unsigned char* lds, const bf16_t* A, const bf16_t* Bt, bf16_t* O) {
    pg8::Gemm g{A, Bt, T, 2 * DFF, D, 0, 0}; pg8::StaticOrder S; S.init(g.M, g.N, lgdim(), lbid()); pg8::EpiSwiGLU E{O}; pg8::gemm_phase(lds, g, S, E);
}
__device__ NOINL void ph_gemm_resid(LAS unsigned char* lds, const bf16_t* A, const bf16_t* Bt, int M, int K, const float* Xin, float* Xout, float scale) {
    pg8::Gemm g{A, Bt, M, D, K, 0, 0}; pg8::StaticOrder S; S.init(g.M, g.N, lgdim(), lbid()); pg8::EpiResid E{Xin, Xout, scale}; pg8::gemm_phase(lds, g, S, E);
}
__device__ NOINL void ph_gemm_proj(LAS unsigned char* lds, const bf16_t* A, const bf16_t* Bt, bf16_t* O, float* AB) {
    pg8::Gemm g{A, Bt, TS, PW, D, 0, 0}; pg8::StaticOrder S; S.init(g.M, g.N, lgdim(), lbid()); pg8::EpiProj E{O, AB}; pg8::gemm_phase(lds, g, S, E);
}
__device__ NOINL void ph_gemm_branch(LAS unsigned char* lds, const bf16_t* A, const bf16_t* Bt, const bf16_t* P, bf16_t* O) {
    pg8::Gemm g{A, Bt, TS, D, 512, (size_t)TS * 512 * 2, (size_t)D * 512 * 2}; pg8::BranchOrder S; S.init(g.M, g.N, lgdim(), lbid()); pg8::EpiBranch E{P, O}; pg8::gemm_phase(lds, g, S, E);
}

__device__ __forceinline__ void conv_tile(LAS float* scr, const float* src0, const float* src1, int K, int Nsrc, bf16_t* dst, int mode, int tile) {
    const int nkt = K / 64, kt = tile % nkt, rt = tile / nkt, k0 = kt * 64, r0 = rt * 64, tid = ltid();
    {
        const int kk = tid >> 3, rr = (tid & 7) * 8, rho = r0 + rr;
        const float* src = src0; int col = rho;
        if (mode == 1) { const int pn = rho >> 8, bj = (rho >> 7) & 1, j = rho & 127; col = pn * 128 + j; src = bj ? src1 : src0; }
        else if (mode == 2) { col = rho < 4096 ? rho : (rho < 8704 ? rho + 8 : (rho < 8712 ? rho - 8704 + 4096 : -1)); }
        f32x4 a = (f32x4){0.f, 0.f, 0.f, 0.f}, b = a;
        if (col >= 0) { const float* sp = src + (size_t)(k0 + kk) * Nsrc + col; a = *(const f32x4*)sp; b = *(const f32x4*)(sp + 4); }
#pragma unroll
        for (int e = 0; e < 4; ++e) { scr[(rr + e) * 65 + kk] = a[e]; scr[(rr + 4 + e) * 65 + kk] = b[e]; }
    }
    __syncthreads();
    {
        const int rl = tid >> 3, kc = (tid & 7) * 8;
        const LAS float* s = scr + rl * 65 + kc;
        u32x4 w; w.x = cvt_pk_bf16(s[0], s[1]); w.y = cvt_pk_bf16(s[2], s[3]); w.z = cvt_pk_bf16(s[4], s[5]); w.w = cvt_pk_bf16(s[6], s[7]);
        *(u32x4*)(dst + (size_t)(r0 + rl) * K + k0 + kc) = w;
    }
    __syncthreads();
}

__device__ __forceinline__ void convert_layer(LAS unsigned char* lds, const Params& p, int l) {
    LAS float* scr = (LAS float*)lds;
    unsigned char* ws = lptr(p.ws);
    constexpr int N1 = 16 * 88, N2 = 44 * 16, N3 = 16 * 140, N4 = 8 * 16, N5 = 16 * 16;
    constexpr int TOT = N1 + N2 + N3 + 4 * N4 + N5 + N1 + N2;
    for (int it = lbid(); it < TOT; it += lgdim()) {
        int r = it;
        if (r < N1) { conv_tile(scr, p.in[zz() + 2] + (size_t)l * D * DFF, p.in[zz() + 3] + (size_t)l * D * DFF, D, DFF, (bf16_t*)(ws + WS_WGU1), 1, r); continue; } r -= N1;
        if (r < N2) { conv_tile(scr, p.in[zz() + 4] + (size_t)l * DFF * D, nullptr, DFF, D, (bf16_t*)(ws + WS_WD1), 0, r); continue; } r -= N2;
        if (r < N3) { conv_tile(scr, p.in[zz() + 6] + (size_t)l * D * PIN, nullptr, D, PIN, (bf16_t*)(ws + WS_WIN), 2, r); continue; } r -= N3;
        if (r < 4 * N4) { const int g = r / N4; conv_tile(scr, p.in[zz() + 24] + ((size_t)l * 4 + g) * 512 * D, nullptr, 512, D, (bf16_t*)(ws + WS_WB) + (size_t)g * D * 512, 0, r % N4); continue; } r -= 4 * N4;
        if (r < N5) { conv_tile(scr, p.in[zz() + 25] + (size_t)l * D * D, nullptr, D, D, (bf16_t*)(ws + WS_WOUT), 0, r); continue; } r -= N5;
        if (r < N1) { conv_tile(scr, p.in[zz() + 27] + (size_t)l * D * DFF, p.in[zz() + 28] + (size_t)l * D * DFF, D, DFF, (bf16_t*)(ws + WS_WGU2), 1, r); continue; } r -= N1;
        conv_tile(scr, p.in[zz() + 29] + (size_t)l * DFF * D, nullptr, DFF, D, (bf16_t*)(ws + WS_WD2), 0, r);
    }
    bf16_t* waxt = (bf16_t*)(ws + WS_WAXT); bf16_t* pwt = (bf16_t*)(ws + WS_PWT);
    const float* wa = p.in[zz() + 13] + (size_t)l * 8 * 64 * 64; const float* wx = p.in[zz() + 15] + (size_t)l * 8 * 64 * 64; const float* pw = p.in[zz() + 22] + (size_t)l * 4 * 128 * 128;
    for (int e = lbid() * NTHR + ltid(); e < 65536; e += lgdim() * NTHR) {
        { const int h = e >> 13, jp = (e >> 6) & 127, i = e & 63; waxt[e] = f2bf(jp < 64 ? wa[(h * 64 + i) * 64 + jp] : wx[(h * 64 + i) * 64 + jp - 64]); }
        { const int g = e >> 14, d = (e >> 7) & 127, c = e & 127; pwt[e] = f2bf(pw[(g * 128 + c) * 128 + d]); }
    }
}

__device__ __forceinline__ void rms_rows_bf16(const float* X, const float* gain, bf16_t* H, int nrows) {
    const int wid = ltid() >> 6, lane = ltid() & 63;
    f32x4 gv[4];
#pragma unroll
    for (int j = 0; j < 4; ++j) gv[j] = *(const f32x4*)(gain + (lane + 64 * j) * 4);
    for (int row = lbid() * 8 + wid; row < nrows; row += lgdim() * 8) {
        const f32x4* xr = (const f32x4*)(X + (size_t)row * D) + lane;
        f32x4 v[4]; float s = 0.f;
#pragma unroll
        for (int j = 0; j < 4; ++j) { v[j] = xr[64 * j]; s += (v[j].x * v[j].x + v[j].y * v[j].y) + (v[j].z * v[j].z + v[j].w * v[j].w); }
        const float rs = rsqrtf(wave_sum(s) * (1.0f / D) + EPS);
        u32x2* o = (u32x2*)(H + (size_t)row * D) + lane;
#pragma unroll
        for (int j = 0; j < 4; ++j) { u32x2 w; w.x = cvt_pk_bf16(v[j].x * rs * gv[j].x, v[j].y * rs * gv[j].y); w.y = cvt_pk_bf16(v[j].z * rs * gv[j].z, v[j].w * rs * gv[j].w); o[64 * j] = w; }
    }
}
__device__ __forceinline__ void rms_rows_f32_inplace(float* X, const float* gain, int nrows) {
    const int wid = ltid() >> 6, lane = ltid() & 63;
    f32x4 gv[4];
#pragma unroll
    for (int j = 0; j < 4; ++j) gv[j] = *(const f32x4*)(gain + (lane + 64 * j) * 4);
    for (int row = lbid() * 8 + wid; row < nrows; row += lgdim() * 8) {
        f32x4* xr = (f32x4*)(X + (size_t)row * D) + lane;
        f32x4 v[4]; float s = 0.f;
#pragma unroll
        for (int j = 0; j < 4; ++j) { v[j] = xr[64 * j]; s += (v[j].x * v[j].x + v[j].y * v[j].y) + (v[j].z * v[j].z + v[j].w * v[j].w); }
        const float rs = rsqrtf(wave_sum(s) * (1.0f / D) + EPS);
#pragma unroll
        for (int j = 0; j < 4; ++j) xr[64 * j] = v[j] * rs * gv[j];
    }
}

__device__ __forceinline__ void sgu_tile(LAS unsigned char* lds, const Params& p, int l, const bf16_t* proj, bf16_t* ya, int tile) {
    const int tid = ltid(), wid = tid >> 6, lane = tid & 63, fr = lane & 15, fq = lane >> 4;
    const int blk = tile >> 2, g = tile & 3, r0 = blk * 128;
    LAS bf16_t* Wl = (LAS bf16_t*)lds;
    LAS bf16_t* VT = (LAS bf16_t*)(lds + 34816);
    const float* lng = p.in[zz() + 7] + l * 512 + g * 128; const float* lnb = p.in[zz() + 8] + l * 512 + g * 128;
    {
        const int i = tid >> 2, qd = tid & 3;
        const bf16_t* vrow = proj + (size_t)(r0 + i) * PW + PC_AV + qd * 128;
        float s = 0.f, s2 = 0.f;
#pragma unroll 4
        for (int e8 = 0; e8 < 16; ++e8) { const u32x4 w = *(const u32x4*)(vrow + e8 * 8);
#pragma unroll
            for (int q = 0; q < 4; ++q) { const float a = geluf_(lo_bf(w[q])), b = geluf_(hi_bf(w[q])); s += a + b; s2 += a * a + b * b; } }
        s += __shfl_xor(s, 1); s += __shfl_xor(s, 2); s2 += __shfl_xor(s2, 1); s2 += __shfl_xor(s2, 2);
        const float mean = s * (1.0f / 512.0f), var = fmaxf(s2 * (1.0f / 512.0f) - mean * mean, 0.f), rstd = rsqrtf(var + EPS);
        const bf16_t* vg = proj + (size_t)(r0 + i) * PW + PC_AV + g * 128 + qd * 32;
#pragma unroll
        for (int e8 = 0; e8 < 4; ++e8) { const u32x4 w = *(const u32x4*)(vg + e8 * 8);
#pragma unroll
            for (int q = 0; q < 4; ++q) { const int c = qd * 32 + e8 * 8 + 2 * q;
                VT[c * 136 + i] = f2bf((geluf_(lo_bf(w[q])) - mean) * rstd * lng[c] + lnb[c]);
                VT[(c + 1) * 136 + i] = f2bf((geluf_(hi_bf(w[q])) - mean) * rstd * lng[c + 1] + lnb[c + 1]); } }
        const float* wsrc = p.in[zz() + 9] + (((size_t)l * 4 + g) * 128 + i) * 128 + qd * 32;
#pragma unroll
        for (int e4 = 0; e4 < 8; ++e4) { f32x4 w = *(const f32x4*)(wsrc + e4 * 4); if (i < 64 && qd >= 2) w = (f32x4){0.f, 0.f, 0.f, 0.f};
            u32x2 o; o.x = cvt_pk_bf16(w.x, w.y); o.y = cvt_pk_bf16(w.z, w.w); *(LAS u32x2*)(Wl + i * 136 + qd * 32 + e4 * 4) = o; }
    }
    __syncthreads();
    f32x4 acc[8];
#pragma unroll
    for (int n = 0; n < 8; ++n) acc[n] = (f32x4){0.f, 0.f, 0.f, 0.f};
#pragma unroll
    for (int ks = 0; ks < 4; ++ks) {
        const bf16x8 af = *(const LAS bf16x8*)(Wl + (wid * 16 + fr) * 136 + ks * 32 + fq * 8);
#pragma unroll
        for (int n = 0; n < 8; ++n) { const bf16x8 bf = *(const LAS bf16x8*)(VT + (n * 16 + fr) * 136 + ks * 32 + fq * 8); acc[n] = __builtin_amdgcn_mfma_f32_16x16x32_bf16(bf, af, acc[n], 0, 0, 0); }
    }
    {
        const int i = wid * 16 + fr; const float bias = p.in[zz() + 10][((size_t)l * 4 + g) * 128 + i];
        const bf16_t* up = proj + (size_t)(r0 + i) * PW + PC_AU + g * 128 + fq * 4;
        bf16_t* yp = ya + (size_t)(r0 + i) * 512 + g * 128 + fq * 4;
#pragma unroll
        for (int n = 0; n < 8; ++n) { const u32x2 uw = *(const u32x2*)(up + n * 16);
            u32x2 o; o.x = cvt_pk_bf16((acc[n][0] + bias) * geluf_(lo_bf(uw.x)), (acc[n][1] + bias) * geluf_(hi_bf(uw.x)));
            o.y = cvt_pk_bf16((acc[n][2] + bias) * geluf_(lo_bf(uw.y)), (acc[n][3] + bias) * geluf_(hi_bf(uw.y))); *(u32x2*)(yp + n * 16) = o; }
    }
    __syncthreads();
}

template <int WIN>
__device__ __forceinline__ void pool_rows(LAS bf16_t* Al, const bf16_t* xcol, int c, int pos0) {
    float xv[80];
#pragma unroll
    for (int k = 0; k < 80; ++k) xv[k] = (pos0 - 16 + k >= 0) ? bf2f(xcol[(long)(k - 16) * PW]) : 0.f;
    float s = 0.f;
#pragma unroll
    for (int j = 0; j < WIN; ++j) s += xv[16 - j];
#pragma unroll
    for (int tt = 0; tt < 64; ++tt) {
        const int k = tt + 16;
        const int cnt = min(pos0 + tt + 1, WIN);
        Al[tt * 520 + c] = f2bf(s / (float)cnt - xv[k]);
        if (tt < 63) s += xv[k + 1] - xv[k + 1 - WIN];
    }
}
__device__ __forceinline__ void pool_tile(LAS unsigned char* lds, const Params& p, int l, const bf16_t* proj, bf16_t* yd, bf16_t* halo, const bf16_t* pwt, int tile) {
    const int tid = ltid(), wid = tid >> 6, lane = tid & 63, fr = lane & 15, fq = lane >> 4;
    const int t0 = tile * 64, pos0 = t0 % SEQ;
    LAS bf16_t* Al = (LAS bf16_t*)lds;
    {
        const int c = tid, g = wid >> 1;
        const bf16_t* xcol = proj + (size_t)t0 * PW + PC_DX + c;
        if (g == 0) pool_rows<2>(Al, xcol, c, pos0); else if (g == 1) pool_rows<4>(Al, xcol, c, pos0); else if (g == 2) pool_rows<8>(Al, xcol, c, pos0); else pool_rows<16>(Al, xcol, c, pos0);
    }
    if ((tile + 1) % 64 != 0) {
        for (int e = tid; e < 4608; e += NTHR) { const int r = e / 1536, cc = e % 1536; halo[((size_t)(tile + 1) * 3 + r) * 1536 + cc] = proj[(size_t)(t0 + 61 + r) * PW + PC_CQ + cc]; }
    }
    __syncthreads();
    {
        const int g = wid >> 1, nh = wid & 1;
        f32x4 acc[4][4];
#pragma unroll
        for (int m = 0; m < 4; ++m)
#pragma unroll
            for (int n = 0; n < 4; ++n) acc[m][n] = (f32x4){0.f, 0.f, 0.f, 0.f};
#pragma unroll
        for (int ks = 0; ks < 4; ++ks) {
            bf16x8 bfr[4];
#pragma unroll
            for (int n = 0; n < 4; ++n) bfr[n] = *(const bf16x8*)(pwt + ((size_t)(g * 128 + (nh * 4 + n) * 16 + fr)) * 128 + ks * 32 + fq * 8);
#pragma unroll
            for (int m = 0; m < 4; ++m) { const bf16x8 af = *(const LAS bf16x8*)(Al + (m * 16 + fr) * 520 + g * 128 + ks * 32 + fq * 8);
#pragma unroll
                for (int n = 0; n < 4; ++n) acc[m][n] = __builtin_amdgcn_mfma_f32_16x16x32_bf16(bfr[n], af, acc[m][n], 0, 0, 0); }
        }
        const float* sc = p.in[zz() + 23] + l * 512 + g * 128;
#pragma unroll
        for (int n = 0; n < 4; ++n) { const int d = (nh * 4 + n) * 16 + fq * 4; const f32x4 s4 = *(const f32x4*)(sc + d);
#pragma unroll
            for (int m = 0; m < 4; ++m) { u32x2 o; o.x = cvt_pk_bf16(acc[m][n][0] * s4[0], acc[m][n][1] * s4[1]); o.y = cvt_pk_bf16(acc[m][n][2] * s4[2], acc[m][n][3] * s4[3]);
                *(u32x2*)(yd + (size_t)(t0 + m * 16 + fr) * 512 + g * 128 + d) = o; } }
    }
    __syncthreads();
}

__device__ __forceinline__ void lru_tile(LAS unsigned char* lds, const Params& p, int l, const bf16_t* proj, bf16_t* yb, const bf16_t* waxt, float* Aend, float* Hend, const float* carry, int tile, int mode) {
    const int tid = ltid(), wid = tid >> 6, lane = tid & 63, fr = lane & 15, fq = lane >> 4;
    const int t0 = tile * 64, pos0 = t0 % SEQ, c = wid * 64 + lane;
    LAS bf16_t* Aw = (LAS bf16_t*)(lds + wid * 10560);
    LAS float* Xw = (LAS float*)(lds + wid * 10560 + 2304);
    bf16x8 bfr[8][2];
#pragma unroll
    for (int n = 0; n < 8; ++n)
#pragma unroll
        for (int ks = 0; ks < 2; ++ks) bfr[n][ks] = *(const bf16x8*)(waxt + ((size_t)(wid * 128 + n * 16 + fr)) * 64 + ks * 32 + fq * 8);
    const float* cwp = p.in[zz() + 11] + (size_t)l * 4 * 512 + c;
    const float cw0 = cwp[0], cw1 = cwp[512], cw2 = cwp[1024], cw3 = cwp[1536], cb = p.in[zz() + 12][l * 512 + c];
    const float ba = p.in[zz() + 14][l * 512 + c], bx = p.in[zz() + 16][l * 512 + c], sp8 = 8.0f * softplusf_(-p.in[zz() + 17][l * 512 + c]);
    const bf16_t* xcol = proj + (size_t)t0 * PW + PC_BX + c;
    float xm3 = 0.f, xm2 = 0.f, xm1 = 0.f;
    if (pos0 > 0) { xm3 = bf2f(xcol[-3L * PW]); xm2 = bf2f(xcol[-2L * PW]); xm1 = bf2f(xcol[-1L * PW]); }
    const bf16_t* gcol = proj + (size_t)t0 * PW + PC_BG + c;
    bf16_t* ycol = yb + (size_t)t0 * 512 + c;
    float h = mode ? carry[(size_t)tile * 512 + c] : 0.f, Ap = 1.f;
    for (int sub = 0; sub < 4; ++sub) {
        float xc[16];
#pragma unroll
        for (int tt = 0; tt < 16; ++tt) { const float xin = bf2f(*xcol); xcol += PW; xc[tt] = cb + cw0 * xm3 + cw1 * xm2 + cw2 * xm1 + cw3 * xin; xm3 = xm2; xm2 = xm1; xm1 = xin; Aw[tt * 72 + lane] = f2bf(xc[tt]); }
        __syncthreads();
        f32x4 acc[8];
#pragma unroll
        for (int n = 0; n < 8; ++n) acc[n] = (f32x4){0.f, 0.f, 0.f, 0.f};
#pragma unroll
        for (int ks = 0; ks < 2; ++ks) { const bf16x8 af = *(const LAS bf16x8*)(Aw + fr * 72 + ks * 32 + fq * 8);
#pragma unroll
            for (int n = 0; n < 8; ++n) acc[n] = __builtin_amdgcn_mfma_f32_16x16x32_bf16(bfr[n][ks], af, acc[n], 0, 0, 0); }
#pragma unroll
        for (int n = 0; n < 8; ++n)
#pragma unroll
            for (int j = 0; j < 4; ++j) Xw[fr * 129 + n * 16 + fq * 4 + j] = acc[n][j];
        __syncthreads();
#pragma unroll
        for (int tt = 0; tt < 16; ++tt) {
            const float r = sigmoidf_(Xw[tt * 129 + lane] + ba), ig = sigmoidf_(Xw[tt * 129 + 64 + lane] + bx);
            const float la = -sp8 * r, a = __expf(la), x2 = 2.0f * la;
            const float om = (x2 > -0.1f) ? -x2 * (1.0f + x2 * (0.5f + x2 * (0.16666667f + x2 * 0.041666668f))) : 1.0f - a * a;
            h = a * h + sqrtf(om) * ig * xc[tt]; Ap *= a;
            if (mode) { const float gt = bf2f(*gcol); gcol += PW; *ycol = f2bf(h * geluf_(gt)); ycol += 512; }
        }
        __syncthreads();
    }
    if (!mode) { Aend[(size_t)tile * 512 + c] = Ap; Hend[(size_t)tile * 512 + c] = h; }
}
__device__ __forceinline__ void lru_carry(const float* Aend, const float* Hend, float* carry) {
    const int gid = lbid() * NTHR + ltid();
    if (gid < (TS / SEQ) * 512) {
        const int bl = gid >> 9, c = gid & 511; float h = 0.f;
        for (int n = 0; n < 64; ++n) { const size_t o = (size_t)(bl * 64 + n) * 512 + c; carry[o] = h; h = Aend[o] * h + Hend[o]; }
    }
}

__device__ __forceinline__ void gdn_prep(LAS unsigned char* lds, const Params& p, int l, bf16_t* proj, const float* AB, const bf16_t* halo, float* edec, int item) {
    const int tid = ltid(), wid = tid >> 6, lane = tid & 63, fr = lane & 15, fq = lane >> 4;
    const int bl = item >> 8, n = (item & 255) >> 2, hh = item & 3, ch = bl * 64 + n, t0 = ch * 64;
    LAS bf16_t* Kl = (LAS bf16_t*)lds;
    LAS bf16_t* Ql = (LAS bf16_t*)(lds + 17408);
    LAS float* RHS = (LAS float*)(lds + 34816);
    LAS float* Am = (LAS float*)(lds + 100352);
    LAS float* gc = (LAS float*)(lds + 116736);
    LAS float* bt = (LAS float*)(lds + 116992);
    const int t = tid >> 3, d0 = (tid & 7) * 16;
    float qkv[3][16];
#pragma unroll
    for (int sec = 0; sec < 3; ++sec) {
        const int colh = sec * 512 + hh * 128 + d0;
        float a[16];
#pragma unroll
        for (int e = 0; e < 16; ++e) a[e] = 0.f;
#pragma unroll
        for (int k = 0; k < 4; ++k) {
            const int tt = t - 3 + k;
            const bf16_t* src = nullptr;
            if (tt >= 0) src = proj + (size_t)(t0 + tt) * PW + PC_CQ + colh; else if (n > 0) src = halo + ((size_t)ch * 3 + (tt + 3)) * 1536 + colh;
            if (src) {
                const u32x4 w0 = *(const u32x4*)src, w1 = *(const u32x4*)(src + 8);
                const float* cw = p.in[zz() + 18] + ((size_t)l * 4 + k) * 1536 + colh;
#pragma unroll
                for (int q = 0; q < 4; ++q) { const f32x4 c4 = *(const f32x4*)(cw + q * 4);
                    const unsigned wa = (q < 2) ? w0[2 * q] : w1[2 * q - 4], wb = (q < 2) ? w0[2 * q + 1] : w1[2 * q - 3];
                    a[q * 4 + 0] += c4[0] * lo_bf(wa); a[q * 4 + 1] += c4[1] * hi_bf(wa); a[q * 4 + 2] += c4[2] * lo_bf(wb); a[q * 4 + 3] += c4[3] * hi_bf(wb); }
            }
        }
#pragma unroll
        for (int e = 0; e < 16; ++e) qkv[sec][e] = siluf_(a[e]);
    }
    {
        float sq = 0.f, sk = 0.f;
#pragma unroll
        for (int e = 0; e < 16; ++e) { sq += qkv[0][e] * qkv[0][e]; sk += qkv[1][e] * qkv[1][e]; }
        sq += __shfl_xor(sq, 1); sq += __shfl_xor(sq, 2); sq += __shfl_xor(sq, 4); sk += __shfl_xor(sk, 1); sk += __shfl_xor(sk, 2); sk += __shfl_xor(sk, 4);
        const float qn = rsqrtf(sq + EPS) * 0.08838834764831845f, kn = rsqrtf(sk + EPS);
#pragma unroll
        for (int e = 0; e < 16; ++e) { qkv[0][e] *= qn; qkv[1][e] *= kn; }
#pragma unroll
        for (int e = 0; e < 16; e += 2) { *(LAS unsigned*)(Ql + t * 136 + d0 + e) = cvt_pk_bf16(qkv[0][e], qkv[0][e + 1]); *(LAS unsigned*)(Kl + t * 136 + d0 + e) = cvt_pk_bf16(qkv[1][e], qkv[1][e + 1]); }
    }
    if (wid == 0) {
        const float al = AB[(size_t)(t0 + lane) * 8 + 4 + hh], be = AB[(size_t)(t0 + lane) * 8 + hh];
        float gv = -__expf(p.in[zz() + 19][l * 4 + hh]) * softplusf_(al + p.in[zz() + 20][l * 4 + hh]);
#pragma unroll
        for (int o = 1; o < 64; o <<= 1) { const float u = __shfl_up(gv, o); if (lane >= o) gv += u; }
        gc[lane] = gv; bt[lane] = sigmoidf_(be);
        if (lane == 63) edec[item] = __expf(gv);
    }
    __syncthreads();
    {
        const float bet = bt[t], gct = gc[t], eg = __expf(gct), ekd = __expf(gc[63] - gct);
#pragma unroll
        for (int e = 0; e < 16; ++e) { RHS[t * 256 + d0 + e] = qkv[2][e] * bet; RHS[t * 256 + 128 + d0 + e] = qkv[1][e] * bet * eg; }
        bf16_t* qdst = proj + (size_t)(t0 + t) * PW + PC_CQ + hh * 128 + d0;
        u32x4 w0, w1;
        w0.x = cvt_pk_bf16(qkv[0][0] * eg, qkv[0][1] * eg); w0.y = cvt_pk_bf16(qkv[0][2] * eg, qkv[0][3] * eg); w0.z = cvt_pk_bf16(qkv[0][4] * eg, qkv[0][5] * eg); w0.w = cvt_pk_bf16(qkv[0][6] * eg, qkv[0][7] * eg);
        w1.x = cvt_pk_bf16(qkv[0][8] * eg, qkv[0][9] * eg); w1.y = cvt_pk_bf16(qkv[0][10] * eg, qkv[0][11] * eg); w1.z = cvt_pk_bf16(qkv[0][12] * eg, qkv[0][13] * eg); w1.w = cvt_pk_bf16(qkv[0][14] * eg, qkv[0][15] * eg);
        *(u32x4*)qdst = w0; *(u32x4*)(qdst + 8) = w1;
#pragma unroll
        for (int e = 0; e < 16; ++e) qkv[1][e] *= ekd;
    }
    {
        const int it = wid & 3, which = wid >> 2;
        LAS bf16_t* Xi = which ? Ql : Kl;
        bf16x8 af[4];
#pragma unroll
        for (int ks = 0; ks < 4; ++ks) af[ks] = *(const LAS bf16x8*)(Xi + (it * 16 + fr) * 136 + ks * 32 + fq * 8);
        const int i = it * 16 + fr; const float gci = gc[i], bti = bt[i];
#pragma unroll
        for (int jt = 0; jt < 4; ++jt) {
            f32x4 acc = (f32x4){0.f, 0.f, 0.f, 0.f};
#pragma unroll
            for (int ks = 0; ks < 4; ++ks) { const bf16x8 bf = *(const LAS bf16x8*)(Kl + (jt * 16 + fr) * 136 + ks * 32 + fq * 8); acc = __builtin_amdgcn_mfma_f32_16x16x32_bf16(bf, af[ks], acc, 0, 0, 0); }
            float v[4];
#pragma unroll
            for (int jj = 0; jj < 4; ++jj) { const int j = jt * 16 + fq * 4 + jj; const float dec = (i >= j) ? __expf(gci - gc[j]) : 0.f;
                v[jj] = which ? acc[jj] * dec : ((i > j) ? bti * acc[jj] * dec : 0.f); }
            if (which) { u32x2 o; o.x = cvt_pk_bf16(v[0], v[1]); o.y = cvt_pk_bf16(v[2], v[3]); *(u32x2*)(proj + (size_t)(t0 + i) * PW + PC_AV + hh * 64 + jt * 16 + fq * 4) = o; }
            else *(LAS f32x4*)(Am + i * 64 + jt * 16 + fq * 4) = (f32x4){v[0], v[1], v[2], v[3]};
        }
    }
    __syncthreads();
    {
        LAS bf16_t* KDT = Ql;
#pragma unroll
        for (int e = 0; e < 16; ++e) KDT[(d0 + e) * 68 + t] = f2bf(qkv[1][e]);
    }
    if (tid < 256) {
        float x[64];
        int lz; asm volatile("v_mov_b32 %0, 0" : "=v"(lz));
        const LAS float* Amz = Am + lz;
#pragma unroll
        for (int i = 0; i < 64; ++i) x[i] = 0.f;
#pragma unroll
        for (int i = 0; i < 64; ++i) {
            float s = RHS[i * 256 + tid];
#pragma unroll
            for (int j4 = 0; j4 < (i + 3) / 4; ++j4) { const f32x4 a4 = *(const LAS f32x4*)(Amz + i * 64 + j4 * 4);
                s -= a4[0] * x[j4 * 4]; s -= a4[1] * x[j4 * 4 + 1]; s -= a4[2] * x[j4 * 4 + 2]; s -= a4[3] * x[j4 * 4 + 3]; }
            x[i] = s; RHS[i * 256 + tid] = s;
        }
    }
    __syncthreads();
    {
        const int seg = tid & 7;
        const LAS float* xr = RHS + t * 256 + seg * 32;
        bf16_t* dst = proj + (size_t)(t0 + t) * PW + ((seg < 4) ? (PC_CV + hh * 128 + seg * 32) : (PC_AU + hh * 128 + (seg - 4) * 32));
#pragma unroll
        for (int q = 0; q < 4; ++q) { const f32x4 a = *(const LAS f32x4*)(xr + q * 8), b = *(const LAS f32x4*)(xr + q * 8 + 4);
            u32x4 w; w.x = cvt_pk_bf16(a[0], a[1]); w.y = cvt_pk_bf16(a[2], a[3]); w.z = cvt_pk_bf16(b[0], b[1]); w.w = cvt_pk_bf16(b[2], b[3]); *(u32x4*)(dst + q * 8) = w; }
        const LAS bf16_t* kr = Ql + (2 * t + (seg >> 2)) * 68 + (seg & 3) * 16;
        const u32x2 k0 = *(const LAS u32x2*)kr, k1 = *(const LAS u32x2*)(kr + 4), k2 = *(const LAS u32x2*)(kr + 8), k3 = *(const LAS u32x2*)(kr + 12);
        bf16_t* kdst = proj + (size_t)(t0 + t) * PW + PC_CK + hh * 128 + seg * 16;
        *(u32x4*)kdst = (u32x4){k0.x, k0.y, k1.x, k1.y}; *(u32x4*)(kdst + 8) = (u32x4){k2.x, k2.y, k3.x, k3.y};
    }
    __syncthreads();
}

__device__ __forceinline__ void gdn_scan(LAS unsigned char* lds, const bf16_t* proj, float* oraw, const float* edec, int chain) {
    const int tid = ltid(), wid = tid >> 6, lane = tid & 63, fr = lane & 15, fq = lane >> 4;
    const int bl = chain >> 5, hh = (chain >> 3) & 3, es = chain & 7, e0 = es * 16;
    constexpr int BUF = 64512, O_W = 0, O_Q = 17408, O_KT = 34816, O_AT = 53248, O_U = 62464;
    int soff[8], doff[8]; bool act[8];
#pragma unroll
    for (int s = 0; s < 8; ++s) {
        const int idx = tid + NTHR * s; act[s] = true;
        if (idx < 1024) { const int row = idx >> 4, pc = idx & 15; soff[s] = row * PW + PC_AU + hh * 128 + pc * 8; doff[s] = O_W + (row * 136 + pc * 8) * 2; }
        else if (idx < 2048) { const int i2 = idx - 1024, row = i2 >> 4, pc = i2 & 15; soff[s] = row * PW + PC_CQ + hh * 128 + pc * 8; doff[s] = O_Q + (row * 136 + pc * 8) * 2; }
        else if (idx < 3072) { const int i2 = idx - 2048, row = i2 >> 4, pc = i2 & 15; soff[s] = row * PW + PC_CK + hh * 128 + pc * 8; doff[s] = O_KT + ((2 * row + (pc >> 3)) * 72 + (pc & 7) * 8) * 2; }
        else if (idx < 3584) { const int i2 = idx - 3072, row = i2 >> 3, pc = i2 & 7; soff[s] = row * PW + PC_AV + hh * 64 + pc * 8; doff[s] = O_AT + (row * 72 + pc * 8) * 2; }
        else if (idx < 3712) { const int i2 = idx - 3584, row = i2 >> 1, pc = i2 & 1; soff[s] = row * PW + PC_CV + hh * 128 + e0 + pc * 8; doff[s] = O_U + (row * 16 + pc * 8) * 2; }
        else { act[s] = false; soff[s] = 0; doff[s] = 0; }
    }
    u32x4 stg[8];
    const bf16_t* base0 = proj + (size_t)(bl * 64) * 64 * PW;
#pragma unroll
    for (int s = 0; s < 8; ++s) if (act[s]) stg[s] = *(const u32x4*)(base0 + soff[s]);
#pragma unroll
    for (int s = 0; s < 8; ++s) if (act[s]) *(LAS u32x4*)(lds + doff[s]) = stg[s];
    __syncthreads();
    f32x4 Sacc[8];
#pragma unroll
    for (int d = 0; d < 8; ++d) Sacc[d] = (f32x4){0.f, 0.f, 0.f, 0.f};
    for (int n = 0; n < 64; ++n) {
        const int t0 = (bl * 64 + n) * 64;
        if (n + 1 < 64) { const bf16_t* bn = proj + (size_t)(t0 + 64) * PW;
#pragma unroll
            for (int s = 0; s < 8; ++s) if (act[s]) stg[s] = *(const u32x4*)(bn + soff[s]); }
        if (wid == 0) {
            LAS unsigned char* B = lds + (n & 1) * BUF;
            const float dec = edec[bl * 256 + n * 4 + hh];
            bf16x8 sb[4];
#pragma unroll
            for (int kt = 0; kt < 4; ++kt) { u32x4 w; w.x = cvt_pk_bf16(Sacc[2 * kt][0], Sacc[2 * kt][1]); w.y = cvt_pk_bf16(Sacc[2 * kt][2], Sacc[2 * kt][3]);
                w.z = cvt_pk_bf16(Sacc[2 * kt + 1][0], Sacc[2 * kt + 1][1]); w.w = cvt_pk_bf16(Sacc[2 * kt + 1][2], Sacc[2 * kt + 1][3]); sb[kt] = __builtin_bit_cast(bf16x8, w); }
            f32x4 WS[4], OS[4];
#pragma unroll
            for (int m = 0; m < 4; ++m) { WS[m] = (f32x4){0.f, 0.f, 0.f, 0.f}; OS[m] = (f32x4){0.f, 0.f, 0.f, 0.f}; }
#pragma unroll
            for (int kt = 0; kt < 4; ++kt)
#pragma unroll
                for (int m = 0; m < 4; ++m) {
                    const LAS unsigned char* wp = B + O_W + ((m * 16 + fr) * 136 + kt * 32 + fq * 4) * 2; const LAS unsigned char* qp = B + O_Q + ((m * 16 + fr) * 136 + kt * 32 + fq * 4) * 2;
                    u32x4 wa; { const u32x2 lo = *(const LAS u32x2*)wp, hi = *(const LAS u32x2*)(wp + 32); wa.x = lo.x; wa.y = lo.y; wa.z = hi.x; wa.w = hi.y; }
                    u32x4 qa; { const u32x2 lo = *(const LAS u32x2*)qp, hi = *(const LAS u32x2*)(qp + 32); qa.x = lo.x; qa.y = lo.y; qa.z = hi.x; qa.w = hi.y; }
                    WS[m] = __builtin_amdgcn_mfma_f32_16x16x32_bf16(__builtin_bit_cast(bf16x8, wa), sb[kt], WS[m], 0, 0, 0);
                    OS[m] = __builtin_amdgcn_mfma_f32_16x16x32_bf16(__builtin_bit_cast(bf16x8, qa), sb[kt], OS[m], 0, 0, 0);
                }
#pragma unroll
            for (int m = 0; m < 4; ++m)
#pragma unroll
                for (int jj = 0; jj < 4; ++jj) WS[m][jj] = bf2f(*(const LAS bf16_t*)(B + O_U + ((m * 16 + fq * 4 + jj) * 16 + fr) * 2)) - WS[m][jj];
            bf16x8 vb[2];
#pragma unroll
            for (int kc = 0; kc < 2; ++kc) { u32x4 w; w.x = cvt_pk_bf16(WS[2 * kc][0], WS[2 * kc][1]); w.y = cvt_pk_bf16(WS[2 * kc][2], WS[2 * kc][3]);
                w.z = cvt_pk_bf16(WS[2 * kc + 1][0], WS[2 * kc + 1][1]); w.w = cvt_pk_bf16(WS[2 * kc + 1][2], WS[2 * kc + 1][3]); vb[kc] = __builtin_bit_cast(bf16x8, w); }
#pragma unroll
            for (int d = 0; d < 8; ++d) Sacc[d] *= dec;
#pragma unroll
            for (int kc = 0; kc < 2; ++kc) {
#pragma unroll
                for (int m = 0; m < 4; ++m) { const LAS unsigned char* ap = B + O_AT + ((m * 16 + fr) * 72 + kc * 32 + fq * 4) * 2;
                    u32x4 a; { const u32x2 lo = *(const LAS u32x2*)ap, hi = *(const LAS u32x2*)(ap + 32); a.x = lo.x; a.y = lo.y; a.z = hi.x; a.w = hi.y; }
                    OS[m] = __builtin_amdgcn_mfma_f32_16x16x32_bf16(__builtin_bit_cast(bf16x8, a), vb[kc], OS[m], 0, 0, 0); }
#pragma unroll
                for (int d = 0; d < 8; ++d) { const LAS unsigned char* kp = B + O_KT + ((d * 16 + fr) * 72 + kc * 32 + fq * 4) * 2;
                    u32x4 a; { const u32x2 lo = *(const LAS u32x2*)kp, hi = *(const LAS u32x2*)(kp + 32); a.x = lo.x; a.y = lo.y; a.z = hi.x; a.w = hi.y; }
                    Sacc[d] = __builtin_amdgcn_mfma_f32_16x16x32_bf16(__builtin_bit_cast(bf16x8, a), vb[kc], Sacc[d], 0, 0, 0); }
            }
#pragma unroll
            for (int m = 0; m < 4; ++m)
#pragma unroll
                for (int jj = 0; jj < 4; ++jj) oraw[(size_t)(t0 + m * 16 + fq * 4 + jj) * 512 + hh * 128 + e0 + fr] = OS[m][jj];
        }
        if (n + 1 < 64) { LAS unsigned char* Bn = lds + ((n + 1) & 1) * BUF;
#pragma unroll
            for (int s = 0; s < 8; ++s) if (act[s]) *(LAS u32x4*)(Bn + doff[s]) = stg[s]; }
        __syncthreads();
    }
}
__device__ __forceinline__ void gdn_out(const Params& p, int l, const float* oraw, const bf16_t* proj, bf16_t* yc) {
    const int tid = ltid(), sub = tid & 15;
    const float* ng = p.in[zz() + 21] + l * 128 + sub * 8;
    const f32x4 g0 = *(const f32x4*)ng, g1 = *(const f32x4*)(ng + 4);
    for (int rowi = lbid() * 32 + (tid >> 4); rowi < TS * 4; rowi += lgdim() * 32) {
        const int t = rowi >> 2, hh = rowi & 3;
        const float* op = oraw + (size_t)t * 512 + hh * 128 + sub * 8;
        const f32x4 o0 = *(const f32x4*)op, o1 = *(const f32x4*)(op + 4);
        float ss = (o0[0] * o0[0] + o0[1] * o0[1]) + (o0[2] * o0[2] + o0[3] * o0[3]) + (o1[0] * o1[0] + o1[1] * o1[1]) + (o1[2] * o1[2] + o1[3] * o1[3]);
        ss += __shfl_xor(ss, 1); ss += __shfl_xor(ss, 2); ss += __shfl_xor(ss, 4); ss += __shfl_xor(ss, 8);
        const float rs = rsqrtf(ss * (1.0f / 128.0f) + EPS);
        const u32x4 z = *(const u32x4*)(proj + (size_t)t * PW + PC_CZ + hh * 128 + sub * 8);
        u32x4 w;
        w.x = cvt_pk_bf16(o0[0] * rs * g0[0] * siluf_(lo_bf(z.x)), o0[1] * rs * g0[1] * siluf_(hi_bf(z.x)));
        w.y = cvt_pk_bf16(o0[2] * rs * g0[2] * siluf_(lo_bf(z.y)), o0[3] * rs * g0[3] * siluf_(hi_bf(z.y)));
        w.z = cvt_pk_bf16(o1[0] * rs * g1[0] * siluf_(lo_bf(z.z)), o1[1] * rs * g1[1] * siluf_(hi_bf(z.z)));
        w.w = cvt_pk_bf16(o1[2] * rs * g1[2] * siluf_(lo_bf(z.w)), o1[3] * rs * g1[3] * siluf_(hi_bf(z.w)));
        *(u32x4*)(yc + (size_t)t * 512 + hh * 128 + sub * 8) = w;
    }
}

constexpr int PH_PER_LAYER = 22, N_PHASES = 2 * PH_PER_LAYER + 1;

__device__ __forceinline__ void run_phase(LAS unsigned char* lds, const Params& p, int ph) {
    unsigned char* ws = lptr(p.ws);
    bf16_t* hbuf = (bf16_t*)(ws + WS_H);
    bf16_t* act = (bf16_t*)(ws + WS_PROJ);
    bf16_t* proj = (bf16_t*)(ws + WS_PROJ);
    bf16_t* hslab = hbuf;
    bf16_t* merged = hbuf + (size_t)TS * D;
    float* oraw = (float*)(ws + WS_H);
    bf16_t* ys = (bf16_t*)(ws + WS_YS);
    float* AB = (float*)(ws + WS_AB);
    bf16_t* halo = (bf16_t*)(ws + WS_HALO);
    float* Aend = (float*)(ws + WS_AEND); float* Hend = (float*)(ws + WS_HEND); float* carry = (float*)(ws + WS_CARRY); float* edec = (float*)(ws + WS_EDEC);
    const bf16_t* waxt = (const bf16_t*)(ws + WS_WAXT); const bf16_t* pwt = (const bf16_t*)(ws + WS_PWT);
    const int G = lgdim(), c = lbid();
    if (ph == N_PHASES - 1) { PHON(0) rms_rows_f32_inplace(lptr(p.out), p.in[zz() + 30], T); return; }
    const int l = ph / PH_PER_LAYER, r = ph % PH_PER_LAYER;
    const float* xcur = (l == 0) ? p.in[zz() + 0] : lptr(p.out);
    if (r == 0) { PHON(1) convert_layer(lds, p, l); PHON(0) rms_rows_bf16(xcur, p.in[zz() + 1] + l * D, hbuf, T); return; }
    if (r == 1 || r == 20) { PHON(2) ph_gemm_swiglu(lds, hbuf, (const bf16_t*)(ws + (r == 1 ? WS_WGU1 : WS_WGU2)), act); return; }
    if (r == 2 || r == 21) { PHON(3) ph_gemm_resid(lds, act, (const bf16_t*)(ws + (r == 2 ? WS_WD1 : WS_WD2)), T, DFF, (r == 2) ? xcur : lptr(p.out), lptr(p.out), 0.5f); return; }
    if (r == 19) { rms_rows_bf16(lptr(p.out), p.in[zz() + 26] + l * D, hbuf, T); return; }
    const int slab = (r - 3) >> 3, q = (r - 3) & 7;
    float* xs = lptr(p.out) + (size_t)slab * TS * D;
    switch (q) {
    case 0: rms_rows_bf16(xs, p.in[zz() + 5] + l * D, hslab, TS); break;
    case 1: PHON(4) ph_gemm_proj(lds, hslab, (const bf16_t*)(ws + WS_WIN), proj, AB); break;
    case 2:
        PHON(5) for (int t = c; t < (TS / 128) * 4; t += G) sgu_tile(lds, p, l, proj, ys, t);
        PHON(6) for (int t = c; t < TS / 64; t += G) pool_tile(lds, p, l, proj, ys + (size_t)3 * TS * 512, halo, pwt, t);
        PHON(7) for (int t = c; t < TS / 64; t += G) lru_tile(lds, p, l, proj, nullptr, waxt, Aend, Hend, carry, t, 0);
        break;
    case 3:
        PHON(8) for (int it = c; it < (TS / 64) * 4; it += G) gdn_prep(lds, p, l, proj, AB, halo, edec, it);
        lru_carry(Aend, Hend, carry);
        break;
    case 4:
        PHON(9) if (c < 128 || G < 256) { for (int ch = c; ch < 128; ch += G) gdn_scan(lds, proj, oraw, edec, ch); }
        PHON(10) if (G >= 256) { if (c >= 128) for (int t = c - 128; t < TS / 64; t += G - 128) lru_tile(lds, p, l, proj, ys + (size_t)TS * 512, waxt, Aend, Hend, carry, t, 1); }
        else { for (int t = c; t < TS / 64; t += G) lru_tile(lds, p, l, proj, ys + (size_t)TS * 512, waxt, Aend, Hend, carry, t, 1); }
        break;
    case 5: PHON(11) gdn_out(p, l, oraw, proj, ys + (size_t)2 * TS * 512); break;
    case 6: PHON(12) ph_gemm_branch(lds, ys, (const bf16_t*)(ws + WS_WB), proj, merged); break;
    default: PHON(13) ph_gemm_resid(lds, merged, (const bf16_t*)(ws + WS_WOUT), TS, D, xs, xs, 1.0f); break;
    }
}

extern __shared__ __attribute__((aligned(16))) unsigned char smem_dyn[];

__global__ void __launch_bounds__(NTHR) fwd_megakernel(Params p) {
    cg::grid_group grid = cg::this_grid();
    LAS unsigned char* lds = (LAS unsigned char*)smem_dyn;
    for (int ph = p.ph_lo; ph < p.ph_hi; ++ph) {
        if (ph > p.ph_lo) grid.sync();
        run_phase(lds, p, ph);
    }
}

extern "C" void kernel_launch(void* const* d_in, const int* in_sizes, int n_in, void* d_out, int out_size, void* d_ws, size_t ws_size, hipStream_t stream) {
    static int grid_blocks = 0;
    if (grid_blocks == 0) {
        if (n_in != 31 || out_size != T * D || ws_size < WS_END) { fprintf(stderr, "kernel_launch: unexpected shapes (n_in %d out %d ws %zu need %zu)\n", n_in, out_size, ws_size, (size_t)WS_END); grid_blocks = -1; return; }
        int dev = 0, cus = 0, per_cu = 0;
        hipGetDevice(&dev);
        hipDeviceGetAttribute(&cus, hipDeviceAttributeMultiprocessorCount, dev);
        if (hipFuncSetAttribute((const void*)fwd_megakernel, hipFuncAttributeMaxDynamicSharedMemorySize, LDS_BYTES) != hipSuccess) { fprintf(stderr, "kernel_launch: hipFuncSetAttribute failed\n"); grid_blocks = -1; return; }
        hipOccupancyMaxActiveBlocksPerMultiprocessor(&per_cu, (const void*)fwd_megakernel, NTHR, LDS_BYTES);
        if (per_cu < 1) { fprintf(stderr, "kernel_launch: occupancy query returned %d\n", per_cu); per_cu = 1; }
        grid_blocks = cus * per_cu;
    }
    if (grid_blocks < 0) return;
    Params p{};
    for (int i = 0; i < 31; ++i) p.in[i] = (const float*)d_in[i];
    p.out = (float*)d_out; p.ws = (unsigned char*)d_ws;
#if MULTI_LAUNCH
    for (int ph = 0; ph < N_PHASES; ++ph) {
        p.ph_lo = ph; p.ph_hi = ph + 1;
        hipLaunchKernelGGL(fwd_megakernel, dim3(grid_blocks), dim3(NTHR), LDS_BYTES, stream, p);
    }
#else
    p.ph_lo = 0; p.ph_hi = N_PHASES;
    void* args[] = {&p};
    hipError_t e = hipLaunchCooperativeKernel((const void*)fwd_megakernel, dim3(grid_blocks), dim3(NTHR), args, LDS_BYTES, stream);
    if (e != hipSuccess) fprintf(stderr, "cooperative launch failed: %s (grid %d)\n", hipGetErrorString(e), grid_blocks);
#endif
}
```

```cpp
#include <hip/hip_runtime.h>
#include <hip/hip_cooperative_groups.h>
#include <cstdio>
namespace cg = cooperative_groups;

#ifndef MULTI_LAUNCH
#define MULTI_LAUNCH 0
#endif

#ifndef PH_MASK
#define PH_MASK 0xFFFFF
#endif
#define PHON(k) if constexpr ((PH_MASK >> (k)) & 1)
#define LAS __attribute__((address_space(3)))
typedef unsigned short bf16_t;
typedef short bf16x8 __attribute__((ext_vector_type(8)));
typedef short bf16x4 __attribute__((ext_vector_type(4)));
typedef float f32x4 __attribute__((ext_vector_type(4)));
typedef unsigned u32x4 __attribute__((ext_vector_type(4)));
typedef unsigned u32x2 __attribute__((ext_vector_type(2)));

constexpr int T = 32768, D = 1024, DFF = 2816, NSLAB = 2, TS = T / NSLAB, SEQ = 4096, PW = 8960, PIN = 8712;
constexpr int PC_AU = 0, PC_AV = 512, PC_BX = 1024, PC_BG = 1536, PC_CQ = 2048, PC_CK = 2560, PC_CV = 3072, PC_CZ = 3584, PC_DX = 4096, PC_GATE = 4608, PC_AB = 8704;
constexpr float EPS = 1e-6f;
constexpr int NTHR = 512;
constexpr int LDS_BYTES = 147456;

constexpr size_t WS_WGU1 = 0;
constexpr size_t WS_WD1 = WS_WGU1 + (size_t)5632 * 1024 * 2;
constexpr size_t WS_WIN = WS_WD1 + (size_t)1024 * 2816 * 2;
constexpr size_t WS_WB = WS_WIN + (size_t)PW * 1024 * 2;
constexpr size_t WS_WOUT = WS_WB + (size_t)4 * 1024 * 512 * 2;
constexpr size_t WS_WGU2 = WS_WOUT + (size_t)1024 * 1024 * 2;
constexpr size_t WS_WD2 = WS_WGU2 + (size_t)5632 * 1024 * 2;
constexpr size_t WS_WAXT = WS_WD2 + (size_t)1024 * 2816 * 2;
constexpr size_t WS_PWT = WS_WAXT + 131072;
constexpr size_t WS_PROJ = WS_PWT + 131072;
constexpr size_t WS_H = WS_PROJ + (size_t)TS * PW * 2;
constexpr size_t WS_YS = WS_H + (size_t)T * D * 2;
constexpr size_t WS_AB = WS_YS + (size_t)4 * TS * 512 * 2;
constexpr size_t WS_HALO = WS_AB + (size_t)TS * 8 * 4;
constexpr size_t WS_AEND = WS_HALO + (size_t)(TS / 64) * 3 * 1536 * 2;
constexpr size_t WS_HEND = WS_AEND + (size_t)(TS / 64) * 512 * 4;
constexpr size_t WS_CARRY = WS_HEND + (size_t)(TS / 64) * 512 * 4;
constexpr size_t WS_EDEC = WS_CARRY + (size_t)(TS / 64) * 512 * 4;
constexpr size_t WS_BAR = WS_EDEC + 4096;
constexpr size_t WS_END = WS_BAR + 16384;

struct Params { const float* in[31]; float* out; unsigned char* ws; int ph_lo, ph_hi; };

__device__ __forceinline__ int ltid() { int t = threadIdx.x; asm volatile("" : "+v"(t)); return t; }
__device__ __forceinline__ int lbid() { int t = blockIdx.x; asm volatile("" : "+s"(t)); return t; }
__device__ __forceinline__ int lgdim() { int t = gridDim.x; asm volatile("" : "+s"(t)); return t; }
__device__ __forceinline__ int zz() { int z; asm volatile("s_mov_b32 %0, 0" : "=s"(z)); return z; }
template <class P> __device__ __forceinline__ P* lptr(P* q) { asm volatile("" : "+s"(q)); return q; }
__device__ __forceinline__ float bf2f(unsigned short b) { return __uint_as_float(((unsigned)b) << 16); }
__device__ __forceinline__ unsigned cvt_pk_bf16(float lo, float hi) { unsigned r; asm("v_cvt_pk_bf16_f32 %0, %1, %2" : "=v"(r) : "v"(lo), "v"(hi)); return r; }
__device__ __forceinline__ unsigned short f2bf(float f) { return (unsigned short)(cvt_pk_bf16(f, 0.f) & 0xffffu); }
__device__ __forceinline__ float lo_bf(unsigned w) { return __uint_as_float(w << 16); }
__device__ __forceinline__ float hi_bf(unsigned w) { return __uint_as_float(w & 0xffff0000u); }
__device__ __forceinline__ float sigmoidf_(float x) { return 1.0f / (1.0f + __expf(-x)); }
__device__ __forceinline__ float siluf_(float x) { return x / (1.0f + __expf(-x)); }
__device__ __forceinline__ float geluf_(float x) { const float u = 1.5957691216057308f * (x + 0.044715f * x * x * x); return x / (1.0f + __expf(-u)); }
__device__ __forceinline__ float softplusf_(float x) { return fmaxf(x, 0.f) + log1pf(__expf(-fabsf(x))); }
__device__ __forceinline__ float wave_sum(float v) {
#pragma unroll
    for (int o = 1; o < 64; o <<= 1) v += __shfl_xor(v, o);
    return v;
}


#define XB_TMO      128
#define XB_XCNT(j)  (256  + 64 * (j))
#define XB_XSUB(j)  (1280 + 64 * (j))
#define XB_XGEN(j)  (2304 + 64 * (j))
#define XB_TOP      3328
#define XB_TOPGEN   3392
#define XCD_BAR_WORDS 3456
#define XB_SPIN_CAP (1u << 22)
__device__ __forceinline__ unsigned xb_ld(unsigned* p)              { return __hip_atomic_load(p, __ATOMIC_RELAXED, __HIP_MEMORY_SCOPE_AGENT); }
__device__ __forceinline__ unsigned xb_add(unsigned* p, unsigned v) { return __hip_atomic_fetch_add(p, v, __ATOMIC_RELAXED, __HIP_MEMORY_SCOPE_AGENT); }
__device__ __forceinline__ unsigned xb_xcc_id() { return (unsigned)__builtin_amdgcn_s_getreg((3 << 11) | 20) & 0xFu; }
#define XB_SPIN(cond, bar) do { unsigned _sp = 0; while (cond) { __builtin_amdgcn_s_sleep(1); \
    if ((++_sp & 255u) == 0u) { if (xb_ld(&(bar)[XB_TMO])) break; if (_sp > XB_SPIN_CAP) { atomicAdd(&(bar)[XB_TMO], 1u); break; } } } } while (0)
struct XcdBarrier { unsigned* bar; unsigned x; volatile LAS unsigned* st; };
__device__ __forceinline__ XcdBarrier xcd_barrier_post(unsigned* bar, volatile LAS unsigned* st) {
    XcdBarrier b; b.bar = bar; b.x = xb_xcc_id(); b.st = st;
    if (threadIdx.x == 0) (void)xb_add(&bar[XB_XCNT(b.x)], 1u);
    return b;
}
__device__ __forceinline__ void xcd_barrier_complete(unsigned* bar, unsigned x, unsigned& nloc, unsigned& nx) {
    const unsigned G = gridDim.x * gridDim.y * gridDim.z;
    unsigned sum, cnt, mine, sp = 0u;
    for (;;) {
        sum = 0u; cnt = 0u; mine = 0u;
#pragma unroll
        for (unsigned j = 0; j < 16; ++j) { const unsigned c = xb_ld(&bar[XB_XCNT(j)]); sum += c; cnt += (c > 0u) ? 1u : 0u; mine = (j == x) ? c : mine; }
        if (sum == G) break;
        __builtin_amdgcn_s_sleep(1);
        if ((++sp & 255u) == 0u) { if (xb_ld(&bar[XB_TMO])) break; if (sp > XB_SPIN_CAP) { atomicAdd(&bar[XB_TMO], 1u); break; } }
    }
    nloc = mine > 0u ? mine : 1u; nx = cnt > 0u ? cnt : 1u;
}
__device__ __forceinline__ void xcd_barrier(const XcdBarrier& b) {
    asm volatile("s_waitcnt vmcnt(0)" ::: "memory");
    __syncthreads();
    if (threadIdx.x == 0) {
        unsigned* bar = b.bar;
        __builtin_amdgcn_s_waitcnt(0);
        unsigned nloc = b.st[0], nx = b.st[1];
        if (nloc == 0u) { xcd_barrier_complete(bar, b.x, nloc, nx); b.st[0] = nloc; b.st[1] = nx; }
        const unsigned old = xb_add(&bar[XB_XSUB(b.x)], 1u);
        const unsigned gen = old / nloc;
        if (old + 1u == (gen + 1u) * nloc) {
            __builtin_amdgcn_fence(__ATOMIC_RELEASE, "agent");
            asm volatile("s_waitcnt vmcnt(0)" ::: "memory");
            const unsigned og = xb_add(&bar[XB_TOP], 1u);
            const unsigned tg = og / nx;
            if (og + 1u == (tg + 1u) * nx) xb_add(&bar[XB_TOPGEN], 1u);
            else XB_SPIN(xb_ld(&bar[XB_TOPGEN]) == tg, bar);
            __builtin_amdgcn_fence(__ATOMIC_ACQUIRE, "agent");
            xb_add(&bar[XB_XGEN(b.x)], 1u);
            asm volatile("s_waitcnt vmcnt(0)" ::: "memory");
        } else {
            XB_SPIN(xb_ld(&bar[XB_XGEN(b.x)]) == gen, bar);
            __builtin_amdgcn_fence(__ATOMIC_ACQUIRE, "agent");
            asm volatile("s_waitcnt vmcnt(0)" ::: "memory");
        }
    }
    __syncthreads();
}

namespace pg8 {
constexpr int BM = 256, BK = 64, HALF = 128, HTB = HALF * BK * 2, STAGE_BYTES = 8 * HTB, NXCD = 8, WGM = 8;
__host__ __device__ __forceinline__ int lds_byte(int r, int c) { const int st = (r >> 4) * 2 + (c >> 5), rr = r & 15, cc = c & 31, ob = rr * 64 + cc * 2; return st * 1024 + (ob ^ (((ob >> 9) & 1) << 5)); }
__host__ __device__ __forceinline__ void stage_rc(int b, int& R, int& C) { const int st = b / 1024, sb = b % 1024, swz = sb ^ (((sb >> 9) & 1) << 5); R = (st >> 1) * 16 + swz / 64; C = (st & 1) * 32 + (swz % 64) / 2; }
__host__ __device__ __forceinline__ int perm32(int rho) { const int n = rho >> 4, i = rho & 15; return 8 * (i >> 2) + 4 * n + (i & 3); }

struct Unit { int pm, pn, g; };
struct Gemm { const bf16_t* A; const bf16_t* Bt; int M, N, K; size_t gsA, gsB; };

__device__ __forceinline__ void tile_of(int wgid, int nM, int nN, int nwg, Unit& u) {
    { const int q = nwg / NXCD, r = nwg % NXCD, xcd = wgid % NXCD, off = wgid / NXCD; wgid = (xcd < r ? xcd * (q + 1) : r * (q + 1) + (xcd - r) * q) + off; }
    const int nig = WGM * nN, gid = wgid / nig, fm = gid * WGM, gsz = (nM - fm) < WGM ? (nM - fm) : WGM;
    u.pm = fm + ((wgid % nig) % gsz); u.pn = (wgid % nig) / gsz;
}
struct StaticOrder {
    int nM, nN, nwg, G, c;
    __device__ void init(int M, int N, int G_, int c_) { nM = M / BM; nN = N / BM; nwg = nM * nN; G = G_; c = c_; }
    __device__ bool next(int i, Unit& u) const {
        const long L = (long)i * G + c; if (L >= nwg) return false;
        tile_of((int)L, nM, nN, nwg, u); u.g = 0; return true;
    }
};
struct BranchOrder {
    int nM, nN, nwg, G, c;
    __device__ void init(int M, int N, int G_, int c_) { nM = M / BM; nN = N / BM; nwg = nM * nN; G = G_; c = c_; }
    __device__ bool next(int i, Unit& u) const {
        const long L = (long)(i >> 2) * G + c; if (L >= nwg) return false;
        tile_of((int)L, nM, nN, nwg, u); u.g = i & 3; return true;
    }
};

struct EpiSwiGLU {
    static constexpr bool PERM = true;
    bf16_t* O;
    __device__ __forceinline__ bool keep(const Unit&) const { return false; }
    __device__ __forceinline__ void operator()(f32x4 (&acc)[2][2][4][2], const Unit& u, int wr, int wc, int fr, int fq) const {
        const int row0 = u.pm * BM + wr * 64 + fr, col0 = u.pn * 128 + wc * 32 + 8 * fq;
#pragma unroll
        for (int ai = 0; ai < 2; ++ai)
#pragma unroll
            for (int m = 0; m < 4; ++m) {
                bf16_t* rowp = O + (size_t)(row0 + ai * HALF + m * 16) * DFF + col0;
                float v[8];
#pragma unroll
                for (int n = 0; n < 2; ++n)
#pragma unroll
                    for (int j = 0; j < 4; ++j) v[n * 4 + j] = siluf_(acc[ai][0][m][n][j]) * acc[ai][1][m][n][j];
                u32x4 w; w.x = cvt_pk_bf16(v[0], v[1]); w.y = cvt_pk_bf16(v[2], v[3]); w.z = cvt_pk_bf16(v[4], v[5]); w.w = cvt_pk_bf16(v[6], v[7]);
                *(u32x4*)rowp = w;
                __builtin_amdgcn_sched_barrier(0);
            }
    }
};
struct EpiResid {
    static constexpr bool PERM = false;
    const float* Xin; float* Xout; float scale;
    __device__ __forceinline__ bool keep(const Unit&) const { return false; }
    __device__ __forceinline__ void operator()(f32x4 (&acc)[2][2][4][2], const Unit& u, int wr, int wc, int fr, int fq) const {
        const int row0 = u.pm * BM + wr * 64 + fr, col0 = u.pn * BM + wc * 32 + 4 * fq;
#pragma unroll
        for (int ai = 0; ai < 2; ++ai)
#pragma unroll
            for (int m = 0; m < 4; ++m) {
                const size_t ro = (size_t)(row0 + ai * HALF + m * 16) * D + col0;
#pragma unroll
                for (int bj = 0; bj < 2; ++bj)
#pragma unroll
                    for (int n = 0; n < 2; ++n) { const f32x4 xi = *(const f32x4*)(Xin + ro + bj * HALF + n * 16); *(f32x4*)(Xout + ro + bj * HALF + n * 16) = xi + acc[ai][bj][m][n] * scale; }
                __builtin_amdgcn_sched_barrier(0);
            }
    }
};
struct EpiProj {
    static constexpr bool PERM = true;
    bf16_t* O; float* AB;
    __device__ __forceinline__ bool keep(const Unit&) const { return false; }
    __device__ __forceinline__ void operator()(f32x4 (&acc)[2][2][4][2], const Unit& u, int wr, int wc, int fr, int fq) const {
        const int row0 = u.pm * BM + wr * 64 + fr, col0 = u.pn * BM + wc * 32 + 8 * fq;
        const bool ab = (u.pn == PC_AB / BM) && wc == 0 && fq == 0;
#pragma unroll
        for (int ai = 0; ai < 2; ++ai)
#pragma unroll
            for (int m = 0; m < 4; ++m) {
                const int row = row0 + ai * HALF + m * 16;
                bf16_t* rowp = O + (size_t)row * PW + col0;
#pragma unroll
                for (int bj = 0; bj < 2; ++bj) {
                    const f32x4 v0 = acc[ai][bj][m][0], v1 = acc[ai][bj][m][1];
                    u32x4 w; w.x = cvt_pk_bf16(v0[0], v0[1]); w.y = cvt_pk_bf16(v0[2], v0[3]); w.z = cvt_pk_bf16(v1[0], v1[1]); w.w = cvt_pk_bf16(v1[2], v1[3]);
                    *(u32x4*)(rowp + bj * HALF) = w;
                }
                __builtin_amdgcn_sched_barrier(0);
            }
        if (ab) {
#pragma unroll
            for (int ai = 0; ai < 2; ++ai)
#pragma unroll
                for (int m = 0; m < 4; ++m) { const int row = row0 + ai * HALF + m * 16; *(f32x4*)(AB + (size_t)row * 8) = acc[ai][0][m][0]; *(f32x4*)(AB + (size_t)row * 8 + 4) = acc[ai][0][m][1]; }
        }
    }
};
struct EpiBranch {
    static constexpr bool PERM = true;
    const bf16_t* P; bf16_t* O;
    __device__ __forceinline__ bool keep(const Unit& u) const { return u.g < 3; }
    __device__ __forceinline__ void operator()(f32x4 (&acc)[2][2][4][2], const Unit& u, int wr, int wc, int fr, int fq) const {
        const int row0 = u.pm * BM + wr * 64 + fr, col0 = u.pn * BM + wc * 32 + 8 * fq;
        const bool last = (u.g == 3);
#pragma unroll
        for (int ai = 0; ai < 2; ++ai)
#pragma unroll
            for (int m = 0; m < 4; ++m) {
                const int row = row0 + ai * HALF + m * 16;
                const bf16_t* gp = P + (size_t)row * PW + PC_GATE + u.g * D + col0;
#pragma unroll
                for (int bj = 0; bj < 2; ++bj) {
                    const u32x4 g0 = *(const u32x4*)(gp + bj * HALF);
                    float f[8];
                    if (!last) {
                        const u32x4 g1 = *(const u32x4*)(gp + D + bj * HALF);
#pragma unroll
                        for (int q = 0; q < 4; ++q) {
                            f[2 * q] = (1.0f + __expf(-lo_bf(g1[q]))) / (1.0f + __expf(-lo_bf(g0[q])));
                            f[2 * q + 1] = (1.0f + __expf(-hi_bf(g1[q]))) / (1.0f + __expf(-hi_bf(g0[q])));
                        }
                    } else {
#pragma unroll
                        for (int q = 0; q < 4; ++q) { f[2 * q] = 1.0f / (1.0f + __expf(-lo_bf(g0[q]))); f[2 * q + 1] = 1.0f / (1.0f + __expf(-hi_bf(g0[q]))); }
                    }
#pragma unroll
                    for (int n = 0; n < 2; ++n)
#pragma unroll
                        for (int j = 0; j < 4; ++j) acc[ai][bj][m][n][j] *= f[n * 4 + j];
                    if (last) {
                        const f32x4 v0 = acc[ai][bj][m][0], v1 = acc[ai][bj][m][1];
                        u32x4 w; w.x = cvt_pk_bf16(v0[0], v0[1]); w.y = cvt_pk_bf16(v0[2], v0[3]); w.z = cvt_pk_bf16(v1[0], v1[1]); w.w = cvt_pk_bf16(v1[2], v1[3]);
                        *(u32x4*)(O + (size_t)row * D + col0 + bj * HALF) = w;
                    }
                    __builtin_amdgcn_sched_barrier(0);
                }
            }
    }
};

template <class Epi, class Sched>
__device__ __forceinline__ void gemm_phase(LAS unsigned char* lds, const Gemm g, const Sched& S, const Epi& E) {
    const int tid = ltid(), wid = __builtin_amdgcn_readfirstlane(tid >> 6), lane = tid & 63, wr = wid >> 2, wc = wid & 3, fr = lane & 15, fq = lane >> 4;
    const int K = g.K, nt = K / BK;
    unsigned voffA[2], voffB[2];
#pragma unroll
    for (int i = 0; i < 2; ++i) { int R, C; stage_rc(tid * 16 + i * 8192, R, C); const int Rb = Epi::PERM ? ((R & ~31) + perm32(R & 31)) : R;
        voffA[i] = (unsigned)(R * K + C) * 2u; voffB[i] = (unsigned)(Rb * K + C) * 2u; }
    const size_t kstep = (size_t)(BK * 2);
    const size_t hstep = (size_t)HALF * K * 2;
    const size_t tstep = 2 * hstep;
    const unsigned ldsw = (unsigned)wid * 1024u;
    const int aoff = lds_byte(wr * 64 + fr, fq * 8), boff = lds_byte(wc * 32 + fr, fq * 8);
#define PG8_SA(b, h) (((b) * 2 + (h)) * HTB)
#define PG8_SB(b, h) ((4 + (b) * 2 + (h)) * HTB)
#define PG8_STAGE(bufoff, gbase, voff) do { _Pragma("unroll") for (int _i = 0; _i < 2; ++_i) \
        __builtin_amdgcn_global_load_lds((const unsigned*)((const char*)(gbase) + (voff)[_i]), (LAS unsigned*)(lds + (bufoff) + ldsw + _i * 8192), 16, 0, 0); } while (0)
#define PG8_LDA(dst, b, h) do { _Pragma("unroll") for (int m = 0; m < 4; ++m) _Pragma("unroll") for (int k = 0; k < 2; ++k) dst[m][k] = *(const LAS bf16x8*)(lds + PG8_SA(b, h) + aoff + m * 2048 + k * 1024); } while (0)
#define PG8_LDB(dst, b, h) do { _Pragma("unroll") for (int n = 0; n < 2; ++n) _Pragma("unroll") for (int k = 0; k < 2; ++k) dst[n][k] = *(const LAS bf16x8*)(lds + PG8_SB(b, h) + boff + n * 2048 + k * 1024); } while (0)
#define PG8_MMA(ai, bj, At, Bt) do { __builtin_amdgcn_s_setprio(1); _Pragma("unroll") for (int m = 0; m < 4; ++m) _Pragma("unroll") for (int n = 0; n < 2; ++n) _Pragma("unroll") for (int k = 0; k < 2; ++k) \
        acc[ai][bj][m][n] = __builtin_amdgcn_mfma_f32_16x16x32_bf16(Bt[n][k], At[m][k], acc[ai][bj][m][n], 0, 0, 0); __builtin_amdgcn_s_setprio(0); } while (0)
#define PG8_WAIT_V(n) asm volatile("s_waitcnt vmcnt(" #n ")" ::: "memory")
#define PG8_WAIT_L(n) asm volatile("s_waitcnt lgkmcnt(" #n ")" ::: "memory")
#define PG8_BAR __builtin_amdgcn_s_barrier()
#define PG8_SCHED __builtin_amdgcn_sched_barrier(0)
    Unit cur, nxt; int ui = 0;
    if (!S.next(0, cur)) return;
    f32x4 acc[2][2][4][2];
#pragma unroll
    for (int a = 0; a < 2; ++a)
#pragma unroll
        for (int b = 0; b < 2; ++b)
#pragma unroll
            for (int m = 0; m < 4; ++m)
#pragma unroll
                for (int n = 0; n < 2; ++n) acc[a][b][m][n] = (f32x4){0.f, 0.f, 0.f, 0.f};
    bf16x8 At[4][2], B0[2][2], B1[2][2];
    const char* cA = (const char*)g.A + (size_t)cur.g * g.gsA + (size_t)cur.pm * tstep; const char* cB = (const char*)g.Bt + (size_t)cur.g * g.gsB + (size_t)cur.pn * tstep;
    PG8_STAGE(PG8_SB(0, 0), cB, voffB); PG8_STAGE(PG8_SA(0, 0), cA, voffA); PG8_STAGE(PG8_SB(0, 1), cB + hstep, voffB); PG8_STAGE(PG8_SA(0, 1), cA + hstep, voffA);
    if (wr == 1) PG8_BAR;
    PG8_WAIT_V(4); PG8_BAR;
    PG8_STAGE(PG8_SB(1, 0), cB + kstep, voffB); PG8_STAGE(PG8_SA(1, 0), cA + kstep, voffA); PG8_STAGE(PG8_SB(1, 1), cB + hstep + kstep, voffB);
    PG8_WAIT_V(6); PG8_BAR;
    for (;;) {
        const bool has_next = S.next(ui + 1, nxt);
        const char* nA = has_next ? (const char*)g.A + (size_t)nxt.g * g.gsA + (size_t)nxt.pm * tstep : cA; const char* nB = has_next ? (const char*)g.Bt + (size_t)nxt.g * g.gsB + (size_t)nxt.pn * tstep : cB;
        for (int t = 0; t < nt; t += 2) {
            const bool last = (t == nt - 2);
            const char* a1 = cA + (size_t)(t + 1) * kstep;
            const char* a2 = last ? nA : cA + (size_t)(t + 2) * kstep; const char* b2 = last ? nB : cB + (size_t)(t + 2) * kstep;
            const char* a3 = a2 + kstep; const char* b3 = b2 + kstep;
            PG8_LDB(B0, 0, 0); PG8_SCHED; PG8_LDA(At, 0, 0); PG8_STAGE(PG8_SA(1, 1), a1 + hstep, voffA);
            PG8_WAIT_L(8); PG8_BAR; PG8_WAIT_L(0); PG8_MMA(0, 0, At, B0); PG8_BAR; PG8_SCHED;
            PG8_LDB(B1, 0, 1); PG8_STAGE(PG8_SB(0, 0), b2, voffB);
            PG8_BAR; PG8_WAIT_L(0); PG8_MMA(0, 1, At, B1); PG8_BAR;
            PG8_LDA(At, 0, 1); PG8_STAGE(PG8_SA(0, 0), a2, voffA);
            PG8_BAR; PG8_WAIT_L(0); PG8_MMA(1, 0, At, B0); PG8_BAR; PG8_SCHED;
            PG8_STAGE(PG8_SB(0, 1), b2 + hstep, voffB);
            PG8_WAIT_V(6); PG8_BAR; PG8_MMA(1, 1, At, B1); PG8_BAR;
            PG8_LDB(B0, 1, 0); PG8_SCHED; PG8_LDA(At, 1, 0); PG8_STAGE(PG8_SA(0, 1), a2 + hstep, voffA);
            PG8_WAIT_L(8); PG8_BAR; PG8_WAIT_L(0); PG8_MMA(0, 0, At, B0); PG8_BAR; PG8_SCHED;
            PG8_LDB(B1, 1, 1); PG8_STAGE(PG8_SB(1, 0), b3, voffB);
            PG8_BAR; PG8_WAIT_L(0); PG8_MMA(0, 1, At, B1); PG8_BAR;
            PG8_LDA(At, 1, 1); PG8_STAGE(PG8_SA(1, 0), a3, voffA);
            PG8_BAR; PG8_WAIT_L(0); PG8_MMA(1, 0, At, B0); PG8_BAR; PG8_SCHED;
            PG8_STAGE(PG8_SB(1, 1), b3 + hstep, voffB);
            PG8_WAIT_V(6); PG8_BAR; PG8_MMA(1, 1, At, B1); PG8_BAR;
        }
        E(acc, cur, wr, wc, fr, fq);
        if (!has_next) break;
        if (!E.keep(cur)) {
#pragma unroll
            for (int a = 0; a < 2; ++a)
#pragma unroll
                for (int b = 0; b < 2; ++b)
#pragma unroll
                    for (int m = 0; m < 4; ++m)
#pragma unroll
                        for (int n = 0; n < 2; ++n) acc[a][b][m][n] = (f32x4){0.f, 0.f, 0.f, 0.f};
        }
        cur = nxt; cA = nA; cB = nB; ++ui;
    }
    PG8_WAIT_V(0);
    if (wr == 0) PG8_BAR;
    PG8_BAR;
#undef PG8_SA
#undef PG8_SB
#undef PG8_STAGE
#undef PG8_LDA
#undef PG8_LDB
#undef PG8_MMA
#undef PG8_WAIT_V
#undef PG8_WAIT_L
#undef PG8_BAR
#undef PG8_SCHED
}
}


#define NOINL __forceinline__
__device__ NOINL void ph_gemm_swiglu(LAS unsigned char* lds, const bf16_t* A, const bf16_t* Bt, bf16_t* O) {
    pg8::Gemm g{A, Bt, T, 2 * DFF, D, 0, 0}; pg8::StaticOrder S; S.init(g.M, g.N, lgdim(), lbid()); pg8::EpiSwiGLU E{O}; pg8::gemm_phase(lds, g, S, E);
}
__device__ NOINL void ph_gemm_resid(LAS unsigned char* lds, const bf16_t* A, const bf16_t* Bt, int M, int K, const float* Xin, float* Xout, float scale) {
    pg8::Gemm g{A, Bt, M, D, K, 0, 0}; pg8::StaticOrder S; S.init(g.M, g.N, lgdim(), lbid()); pg8::EpiResid E{Xin, Xout, scale}; pg8::gemm_phase(lds, g, S, E);
}
__device__ NOINL void ph_gemm_proj(LAS unsigned char* lds, const bf16_t* A, const bf16_t* Bt, bf16_t* O, float* AB) {
    pg8::Gemm g{A, Bt, TS, PW, D, 0, 0}; pg8::StaticOrder S; S.init(g.M, g.N, lgdim(), lbid()); pg8::EpiProj E{O, AB}; pg8::gemm_phase(lds, g, S, E);
}
__device__ NOINL void ph_gemm_branch(LAS unsigned char* lds, const bf16_t* A, const bf16_t* Bt, const bf16_t* P, bf16_t* O) {
    pg8::Gemm g{A, Bt, TS, D, 512, (size_t)TS * 512 * 2, (size_t)D * 512 * 2}; pg8::BranchOrder S; S.init(g.M, g.N, lgdim(), lbid()); pg8::EpiBranch E{P, O}; pg8::gemm_phase(lds, g, S, E);
}

__device__ __forceinline__ void conv_tile(LAS float* scr, const float* src0, const float* src1, int K, int Nsrc, bf16_t* dst, int mode, int tile) {
    const int nkt = K / 64, kt = tile % nkt, rt = tile / nkt, k0 = kt * 64, r0 = rt * 64, tid = ltid();
    {
        const int kk = tid >> 3, rr = (tid & 7) * 8, rho = r0 + rr;
        const float* src = src0; int col = rho;
        if (mode == 1) { const int pn = rho >> 8, bj = (rho >> 7) & 1, j = rho & 127; col = pn * 128 + j; src = bj ? src1 : src0; }
        else if (mode == 2) { col = rho < 4096 ? rho : (rho < 8704 ? rho + 8 : (rho < 8712 ? rho - 8704 + 4096 : -1)); }
        f32x4 a = (f32x4){0.f, 0.f, 0.f, 0.f}, b = a;
        if (col >= 0) { const float* sp = src + (size_t)(k0 + kk) * Nsrc + col; a = *(const f32x4*)sp; b = *(const f32x4*)(sp + 4); }
#pragma unroll
        for (int e = 0; e < 4; ++e) { scr[(rr + e) * 65 + kk] = a[e]; scr[(rr + 4 + e) * 65 + kk] = b[e]; }
    }
    __syncthreads();
    {
        const int rl = tid >> 3, kc = (tid & 7) * 8;
        const LAS float* s = scr + rl * 65 + kc;
        u32x4 w; w.x = cvt_pk_bf16(s[0], s[1]); w.y = cvt_pk_bf16(s[2], s[3]); w.z = cvt_pk_bf16(s[4], s[5]); w.w = cvt_pk_bf16(s[6], s[7]);
        *(u32x4*)(dst + (size_t)(r0 + rl) * K + k0 + kc) = w;
    }
    __syncthreads();
}

__device__ __forceinline__ void convert_layer(LAS unsigned char* lds, const Params& p, int l) {
    LAS float* scr = (LAS float*)lds;
    unsigned char* ws = lptr(p.ws);
    constexpr int N1 = 16 * 88, N2 = 44 * 16, N3 = 16 * 140, N4 = 8 * 16, N5 = 16 * 16;
    constexpr int TOT = N1 + N2 + N3 + 4 * N4 + N5 + N1 + N2;
    for (int it = lbid(); it < TOT; it += lgdim()) {
        int r = it;
        if (r < N1) { conv_tile(scr, p.in[zz() + 2] + (size_t)l * D * DFF, p.in[zz() + 3] + (size_t)l * D * DFF, D, DFF, (bf16_t*)(ws + WS_WGU1), 1, r); continue; } r -= N1;
        if (r < N2) { conv_tile(scr, p.in[zz() + 4] + (size_t)l * DFF * D, nullptr, DFF, D, (bf16_t*)(ws + WS_WD1), 0, r); continue; } r -= N2;
        if (r < N3) { conv_tile(scr, p.in[zz() + 6] + (size_t)l * D * PIN, nullptr, D, PIN, (bf16_t*)(ws + WS_WIN), 2, r); continue; } r -= N3;
        if (r < 4 * N4) { const int g = r / N4; conv_tile(scr, p.in[zz() + 24] + ((size_t)l * 4 + g) * 512 * D, nullptr, 512, D, (bf16_t*)(ws + WS_WB) + (size_t)g * D * 512, 0, r % N4); continue; } r -= 4 * N4;
        if (r < N5) { conv_tile(scr, p.in[zz() + 25] + (size_t)l * D * D, nullptr, D, D, (bf16_t*)(ws + WS_WOUT), 0, r); continue; } r -= N5;
        if (r < N1) { conv_tile(scr, p.in[zz() + 27] + (size_t)l * D * DFF, p.in[zz() + 28] + (size_t)l * D * DFF, D, DFF, (bf16_t*)(ws + WS_WGU2), 1, r); continue; } r -= N1;
        conv_tile(scr, p.in[zz() + 29] + (size_t)l * DFF * D, nullptr, DFF, D, (bf16_t*)(ws + WS_WD2), 0, r);
    }
    bf16_t* waxt = (bf16_t*)(ws + WS_WAXT); bf16_t* pwt = (bf16_t*)(ws + WS_PWT);
    const float* wa = p.in[zz() + 13] + (size_t)l * 8 * 64 * 64; const float* wx = p.in[zz() + 15] + (size_t)l * 8 * 64 * 64; const float* pw = p.in[zz() + 22] + (size_t)l * 4 * 128 * 128;
    for (int e = lbid() * NTHR + ltid(); e < 65536; e += lgdim() * NTHR) {
        { const int h = e >> 13, jp = (e >> 6) & 127, i = e & 63; waxt[e] = f2bf(jp < 64 ? wa[(h * 64 + i) * 64 + jp] : wx[(h * 64 + i) * 64 + jp - 64]); }
        { const int g = e >> 14, d = (e >> 7) & 127, c = e & 127; pwt[e] = f2bf(pw[(g * 128 + c) * 128 + d]); }
    }
}

__device__ __forceinline__ void rms_rows_bf16(const float* X, const float* gain, bf16_t* H, int nrows) {
    const int wid = ltid() >> 6, lane = ltid() & 63;
    f32x4 gv[4];
#pragma unroll
    for (int j = 0; j < 4; ++j) gv[j] = *(const f32x4*)(gain + (lane + 64 * j) * 4);
    for (int row = lbid() * 8 + wid; row < nrows; row += lgdim() * 8) {
        const f32x4* xr = (const f32x4*)(X + (size_t)row * D) + lane;
        f32x4 v[4]; float s = 0.f;
#pragma unroll
        for (int j = 0; j < 4; ++j) { v[j] = xr[64 * j]; s += (v[j].x * v[j].x + v[j].y * v[j].y) + (v[j].z * v[j].z + v[j].w * v[j].w); }
        const float rs = rsqrtf(wave_sum(s) * (1.0f / D) + EPS);
        u32x2* o = (u32x2*)(H + (size_t)row * D) + lane;
#pragma unroll
        for (int j = 0; j < 4; ++j) { u32x2 w; w.x = cvt_pk_bf16(v[j].x * rs * gv[j].x, v[j].y * rs * gv[j].y); w.y = cvt_pk_bf16(v[j].z * rs * gv[j].z, v[j].w * rs * gv[j].w); o[64 * j] = w; }
    }
}
__device__ __forceinline__ void rms_rows_f32_inplace(float* X, const float* gain, int nrows) {
    const int wid = ltid() >> 6, lane = ltid() & 63;
    f32x4 gv[4];
#pragma unroll
    for (int j = 0; j < 4; ++j) gv[j] = *(const f32x4*)(gain + (lane + 64 * j) * 4);
    for (int row = lbid() * 8 + wid; row < nrows; row += lgdim() * 8) {
        f32x4* xr = (f32x4*)(X + (size_t)row * D) + lane;
        f32x4 v[4]; float s = 0.f;
#pragma unroll
        for (int j = 0; j < 4; ++j) { v[j] = xr[64 * j]; s += (v[j].x * v[j].x + v[j].y * v[j].y) + (v[j].z * v[j].z + v[j].w * v[j].w); }
        const float rs = rsqrtf(wave_sum(s) * (1.0f / D) + EPS);
#pragma unroll
        for (int j = 0; j < 4; ++j) xr[64 * j] = v[j] * rs * gv[j];
    }
}

__device__ __forceinline__ void sgu_tile(LAS unsigned char* lds, const Params& p, int l, const bf16_t* proj, bf16_t* ya, int tile) {
    const int tid = ltid(), wid = tid >> 6, lane = tid & 63, fr = lane & 15, fq = lane >> 4;
    const int blk = tile >> 2, g = tile & 3, r0 = blk * 128;
    LAS bf16_t* Wl = (LAS bf16_t*)lds;
    LAS bf16_t* VT = (LAS bf16_t*)(lds + 34816);
    const float* lng = p.in[zz() + 7] + l * 512 + g * 128; const float* lnb = p.in[zz() + 8] + l * 512 + g * 128;
    {
        const int i = tid >> 2, qd = tid & 3;
        const bf16_t* vrow = proj + (size_t)(r0 + i) * PW + PC_AV + qd * 128;
        float s = 0.f, s2 = 0.f;
#pragma unroll 4
        for (int e8 = 0; e8 < 16; ++e8) { const u32x4 w = *(const u32x4*)(vrow + e8 * 8);
#pragma unroll
            for (int q = 0; q < 4; ++q) { const float a = geluf_(lo_bf(w[q])), b = geluf_(hi_bf(w[q])); s += a + b; s2 += a * a + b * b; } }
        s += __shfl_xor(s, 1); s += __shfl_xor(s, 2); s2 += __shfl_xor(s2, 1); s2 += __shfl_xor(s2, 2);
        const float mean = s * (1.0f / 512.0f), var = fmaxf(s2 * (1.0f / 512.0f) - mean * mean, 0.f), rstd = rsqrtf(var + EPS);
        const bf16_t* vg = proj + (size_t)(r0 + i) * PW + PC_AV + g * 128 + qd * 32;
#pragma unroll
        for (int e8 = 0; e8 < 4; ++e8) { const u32x4 w = *(const u32x4*)(vg + e8 * 8);
#pragma unroll
            for (int q = 0; q < 4; ++q) { const int c = qd * 32 + e8 * 8 + 2 * q;
                VT[c * 136 + i] = f2bf((geluf_(lo_bf(w[q])) - mean) * rstd * lng[c] + lnb[c]);
                VT[(c + 1) * 136 + i] = f2bf((geluf_(hi_bf(w[q])) - mean) * rstd * lng[c + 1] + lnb[c + 1]); } }
        const float* wsrc = p.in[zz() + 9] + (((size_t)l * 4 + g) * 128 + i) * 128 + qd * 32;
#pragma unroll
        for (int e4 = 0; e4 < 8; ++e4) { f32x4 w = *(const f32x4*)(wsrc + e4 * 4); if (i < 64 && qd >= 2) w = (f32x4){0.f, 0.f, 0.f, 0.f};
            u32x2 o; o.x = cvt_pk_bf16(w.x, w.y); o.y = cvt_pk_bf16(w.z, w.w); *(LAS u32x2*)(Wl + i * 136 + qd * 32 + e4 * 4) = o; }
    }
    __syncthreads();
    f32x4 acc[8];
#pragma unroll
    for (int n = 0; n < 8; ++n) acc[n] = (f32x4){0.f, 0.f, 0.f, 0.f};
#pragma unroll
    for (int ks = 0; ks < 4; ++ks) {
        const bf16x8 af = *(const LAS bf16x8*)(Wl + (wid * 16 + fr) * 136 + ks * 32 + fq * 8);
#pragma unroll
        for (int n = 0; n < 8; ++n) { const bf16x8 bf = *(const LAS bf16x8*)(VT + (n * 16 + fr) * 136 + ks * 32 + fq * 8); acc[n] = __builtin_amdgcn_mfma_f32_16x16x32_bf16(bf, af, acc[n], 0, 0, 0); }
    }
    {
        const int i = wid * 16 + fr; const float bias = p.in[zz() + 10][((size_t)l * 4 + g) * 128 + i];
        const bf16_t* up = proj + (size_t)(r0 + i) * PW + PC_AU + g * 128 + fq * 4;
        bf16_t* yp = ya + (size_t)(r0 + i) * 512 + g * 128 + fq * 4;
#pragma unroll
        for (int n = 0; n < 8; ++n) { const u32x2 uw = *(const u32x2*)(up + n * 16);
            u32x2 o; o.x = cvt_pk_bf16((acc[n][0] + bias) * geluf_(lo_bf(uw.x)), (acc[n][1] + bias) * geluf_(hi_bf(uw.x)));
            o.y = cvt_pk_bf16((acc[n][2] + bias) * geluf_(lo_bf(uw.y)), (acc[n][3] + bias) * geluf_(hi_bf(uw.y))); *(u32x2*)(yp + n * 16) = o; }
    }
    __syncthreads();
}

template <int WIN>
__device__ __forceinline__ void pool_rows(LAS bf16_t* Al, const bf16_t* xcol, int c, int pos0) {
    float xv[80];
#pragma unroll
    for (int k = 0; k < 80; ++k) xv[k] = (pos0 - 16 + k >= 0) ? bf2f(xcol[(long)(k - 16) * PW]) : 0.f;
    float s = 0.f;
#pragma unroll
    for (int j = 0; j < WIN; ++j) s += xv[16 - j];
#pragma unroll
    for (int tt = 0; tt < 64; ++tt) {
        const int k = tt + 16;
        const int cnt = min(pos0 + tt + 1, WIN);
        Al[tt * 520 + c] = f2bf(s / (float)cnt - xv[k]);
        if (tt < 63) s += xv[k + 1] - xv[k + 1 - WIN];
    }
}
__device__ __forceinline__ void pool_tile(LAS unsigned char* lds, const Params& p, int l, const bf16_t* proj, bf16_t* yd, bf16_t* halo, const bf16_t* pwt, int tile) {
    const int tid = ltid(), wid = tid >> 6, lane = tid & 63, fr = lane & 15, fq = lane >> 4;
    const int t0 = tile * 64, pos0 = t0 % SEQ;
    LAS bf16_t* Al = (LAS bf16_t*)lds;
    {
        const int c = tid, g = wid >> 1;
        const bf16_t* xcol = proj + (size_t)t0 * PW + PC_DX + c;
        if (g == 0) pool_rows<2>(Al, xcol, c, pos0); else if (g == 1) pool_rows<4>(Al, xcol, c, pos0); else if (g == 2) pool_rows<8>(Al, xcol, c, pos0); else pool_rows<16>(Al, xcol, c, pos0);
    }
    if ((tile + 1) % 64 != 0) {
        for (int e = tid; e < 4608; e += NTHR) { const int r = e / 1536, cc = e % 1536; halo[((size_t)(tile + 1) * 3 + r) * 1536 + cc] = proj[(size_t)(t0 + 61 + r) * PW + PC_CQ + cc]; }
    }
    __syncthreads();
    {
        const int g = wid >> 1, nh = wid & 1;
        f32x4 acc[4][4];
#pragma unroll
        for (int m = 0; m < 4; ++m)
#pragma unroll
            for (int n = 0; n < 4; ++n) acc[m][n] = (f32x4){0.f, 0.f, 0.f, 0.f};
#pragma unroll
        for (int ks = 0; ks < 4; ++ks) {
            bf16x8 bfr[4];
#pragma unroll
            for (int n = 0; n < 4; ++n) bfr[n] = *(const bf16x8*)(pwt + ((size_t)(g * 128 + (nh * 4 + n) * 16 + fr)) * 128 + ks * 32 + fq * 8);
#pragma unroll
            for (int m = 0; m < 4; ++m) { const bf16x8 af = *(const LAS bf16x8*)(Al + (m * 16 + fr) * 520 + g * 128 + ks * 32 + fq * 8);
#pragma unroll
                for (int n = 0; n < 4; ++n) acc[m][n] = __builtin_amdgcn_mfma_f32_16x16x32_bf16(bfr[n], af, acc[m][n], 0, 0, 0); }
        }
        const float* sc = p.in[zz() + 23] + l * 512 + g * 128;
#pragma unroll
        for (int n = 0; n < 4; ++n) { const int d = (nh * 4 + n) * 16 + fq * 4; const f32x4 s4 = *(const f32x4*)(sc + d);
#pragma unroll
            for (int m = 0; m < 4; ++m) { u32x2 o; o.x = cvt_pk_bf16(acc[m][n][0] * s4[0], acc[m][n][1] * s4[1]); o.y = cvt_pk_bf16(acc[m][n][2] * s4[2], acc[m][n][3] * s4[3]);
                *(u32x2*)(yd + (size_t)(t0 + m * 16 + fr) * 512 + g * 128 + d) = o; } }
    }
    __syncthreads();
}

__device__ __forceinline__ void lru_tile(LAS unsigned char* lds, const Params& p, int l, const bf16_t* proj, bf16_t* yb, const bf16_t* waxt, float* Aend, float* Hend, const float* carry, int tile, int mode) {
    const int tid = ltid(), wid = tid >> 6, lane = tid & 63, fr = lane & 15, fq = lane >> 4;
    const int t0 = tile * 64, pos0 = t0 % SEQ, c = wid * 64 + lane;
    LAS bf16_t* Aw = (LAS bf16_t*)(lds + wid * 10560);
    LAS float* Xw = (LAS float*)(lds + wid * 10560 + 2304);
    bf16x8 bfr[8][2];
#pragma unroll
    for (int n = 0; n < 8; ++n)
#pragma unroll
        for (int ks = 0; ks < 2; ++ks) bfr[n][ks] = *(const bf16x8*)(waxt + ((size_t)(wid * 128 + n * 16 + fr)) * 64 + ks * 32 + fq * 8);
    const float* cwp = p.in[zz() + 11] + (size_t)l * 4 * 512 + c;
    const float cw0 = cwp[0], cw1 = cwp[512], cw2 = cwp[1024], cw3 = cwp[1536], cb = p.in[zz() + 12][l * 512 + c];
    const float ba = p.in[zz() + 14][l * 512 + c], bx = p.in[zz() + 16][l * 512 + c], sp8 = 8.0f * softplusf_(-p.in[zz() + 17][l * 512 + c]);
    const bf16_t* xcol = proj + (size_t)t0 * PW + PC_BX + c;
    float xm3 = 0.f, xm2 = 0.f, xm1 = 0.f;
    if (pos0 > 0) { xm3 = bf2f(xcol[-3L * PW]); xm2 = bf2f(xcol[-2L * PW]); xm1 = bf2f(xcol[-1L * PW]); }
    const bf16_t* gcol = proj + (size_t)t0 * PW + PC_BG + c;
    bf16_t* ycol = yb + (size_t)t0 * 512 + c;
    float h = mode ? carry[(size_t)tile * 512 + c] : 0.f, Ap = 1.f;
    for (int sub = 0; sub < 4; ++sub) {
        float xc[16];
#pragma unroll
        for (int tt = 0; tt < 16; ++tt) { const float xin = bf2f(*xcol); xcol += PW; xc[tt] = cb + cw0 * xm3 + cw1 * xm2 + cw2 * xm1 + cw3 * xin; xm3 = xm2; xm2 = xm1; xm1 = xin; Aw[tt * 72 + lane] = f2bf(xc[tt]); }
        __syncthreads();
        f32x4 acc[8];
#pragma unroll
        for (int n = 0; n < 8; ++n) acc[n] = (f32x4){0.f, 0.f, 0.f, 0.f};
#pragma unroll
        for (int ks = 0; ks < 2; ++ks) { const bf16x8 af = *(const LAS bf16x8*)(Aw + fr * 72 + ks * 32 + fq * 8);
#pragma unroll
            for (int n = 0; n < 8; ++n) acc[n] = __builtin_amdgcn_mfma_f32_16x16x32_bf16(bfr[n][ks], af, acc[n], 0, 0, 0); }
#pragma unroll
        for (int n = 0; n < 8; ++n)
#pragma unroll
            for (int j = 0; j < 4; ++j) Xw[fr * 129 + n * 16 + fq * 4 + j] = acc[n][j];
        __syncthreads();
#pragma unroll
        for (int tt = 0; tt < 16; ++tt) {
            const float r = sigmoidf_(Xw[tt * 129 + lane] + ba), ig = sigmoidf_(Xw[tt * 129 + 64 + lane] + bx);
            const float la = -sp8 * r, a = __expf(la), x2 = 2.0f * la;
            const float om = (x2 > -0.1f) ? -x2 * (1.0f + x2 * (0.5f + x2 * (0.16666667f + x2 * 0.041666668f))) : 1.0f - a * a;
            h = a * h + sqrtf(om) * ig * xc[tt]; Ap *= a;
            if (mode) { const float gt = bf2f(*gcol); gcol += PW; *ycol = f2bf(h * geluf_(gt)); ycol += 512; }
        }
        __syncthreads();
    }
    if (!mode) { Aend[(size_t)tile * 512 + c] = Ap; Hend[(size_t)tile * 512 + c] = h; }
}
__device__ __forceinline__ void lru_carry(const float* Aend, const float* Hend, float* carry) {
    const int gid = lbid() * NTHR + ltid();
    if (gid < (TS / SEQ) * 512) {
        const int bl = gid >> 9, c = gid & 511; float h = 0.f;
        for (int n = 0; n < 64; ++n) { const size_t o = (size_t)(bl * 64 + n) * 512 + c; carry[o] = h; h = Aend[o] * h + Hend[o]; }
    }
}

__device__ __forceinline__ void gdn_prep(LAS unsigned char* lds, const Params& p, int l, bf16_t* proj, const float* AB, const bf16_t* halo, float* edec, int item) {
    const int tid = ltid(), wid = tid >> 6, lane = tid & 63, fr = lane & 15, fq = lane >> 4;
    const int bl = item >> 8, n = (item & 255) >> 2, hh = item & 3, ch = bl * 64 + n, t0 = ch * 64;
    LAS bf16_t* Kl = (LAS bf16_t*)lds;
    LAS bf16_t* Ql = (LAS bf16_t*)(lds + 17408);
    LAS float* RHS = (LAS float*)(lds + 34816);
    LAS float* Am = (LAS float*)(lds + 100352);
    LAS float* gc = (LAS float*)(lds + 116736);
    LAS float* bt = (LAS float*)(lds + 116992);
    const int t = tid >> 3, d0 = (tid & 7) * 16;
    float qkv[3][16];
#pragma unroll
    for (int sec = 0; sec < 3; ++sec) {
        const int colh = sec * 512 + hh * 128 + d0;
        float a[16];
#pragma unroll
        for (int e = 0; e < 16; ++e) a[e] = 0.f;
#pragma unroll
        for (int k = 0; k < 4; ++k) {
            const int tt = t - 3 + k;
            const bf16_t* src = nullptr;
            if (tt >= 0) src = proj + (size_t)(t0 + tt) * PW + PC_CQ + colh; else if (n > 0) src = halo + ((size_t)ch * 3 + (tt + 3)) * 1536 + colh;
            if (src) {
                const u32x4 w0 = *(const u32x4*)src, w1 = *(const u32x4*)(src + 8);
                const float* cw = p.in[zz() + 18] + ((size_t)l * 4 + k) * 1536 + colh;
#pragma unroll
                for (int q = 0; q < 4; ++q) { const f32x4 c4 = *(const f32x4*)(cw + q * 4);
                    const unsigned wa = (q < 2) ? w0[2 * q] : w1[2 * q - 4], wb = (q < 2) ? w0[2 * q + 1] : w1[2 * q - 3];
                    a[q * 4 + 0] += c4[0] * lo_bf(wa); a[q * 4 + 1] += c4[1] * hi_bf(wa); a[q * 4 + 2] += c4[2] * lo_bf(wb); a[q * 4 + 3] += c4[3] * hi_bf(wb); }
            }
        }
#pragma unroll
        for (int e = 0; e < 16; ++e) qkv[sec][e] = siluf_(a[e]);
    }
    {
        float sq = 0.f, sk = 0.f;
#pragma unroll
        for (int e = 0; e < 16; ++e) { sq += qkv[0][e] * qkv[0][e]; sk += qkv[1][e] * qkv[1][e]; }
        sq += __shfl_xor(sq, 1); sq += __shfl_xor(sq, 2); sq += __shfl_xor(sq, 4); sk += __shfl_xor(sk, 1); sk += __shfl_xor(sk, 2); sk += __shfl_xor(sk, 4);
        const float qn = rsqrtf(sq + EPS) * 0.08838834764831845f, kn = rsqrtf(sk + EPS);
#pragma unroll
        for (int e = 0; e < 16; ++e) { qkv[0][e] *= qn; qkv[1][e] *= kn; }
#pragma unroll
        for (int e = 0; e < 16; e += 2) { *(LAS unsigned*)(Ql + t * 136 + d0 + e) = cvt_pk_bf16(qkv[0][e], qkv[0][e + 1]); *(LAS unsigned*)(Kl + t * 136 + d0 + e) = cvt_pk_bf16(qkv[1][e], qkv[1][e + 1]); }
    }
    if (wid == 0) {
        const float al = AB[(size_t)(t0 + lane) * 8 + 4 + hh], be = AB[(size_t)(t0 + lane) * 8 + hh];
        float gv = -__expf(p.in[zz() + 19][l * 4 + hh]) * softplusf_(al + p.in[zz() + 20][l * 4 + hh]);
#pragma unroll
        for (int o = 1; o < 64; o <<= 1) { const float u = __shfl_up(gv, o); if (lane >= o) gv += u; }
        gc[lane] = gv; bt[lane] = sigmoidf_(be);
        if (lane == 63) edec[item] = __expf(gv);
    }
    __syncthreads();
    {
        const float bet = bt[t], gct = gc[t], eg = __expf(gct), ekd = __expf(gc[63] - gct);
#pragma unroll
        for (int e = 0; e < 16; ++e) { RHS[t * 256 + d0 + e] = qkv[2][e] * bet; RHS[t * 256 + 128 + d0 + e] = qkv[1][e] * bet * eg; }
        bf16_t* qdst = proj + (size_t)(t0 + t) * PW + PC_CQ + hh * 128 + d0;
        u32x4 w0, w1;
        w0.x = cvt_pk_bf16(qkv[0][0] * eg, qkv[0][1] * eg); w0.y = cvt_pk_bf16(qkv[0][2] * eg, qkv[0][3] * eg); w0.z = cvt_pk_bf16(qkv[0][4] * eg, qkv[0][5] * eg); w0.w = cvt_pk_bf16(qkv[0][6] * eg, qkv[0][7] * eg);
        w1.x = cvt_pk_bf16(qkv[0][8] * eg, qkv[0][9] * eg); w1.y = cvt_pk_bf16(qkv[0][10] * eg, qkv[0][11] * eg); w1.z = cvt_pk_bf16(qkv[0][12] * eg, qkv[0][13] * eg); w1.w = cvt_pk_bf16(qkv[0][14] * eg, qkv[0][15] * eg);
        *(u32x4*)qdst = w0; *(u32x4*)(qdst + 8) = w1;
#pragma unroll
        for (int e = 0; e < 16; ++e) qkv[1][e] *= ekd;
    }
    {
        const int it = wid & 3, which = wid >> 2;
        LAS bf16_t* Xi = which ? Ql : Kl;
        bf16x8 af[4];
#pragma unroll
        for (int ks = 0; ks < 4; ++ks) af[ks] = *(const LAS bf16x8*)(Xi + (it * 16 + fr) * 136 + ks * 32 + fq * 8);
        const int i = it * 16 + fr; const float gci = gc[i], bti = bt[i];
#pragma unroll
        for (int jt = 0; jt < 4; ++jt) {
            f32x4 acc = (f32x4){0.f, 0.f, 0.f, 0.f};
#pragma unroll
            for (int ks = 0; ks < 4; ++ks) { const bf16x8 bf = *(const LAS bf16x8*)(Kl + (jt * 16 + fr) * 136 + ks * 32 + fq * 8); acc = __builtin_amdgcn_mfma_f32_16x16x32_bf16(bf, af[ks], acc, 0, 0, 0); }
            float v[4];
#pragma unroll
            for (int jj = 0; jj < 4; ++jj) { const int j = jt * 16 + fq * 4 + jj; const float dec = (i >= j) ? __expf(gci - gc[j]) : 0.f;
                v[jj] = which ? acc[jj] * dec : ((i > j) ? bti * acc[jj] * dec : 0.f); }
            if (which) { u32x2 o; o.x = cvt_pk_bf16(v[0], v[1]); o.y = cvt_pk_bf16(v[2], v[3]); *(u32x2*)(proj + (size_t)(t0 + i) * PW + PC_AV + hh * 64 + jt * 16 + fq * 4) = o; }
            else *(LAS f32x4*)(Am + i * 64 + jt * 16 + fq * 4) = (f32x4){v[0], v[1], v[2], v[3]};
        }
    }
    __syncthreads();
    {
        LAS bf16_t* KDT = Ql;
#pragma unroll
        for (int e = 0; e < 16; ++e) KDT[(d0 + e) * 68 + t] = f2bf(qkv[1][e]);
    }
    if (tid < 256) {
        float x[64];
        int lz; asm volatile("v_mov_b32 %0, 0" : "=v"(lz));
        const LAS float* Amz = Am + lz;
#pragma unroll
        for (int i = 0; i < 64; ++i) x[i] = 0.f;
#pragma unroll
        for (int i = 0; i < 64; ++i) {
            float s = RHS[i * 256 + tid];
#pragma unroll
            for (int j4 = 0; j4 < (i + 3) / 4; ++j4) { const f32x4 a4 = *(const LAS f32x4*)(Amz + i * 64 + j4 * 4);
                s -= a4[0] * x[j4 * 4]; s -= a4[1] * x[j4 * 4 + 1]; s -= a4[2] * x[j4 * 4 + 2]; s -= a4[3] * x[j4 * 4 + 3]; }
            x[i] = s; RHS[i * 256 + tid] = s;
        }
    }
    __syncthreads();
    {
        const int seg = tid & 7;
        const LAS float* xr = RHS + t * 256 + seg * 32;
        bf16_t* dst = proj + (size_t)(t0 + t) * PW + ((seg < 4) ? (PC_CV + hh * 128 + seg * 32) : (PC_AU + hh * 128 + (seg - 4) * 32));
#pragma unroll
        for (int q = 0; q < 4; ++q) { const f32x4 a = *(const LAS f32x4*)(xr + q * 8), b = *(const LAS f32x4*)(xr + q * 8 + 4);
            u32x4 w; w.x = cvt_pk_bf16(a[0], a[1]); w.y = cvt_pk_bf16(a[2], a[3]); w.z = cvt_pk_bf16(b[0], b[1]); w.w = cvt_pk_bf16(b[2], b[3]); *(u32x4*)(dst + q * 8) = w; }
        const LAS bf16_t* kr = Ql + (2 * t + (seg >> 2)) * 68 + (seg & 3) * 16;
        const u32x2 k0 = *(const LAS u32x2*)kr, k1 = *(const LAS u32x2*)(kr + 4), k2 = *(const LAS u32x2*)(kr + 8), k3 = *(const LAS u32x2*)(kr + 12);
        bf16_t* kdst = proj + (size_t)(t0 + t) * PW + PC_CK + hh * 128 + seg * 16;
        *(u32x4*)kdst = (u32x4){k0.x, k0.y, k1.x, k1.y}; *(u32x4*)(kdst + 8) = (u32x4){k2.x, k2.y, k3.x, k3.y};
    }
    __syncthreads();
}

__device__ __forceinline__ void gdn_scan(LAS unsigned char* lds, const bf16_t* proj, float* oraw, const float* edec, int chain) {
    const int tid = ltid(), wid = tid >> 6, lane = tid & 63, fr = lane & 15, fq = lane >> 4;
    const int bl = chain >> 5, hh = (chain >> 3) & 3, es = chain & 7, e0 = es * 16;
    constexpr int BUF = 64512, O_W = 0, O_Q = 17408, O_KT = 34816, O_AT = 53248, O_U = 62464;
    int soff[8], doff[8]; bool act[8];
#pragma unroll
    for (int s = 0; s < 8; ++s) {
        const int idx = tid + NTHR * s; act[s] = true;
        if (idx < 1024) { const int row = idx >> 4, pc = idx & 15; soff[s] = row * PW + PC_AU + hh * 128 + pc * 8; doff[s] = O_W + (row * 136 + pc * 8) * 2; }
        else if (idx < 2048) { const int i2 = idx - 1024, row = i2 >> 4, pc = i2 & 15; soff[s] = row * PW + PC_CQ + hh * 128 + pc * 8; doff[s] = O_Q + (row * 136 + pc * 8) * 2; }
        else if (idx < 3072) { const int i2 = idx - 2048, row = i2 >> 4, pc = i2 & 15; soff[s] = row * PW + PC_CK + hh * 128 + pc * 8; doff[s] = O_KT + ((2 * row + (pc >> 3)) * 72 + (pc & 7) * 8) * 2; }
        else if (idx < 3584) { const int i2 = idx - 3072, row = i2 >> 3, pc = i2 & 7; soff[s] = row * PW + PC_AV + hh * 64 + pc * 8; doff[s] = O_AT + (row * 72 + pc * 8) * 2; }
        else if (idx < 3712) { const int i2 = idx - 3584, row = i2 >> 1, pc = i2 & 1; soff[s] = row * PW + PC_CV + hh * 128 + e0 + pc * 8; doff[s] = O_U + (row * 16 + pc * 8) * 2; }
        else { act[s] = false; soff[s] = 0; doff[s] = 0; }
    }
    u32x4 stg[8];
    const bf16_t* base0 = proj + (size_t)(bl * 64) * 64 * PW;
#pragma unroll
    for (int s = 0; s < 8; ++s) if (act[s]) stg[s] = *(const u32x4*)(base0 + soff[s]);
#pragma unroll
    for (int s = 0; s < 8; ++s) if (act[s]) *(LAS u32x4*)(lds + doff[s]) = stg[s];
    __syncthreads();
    f32x4 Sacc[8];
#pragma unroll
    for (int d = 0; d < 8; ++d) Sacc[d] = (f32x4){0.f, 0.f, 0.f, 0.f};
    for (int n = 0; n < 64; ++n) {
        const int t0 = (bl * 64 + n) * 64;
        if (n + 1 < 64) { const bf16_t* bn = proj + (size_t)(t0 + 64) * PW;
#pragma unroll
            for (int s = 0; s < 8; ++s) if (act[s]) stg[s] = *(const u32x4*)(bn + soff[s]); }
        if (wid == 0) {
            LAS unsigned char* B = lds + (n & 1) * BUF;
            const float dec = edec[bl * 256 + n * 4 + hh];
            bf16x8 sb[4];
#pragma unroll
            for (int kt = 0; kt < 4; ++kt) { u32x4 w; w.x = cvt_pk_bf16(Sacc[2 * kt][0], Sacc[2 * kt][1]); w.y = cvt_pk_bf16(Sacc[2 * kt][2], Sacc[2 * kt][3]);
                w.z = cvt_pk_bf16(Sacc[2 * kt + 1][0], Sacc[2 * kt + 1][1]); w.w = cvt_pk_bf16(Sacc[2 * kt + 1][2], Sacc[2 * kt + 1][3]); sb[kt] = __builtin_bit_cast(bf16x8, w); }
            f32x4 WS[4], OS[4];
#pragma unroll
            for (int m = 0; m < 4; ++m) { WS[m] = (f32x4){0.f, 0.f, 0.f, 0.f}; OS[m] = (f32x4){0.f, 0.f, 0.f, 0.f}; }
#pragma unroll
            for (int kt = 0; kt < 4; ++kt)
#pragma unroll
                for (int m = 0; m < 4; ++m) {
                    const LAS unsigned char* wp = B + O_W + ((m * 16 + fr) * 136 + kt * 32 + fq * 4) * 2; const LAS unsigned char* qp = B + O_Q + ((m * 16 + fr) * 136 + kt * 32 + fq * 4) * 2;
                    u32x4 wa; { const u32x2 lo = *(const LAS u32x2*)wp, hi = *(const LAS u32x2*)(wp + 32); wa.x = lo.x; wa.y = lo.y; wa.z = hi.x; wa.w = hi.y; }
                    u32x4 qa; { const u32x2 lo = *(const LAS u32x2*)qp, hi = *(const LAS u32x2*)(qp + 32); qa.x = lo.x; qa.y = lo.y; qa.z = hi.x; qa.w = hi.y; }
                    WS[m] = __builtin_amdgcn_mfma_f32_16x16x32_bf16(__builtin_bit_cast(bf16x8, wa), sb[kt], WS[m], 0, 0, 0);
                    OS[m] = __builtin_amdgcn_mfma_f32_16x16x32_bf16(__builtin_bit_cast(bf16x8, qa), sb[kt], OS[m], 0, 0, 0);
                }
#pragma unroll
            for (int m = 0; m < 4; ++m)
#pragma unroll
                for (int jj = 0; jj < 4; ++jj) WS[m][jj] = bf2f(*(const LAS bf16_t*)(B + O_U + ((m * 16 + fq * 4 + jj) * 16 + fr) * 2)) - WS[m][jj];
            bf16x8 vb[2];
#pragma unroll
            for (int kc = 0; kc < 2; ++kc) { u32x4 w; w.x = cvt_pk_bf16(WS[2 * kc][0], WS[2 * kc][1]); w.y = cvt_pk_bf16(WS[2 * kc][2], WS[2 * kc][3]);
                w.z = cvt_pk_bf16(WS[2 * kc + 1][0], WS[2 * kc + 1][1]); w.w = cvt_pk_bf16(WS[2 * kc + 1][2], WS[2 * kc + 1][3]); vb[kc] = __builtin_bit_cast(bf16x8, w); }
#pragma unroll
            for (int d = 0; d < 8; ++d) Sacc[d] *= dec;
#pragma unroll
            for (int kc = 0; kc < 2; ++kc) {
#pragma unroll
                for (int m = 0; m < 4; ++m) { const LAS unsigned char* ap = B + O_AT + ((m * 16 + fr) * 72 + kc * 32 + fq * 4) * 2;
                    u32x4 a; { const u32x2 lo = *(const LAS u32x2*)ap, hi = *(const LAS u32x2*)(ap + 32); a.x = lo.x; a.y = lo.y; a.z = hi.x; a.w = hi.y; }
                    OS[m] = __builtin_amdgcn_mfma_f32_16x16x32_bf16(__builtin_bit_cast(bf16x8, a), vb[kc], OS[m], 0, 0, 0); }
#pragma unroll
                for (int d = 0; d < 8; ++d) { const LAS unsigned char* kp = B + O_KT + ((d * 16 + fr) * 72 + kc * 32 + fq * 4) * 2;
                    u32x4 a; { const u32x2 lo = *(const LAS u32x2*)kp, hi = *(const LAS u32x2*)(kp + 32); a.x = lo.x; a.y = lo.y; a.z = hi.x; a.w = hi.y; }
                    Sacc[d] = __builtin_amdgcn_mfma_f32_16x16x32_bf16(__builtin_bit_cast(bf16x8, a), vb[kc], Sacc[d], 0, 0, 0); }
            }
#pragma unroll
            for (int m = 0; m < 4; ++m)
#pragma unroll
                for (int jj = 0; jj < 4; ++jj) oraw[(size_t)(t0 + m * 16 + fq * 4 + jj) * 512 + hh * 128 + e0 + fr] = OS[m][jj];
        }
        if (n + 1 < 64) { LAS unsigned char* Bn = lds + ((n + 1) & 1) * BUF;
#pragma unroll
            for (int s = 0; s < 8; ++s) if (act[s]) *(LAS u32x4*)(Bn + doff[s]) = stg[s]; }
        __syncthreads();
    }
}
__device__ __forceinline__ void gdn_out(const Params& p, int l, const float* oraw, const bf16_t* proj, bf16_t* yc) {
    const int tid = ltid(), sub = tid & 15;
    const float* ng = p.in[zz() + 21] + l * 128 + sub * 8;
    const f32x4 g0 = *(const f32x4*)ng, g1 = *(const f32x4*)(ng + 4);
    for (int rowi = lbid() * 32 + (tid >> 4); rowi < TS * 4; rowi += lgdim() * 32) {
        const int t = rowi >> 2, hh = rowi & 3;
        const float* op = oraw + (size_t)t * 512 + hh * 128 + sub * 8;
        const f32x4 o0 = *(const f32x4*)op, o1 = *(const f32x4*)(op + 4);
        float ss = (o0[0] * o0[0] + o0[1] * o0[1]) + (o0[2] * o0[2] + o0[3] * o0[3]) + (o1[0] * o1[0] + o1[1] * o1[1]) + (o1[2] * o1[2] + o1[3] * o1[3]);
        ss += __shfl_xor(ss, 1); ss += __shfl_xor(ss, 2); ss += __shfl_xor(ss, 4); ss += __shfl_xor(ss, 8);
        const float rs = rsqrtf(ss * (1.0f / 128.0f) + EPS);
        const u32x4 z = *(const u32x4*)(proj + (size_t)t * PW + PC_CZ + hh * 128 + sub * 8);
        u32x4 w;
        w.x = cvt_pk_bf16(o0[0] * rs * g0[0] * siluf_(lo_bf(z.x)), o0[1] * rs * g0[1] * siluf_(hi_bf(z.x)));
        w.y = cvt_pk_bf16(o0[2] * rs * g0[2] * siluf_(lo_bf(z.y)), o0[3] * rs * g0[3] * siluf_(hi_bf(z.y)));
        w.z = cvt_pk_bf16(o1[0] * rs * g1[0] * siluf_(lo_bf(z.z)), o1[1] * rs * g1[1] * siluf_(hi_bf(z.z)));
        w.w = cvt_pk_bf16(o1[2] * rs * g1[2] * siluf_(lo_bf(z.w)), o1[3] * rs * g1[3] * siluf_(hi_bf(z.w)));
        *(u32x4*)(yc + (size_t)t * 512 + hh * 128 + sub * 8) = w;
    }
}

constexpr int PH_PER_LAYER = 22, N_PHASES = 2 * PH_PER_LAYER + 1;

__device__ __forceinline__ void run_phase(LAS unsigned char* lds, const Params& p, int ph) {
    unsigned char* ws = lptr(p.ws);
    bf16_t* hbuf = (bf16_t*)(ws + WS_H);
    bf16_t* act = (bf16_t*)(ws + WS_PROJ);
    bf16_t* proj = (bf16_t*)(ws + WS_PROJ);
    bf16_t* hslab = hbuf;
    bf16_t* merged = hbuf + (size_t)TS * D;
    float* oraw = (float*)(ws + WS_H);
    bf16_t* ys = (bf16_t*)(ws + WS_YS);
    float* AB = (float*)(ws + WS_AB);
    bf16_t* halo = (bf16_t*)(ws + WS_HALO);
    float* Aend = (float*)(ws + WS_AEND); float* Hend = (float*)(ws + WS_HEND); float* carry = (float*)(ws + WS_CARRY); float* edec = (float*)(ws + WS_EDEC);
    const bf16_t* waxt = (const bf16_t*)(ws + WS_WAXT); const bf16_t* pwt = (const bf16_t*)(ws + WS_PWT);
    const int G = lgdim(), c = lbid();
    if (ph == N_PHASES - 1) { PHON(0) rms_rows_f32_inplace(lptr(p.out), p.in[zz() + 30], T); return; }
    const int l = ph / PH_PER_LAYER, r = ph % PH_PER_LAYER;
    const float* xcur = (l == 0) ? p.in[zz() + 0] : lptr(p.out);
    if (r == 0) { PHON(1) convert_layer(lds, p, l); PHON(0) rms_rows_bf16(xcur, p.in[zz() + 1] + l * D, hbuf, T); return; }
    if (r == 1 || r == 20) { PHON(2) ph_gemm_swiglu(lds, hbuf, (const bf16_t*)(ws + (r == 1 ? WS_WGU1 : WS_WGU2)), act); return; }
    if (r == 2 || r == 21) { PHON(3) ph_gemm_resid(lds, act, (const bf16_t*)(ws + (r == 2 ? WS_WD1 : WS_WD2)), T, DFF, (r == 2) ? xcur : lptr(p.out), lptr(p.out), 0.5f); return; }
    if (r == 19) { rms_rows_bf16(lptr(p.out), p.in[zz() + 26] + l * D, hbuf, T); return; }
    const int slab = (r - 3) >> 3, q = (r - 3) & 7;
    float* xs = lptr(p.out) + (size_t)slab * TS * D;
    switch (q) {
    case 0: rms_rows_bf16(xs, p.in[zz() + 5] + l * D, hslab, TS); break;
    case 1: PHON(4) ph_gemm_proj(lds, hslab, (const bf16_t*)(ws + WS_WIN), proj, AB); break;
    case 2:
        PHON(5) for (int t = c; t < (TS / 128) * 4; t += G) sgu_tile(lds, p, l, proj, ys, t);
        PHON(6) for (int t = c; t < TS / 64; t += G) pool_tile(lds, p, l, proj, ys + (size_t)3 * TS * 512, halo, pwt, t);
        PHON(7) for (int t = c; t < TS / 64; t += G) lru_tile(lds, p, l, proj, nullptr, waxt, Aend, Hend, carry, t, 0);
        break;
    case 3:
        PHON(8) for (int it = c; it < (TS / 64) * 4; it += G) gdn_prep(lds, p, l, proj, AB, halo, edec, it);
        lru_carry(Aend, Hend, carry);
        break;
    case 4:
        PHON(9) if (c < 128 || G < 256) { for (int ch = c; ch < 128; ch += G) gdn_scan(lds, proj, oraw, edec, ch); }
        PHON(10) if (G >= 256) { if (c >= 128) for (int t = c - 128; t < TS / 64; t += G - 128) lru_tile(lds, p, l, proj, ys + (size_t)TS * 512, waxt, Aend, Hend, carry, t, 1); }
        else { for (int t = c; t < TS / 64; t += G) lru_tile(lds, p, l, proj, ys + (size_t)TS * 512, waxt, Aend, Hend, carry, t, 1); }
        break;
    case 5: PHON(11) gdn_out(p, l, oraw, proj, ys + (size_t)2 * TS * 512); break;
    case 6: PHON(12) ph_gemm_branch(lds, ys, (const bf16_t*)(ws + WS_WB), proj, merged); break;
    default: PHON(13) ph_gemm_resid(lds, merged, (const bf16_t*)(ws + WS_WOUT), TS, D, xs, xs, 1.0f); break;
    }
}

extern __shared__ __attribute__((aligned(16))) unsigned char smem_dyn[];

#ifndef DUP_TYPE
#define DUP_TYPE -1
#endif
__device__ __forceinline__ int phase_type(int ph) {
    if (ph == N_PHASES - 1) return 12;
    const int r = ph % PH_PER_LAYER;
    if (r == 0) return 0; if (r == 1 || r == 20) return 1; if (r == 2 || r == 21) return 2; if (r == 19) return 11;
    const int q = (r - 3) & 7;
    return 3 + q;
}
__global__ void __launch_bounds__(NTHR) fwd_megakernel(Params p) {
    cg::grid_group grid = cg::this_grid();
    LAS unsigned char* lds = (LAS unsigned char*)smem_dyn;
    volatile LAS unsigned* st = (volatile LAS unsigned*)(lds + LDS_BYTES - 16);
    if (threadIdx.x == 0) { st[0] = 0u; st[1] = 0u; }
    __syncthreads();
    const XcdBarrier xb = xcd_barrier_post((unsigned*)(p.ws + WS_BAR), st);
    grid.sync();
    for (int ph = p.ph_lo; ph < p.ph_hi; ++ph) {
        if (ph > p.ph_lo) xcd_barrier(xb);
        run_phase(lds, p, ph);
#if DUP_TYPE == 6
        if (phase_type(ph) == 6) { xcd_barrier(xb); run_phase(lds, p, ph - 2); xcd_barrier(xb); run_phase(lds, p, ph - 1); xcd_barrier(xb); run_phase(lds, p, ph); }
#elif DUP_TYPE >= 0
        if (phase_type(ph) == DUP_TYPE) { xcd_barrier(xb); run_phase(lds, p, ph); }
#endif
    }
}

extern "C" void kernel_launch(void* const* d_in, const int* in_sizes, int n_in, void* d_out, int out_size, void* d_ws, size_t ws_size, hipStream_t stream) {
    static int grid_blocks = 0;
    if (grid_blocks == 0) {
        if (n_in != 31 || out_size != T * D || ws_size < WS_END) { fprintf(stderr, "kernel_launch: unexpected shapes (n_in %d out %d ws %zu need %zu)\n", n_in, out_size, ws_size, (size_t)WS_END); grid_blocks = -1; return; }
        int dev = 0, cus = 0, per_cu = 0;
        hipGetDevice(&dev);
        hipDeviceGetAttribute(&cus, hipDeviceAttributeMultiprocessorCount, dev);
        if (hipFuncSetAttribute((const void*)fwd_megakernel, hipFuncAttributeMaxDynamicSharedMemorySize, LDS_BYTES) != hipSuccess) { fprintf(stderr, "kernel_launch: hipFuncSetAttribute failed\n"); grid_blocks = -1; return; }
        hipOccupancyMaxActiveBlocksPerMultiprocessor(&per_cu, (const void*)fwd_megakernel, NTHR, LDS_BYTES);
        if (per_cu < 1) { fprintf(stderr, "kernel_launch: occupancy query returned %d\n", per_cu); per_cu = 1; }
        grid_blocks = cus * per_cu;
    }
    if (grid_blocks < 0) return;
    Params p{};
    for (int i = 0; i < 31; ++i) p.in[i] = (const float*)d_in[i];
    p.out = (float*)d_out; p.ws = (unsigned char*)d_ws;
    hipMemsetAsync((unsigned char*)d_ws + WS_BAR, 0, 16384, stream);
    p.ph_lo = 0; p.ph_hi = N_PHASES;
    void* args[] = {&p};
    hipError_t e = hipLaunchCooperativeKernel((const void*)fwd_megakernel, dim3(grid_blocks), dim3(NTHR), args, LDS_BYTES, stream);
    if (e != hipSuccess) fprintf(stderr, "cooperative launch failed: %s (grid %d)\n", hipGetErrorString(e), grid_blocks);
}
```

```cpp
#include <hip/hip_runtime.h>
#include <hip/hip_cooperative_groups.h>
#include <cstdio>
namespace cg = cooperative_groups;

#ifndef MULTI_LAUNCH
#define MULTI_LAUNCH 0
#endif

#ifndef PH_MASK
#define PH_MASK 0xFFFFF
#endif
#define PHON(k) if constexpr ((PH_MASK >> (k)) & 1)
#define LAS __attribute__((address_space(3)))
typedef unsigned short bf16_t;
typedef short bf16x8 __attribute__((ext_vector_type(8)));
typedef short bf16x4 __attribute__((ext_vector_type(4)));
typedef float f32x4 __attribute__((ext_vector_type(4)));
typedef unsigned u32x4 __attribute__((ext_vector_type(4)));
typedef unsigned u32x2 __attribute__((ext_vector_type(2)));

constexpr int T = 32768, D = 1024, DFF = 2816, NSLAB = 2, TS = T / NSLAB, SEQ = 4096, PW = 8960, PIN = 8712;
constexpr int PC_AU = 0, PC_AV = 512, PC_BX = 1024, PC_BG = 1536, PC_CQ = 2048, PC_CK = 2560, PC_CV = 3072, PC_CZ = 3584, PC_DX = 4096, PC_GATE = 4608, PC_AB = 8704;
constexpr float EPS = 1e-6f;
constexpr int NTHR = 512;
constexpr int LDS_BYTES = 147456;

constexpr size_t WS_WGU1 = 0;
constexpr size_t WS_WD1 = WS_WGU1 + (size_t)5632 * 1024 * 2;
constexpr size_t WS_WIN = WS_WD1 + (size_t)1024 * 2816 * 2;
constexpr size_t WS_WB = WS_WIN + (size_t)PW * 1024 * 2;
constexpr size_t WS_WOUT = WS_WB + (size_t)4 * 1024 * 512 * 2;
constexpr size_t WS_WGU2 = WS_WOUT + (size_t)1024 * 1024 * 2;
constexpr size_t WS_WD2 = WS_WGU2 + (size_t)5632 * 1024 * 2;
constexpr size_t WS_WAXT = WS_WD2 + (size_t)1024 * 2816 * 2;
constexpr size_t WS_PWT = WS_WAXT + 131072;
constexpr size_t WS_PROJ = WS_PWT + 131072;
constexpr size_t WS_H = WS_PROJ + (size_t)TS * PW * 2;
constexpr size_t WS_YS = WS_H + (size_t)T * D * 2;
constexpr size_t WS_AB = WS_YS + (size_t)4 * TS * 512 * 2;
constexpr size_t WS_HALO = WS_AB + (size_t)TS * 8 * 4;
constexpr size_t WS_AEND = WS_HALO + (size_t)(TS / 64) * 3 * 1536 * 2;
constexpr size_t WS_HEND = WS_AEND + (size_t)(TS / 64) * 512 * 4;
constexpr size_t WS_CARRY = WS_HEND + (size_t)(TS / 64) * 512 * 4;
constexpr size_t WS_EDEC = WS_CARRY + (size_t)(TS / 64) * 512 * 4;
constexpr size_t WS_BAR = WS_EDEC + 4096;
constexpr size_t WS_GDQ = WS_H + (size_t)TS * D * 2;
constexpr size_t WS_GDK = WS_GDQ + (size_t)TS * 512 * 2;
constexpr size_t WS_GDU = WS_BAR + 16384;
constexpr size_t WS_GDW = WS_GDU + (size_t)TS * 512 * 2;
constexpr size_t WS_GDA = WS_GDW + (size_t)TS * 512 * 2;
constexpr size_t WS_END = WS_GDA + (size_t)TS * 256 * 2;
static_assert(WS_END <= (size_t)512 * 1024 * 1024, "workspace budget");

struct Params { const float* in[31]; float* out; unsigned char* ws; int ph_lo, ph_hi; };

__device__ __forceinline__ int ltid() { int t = threadIdx.x; asm volatile("" : "+v"(t)); return t; }
__device__ __forceinline__ int lbid() { int t = blockIdx.x; asm volatile("" : "+s"(t)); return t; }
__device__ __forceinline__ int lgdim() { int t = gridDim.x; asm volatile("" : "+s"(t)); return t; }
__device__ __forceinline__ int zz() { int z; asm volatile("s_mov_b32 %0, 0" : "=s"(z)); return z; }
template <class P> __device__ __forceinline__ P* lptr(P* q) { asm volatile("" : "+s"(q)); return q; }
__device__ __forceinline__ float bf2f(unsigned short b) { return __uint_as_float(((unsigned)b) << 16); }
__device__ __forceinline__ unsigned cvt_pk_bf16(float lo, float hi) { unsigned r; asm("v_cvt_pk_bf16_f32 %0, %1, %2" : "=v"(r) : "v"(lo), "v"(hi)); return r; }
__device__ __forceinline__ unsigned short f2bf(float f) { return (unsigned short)(cvt_pk_bf16(f, 0.f) & 0xffffu); }
__device__ __forceinline__ float lo_bf(unsigned w) { return __uint_as_float(w << 16); }
__device__ __forceinline__ float hi_bf(unsigned w) { return __uint_as_float(w & 0xffff0000u); }
__device__ __forceinline__ float sigmoidf_(float x) { return 1.0f / (1.0f + __expf(-x)); }
__device__ __forceinline__ float siluf_(float x) { return x / (1.0f + __expf(-x)); }
__device__ __forceinline__ float geluf_(float x) { const float u = 1.5957691216057308f * (x + 0.044715f * x * x * x); return x / (1.0f + __expf(-u)); }
__device__ __forceinline__ float softplusf_(float x) { return fmaxf(x, 0.f) + log1pf(__expf(-fabsf(x))); }
__device__ __forceinline__ float wave_sum(float v) {
#pragma unroll
    for (int o = 1; o < 64; o <<= 1) v += __shfl_xor(v, o);
    return v;
}


#define XB_TMO      128
#define XB_XCNT(j)  (256  + 64 * (j))
#define XB_XSUB(j)  (1280 + 64 * (j))
#define XB_XGEN(j)  (2304 + 64 * (j))
#define XB_TOP      3328
#define XB_TOPGEN   3392
#define XCD_BAR_WORDS 3456
#define XB_SPIN_CAP (1u << 22)
__device__ __forceinline__ unsigned xb_ld(unsigned* p)              { return __hip_atomic_load(p, __ATOMIC_RELAXED, __HIP_MEMORY_SCOPE_AGENT); }
__device__ __forceinline__ unsigned xb_add(unsigned* p, unsigned v) { return __hip_atomic_fetch_add(p, v, __ATOMIC_RELAXED, __HIP_MEMORY_SCOPE_AGENT); }
__device__ __forceinline__ unsigned xb_xcc_id() { return (unsigned)__builtin_amdgcn_s_getreg((3 << 11) | 20) & 0xFu; }
#define XB_SPIN(cond, bar) do { unsigned _sp = 0; while (cond) { __builtin_amdgcn_s_sleep(1); \
    if ((++_sp & 255u) == 0u) { if (xb_ld(&(bar)[XB_TMO])) break; if (_sp > XB_SPIN_CAP) { atomicAdd(&(bar)[XB_TMO], 1u); break; } } } } while (0)
struct XcdBarrier { unsigned* bar; unsigned x; volatile LAS unsigned* st; };
__device__ __forceinline__ XcdBarrier xcd_barrier_post(unsigned* bar, volatile LAS unsigned* st) {
    XcdBarrier b; b.bar = bar; b.x = xb_xcc_id(); b.st = st;
    if (threadIdx.x == 0) (void)xb_add(&bar[XB_XCNT(b.x)], 1u);
    return b;
}
__device__ __forceinline__ void xcd_barrier_complete(unsigned* bar, unsigned x, unsigned& nloc, unsigned& nx) {
    const unsigned G = gridDim.x * gridDim.y * gridDim.z;
    unsigned sum, cnt, mine, sp = 0u;
    for (;;) {
        sum = 0u; cnt = 0u; mine = 0u;
#pragma unroll
        for (unsigned j = 0; j < 16; ++j) { const unsigned c = xb_ld(&bar[XB_XCNT(j)]); sum += c; cnt += (c > 0u) ? 1u : 0u; mine = (j == x) ? c : mine; }
        if (sum == G) break;
        __builtin_amdgcn_s_sleep(1);
        if ((++sp & 255u) == 0u) { if (xb_ld(&bar[XB_TMO])) break; if (sp > XB_SPIN_CAP) { atomicAdd(&bar[XB_TMO], 1u); break; } }
    }
    nloc = mine > 0u ? mine : 1u; nx = cnt > 0u ? cnt : 1u;
}
__device__ __forceinline__ void xcd_barrier(const XcdBarrier& b) {
    asm volatile("s_waitcnt vmcnt(0)" ::: "memory");
    __syncthreads();
    if (threadIdx.x == 0) {
        unsigned* bar = b.bar;
        __builtin_amdgcn_s_waitcnt(0);
        unsigned nloc = b.st[0], nx = b.st[1];
        if (nloc == 0u) { xcd_barrier_complete(bar, b.x, nloc, nx); b.st[0] = nloc; b.st[1] = nx; }
        const unsigned old = xb_add(&bar[XB_XSUB(b.x)], 1u);
        const unsigned gen = old / nloc;
        if (old + 1u == (gen + 1u) * nloc) {
            __builtin_amdgcn_fence(__ATOMIC_RELEASE, "agent");
            asm volatile("s_waitcnt vmcnt(0)" ::: "memory");
            const unsigned og = xb_add(&bar[XB_TOP], 1u);
            const unsigned tg = og / nx;
            if (og + 1u == (tg + 1u) * nx) xb_add(&bar[XB_TOPGEN], 1u);
            else XB_SPIN(xb_ld(&bar[XB_TOPGEN]) == tg, bar);
            __builtin_amdgcn_fence(__ATOMIC_ACQUIRE, "agent");
            xb_add(&bar[XB_XGEN(b.x)], 1u);
            asm volatile("s_waitcnt vmcnt(0)" ::: "memory");
        } else {
            XB_SPIN(xb_ld(&bar[XB_XGEN(b.x)]) == gen, bar);
            __builtin_amdgcn_fence(__ATOMIC_ACQUIRE, "agent");
            asm volatile("s_waitcnt vmcnt(0)" ::: "memory");
        }
    }
    __syncthreads();
}

namespace pg8 {
constexpr int BM = 256, BK = 64, HALF = 128, HTB = HALF * BK * 2, STAGE_BYTES = 8 * HTB, NXCD = 8, WGM = 8;
__host__ __device__ __forceinline__ int lds_byte(int r, int c) { const int st = (r >> 4) * 2 + (c >> 5), rr = r & 15, cc = c & 31, ob = rr * 64 + cc * 2; return st * 1024 + (ob ^ (((ob >> 9) & 1) << 5)); }
__host__ __device__ __forceinline__ void stage_rc(int b, int& R, int& C) { const int st = b / 1024, sb = b % 1024, swz = sb ^ (((sb >> 9) & 1) << 5); R = (st >> 1) * 16 + swz / 64; C = (st & 1) * 32 + (swz % 64) / 2; }
__host__ __device__ __forceinline__ int perm32(int rho) { const int n = rho >> 4, i = rho & 15; return 8 * (i >> 2) + 4 * n + (i & 3); }

struct Unit { int pm, pn, g; };
struct Gemm { const bf16_t* A; const bf16_t* Bt; int M, N, K; size_t gsA, gsB; };

__device__ __forceinline__ void tile_of(int wgid, int nM, int nN, int nwg, Unit& u) {
    { const int q = nwg / NXCD, r = nwg % NXCD, xcd = wgid % NXCD, off = wgid / NXCD; wgid = (xcd < r ? xcd * (q + 1) : r * (q + 1) + (xcd - r) * q) + off; }
    const int nig = WGM * nN, gid = wgid / nig, fm = gid * WGM, gsz = (nM - fm) < WGM ? (nM - fm) : WGM;
    u.pm = fm + ((wgid % nig) % gsz); u.pn = (wgid % nig) / gsz;
}
struct StaticOrder {
    int nM, nN, nwg, G, c;
    __device__ void init(int M, int N, int G_, int c_) { nM = M / BM; nN = N / BM; nwg = nM * nN; G = G_; c = c_; }
    __device__ bool next(int i, Unit& u) const {
        const long L = (long)i * G + c; if (L >= nwg) return false;
        tile_of((int)L, nM, nN, nwg, u); u.g = 0; return true;
    }
};
struct BranchOrder {
    int nM, nN, nwg, G, c;
    __device__ void init(int M, int N, int G_, int c_) { nM = M / BM; nN = N / BM; nwg = nM * nN; G = G_; c = c_; }
    __device__ bool next(int i, Unit& u) const {
        const long L = (long)(i >> 2) * G + c; if (L >= nwg) return false;
        tile_of((int)L, nM, nN, nwg, u); u.g = i & 3; return true;
    }
};

struct EpiSwiGLU {
    static constexpr bool PERM = true;
    bf16_t* O;
    __device__ __forceinline__ bool keep(const Unit&) const { return false; }
    __device__ __forceinline__ void operator()(f32x4 (&acc)[2][2][4][2], const Unit& u, int wr, int wc, int fr, int fq) const {
        const int row0 = u.pm * BM + wr * 64 + fr, col0 = u.pn * 128 + wc * 32 + 8 * fq;
#pragma unroll
        for (int ai = 0; ai < 2; ++ai)
#pragma unroll
            for (int m = 0; m < 4; ++m) {
                bf16_t* rowp = O + (size_t)(row0 + ai * HALF + m * 16) * DFF + col0;
                float v[8];
#pragma unroll
                for (int n = 0; n < 2; ++n)
#pragma unroll
                    for (int j = 0; j < 4; ++j) v[n * 4 + j] = siluf_(acc[ai][0][m][n][j]) * acc[ai][1][m][n][j];
                u32x4 w; w.x = cvt_pk_bf16(v[0], v[1]); w.y = cvt_pk_bf16(v[2], v[3]); w.z = cvt_pk_bf16(v[4], v[5]); w.w = cvt_pk_bf16(v[6], v[7]);
                *(u32x4*)rowp = w;
                __builtin_amdgcn_sched_barrier(0);
            }
    }
};
struct EpiResid {
    static constexpr bool PERM = false;
    const float* Xin; float* Xout; float scale;
    __device__ __forceinline__ bool keep(const Unit&) const { return false; }
    __device__ __forceinline__ void operator()(f32x4 (&acc)[2][2][4][2], const Unit& u, int wr, int wc, int fr, int fq) const {
        const int row0 = u.pm * BM + wr * 64 + fr, col0 = u.pn * BM + wc * 32 + 4 * fq;
#pragma unroll
        for (int ai = 0; ai < 2; ++ai)
#pragma unroll
            for (int m = 0; m < 4; ++m) {
                const size_t ro = (size_t)(row0 + ai * HALF + m * 16) * D + col0;
#pragma unroll
                for (int bj = 0; bj < 2; ++bj)
#pragma unroll
                    for (int n = 0; n < 2; ++n) { const f32x4 xi = *(const f32x4*)(Xin + ro + bj * HALF + n * 16); *(f32x4*)(Xout + ro + bj * HALF + n * 16) = xi + acc[ai][bj][m][n] * scale; }
                __builtin_amdgcn_sched_barrier(0);
            }
    }
};
struct EpiProj {
    static constexpr bool PERM = true;
    bf16_t* O; float* AB;
    __device__ __forceinline__ bool keep(const Unit&) const { return false; }
    __device__ __forceinline__ void operator()(f32x4 (&acc)[2][2][4][2], const Unit& u, int wr, int wc, int fr, int fq) const {
        const int row0 = u.pm * BM + wr * 64 + fr, col0 = u.pn * BM + wc * 32 + 8 * fq;
        const bool ab = (u.pn == PC_AB / BM) && wc == 0 && fq == 0;
#pragma unroll
        for (int ai = 0; ai < 2; ++ai)
#pragma unroll
            for (int m = 0; m < 4; ++m) {
                const int row = row0 + ai * HALF + m * 16;
                bf16_t* rowp = O + (size_t)row * PW + col0;
#pragma unroll
                for (int bj = 0; bj < 2; ++bj) {
                    const f32x4 v0 = acc[ai][bj][m][0], v1 = acc[ai][bj][m][1];
                    u32x4 w; w.x = cvt_pk_bf16(v0[0], v0[1]); w.y = cvt_pk_bf16(v0[2], v0[3]); w.z = cvt_pk_bf16(v1[0], v1[1]); w.w = cvt_pk_bf16(v1[2], v1[3]);
                    *(u32x4*)(rowp + bj * HALF) = w;
                }
                __builtin_amdgcn_sched_barrier(0);
            }
        if (ab) {
#pragma unroll
            for (int ai = 0; ai < 2; ++ai)
#pragma unroll
                for (int m = 0; m < 4; ++m) { const int row = row0 + ai * HALF + m * 16; *(f32x4*)(AB + (size_t)row * 8) = acc[ai][0][m][0]; *(f32x4*)(AB + (size_t)row * 8 + 4) = acc[ai][0][m][1]; }
        }
    }
};
struct EpiBranch {
    static constexpr bool PERM = true;
    const bf16_t* P; bf16_t* O;
    __device__ __forceinline__ bool keep(const Unit& u) const { return u.g < 3; }
    __device__ __forceinline__ void operator()(f32x4 (&acc)[2][2][4][2], const Unit& u, int wr, int wc, int fr, int fq) const {
        const int row0 = u.pm * BM + wr * 64 + fr, col0 = u.pn * BM + wc * 32 + 8 * fq;
        const bool last = (u.g == 3);
#pragma unroll
        for (int ai = 0; ai < 2; ++ai)
#pragma unroll
            for (int m = 0; m < 4; ++m) {
                const int row = row0 + ai * HALF + m * 16;
                const bf16_t* gp = P + (size_t)row * PW + PC_GATE + u.g * D + col0;
#pragma unroll
                for (int bj = 0; bj < 2; ++bj) {
                    const u32x4 g0 = *(const u32x4*)(gp + bj * HALF);
                    float f[8];
                    if (!last) {
                        const u32x4 g1 = *(const u32x4*)(gp + D + bj * HALF);
#pragma unroll
                        for (int q = 0; q < 4; ++q) {
                            f[2 * q] = (1.0f + __expf(-lo_bf(g1[q]))) * __builtin_amdgcn_rcpf(1.0f + __expf(-lo_bf(g0[q])));
                            f[2 * q + 1] = (1.0f + __expf(-hi_bf(g1[q]))) * __builtin_amdgcn_rcpf(1.0f + __expf(-hi_bf(g0[q])));
                        }
                    } else {
#pragma unroll
                        for (int q = 0; q < 4; ++q) { f[2 * q] = __builtin_amdgcn_rcpf(1.0f + __expf(-lo_bf(g0[q]))); f[2 * q + 1] = __builtin_amdgcn_rcpf(1.0f + __expf(-hi_bf(g0[q]))); }
                    }
#pragma unroll
                    for (int n = 0; n < 2; ++n)
#pragma unroll
                        for (int j = 0; j < 4; ++j) acc[ai][bj][m][n][j] *= f[n * 4 + j];
                    if (last) {
                        const f32x4 v0 = acc[ai][bj][m][0], v1 = acc[ai][bj][m][1];
                        u32x4 w; w.x = cvt_pk_bf16(v0[0], v0[1]); w.y = cvt_pk_bf16(v0[2], v0[3]); w.z = cvt_pk_bf16(v1[0], v1[1]); w.w = cvt_pk_bf16(v1[2], v1[3]);
                        *(u32x4*)(O + (size_t)row * D + col0 + bj * HALF) = w;
                    }
                    __builtin_amdgcn_sched_barrier(0);
                }
            }
    }
};

template <class Epi, class Sched>
__device__ __forceinline__ void gemm_phase(LAS unsigned char* lds, const Gemm g, const Sched& S, const Epi& E) {
    const int tid = ltid(), wid = __builtin_amdgcn_readfirstlane(tid >> 6), lane = tid & 63, wr = wid >> 2, wc = wid & 3, fr = lane & 15, fq = lane >> 4;
    const int K = g.K, nt = K / BK;
    unsigned voffA[2], voffB[2];
#pragma unroll
    for (int i = 0; i < 2; ++i) { int R, C; stage_rc(tid * 16 + i * 8192, R, C); const int Rb = Epi::PERM ? ((R & ~31) + perm32(R & 31)) : R;
        voffA[i] = (unsigned)(R * K + C) * 2u; voffB[i] = (unsigned)(Rb * K + C) * 2u; }
    const size_t kstep = (size_t)(BK * 2);
    const size_t hstep = (size_t)HALF * K * 2;
    const size_t tstep = 2 * hstep;
    const unsigned ldsw = (unsigned)wid * 1024u;
    const int aoff = lds_byte(wr * 64 + fr, fq * 8), boff = lds_byte(wc * 32 + fr, fq * 8);
#define PG8_SA(b, h) (((b) * 2 + (h)) * HTB)
#define PG8_SB(b, h) ((4 + (b) * 2 + (h)) * HTB)
#define PG8_STAGE(bufoff, gbase, voff) do { _Pragma("unroll") for (int _i = 0; _i < 2; ++_i) \
        __builtin_amdgcn_global_load_lds((const unsigned*)((const char*)(gbase) + (voff)[_i]), (LAS unsigned*)(lds + (bufoff) + ldsw + _i * 8192), 16, 0, 0); } while (0)
#define PG8_LDA(dst, b, h) do { _Pragma("unroll") for (int m = 0; m < 4; ++m) _Pragma("unroll") for (int k = 0; k < 2; ++k) dst[m][k] = *(const LAS bf16x8*)(lds + PG8_SA(b, h) + aoff + m * 2048 + k * 1024); } while (0)
#define PG8_LDB(dst, b, h) do { _Pragma("unroll") for (int n = 0; n < 2; ++n) _Pragma("unroll") for (int k = 0; k < 2; ++k) dst[n][k] = *(const LAS bf16x8*)(lds + PG8_SB(b, h) + boff + n * 2048 + k * 1024); } while (0)
#define PG8_MMA(ai, bj, At, Bt) do { __builtin_amdgcn_s_setprio(1); _Pragma("unroll") for (int m = 0; m < 4; ++m) _Pragma("unroll") for (int n = 0; n < 2; ++n) _Pragma("unroll") for (int k = 0; k < 2; ++k) \
        acc[ai][bj][m][n] = __builtin_amdgcn_mfma_f32_16x16x32_bf16(Bt[n][k], At[m][k], acc[ai][bj][m][n], 0, 0, 0); __builtin_amdgcn_s_setprio(0); } while (0)
#define PG8_WAIT_V(n) asm volatile("s_waitcnt vmcnt(" #n ")" ::: "memory")
#define PG8_WAIT_L(n) asm volatile("s_waitcnt lgkmcnt(" #n ")" ::: "memory")
#define PG8_BAR __builtin_amdgcn_s_barrier()
#define PG8_SCHED __builtin_amdgcn_sched_barrier(0)
    Unit cur, nxt; int ui = 0;
    if (!S.next(0, cur)) return;
    f32x4 acc[2][2][4][2];
#pragma unroll
    for (int a = 0; a < 2; ++a)
#pragma unroll
        for (int b = 0; b < 2; ++b)
#pragma unroll
            for (int m = 0; m < 4; ++m)
#pragma unroll
                for (int n = 0; n < 2; ++n) acc[a][b][m][n] = (f32x4){0.f, 0.f, 0.f, 0.f};
    bf16x8 At[4][2], B0[2][2], B1[2][2];
    const char* cA = (const char*)g.A + (size_t)cur.g * g.gsA + (size_t)cur.pm * tstep; const char* cB = (const char*)g.Bt + (size_t)cur.g * g.gsB + (size_t)cur.pn * tstep;
    PG8_STAGE(PG8_SB(0, 0), cB, voffB); PG8_STAGE(PG8_SA(0, 0), cA, voffA); PG8_STAGE(PG8_SB(0, 1), cB + hstep, voffB); PG8_STAGE(PG8_SA(0, 1), cA + hstep, voffA);
    if (wr == 1) PG8_BAR;
    PG8_WAIT_V(4); PG8_BAR;
    PG8_STAGE(PG8_SB(1, 0), cB + kstep, voffB); PG8_STAGE(PG8_SA(1, 0), cA + kstep, voffA); PG8_STAGE(PG8_SB(1, 1), cB + hstep + kstep, voffB);
    PG8_WAIT_V(6); PG8_BAR;
    for (;;) {
        const bool has_next = S.next(ui + 1, nxt);
        const char* nA = has_next ? (const char*)g.A + (size_t)nxt.g * g.gsA + (size_t)nxt.pm * tstep : cA; const char* nB = has_next ? (const char*)g.Bt + (size_t)nxt.g * g.gsB + (size_t)nxt.pn * tstep : cB;
        for (int t = 0; t < nt; t += 2) {
            const bool last = (t == nt - 2);
            const char* a1 = cA + (size_t)(t + 1) * kstep;
            const char* a2 = last ? nA : cA + (size_t)(t + 2) * kstep; const char* b2 = last ? nB : cB + (size_t)(t + 2) * kstep;
            const char* a3 = a2 + kstep; const char* b3 = b2 + kstep;
            PG8_LDB(B0, 0, 0); PG8_SCHED; PG8_LDA(At, 0, 0); PG8_STAGE(PG8_SA(1, 1), a1 + hstep, voffA);
            PG8_WAIT_L(8); PG8_BAR; PG8_WAIT_L(0); PG8_MMA(0, 0, At, B0); PG8_BAR; PG8_SCHED;
            PG8_LDB(B1, 0, 1); PG8_STAGE(PG8_SB(0, 0), b2, voffB);
            PG8_BAR; PG8_WAIT_L(0); PG8_MMA(0, 1, At, B1); PG8_BAR;
            PG8_LDA(At, 0, 1); PG8_STAGE(PG8_SA(0, 0), a2, voffA);
            PG8_BAR; PG8_WAIT_L(0); PG8_MMA(1, 0, At, B0); PG8_BAR; PG8_SCHED;
            PG8_STAGE(PG8_SB(0, 1), b2 + hstep, voffB);
            PG8_WAIT_V(6); PG8_BAR; PG8_MMA(1, 1, At, B1); PG8_BAR;
            PG8_LDB(B0, 1, 0); PG8_SCHED; PG8_LDA(At, 1, 0); PG8_STAGE(PG8_SA(0, 1), a2 + hstep, voffA);
            PG8_WAIT_L(8); PG8_BAR; PG8_WAIT_L(0); PG8_MMA(0, 0, At, B0); PG8_BAR; PG8_SCHED;
            PG8_LDB(B1, 1, 1); PG8_STAGE(PG8_SB(1, 0), b3, voffB);
            PG8_BAR; PG8_WAIT_L(0); PG8_MMA(0, 1, At, B1); PG8_BAR;
            PG8_LDA(At, 1, 1); PG8_STAGE(PG8_SA(1, 0), a3, voffA);
            PG8_BAR; PG8_WAIT_L(0); PG8_MMA(1, 0, At, B0); PG8_BAR; PG8_SCHED;
            PG8_STAGE(PG8_SB(1, 1), b3 + hstep, voffB);
            PG8_WAIT_V(6); PG8_BAR; PG8_MMA(1, 1, At, B1); PG8_BAR;
        }
        E(acc, cur, wr, wc, fr, fq);
        if (!has_next) break;
        if (!E.keep(cur)) {
#pragma unroll
            for (int a = 0; a < 2; ++a)
#pragma unroll
                for (int b = 0; b < 2; ++b)
#pragma unroll
                    for (int m = 0; m < 4; ++m)
#pragma unroll
                        for (int n = 0; n < 2; ++n) acc[a][b][m][n] = (f32x4){0.f, 0.f, 0.f, 0.f};
        }
        cur = nxt; cA = nA; cB = nB; ++ui;
    }
    PG8_WAIT_V(0);
    if (wr == 0) PG8_BAR;
    PG8_BAR;
#undef PG8_SA
#undef PG8_SB
#undef PG8_STAGE
#undef PG8_LDA
#undef PG8_LDB
#undef PG8_MMA
#undef PG8_WAIT_V
#undef PG8_WAIT_L
#undef PG8_BAR
#undef PG8_SCHED
}
}


#define NOINL __forceinline__
__device__ NOINL void ph_gemm_swiglu(LAS unsigned char* lds, const bf16_t* A, const bf16_t* Bt, bf16_t* O) {
    pg8::Gemm g{A, Bt, T, 2 * DFF, D, 0, 0}; pg8::StaticOrder S; S.init(g.M, g.N, lgdim(), lbid()); pg8::EpiSwiGLU E{O}; pg8::gemm_phase(lds, g, S, E);
}
__device__ NOINL void ph_gemm_resid(LAS unsigned char* lds, const bf16_t* A, const bf16_t* Bt, int M, int K, const float* Xin, float* Xout, float scale) {
    pg8::Gemm g{A, Bt, M, D, K, 0, 0}; pg8::StaticOrder S; S.init(g.M, g.N, lgdim(), lbid()); pg8::EpiResid E{Xin, Xout, scale}; pg8::gemm_phase(lds, g, S, E);
}
__device__ NOINL void ph_gemm_proj(LAS unsigned char* lds, const bf16_t* A, const bf16_t* Bt, bf16_t* O, float* AB) {
    pg8::Gemm g{A, Bt, TS, PW, D, 0, 0}; pg8::StaticOrder S; S.init(g.M, g.N, lgdim(), lbid()); pg8::EpiProj E{O, AB}; pg8::gemm_phase(lds, g, S, E);
}
__device__ NOINL void ph_gemm_branch(LAS unsigned char* lds, const bf16_t* A, const bf16_t* Bt, const bf16_t* P, bf16_t* O) {
    pg8::Gemm g{A, Bt, TS, D, 512, (size_t)TS * 512 * 2, (size_t)D * 512 * 2}; pg8::BranchOrder S; S.init(g.M, g.N, lgdim(), lbid()); pg8::EpiBranch E{P, O}; pg8::gemm_phase(lds, g, S, E);
}

__device__ __forceinline__ void conv_tile(LAS float* scr, const float* src0, const float* src1, int K, int Nsrc, bf16_t* dst, int mode, int tile) {
    const int nkt = K / 64, kt = tile % nkt, rt = tile / nkt, k0 = kt * 64, r0 = rt * 64, tid = ltid();
    {
        const int kk = tid >> 3, rr = (tid & 7) * 8, rho = r0 + rr;
        const float* src = src0; int col = rho;
        if (mode == 1) { const int pn = rho >> 8, bj = (rho >> 7) & 1, j = rho & 127; col = pn * 128 + j; src = bj ? src1 : src0; }
        else if (mode == 2) { col = rho < 4096 ? rho : (rho < 8704 ? rho + 8 : (rho < 8712 ? rho - 8704 + 4096 : -1)); }
        f32x4 a = (f32x4){0.f, 0.f, 0.f, 0.f}, b = a;
        if (col >= 0) { const float* sp = src + (size_t)(k0 + kk) * Nsrc + col; a = *(const f32x4*)sp; b = *(const f32x4*)(sp + 4); }
#pragma unroll
        for (int e = 0; e < 4; ++e) { scr[(rr + e) * 65 + kk] = a[e]; scr[(rr + 4 + e) * 65 + kk] = b[e]; }
    }
    __syncthreads();
    {
        const int rl = tid >> 3, kc = (tid & 7) * 8;
        const LAS float* s = scr + rl * 65 + kc;
        u32x4 w; w.x = cvt_pk_bf16(s[0], s[1]); w.y = cvt_pk_bf16(s[2], s[3]); w.z = cvt_pk_bf16(s[4], s[5]); w.w = cvt_pk_bf16(s[6], s[7]);
        *(u32x4*)(dst + (size_t)(r0 + rl) * K + k0 + kc) = w;
    }
    __syncthreads();
}

__device__ __forceinline__ void convert_layer(LAS unsigned char* lds, const Params& p, int l) {
    LAS float* scr = (LAS float*)lds;
    unsigned char* ws = lptr(p.ws);
    constexpr int N1 = 16 * 88, N2 = 44 * 16, N3 = 16 * 140, N4 = 8 * 16, N5 = 16 * 16;
    constexpr int TOT = N1 + N2 + N3 + 4 * N4 + N5 + N1 + N2;
    for (int it = lbid(); it < TOT; it += lgdim()) {
        int r = it;
        if (r < N1) { conv_tile(scr, p.in[zz() + 2] + (size_t)l * D * DFF, p.in[zz() + 3] + (size_t)l * D * DFF, D, DFF, (bf16_t*)(ws + WS_WGU1), 1, r); continue; } r -= N1;
        if (r < N2) { conv_tile(scr, p.in[zz() + 4] + (size_t)l * DFF * D, nullptr, DFF, D, (bf16_t*)(ws + WS_WD1), 0, r); continue; } r -= N2;
        if (r < N3) { conv_tile(scr, p.in[zz() + 6] + (size_t)l * D * PIN, nullptr, D, PIN, (bf16_t*)(ws + WS_WIN), 2, r); continue; } r -= N3;
        if (r < 4 * N4) { const int g = r / N4; conv_tile(scr, p.in[zz() + 24] + ((size_t)l * 4 + g) * 512 * D, nullptr, 512, D, (bf16_t*)(ws + WS_WB) + (size_t)g * D * 512, 0, r % N4); continue; } r -= 4 * N4;
        if (r < N5) { conv_tile(scr, p.in[zz() + 25] + (size_t)l * D * D, nullptr, D, D, (bf16_t*)(ws + WS_WOUT), 0, r); continue; } r -= N5;
        if (r < N1) { conv_tile(scr, p.in[zz() + 27] + (size_t)l * D * DFF, p.in[zz() + 28] + (size_t)l * D * DFF, D, DFF, (bf16_t*)(ws + WS_WGU2), 1, r); continue; } r -= N1;
        conv_tile(scr, p.in[zz() + 29] + (size_t)l * DFF * D, nullptr, DFF, D, (bf16_t*)(ws + WS_WD2), 0, r);
    }
    bf16_t* waxt = (bf16_t*)(ws + WS_WAXT); bf16_t* pwt = (bf16_t*)(ws + WS_PWT);
    const float* wa = p.in[zz() + 13] + (size_t)l * 8 * 64 * 64; const float* wx = p.in[zz() + 15] + (size_t)l * 8 * 64 * 64; const float* pw = p.in[zz() + 22] + (size_t)l * 4 * 128 * 128;
    for (int e = lbid() * NTHR + ltid(); e < 65536; e += lgdim() * NTHR) {
        { const int h = e >> 13, jp = (e >> 6) & 127, i = e & 63; waxt[e] = f2bf(jp < 64 ? wa[(h * 64 + i) * 64 + jp] : wx[(h * 64 + i) * 64 + jp - 64]); }
        { const int g = e >> 14, d = (e >> 7) & 127, c = e & 127; pwt[e] = f2bf(pw[(g * 128 + c) * 128 + d]); }
    }
}

__device__ __forceinline__ void rms_rows_bf16(const float* X, const float* gain, bf16_t* H, int nrows) {
    const int wid = ltid() >> 6, lane = ltid() & 63;
    f32x4 gv[4];
#pragma unroll
    for (int j = 0; j < 4; ++j) gv[j] = *(const f32x4*)(gain + (lane + 64 * j) * 4);
    for (int row = lbid() * 8 + wid; row < nrows; row += lgdim() * 8) {
        const f32x4* xr = (const f32x4*)(X + (size_t)row * D) + lane;
        f32x4 v[4]; float s = 0.f;
#pragma unroll
        for (int j = 0; j < 4; ++j) { v[j] = xr[64 * j]; s += (v[j].x * v[j].x + v[j].y * v[j].y) + (v[j].z * v[j].z + v[j].w * v[j].w); }
        const float rs = rsqrtf(wave_sum(s) * (1.0f / D) + EPS);
        u32x2* o = (u32x2*)(H + (size_t)row * D) + lane;
#pragma unroll
        for (int j = 0; j < 4; ++j) { u32x2 w; w.x = cvt_pk_bf16(v[j].x * rs * gv[j].x, v[j].y * rs * gv[j].y); w.y = cvt_pk_bf16(v[j].z * rs * gv[j].z, v[j].w * rs * gv[j].w); o[64 * j] = w; }
    }
}
__device__ __forceinline__ void rms_rows_f32_inplace(float* X, const float* gain, int nrows) {
    const int wid = ltid() >> 6, lane = ltid() & 63;
    f32x4 gv[4];
#pragma unroll
    for (int j = 0; j < 4; ++j) gv[j] = *(const f32x4*)(gain + (lane + 64 * j) * 4);
    for (int row = lbid() * 8 + wid; row < nrows; row += lgdim() * 8) {
        f32x4* xr = (f32x4*)(X + (size_t)row * D) + lane;
        f32x4 v[4]; float s = 0.f;
#pragma unroll
        for (int j = 0; j < 4; ++j) { v[j] = xr[64 * j]; s += (v[j].x * v[j].x + v[j].y * v[j].y) + (v[j].z * v[j].z + v[j].w * v[j].w); }
        const float rs = rsqrtf(wave_sum(s) * (1.0f / D) + EPS);
#pragma unroll
        for (int j = 0; j < 4; ++j) xr[64 * j] = v[j] * rs * gv[j];
    }
}

__device__ __forceinline__ void sgu_tile(LAS unsigned char* lds, const Params& p, int l, const bf16_t* proj, bf16_t* ya, int tile) {
    const int tid = ltid(), wid = tid >> 6, lane = tid & 63, fr = lane & 15, fq = lane >> 4;
    const int blk = tile >> 2, g = tile & 3, r0 = blk * 128;
    LAS bf16_t* Wl = (LAS bf16_t*)lds;
    LAS bf16_t* VT = (LAS bf16_t*)(lds + 34816);
    const float* lng = p.in[zz() + 7] + l * 512 + g * 128; const float* lnb = p.in[zz() + 8] + l * 512 + g * 128;
    {
        const int i = tid >> 2, qd = tid & 3;
        const bf16_t* vrow = proj + (size_t)(r0 + i) * PW + PC_AV + qd * 128;
        float s = 0.f, s2 = 0.f;
#pragma unroll 4
        for (int e8 = 0; e8 < 16; ++e8) { const u32x4 w = *(const u32x4*)(vrow + e8 * 8);
#pragma unroll
            for (int q = 0; q < 4; ++q) { const float a = geluf_(lo_bf(w[q])), b = geluf_(hi_bf(w[q])); s += a + b; s2 += a * a + b * b; } }
        s += __shfl_xor(s, 1); s += __shfl_xor(s, 2); s2 += __shfl_xor(s2, 1); s2 += __shfl_xor(s2, 2);
        const float mean = s * (1.0f / 512.0f), var = fmaxf(s2 * (1.0f / 512.0f) - mean * mean, 0.f), rstd = rsqrtf(var + EPS);
        const bf16_t* vg = proj + (size_t)(r0 + i) * PW + PC_AV + g * 128 + qd * 32;
#pragma unroll
        for (int e8 = 0; e8 < 4; ++e8) { const u32x4 w = *(const u32x4*)(vg + e8 * 8);
#pragma unroll
            for (int q = 0; q < 4; ++q) { const int c = qd * 32 + e8 * 8 + 2 * q;
                VT[c * 136 + i] = f2bf((geluf_(lo_bf(w[q])) - mean) * rstd * lng[c] + lnb[c]);
                VT[(c + 1) * 136 + i] = f2bf((geluf_(hi_bf(w[q])) - mean) * rstd * lng[c + 1] + lnb[c + 1]); } }
        const float* wsrc = p.in[zz() + 9] + (((size_t)l * 4 + g) * 128 + i) * 128 + qd * 32;
#pragma unroll
        for (int e4 = 0; e4 < 8; ++e4) { f32x4 w = *(const f32x4*)(wsrc + e4 * 4); if (i < 64 && qd >= 2) w = (f32x4){0.f, 0.f, 0.f, 0.f};
            u32x2 o; o.x = cvt_pk_bf16(w.x, w.y); o.y = cvt_pk_bf16(w.z, w.w); *(LAS u32x2*)(Wl + i * 136 + qd * 32 + e4 * 4) = o; }
    }
    __syncthreads();
    f32x4 acc[8];
#pragma unroll
    for (int n = 0; n < 8; ++n) acc[n] = (f32x4){0.f, 0.f, 0.f, 0.f};
#pragma unroll
    for (int ks = 0; ks < 4; ++ks) {
        const bf16x8 af = *(const LAS bf16x8*)(Wl + (wid * 16 + fr) * 136 + ks * 32 + fq * 8);
#pragma unroll
        for (int n = 0; n < 8; ++n) { const bf16x8 bf = *(const LAS bf16x8*)(VT + (n * 16 + fr) * 136 + ks * 32 + fq * 8); acc[n] = __builtin_amdgcn_mfma_f32_16x16x32_bf16(bf, af, acc[n], 0, 0, 0); }
    }
    {
        const int i = wid * 16 + fr; const float bias = p.in[zz() + 10][((size_t)l * 4 + g) * 128 + i];
        const bf16_t* up = proj + (size_t)(r0 + i) * PW + PC_AU + g * 128 + fq * 4;
        bf16_t* yp = ya + (size_t)(r0 + i) * 512 + g * 128 + fq * 4;
#pragma unroll
        for (int n = 0; n < 8; ++n) { const u32x2 uw = *(const u32x2*)(up + n * 16);
            u32x2 o; o.x = cvt_pk_bf16((acc[n][0] + bias) * geluf_(lo_bf(uw.x)), (acc[n][1] + bias) * geluf_(hi_bf(uw.x)));
            o.y = cvt_pk_bf16((acc[n][2] + bias) * geluf_(lo_bf(uw.y)), (acc[n][3] + bias) * geluf_(hi_bf(uw.y))); *(u32x2*)(yp + n * 16) = o; }
    }
    __syncthreads();
}

template <int WIN>
__device__ __forceinline__ void pool_rows(LAS bf16_t* Al, const bf16_t* xcol, int c, int pos0) {
    float xv[80];
#pragma unroll
    for (int k = 0; k < 80; ++k) xv[k] = (pos0 - 16 + k >= 0) ? bf2f(xcol[(long)(k - 16) * PW]) : 0.f;
    float s = 0.f;
#pragma unroll
    for (int j = 0; j < WIN; ++j) s += xv[16 - j];
#pragma unroll
    for (int tt = 0; tt < 64; ++tt) {
        const int k = tt + 16;
        const int cnt = min(pos0 + tt + 1, WIN);
        Al[tt * 520 + c] = f2bf(s / (float)cnt - xv[k]);
        if (tt < 63) s += xv[k + 1] - xv[k + 1 - WIN];
    }
}
__device__ __forceinline__ void pool_tile(LAS unsigned char* lds, const Params& p, int l, const bf16_t* proj, bf16_t* yd, bf16_t* halo, const bf16_t* pwt, int tile) {
    const int tid = ltid(), wid = tid >> 6, lane = tid & 63, fr = lane & 15, fq = lane >> 4;
    const int t0 = tile * 64, pos0 = t0 % SEQ;
    LAS bf16_t* Al = (LAS bf16_t*)lds;
    {
        const int c = tid, g = wid >> 1;
        const bf16_t* xcol = proj + (size_t)t0 * PW + PC_DX + c;
        if (g == 0) pool_rows<2>(Al, xcol, c, pos0); else if (g == 1) pool_rows<4>(Al, xcol, c, pos0); else if (g == 2) pool_rows<8>(Al, xcol, c, pos0); else pool_rows<16>(Al, xcol, c, pos0);
    }
    __syncthreads();
    {
        const int g = wid >> 1, nh = wid & 1;
        f32x4 acc[4][4];
#pragma unroll
        for (int m = 0; m < 4; ++m)
#pragma unroll
            for (int n = 0; n < 4; ++n) acc[m][n] = (f32x4){0.f, 0.f, 0.f, 0.f};
#pragma unroll
        for (int ks = 0; ks < 4; ++ks) {
            bf16x8 bfr[4];
#pragma unroll
            for (int n = 0; n < 4; ++n) bfr[n] = *(const bf16x8*)(pwt + ((size_t)(g * 128 + (nh * 4 + n) * 16 + fr)) * 128 + ks * 32 + fq * 8);
#pragma unroll
            for (int m = 0; m < 4; ++m) { const bf16x8 af = *(const LAS bf16x8*)(Al + (m * 16 + fr) * 520 + g * 128 + ks * 32 + fq * 8);
#pragma unroll
                for (int n = 0; n < 4; ++n) acc[m][n] = __builtin_amdgcn_mfma_f32_16x16x32_bf16(bfr[n], af, acc[m][n], 0, 0, 0); }
        }
        const float* sc = p.in[zz() + 23] + l * 512 + g * 128;
#pragma unroll
        for (int n = 0; n < 4; ++n) { const int d = (nh * 4 + n) * 16 + fq * 4; const f32x4 s4 = *(const f32x4*)(sc + d);
#pragma unroll
            for (int m = 0; m < 4; ++m) { u32x2 o; o.x = cvt_pk_bf16(acc[m][n][0] * s4[0], acc[m][n][1] * s4[1]); o.y = cvt_pk_bf16(acc[m][n][2] * s4[2], acc[m][n][3] * s4[3]);
                *(u32x2*)(yd + (size_t)(t0 + m * 16 + fr) * 512 + g * 128 + d) = o; } }
    }
    __syncthreads();
}

__device__ __forceinline__ void lru_tile(LAS unsigned char* lds, const Params& p, int l, const bf16_t* proj, bf16_t* yb, const bf16_t* waxt, float* Aend, float* Hend, const float* carry, int tile, int mode) {
    const int tid = ltid(), wid = tid >> 6, lane = tid & 63, fr = lane & 15, fq = lane >> 4;
    const int t0 = tile * 64, pos0 = t0 % SEQ, c = wid * 64 + lane;
    LAS bf16_t* Aw = (LAS bf16_t*)(lds + wid * 10560);
    LAS float* Xw = (LAS float*)(lds + wid * 10560 + 2304);
    bf16x8 bfr[8][2];
#pragma unroll
    for (int n = 0; n < 8; ++n)
#pragma unroll
        for (int ks = 0; ks < 2; ++ks) bfr[n][ks] = *(const bf16x8*)(waxt + ((size_t)(wid * 128 + n * 16 + fr)) * 64 + ks * 32 + fq * 8);
    const float* cwp = p.in[zz() + 11] + (size_t)l * 4 * 512 + c;
    const float cw0 = cwp[0], cw1 = cwp[512], cw2 = cwp[1024], cw3 = cwp[1536], cb = p.in[zz() + 12][l * 512 + c];
    const float ba = p.in[zz() + 14][l * 512 + c], bx = p.in[zz() + 16][l * 512 + c], sp8 = 8.0f * softplusf_(-p.in[zz() + 17][l * 512 + c]);
    const bf16_t* xcol = proj + (size_t)t0 * PW + PC_BX + c;
    float xm3 = 0.f, xm2 = 0.f, xm1 = 0.f;
    if (pos0 > 0) { xm3 = bf2f(xcol[-3L * PW]); xm2 = bf2f(xcol[-2L * PW]); xm1 = bf2f(xcol[-1L * PW]); }
    const bf16_t* gcol = proj + (size_t)t0 * PW + PC_BG + c;
    bf16_t* ycol = yb + (size_t)t0 * 512 + c;
    float h = mode ? carry[(size_t)tile * 512 + c] : 0.f, Ap = 1.f;
    for (int sub = 0; sub < 4; ++sub) {
        float xc[16];
#pragma unroll
        for (int tt = 0; tt < 16; ++tt) { const float xin = bf2f(*xcol); xcol += PW; xc[tt] = cb + cw0 * xm3 + cw1 * xm2 + cw2 * xm1 + cw3 * xin; xm3 = xm2; xm2 = xm1; xm1 = xin; Aw[tt * 72 + lane] = f2bf(xc[tt]); }
        __syncthreads();
        f32x4 acc[8];
#pragma unroll
        for (int n = 0; n < 8; ++n) acc[n] = (f32x4){0.f, 0.f, 0.f, 0.f};
#pragma unroll
        for (int ks = 0; ks < 2; ++ks) { const bf16x8 af = *(const LAS bf16x8*)(Aw + fr * 72 + ks * 32 + fq * 8);
#pragma unroll
            for (int n = 0; n < 8; ++n) acc[n] = __builtin_amdgcn_mfma_f32_16x16x32_bf16(bfr[n][ks], af, acc[n], 0, 0, 0); }
#pragma unroll
        for (int n = 0; n < 8; ++n)
#pragma unroll
            for (int j = 0; j < 4; ++j) Xw[fr * 129 + n * 16 + fq * 4 + j] = acc[n][j];
        __syncthreads();
#pragma unroll
        for (int tt = 0; tt < 16; ++tt) {
            const float r = sigmoidf_(Xw[tt * 129 + lane] + ba), ig = sigmoidf_(Xw[tt * 129 + 64 + lane] + bx);
            const float la = -sp8 * r, a = __expf(la), x2 = 2.0f * la;
            const float om = (x2 > -0.1f) ? -x2 * (1.0f + x2 * (0.5f + x2 * (0.16666667f + x2 * 0.041666668f))) : 1.0f - a * a;
            h = a * h + sqrtf(om) * ig * xc[tt]; Ap *= a;
            if (mode) { const float gt = bf2f(*gcol); gcol += PW; *ycol = f2bf(h * geluf_(gt)); ycol += 512; }
        }
        __syncthreads();
    }
    if (!mode) { Aend[(size_t)tile * 512 + c] = Ap; Hend[(size_t)tile * 512 + c] = h; }
}
__device__ __forceinline__ void lru_carry(const float* Aend, const float* Hend, float* carry) {
    const int gid = lbid() * NTHR + ltid();
    if (gid < (TS / SEQ) * 512) {
        const int bl = gid >> 9, c = gid & 511; float h = 0.f;
        for (int n = 0; n < 64; ++n) { const size_t o = (size_t)(bl * 64 + n) * 512 + c; carry[o] = h; h = Aend[o] * h + Hend[o]; }
    }
}

__device__ __forceinline__ void gdn_prep(LAS unsigned char* lds, const Params& p, int l, const bf16_t* proj, const float* AB, bf16_t* GQ, bf16_t* GK, bf16_t* GU, bf16_t* GW, bf16_t* GA, float* edec, int item) {
    const int tid = ltid(), wid = tid >> 6, lane = tid & 63, fr = lane & 15, fq = lane >> 4;
    const int bl = item >> 8, n = (item & 255) >> 2, hh = item & 3, ch = bl * 64 + n, t0 = ch * 64;
    LAS bf16_t* Kl = (LAS bf16_t*)lds;
    LAS bf16_t* Ql = (LAS bf16_t*)(lds + 17408);
    LAS float* RHS = (LAS float*)(lds + 34816);
    LAS float* Am = (LAS float*)(lds + 100352);
    LAS float* gc = (LAS float*)(lds + 116736);
    LAS float* bt = (LAS float*)(lds + 116992);
    const int t = tid >> 3, d0 = (tid & 7) * 16;
    float qkv[3][16];
#pragma unroll
    for (int sec = 0; sec < 3; ++sec) {
        const int colh = sec * 512 + hh * 128 + d0;
        float a[16];
#pragma unroll
        for (int e = 0; e < 16; ++e) a[e] = 0.f;
#pragma unroll
        for (int k = 0; k < 4; ++k) {
            const int tt = t - 3 + k;
            const bf16_t* src = nullptr;
            if (tt >= 0 || n > 0) src = proj + (long)(t0 + tt) * PW + PC_CQ + colh;
            if (src) {
                const u32x4 w0 = *(const u32x4*)src, w1 = *(const u32x4*)(src + 8);
                const float* cw = p.in[zz() + 18] + ((size_t)l * 4 + k) * 1536 + colh;
#pragma unroll
                for (int q = 0; q < 4; ++q) { const f32x4 c4 = *(const f32x4*)(cw + q * 4);
                    const unsigned wa = (q < 2) ? w0[2 * q] : w1[2 * q - 4], wb = (q < 2) ? w0[2 * q + 1] : w1[2 * q - 3];
                    a[q * 4 + 0] += c4[0] * lo_bf(wa); a[q * 4 + 1] += c4[1] * hi_bf(wa); a[q * 4 + 2] += c4[2] * lo_bf(wb); a[q * 4 + 3] += c4[3] * hi_bf(wb); }
            }
        }
#pragma unroll
        for (int e = 0; e < 16; ++e) qkv[sec][e] = siluf_(a[e]);
    }
    {
        float sq = 0.f, sk = 0.f;
#pragma unroll
        for (int e = 0; e < 16; ++e) { sq += qkv[0][e] * qkv[0][e]; sk += qkv[1][e] * qkv[1][e]; }
        sq += __shfl_xor(sq, 1); sq += __shfl_xor(sq, 2); sq += __shfl_xor(sq, 4); sk += __shfl_xor(sk, 1); sk += __shfl_xor(sk, 2); sk += __shfl_xor(sk, 4);
        const float qn = rsqrtf(sq + EPS) * 0.08838834764831845f, kn = rsqrtf(sk + EPS);
#pragma unroll
        for (int e = 0; e < 16; ++e) { qkv[0][e] *= qn; qkv[1][e] *= kn; }
#pragma unroll
        for (int e = 0; e < 16; e += 2) { *(LAS unsigned*)(Ql + t * 136 + d0 + e) = cvt_pk_bf16(qkv[0][e], qkv[0][e + 1]); *(LAS unsigned*)(Kl + t * 136 + d0 + e) = cvt_pk_bf16(qkv[1][e], qkv[1][e + 1]); }
    }
    if (wid == 0) {
        const float al = AB[(size_t)(t0 + lane) * 8 + 4 + hh], be = AB[(size_t)(t0 + lane) * 8 + hh];
        float gv = -__expf(p.in[zz() + 19][l * 4 + hh]) * softplusf_(al + p.in[zz() + 20][l * 4 + hh]);
#pragma unroll
        for (int o = 1; o < 64; o <<= 1) { const float u = __shfl_up(gv, o); if (lane >= o) gv += u; }
        gc[lane] = gv; bt[lane] = sigmoidf_(be);
        if (lane == 63) edec[item] = __expf(gv);
    }
    __syncthreads();
    {
        const float bet = bt[t], gct = gc[t], eg = __expf(gct), ekd = __expf(gc[63] - gct);
#pragma unroll
        for (int e = 0; e < 16; ++e) { RHS[t * 256 + d0 + e] = qkv[2][e] * bet; RHS[t * 256 + 128 + d0 + e] = qkv[1][e] * bet * eg; }
        bf16_t* qdst = GQ + (size_t)(t0 + t) * 512 + hh * 128 + d0;
        u32x4 w0, w1;
        w0.x = cvt_pk_bf16(qkv[0][0] * eg, qkv[0][1] * eg); w0.y = cvt_pk_bf16(qkv[0][2] * eg, qkv[0][3] * eg); w0.z = cvt_pk_bf16(qkv[0][4] * eg, qkv[0][5] * eg); w0.w = cvt_pk_bf16(qkv[0][6] * eg, qkv[0][7] * eg);
        w1.x = cvt_pk_bf16(qkv[0][8] * eg, qkv[0][9] * eg); w1.y = cvt_pk_bf16(qkv[0][10] * eg, qkv[0][11] * eg); w1.z = cvt_pk_bf16(qkv[0][12] * eg, qkv[0][13] * eg); w1.w = cvt_pk_bf16(qkv[0][14] * eg, qkv[0][15] * eg);
        *(u32x4*)qdst = w0; *(u32x4*)(qdst + 8) = w1;
#pragma unroll
        for (int e = 0; e < 16; ++e) qkv[1][e] *= ekd;
    }
    {
        const int it = wid & 3, which = wid >> 2;
        LAS bf16_t* Xi = which ? Ql : Kl;
        bf16x8 af[4];
#pragma unroll
        for (int ks = 0; ks < 4; ++ks) af[ks] = *(const LAS bf16x8*)(Xi + (it * 16 + fr) * 136 + ks * 32 + fq * 8);
        const int i = it * 16 + fr; const float gci = gc[i], bti = bt[i];
#pragma unroll
        for (int jt = 0; jt < 4; ++jt) {
            f32x4 acc = (f32x4){0.f, 0.f, 0.f, 0.f};
#pragma unroll
            for (int ks = 0; ks < 4; ++ks) { const bf16x8 bf = *(const LAS bf16x8*)(Kl + (jt * 16 + fr) * 136 + ks * 32 + fq * 8); acc = __builtin_amdgcn_mfma_f32_16x16x32_bf16(bf, af[ks], acc, 0, 0, 0); }
            float v[4];
#pragma unroll
            for (int jj = 0; jj < 4; ++jj) { const int j = jt * 16 + fq * 4 + jj; const float dec = (i >= j) ? __expf(gci - gc[j]) : 0.f;
                v[jj] = which ? acc[jj] * dec : ((i > j) ? bti * acc[jj] * dec : 0.f); }
            if (which) { u32x2 o; o.x = cvt_pk_bf16(v[0], v[1]); o.y = cvt_pk_bf16(v[2], v[3]); *(u32x2*)(GA + (size_t)(t0 + i) * 256 + hh * 64 + jt * 16 + fq * 4) = o; }
            else *(LAS f32x4*)(Am + i * 64 + jt * 16 + fq * 4) = (f32x4){v[0], v[1], v[2], v[3]};
        }
    }
    __syncthreads();
    {
        LAS bf16_t* KDT = Ql;
#pragma unroll
        for (int e = 0; e < 16; ++e) KDT[(d0 + e) * 68 + t] = f2bf(qkv[1][e]);
    }
    if (tid < 256) {
        float x[64];
        int lz; asm volatile("v_mov_b32 %0, 0" : "=v"(lz));
        const LAS float* Amz = Am + lz;
#pragma unroll
        for (int i = 0; i < 64; ++i) x[i] = 0.f;
#pragma unroll
        for (int i = 0; i < 64; ++i) {
            float s = RHS[i * 256 + tid];
#pragma unroll
            for (int j4 = 0; j4 < (i + 3) / 4; ++j4) { const f32x4 a4 = *(const LAS f32x4*)(Amz + i * 64 + j4 * 4);
                s -= a4[0] * x[j4 * 4]; s -= a4[1] * x[j4 * 4 + 1]; s -= a4[2] * x[j4 * 4 + 2]; s -= a4[3] * x[j4 * 4 + 3]; }
            x[i] = s; RHS[i * 256 + tid] = s;
        }
    }
    __syncthreads();
    {
        const int seg = tid & 7;
        const LAS float* xr = RHS + t * 256 + seg * 32;
        bf16_t* dst = ((seg < 4) ? GU : GW) + (size_t)(t0 + t) * 512 + hh * 128 + (seg & 3) * 32;
#pragma unroll
        for (int q = 0; q < 4; ++q) { const f32x4 a = *(const LAS f32x4*)(xr + q * 8), b = *(const LAS f32x4*)(xr + q * 8 + 4);
            u32x4 w; w.x = cvt_pk_bf16(a[0], a[1]); w.y = cvt_pk_bf16(a[2], a[3]); w.z = cvt_pk_bf16(b[0], b[1]); w.w = cvt_pk_bf16(b[2], b[3]); *(u32x4*)(dst + q * 8) = w; }
        const LAS bf16_t* kr = Ql + (2 * t + (seg >> 2)) * 68 + (seg & 3) * 16;
        const u32x2 k0 = *(const LAS u32x2*)kr, k1 = *(const LAS u32x2*)(kr + 4), k2 = *(const LAS u32x2*)(kr + 8), k3 = *(const LAS u32x2*)(kr + 12);
        bf16_t* kdst = GK + (size_t)(t0 + t) * 512 + hh * 128 + seg * 16;
        *(u32x4*)kdst = (u32x4){k0.x, k0.y, k1.x, k1.y}; *(u32x4*)(kdst + 8) = (u32x4){k2.x, k2.y, k3.x, k3.y};
    }
    __syncthreads();
}

__device__ __forceinline__ void gdn_scan(LAS unsigned char* lds, const unsigned char* ws, float* oraw, const float* edec, int chain) {
    const int tid = ltid(), wid = __builtin_amdgcn_readfirstlane(tid >> 6), lane = tid & 63, fr = lane & 15, fq = lane >> 4;
    const int bl = chain >> 5, hh = (chain >> 3) & 3, es = chain & 7, e0 = es * 16;
    constexpr int BUF = 64512, O_W = 0, O_Q = 17408, O_KT = 34816, O_AT = 53248, O_U = 62464, O_PS = 2 * BUF, O_PV = 2 * BUF + 4096;
    const unsigned rb = (unsigned)(bl * 64) * 64u;
    const bool stager = (wid >= 2);
    int soff[10], doff[10];
    {
        const int sid = tid - 128;
#pragma unroll
        for (int s = 0; s < 10; ++s) {
            int idx = sid + 384 * s; if (idx >= 3712) idx -= 128;
            if (!stager) { soff[s] = 0; doff[s] = 0; }
            else if (idx < 1024) { const int row = idx >> 4, pc = idx & 15; soff[s] = (int)(WS_GDW + ((size_t)(rb + row) * 512 + hh * 128 + pc * 8) * 2); doff[s] = O_W + (row * 136 + pc * 8) * 2; }
            else if (idx < 2048) { const int i2 = idx - 1024, row = i2 >> 4, pc = i2 & 15; soff[s] = (int)(WS_GDQ + ((size_t)(rb + row) * 512 + hh * 128 + pc * 8) * 2); doff[s] = O_Q + (row * 136 + pc * 8) * 2; }
            else if (idx < 3072) { const int i2 = idx - 2048, row = i2 >> 4, pc = i2 & 15; soff[s] = (int)(WS_GDK + ((size_t)(rb + row) * 512 + hh * 128 + pc * 8) * 2); doff[s] = O_KT + ((2 * row + (pc >> 3)) * 72 + (pc & 7) * 8) * 2; }
            else if (idx < 3584) { const int i2 = idx - 3072, row = i2 >> 3, pc = i2 & 7; soff[s] = (int)(WS_GDA + ((size_t)(rb + row) * 256 + hh * 64 + pc * 8) * 2); doff[s] = O_AT + (row * 72 + pc * 8) * 2; }
            else { const int i2 = idx - 3584, row = i2 >> 1, pc = i2 & 1; soff[s] = (int)(WS_GDU + ((size_t)(rb + row) * 512 + hh * 128 + e0 + pc * 8) * 2); doff[s] = O_U + (row * 16 + pc * 8) * 2; }
        }
    }
    const unsigned step9 = (tid - 128 < 128) ? 32768u : 65536u;
#define SSTEP(s) ((s) < 8 ? 65536u : ((s) == 8 ? 32768u : step9))
    u32x4 stg[10];
    if (stager) {
#pragma unroll
        for (int s = 0; s < 10; ++s) stg[s] = *(const u32x4*)(ws + (unsigned)soff[s]);
#pragma unroll
        for (int s = 0; s < 10; ++s) *(LAS u32x4*)(lds + doff[s]) = stg[s];
#pragma unroll
        for (int s = 0; s < 10; ++s) stg[s] = *(const u32x4*)(ws + (unsigned)soff[s] + SSTEP(s));
    }
    if (wid == 1) {
#pragma unroll
        for (int kt = 0; kt < 4; ++kt) *(LAS u32x4*)(lds + O_PS + kt * 1024 + lane * 16) = (u32x4){0u, 0u, 0u, 0u};
    }
    const float dv = edec[bl * 256 + lane * 4 + hh];
    f32x4 Sacc[8];
#pragma unroll
    for (int d = 0; d < 8; ++d) Sacc[d] = (f32x4){0.f, 0.f, 0.f, 0.f};
    __syncthreads();
    for (int n = 0; n < 64; ++n) {
        const LAS unsigned char* B = lds + (n & 1) * BUF;
        const int t0 = (bl * 64 + n) * 64;
        f32x4 OS[4];
        bf16x8 vb[2];
        if (wid == 0) {
            f32x4 WS[4];
            bf16x8 sb[4];
#pragma unroll
            for (int kt = 0; kt < 4; ++kt) { u32x4 w; w.x = cvt_pk_bf16(Sacc[2 * kt][0], Sacc[2 * kt][1]); w.y = cvt_pk_bf16(Sacc[2 * kt][2], Sacc[2 * kt][3]);
                w.z = cvt_pk_bf16(Sacc[2 * kt + 1][0], Sacc[2 * kt + 1][1]); w.w = cvt_pk_bf16(Sacc[2 * kt + 1][2], Sacc[2 * kt + 1][3]); sb[kt] = __builtin_bit_cast(bf16x8, w); }
#pragma unroll
            for (int m = 0; m < 4; ++m) WS[m] = (f32x4){0.f, 0.f, 0.f, 0.f};
#pragma unroll
            for (int kt = 0; kt < 4; ++kt)
#pragma unroll
                for (int m = 0; m < 4; ++m) { const LAS unsigned char* wp = B + O_W + ((m * 16 + fr) * 136 + kt * 32 + fq * 4) * 2;
                    u32x4 wa; { const u32x2 lo = *(const LAS u32x2*)wp, hi = *(const LAS u32x2*)(wp + 32); wa.x = lo.x; wa.y = lo.y; wa.z = hi.x; wa.w = hi.y; }
                    WS[m] = __builtin_amdgcn_mfma_f32_16x16x32_bf16(__builtin_bit_cast(bf16x8, wa), sb[kt], WS[m], 0, 0, 0); }
#pragma unroll
            for (int m = 0; m < 4; ++m)
#pragma unroll
                for (int jj = 0; jj < 4; ++jj) WS[m][jj] = bf2f(*(const LAS bf16_t*)(B + O_U + ((m * 16 + fq * 4 + jj) * 16 + fr) * 2)) - WS[m][jj];
#pragma unroll
            for (int kc = 0; kc < 2; ++kc) { u32x4 w; w.x = cvt_pk_bf16(WS[2 * kc][0], WS[2 * kc][1]); w.y = cvt_pk_bf16(WS[2 * kc][2], WS[2 * kc][3]);
                w.z = cvt_pk_bf16(WS[2 * kc + 1][0], WS[2 * kc + 1][1]); w.w = cvt_pk_bf16(WS[2 * kc + 1][2], WS[2 * kc + 1][3]); vb[kc] = __builtin_bit_cast(bf16x8, w);
                *(LAS u32x4*)(lds + O_PV + kc * 1024 + lane * 16) = w; }
        } else if (wid == 1) {
#pragma unroll
            for (int m = 0; m < 4; ++m) OS[m] = (f32x4){0.f, 0.f, 0.f, 0.f};
#pragma unroll
            for (int kt = 0; kt < 4; ++kt) {
                const bf16x8 sbr = *(const LAS bf16x8*)(lds + O_PS + kt * 1024 + lane * 16);
#pragma unroll
                for (int m = 0; m < 4; ++m) { const LAS unsigned char* qp = B + O_Q + ((m * 16 + fr) * 136 + kt * 32 + fq * 4) * 2;
                    u32x4 qa; { const u32x2 lo = *(const LAS u32x2*)qp, hi = *(const LAS u32x2*)(qp + 32); qa.x = lo.x; qa.y = lo.y; qa.z = hi.x; qa.w = hi.y; }
                    OS[m] = __builtin_amdgcn_mfma_f32_16x16x32_bf16(__builtin_bit_cast(bf16x8, qa), sbr, OS[m], 0, 0, 0); }
            }
        }
        __syncthreads();
        if (wid == 0) {
            const float dec = __shfl(dv, n);
#pragma unroll
            for (int d = 0; d < 8; ++d) Sacc[d] *= dec;
#pragma unroll
            for (int kc = 0; kc < 2; ++kc)
#pragma unroll
                for (int d = 0; d < 8; ++d) { const LAS unsigned char* kp = B + O_KT + ((d * 16 + fr) * 72 + kc * 32 + fq * 4) * 2;
                    u32x4 a; { const u32x2 lo = *(const LAS u32x2*)kp, hi = *(const LAS u32x2*)(kp + 32); a.x = lo.x; a.y = lo.y; a.z = hi.x; a.w = hi.y; }
                    Sacc[d] = __builtin_amdgcn_mfma_f32_16x16x32_bf16(__builtin_bit_cast(bf16x8, a), vb[kc], Sacc[d], 0, 0, 0); }
#pragma unroll
            for (int kt = 0; kt < 4; ++kt) { u32x4 w; w.x = cvt_pk_bf16(Sacc[2 * kt][0], Sacc[2 * kt][1]); w.y = cvt_pk_bf16(Sacc[2 * kt][2], Sacc[2 * kt][3]);
                w.z = cvt_pk_bf16(Sacc[2 * kt + 1][0], Sacc[2 * kt + 1][1]); w.w = cvt_pk_bf16(Sacc[2 * kt + 1][2], Sacc[2 * kt + 1][3]);
                *(LAS u32x4*)(lds + O_PS + kt * 1024 + lane * 16) = w; }
        } else if (wid == 1) {
#pragma unroll
            for (int kc = 0; kc < 2; ++kc) {
                const bf16x8 vbr = *(const LAS bf16x8*)(lds + O_PV + kc * 1024 + lane * 16);
#pragma unroll
                for (int m = 0; m < 4; ++m) { const LAS unsigned char* ap = B + O_AT + ((m * 16 + fr) * 72 + kc * 32 + fq * 4) * 2;
                    u32x4 a; { const u32x2 lo = *(const LAS u32x2*)ap, hi = *(const LAS u32x2*)(ap + 32); a.x = lo.x; a.y = lo.y; a.z = hi.x; a.w = hi.y; }
                    OS[m] = __builtin_amdgcn_mfma_f32_16x16x32_bf16(__builtin_bit_cast(bf16x8, a), vbr, OS[m], 0, 0, 0); }
            }
            float* op = oraw + (size_t)(t0 + fq * 4) * 512 + hh * 128 + e0 + fr;
#pragma unroll
            for (int m = 0; m < 4; ++m)
#pragma unroll
                for (int jj = 0; jj < 4; ++jj) op[(size_t)(m * 16 + jj) * 512] = OS[m][jj];
        } else if (stager) {
            if (n + 1 < 64) { LAS unsigned char* Bn = lds + ((n + 1) & 1) * BUF;
#pragma unroll
                for (int s = 0; s < 10; ++s) *(LAS u32x4*)(Bn + doff[s]) = stg[s]; }
            if (n + 2 < 64) {
#pragma unroll
                for (int s = 0; s < 10; ++s) stg[s] = *(const u32x4*)(ws + (unsigned)soff[s] + (unsigned)(n + 2) * SSTEP(s)); }
        }
        __syncthreads();
    }
}
__device__ __forceinline__ void gdn_out(const Params& p, int l, const float* oraw, const bf16_t* proj, bf16_t* yc) {
    const int tid = ltid(), sub = tid & 15;
    const float* ng = p.in[zz() + 21] + l * 128 + sub * 8;
    const f32x4 g0 = *(const f32x4*)ng, g1 = *(const f32x4*)(ng + 4);
    for (int rowi = lbid() * 32 + (tid >> 4); rowi < TS * 4; rowi += lgdim() * 32) {
        const int t = rowi >> 2, hh = rowi & 3;
        const float* op = oraw + (size_t)t * 512 + hh * 128 + sub * 8;
        const f32x4 o0 = *(const f32x4*)op, o1 = *(const f32x4*)(op + 4);
        float ss = (o0[0] * o0[0] + o0[1] * o0[1]) + (o0[2] * o0[2] + o0[3] * o0[3]) + (o1[0] * o1[0] + o1[1] * o1[1]) + (o1[2] * o1[2] + o1[3] * o1[3]);
        ss += __shfl_xor(ss, 1); ss += __shfl_xor(ss, 2); ss += __shfl_xor(ss, 4); ss += __shfl_xor(ss, 8);
        const float rs = rsqrtf(ss * (1.0f / 128.0f) + EPS);
        const u32x4 z = *(const u32x4*)(proj + (size_t)t * PW + PC_CZ + hh * 128 + sub * 8);
        u32x4 w;
        w.x = cvt_pk_bf16(o0[0] * rs * g0[0] * siluf_(lo_bf(z.x)), o0[1] * rs * g0[1] * siluf_(hi_bf(z.x)));
        w.y = cvt_pk_bf16(o0[2] * rs * g0[2] * siluf_(lo_bf(z.y)), o0[3] * rs * g0[3] * siluf_(hi_bf(z.y)));
        w.z = cvt_pk_bf16(o1[0] * rs * g1[0] * siluf_(lo_bf(z.z)), o1[1] * rs * g1[1] * siluf_(hi_bf(z.z)));
        w.w = cvt_pk_bf16(o1[2] * rs * g1[2] * siluf_(lo_bf(z.w)), o1[3] * rs * g1[3] * siluf_(hi_bf(z.w)));
        *(u32x4*)(yc + (size_t)t * 512 + hh * 128 + sub * 8) = w;
    }
}

constexpr int PH_PER_LAYER = 22, N_PHASES = 2 * PH_PER_LAYER + 1;

__device__ __forceinline__ void run_phase(LAS unsigned char* lds, const Params& p, int ph) {
    unsigned char* ws = lptr(p.ws);
    bf16_t* hbuf = (bf16_t*)(ws + WS_H);
    bf16_t* act = (bf16_t*)(ws + WS_PROJ);
    bf16_t* proj = (bf16_t*)(ws + WS_PROJ);
    bf16_t* hslab = hbuf;
    bf16_t* merged = hbuf + (size_t)TS * D;
    float* oraw = (float*)(ws + WS_H);
    bf16_t* ys = (bf16_t*)(ws + WS_YS);
    float* AB = (float*)(ws + WS_AB);
    bf16_t* halo = (bf16_t*)(ws + WS_HALO);
    float* Aend = (float*)(ws + WS_AEND); float* Hend = (float*)(ws + WS_HEND); float* carry = (float*)(ws + WS_CARRY); float* edec = (float*)(ws + WS_EDEC);
    const bf16_t* waxt = (const bf16_t*)(ws + WS_WAXT); const bf16_t* pwt = (const bf16_t*)(ws + WS_PWT);
    const int G = lgdim(), c = lbid();
    if (ph == N_PHASES - 1) { PHON(0) rms_rows_f32_inplace(lptr(p.out), p.in[zz() + 30], T); return; }
    const int l = ph / PH_PER_LAYER, r = ph % PH_PER_LAYER;
    const float* xcur = (l == 0) ? p.in[zz() + 0] : lptr(p.out);
    if (r == 0) { PHON(1) convert_layer(lds, p, l); PHON(0) rms_rows_bf16(xcur, p.in[zz() + 1] + l * D, hbuf, T); return; }
    if (r == 1 || r == 20) { PHON(2) ph_gemm_swiglu(lds, hbuf, (const bf16_t*)(ws + (r == 1 ? WS_WGU1 : WS_WGU2)), act); return; }
    if (r == 2 || r == 21) { PHON(3) ph_gemm_resid(lds, act, (const bf16_t*)(ws + (r == 2 ? WS_WD1 : WS_WD2)), T, DFF, (r == 2) ? xcur : lptr(p.out), lptr(p.out), 0.5f); return; }
    if (r == 19) { rms_rows_bf16(lptr(p.out), p.in[zz() + 26] + l * D, hbuf, T); return; }
    const int slab = (r - 3) >> 3, q = (r - 3) & 7;
    float* xs = lptr(p.out) + (size_t)slab * TS * D;
    switch (q) {
    case 0: rms_rows_bf16(xs, p.in[zz() + 5] + l * D, hslab, TS); break;
    case 1: PHON(4) ph_gemm_proj(lds, hslab, (const bf16_t*)(ws + WS_WIN), proj, AB); break;
    case 2:
        PHON(5) for (int t = c; t < (TS / 128) * 4; t += G) sgu_tile(lds, p, l, proj, ys, t);
        PHON(6) for (int t = c; t < TS / 64; t += G) pool_tile(lds, p, l, proj, ys + (size_t)3 * TS * 512, halo, pwt, t);
        PHON(7) for (int t = c; t < TS / 64; t += G) lru_tile(lds, p, l, proj, nullptr, waxt, Aend, Hend, carry, t, 0);
        break;
    case 3:
        PHON(8) for (int it = c; it < (TS / 64) * 4; it += G) gdn_prep(lds, p, l, proj, AB, (bf16_t*)(ws + WS_GDQ), (bf16_t*)(ws + WS_GDK), (bf16_t*)(ws + WS_GDU), (bf16_t*)(ws + WS_GDW), (bf16_t*)(ws + WS_GDA), edec, it);
        lru_carry(Aend, Hend, carry);
        break;
    case 4:
        PHON(9) if (c < 128 || G < 256) { for (int ch = c; ch < 128; ch += G) gdn_scan(lds, ws, oraw, edec, ch); }
        PHON(10) if (G >= 256) { if (c >= 128) for (int t = c - 128; t < TS / 64; t += G - 128) lru_tile(lds, p, l, proj, ys + (size_t)TS * 512, waxt, Aend, Hend, carry, t, 1); }
        else { for (int t = c; t < TS / 64; t += G) lru_tile(lds, p, l, proj, ys + (size_t)TS * 512, waxt, Aend, Hend, carry, t, 1); }
        break;
    case 5: PHON(11) gdn_out(p, l, oraw, proj, ys + (size_t)2 * TS * 512); break;
    case 6: PHON(12) ph_gemm_branch(lds, ys, (const bf16_t*)(ws + WS_WB), proj, merged); break;
    default: PHON(13) ph_gemm_resid(lds, merged, (const bf16_t*)(ws + WS_WOUT), TS, D, xs, xs, 1.0f); break;
    }
}

extern __shared__ __attribute__((aligned(16))) unsigned char smem_dyn[];

#ifndef DUP_TYPE
#define DUP_TYPE -1
#endif
__device__ __forceinline__ int phase_type(int ph) {
    if (ph == N_PHASES - 1) return 12;
    const int r = ph % PH_PER_LAYER;
    if (r == 0) return 0; if (r == 1 || r == 20) return 1; if (r == 2 || r == 21) return 2; if (r == 19) return 11;
    const int q = (r - 3) & 7;
    return 3 + q;
}
__global__ void __launch_bounds__(NTHR) fwd_megakernel(Params p) {
    cg::grid_group grid = cg::this_grid();
    LAS unsigned char* lds = (LAS unsigned char*)smem_dyn;
    volatile LAS unsigned* st = (volatile LAS unsigned*)(lds + LDS_BYTES - 16);
    if (threadIdx.x == 0) { st[0] = 0u; st[1] = 0u; }
    __syncthreads();
    const XcdBarrier xb = xcd_barrier_post((unsigned*)(p.ws + WS_BAR), st);
    grid.sync();
    for (int ph = p.ph_lo; ph < p.ph_hi; ++ph) {
        if (ph > p.ph_lo) xcd_barrier(xb);
        run_phase(lds, p, ph);
#if DUP_TYPE == 6
        if (phase_type(ph) == 6) { xcd_barrier(xb); run_phase(lds, p, ph - 2); xcd_barrier(xb); run_phase(lds, p, ph - 1); xcd_barrier(xb); run_phase(lds, p, ph); }
#elif DUP_TYPE >= 0
        if (phase_type(ph) == DUP_TYPE) { xcd_barrier(xb); run_phase(lds, p, ph); }
#endif
    }
}

extern "C" void kernel_launch(void* const* d_in, const int* in_sizes, int n_in, void* d_out, int out_size, void* d_ws, size_t ws_size, hipStream_t stream) {
    static int grid_blocks = 0;
    if (grid_blocks == 0) {
        if (n_in != 31 || out_size != T * D || ws_size < WS_END) { fprintf(stderr, "kernel_launch: unexpected shapes (n_in %d out %d ws %zu need %zu)\n", n_in, out_size, ws_size, (size_t)WS_END); grid_blocks = -1; return; }
        int dev = 0, cus = 0, per_cu = 0;
        hipGetDevice(&dev);
        hipDeviceGetAttribute(&cus, hipDeviceAttributeMultiprocessorCount, dev);
        if (hipFuncSetAttribute((const void*)fwd_megakernel, hipFuncAttributeMaxDynamicSharedMemorySize, LDS_BYTES) != hipSuccess) { fprintf(stderr, "kernel_launch: hipFuncSetAttribute failed\n"); grid_blocks = -1; return; }
        hipOccupancyMaxActiveBlocksPerMultiprocessor(&per_cu, (const void*)fwd_megakernel, NTHR, LDS_BYTES);
        if (per_cu < 1) { fprintf(stderr, "kernel_launch: occupancy query returned %d\n", per_cu); per_cu = 1; }
        grid_blocks = cus * per_cu;
    }
    if (grid_blocks < 0) return;
    Params p{};
    for (int i = 0; i < 31; ++i) p.in[i] = (const float*)d_in[i];
    p.out = (float*)d_out; p.ws = (unsigned char*)d_ws;
    hipMemsetAsync((unsigned char*)d_ws + WS_BAR, 0, 16384, stream);
    p.ph_lo = 0; p.ph_hi = N_PHASES;
    void* args[] = {&p};
    hipError_t e = hipLaunchCooperativeKernel((const void*)fwd_megakernel, dim3(grid_blocks), dim3(NTHR), args, LDS_BYTES, stream);
    if (e != hipSuccess) fprintf(stderr, "cooperative launch failed: %s (grid %d)\n", hipGetErrorString(e), grid_blocks);
}
```

```cpp
#include <hip/hip_runtime.h>
#include <hip/hip_cooperative_groups.h>
#include <cstdio>
namespace cg = cooperative_groups;

#ifndef MULTI_LAUNCH
#define MULTI_LAUNCH 0
#endif

#ifndef PH_MASK
#define PH_MASK 0xFFFFF
#endif
#define PHON(k) if constexpr ((PH_MASK >> (k)) & 1)
#define LAS __attribute__((address_space(3)))
typedef unsigned short bf16_t;
typedef short bf16x8 __attribute__((ext_vector_type(8)));
typedef short bf16x4 __attribute__((ext_vector_type(4)));
typedef float f32x4 __attribute__((ext_vector_type(4)));
typedef unsigned u32x4 __attribute__((ext_vector_type(4)));
typedef unsigned u32x2 __attribute__((ext_vector_type(2)));

constexpr int T = 32768, D = 1024, DFF = 2816, NSLAB = 2, TS = T / NSLAB, SEQ = 4096, PW = 8960, PIN = 8712;
constexpr int PC_AU = 0, PC_AV = 512, PC_BX = 1024, PC_BG = 1536, PC_CQ = 2048, PC_CK = 2560, PC_CV = 3072, PC_CZ = 3584, PC_DX = 4096, PC_GATE = 4608, PC_AB = 8704;
constexpr float EPS = 1e-6f;
constexpr int NTHR = 512;
constexpr int LDS_BYTES = 147456;

constexpr size_t WS_WGU1 = 0;
constexpr size_t WS_WD1 = WS_WGU1 + (size_t)5632 * 1024 * 2;
constexpr size_t WS_WIN = WS_WD1 + (size_t)1024 * 2816 * 2;
constexpr size_t WS_WB = WS_WIN + (size_t)PW * 1024 * 2;
constexpr size_t WS_WOUT = WS_WB + (size_t)4 * 1024 * 512 * 2;
constexpr size_t WS_WGU2 = WS_WOUT + (size_t)1024 * 1024 * 2;
constexpr size_t WS_WD2 = WS_WGU2 + (size_t)5632 * 1024 * 2;
constexpr size_t WS_WAXT = WS_WD2 + (size_t)1024 * 2816 * 2;
constexpr size_t WS_PWT = WS_WAXT + 131072;
constexpr size_t WS_PROJ = WS_PWT + 131072;
constexpr size_t WS_H = WS_PROJ + (size_t)TS * PW * 2;
constexpr size_t WS_YS = WS_H + (size_t)T * D * 2;
constexpr size_t WS_AB = WS_YS + (size_t)4 * TS * 512 * 2;
constexpr size_t WS_HALO = WS_AB + (size_t)TS * 8 * 4;
constexpr size_t WS_AEND = WS_HALO + (size_t)(TS / 64) * 3 * 1536 * 2;
constexpr size_t WS_HEND = WS_AEND + (size_t)(TS / 64) * 512 * 4;
constexpr size_t WS_CARRY = WS_HEND + (size_t)(TS / 64) * 512 * 4;
constexpr size_t WS_EDEC = WS_CARRY + (size_t)(TS / 64) * 512 * 4;
constexpr size_t WS_BAR = WS_EDEC + 4096;
constexpr size_t WS_GDQ = WS_H + (size_t)TS * D * 2;
constexpr size_t WS_GDK = WS_GDQ + (size_t)TS * 512 * 2;
constexpr size_t WS_GDU = WS_BAR + 16384;
constexpr size_t WS_GDW = WS_GDU + (size_t)TS * 512 * 2;
constexpr size_t WS_GDA = WS_GDW + (size_t)TS * 512 * 2;
constexpr size_t WS_END = WS_GDA + (size_t)TS * 256 * 2;
static_assert(WS_END <= (size_t)512 * 1024 * 1024, "workspace budget");

struct Params { const float* in[31]; float* out; unsigned char* ws; int ph_lo, ph_hi; };

__device__ __forceinline__ int ltid() { int t = threadIdx.x; asm volatile("" : "+v"(t)); return t; }
__device__ __forceinline__ int lbid() { int t = blockIdx.x; asm volatile("" : "+s"(t)); return t; }
__device__ __forceinline__ int lgdim() { int t = gridDim.x; asm volatile("" : "+s"(t)); return t; }
__device__ __forceinline__ int zz() { int z; asm volatile("s_mov_b32 %0, 0" : "=s"(z)); return z; }
template <class P> __device__ __forceinline__ P* lptr(P* q) { asm volatile("" : "+s"(q)); return q; }
__device__ __forceinline__ float bf2f(unsigned short b) { return __uint_as_float(((unsigned)b) << 16); }
__device__ __forceinline__ unsigned cvt_pk_bf16(float lo, float hi) { unsigned r; asm("v_cvt_pk_bf16_f32 %0, %1, %2" : "=v"(r) : "v"(lo), "v"(hi)); return r; }
__device__ __forceinline__ unsigned short f2bf(float f) { return (unsigned short)(cvt_pk_bf16(f, 0.f) & 0xffffu); }
__device__ __forceinline__ float lo_bf(unsigned w) { return __uint_as_float(w << 16); }
__device__ __forceinline__ float hi_bf(unsigned w) { return __uint_as_float(w & 0xffff0000u); }
__device__ __forceinline__ float sigmoidf_(float x) { return __builtin_amdgcn_rcpf(1.0f + __expf(-x)); }
__device__ __forceinline__ float siluf_(float x) { return x * __builtin_amdgcn_rcpf(1.0f + __expf(-x)); }
__device__ __forceinline__ float geluf_(float x) { const float u = 1.5957691216057308f * (x + 0.044715f * x * x * x); return x * __builtin_amdgcn_rcpf(1.0f + __expf(-u)); }
__device__ __forceinline__ float softplusf_(float x) { return fmaxf(x, 0.f) + log1pf(__expf(-fabsf(x))); }
__device__ __forceinline__ float wave_sum(float v) {
#pragma unroll
    for (int o = 1; o < 64; o <<= 1) v += __shfl_xor(v, o);
    return v;
}


#define XB_TMO      128
#define XB_XCNT(j)  (256  + 64 * (j))
#define XB_XSUB(j)  (1280 + 64 * (j))
#define XB_XGEN(j)  (2304 + 64 * (j))
#define XB_TOP      3328
#define XB_TOPGEN   3392
#define XCD_BAR_WORDS 3456
#define XB_SPIN_CAP (1u << 22)
__device__ __forceinline__ unsigned xb_ld(unsigned* p)              { return __hip_atomic_load(p, __ATOMIC_RELAXED, __HIP_MEMORY_SCOPE_AGENT); }
__device__ __forceinline__ unsigned xb_add(unsigned* p, unsigned v) { return __hip_atomic_fetch_add(p, v, __ATOMIC_RELAXED, __HIP_MEMORY_SCOPE_AGENT); }
__device__ __forceinline__ unsigned xb_xcc_id() { return (unsigned)__builtin_amdgcn_s_getreg((3 << 11) | 20) & 0xFu; }
#define XB_SPIN(cond, bar) do { unsigned _sp = 0; while (cond) { __builtin_amdgcn_s_sleep(1); \
    if ((++_sp & 255u) == 0u) { if (xb_ld(&(bar)[XB_TMO])) break; if (_sp > XB_SPIN_CAP) { atomicAdd(&(bar)[XB_TMO], 1u); break; } } } } while (0)
struct XcdBarrier { unsigned* bar; unsigned x; volatile LAS unsigned* st; };
__device__ __forceinline__ XcdBarrier xcd_barrier_post(unsigned* bar, volatile LAS unsigned* st) {
    XcdBarrier b; b.bar = bar; b.x = xb_xcc_id(); b.st = st;
    if (threadIdx.x == 0) (void)xb_add(&bar[XB_XCNT(b.x)], 1u);
    return b;
}
__device__ __forceinline__ void xcd_barrier_complete(unsigned* bar, unsigned x, unsigned& nloc, unsigned& nx) {
    const unsigned G = gridDim.x * gridDim.y * gridDim.z;
    unsigned sum, cnt, mine, sp = 0u;
    for (;;) {
        sum = 0u; cnt = 0u; mine = 0u;
#pragma unroll
        for (unsigned j = 0; j < 16; ++j) { const unsigned c = xb_ld(&bar[XB_XCNT(j)]); sum += c; cnt += (c > 0u) ? 1u : 0u; mine = (j == x) ? c : mine; }
        if (sum == G) break;
        __builtin_amdgcn_s_sleep(1);
        if ((++sp & 255u) == 0u) { if (xb_ld(&bar[XB_TMO])) break; if (sp > XB_SPIN_CAP) { atomicAdd(&bar[XB_TMO], 1u); break; } }
    }
    nloc = mine > 0u ? mine : 1u; nx = cnt > 0u ? cnt : 1u;
}
__device__ __forceinline__ void xcd_barrier(const XcdBarrier& b) {
    asm volatile("s_waitcnt vmcnt(0)" ::: "memory");
    __syncthreads();
    if (threadIdx.x == 0) {
        unsigned* bar = b.bar;
        __builtin_amdgcn_s_waitcnt(0);
        unsigned nloc = b.st[0], nx = b.st[1];
        if (nloc == 0u) { xcd_barrier_complete(bar, b.x, nloc, nx); b.st[0] = nloc; b.st[1] = nx; }
        const unsigned old = xb_add(&bar[XB_XSUB(b.x)], 1u);
        const unsigned gen = old / nloc;
        if (old + 1u == (gen + 1u) * nloc) {
            __builtin_amdgcn_fence(__ATOMIC_RELEASE, "agent");
            asm volatile("s_waitcnt vmcnt(0)" ::: "memory");
            const unsigned og = xb_add(&bar[XB_TOP], 1u);
            const unsigned tg = og / nx;
            if (og + 1u == (tg + 1u) * nx) xb_add(&bar[XB_TOPGEN], 1u);
            else XB_SPIN(xb_ld(&bar[XB_TOPGEN]) == tg, bar);
            __builtin_amdgcn_fence(__ATOMIC_ACQUIRE, "agent");
            xb_add(&bar[XB_XGEN(b.x)], 1u);
            asm volatile("s_waitcnt vmcnt(0)" ::: "memory");
        } else {
            XB_SPIN(xb_ld(&bar[XB_XGEN(b.x)]) == gen, bar);
            __builtin_amdgcn_fence(__ATOMIC_ACQUIRE, "agent");
            asm volatile("s_waitcnt vmcnt(0)" ::: "memory");
        }
    }
    __syncthreads();
}

namespace pg8 {
constexpr int BM = 256, BK = 64, HALF = 128, HTB = HALF * BK * 2, STAGE_BYTES = 8 * HTB, NXCD = 8, WGM = 8;
__host__ __device__ __forceinline__ int lds_byte(int r, int c) { const int st = (r >> 4) * 2 + (c >> 5), rr = r & 15, cc = c & 31, ob = rr * 64 + cc * 2; return st * 1024 + (ob ^ (((ob >> 9) & 1) << 5)); }
__host__ __device__ __forceinline__ void stage_rc(int b, int& R, int& C) { const int st = b / 1024, sb = b % 1024, swz = sb ^ (((sb >> 9) & 1) << 5); R = (st >> 1) * 16 + swz / 64; C = (st & 1) * 32 + (swz % 64) / 2; }
__host__ __device__ __forceinline__ int perm32(int rho) { const int n = rho >> 4, i = rho & 15; return 8 * (i >> 2) + 4 * n + (i & 3); }

struct Unit { int pm, pn, g; };
struct Gemm { const bf16_t* A; const bf16_t* Bt; int M, N, K; size_t gsA, gsB; };

__device__ __forceinline__ void tile_of(int wgid, int nM, int nN, int nwg, Unit& u) {
    { const int q = nwg / NXCD, r = nwg % NXCD, xcd = wgid % NXCD, off = wgid / NXCD; wgid = (xcd < r ? xcd * (q + 1) : r * (q + 1) + (xcd - r) * q) + off; }
    const int nig = WGM * nN, gid = wgid / nig, fm = gid * WGM, gsz = (nM - fm) < WGM ? (nM - fm) : WGM;
    u.pm = fm + ((wgid % nig) % gsz); u.pn = (wgid % nig) / gsz;
}
struct StaticOrder {
    int nM, nN, nwg, G, c;
    __device__ void init(int M, int N, int G_, int c_) { nM = M / BM; nN = N / BM; nwg = nM * nN; G = G_; c = c_; }
    __device__ bool next(int i, Unit& u) const {
        const long L = (long)i * G + c; if (L >= nwg) return false;
        tile_of((int)L, nM, nN, nwg, u); u.g = 0; return true;
    }
};
struct BranchOrder {
    int nM, nN, nwg, G, c;
    __device__ void init(int M, int N, int G_, int c_) { nM = M / BM; nN = N / BM; nwg = nM * nN; G = G_; c = c_; }
    __device__ bool next(int i, Unit& u) const {
        const long L = (long)(i >> 2) * G + c; if (L >= nwg) return false;
        tile_of((int)L, nM, nN, nwg, u); u.g = i & 3; return true;
    }
};

struct EpiSwiGLU {
    static constexpr bool PERM = true;
    bf16_t* O;
    __device__ __forceinline__ bool keep(const Unit&) const { return false; }
    __device__ __forceinline__ void operator()(f32x4 (&acc)[2][2][4][2], const Unit& u, int wr, int wc, int fr, int fq) const {
        const int row0 = u.pm * BM + wr * 64 + fr, col0 = u.pn * 128 + wc * 32 + 8 * fq;
#pragma unroll
        for (int ai = 0; ai < 2; ++ai)
#pragma unroll
            for (int m = 0; m < 4; ++m) {
                bf16_t* rowp = O + (size_t)(row0 + ai * HALF + m * 16) * DFF + col0;
                float v[8];
#pragma unroll
                for (int n = 0; n < 2; ++n)
#pragma unroll
                    for (int j = 0; j < 4; ++j) v[n * 4 + j] = siluf_(acc[ai][0][m][n][j]) * acc[ai][1][m][n][j];
                u32x4 w; w.x = cvt_pk_bf16(v[0], v[1]); w.y = cvt_pk_bf16(v[2], v[3]); w.z = cvt_pk_bf16(v[4], v[5]); w.w = cvt_pk_bf16(v[6], v[7]);
                *(u32x4*)rowp = w;
                __builtin_amdgcn_sched_barrier(0);
            }
    }
};
struct EpiResid {
    static constexpr bool PERM = false;
    const float* Xin; float* Xout; float scale;
    __device__ __forceinline__ bool keep(const Unit&) const { return false; }
    __device__ __forceinline__ void operator()(f32x4 (&acc)[2][2][4][2], const Unit& u, int wr, int wc, int fr, int fq) const {
        const int row0 = u.pm * BM + wr * 64 + fr, col0 = u.pn * BM + wc * 32 + 4 * fq;
#pragma unroll
        for (int ai = 0; ai < 2; ++ai)
#pragma unroll
            for (int m = 0; m < 4; ++m) {
                const size_t ro = (size_t)(row0 + ai * HALF + m * 16) * D + col0;
#pragma unroll
                for (int bj = 0; bj < 2; ++bj)
#pragma unroll
                    for (int n = 0; n < 2; ++n) { const f32x4 xi = *(const f32x4*)(Xin + ro + bj * HALF + n * 16); *(f32x4*)(Xout + ro + bj * HALF + n * 16) = xi + acc[ai][bj][m][n] * scale; }
                __builtin_amdgcn_sched_barrier(0);
            }
    }
};
struct EpiProj {
    static constexpr bool PERM = true;
    bf16_t* O; float* AB;
    __device__ __forceinline__ bool keep(const Unit&) const { return false; }
    __device__ __forceinline__ void operator()(f32x4 (&acc)[2][2][4][2], const Unit& u, int wr, int wc, int fr, int fq) const {
        const int row0 = u.pm * BM + wr * 64 + fr, col0 = u.pn * BM + wc * 32 + 8 * fq;
        const bool ab = (u.pn == PC_AB / BM) && wc == 0 && fq == 0;
#pragma unroll
        for (int ai = 0; ai < 2; ++ai)
#pragma unroll
            for (int m = 0; m < 4; ++m) {
                const int row = row0 + ai * HALF + m * 16;
                bf16_t* rowp = O + (size_t)row * PW + col0;
#pragma unroll
                for (int bj = 0; bj < 2; ++bj) {
                    const f32x4 v0 = acc[ai][bj][m][0], v1 = acc[ai][bj][m][1];
                    u32x4 w; w.x = cvt_pk_bf16(v0[0], v0[1]); w.y = cvt_pk_bf16(v0[2], v0[3]); w.z = cvt_pk_bf16(v1[0], v1[1]); w.w = cvt_pk_bf16(v1[2], v1[3]);
                    *(u32x4*)(rowp + bj * HALF) = w;
                }
                __builtin_amdgcn_sched_barrier(0);
            }
        if (ab) {
#pragma unroll
            for (int ai = 0; ai < 2; ++ai)
#pragma unroll
                for (int m = 0; m < 4; ++m) { const int row = row0 + ai * HALF + m * 16; *(f32x4*)(AB + (size_t)row * 8) = acc[ai][0][m][0]; *(f32x4*)(AB + (size_t)row * 8 + 4) = acc[ai][0][m][1]; }
        }
    }
};
struct EpiBranch {
    static constexpr bool PERM = true;
    const bf16_t* P; bf16_t* O;
    __device__ __forceinline__ bool keep(const Unit& u) const { return u.g < 3; }
    __device__ __forceinline__ void operator()(f32x4 (&acc)[2][2][4][2], const Unit& u, int wr, int wc, int fr, int fq) const {
        const int row0 = u.pm * BM + wr * 64 + fr, col0 = u.pn * BM + wc * 32 + 8 * fq;
        const bool last = (u.g == 3);
#pragma unroll
        for (int ai = 0; ai < 2; ++ai)
#pragma unroll
            for (int m = 0; m < 4; ++m) {
                const int row = row0 + ai * HALF + m * 16;
                const bf16_t* gp = P + (size_t)row * PW + PC_GATE + u.g * D + col0;
#pragma unroll
                for (int bj = 0; bj < 2; ++bj) {
                    const u32x4 g0 = *(const u32x4*)(gp + bj * HALF);
                    float f[8];
                    if (!last) {
                        const u32x4 g1 = *(const u32x4*)(gp + D + bj * HALF);
#pragma unroll
                        for (int q = 0; q < 4; ++q) {
                            f[2 * q] = (1.0f + __expf(-lo_bf(g1[q]))) * __builtin_amdgcn_rcpf(1.0f + __expf(-lo_bf(g0[q])));
                            f[2 * q + 1] = (1.0f + __expf(-hi_bf(g1[q]))) * __builtin_amdgcn_rcpf(1.0f + __expf(-hi_bf(g0[q])));
                        }
                    } else {
#pragma unroll
                        for (int q = 0; q < 4; ++q) { f[2 * q] = __builtin_amdgcn_rcpf(1.0f + __expf(-lo_bf(g0[q]))); f[2 * q + 1] = __builtin_amdgcn_rcpf(1.0f + __expf(-hi_bf(g0[q]))); }
                    }
#pragma unroll
                    for (int n = 0; n < 2; ++n)
#pragma unroll
                        for (int j = 0; j < 4; ++j) acc[ai][bj][m][n][j] *= f[n * 4 + j];
                    if (last) {
                        const f32x4 v0 = acc[ai][bj][m][0], v1 = acc[ai][bj][m][1];
                        u32x4 w; w.x = cvt_pk_bf16(v0[0], v0[1]); w.y = cvt_pk_bf16(v0[2], v0[3]); w.z = cvt_pk_bf16(v1[0], v1[1]); w.w = cvt_pk_bf16(v1[2], v1[3]);
                        *(u32x4*)(O + (size_t)row * D + col0 + bj * HALF) = w;
                    }
                    __builtin_amdgcn_sched_barrier(0);
                }
            }
    }
};

template <class Epi, class Sched>
__device__ __forceinline__ void gemm_phase(LAS unsigned char* lds, const Gemm g, const Sched& S, const Epi& E) {
    const int tid = ltid(), wid = __builtin_amdgcn_readfirstlane(tid >> 6), lane = tid & 63, wr = wid >> 2, wc = wid & 3, fr = lane & 15, fq = lane >> 4;
    const int K = g.K, nt = K / BK;
    unsigned voffA[2], voffB[2];
#pragma unroll
    for (int i = 0; i < 2; ++i) { int R, C; stage_rc(tid * 16 + i * 8192, R, C); const int Rb = Epi::PERM ? ((R & ~31) + perm32(R & 31)) : R;
        voffA[i] = (unsigned)(R * K + C) * 2u; voffB[i] = (unsigned)(Rb * K + C) * 2u; }
    const size_t kstep = (size_t)(BK * 2);
    const size_t hstep = (size_t)HALF * K * 2;
    const size_t tstep = 2 * hstep;
    const unsigned ldsw = (unsigned)wid * 1024u;
    const int aoff = lds_byte(wr * 64 + fr, fq * 8), boff = lds_byte(wc * 32 + fr, fq * 8);
#define PG8_SA(b, h) (((b) * 2 + (h)) * HTB)
#define PG8_SB(b, h) ((4 + (b) * 2 + (h)) * HTB)
#define PG8_STAGE(bufoff, gbase, voff) do { _Pragma("unroll") for (int _i = 0; _i < 2; ++_i) \
        __builtin_amdgcn_global_load_lds((const unsigned*)((const char*)(gbase) + (voff)[_i]), (LAS unsigned*)(lds + (bufoff) + ldsw + _i * 8192), 16, 0, 0); } while (0)
#define PG8_LDA(dst, b, h) do { _Pragma("unroll") for (int m = 0; m < 4; ++m) _Pragma("unroll") for (int k = 0; k < 2; ++k) dst[m][k] = *(const LAS bf16x8*)(lds + PG8_SA(b, h) + aoff + m * 2048 + k * 1024); } while (0)
#define PG8_LDB(dst, b, h) do { _Pragma("unroll") for (int n = 0; n < 2; ++n) _Pragma("unroll") for (int k = 0; k < 2; ++k) dst[n][k] = *(const LAS bf16x8*)(lds + PG8_SB(b, h) + boff + n * 2048 + k * 1024); } while (0)
#define PG8_MMA(ai, bj, At, Bt) do { __builtin_amdgcn_s_setprio(1); _Pragma("unroll") for (int m = 0; m < 4; ++m) _Pragma("unroll") for (int n = 0; n < 2; ++n) _Pragma("unroll") for (int k = 0; k < 2; ++k) \
        acc[ai][bj][m][n] = __builtin_amdgcn_mfma_f32_16x16x32_bf16(Bt[n][k], At[m][k], acc[ai][bj][m][n], 0, 0, 0); __builtin_amdgcn_s_setprio(0); } while (0)
#define PG8_WAIT_V(n) asm volatile("s_waitcnt vmcnt(" #n ")" ::: "memory")
#define PG8_WAIT_L(n) asm volatile("s_waitcnt lgkmcnt(" #n ")" ::: "memory")
#define PG8_BAR __builtin_amdgcn_s_barrier()
#define PG8_SCHED __builtin_amdgcn_sched_barrier(0)
    Unit cur, nxt; int ui = 0;
    if (!S.next(0, cur)) return;
    f32x4 acc[2][2][4][2];
#pragma unroll
    for (int a = 0; a < 2; ++a)
#pragma unroll
        for (int b = 0; b < 2; ++b)
#pragma unroll
            for (int m = 0; m < 4; ++m)
#pragma unroll
                for (int n = 0; n < 2; ++n) acc[a][b][m][n] = (f32x4){0.f, 0.f, 0.f, 0.f};
    bf16x8 At[4][2], B0[2][2], B1[2][2];
    const char* cA = (const char*)g.A + (size_t)cur.g * g.gsA + (size_t)cur.pm * tstep; const char* cB = (const char*)g.Bt + (size_t)cur.g * g.gsB + (size_t)cur.pn * tstep;
    PG8_STAGE(PG8_SB(0, 0), cB, voffB); PG8_STAGE(PG8_SA(0, 0), cA, voffA); PG8_STAGE(PG8_SB(0, 1), cB + hstep, voffB); PG8_STAGE(PG8_SA(0, 1), cA + hstep, voffA);
    if (wr == 1) PG8_BAR;
    PG8_WAIT_V(4); PG8_BAR;
    PG8_STAGE(PG8_SB(1, 0), cB + kstep, voffB); PG8_STAGE(PG8_SA(1, 0), cA + kstep, voffA); PG8_STAGE(PG8_SB(1, 1), cB + hstep + kstep, voffB);
    PG8_WAIT_V(6); PG8_BAR;
    for (;;) {
        const bool has_next = S.next(ui + 1, nxt);
        const char* nA = has_next ? (const char*)g.A + (size_t)nxt.g * g.gsA + (size_t)nxt.pm * tstep : cA; const char* nB = has_next ? (const char*)g.Bt + (size_t)nxt.g * g.gsB + (size_t)nxt.pn * tstep : cB;
        for (int t = 0; t < nt; t += 2) {
            const bool last = (t == nt - 2);
            const char* a1 = cA + (size_t)(t + 1) * kstep;
            const char* a2 = last ? nA : cA + (size_t)(t + 2) * kstep; const char* b2 = last ? nB : cB + (size_t)(t + 2) * kstep;
            const char* a3 = a2 + kstep; const char* b3 = b2 + kstep;
            PG8_LDB(B0, 0, 0); PG8_SCHED; PG8_LDA(At, 0, 0); PG8_STAGE(PG8_SA(1, 1), a1 + hstep, voffA);
            PG8_WAIT_L(8); PG8_BAR; PG8_WAIT_L(0); PG8_MMA(0, 0, At, B0); PG8_BAR; PG8_SCHED;
            PG8_LDB(B1, 0, 1); PG8_STAGE(PG8_SB(0, 0), b2, voffB);
            PG8_BAR; PG8_WAIT_L(0); PG8_MMA(0, 1, At, B1); PG8_BAR;
            PG8_LDA(At, 0, 1); PG8_STAGE(PG8_SA(0, 0), a2, voffA);
            PG8_BAR; PG8_WAIT_L(0); PG8_MMA(1, 0, At, B0); PG8_BAR; PG8_SCHED;
            PG8_STAGE(PG8_SB(0, 1), b2 + hstep, voffB);
            PG8_WAIT_V(6); PG8_BAR; PG8_MMA(1, 1, At, B1); PG8_BAR;
            PG8_LDB(B0, 1, 0); PG8_SCHED; PG8_LDA(At, 1, 0); PG8_STAGE(PG8_SA(0, 1), a2 + hstep, voffA);
            PG8_WAIT_L(8); PG8_BAR; PG8_WAIT_L(0); PG8_MMA(0, 0, At, B0); PG8_BAR; PG8_SCHED;
            PG8_LDB(B1, 1, 1); PG8_STAGE(PG8_SB(1, 0), b3, voffB);
            PG8_BAR; PG8_WAIT_L(0); PG8_MMA(0, 1, At, B1); PG8_BAR;
            PG8_LDA(At, 1, 1); PG8_STAGE(PG8_SA(1, 0), a3, voffA);
            PG8_BAR; PG8_WAIT_L(0); PG8_MMA(1, 0, At, B0); PG8_BAR; PG8_SCHED;
            PG8_STAGE(PG8_SB(1, 1), b3 + hstep, voffB);
            PG8_WAIT_V(6); PG8_BAR; PG8_MMA(1, 1, At, B1); PG8_BAR;
        }
        E(acc, cur, wr, wc, fr, fq);
        if (!has_next) break;
        if (!E.keep(cur)) {
#pragma unroll
            for (int a = 0; a < 2; ++a)
#pragma unroll
                for (int b = 0; b < 2; ++b)
#pragma unroll
                    for (int m = 0; m < 4; ++m)
#pragma unroll
                        for (int n = 0; n < 2; ++n) acc[a][b][m][n] = (f32x4){0.f, 0.f, 0.f, 0.f};
        }
        cur = nxt; cA = nA; cB = nB; ++ui;
    }
    PG8_WAIT_V(0);
    if (wr == 0) PG8_BAR;
    PG8_BAR;
#undef PG8_SA
#undef PG8_SB
#undef PG8_STAGE
#undef PG8_LDA
#undef PG8_LDB
#undef PG8_MMA
#undef PG8_WAIT_V
#undef PG8_WAIT_L
#undef PG8_BAR
#undef PG8_SCHED
}
}


#define NOINL __forceinline__
__device__ NOINL void ph_gemm_swiglu(LAS unsigned char* lds, const bf16_t* A, const bf16_t* Bt, bf16_t* O) {
    pg8::Gemm g{A, Bt, T, 2 * DFF, D, 0, 0}; pg8::StaticOrder S; S.init(g.M, g.N, lgdim(), lbid()); pg8::EpiSwiGLU E{O}; pg8::gemm_phase(lds, g, S, E);
}
__device__ NOINL void ph_gemm_resid(LAS unsigned char* lds, const bf16_t* A, const bf16_t* Bt, int M, int K, const float* Xin, float* Xout, float scale) {
    pg8::Gemm g{A, Bt, M, D, K, 0, 0}; pg8::StaticOrder S; S.init(g.M, g.N, lgdim(), lbid()); pg8::EpiResid E{Xin, Xout, scale}; pg8::gemm_phase(lds, g, S, E);
}
__device__ NOINL void ph_gemm_proj(LAS unsigned char* lds, const bf16_t* A, const bf16_t* Bt, bf16_t* O, float* AB) {
    pg8::Gemm g{A, Bt, TS, PW, D, 0, 0}; pg8::StaticOrder S; S.init(g.M, g.N, lgdim(), lbid()); pg8::EpiProj E{O, AB}; pg8::gemm_phase(lds, g, S, E);
}
__device__ NOINL void ph_gemm_branch(LAS unsigned char* lds, const bf16_t* A, const bf16_t* Bt, const bf16_t* P, bf16_t* O) {
    pg8::Gemm g{A, Bt, TS, D, 512, (size_t)TS * 512 * 2, (size_t)D * 512 * 2}; pg8::BranchOrder S; S.init(g.M, g.N, lgdim(), lbid()); pg8::EpiBranch E{P, O}; pg8::gemm_phase(lds, g, S, E);
}

__device__ __forceinline__ void conv_tile(LAS float* scr, const float* src0, const float* src1, int K, int Nsrc, bf16_t* dst, int mode, int tile) {
    const int nkt = K / 64, kt = tile % nkt, rt = tile / nkt, k0 = kt * 64, r0 = rt * 64, tid = ltid();
    {
        const int kk = tid >> 3, rr = (tid & 7) * 8, rho = r0 + rr;
        const float* src = src0; int col = rho;
        if (mode == 1) { const int pn = rho >> 8, bj = (rho >> 7) & 1, j = rho & 127; col = pn * 128 + j; src = bj ? src1 : src0; }
        else if (mode == 2) { col = rho < 4096 ? rho : (rho < 8704 ? rho + 8 : (rho < 8712 ? rho - 8704 + 4096 : -1)); }
        f32x4 a = (f32x4){0.f, 0.f, 0.f, 0.f}, b = a;
        if (col >= 0) { const float* sp = src + (size_t)(k0 + kk) * Nsrc + col; a = *(const f32x4*)sp; b = *(const f32x4*)(sp + 4); }
#pragma unroll
        for (int e = 0; e < 4; ++e) { scr[(rr + e) * 65 + kk] = a[e]; scr[(rr + 4 + e) * 65 + kk] = b[e]; }
    }
    __syncthreads();
    {
        const int rl = tid >> 3, kc = (tid & 7) * 8;
        const LAS float* s = scr + rl * 65 + kc;
        u32x4 w; w.x = cvt_pk_bf16(s[0], s[1]); w.y = cvt_pk_bf16(s[2], s[3]); w.z = cvt_pk_bf16(s[4], s[5]); w.w = cvt_pk_bf16(s[6], s[7]);
        *(u32x4*)(dst + (size_t)(r0 + rl) * K + k0 + kc) = w;
    }
    __syncthreads();
}

__device__ __forceinline__ void convert_layer(LAS unsigned char* lds, const Params& p, int l) {
    LAS float* scr = (LAS float*)lds;
    unsigned char* ws = lptr(p.ws);
    constexpr int N1 = 16 * 88, N2 = 44 * 16, N3 = 16 * 140, N4 = 8 * 16, N5 = 16 * 16;
    constexpr int TOT = N1 + N2 + N3 + 4 * N4 + N5 + N1 + N2;
    for (int it = lbid(); it < TOT; it += lgdim()) {
        int r = it;
        if (r < N1) { conv_tile(scr, p.in[zz() + 2] + (size_t)l * D * DFF, p.in[zz() + 3] + (size_t)l * D * DFF, D, DFF, (bf16_t*)(ws + WS_WGU1), 1, r); continue; } r -= N1;
        if (r < N2) { conv_tile(scr, p.in[zz() + 4] + (size_t)l * DFF * D, nullptr, DFF, D, (bf16_t*)(ws + WS_WD1), 0, r); continue; } r -= N2;
        if (r < N3) { conv_tile(scr, p.in[zz() + 6] + (size_t)l * D * PIN, nullptr, D, PIN, (bf16_t*)(ws + WS_WIN), 2, r); continue; } r -= N3;
        if (r < 4 * N4) { const int g = r / N4; conv_tile(scr, p.in[zz() + 24] + ((size_t)l * 4 + g) * 512 * D, nullptr, 512, D, (bf16_t*)(ws + WS_WB) + (size_t)g * D * 512, 0, r % N4); continue; } r -= 4 * N4;
        if (r < N5) { conv_tile(scr, p.in[zz() + 25] + (size_t)l * D * D, nullptr, D, D, (bf16_t*)(ws + WS_WOUT), 0, r); continue; } r -= N5;
        if (r < N1) { conv_tile(scr, p.in[zz() + 27] + (size_t)l * D * DFF, p.in[zz() + 28] + (size_t)l * D * DFF, D, DFF, (bf16_t*)(ws + WS_WGU2), 1, r); continue; } r -= N1;
        conv_tile(scr, p.in[zz() + 29] + (size_t)l * DFF * D, nullptr, DFF, D, (bf16_t*)(ws + WS_WD2), 0, r);
    }
    bf16_t* waxt = (bf16_t*)(ws + WS_WAXT); bf16_t* pwt = (bf16_t*)(ws + WS_PWT);
    const float* wa = p.in[zz() + 13] + (size_t)l * 8 * 64 * 64; const float* wx = p.in[zz() + 15] + (size_t)l * 8 * 64 * 64; const float* pw = p.in[zz() + 22] + (size_t)l * 4 * 128 * 128;
    for (int e = lbid() * NTHR + ltid(); e < 65536; e += lgdim() * NTHR) {
        { const int h = e >> 13, jp = (e >> 6) & 127, i = e & 63; waxt[e] = f2bf(jp < 64 ? wa[(h * 64 + i) * 64 + jp] : wx[(h * 64 + i) * 64 + jp - 64]); }
        { const int g = e >> 14, d = (e >> 7) & 127, c = e & 127; pwt[e] = f2bf(pw[(g * 128 + c) * 128 + d]); }
    }
}

__device__ __forceinline__ void rms_rows_bf16(const float* X, const float* gain, bf16_t* H, int nrows) {
    const int wid = ltid() >> 6, lane = ltid() & 63;
    f32x4 gv[4];
#pragma unroll
    for (int j = 0; j < 4; ++j) gv[j] = *(const f32x4*)(gain + (lane + 64 * j) * 4);
    for (int row = lbid() * 8 + wid; row < nrows; row += lgdim() * 8) {
        const f32x4* xr = (const f32x4*)(X + (size_t)row * D) + lane;
        f32x4 v[4]; float s = 0.f;
#pragma unroll
        for (int j = 0; j < 4; ++j) { v[j] = xr[64 * j]; s += (v[j].x * v[j].x + v[j].y * v[j].y) + (v[j].z * v[j].z + v[j].w * v[j].w); }
        const float rs = rsqrtf(wave_sum(s) * (1.0f / D) + EPS);
        u32x2* o = (u32x2*)(H + (size_t)row * D) + lane;
#pragma unroll
        for (int j = 0; j < 4; ++j) { u32x2 w; w.x = cvt_pk_bf16(v[j].x * rs * gv[j].x, v[j].y * rs * gv[j].y); w.y = cvt_pk_bf16(v[j].z * rs * gv[j].z, v[j].w * rs * gv[j].w); o[64 * j] = w; }
    }
}
__device__ __forceinline__ void rms_rows_f32_inplace(float* X, const float* gain, int nrows) {
    const int wid = ltid() >> 6, lane = ltid() & 63;
    f32x4 gv[4];
#pragma unroll
    for (int j = 0; j < 4; ++j) gv[j] = *(const f32x4*)(gain + (lane + 64 * j) * 4);
    for (int row = lbid() * 8 + wid; row < nrows; row += lgdim() * 8) {
        f32x4* xr = (f32x4*)(X + (size_t)row * D) + lane;
        f32x4 v[4]; float s = 0.f;
#pragma unroll
        for (int j = 0; j < 4; ++j) { v[j] = xr[64 * j]; s += (v[j].x * v[j].x + v[j].y * v[j].y) + (v[j].z * v[j].z + v[j].w * v[j].w); }
        const float rs = rsqrtf(wave_sum(s) * (1.0f / D) + EPS);
#pragma unroll
        for (int j = 0; j < 4; ++j) xr[64 * j] = v[j] * rs * gv[j];
    }
}

__device__ __forceinline__ void sgu_tile(LAS unsigned char* lds, const Params& p, int l, const bf16_t* proj, bf16_t* ya, int tile) {
    const int tid = ltid(), wid = tid >> 6, lane = tid & 63, fr = lane & 15, fq = lane >> 4;
    const int blk = tile >> 2, g = tile & 3, r0 = blk * 128;
    LAS bf16_t* Wl = (LAS bf16_t*)lds;
    LAS bf16_t* VT = (LAS bf16_t*)(lds + 34816);
    const float* lng = p.in[zz() + 7] + l * 512 + g * 128; const float* lnb = p.in[zz() + 8] + l * 512 + g * 128;
    {
        const int i = tid >> 2, qd = tid & 3;
        const bf16_t* vrow = proj + (size_t)(r0 + i) * PW + PC_AV + qd * 8;
        float s = 0.f, s2 = 0.f;
#pragma unroll 4
        for (int e8 = 0; e8 < 16; ++e8) { const u32x4 w = *(const u32x4*)(vrow + e8 * 32);
#pragma unroll
            for (int q = 0; q < 4; ++q) { const float a = geluf_(lo_bf(w[q])), b = geluf_(hi_bf(w[q])); s += a + b; s2 += a * a + b * b; } }
        s += __shfl_xor(s, 1); s += __shfl_xor(s, 2); s2 += __shfl_xor(s2, 1); s2 += __shfl_xor(s2, 2);
        const float mean = s * (1.0f / 512.0f), var = fmaxf(s2 * (1.0f / 512.0f) - mean * mean, 0.f), rstd = rsqrtf(var + EPS);
        const bf16_t* vg = proj + (size_t)(r0 + i) * PW + PC_AV + g * 128 + qd * 8;
#pragma unroll
        for (int e8 = 0; e8 < 4; ++e8) { const u32x4 w = *(const u32x4*)(vg + e8 * 32);
#pragma unroll
            for (int q = 0; q < 4; ++q) { const int c = e8 * 32 + qd * 8 + 2 * q;
                VT[c * 136 + i] = f2bf((geluf_(lo_bf(w[q])) - mean) * rstd * lng[c] + lnb[c]);
                VT[(c + 1) * 136 + i] = f2bf((geluf_(hi_bf(w[q])) - mean) * rstd * lng[c + 1] + lnb[c + 1]); } }
        const float* wsrc = p.in[zz() + 9] + (((size_t)l * 4 + g) * 128 + i) * 128 + qd * 32;
#pragma unroll
        for (int e4 = 0; e4 < 8; ++e4) { f32x4 w = *(const f32x4*)(wsrc + e4 * 4); if (i < 64 && qd >= 2) w = (f32x4){0.f, 0.f, 0.f, 0.f};
            u32x2 o; o.x = cvt_pk_bf16(w.x, w.y); o.y = cvt_pk_bf16(w.z, w.w); *(LAS u32x2*)(Wl + i * 136 + qd * 32 + e4 * 4) = o; }
    }
    __syncthreads();
    f32x4 acc[8];
#pragma unroll
    for (int n = 0; n < 8; ++n) acc[n] = (f32x4){0.f, 0.f, 0.f, 0.f};
#pragma unroll
    for (int ks = 0; ks < 4; ++ks) {
        const bf16x8 af = *(const LAS bf16x8*)(Wl + (wid * 16 + fr) * 136 + ks * 32 + fq * 8);
#pragma unroll
        for (int n = 0; n < 8; ++n) { const bf16x8 bf = *(const LAS bf16x8*)(VT + (n * 16 + fr) * 136 + ks * 32 + fq * 8); acc[n] = __builtin_amdgcn_mfma_f32_16x16x32_bf16(bf, af, acc[n], 0, 0, 0); }
    }
    {
        const int i = wid * 16 + fr; const float bias = p.in[zz() + 10][((size_t)l * 4 + g) * 128 + i];
        const bf16_t* up = proj + (size_t)(r0 + i) * PW + PC_AU + g * 128 + fq * 4;
        bf16_t* yp = ya + (size_t)(r0 + i) * 512 + g * 128 + fq * 4;
#pragma unroll
        for (int n = 0; n < 8; ++n) { const u32x2 uw = *(const u32x2*)(up + n * 16);
            u32x2 o; o.x = cvt_pk_bf16((acc[n][0] + bias) * geluf_(lo_bf(uw.x)), (acc[n][1] + bias) * geluf_(hi_bf(uw.x)));
            o.y = cvt_pk_bf16((acc[n][2] + bias) * geluf_(lo_bf(uw.y)), (acc[n][3] + bias) * geluf_(hi_bf(uw.y))); *(u32x2*)(yp + n * 16) = o; }
    }
    __syncthreads();
}

template <int WIN>
__device__ __forceinline__ void pool_rows(LAS bf16_t* Al, const bf16_t* xcol, int c, int pos0) {
    float xv[80];
#pragma unroll
    for (int k = 0; k < 80; ++k) xv[k] = (pos0 - 16 + k >= 0) ? bf2f(xcol[(long)(k - 16) * PW]) : 0.f;
    float s = 0.f;
#pragma unroll
    for (int j = 0; j < WIN; ++j) s += xv[16 - j];
#pragma unroll
    for (int tt = 0; tt < 64; ++tt) {
        const int k = tt + 16;
        const int cnt = min(pos0 + tt + 1, WIN);
        Al[tt * 520 + c] = f2bf(s / (float)cnt - xv[k]);
        if (tt < 63) s += xv[k + 1] - xv[k + 1 - WIN];
    }
}
__device__ __forceinline__ void pool_tile(LAS unsigned char* lds, const Params& p, int l, const bf16_t* proj, bf16_t* yd, bf16_t* halo, const bf16_t* pwt, int tile) {
    const int tid = ltid(), wid = tid >> 6, lane = tid & 63, fr = lane & 15, fq = lane >> 4;
    const int t0 = tile * 64, pos0 = t0 % SEQ;
    LAS bf16_t* Al = (LAS bf16_t*)lds;
    {
        const int c = tid, g = wid >> 1;
        const bf16_t* xcol = proj + (size_t)t0 * PW + PC_DX + c;
        if (g == 0) pool_rows<2>(Al, xcol, c, pos0); else if (g == 1) pool_rows<4>(Al, xcol, c, pos0); else if (g == 2) pool_rows<8>(Al, xcol, c, pos0); else pool_rows<16>(Al, xcol, c, pos0);
    }
    __syncthreads();
    {
        const int g = wid >> 1, nh = wid & 1;
        f32x4 acc[4][4];
#pragma unroll
        for (int m = 0; m < 4; ++m)
#pragma unroll
            for (int n = 0; n < 4; ++n) acc[m][n] = (f32x4){0.f, 0.f, 0.f, 0.f};
#pragma unroll
        for (int ks = 0; ks < 4; ++ks) {
            bf16x8 bfr[4];
#pragma unroll
            for (int n = 0; n < 4; ++n) bfr[n] = *(const bf16x8*)(pwt + ((size_t)(g * 128 + (nh * 4 + n) * 16 + fr)) * 128 + ks * 32 + fq * 8);
#pragma unroll
            for (int m = 0; m < 4; ++m) { const bf16x8 af = *(const LAS bf16x8*)(Al + (m * 16 + fr) * 520 + g * 128 + ks * 32 + fq * 8);
#pragma unroll
                for (int n = 0; n < 4; ++n) acc[m][n] = __builtin_amdgcn_mfma_f32_16x16x32_bf16(bfr[n], af, acc[m][n], 0, 0, 0); }
        }
        const float* sc = p.in[zz() + 23] + l * 512 + g * 128;
#pragma unroll
        for (int n = 0; n < 4; ++n) { const int d = (nh * 4 + n) * 16 + fq * 4; const f32x4 s4 = *(const f32x4*)(sc + d);
#pragma unroll
            for (int m = 0; m < 4; ++m) { u32x2 o; o.x = cvt_pk_bf16(acc[m][n][0] * s4[0], acc[m][n][1] * s4[1]); o.y = cvt_pk_bf16(acc[m][n][2] * s4[2], acc[m][n][3] * s4[3]);
                *(u32x2*)(yd + (size_t)(t0 + m * 16 + fr) * 512 + g * 128 + d) = o; } }
    }
    __syncthreads();
}

__device__ __forceinline__ void lru_tile(LAS unsigned char* lds, const Params& p, int l, const bf16_t* proj, bf16_t* yb, const bf16_t* waxt, float* Aend, float* Hend, const float* carry, int tile, int mode) {
    const int tid = ltid(), wid = tid >> 6, lane = tid & 63, fr = lane & 15, fq = lane >> 4;
    const int t0 = tile * 64, pos0 = t0 % SEQ, c = wid * 64 + lane;
    LAS bf16_t* Aw = (LAS bf16_t*)(lds + wid * 10560);
    LAS float* Xw = (LAS float*)(lds + wid * 10560 + 2304);
    bf16x8 bfr[8][2];
#pragma unroll
    for (int n = 0; n < 8; ++n)
#pragma unroll
        for (int ks = 0; ks < 2; ++ks) bfr[n][ks] = *(const bf16x8*)(waxt + ((size_t)(wid * 128 + n * 16 + fr)) * 64 + ks * 32 + fq * 8);
    const float* cwp = p.in[zz() + 11] + (size_t)l * 4 * 512 + c;
    const float cw0 = cwp[0], cw1 = cwp[512], cw2 = cwp[1024], cw3 = cwp[1536], cb = p.in[zz() + 12][l * 512 + c];
    const float ba = p.in[zz() + 14][l * 512 + c], bx = p.in[zz() + 16][l * 512 + c], sp8 = 8.0f * softplusf_(-p.in[zz() + 17][l * 512 + c]);
    const bf16_t* xcol = proj + (size_t)t0 * PW + PC_BX + c;
    float xm3 = 0.f, xm2 = 0.f, xm1 = 0.f;
    if (pos0 > 0) { xm3 = bf2f(xcol[-3L * PW]); xm2 = bf2f(xcol[-2L * PW]); xm1 = bf2f(xcol[-1L * PW]); }
    const bf16_t* gcol = proj + (size_t)t0 * PW + PC_BG + c;
    bf16_t* ycol = yb + (size_t)t0 * 512 + c;
    float h = mode ? carry[(size_t)tile * 512 + c] : 0.f, Ap = 1.f;
    for (int sub = 0; sub < 4; ++sub) {
        float xc[16];
#pragma unroll
        for (int tt = 0; tt < 16; ++tt) { const float xin = bf2f(*xcol); xcol += PW; xc[tt] = cb + cw0 * xm3 + cw1 * xm2 + cw2 * xm1 + cw3 * xin; xm3 = xm2; xm2 = xm1; xm1 = xin; Aw[tt * 72 + lane] = f2bf(xc[tt]); }
        __syncthreads();
        f32x4 acc[8];
#pragma unroll
        for (int n = 0; n < 8; ++n) acc[n] = (f32x4){0.f, 0.f, 0.f, 0.f};
#pragma unroll
        for (int ks = 0; ks < 2; ++ks) { const bf16x8 af = *(const LAS bf16x8*)(Aw + fr * 72 + ks * 32 + fq * 8);
#pragma unroll
            for (int n = 0; n < 8; ++n) acc[n] = __builtin_amdgcn_mfma_f32_16x16x32_bf16(bfr[n][ks], af, acc[n], 0, 0, 0); }
#pragma unroll
        for (int n = 0; n < 8; ++n)
#pragma unroll
            for (int j = 0; j < 4; ++j) Xw[fr * 129 + n * 16 + fq * 4 + j] = acc[n][j];
        __syncthreads();
#pragma unroll
        for (int tt = 0; tt < 16; ++tt) {
            const float r = sigmoidf_(Xw[tt * 129 + lane] + ba), ig = sigmoidf_(Xw[tt * 129 + 64 + lane] + bx);
            const float la = -sp8 * r, a = __expf(la), x2 = 2.0f * la;
            const float om = (x2 > -0.1f) ? -x2 * (1.0f + x2 * (0.5f + x2 * (0.16666667f + x2 * 0.041666668f))) : 1.0f - a * a;
            h = a * h + __builtin_amdgcn_sqrtf(om) * ig * xc[tt]; Ap *= a;
            if (mode) { const float gt = bf2f(*gcol); gcol += PW; *ycol = f2bf(h * geluf_(gt)); ycol += 512; }
        }
        __syncthreads();
    }
    if (!mode) { Aend[(size_t)tile * 512 + c] = Ap; Hend[(size_t)tile * 512 + c] = h; }
}
__device__ __forceinline__ void lru_carry(const float* Aend, const float* Hend, float* carry) {
    const int gid = lbid() * NTHR + ltid();
    if (gid < (TS / SEQ) * 512) {
        const int bl = gid >> 9, c = gid & 511; float h = 0.f;
        for (int n = 0; n < 64; ++n) { const size_t o = (size_t)(bl * 64 + n) * 512 + c; carry[o] = h; h = Aend[o] * h + Hend[o]; }
    }
}

__device__ __forceinline__ void gdn_prep(LAS unsigned char* lds, const Params& p, int l, const bf16_t* proj, const float* AB, bf16_t* GQ, bf16_t* GK, bf16_t* GU, bf16_t* GW, bf16_t* GA, float* edec, int item) {
    const int tid = ltid(), wid = tid >> 6, lane = tid & 63, fr = lane & 15, fq = lane >> 4;
    const int bl = item >> 8, n = (item & 255) >> 2, hh = item & 3, ch = bl * 64 + n, t0 = ch * 64;
    LAS bf16_t* Kl = (LAS bf16_t*)lds;
    LAS bf16_t* Ql = (LAS bf16_t*)(lds + 17408);
    LAS float* RHS = (LAS float*)(lds + 34816);
    LAS float* Am = (LAS float*)(lds + 101376);
    LAS float* gc = (LAS float*)(lds + 117760);
    LAS float* bt = (LAS float*)(lds + 118016);
    const int t = tid >> 3, d0 = (tid & 7) * 16;
    float qkv[3][16];
#pragma unroll
    for (int sec = 0; sec < 3; ++sec) {
        const int colh = sec * 512 + hh * 128 + d0;
        float a[16];
#pragma unroll
        for (int e = 0; e < 16; ++e) a[e] = 0.f;
#pragma unroll
        for (int k = 0; k < 4; ++k) {
            const int tt = t - 3 + k;
            const bf16_t* src = nullptr;
            if (tt >= 0 || n > 0) src = proj + (long)(t0 + tt) * PW + PC_CQ + colh;
            if (src) {
                const u32x4 w0 = *(const u32x4*)src, w1 = *(const u32x4*)(src + 8);
                const float* cw = p.in[zz() + 18] + ((size_t)l * 4 + k) * 1536 + colh;
#pragma unroll
                for (int q = 0; q < 4; ++q) { const f32x4 c4 = *(const f32x4*)(cw + q * 4);
                    const unsigned wa = (q < 2) ? w0[2 * q] : w1[2 * q - 4], wb = (q < 2) ? w0[2 * q + 1] : w1[2 * q - 3];
                    a[q * 4 + 0] += c4[0] * lo_bf(wa); a[q * 4 + 1] += c4[1] * hi_bf(wa); a[q * 4 + 2] += c4[2] * lo_bf(wb); a[q * 4 + 3] += c4[3] * hi_bf(wb); }
            }
        }
#pragma unroll
        for (int e = 0; e < 16; ++e) qkv[sec][e] = siluf_(a[e]);
    }
    {
        float sq = 0.f, sk = 0.f;
#pragma unroll
        for (int e = 0; e < 16; ++e) { sq += qkv[0][e] * qkv[0][e]; sk += qkv[1][e] * qkv[1][e]; }
        sq += __shfl_xor(sq, 1); sq += __shfl_xor(sq, 2); sq += __shfl_xor(sq, 4); sk += __shfl_xor(sk, 1); sk += __shfl_xor(sk, 2); sk += __shfl_xor(sk, 4);
        const float qn = rsqrtf(sq + EPS) * 0.08838834764831845f, kn = rsqrtf(sk + EPS);
#pragma unroll
        for (int e = 0; e < 16; ++e) { qkv[0][e] *= qn; qkv[1][e] *= kn; }
#pragma unroll
        for (int e = 0; e < 16; e += 2) { *(LAS unsigned*)(Ql + t * 136 + d0 + e) = cvt_pk_bf16(qkv[0][e], qkv[0][e + 1]); *(LAS unsigned*)(Kl + t * 136 + d0 + e) = cvt_pk_bf16(qkv[1][e], qkv[1][e + 1]); }
    }
    if (wid == 0) {
        const float al = AB[(size_t)(t0 + lane) * 8 + 4 + hh], be = AB[(size_t)(t0 + lane) * 8 + hh];
        float gv = -__expf(p.in[zz() + 19][l * 4 + hh]) * softplusf_(al + p.in[zz() + 20][l * 4 + hh]);
#pragma unroll
        for (int o = 1; o < 64; o <<= 1) { const float u = __shfl_up(gv, o); if (lane >= o) gv += u; }
        gc[lane] = gv; bt[lane] = sigmoidf_(be);
        if (lane == 63) edec[item] = __expf(gv);
    }
    __syncthreads();
    {
        const float bet = bt[t], gct = gc[t], eg = __expf(gct), ekd = __expf(gc[63] - gct);
#pragma unroll
        for (int e = 0; e < 16; ++e) { RHS[t * 260 + d0 + e] = qkv[2][e] * bet; RHS[t * 260 + 128 + d0 + e] = qkv[1][e] * bet * eg; }
        bf16_t* qdst = GQ + (size_t)(t0 + t) * 512 + hh * 128 + d0;
        u32x4 w0, w1;
        w0.x = cvt_pk_bf16(qkv[0][0] * eg, qkv[0][1] * eg); w0.y = cvt_pk_bf16(qkv[0][2] * eg, qkv[0][3] * eg); w0.z = cvt_pk_bf16(qkv[0][4] * eg, qkv[0][5] * eg); w0.w = cvt_pk_bf16(qkv[0][6] * eg, qkv[0][7] * eg);
        w1.x = cvt_pk_bf16(qkv[0][8] * eg, qkv[0][9] * eg); w1.y = cvt_pk_bf16(qkv[0][10] * eg, qkv[0][11] * eg); w1.z = cvt_pk_bf16(qkv[0][12] * eg, qkv[0][13] * eg); w1.w = cvt_pk_bf16(qkv[0][14] * eg, qkv[0][15] * eg);
        *(u32x4*)qdst = w0; *(u32x4*)(qdst + 8) = w1;
#pragma unroll
        for (int e = 0; e < 16; ++e) qkv[1][e] *= ekd;
    }
    {
        const int it = wid & 3, which = wid >> 2;
        LAS bf16_t* Xi = which ? Ql : Kl;
        bf16x8 af[4];
#pragma unroll
        for (int ks = 0; ks < 4; ++ks) af[ks] = *(const LAS bf16x8*)(Xi + (it * 16 + fr) * 136 + ks * 32 + fq * 8);
        const int i = it * 16 + fr; const float gci = gc[i], bti = bt[i];
#pragma unroll
        for (int jt = 0; jt < 4; ++jt) {
            f32x4 acc = (f32x4){0.f, 0.f, 0.f, 0.f};
#pragma unroll
            for (int ks = 0; ks < 4; ++ks) { const bf16x8 bf = *(const LAS bf16x8*)(Kl + (jt * 16 + fr) * 136 + ks * 32 + fq * 8); acc = __builtin_amdgcn_mfma_f32_16x16x32_bf16(bf, af[ks], acc, 0, 0, 0); }
            float v[4];
#pragma unroll
            for (int jj = 0; jj < 4; ++jj) { const int j = jt * 16 + fq * 4 + jj; const float dec = (i >= j) ? __expf(gci - gc[j]) : 0.f;
                v[jj] = which ? acc[jj] * dec : ((i > j) ? bti * acc[jj] * dec : 0.f); }
            if (which) { u32x2 o; o.x = cvt_pk_bf16(v[0], v[1]); o.y = cvt_pk_bf16(v[2], v[3]); *(u32x2*)(GA + (size_t)(t0 + i) * 256 + hh * 64 + jt * 16 + fq * 4) = o; }
            else *(LAS f32x4*)(Am + i * 64 + jt * 16 + fq * 4) = (f32x4){v[0], v[1], v[2], v[3]};
        }
    }
    __syncthreads();
    {
        LAS bf16_t* KDT = Ql;
#pragma unroll
        for (int e = 0; e < 16; ++e) KDT[(d0 + e) * 68 + t] = f2bf(qkv[1][e]);
    }
    if (tid < 256) {
        float x[64];
        int lz; asm volatile("v_mov_b32 %0, 0" : "=v"(lz));
        const LAS float* Amz = Am + lz;
#pragma unroll
        for (int i = 0; i < 64; ++i) x[i] = 0.f;
#pragma unroll
        for (int i = 0; i < 64; ++i) {
            float s = RHS[i * 260 + tid];
#pragma unroll
            for (int j4 = 0; j4 < (i + 3) / 4; ++j4) { const f32x4 a4 = *(const LAS f32x4*)(Amz + i * 64 + j4 * 4);
                s -= a4[0] * x[j4 * 4]; s -= a4[1] * x[j4 * 4 + 1]; s -= a4[2] * x[j4 * 4 + 2]; s -= a4[3] * x[j4 * 4 + 3]; }
            x[i] = s; RHS[i * 260 + tid] = s;
        }
    }
    __syncthreads();
    {
        const int seg = tid & 7;
        const LAS float* xr = RHS + t * 260 + seg * 32;
        bf16_t* dst = ((seg < 4) ? GU : GW) + (size_t)(t0 + t) * 512 + hh * 128 + (seg & 3) * 32;
#pragma unroll
        for (int q = 0; q < 4; ++q) { const f32x4 a = *(const LAS f32x4*)(xr + q * 8), b = *(const LAS f32x4*)(xr + q * 8 + 4);
            u32x4 w; w.x = cvt_pk_bf16(a[0], a[1]); w.y = cvt_pk_bf16(a[2], a[3]); w.z = cvt_pk_bf16(b[0], b[1]); w.w = cvt_pk_bf16(b[2], b[3]); *(u32x4*)(dst + q * 8) = w; }
        const LAS bf16_t* kr = Ql + (2 * t + (seg >> 2)) * 68 + (seg & 3) * 16;
        const u32x2 k0 = *(const LAS u32x2*)kr, k1 = *(const LAS u32x2*)(kr + 4), k2 = *(const LAS u32x2*)(kr + 8), k3 = *(const LAS u32x2*)(kr + 12);
        bf16_t* kdst = GK + (size_t)(t0 + t) * 512 + hh * 128 + seg * 16;
        *(u32x4*)kdst = (u32x4){k0.x, k0.y, k1.x, k1.y}; *(u32x4*)(kdst + 8) = (u32x4){k2.x, k2.y, k3.x, k3.y};
    }
    __syncthreads();
}

__device__ __forceinline__ void gdn_scan(LAS unsigned char* lds, const unsigned char* ws, float* oraw, const float* edec, int chain) {
    const int tid = ltid(), wid = __builtin_amdgcn_readfirstlane(tid >> 6), lane = tid & 63, fr = lane & 15, fq = lane >> 4;
    const int bl = chain >> 5, hh = (chain >> 3) & 3, es = chain & 7, e0 = es * 16;
    constexpr int BUF = 64512, O_W = 0, O_Q = 17408, O_KT = 34816, O_AT = 53248, O_U = 62464, O_PS = 2 * BUF, O_PV = 2 * BUF + 4096;
    const unsigned rb = (unsigned)(bl * 64) * 64u;
    const bool stager = (wid >= 2);
    int soff[10], doff[10];
    {
        const int sid = tid - 128;
#pragma unroll
        for (int s = 0; s < 10; ++s) {
            int idx = sid + 384 * s; if (idx >= 3712) idx -= 128;
            if (!stager) { soff[s] = 0; doff[s] = 0; }
            else if (idx < 1024) { const int row = idx >> 4, pc = idx & 15; soff[s] = (int)(WS_GDW + ((size_t)(rb + row) * 512 + hh * 128 + pc * 8) * 2); doff[s] = O_W + (row * 136 + pc * 8) * 2; }
            else if (idx < 2048) { const int i2 = idx - 1024, row = i2 >> 4, pc = i2 & 15; soff[s] = (int)(WS_GDQ + ((size_t)(rb + row) * 512 + hh * 128 + pc * 8) * 2); doff[s] = O_Q + (row * 136 + pc * 8) * 2; }
            else if (idx < 3072) { const int i2 = idx - 2048, row = i2 >> 4, pc = i2 & 15; soff[s] = (int)(WS_GDK + ((size_t)(rb + row) * 512 + hh * 128 + pc * 8) * 2); doff[s] = O_KT + ((2 * row + (pc >> 3)) * 72 + (pc & 7) * 8) * 2; }
            else if (idx < 3584) { const int i2 = idx - 3072, row = i2 >> 3, pc = i2 & 7; soff[s] = (int)(WS_GDA + ((size_t)(rb + row) * 256 + hh * 64 + pc * 8) * 2); doff[s] = O_AT + (row * 72 + pc * 8) * 2; }
            else { const int i2 = idx - 3584, row = i2 >> 1, pc = i2 & 1; soff[s] = (int)(WS_GDU + ((size_t)(rb + row) * 512 + hh * 128 + e0 + pc * 8) * 2); doff[s] = O_U + (row * 16 + pc * 8) * 2; }
        }
    }
    const unsigned step9 = (tid - 128 < 128) ? 32768u : 65536u;
#define SSTEP(s) ((s) < 8 ? 65536u : ((s) == 8 ? 32768u : step9))
    u32x4 stg[10];
    if (stager) {
#pragma unroll
        for (int s = 0; s < 10; ++s) stg[s] = *(const u32x4*)(ws + (unsigned)soff[s]);
#pragma unroll
        for (int s = 0; s < 10; ++s) *(LAS u32x4*)(lds + doff[s]) = stg[s];
#pragma unroll
        for (int s = 0; s < 10; ++s) stg[s] = *(const u32x4*)(ws + (unsigned)soff[s] + SSTEP(s));
    }
    if (wid == 1) {
#pragma unroll
        for (int kt = 0; kt < 4; ++kt) *(LAS u32x4*)(lds + O_PS + kt * 1024 + lane * 16) = (u32x4){0u, 0u, 0u, 0u};
    }
    const float dv = edec[bl * 256 + lane * 4 + hh];
    f32x4 Sacc[8];
#pragma unroll
    for (int d = 0; d < 8; ++d) Sacc[d] = (f32x4){0.f, 0.f, 0.f, 0.f};
    __syncthreads();
    for (int n = 0; n < 64; ++n) {
        const LAS unsigned char* B = lds + (n & 1) * BUF;
        const int t0 = (bl * 64 + n) * 64;
        f32x4 OS[4];
        bf16x8 vb[2];
        if (wid == 0) {
            f32x4 WS[4];
            bf16x8 sb[4];
#pragma unroll
            for (int kt = 0; kt < 4; ++kt) { u32x4 w; w.x = cvt_pk_bf16(Sacc[2 * kt][0], Sacc[2 * kt][1]); w.y = cvt_pk_bf16(Sacc[2 * kt][2], Sacc[2 * kt][3]);
                w.z = cvt_pk_bf16(Sacc[2 * kt + 1][0], Sacc[2 * kt + 1][1]); w.w = cvt_pk_bf16(Sacc[2 * kt + 1][2], Sacc[2 * kt + 1][3]); sb[kt] = __builtin_bit_cast(bf16x8, w); }
#pragma unroll
            for (int m = 0; m < 4; ++m) WS[m] = (f32x4){0.f, 0.f, 0.f, 0.f};
#pragma unroll
            for (int kt = 0; kt < 4; ++kt)
#pragma unroll
                for (int m = 0; m < 4; ++m) { const LAS unsigned char* wp = B + O_W + ((m * 16 + fr) * 136 + kt * 32 + fq * 4) * 2;
                    u32x4 wa; { const u32x2 lo = *(const LAS u32x2*)wp, hi = *(const LAS u32x2*)(wp + 32); wa.x = lo.x; wa.y = lo.y; wa.z = hi.x; wa.w = hi.y; }
                    WS[m] = __builtin_amdgcn_mfma_f32_16x16x32_bf16(__builtin_bit_cast(bf16x8, wa), sb[kt], WS[m], 0, 0, 0); }
#pragma unroll
            for (int m = 0; m < 4; ++m)
#pragma unroll
                for (int jj = 0; jj < 4; ++jj) WS[m][jj] = bf2f(*(const LAS bf16_t*)(B + O_U + ((m * 16 + fq * 4 + jj) * 16 + fr) * 2)) - WS[m][jj];
#pragma unroll
            for (int kc = 0; kc < 2; ++kc) { u32x4 w; w.x = cvt_pk_bf16(WS[2 * kc][0], WS[2 * kc][1]); w.y = cvt_pk_bf16(WS[2 * kc][2], WS[2 * kc][3]);
                w.z = cvt_pk_bf16(WS[2 * kc + 1][0], WS[2 * kc + 1][1]); w.w = cvt_pk_bf16(WS[2 * kc + 1][2], WS[2 * kc + 1][3]); vb[kc] = __builtin_bit_cast(bf16x8, w);
                *(LAS u32x4*)(lds + O_PV + kc * 1024 + lane * 16) = w; }
        } else if (wid == 1) {
#pragma unroll
            for (int m = 0; m < 4; ++m) OS[m] = (f32x4){0.f, 0.f, 0.f, 0.f};
#pragma unroll
            for (int kt = 0; kt < 4; ++kt) {
                const bf16x8 sbr = *(const LAS bf16x8*)(lds + O_PS + kt * 1024 + lane * 16);
#pragma unroll
                for (int m = 0; m < 4; ++m) { const LAS unsigned char* qp = B + O_Q + ((m * 16 + fr) * 136 + kt * 32 + fq * 4) * 2;
                    u32x4 qa; { const u32x2 lo = *(const LAS u32x2*)qp, hi = *(const LAS u32x2*)(qp + 32); qa.x = lo.x; qa.y = lo.y; qa.z = hi.x; qa.w = hi.y; }
                    OS[m] = __builtin_amdgcn_mfma_f32_16x16x32_bf16(__builtin_bit_cast(bf16x8, qa), sbr, OS[m], 0, 0, 0); }
            }
        }
        __syncthreads();
        if (wid == 0) {
            const float dec = __shfl(dv, n);
#pragma unroll
            for (int d = 0; d < 8; ++d) Sacc[d] *= dec;
#pragma unroll
            for (int kc = 0; kc < 2; ++kc)
#pragma unroll
                for (int d = 0; d < 8; ++d) { const LAS unsigned char* kp = B + O_KT + ((d * 16 + fr) * 72 + kc * 32 + fq * 4) * 2;
                    u32x4 a; { const u32x2 lo = *(const LAS u32x2*)kp, hi = *(const LAS u32x2*)(kp + 32); a.x = lo.x; a.y = lo.y; a.z = hi.x; a.w = hi.y; }
                    Sacc[d] = __builtin_amdgcn_mfma_f32_16x16x32_bf16(__builtin_bit_cast(bf16x8, a), vb[kc], Sacc[d], 0, 0, 0); }
#pragma unroll
            for (int kt = 0; kt < 4; ++kt) { u32x4 w; w.x = cvt_pk_bf16(Sacc[2 * kt][0], Sacc[2 * kt][1]); w.y = cvt_pk_bf16(Sacc[2 * kt][2], Sacc[2 * kt][3]);
                w.z = cvt_pk_bf16(Sacc[2 * kt + 1][0], Sacc[2 * kt + 1][1]); w.w = cvt_pk_bf16(Sacc[2 * kt + 1][2], Sacc[2 * kt + 1][3]);
                *(LAS u32x4*)(lds + O_PS + kt * 1024 + lane * 16) = w; }
        } else if (wid == 1) {
#pragma unroll
            for (int kc = 0; kc < 2; ++kc) {
                const bf16x8 vbr = *(const LAS bf16x8*)(lds + O_PV + kc * 1024 + lane * 16);
#pragma unroll
                for (int m = 0; m < 4; ++m) { const LAS unsigned char* ap = B + O_AT + ((m * 16 + fr) * 72 + kc * 32 + fq * 4) * 2;
                    u32x4 a; { const u32x2 lo = *(const LAS u32x2*)ap, hi = *(const LAS u32x2*)(ap + 32); a.x = lo.x; a.y = lo.y; a.z = hi.x; a.w = hi.y; }
                    OS[m] = __builtin_amdgcn_mfma_f32_16x16x32_bf16(__builtin_bit_cast(bf16x8, a), vbr, OS[m], 0, 0, 0); }
            }
            float* op = oraw + (size_t)(t0 + fq * 4) * 512 + hh * 128 + e0 + fr;
#pragma unroll
            for (int m = 0; m < 4; ++m)
#pragma unroll
                for (int jj = 0; jj < 4; ++jj) op[(size_t)(m * 16 + jj) * 512] = OS[m][jj];
        } else if (stager) {
            if (n + 1 < 64) { LAS unsigned char* Bn = lds + ((n + 1) & 1) * BUF;
#pragma unroll
                for (int s = 0; s < 10; ++s) *(LAS u32x4*)(Bn + doff[s]) = stg[s]; }
            if (n + 2 < 64) {
#pragma unroll
                for (int s = 0; s < 10; ++s) stg[s] = *(const u32x4*)(ws + (unsigned)soff[s] + (unsigned)(n + 2) * SSTEP(s)); }
        }
        __syncthreads();
    }
}
__device__ __forceinline__ void gdn_out(const Params& p, int l, const float* oraw, const bf16_t* proj, bf16_t* yc) {
    const int tid = ltid(), sub = tid & 15;
    const float* ng = p.in[zz() + 21] + l * 128 + sub * 8;
    const f32x4 g0 = *(const f32x4*)ng, g1 = *(const f32x4*)(ng + 4);
    for (int rowi = lbid() * 32 + (tid >> 4); rowi < TS * 4; rowi += lgdim() * 32) {
        const int t = rowi >> 2, hh = rowi & 3;
        const float* op = oraw + (size_t)t * 512 + hh * 128 + sub * 8;
        const f32x4 o0 = *(const f32x4*)op, o1 = *(const f32x4*)(op + 4);
        float ss = (o0[0] * o0[0] + o0[1] * o0[1]) + (o0[2] * o0[2] + o0[3] * o0[3]) + (o1[0] * o1[0] + o1[1] * o1[1]) + (o1[2] * o1[2] + o1[3] * o1[3]);
        ss += __shfl_xor(ss, 1); ss += __shfl_xor(ss, 2); ss += __shfl_xor(ss, 4); ss += __shfl_xor(ss, 8);
        const float rs = rsqrtf(ss * (1.0f / 128.0f) + EPS);
        const u32x4 z = *(const u32x4*)(proj + (size_t)t * PW + PC_CZ + hh * 128 + sub * 8);
        u32x4 w;
        w.x = cvt_pk_bf16(o0[0] * rs * g0[0] * siluf_(lo_bf(z.x)), o0[1] * rs * g0[1] * siluf_(hi_bf(z.x)));
        w.y = cvt_pk_bf16(o0[2] * rs * g0[2] * siluf_(lo_bf(z.y)), o0[3] * rs * g0[3] * siluf_(hi_bf(z.y)));
        w.z = cvt_pk_bf16(o1[0] * rs * g1[0] * siluf_(lo_bf(z.z)), o1[1] * rs * g1[1] * siluf_(hi_bf(z.z)));
        w.w = cvt_pk_bf16(o1[2] * rs * g1[2] * siluf_(lo_bf(z.w)), o1[3] * rs * g1[3] * siluf_(hi_bf(z.w)));
        *(u32x4*)(yc + (size_t)t * 512 + hh * 128 + sub * 8) = w;
    }
}

constexpr int PH_PER_LAYER = 22, N_PHASES = 2 * PH_PER_LAYER + 1;

__device__ __forceinline__ void run_phase(LAS unsigned char* lds, const Params& p, int ph) {
    unsigned char* ws = lptr(p.ws);
    bf16_t* hbuf = (bf16_t*)(ws + WS_H);
    bf16_t* act = (bf16_t*)(ws + WS_PROJ);
    bf16_t* proj = (bf16_t*)(ws + WS_PROJ);
    bf16_t* hslab = hbuf;
    bf16_t* merged = hbuf + (size_t)TS * D;
    float* oraw = (float*)(ws + WS_H);
    bf16_t* ys = (bf16_t*)(ws + WS_YS);
    float* AB = (float*)(ws + WS_AB);
    bf16_t* halo = (bf16_t*)(ws + WS_HALO);
    float* Aend = (float*)(ws + WS_AEND); float* Hend = (float*)(ws + WS_HEND); float* carry = (float*)(ws + WS_CARRY); float* edec = (float*)(ws + WS_EDEC);
    const bf16_t* waxt = (const bf16_t*)(ws + WS_WAXT); const bf16_t* pwt = (const bf16_t*)(ws + WS_PWT);
    const int G = lgdim(), c = lbid();
    if (ph == N_PHASES - 1) { PHON(0) rms_rows_f32_inplace(lptr(p.out), p.in[zz() + 30], T); return; }
    const int l = ph / PH_PER_LAYER, r = ph % PH_PER_LAYER;
    const float* xcur = (l == 0) ? p.in[zz() + 0] : lptr(p.out);
    if (r == 0) { PHON(1) convert_layer(lds, p, l); PHON(0) rms_rows_bf16(xcur, p.in[zz() + 1] + l * D, hbuf, T); return; }
    if (r == 1 || r == 20) { PHON(2) ph_gemm_swiglu(lds, hbuf, (const bf16_t*)(ws + (r == 1 ? WS_WGU1 : WS_WGU2)), act); return; }
    if (r == 2 || r == 21) { PHON(3) ph_gemm_resid(lds, act, (const bf16_t*)(ws + (r == 2 ? WS_WD1 : WS_WD2)), T, DFF, (r == 2) ? xcur : lptr(p.out), lptr(p.out), 0.5f); return; }
    if (r == 19) { rms_rows_bf16(lptr(p.out), p.in[zz() + 26] + l * D, hbuf, T); return; }
    const int slab = (r - 3) >> 3, q = (r - 3) & 7;
    float* xs = lptr(p.out) + (size_t)slab * TS * D;
    switch (q) {
    case 0: rms_rows_bf16(xs, p.in[zz() + 5] + l * D, hslab, TS); break;
    case 1: PHON(4) ph_gemm_proj(lds, hslab, (const bf16_t*)(ws + WS_WIN), proj, AB); break;
    case 2:
        PHON(7) for (int t = c; t < TS / 64; t += G) lru_tile(lds, p, l, proj, nullptr, waxt, Aend, Hend, carry, t, 0);
        break;
    case 3:
        PHON(8) for (int it = c; it < (TS / 64) * 4; it += G) gdn_prep(lds, p, l, proj, AB, (bf16_t*)(ws + WS_GDQ), (bf16_t*)(ws + WS_GDK), (bf16_t*)(ws + WS_GDU), (bf16_t*)(ws + WS_GDW), (bf16_t*)(ws + WS_GDA), edec, it);
        lru_carry(Aend, Hend, carry);
        break;
    case 4:
        PHON(9) if (c < 128 || G < 256) { for (int ch = c; ch < 128; ch += G) gdn_scan(lds, ws, oraw, edec, ch); }
        if (G >= 256) {
            if (c >= 128) {
                const int cc = c - 128, GG = G - 128;
                PHON(10) for (int t = cc; t < TS / 128; t += GG) lru_tile(lds, p, l, proj, ys + (size_t)TS * 512, waxt, Aend, Hend, carry, t, 1);
                PHON(5) for (int t = cc; t < (TS / 128) * 4; t += GG) sgu_tile(lds, p, l, proj, ys, t);
                PHON(6) for (int t = cc; t < TS / 64; t += GG) pool_tile(lds, p, l, proj, ys + (size_t)3 * TS * 512, halo, pwt, t);
            }
        } else {
            for (int t = c; t < TS / 64; t += G) lru_tile(lds, p, l, proj, ys + (size_t)TS * 512, waxt, Aend, Hend, carry, t, 1);
            for (int t = c; t < (TS / 128) * 4; t += G) sgu_tile(lds, p, l, proj, ys, t);
            for (int t = c; t < TS / 64; t += G) pool_tile(lds, p, l, proj, ys + (size_t)3 * TS * 512, halo, pwt, t);
        }
        break;
    case 5: if (G >= 256) { for (int t = TS / 128 + c; t < TS / 64; t += G) lru_tile(lds, p, l, proj, ys + (size_t)TS * 512, waxt, Aend, Hend, carry, t, 1); }
        PHON(11) gdn_out(p, l, oraw, proj, ys + (size_t)2 * TS * 512); break;
    case 6: PHON(12) ph_gemm_branch(lds, ys, (const bf16_t*)(ws + WS_WB), proj, merged); break;
    default: PHON(13) ph_gemm_resid(lds, merged, (const bf16_t*)(ws + WS_WOUT), TS, D, xs, xs, 1.0f); break;
    }
}

extern __shared__ __attribute__((aligned(16))) unsigned char smem_dyn[];

#ifndef DUP_TYPE
#define DUP_TYPE -1
#endif
__device__ __forceinline__ int phase_type(int ph) {
    if (ph == N_PHASES - 1) return 12;
    const int r = ph % PH_PER_LAYER;
    if (r == 0) return 0; if (r == 1 || r == 20) return 1; if (r == 2 || r == 21) return 2; if (r == 19) return 11;
    const int q = (r - 3) & 7;
    return 3 + q;
}
__global__ void __launch_bounds__(NTHR) fwd_megakernel(Params p) {
    cg::grid_group grid = cg::this_grid();
    LAS unsigned char* lds = (LAS unsigned char*)smem_dyn;
    volatile LAS unsigned* st = (volatile LAS unsigned*)(lds + LDS_BYTES - 16);
    if (threadIdx.x == 0) { st[0] = 0u; st[1] = 0u; }
    __syncthreads();
    const XcdBarrier xb = xcd_barrier_post((unsigned*)(p.ws + WS_BAR), st);
    grid.sync();
    for (int ph = p.ph_lo; ph < p.ph_hi; ++ph) {
        if (ph > p.ph_lo) xcd_barrier(xb);
        run_phase(lds, p, ph);
#if DUP_TYPE == 6
        if (phase_type(ph) == 6) { xcd_barrier(xb); run_phase(lds, p, ph - 2); xcd_barrier(xb); run_phase(lds, p, ph - 1); xcd_barrier(xb); run_phase(lds, p, ph); }
#elif DUP_TYPE >= 0
        if (phase_type(ph) == DUP_TYPE) { xcd_barrier(xb); run_phase(lds, p, ph); }
#endif
    }
}

extern "C" void kernel_launch(void* const* d_in, const int* in_sizes, int n_in, void* d_out, int out_size, void* d_ws, size_t ws_size, hipStream_t stream) {
    static int grid_blocks = 0;
    if (grid_blocks == 0) {
        if (n_in != 31 || out_size != T * D || ws_size < WS_END) { fprintf(stderr, "kernel_launch: unexpected shapes (n_in %d out %d ws %zu need %zu)\n", n_in, out_size, ws_size, (size_t)WS_END); grid_blocks = -1; return; }
        int dev = 0, cus = 0, per_cu = 0;
        hipGetDevice(&dev);
        hipDeviceGetAttribute(&cus, hipDeviceAttributeMultiprocessorCount, dev);
        if (hipFuncSetAttribute((const void*)fwd_megakernel, hipFuncAttributeMaxDynamicSharedMemorySize, LDS_BYTES) != hipSuccess) { fprintf(stderr, "kernel_launch: hipFuncSetAttribute failed\n"); grid_blocks = -1; return; }
        hipOccupancyMaxActiveBlocksPerMultiprocessor(&per_cu, (const void*)fwd_megakernel, NTHR, LDS_BYTES);
        if (per_cu < 1) { fprintf(stderr, "kernel_launch: occupancy query returned %d\n", per_cu); per_cu = 1; }
        grid_blocks = cus * per_cu;
    }
    if (grid_blocks < 0) return;
    Params p{};
    for (int i = 0; i < 31; ++i) p.in[i] = (const float*)d_in[i];
    p.out = (float*)d_out; p.ws = (unsigned char*)d_ws;
    hipMemsetAsync((unsigned char*)d_ws + WS_BAR, 0, 16384, stream);
    p.ph_lo = 0; p.ph_hi = N_PHASES;
    void* args[] = {&p};
    hipError_t e = hipLaunchCooperativeKernel((const void*)fwd_megakernel, dim3(grid_blocks), dim3(NTHR), args, LDS_BYTES, stream);
    if (e != hipSuccess) fprintf(stderr, "cooperative launch failed: %s (grid %d)\n", hipGetErrorString(e), grid_blocks);
}
```

```cpp
#include <hip/hip_runtime.h>
#include <hip/hip_cooperative_groups.h>
#include <cstdio>
namespace cg = cooperative_groups;

#ifndef MULTI_LAUNCH
#define MULTI_LAUNCH 0
#endif

#ifndef PH_MASK
#define PH_MASK 0xFFFFF
#endif
#define PHON(k) if constexpr ((PH_MASK >> (k)) & 1)
#define LAS __attribute__((address_space(3)))
typedef unsigned short bf16_t;
typedef short bf16x8 __attribute__((ext_vector_type(8)));
typedef short bf16x4 __attribute__((ext_vector_type(4)));
typedef float f32x4 __attribute__((ext_vector_type(4)));
typedef unsigned u32x4 __attribute__((ext_vector_type(4)));
typedef unsigned u32x2 __attribute__((ext_vector_type(2)));

constexpr int T = 32768, D = 1024, DFF = 2816, NSLAB = 2, TS = T / NSLAB, SEQ = 4096, PW = 8960, PIN = 8712;
constexpr int PC_AU = 0, PC_AV = 512, PC_BX = 1024, PC_BG = 1536, PC_CQ = 2048, PC_CK = 2560, PC_CV = 3072, PC_CZ = 3584, PC_DX = 4096, PC_GATE = 4608, PC_AB = 8704;
constexpr float EPS = 1e-6f;
constexpr int NTHR = 512;
constexpr int LDS_BYTES = 147456;

constexpr size_t WS_WGU1 = 0;
constexpr size_t WS_WD1 = WS_WGU1 + (size_t)5632 * 1024 * 2;
constexpr size_t WS_WIN = WS_WD1 + (size_t)1024 * 2816 * 2;
constexpr size_t WS_WB = WS_WIN + (size_t)PW * 1024 * 2;
constexpr size_t WS_WOUT = WS_WB + (size_t)4 * 1024 * 512 * 2;
constexpr size_t WS_WGU2 = WS_WOUT + (size_t)1024 * 1024 * 2;
constexpr size_t WS_WD2 = WS_WGU2 + (size_t)5632 * 1024 * 2;
constexpr size_t WS_WAXT = WS_WD2 + (size_t)1024 * 2816 * 2;
constexpr size_t WS_PWT = WS_WAXT + 131072;
constexpr size_t WS_PROJ = WS_PWT + 131072;
constexpr size_t WS_H = WS_PROJ + (size_t)TS * PW * 2;
constexpr size_t WS_YS = WS_H + (size_t)T * D * 2;
constexpr size_t WS_AB = WS_YS + (size_t)4 * TS * 512 * 2;
constexpr size_t WS_HALO = WS_AB + (size_t)TS * 8 * 4;
constexpr size_t WS_AEND = WS_HALO + (size_t)(TS / 64) * 3 * 1536 * 2;
constexpr size_t WS_HEND = WS_AEND + (size_t)(TS / 64) * 512 * 4;
constexpr size_t WS_CARRY = WS_HEND + (size_t)(TS / 64) * 512 * 4;
constexpr size_t WS_EDEC = WS_CARRY + (size_t)(TS / 64) * 512 * 4;
constexpr size_t WS_BAR = WS_EDEC + 4096;
constexpr size_t WS_GDQ = WS_H + (size_t)TS * D * 2;
constexpr size_t WS_GDK = WS_GDQ + (size_t)TS * 512 * 2;
constexpr size_t WS_GDU = WS_BAR + 16384;
constexpr size_t WS_GDW = WS_GDU + (size_t)TS * 512 * 2;
constexpr size_t WS_GDA = WS_GDW + (size_t)TS * 512 * 2;
constexpr size_t WS_END = WS_GDA + (size_t)TS * 256 * 2;
static_assert(WS_END <= (size_t)512 * 1024 * 1024, "workspace budget");

struct Params { const float* in[31]; float* out; unsigned char* ws; int ph_lo, ph_hi; };

__device__ __forceinline__ int ltid() { int t = threadIdx.x; asm volatile("" : "+v"(t)); return t; }
__device__ __forceinline__ int lbid() { int t = blockIdx.x; asm volatile("" : "+s"(t)); return t; }
__device__ __forceinline__ int lgdim() { int t = gridDim.x; asm volatile("" : "+s"(t)); return t; }
__device__ __forceinline__ int zz() { int z; asm volatile("s_mov_b32 %0, 0" : "=s"(z)); return z; }
template <class P> __device__ __forceinline__ P* lptr(P* q) { asm volatile("" : "+s"(q)); return q; }
__device__ __forceinline__ float bf2f(unsigned short b) { return __uint_as_float(((unsigned)b) << 16); }
__device__ __forceinline__ unsigned cvt_pk_bf16(float lo, float hi) { unsigned r; asm("v_cvt_pk_bf16_f32 %0, %1, %2" : "=v"(r) : "v"(lo), "v"(hi)); return r; }
__device__ __forceinline__ unsigned short f2bf(float f) { return (unsigned short)(cvt_pk_bf16(f, 0.f) & 0xffffu); }
__device__ __forceinline__ float lo_bf(unsigned w) { return __uint_as_float(w << 16); }
__device__ __forceinline__ float hi_bf(unsigned w) { return __uint_as_float(w & 0xffff0000u); }
__device__ __forceinline__ float sigmoidf_(float x) { return __builtin_amdgcn_rcpf(1.0f + __expf(-x)); }
__device__ __forceinline__ float siluf_(float x) { return x * __builtin_amdgcn_rcpf(1.0f + __expf(-x)); }
__device__ __forceinline__ float geluf_(float x) { const float u = 1.5957691216057308f * (x + 0.044715f * x * x * x); return x * __builtin_amdgcn_rcpf(1.0f + __expf(-u)); }
__device__ __forceinline__ float softplusf_(float x) { return fmaxf(x, 0.f) + log1pf(__expf(-fabsf(x))); }
__device__ __forceinline__ float wave_sum(float v) {
#pragma unroll
    for (int o = 1; o < 64; o <<= 1) v += __shfl_xor(v, o);
    return v;
}


#define XB_TMO      128
#define XB_XCNT(j)  (256  + 64 * (j))
#define XB_XSUB(j)  (1280 + 64 * (j))
#define XB_XGEN(j)  (2304 + 64 * (j))
#define XB_TOP      3328
#define XB_TOPGEN   3392
#define XCD_BAR_WORDS 3456
#define XB_SPIN_CAP (1u << 22)
__device__ __forceinline__ unsigned xb_ld(unsigned* p)              { return __hip_atomic_load(p, __ATOMIC_RELAXED, __HIP_MEMORY_SCOPE_AGENT); }
__device__ __forceinline__ unsigned xb_add(unsigned* p, unsigned v) { return __hip_atomic_fetch_add(p, v, __ATOMIC_RELAXED, __HIP_MEMORY_SCOPE_AGENT); }
__device__ __forceinline__ unsigned xb_xcc_id() { return (unsigned)__builtin_amdgcn_s_getreg((3 << 11) | 20) & 0xFu; }
#define XB_SPIN(cond, bar) do { unsigned _sp = 0; while (cond) { __builtin_amdgcn_s_sleep(1); \
    if ((++_sp & 255u) == 0u) { if (xb_ld(&(bar)[XB_TMO])) break; if (_sp > XB_SPIN_CAP) { atomicAdd(&(bar)[XB_TMO], 1u); break; } } } } while (0)
struct XcdBarrier { unsigned* bar; unsigned x; volatile LAS unsigned* st; };
__device__ __forceinline__ XcdBarrier xcd_barrier_post(unsigned* bar, volatile LAS unsigned* st) {
    XcdBarrier b; b.bar = bar; b.x = xb_xcc_id(); b.st = st;
    if (threadIdx.x == 0) (void)xb_add(&bar[XB_XCNT(b.x)], 1u);
    return b;
}
__device__ __forceinline__ void xcd_barrier_complete(unsigned* bar, unsigned x, unsigned& nloc, unsigned& nx) {
    const unsigned G = gridDim.x * gridDim.y * gridDim.z;
    unsigned sum, cnt, mine, sp = 0u;
    for (;;) {
        sum = 0u; cnt = 0u; mine = 0u;
#pragma unroll
        for (unsigned j = 0; j < 16; ++j) { const unsigned c = xb_ld(&bar[XB_XCNT(j)]); sum += c; cnt += (c > 0u) ? 1u : 0u; mine = (j == x) ? c : mine; }
        if (sum == G) break;
        __builtin_amdgcn_s_sleep(1);
        if ((++sp & 255u) == 0u) { if (xb_ld(&bar[XB_TMO])) break; if (sp > XB_SPIN_CAP) { atomicAdd(&bar[XB_TMO], 1u); break; } }
    }
    nloc = mine > 0u ? mine : 1u; nx = cnt > 0u ? cnt : 1u;
}
__device__ __forceinline__ void xcd_barrier(const XcdBarrier& b) {
    asm volatile("s_waitcnt vmcnt(0)" ::: "memory");
    __syncthreads();
    if (threadIdx.x == 0) {
        unsigned* bar = b.bar;
        __builtin_amdgcn_s_waitcnt(0);
        unsigned nloc = b.st[0], nx = b.st[1];
        if (nloc == 0u) { xcd_barrier_complete(bar, b.x, nloc, nx); b.st[0] = nloc; b.st[1] = nx; }
        const unsigned old = xb_add(&bar[XB_XSUB(b.x)], 1u);
        const unsigned gen = old / nloc;
        if (old + 1u == (gen + 1u) * nloc) {
            __builtin_amdgcn_fence(__ATOMIC_RELEASE, "agent");
            asm volatile("s_waitcnt vmcnt(0)" ::: "memory");
            const unsigned og = xb_add(&bar[XB_TOP], 1u);
            const unsigned tg = og / nx;
            if (og + 1u == (tg + 1u) * nx) xb_add(&bar[XB_TOPGEN], 1u);
            else XB_SPIN(xb_ld(&bar[XB_TOPGEN]) == tg, bar);
            __builtin_amdgcn_fence(__ATOMIC_ACQUIRE, "agent");
            xb_add(&bar[XB_XGEN(b.x)], 1u);
            asm volatile("s_waitcnt vmcnt(0)" ::: "memory");
        } else {
            XB_SPIN(xb_ld(&bar[XB_XGEN(b.x)]) == gen, bar);
            __builtin_amdgcn_fence(__ATOMIC_ACQUIRE, "agent");
            asm volatile("s_waitcnt vmcnt(0)" ::: "memory");
        }
    }
    __syncthreads();
}

namespace pg8 {
constexpr int BM = 256, BK = 64, HALF = 128, HTB = HALF * BK * 2, STAGE_BYTES = 8 * HTB, NXCD = 8, WGM = 8;
__host__ __device__ __forceinline__ int lds_byte(int r, int c) { const int st = (r >> 4) * 2 + (c >> 5), rr = r & 15, cc = c & 31, ob = rr * 64 + cc * 2; return st * 1024 + (ob ^ (((ob >> 9) & 1) << 5)); }
__host__ __device__ __forceinline__ void stage_rc(int b, int& R, int& C) { const int st = b / 1024, sb = b % 1024, swz = sb ^ (((sb >> 9) & 1) << 5); R = (st >> 1) * 16 + swz / 64; C = (st & 1) * 32 + (swz % 64) / 2; }
__host__ __device__ __forceinline__ int perm32(int rho) { const int n = rho >> 4, i = rho & 15; return 8 * (i >> 2) + 4 * n + (i & 3); }

struct Unit { int pm, pn, g; };
struct Gemm { const bf16_t* A; const bf16_t* Bt; int M, N, K; size_t gsA, gsB; };

__device__ __forceinline__ void tile_of(int wgid, int nM, int nN, int nwg, Unit& u) {
    { const int q = nwg / NXCD, r = nwg % NXCD, xcd = wgid % NXCD, off = wgid / NXCD; wgid = (xcd < r ? xcd * (q + 1) : r * (q + 1) + (xcd - r) * q) + off; }
    const int nig = WGM * nN, gid = wgid / nig, fm = gid * WGM, gsz = (nM - fm) < WGM ? (nM - fm) : WGM;
    u.pm = fm + ((wgid % nig) % gsz); u.pn = (wgid % nig) / gsz;
}
struct StaticOrder {
    int nM, nN, nwg, G, c;
    __device__ void init(int M, int N, int G_, int c_) { nM = M / BM; nN = N / BM; nwg = nM * nN; G = G_; c = c_; }
    __device__ bool next(int i, Unit& u) const {
        const long L = (long)i * G + c; if (L >= nwg) return false;
        tile_of((int)L, nM, nN, nwg, u); u.g = 0; return true;
    }
};
struct BranchOrder {
    int nM, nN, nwg, G, c;
    __device__ void init(int M, int N, int G_, int c_) { nM = M / BM; nN = N / BM; nwg = nM * nN; G = G_; c = c_; }
    __device__ bool next(int i, Unit& u) const {
        const long L = (long)(i >> 2) * G + c; if (L >= nwg) return false;
        tile_of((int)L, nM, nN, nwg, u); u.g = i & 3; return true;
    }
};

struct EpiSwiGLU {
    static constexpr bool PERM = true;
    bf16_t* O;
    __device__ __forceinline__ bool keep(const Unit&) const { return false; }
    __device__ __forceinline__ void operator()(f32x4 (&acc)[2][2][4][2], const Unit& u, int wr, int wc, int fr, int fq) const {
        const int row0 = u.pm * BM + wr * 64 + fr, col0 = u.pn * 128 + wc * 32 + 8 * fq;
#pragma unroll
        for (int ai = 0; ai < 2; ++ai)
#pragma unroll
            for (int m = 0; m < 4; ++m) {
                bf16_t* rowp = O + (size_t)(row0 + ai * HALF + m * 16) * DFF + col0;
                float v[8];
#pragma unroll
                for (int n = 0; n < 2; ++n)
#pragma unroll
                    for (int j = 0; j < 4; ++j) v[n * 4 + j] = siluf_(acc[ai][0][m][n][j]) * acc[ai][1][m][n][j];
                u32x4 w; w.x = cvt_pk_bf16(v[0], v[1]); w.y = cvt_pk_bf16(v[2], v[3]); w.z = cvt_pk_bf16(v[4], v[5]); w.w = cvt_pk_bf16(v[6], v[7]);
                *(u32x4*)rowp = w;
                __builtin_amdgcn_sched_barrier(0);
            }
    }
};
struct EpiResid {
    static constexpr bool PERM = false;
    const float* Xin; float* Xout; float scale;
    __device__ __forceinline__ bool keep(const Unit&) const { return false; }
    __device__ __forceinline__ void operator()(f32x4 (&acc)[2][2][4][2], const Unit& u, int wr, int wc, int fr, int fq) const {
        const int row0 = u.pm * BM + wr * 64 + fr, col0 = u.pn * BM + wc * 32 + 4 * fq;
#pragma unroll
        for (int ai = 0; ai < 2; ++ai)
#pragma unroll
            for (int m = 0; m < 4; ++m) {
                const size_t ro = (size_t)(row0 + ai * HALF + m * 16) * D + col0;
#pragma unroll
                for (int bj = 0; bj < 2; ++bj)
#pragma unroll
                    for (int n = 0; n < 2; ++n) { const f32x4 xi = *(const f32x4*)(Xin + ro + bj * HALF + n * 16); *(f32x4*)(Xout + ro + bj * HALF + n * 16) = xi + acc[ai][bj][m][n] * scale; }
                __builtin_amdgcn_sched_barrier(0);
            }
    }
};
struct EpiProj {
    static constexpr bool PERM = true;
    bf16_t* O; float* AB;
    __device__ __forceinline__ bool keep(const Unit&) const { return false; }
    __device__ __forceinline__ void operator()(f32x4 (&acc)[2][2][4][2], const Unit& u, int wr, int wc, int fr, int fq) const {
        const int row0 = u.pm * BM + wr * 64 + fr, col0 = u.pn * BM + wc * 32 + 8 * fq;
        const bool ab = (u.pn == PC_AB / BM) && wc == 0 && fq == 0;
#pragma unroll
        for (int ai = 0; ai < 2; ++ai)
#pragma unroll
            for (int m = 0; m < 4; ++m) {
                const int row = row0 + ai * HALF + m * 16;
                bf16_t* rowp = O + (size_t)row * PW + col0;
#pragma unroll
                for (int bj = 0; bj < 2; ++bj) {
                    const f32x4 v0 = acc[ai][bj][m][0], v1 = acc[ai][bj][m][1];
                    u32x4 w; w.x = cvt_pk_bf16(v0[0], v0[1]); w.y = cvt_pk_bf16(v0[2], v0[3]); w.z = cvt_pk_bf16(v1[0], v1[1]); w.w = cvt_pk_bf16(v1[2], v1[3]);
                    *(u32x4*)(rowp + bj * HALF) = w;
                }
                __builtin_amdgcn_sched_barrier(0);
            }
        if (ab) {
#pragma unroll
            for (int ai = 0; ai < 2; ++ai)
#pragma unroll
                for (int m = 0; m < 4; ++m) { const int row = row0 + ai * HALF + m * 16; *(f32x4*)(AB + (size_t)row * 8) = acc[ai][0][m][0]; *(f32x4*)(AB + (size_t)row * 8 + 4) = acc[ai][0][m][1]; }
        }
    }
};
struct EpiBranch {
    static constexpr bool PERM = true;
    const bf16_t* P; bf16_t* O;
    __device__ __forceinline__ bool keep(const Unit& u) const { return u.g < 3; }
    __device__ __forceinline__ void operator()(f32x4 (&acc)[2][2][4][2], const Unit& u, int wr, int wc, int fr, int fq) const {
        const int row0 = u.pm * BM + wr * 64 + fr, col0 = u.pn * BM + wc * 32 + 8 * fq;
        const bool last = (u.g == 3);
#pragma unroll
        for (int ai = 0; ai < 2; ++ai)
#pragma unroll
            for (int m = 0; m < 4; ++m) {
                const int row = row0 + ai * HALF + m * 16;
                const bf16_t* gp = P + (size_t)row * PW + PC_GATE + u.g * D + col0;
#pragma unroll
                for (int bj = 0; bj < 2; ++bj) {
                    const u32x4 g0 = *(const u32x4*)(gp + bj * HALF);
                    float f[8];
                    if (!last) {
                        const u32x4 g1 = *(const u32x4*)(gp + D + bj * HALF);
#pragma unroll
                        for (int q = 0; q < 4; ++q) {
                            f[2 * q] = (1.0f + __expf(-lo_bf(g1[q]))) * __builtin_amdgcn_rcpf(1.0f + __expf(-lo_bf(g0[q])));
                            f[2 * q + 1] = (1.0f + __expf(-hi_bf(g1[q]))) * __builtin_amdgcn_rcpf(1.0f + __expf(-hi_bf(g0[q])));
                        }
                    } else {
#pragma unroll
                        for (int q = 0; q < 4; ++q) { f[2 * q] = __builtin_amdgcn_rcpf(1.0f + __expf(-lo_bf(g0[q]))); f[2 * q + 1] = __builtin_amdgcn_rcpf(1.0f + __expf(-hi_bf(g0[q]))); }
                    }
#pragma unroll
                    for (int n = 0; n < 2; ++n)
#pragma unroll
                        for (int j = 0; j < 4; ++j) acc[ai][bj][m][n][j] *= f[n * 4 + j];
                    if (last) {
                        const f32x4 v0 = acc[ai][bj][m][0], v1 = acc[ai][bj][m][1];
                        u32x4 w; w.x = cvt_pk_bf16(v0[0], v0[1]); w.y = cvt_pk_bf16(v0[2], v0[3]); w.z = cvt_pk_bf16(v1[0], v1[1]); w.w = cvt_pk_bf16(v1[2], v1[3]);
                        *(u32x4*)(O + (size_t)row * D + col0 + bj * HALF) = w;
                    }
                    __builtin_amdgcn_sched_barrier(0);
                }
            }
    }
};

template <class Epi, class Sched>
__device__ __forceinline__ void gemm_phase(LAS unsigned char* lds, const Gemm g, const Sched& S, const Epi& E) {
    const int tid = ltid(), wid = __builtin_amdgcn_readfirstlane(tid >> 6), lane = tid & 63, wr = wid >> 2, wc = wid & 3, fr = lane & 15, fq = lane >> 4;
    const int K = g.K, nt = K / BK;
    unsigned voffA[2], voffB[2];
#pragma unroll
    for (int i = 0; i < 2; ++i) { int R, C; stage_rc(tid * 16 + i * 8192, R, C); const int Rb = Epi::PERM ? ((R & ~31) + perm32(R & 31)) : R;
        voffA[i] = (unsigned)(R * K + C) * 2u; voffB[i] = (unsigned)(Rb * K + C) * 2u; }
    const size_t kstep = (size_t)(BK * 2);
    const size_t hstep = (size_t)HALF * K * 2;
    const size_t tstep = 2 * hstep;
    const unsigned ldsw = (unsigned)wid * 1024u;
    const int aoff = lds_byte(wr * 64 + fr, fq * 8), boff = lds_byte(wc * 32 + fr, fq * 8);
#define PG8_SA(b, h) (((b) * 2 + (h)) * HTB)
#define PG8_SB(b, h) ((4 + (b) * 2 + (h)) * HTB)
#define PG8_STAGE(bufoff, gbase, voff) do { _Pragma("unroll") for (int _i = 0; _i < 2; ++_i) \
        __builtin_amdgcn_global_load_lds((const unsigned*)((const char*)(gbase) + (voff)[_i]), (LAS unsigned*)(lds + (bufoff) + ldsw + _i * 8192), 16, 0, 0); } while (0)
#define PG8_LDA(dst, b, h) do { _Pragma("unroll") for (int m = 0; m < 4; ++m) _Pragma("unroll") for (int k = 0; k < 2; ++k) dst[m][k] = *(const LAS bf16x8*)(lds + PG8_SA(b, h) + aoff + m * 2048 + k * 1024); } while (0)
#define PG8_LDB(dst, b, h) do { _Pragma("unroll") for (int n = 0; n < 2; ++n) _Pragma("unroll") for (int k = 0; k < 2; ++k) dst[n][k] = *(const LAS bf16x8*)(lds + PG8_SB(b, h) + boff + n * 2048 + k * 1024); } while (0)
#define PG8_MMA(ai, bj, At, Bt) do { __builtin_amdgcn_s_setprio(1); _Pragma("unroll") for (int m = 0; m < 4; ++m) _Pragma("unroll") for (int n = 0; n < 2; ++n) _Pragma("unroll") for (int k = 0; k < 2; ++k) \
        acc[ai][bj][m][n] = __builtin_amdgcn_mfma_f32_16x16x32_bf16(Bt[n][k], At[m][k], acc[ai][bj][m][n], 0, 0, 0); __builtin_amdgcn_s_setprio(0); } while (0)
#define PG8_WAIT_V(n) asm volatile("s_waitcnt vmcnt(" #n ")" ::: "memory")
#define PG8_WAIT_L(n) asm volatile("s_waitcnt lgkmcnt(" #n ")" ::: "memory")
#define PG8_BAR __builtin_amdgcn_s_barrier()
#define PG8_SCHED __builtin_amdgcn_sched_barrier(0)
    Unit cur, nxt; int ui = 0;
    if (!S.next(0, cur)) return;
    f32x4 acc[2][2][4][2];
#pragma unroll
    for (int a = 0; a < 2; ++a)
#pragma unroll
        for (int b = 0; b < 2; ++b)
#pragma unroll
            for (int m = 0; m < 4; ++m)
#pragma unroll
                for (int n = 0; n < 2; ++n) acc[a][b][m][n] = (f32x4){0.f, 0.f, 0.f, 0.f};
    bf16x8 At[4][2], B0[2][2], B1[2][2];
    const char* cA = (const char*)g.A + (size_t)cur.g * g.gsA + (size_t)cur.pm * tstep; const char* cB = (const char*)g.Bt + (size_t)cur.g * g.gsB + (size_t)cur.pn * tstep;
    PG8_STAGE(PG8_SB(0, 0), cB, voffB); PG8_STAGE(PG8_SA(0, 0), cA, voffA); PG8_STAGE(PG8_SB(0, 1), cB + hstep, voffB); PG8_STAGE(PG8_SA(0, 1), cA + hstep, voffA);
    if (wr == 1) PG8_BAR;
    PG8_WAIT_V(4); PG8_BAR;
    PG8_STAGE(PG8_SB(1, 0), cB + kstep, voffB); PG8_STAGE(PG8_SA(1, 0), cA + kstep, voffA); PG8_STAGE(PG8_SB(1, 1), cB + hstep + kstep, voffB);
    PG8_WAIT_V(6); PG8_BAR;
    for (;;) {
        const bool has_next = S.next(ui + 1, nxt);
        const char* nA = has_next ? (const char*)g.A + (size_t)nxt.g * g.gsA + (size_t)nxt.pm * tstep : cA; const char* nB = has_next ? (const char*)g.Bt + (size_t)nxt.g * g.gsB + (size_t)nxt.pn * tstep : cB;
        for (int t = 0; t < nt; t += 2) {
            const bool last = (t == nt - 2);
            const char* a1 = cA + (size_t)(t + 1) * kstep;
            const char* a2 = last ? nA : cA + (size_t)(t + 2) * kstep; const char* b2 = last ? nB : cB + (size_t)(t + 2) * kstep;
            const char* a3 = a2 + kstep; const char* b3 = b2 + kstep;
            PG8_LDB(B0, 0, 0); PG8_SCHED; PG8_LDA(At, 0, 0); PG8_STAGE(PG8_SA(1, 1), a1 + hstep, voffA);
            PG8_WAIT_L(8); PG8_BAR; PG8_WAIT_L(0); PG8_MMA(0, 0, At, B0); PG8_BAR; PG8_SCHED;
            PG8_LDB(B1, 0, 1); PG8_STAGE(PG8_SB(0, 0), b2, voffB);
            PG8_BAR; PG8_WAIT_L(0); PG8_MMA(0, 1, At, B1); PG8_BAR;
            PG8_LDA(At, 0, 1); PG8_STAGE(PG8_SA(0, 0), a2, voffA);
            PG8_BAR; PG8_WAIT_L(0); PG8_MMA(1, 0, At, B0); PG8_BAR; PG8_SCHED;
            PG8_STAGE(PG8_SB(0, 1), b2 + hstep, voffB);
            PG8_WAIT_V(6); PG8_BAR; PG8_MMA(1, 1, At, B1); PG8_BAR;
            PG8_LDB(B0, 1, 0); PG8_SCHED; PG8_LDA(At, 1, 0); PG8_STAGE(PG8_SA(0, 1), a2 + hstep, voffA);
            PG8_WAIT_L(8); PG8_BAR; PG8_WAIT_L(0); PG8_MMA(0, 0, At, B0); PG8_BAR; PG8_SCHED;
            PG8_LDB(B1, 1, 1); PG8_STAGE(PG8_SB(1, 0), b3, voffB);
            PG8_BAR; PG8_WAIT_L(0); PG8_MMA(0, 1, At, B1); PG8_BAR;
            PG8_LDA(At, 1, 1); PG8_STAGE(PG8_SA(1, 0), a3, voffA);
            PG8_BAR; PG8_WAIT_L(0); PG8_MMA(1, 0, At, B0); PG8_BAR; PG8_SCHED;
            PG8_STAGE(PG8_SB(1, 1), b3 + hstep, voffB);
            PG8_WAIT_V(6); PG8_BAR; PG8_MMA(1, 1, At, B1); PG8_BAR;
        }
        E(acc, cur, wr, wc, fr, fq);
        if (!has_next) break;
        if (!E.keep(cur)) {
#pragma unroll
            for (int a = 0; a < 2; ++a)
#pragma unroll
                for (int b = 0; b < 2; ++b)
#pragma unroll
                    for (int m = 0; m < 4; ++m)
#pragma unroll
                        for (int n = 0; n < 2; ++n) acc[a][b][m][n] = (f32x4){0.f, 0.f, 0.f, 0.f};
        }
        cur = nxt; cA = nA; cB = nB; ++ui;
    }
    PG8_WAIT_V(0);
    if (wr == 0) PG8_BAR;
    PG8_BAR;
#undef PG8_SA
#undef PG8_SB
#undef PG8_STAGE
#undef PG8_LDA
#undef PG8_LDB
#undef PG8_MMA
#undef PG8_WAIT_V
#undef PG8_WAIT_L
#undef PG8_BAR
#undef PG8_SCHED
}
}


#define NOINL __forceinline__
__device__ NOINL void ph_gemm_swiglu(LAS unsigned char* lds, const bf16_t* A, const bf16_t* Bt, bf16_t* O) {
    pg8::Gemm g{A, Bt, T, 2 * DFF, D, 0, 0}; pg8::StaticOrder S; S.init(g.M, g.N, lgdim(), lbid()); pg8::EpiSwiGLU E{O}; pg8::gemm_phase(lds, g, S, E);
}
__device__ NOINL void ph_gemm_resid(LAS unsigned char* lds, const bf16_t* A, const bf16_t* Bt, int M, int K, const float* Xin, float* Xout, float scale) {
    pg8::Gemm g{A, Bt, M, D, K, 0, 0}; pg8::StaticOrder S; S.init(g.M, g.N, lgdim(), lbid()); pg8::EpiResid E{Xin, Xout, scale}; pg8::gemm_phase(lds, g, S, E);
}
__device__ NOINL void ph_gemm_proj(LAS unsigned char* lds, const bf16_t* A, const bf16_t* Bt, bf16_t* O, float* AB) {
    pg8::Gemm g{A, Bt, TS, PW, D, 0, 0}; pg8::StaticOrder S; S.init(g.M, g.N, lgdim(), lbid()); pg8::EpiProj E{O, AB}; pg8::gemm_phase(lds, g, S, E);
}
__device__ NOINL void ph_gemm_branch(LAS unsigned char* lds, const bf16_t* A, const bf16_t* Bt, const bf16_t* P, bf16_t* O) {
    pg8::Gemm g{A, Bt, TS, D, 512, (size_t)TS * 512 * 2, (size_t)D * 512 * 2}; pg8::BranchOrder S; S.init(g.M, g.N, lgdim(), lbid()); pg8::EpiBranch E{P, O}; pg8::gemm_phase(lds, g, S, E);
}

__device__ __forceinline__ void conv_tile(LAS float* scr, const float* src0, const float* src1, int K, int Nsrc, bf16_t* dst, int mode, int tile) {
    const int nkt = K / 64, kt = tile % nkt, rt = tile / nkt, k0 = kt * 64, r0 = rt * 64, tid = ltid();
    {
        const int kk = tid >> 3, rr = (tid & 7) * 8, rho = r0 + rr;
        const float* src = src0; int col = rho;
        if (mode == 1) { const int pn = rho >> 8, bj = (rho >> 7) & 1, j = rho & 127; col = pn * 128 + j; src = bj ? src1 : src0; }
        else if (mode == 2) { col = rho < 4096 ? rho : (rho < 8704 ? rho + 8 : (rho < 8712 ? rho - 8704 + 4096 : -1)); }
        f32x4 a = (f32x4){0.f, 0.f, 0.f, 0.f}, b = a;
        if (col >= 0) { const float* sp = src + (size_t)(k0 + kk) * Nsrc + col; a = *(const f32x4*)sp; b = *(const f32x4*)(sp + 4); }
#pragma unroll
        for (int e = 0; e < 4; ++e) { scr[(rr + e) * 65 + kk] = a[e]; scr[(rr + 4 + e) * 65 + kk] = b[e]; }
    }
    __syncthreads();
    {
        const int rl = tid >> 3, kc = (tid & 7) * 8;
        const LAS float* s = scr + rl * 65 + kc;
        u32x4 w; w.x = cvt_pk_bf16(s[0], s[1]); w.y = cvt_pk_bf16(s[2], s[3]); w.z = cvt_pk_bf16(s[4], s[5]); w.w = cvt_pk_bf16(s[6], s[7]);
        *(u32x4*)(dst + (size_t)(r0 + rl) * K + k0 + kc) = w;
    }
    __syncthreads();
}

__device__ __forceinline__ void convert_layer(LAS unsigned char* lds, const Params& p, int l) {
    LAS float* scr = (LAS float*)lds;
    unsigned char* ws = lptr(p.ws);
    constexpr int N1 = 16 * 88, N2 = 44 * 16, N3 = 16 * 140, N4 = 8 * 16, N5 = 16 * 16;
    constexpr int TOT = N1 + N2 + N3 + 4 * N4 + N5 + N1 + N2;
    for (int it = lbid(); it < TOT; it += lgdim()) {
        int r = it;
        if (r < N1) { conv_tile(scr, p.in[zz() + 2] + (size_t)l * D * DFF, p.in[zz() + 3] + (size_t)l * D * DFF, D, DFF, (bf16_t*)(ws + WS_WGU1), 1, r); continue; } r -= N1;
        if (r < N2) { conv_tile(scr, p.in[zz() + 4] + (size_t)l * DFF * D, nullptr, DFF, D, (bf16_t*)(ws + WS_WD1), 0, r); continue; } r -= N2;
        if (r < N3) { conv_tile(scr, p.in[zz() + 6] + (size_t)l * D * PIN, nullptr, D, PIN, (bf16_t*)(ws + WS_WIN), 2, r); continue; } r -= N3;
        if (r < 4 * N4) { const int g = r / N4; conv_tile(scr, p.in[zz() + 24] + ((size_t)l * 4 + g) * 512 * D, nullptr, 512, D, (bf16_t*)(ws + WS_WB) + (size_t)g * D * 512, 0, r % N4); continue; } r -= 4 * N4;
        if (r < N5) { conv_tile(scr, p.in[zz() + 25] + (size_t)l * D * D, nullptr, D, D, (bf16_t*)(ws + WS_WOUT), 0, r); continue; } r -= N5;
        if (r < N1) { conv_tile(scr, p.in[zz() + 27] + (size_t)l * D * DFF, p.in[zz() + 28] + (size_t)l * D * DFF, D, DFF, (bf16_t*)(ws + WS_WGU2), 1, r); continue; } r -= N1;
        conv_tile(scr, p.in[zz() + 29] + (size_t)l * DFF * D, nullptr, DFF, D, (bf16_t*)(ws + WS_WD2), 0, r);
    }
    bf16_t* waxt = (bf16_t*)(ws + WS_WAXT); bf16_t* pwt = (bf16_t*)(ws + WS_PWT);
    const float* wa = p.in[zz() + 13] + (size_t)l * 8 * 64 * 64; const float* wx = p.in[zz() + 15] + (size_t)l * 8 * 64 * 64; const float* pw = p.in[zz() + 22] + (size_t)l * 4 * 128 * 128;
    for (int e = lbid() * NTHR + ltid(); e < 65536; e += lgdim() * NTHR) {
        { const int h = e >> 13, jp = (e >> 6) & 127, i = e & 63; waxt[e] = f2bf(jp < 64 ? wa[(h * 64 + i) * 64 + jp] : wx[(h * 64 + i) * 64 + jp - 64]); }
        { const int g = e >> 14, d = (e >> 7) & 127, c = e & 127; pwt[e] = f2bf(pw[(g * 128 + c) * 128 + d]); }
    }
}

__device__ __forceinline__ void rms_rows_bf16(const float* X, const float* gain, bf16_t* H, int nrows) {
    const int wid = ltid() >> 6, lane = ltid() & 63;
    f32x4 gv[4];
#pragma unroll
    for (int j = 0; j < 4; ++j) gv[j] = *(const f32x4*)(gain + (lane + 64 * j) * 4);
    for (int row = lbid() * 8 + wid; row < nrows; row += lgdim() * 8) {
        const f32x4* xr = (const f32x4*)(X + (size_t)row * D) + lane;
        f32x4 v[4]; float s = 0.f;
#pragma unroll
        for (int j = 0; j < 4; ++j) { v[j] = xr[64 * j]; s += (v[j].x * v[j].x + v[j].y * v[j].y) + (v[j].z * v[j].z + v[j].w * v[j].w); }
        const float rs = rsqrtf(wave_sum(s) * (1.0f / D) + EPS);
        u32x2* o = (u32x2*)(H + (size_t)row * D) + lane;
#pragma unroll
        for (int j = 0; j < 4; ++j) { u32x2 w; w.x = cvt_pk_bf16(v[j].x * rs * gv[j].x, v[j].y * rs * gv[j].y); w.y = cvt_pk_bf16(v[j].z * rs * gv[j].z, v[j].w * rs * gv[j].w); o[64 * j] = w; }
    }
}
__device__ __forceinline__ void rms_rows_f32_inplace(float* X, const float* gain, int nrows) {
    const int wid = ltid() >> 6, lane = ltid() & 63;
    f32x4 gv[4];
#pragma unroll
    for (int j = 0; j < 4; ++j) gv[j] = *(const f32x4*)(gain + (lane + 64 * j) * 4);
    for (int row = lbid() * 8 + wid; row < nrows; row += lgdim() * 8) {
        f32x4* xr = (f32x4*)(X + (size_t)row * D) + lane;
        f32x4 v[4]; float s = 0.f;
#pragma unroll
        for (int j = 0; j < 4; ++j) { v[j] = xr[64 * j]; s += (v[j].x * v[j].x + v[j].y * v[j].y) + (v[j].z * v[j].z + v[j].w * v[j].w); }
        const float rs = rsqrtf(wave_sum(s) * (1.0f / D) + EPS);
#pragma unroll
        for (int j = 0; j < 4; ++j) xr[64 * j] = v[j] * rs * gv[j];
    }
}

__device__ __forceinline__ void sgu_tile(LAS unsigned char* lds, const Params& p, int l, const bf16_t* proj, bf16_t* ya, int tile) {
    const int tid = ltid(), wid = tid >> 6, lane = tid & 63, fr = lane & 15, fq = lane >> 4;
    const int blk = tile >> 2, g = tile & 3, r0 = blk * 128;
    LAS bf16_t* Wl = (LAS bf16_t*)lds;
    LAS bf16_t* VT = (LAS bf16_t*)(lds + 34816);
    const float* lng = p.in[zz() + 7] + l * 512 + g * 128; const float* lnb = p.in[zz() + 8] + l * 512 + g * 128;
    {
        const int i = tid >> 2, qd = tid & 3;
        const bf16_t* vrow = proj + (size_t)(r0 + i) * PW + PC_AV + qd * 8;
        float s = 0.f, s2 = 0.f;
#pragma unroll 4
        for (int e8 = 0; e8 < 16; ++e8) { const u32x4 w = *(const u32x4*)(vrow + e8 * 32);
#pragma unroll
            for (int q = 0; q < 4; ++q) { const float a = geluf_(lo_bf(w[q])), b = geluf_(hi_bf(w[q])); s += a + b; s2 += a * a + b * b; } }
        s += __shfl_xor(s, 1); s += __shfl_xor(s, 2); s2 += __shfl_xor(s2, 1); s2 += __shfl_xor(s2, 2);
        const float mean = s * (1.0f / 512.0f), var = fmaxf(s2 * (1.0f / 512.0f) - mean * mean, 0.f), rstd = rsqrtf(var + EPS);
        const bf16_t* vg = proj + (size_t)(r0 + i) * PW + PC_AV + g * 128 + qd * 8;
#pragma unroll
        for (int e8 = 0; e8 < 4; ++e8) { const u32x4 w = *(const u32x4*)(vg + e8 * 32);
#pragma unroll
            for (int q = 0; q < 4; ++q) { const int c = e8 * 32 + qd * 8 + 2 * q;
                VT[c * 136 + i] = f2bf((geluf_(lo_bf(w[q])) - mean) * rstd * lng[c] + lnb[c]);
                VT[(c + 1) * 136 + i] = f2bf((geluf_(hi_bf(w[q])) - mean) * rstd * lng[c + 1] + lnb[c + 1]); } }
        const float* wsrc = p.in[zz() + 9] + (((size_t)l * 4 + g) * 128 + i) * 128 + qd * 32;
#pragma unroll
        for (int e4 = 0; e4 < 8; ++e4) { f32x4 w = *(const f32x4*)(wsrc + e4 * 4); if (i < 64 && qd >= 2) w = (f32x4){0.f, 0.f, 0.f, 0.f};
            u32x2 o; o.x = cvt_pk_bf16(w.x, w.y); o.y = cvt_pk_bf16(w.z, w.w); *(LAS u32x2*)(Wl + i * 136 + qd * 32 + e4 * 4) = o; }
    }
    __syncthreads();
    f32x4 acc[8];
#pragma unroll
    for (int n = 0; n < 8; ++n) acc[n] = (f32x4){0.f, 0.f, 0.f, 0.f};
#pragma unroll
    for (int ks = 0; ks < 4; ++ks) {
        const bf16x8 af = *(const LAS bf16x8*)(Wl + (wid * 16 + fr) * 136 + ks * 32 + fq * 8);
#pragma unroll
        for (int n = 0; n < 8; ++n) { const bf16x8 bf = *(const LAS bf16x8*)(VT + (n * 16 + fr) * 136 + ks * 32 + fq * 8); acc[n] = __builtin_amdgcn_mfma_f32_16x16x32_bf16(bf, af, acc[n], 0, 0, 0); }
    }
    {
        const int i = wid * 16 + fr; const float bias = p.in[zz() + 10][((size_t)l * 4 + g) * 128 + i];
        const bf16_t* up = proj + (size_t)(r0 + i) * PW + PC_AU + g * 128 + fq * 4;
        bf16_t* yp = ya + (size_t)(r0 + i) * 512 + g * 128 + fq * 4;
#pragma unroll
        for (int n = 0; n < 8; ++n) { const u32x2 uw = *(const u32x2*)(up + n * 16);
            u32x2 o; o.x = cvt_pk_bf16((acc[n][0] + bias) * geluf_(lo_bf(uw.x)), (acc[n][1] + bias) * geluf_(hi_bf(uw.x)));
            o.y = cvt_pk_bf16((acc[n][2] + bias) * geluf_(lo_bf(uw.y)), (acc[n][3] + bias) * geluf_(hi_bf(uw.y))); *(u32x2*)(yp + n * 16) = o; }
    }
    __syncthreads();
}

template <int WIN>
__device__ __forceinline__ void pool_rows(LAS bf16_t* Al, const bf16_t* xcol, int c, int pos0) {
    float xv[80];
#pragma unroll
    for (int k = 0; k < 80; ++k) xv[k] = (pos0 - 16 + k >= 0) ? bf2f(xcol[(long)(k - 16) * PW]) : 0.f;
    float s = 0.f;
#pragma unroll
    for (int j = 0; j < WIN; ++j) s += xv[16 - j];
#pragma unroll
    for (int tt = 0; tt < 64; ++tt) {
        const int k = tt + 16;
        const int cnt = min(pos0 + tt + 1, WIN);
        Al[tt * 520 + c] = f2bf(s / (float)cnt - xv[k]);
        if (tt < 63) s += xv[k + 1] - xv[k + 1 - WIN];
    }
}
__device__ __forceinline__ void pool_tile(LAS unsigned char* lds, const Params& p, int l, const bf16_t* proj, bf16_t* yd, bf16_t* halo, const bf16_t* pwt, int tile) {
    const int tid = ltid(), wid = tid >> 6, lane = tid & 63, fr = lane & 15, fq = lane >> 4;
    const int t0 = tile * 64, pos0 = t0 % SEQ;
    LAS bf16_t* Al = (LAS bf16_t*)lds;
    {
        const int c = tid, g = wid >> 1;
        const bf16_t* xcol = proj + (size_t)t0 * PW + PC_DX + c;
        if (g == 0) pool_rows<2>(Al, xcol, c, pos0); else if (g == 1) pool_rows<4>(Al, xcol, c, pos0); else if (g == 2) pool_rows<8>(Al, xcol, c, pos0); else pool_rows<16>(Al, xcol, c, pos0);
    }
    __syncthreads();
    {
        const int g = wid >> 1, nh = wid & 1;
        f32x4 acc[4][4];
#pragma unroll
        for (int m = 0; m < 4; ++m)
#pragma unroll
            for (int n = 0; n < 4; ++n) acc[m][n] = (f32x4){0.f, 0.f, 0.f, 0.f};
#pragma unroll
        for (int ks = 0; ks < 4; ++ks) {
            bf16x8 bfr[4];
#pragma unroll
            for (int n = 0; n < 4; ++n) bfr[n] = *(const bf16x8*)(pwt + ((size_t)(g * 128 + (nh * 4 + n) * 16 + fr)) * 128 + ks * 32 + fq * 8);
#pragma unroll
            for (int m = 0; m < 4; ++m) { const bf16x8 af = *(const LAS bf16x8*)(Al + (m * 16 + fr) * 520 + g * 128 + ks * 32 + fq * 8);
#pragma unroll
                for (int n = 0; n < 4; ++n) acc[m][n] = __builtin_amdgcn_mfma_f32_16x16x32_bf16(bfr[n], af, acc[m][n], 0, 0, 0); }
        }
        const float* sc = p.in[zz() + 23] + l * 512 + g * 128;
#pragma unroll
        for (int n = 0; n < 4; ++n) { const int d = (nh * 4 + n) * 16 + fq * 4; const f32x4 s4 = *(const f32x4*)(sc + d);
#pragma unroll
            for (int m = 0; m < 4; ++m) { u32x2 o; o.x = cvt_pk_bf16(acc[m][n][0] * s4[0], acc[m][n][1] * s4[1]); o.y = cvt_pk_bf16(acc[m][n][2] * s4[2], acc[m][n][3] * s4[3]);
                *(u32x2*)(yd + (size_t)(t0 + m * 16 + fr) * 512 + g * 128 + d) = o; } }
    }
    __syncthreads();
}

__device__ __forceinline__ void lru_tile(LAS unsigned char* lds, const Params& p, int l, const bf16_t* proj, bf16_t* yb, const bf16_t* waxt, float* Aend, float* Hend, const float* carry, int tile, int mode) {
    const int tid = ltid(), wid = tid >> 6, lane = tid & 63, fr = lane & 15, fq = lane >> 4;
    const int t0 = tile * 64, pos0 = t0 % SEQ, c = wid * 64 + lane;
    LAS bf16_t* Aw = (LAS bf16_t*)(lds + wid * 10560);
    LAS float* Xw = (LAS float*)(lds + wid * 10560 + 2304);
    bf16x8 bfr[8][2];
#pragma unroll
    for (int n = 0; n < 8; ++n)
#pragma unroll
        for (int ks = 0; ks < 2; ++ks) bfr[n][ks] = *(const bf16x8*)(waxt + ((size_t)(wid * 128 + n * 16 + fr)) * 64 + ks * 32 + fq * 8);
    const float* cwp = p.in[zz() + 11] + (size_t)l * 4 * 512 + c;
    const float cw0 = cwp[0], cw1 = cwp[512], cw2 = cwp[1024], cw3 = cwp[1536], cb = p.in[zz() + 12][l * 512 + c];
    const float ba = p.in[zz() + 14][l * 512 + c], bx = p.in[zz() + 16][l * 512 + c], sp8 = 8.0f * softplusf_(-p.in[zz() + 17][l * 512 + c]);
    const bf16_t* xcol = proj + (size_t)t0 * PW + PC_BX + c;
    float xm3 = 0.f, xm2 = 0.f, xm1 = 0.f;
    if (pos0 > 0) { xm3 = bf2f(xcol[-3L * PW]); xm2 = bf2f(xcol[-2L * PW]); xm1 = bf2f(xcol[-1L * PW]); }
    const bf16_t* gcol = proj + (size_t)t0 * PW + PC_BG + c;
    bf16_t* ycol = yb + (size_t)t0 * 512 + c;
    float h = mode ? carry[(size_t)tile * 512 + c] : 0.f, Ap = 1.f;
    for (int sub = 0; sub < 4; ++sub) {
        float xc[16];
#pragma unroll
        for (int tt = 0; tt < 16; ++tt) { const float xin = bf2f(*xcol); xcol += PW; xc[tt] = cb + cw0 * xm3 + cw1 * xm2 + cw2 * xm1 + cw3 * xin; xm3 = xm2; xm2 = xm1; xm1 = xin; Aw[tt * 72 + lane] = f2bf(xc[tt]); }
        __syncthreads();
        f32x4 acc[8];
#pragma unroll
        for (int n = 0; n < 8; ++n) acc[n] = (f32x4){0.f, 0.f, 0.f, 0.f};
#pragma unroll
        for (int ks = 0; ks < 2; ++ks) { const bf16x8 af = *(const LAS bf16x8*)(Aw + fr * 72 + ks * 32 + fq * 8);
#pragma unroll
            for (int n = 0; n < 8; ++n) acc[n] = __builtin_amdgcn_mfma_f32_16x16x32_bf16(bfr[n][ks], af, acc[n], 0, 0, 0); }
#pragma unroll
        for (int n = 0; n < 8; ++n)
#pragma unroll
            for (int j = 0; j < 4; ++j) Xw[fr * 129 + n * 16 + fq * 4 + j] = acc[n][j];
        __syncthreads();
#pragma unroll
        for (int tt = 0; tt < 16; ++tt) {
            const float r = sigmoidf_(Xw[tt * 129 + lane] + ba), ig = sigmoidf_(Xw[tt * 129 + 64 + lane] + bx);
            const float la = -sp8 * r, a = __expf(la), x2 = 2.0f * la;
            const float om = (x2 > -0.1f) ? -x2 * (1.0f + x2 * (0.5f + x2 * (0.16666667f + x2 * 0.041666668f))) : 1.0f - a * a;
            h = a * h + __builtin_amdgcn_sqrtf(om) * ig * xc[tt]; Ap *= a;
            if (mode) { const float gt = bf2f(*gcol); gcol += PW; *ycol = f2bf(h * geluf_(gt)); ycol += 512; }
        }
        __syncthreads();
    }
    if (!mode) { Aend[(size_t)tile * 512 + c] = Ap; Hend[(size_t)tile * 512 + c] = h; }
}
__device__ __forceinline__ void lru_carry(const float* Aend, const float* Hend, float* carry) {
    const int gid = lbid() * NTHR + ltid();
    if (gid < (TS / SEQ) * 512) {
        const int bl = gid >> 9, c = gid & 511; float h = 0.f;
        for (int n = 0; n < 64; ++n) { const size_t o = (size_t)(bl * 64 + n) * 512 + c; carry[o] = h; h = Aend[o] * h + Hend[o]; }
    }
}

__device__ __forceinline__ void gdn_prep(LAS unsigned char* lds, const Params& p, int l, const bf16_t* proj, const float* AB, bf16_t* GQ, bf16_t* GK, bf16_t* GU, bf16_t* GW, bf16_t* GA, float* edec, int item) {
    const int tid = ltid(), wid = tid >> 6, lane = tid & 63, fr = lane & 15, fq = lane >> 4;
    const int bl = item >> 8, n = (item & 255) >> 2, hh = item & 3, ch = bl * 64 + n, t0 = ch * 64;
    LAS bf16_t* Kl = (LAS bf16_t*)lds;
    LAS bf16_t* Ql = (LAS bf16_t*)(lds + 17408);
    LAS float* RHS = (LAS float*)(lds + 34816);
    LAS float* Am = (LAS float*)(lds + 101376);
    LAS float* gc = (LAS float*)(lds + 117760);
    LAS float* bt = (LAS float*)(lds + 118016);
    const int t = tid >> 3, d0 = (tid & 7) * 16;
    float qkv[3][16];
#pragma unroll
    for (int sec = 0; sec < 3; ++sec) {
        const int colh = sec * 512 + hh * 128 + d0;
        float a[16];
#pragma unroll
        for (int e = 0; e < 16; ++e) a[e] = 0.f;
#pragma unroll
        for (int k = 0; k < 4; ++k) {
            const int tt = t - 3 + k;
            const bf16_t* src = nullptr;
            if (tt >= 0 || n > 0) src = proj + (long)(t0 + tt) * PW + PC_CQ + colh;
            if (src) {
                const u32x4 w0 = *(const u32x4*)src, w1 = *(const u32x4*)(src + 8);
                const float* cw = p.in[zz() + 18] + ((size_t)l * 4 + k) * 1536 + colh;
#pragma unroll
                for (int q = 0; q < 4; ++q) { const f32x4 c4 = *(const f32x4*)(cw + q * 4);
                    const unsigned wa = (q < 2) ? w0[2 * q] : w1[2 * q - 4], wb = (q < 2) ? w0[2 * q + 1] : w1[2 * q - 3];
                    a[q * 4 + 0] += c4[0] * lo_bf(wa); a[q * 4 + 1] += c4[1] * hi_bf(wa); a[q * 4 + 2] += c4[2] * lo_bf(wb); a[q * 4 + 3] += c4[3] * hi_bf(wb); }
            }
        }
#pragma unroll
        for (int e = 0; e < 16; ++e) qkv[sec][e] = siluf_(a[e]);
    }
    {
        float sq = 0.f, sk = 0.f;
#pragma unroll
        for (int e = 0; e < 16; ++e) { sq += qkv[0][e] * qkv[0][e]; sk += qkv[1][e] * qkv[1][e]; }
        sq += __shfl_xor(sq, 1); sq += __shfl_xor(sq, 2); sq += __shfl_xor(sq, 4); sk += __shfl_xor(sk, 1); sk += __shfl_xor(sk, 2); sk += __shfl_xor(sk, 4);
        const float qn = rsqrtf(sq + EPS) * 0.08838834764831845f, kn = rsqrtf(sk + EPS);
#pragma unroll
        for (int e = 0; e < 16; ++e) { qkv[0][e] *= qn; qkv[1][e] *= kn; }
#pragma unroll
        for (int e = 0; e < 16; e += 2) { *(LAS unsigned*)(Ql + t * 136 + d0 + e) = cvt_pk_bf16(qkv[0][e], qkv[0][e + 1]); *(LAS unsigned*)(Kl + t * 136 + d0 + e) = cvt_pk_bf16(qkv[1][e], qkv[1][e + 1]); }
    }
    if (wid == 0) {
        const float al = AB[(size_t)(t0 + lane) * 8 + 4 + hh], be = AB[(size_t)(t0 + lane) * 8 + hh];
        float gv = -__expf(p.in[zz() + 19][l * 4 + hh]) * softplusf_(al + p.in[zz() + 20][l * 4 + hh]);
#pragma unroll
        for (int o = 1; o < 64; o <<= 1) { const float u = __shfl_up(gv, o); if (lane >= o) gv += u; }
        gc[lane] = gv; bt[lane] = sigmoidf_(be);
        if (lane == 63) edec[item] = __expf(gv);
    }
    __syncthreads();
    {
        const float bet = bt[t], gct = gc[t], eg = __expf(gct), ekd = __expf(gc[63] - gct);
#pragma unroll
        for (int e = 0; e < 16; ++e) { RHS[t * 260 + d0 + e] = qkv[2][e] * bet; RHS[t * 260 + 128 + d0 + e] = qkv[1][e] * bet * eg; }
        bf16_t* qdst = GQ + (size_t)(t0 + t) * 512 + hh * 128 + d0;
        u32x4 w0, w1;
        w0.x = cvt_pk_bf16(qkv[0][0] * eg, qkv[0][1] * eg); w0.y = cvt_pk_bf16(qkv[0][2] * eg, qkv[0][3] * eg); w0.z = cvt_pk_bf16(qkv[0][4] * eg, qkv[0][5] * eg); w0.w = cvt_pk_bf16(qkv[0][6] * eg, qkv[0][7] * eg);
        w1.x = cvt_pk_bf16(qkv[0][8] * eg, qkv[0][9] * eg); w1.y = cvt_pk_bf16(qkv[0][10] * eg, qkv[0][11] * eg); w1.z = cvt_pk_bf16(qkv[0][12] * eg, qkv[0][13] * eg); w1.w = cvt_pk_bf16(qkv[0][14] * eg, qkv[0][15] * eg);
        *(u32x4*)qdst = w0; *(u32x4*)(qdst + 8) = w1;
#pragma unroll
        for (int e = 0; e < 16; ++e) qkv[1][e] *= ekd;
    }
    {
        const int it = wid & 3, which = wid >> 2;
        LAS bf16_t* Xi = which ? Ql : Kl;
        bf16x8 af[4];
#pragma unroll
        for (int ks = 0; ks < 4; ++ks) af[ks] = *(const LAS bf16x8*)(Xi + (it * 16 + fr) * 136 + ks * 32 + fq * 8);
        const int i = it * 16 + fr; const float gci = gc[i], bti = bt[i];
#pragma unroll
        for (int jt = 0; jt < 4; ++jt) {
            f32x4 acc = (f32x4){0.f, 0.f, 0.f, 0.f};
#pragma unroll
            for (int ks = 0; ks < 4; ++ks) { const bf16x8 bf = *(const LAS bf16x8*)(Kl + (jt * 16 + fr) * 136 + ks * 32 + fq * 8); acc = __builtin_amdgcn_mfma_f32_16x16x32_bf16(bf, af[ks], acc, 0, 0, 0); }
            float v[4];
#pragma unroll
            for (int jj = 0; jj < 4; ++jj) { const int j = jt * 16 + fq * 4 + jj; const float dec = (i >= j) ? __expf(gci - gc[j]) : 0.f;
                v[jj] = which ? acc[jj] * dec : ((i > j) ? bti * acc[jj] * dec : 0.f); }
            if (which) { u32x2 o; o.x = cvt_pk_bf16(v[0], v[1]); o.y = cvt_pk_bf16(v[2], v[3]); *(u32x2*)(GA + (size_t)(t0 + i) * 256 + hh * 64 + jt * 16 + fq * 4) = o; }
            else *(LAS f32x4*)(Am + i * 64 + jt * 16 + fq * 4) = (f32x4){v[0], v[1], v[2], v[3]};
        }
    }
    __syncthreads();
    {
        LAS bf16_t* KDT = Ql;
#pragma unroll
        for (int e = 0; e < 16; ++e) KDT[(d0 + e) * 68 + t] = f2bf(qkv[1][e]);
    }
    if (tid < 256) {
        float x[64];
        int lz; asm volatile("v_mov_b32 %0, 0" : "=v"(lz));
        const LAS float* Amz = Am + lz;
#pragma unroll
        for (int i = 0; i < 64; ++i) x[i] = 0.f;
#pragma unroll
        for (int i = 0; i < 64; ++i) {
            float s = RHS[i * 260 + tid];
#pragma unroll
            for (int j4 = 0; j4 < (i + 3) / 4; ++j4) { const f32x4 a4 = *(const LAS f32x4*)(Amz + i * 64 + j4 * 4);
                s -= a4[0] * x[j4 * 4]; s -= a4[1] * x[j4 * 4 + 1]; s -= a4[2] * x[j4 * 4 + 2]; s -= a4[3] * x[j4 * 4 + 3]; }
            x[i] = s; RHS[i * 260 + tid] = s;
        }
    }
    __syncthreads();
    {
        const int seg = tid & 7;
        const LAS float* xr = RHS + t * 260 + seg * 32;
        bf16_t* dst = ((seg < 4) ? GU : GW) + (size_t)(t0 + t) * 512 + hh * 128 + (seg & 3) * 32;
#pragma unroll
        for (int q = 0; q < 4; ++q) { const f32x4 a = *(const LAS f32x4*)(xr + q * 8), b = *(const LAS f32x4*)(xr + q * 8 + 4);
            u32x4 w; w.x = cvt_pk_bf16(a[0], a[1]); w.y = cvt_pk_bf16(a[2], a[3]); w.z = cvt_pk_bf16(b[0], b[1]); w.w = cvt_pk_bf16(b[2], b[3]); *(u32x4*)(dst + q * 8) = w; }
        const LAS bf16_t* kr = Ql + (2 * t + (seg >> 2)) * 68 + (seg & 3) * 16;
        const u32x2 k0 = *(const LAS u32x2*)kr, k1 = *(const LAS u32x2*)(kr + 4), k2 = *(const LAS u32x2*)(kr + 8), k3 = *(const LAS u32x2*)(kr + 12);
        bf16_t* kdst = GK + (size_t)(t0 + t) * 512 + hh * 128 + seg * 16;
        *(u32x4*)kdst = (u32x4){k0.x, k0.y, k1.x, k1.y}; *(u32x4*)(kdst + 8) = (u32x4){k2.x, k2.y, k3.x, k3.y};
    }
    __syncthreads();
}

__device__ __forceinline__ void gdn_scan(LAS unsigned char* lds, const unsigned char* ws, float* oraw, const float* edec, int chain) {
    const int tid = ltid(), wid = __builtin_amdgcn_readfirstlane(tid >> 6), lane = tid & 63, fr = lane & 15, fq = lane >> 4;
    const int bl = chain >> 5, hh = (chain >> 3) & 3, es = chain & 7, e0 = es * 16;
    constexpr int BUF = 64512, O_W = 0, O_Q = 17408, O_KT = 34816, O_AT = 53248, O_U = 62464, O_PS = 2 * BUF, O_PV = 2 * BUF + 4096;
    const unsigned rb = (unsigned)(bl * 64) * 64u;
    const bool stager = (wid >= 2);
    int soff[10], doff[10];
    {
        const int sid = tid - 128;
#pragma unroll
        for (int s = 0; s < 10; ++s) {
            int idx = sid + 384 * s; if (idx >= 3712) idx -= 128;
            if (!stager) { soff[s] = 0; doff[s] = 0; }
            else if (idx < 1024) { const int row = idx >> 4, pc = idx & 15; soff[s] = (int)(WS_GDW + ((size_t)(rb + row) * 512 + hh * 128 + pc * 8) * 2); doff[s] = O_W + (row * 136 + pc * 8) * 2; }
            else if (idx < 2048) { const int i2 = idx - 1024, row = i2 >> 4, pc = i2 & 15; soff[s] = (int)(WS_GDQ + ((size_t)(rb + row) * 512 + hh * 128 + pc * 8) * 2); doff[s] = O_Q + (row * 136 + pc * 8) * 2; }
            else if (idx < 3072) { const int i2 = idx - 2048, row = i2 >> 4, pc = i2 & 15; soff[s] = (int)(WS_GDK + ((size_t)(rb + row) * 512 + hh * 128 + pc * 8) * 2); doff[s] = O_KT + ((2 * row + (pc >> 3)) * 72 + (pc & 7) * 8) * 2; }
            else if (idx < 3584) { const int i2 = idx - 3072, row = i2 >> 3, pc = i2 & 7; soff[s] = (int)(WS_GDA + ((size_t)(rb + row) * 256 + hh * 64 + pc * 8) * 2); doff[s] = O_AT + (row * 72 + pc * 8) * 2; }
            else { const int i2 = idx - 3584, row = i2 >> 1, pc = i2 & 1; soff[s] = (int)(WS_GDU + ((size_t)(rb + row) * 512 + hh * 128 + e0 + pc * 8) * 2); doff[s] = O_U + (row * 16 + pc * 8) * 2; }
        }
    }
    const unsigned step9 = (tid - 128 < 128) ? 32768u : 65536u;
#define SSTEP(s) ((s) < 8 ? 65536u : ((s) == 8 ? 32768u : step9))
    u32x4 stg[10];
    if (stager) {
#pragma unroll
        for (int s = 0; s < 10; ++s) stg[s] = *(const u32x4*)(ws + (unsigned)soff[s]);
#pragma unroll
        for (int s = 0; s < 10; ++s) *(LAS u32x4*)(lds + doff[s]) = stg[s];
#pragma unroll
        for (int s = 0; s < 10; ++s) stg[s] = *(const u32x4*)(ws + (unsigned)soff[s] + SSTEP(s));
    }
    if (wid == 1) {
#pragma unroll
        for (int kt = 0; kt < 4; ++kt) *(LAS u32x4*)(lds + O_PS + kt * 1024 + lane * 16) = (u32x4){0u, 0u, 0u, 0u};
    }
    const float dv = edec[bl * 256 + lane * 4 + hh];
    f32x4 Sacc[8];
#pragma unroll
    for (int d = 0; d < 8; ++d) Sacc[d] = (f32x4){0.f, 0.f, 0.f, 0.f};
    __syncthreads();
    for (int n = 0; n < 64; ++n) {
        const LAS unsigned char* B = lds + (n & 1) * BUF;
        const int t0 = (bl * 64 + n) * 64;
        f32x4 OS[4];
        bf16x8 vb[2];
        if (wid == 0) {
            f32x4 WS[4];
            bf16x8 sb[4];
#pragma unroll
            for (int kt = 0; kt < 4; ++kt) { u32x4 w; w.x = cvt_pk_bf16(Sacc[2 * kt][0], Sacc[2 * kt][1]); w.y = cvt_pk_bf16(Sacc[2 * kt][2], Sacc[2 * kt][3]);
                w.z = cvt_pk_bf16(Sacc[2 * kt + 1][0], Sacc[2 * kt + 1][1]); w.w = cvt_pk_bf16(Sacc[2 * kt + 1][2], Sacc[2 * kt + 1][3]); sb[kt] = __builtin_bit_cast(bf16x8, w); }
#pragma unroll
            for (int m = 0; m < 4; ++m) WS[m] = (f32x4){0.f, 0.f, 0.f, 0.f};
#pragma unroll
            for (int kt = 0; kt < 4; ++kt)
#pragma unroll
                for (int m = 0; m < 4; ++m) { const LAS unsigned char* wp = B + O_W + ((m * 16 + fr) * 136 + kt * 32 + fq * 4) * 2;
                    u32x4 wa; { const u32x2 lo = *(const LAS u32x2*)wp, hi = *(const LAS u32x2*)(wp + 32); wa.x = lo.x; wa.y = lo.y; wa.z = hi.x; wa.w = hi.y; }
                    WS[m] = __builtin_amdgcn_mfma_f32_16x16x32_bf16(__builtin_bit_cast(bf16x8, wa), sb[kt], WS[m], 0, 0, 0); }
#pragma unroll
            for (int m = 0; m < 4; ++m)
#pragma unroll
                for (int jj = 0; jj < 4; ++jj) WS[m][jj] = bf2f(*(const LAS bf16_t*)(B + O_U + ((m * 16 + fq * 4 + jj) * 16 + fr) * 2)) - WS[m][jj];
#pragma unroll
            for (int kc = 0; kc < 2; ++kc) { u32x4 w; w.x = cvt_pk_bf16(WS[2 * kc][0], WS[2 * kc][1]); w.y = cvt_pk_bf16(WS[2 * kc][2], WS[2 * kc][3]);
                w.z = cvt_pk_bf16(WS[2 * kc + 1][0], WS[2 * kc + 1][1]); w.w = cvt_pk_bf16(WS[2 * kc + 1][2], WS[2 * kc + 1][3]); vb[kc] = __builtin_bit_cast(bf16x8, w);
                *(LAS u32x4*)(lds + O_PV + kc * 1024 + lane * 16) = w; }
        } else if (wid == 1) {
#pragma unroll
            for (int m = 0; m < 4; ++m) OS[m] = (f32x4){0.f, 0.f, 0.f, 0.f};
#pragma unroll
            for (int kt = 0; kt < 4; ++kt) {
                const bf16x8 sbr = *(const LAS bf16x8*)(lds + O_PS + kt * 1024 + lane * 16);
#pragma unroll
                for (int m = 0; m < 4; ++m) { const LAS unsigned char* qp = B + O_Q + ((m * 16 + fr) * 136 + kt * 32 + fq * 4) * 2;
                    u32x4 qa; { const u32x2 lo = *(const LAS u32x2*)qp, hi = *(const LAS u32x2*)(qp + 32); qa.x = lo.x; qa.y = lo.y; qa.z = hi.x; qa.w = hi.y; }
                    OS[m] = __builtin_amdgcn_mfma_f32_16x16x32_bf16(__builtin_bit_cast(bf16x8, qa), sbr, OS[m], 0, 0, 0); }
            }
        }
        __syncthreads();
        if (wid == 0) {
            const float dec = __shfl(dv, n);
#pragma unroll
            for (int d = 0; d < 8; ++d) Sacc[d] *= dec;
#pragma unroll
            for (int kc = 0; kc < 2; ++kc)
#pragma unroll
                for (int d = 0; d < 8; ++d) { const LAS unsigned char* kp = B + O_KT + ((d * 16 + fr) * 72 + kc * 32 + fq * 4) * 2;
                    u32x4 a; { const u32x2 lo = *(const LAS u32x2*)kp, hi = *(const LAS u32x2*)(kp + 32); a.x = lo.x; a.y = lo.y; a.z = hi.x; a.w = hi.y; }
                    Sacc[d] = __builtin_amdgcn_mfma_f32_16x16x32_bf16(__builtin_bit_cast(bf16x8, a), vb[kc], Sacc[d], 0, 0, 0); }
#pragma unroll
            for (int kt = 0; kt < 4; ++kt) { u32x4 w; w.x = cvt_pk_bf16(Sacc[2 * kt][0], Sacc[2 * kt][1]); w.y = cvt_pk_bf16(Sacc[2 * kt][2], Sacc[2 * kt][3]);
                w.z = cvt_pk_bf16(Sacc[2 * kt + 1][0], Sacc[2 * kt + 1][1]); w.w = cvt_pk_bf16(Sacc[2 * kt + 1][2], Sacc[2 * kt + 1][3]);
                *(LAS u32x4*)(lds + O_PS + kt * 1024 + lane * 16) = w; }
        } else if (wid == 1) {
#pragma unroll
            for (int kc = 0; kc < 2; ++kc) {
                const bf16x8 vbr = *(const LAS bf16x8*)(lds + O_PV + kc * 1024 + lane * 16);
#pragma unroll
                for (int m = 0; m < 4; ++m) { const LAS unsigned char* ap = B + O_AT + ((m * 16 + fr) * 72 + kc * 32 + fq * 4) * 2;
                    u32x4 a; { const u32x2 lo = *(const LAS u32x2*)ap, hi = *(const LAS u32x2*)(ap + 32); a.x = lo.x; a.y = lo.y; a.z = hi.x; a.w = hi.y; }
                    OS[m] = __builtin_amdgcn_mfma_f32_16x16x32_bf16(__builtin_bit_cast(bf16x8, a), vbr, OS[m], 0, 0, 0); }
            }
            float* op = oraw + (size_t)(t0 + fq * 4) * 512 + hh * 128 + e0 + fr;
#pragma unroll
            for (int m = 0; m < 4; ++m)
#pragma unroll
                for (int jj = 0; jj < 4; ++jj) op[(size_t)(m * 16 + jj) * 512] = OS[m][jj];
        } else if (stager) {
            if (n + 1 < 64) { LAS unsigned char* Bn = lds + ((n + 1) & 1) * BUF;
#pragma unroll
                for (int s = 0; s < 10; ++s) *(LAS u32x4*)(Bn + doff[s]) = stg[s]; }
            if (n + 2 < 64) {
#pragma unroll
                for (int s = 0; s < 10; ++s) stg[s] = *(const u32x4*)(ws + (unsigned)soff[s] + (unsigned)(n + 2) * SSTEP(s)); }
        }
        __syncthreads();
    }
}
__device__ __forceinline__ void gdn_out(const Params& p, int l, const float* oraw, const bf16_t* proj, bf16_t* yc) {
    const int tid = ltid(), sub = tid & 15;
    const float* ng = p.in[zz() + 21] + l * 128 + sub * 8;
    const f32x4 g0 = *(const f32x4*)ng, g1 = *(const f32x4*)(ng + 4);
    for (int rowi = lbid() * 32 + (tid >> 4); rowi < TS * 4; rowi += lgdim() * 32) {
        const int t = rowi >> 2, hh = rowi & 3;
        const float* op = oraw + (size_t)t * 512 + hh * 128 + sub * 8;
        const f32x4 o0 = *(const f32x4*)op, o1 = *(const f32x4*)(op + 4);
        float ss = (o0[0] * o0[0] + o0[1] * o0[1]) + (o0[2] * o0[2] + o0[3] * o0[3]) + (o1[0] * o1[0] + o1[1] * o1[1]) + (o1[2] * o1[2] + o1[3] * o1[3]);
        ss += __shfl_xor(ss, 1); ss += __shfl_xor(ss, 2); ss += __shfl_xor(ss, 4); ss += __shfl_xor(ss, 8);
        const float rs = rsqrtf(ss * (1.0f / 128.0f) + EPS);
        const u32x4 z = *(const u32x4*)(proj + (size_t)t * PW + PC_CZ + hh * 128 + sub * 8);
        u32x4 w;
        w.x = cvt_pk_bf16(o0[0] * rs * g0[0] * siluf_(lo_bf(z.x)), o0[1] * rs * g0[1] * siluf_(hi_bf(z.x)));
        w.y = cvt_pk_bf16(o0[2] * rs * g0[2] * siluf_(lo_bf(z.y)), o0[3] * rs * g0[3] * siluf_(hi_bf(z.y)));
        w.z = cvt_pk_bf16(o1[0] * rs * g1[0] * siluf_(lo_bf(z.z)), o1[1] * rs * g1[1] * siluf_(hi_bf(z.z)));
        w.w = cvt_pk_bf16(o1[2] * rs * g1[2] * siluf_(lo_bf(z.w)), o1[3] * rs * g1[3] * siluf_(hi_bf(z.w)));
        *(u32x4*)(yc + (size_t)t * 512 + hh * 128 + sub * 8) = w;
    }
}

constexpr int PH_PER_LAYER = 22, N_PHASES = 2 * PH_PER_LAYER + 1;

__device__ __forceinline__ void run_phase(LAS unsigned char* lds, const Params& p, int ph) {
    unsigned char* ws = lptr(p.ws);
    bf16_t* hbuf = (bf16_t*)(ws + WS_H);
    bf16_t* act = (bf16_t*)(ws + WS_PROJ);
    bf16_t* proj = (bf16_t*)(ws + WS_PROJ);
    bf16_t* hslab = hbuf;
    bf16_t* merged = hbuf + (size_t)TS * D;
    float* oraw = (float*)(ws + WS_H);
    bf16_t* ys = (bf16_t*)(ws + WS_YS);
    float* AB = (float*)(ws + WS_AB);
    bf16_t* halo = (bf16_t*)(ws + WS_HALO);
    float* Aend = (float*)(ws + WS_AEND); float* Hend = (float*)(ws + WS_HEND); float* carry = (float*)(ws + WS_CARRY); float* edec = (float*)(ws + WS_EDEC);
    const bf16_t* waxt = (const bf16_t*)(ws + WS_WAXT); const bf16_t* pwt = (const bf16_t*)(ws + WS_PWT);
    const int G = lgdim(), c = lbid();
    if (ph == N_PHASES - 1) { PHON(0) rms_rows_f32_inplace(lptr(p.out), p.in[zz() + 30], T); return; }
    const int l = ph / PH_PER_LAYER, r = ph % PH_PER_LAYER;
    const float* xcur = (l == 0) ? p.in[zz() + 0] : lptr(p.out);
    if (r == 0) { PHON(1) convert_layer(lds, p, l); PHON(0) rms_rows_bf16(xcur, p.in[zz() + 1] + l * D, hbuf, T); return; }
    if (r == 1 || r == 20) { PHON(2) ph_gemm_swiglu(lds, hbuf, (const bf16_t*)(ws + (r == 1 ? WS_WGU1 : WS_WGU2)), act); return; }
    if (r == 2 || r == 21) { PHON(3) ph_gemm_resid(lds, act, (const bf16_t*)(ws + (r == 2 ? WS_WD1 : WS_WD2)), T, DFF, (r == 2) ? xcur : lptr(p.out), lptr(p.out), 0.5f); return; }
    if (r == 19) { rms_rows_bf16(lptr(p.out), p.in[zz() + 26] + l * D, hbuf, T); return; }
    const int slab = (r - 3) >> 3, q = (r - 3) & 7;
    float* xs = lptr(p.out) + (size_t)slab * TS * D;
    switch (q) {
    case 0: rms_rows_bf16(xs, p.in[zz() + 5] + l * D, hslab, TS); break;
    case 1: PHON(4) ph_gemm_proj(lds, hslab, (const bf16_t*)(ws + WS_WIN), proj, AB); break;
    case 2:
        PHON(7) for (int t = c; t < TS / 64; t += G) lru_tile(lds, p, l, proj, nullptr, waxt, Aend, Hend, carry, t, 0);
        if (G >= 256) { PHON(5) for (int t = c; t < (TS / 128) * 2; t += G) sgu_tile(lds, p, l, proj, ys, t); }
        break;
    case 3:
        PHON(8) for (int it = c; it < (TS / 64) * 4; it += G) gdn_prep(lds, p, l, proj, AB, (bf16_t*)(ws + WS_GDQ), (bf16_t*)(ws + WS_GDK), (bf16_t*)(ws + WS_GDU), (bf16_t*)(ws + WS_GDW), (bf16_t*)(ws + WS_GDA), edec, it);
        lru_carry(Aend, Hend, carry);
        break;
    case 4:
        PHON(9) if (c < 128 || G < 256) { for (int ch = c; ch < 128; ch += G) gdn_scan(lds, ws, oraw, edec, ch); }
        if (G >= 256) {
            if (c >= 128) {
                const int cc = c - 128, GG = G - 128;
                PHON(10) for (int t = cc; t < TS / 128; t += GG) lru_tile(lds, p, l, proj, ys + (size_t)TS * 512, waxt, Aend, Hend, carry, t, 1);
                PHON(5) for (int t = (TS / 128) * 2 + cc; t < (TS / 128) * 4; t += GG) sgu_tile(lds, p, l, proj, ys, t);
                PHON(6) for (int t = cc; t < TS / 64; t += GG) pool_tile(lds, p, l, proj, ys + (size_t)3 * TS * 512, halo, pwt, t);
            }
        } else {
            for (int t = c; t < TS / 64; t += G) lru_tile(lds, p, l, proj, ys + (size_t)TS * 512, waxt, Aend, Hend, carry, t, 1);
            for (int t = c; t < (TS / 128) * 4; t += G) sgu_tile(lds, p, l, proj, ys, t);
            for (int t = c; t < TS / 64; t += G) pool_tile(lds, p, l, proj, ys + (size_t)3 * TS * 512, halo, pwt, t);
        }
        break;
    case 5: if (G >= 256) { for (int t = TS / 128 + c; t < TS / 64; t += G) lru_tile(lds, p, l, proj, ys + (size_t)TS * 512, waxt, Aend, Hend, carry, t, 1); }
        PHON(11) gdn_out(p, l, oraw, proj, ys + (size_t)2 * TS * 512); break;
    case 6: PHON(12) ph_gemm_branch(lds, ys, (const bf16_t*)(ws + WS_WB), proj, merged); break;
    default: PHON(13) ph_gemm_resid(lds, merged, (const bf16_t*)(ws + WS_WOUT), TS, D, xs, xs, 1.0f); break;
    }
}

extern __shared__ __attribute__((aligned(16))) unsigned char smem_dyn[];

#ifndef DUP_TYPE
#define DUP_TYPE -1
#endif
__device__ __forceinline__ int phase_type(int ph) {
    if (ph == N_PHASES - 1) return 12;
    const int r = ph % PH_PER_LAYER;
    if (r == 0) return 0; if (r == 1 || r == 20) return 1; if (r == 2 || r == 21) return 2; if (r == 19) return 11;
    const int q = (r - 3) & 7;
    return 3 + q;
}
__global__ void __launch_bounds__(NTHR) fwd_megakernel(Params p) {
    cg::grid_group grid = cg::this_grid();
    LAS unsigned char* lds = (LAS unsigned char*)smem_dyn;
    volatile LAS unsigned* st = (volatile LAS unsigned*)(lds + LDS_BYTES - 16);
    if (threadIdx.x == 0) { st[0] = 0u; st[1] = 0u; }
    __syncthreads();
    const XcdBarrier xb = xcd_barrier_post((unsigned*)(p.ws + WS_BAR), st);
    grid.sync();
    for (int ph = p.ph_lo; ph < p.ph_hi; ++ph) {
        if (ph > p.ph_lo) xcd_barrier(xb);
        run_phase(lds, p, ph);
#if DUP_TYPE == 6
        if (phase_type(ph) == 6) { xcd_barrier(xb); run_phase(lds, p, ph - 2); xcd_barrier(xb); run_phase(lds, p, ph - 1); xcd_barrier(xb); run_phase(lds, p, ph); }
#elif DUP_TYPE >= 0
        if (phase_type(ph) == DUP_TYPE) { xcd_barrier(xb); run_phase(lds, p, ph); }
#endif
    }
}

extern "C" void kernel_launch(void* const* d_in, const int* in_sizes, int n_in, void* d_out, int out_size, void* d_ws, size_t ws_size, hipStream_t stream) {
    static int grid_blocks = 0;
    if (grid_blocks == 0) {
        if (n_in != 31 || out_size != T * D || ws_size < WS_END) { fprintf(stderr, "kernel_launch: unexpected shapes (n_in %d out %d ws %zu need %zu)\n", n_in, out_size, ws_size, (size_t)WS_END); grid_blocks = -1; return; }
        int dev = 0, cus = 0, per_cu = 0;
        hipGetDevice(&dev);
        hipDeviceGetAttribute(&cus, hipDeviceAttributeMultiprocessorCount, dev);
        if (hipFuncSetAttribute((const void*)fwd_megakernel, hipFuncAttributeMaxDynamicSharedMemorySize, LDS_BYTES) != hipSuccess) { fprintf(stderr, "kernel_launch: hipFuncSetAttribute failed\n"); grid_blocks = -1; return; }
        hipOccupancyMaxActiveBlocksPerMultiprocessor(&per_cu, (const void*)fwd_megakernel, NTHR, LDS_BYTES);
        if (per_cu < 1) { fprintf(stderr, "kernel_launch: occupancy query returned %d\n", per_cu); per_cu = 1; }
        grid_blocks = cus * per_cu;
    }
    if (grid_blocks < 0) return;
    Params p{};
    for (int i = 0; i < 31; ++i) p.in[i] = (const float*)d_in[i];
    p.out = (float*)d_out; p.ws = (unsigned char*)d_ws;
    hipMemsetAsync((unsigned char*)d_ws + WS_BAR, 0, 16384, stream);
    p.ph_lo = 0; p.ph_hi = N_PHASES;
    void* args[] = {&p};
    hipError_t e = hipLaunchCooperativeKernel((const void*)fwd_megakernel, dim3(grid_blocks), dim3(NTHR), args, LDS_BYTES, stream);
    if (e != hipSuccess) fprintf(stderr, "cooperative launch failed: %s (grid %d)\n", hipGetErrorString(e), grid_blocks);
}
```

```cpp
#include <hip/hip_runtime.h>
#include <hip/hip_cooperative_groups.h>
#include <cstdio>
namespace cg = cooperative_groups;

#ifndef MULTI_LAUNCH
#define MULTI_LAUNCH 0
#endif

#ifndef PH_MASK
#define PH_MASK 0xFFFFF
#endif
#define PHON(k) if constexpr ((PH_MASK >> (k)) & 1)
#define LAS __attribute__((address_space(3)))
typedef unsigned short bf16_t;
typedef short bf16x8 __attribute__((ext_vector_type(8)));
typedef short bf16x4 __attribute__((ext_vector_type(4)));
typedef float f32x4 __attribute__((ext_vector_type(4)));
typedef unsigned u32x4 __attribute__((ext_vector_type(4)));
typedef unsigned u32x2 __attribute__((ext_vector_type(2)));

constexpr int T = 32768, D = 1024, DFF = 2816, NSLAB = 2, TS = T / NSLAB, SEQ = 4096, PW = 8960, PIN = 8712;
constexpr int PC_AU = 0, PC_AV = 512, PC_BX = 1024, PC_BG = 1536, PC_CQ = 2048, PC_CK = 2560, PC_CV = 3072, PC_CZ = 3584, PC_DX = 4096, PC_GATE = 4608, PC_AB = 8704;
constexpr float EPS = 1e-6f;
constexpr int NTHR = 512;
constexpr int LDS_BYTES = 147456;

constexpr size_t WS_WGU1 = 0;
constexpr size_t WS_WD1 = WS_WGU1 + (size_t)5632 * 1024 * 2;
constexpr size_t WS_WIN = WS_WD1 + (size_t)1024 * 2816 * 2;
constexpr size_t WS_WB = WS_WIN + (size_t)PW * 1024 * 2;
constexpr size_t WS_WOUT = WS_WB + (size_t)4 * 1024 * 512 * 2;
constexpr size_t WS_WGU2 = WS_WOUT + (size_t)1024 * 1024 * 2;
constexpr size_t WS_WD2 = WS_WGU2 + (size_t)5632 * 1024 * 2;
constexpr size_t WS_WAXT = WS_WD2 + (size_t)1024 * 2816 * 2;
constexpr size_t WS_PWT = WS_WAXT + 131072;
constexpr size_t WS_PROJ = WS_PWT + 131072;
constexpr size_t WS_H = WS_PROJ + (size_t)TS * PW * 2;
constexpr size_t WS_YS = WS_H + (size_t)T * D * 2;
constexpr size_t WS_AB = WS_YS + (size_t)4 * TS * 512 * 2;
constexpr size_t WS_HALO = WS_AB + (size_t)TS * 8 * 4;
constexpr size_t WS_AEND = WS_HALO + (size_t)(TS / 64) * 3 * 1536 * 2;
constexpr size_t WS_HEND = WS_AEND + (size_t)(TS / 64) * 512 * 4;
constexpr size_t WS_CARRY = WS_HEND + (size_t)(TS / 64) * 512 * 4;
constexpr size_t WS_EDEC = WS_CARRY + (size_t)(TS / 64) * 512 * 4;
constexpr size_t WS_BAR = WS_EDEC + 4096;
constexpr size_t WS_GDQ = WS_H + (size_t)TS * D * 2;
constexpr size_t WS_GDK = WS_GDQ + (size_t)TS * 512 * 2;
constexpr size_t WS_GDU = WS_BAR + 16384;
constexpr size_t WS_GDW = WS_GDU + (size_t)TS * 512 * 2;
constexpr size_t WS_GDA = WS_GDW + (size_t)TS * 512 * 2;
constexpr size_t WS_END = WS_GDA + (size_t)TS * 256 * 2;
static_assert(WS_END <= (size_t)512 * 1024 * 1024, "workspace budget");

struct Params { const float* in[31]; float* out; unsigned char* ws; int ph_lo, ph_hi; };

__device__ __forceinline__ int ltid() { int t = threadIdx.x; asm volatile("" : "+v"(t)); return t; }
__device__ __forceinline__ int lbid() { int t = blockIdx.x; asm volatile("" : "+s"(t)); return t; }
__device__ __forceinline__ int lgdim() { int t = gridDim.x; asm volatile("" : "+s"(t)); return t; }
__device__ __forceinline__ int zz() { int z; asm volatile("s_mov_b32 %0, 0" : "=s"(z)); return z; }
template <class P> __device__ __forceinline__ P* lptr(P* q) { asm volatile("" : "+s"(q)); return q; }
__device__ __forceinline__ float bf2f(unsigned short b) { return __uint_as_float(((unsigned)b) << 16); }
__device__ __forceinline__ unsigned cvt_pk_bf16(float lo, float hi) { unsigned r; asm("v_cvt_pk_bf16_f32 %0, %1, %2" : "=v"(r) : "v"(lo), "v"(hi)); return r; }
__device__ __forceinline__ unsigned short f2bf(float f) { return (unsigned short)(cvt_pk_bf16(f, 0.f) & 0xffffu); }
__device__ __forceinline__ float lo_bf(unsigned w) { return __uint_as_float(w << 16); }
__device__ __forceinline__ float hi_bf(unsigned w) { return __uint_as_float(w & 0xffff0000u); }
__device__ __forceinline__ float sigmoidf_(float x) { return __builtin_amdgcn_rcpf(1.0f + __expf(-x)); }
__device__ __forceinline__ float siluf_(float x) { return x * __builtin_amdgcn_rcpf(1.0f + __expf(-x)); }
__device__ __forceinline__ float geluf_(float x) { const float u = 1.5957691216057308f * (x + 0.044715f * x * x * x); return x * __builtin_amdgcn_rcpf(1.0f + __expf(-u)); }
__device__ __forceinline__ float softplusf_(float x) { return fmaxf(x, 0.f) + log1pf(__expf(-fabsf(x))); }
__device__ __forceinline__ float wave_sum(float v) {
#pragma unroll
    for (int o = 1; o < 64; o <<= 1) v += __shfl_xor(v, o);
    return v;
}


#define XB_TMO      128
#define XB_XCNT(j)  (256  + 64 * (j))
#define XB_XSUB(j)  (1280 + 64 * (j))
#define XB_XGEN(j)  (2304 + 64 * (j))
#define XB_TOP      3328
#define XB_TOPGEN   3392
#define XCD_BAR_WORDS 3456
#define XB_SPIN_CAP (1u << 22)
__device__ __forceinline__ unsigned xb_ld(unsigned* p)              { return __hip_atomic_load(p, __ATOMIC_RELAXED, __HIP_MEMORY_SCOPE_AGENT); }
__device__ __forceinline__ unsigned xb_add(unsigned* p, unsigned v) { return __hip_atomic_fetch_add(p, v, __ATOMIC_RELAXED, __HIP_MEMORY_SCOPE_AGENT); }
__device__ __forceinline__ unsigned xb_xcc_id() { return (unsigned)__builtin_amdgcn_s_getreg((3 << 11) | 20) & 0xFu; }
#define XB_SPIN(cond, bar) do { unsigned _sp = 0; while (cond) { __builtin_amdgcn_s_sleep(1); \
    if ((++_sp & 255u) == 0u) { if (xb_ld(&(bar)[XB_TMO])) break; if (_sp > XB_SPIN_CAP) { atomicAdd(&(bar)[XB_TMO], 1u); break; } } } } while (0)
struct XcdBarrier { unsigned* bar; unsigned x; volatile LAS unsigned* st; };
__device__ __forceinline__ XcdBarrier xcd_barrier_post(unsigned* bar, volatile LAS unsigned* st) {
    XcdBarrier b; b.bar = bar; b.x = xb_xcc_id(); b.st = st;
    if (threadIdx.x == 0) (void)xb_add(&bar[XB_XCNT(b.x)], 1u);
    return b;
}
__device__ __forceinline__ void xcd_barrier_complete(unsigned* bar, unsigned x, unsigned& nloc, unsigned& nx) {
    const unsigned G = gridDim.x * gridDim.y * gridDim.z;
    unsigned sum, cnt, mine, sp = 0u;
    for (;;) {
        sum = 0u; cnt = 0u; mine = 0u;
#pragma unroll
        for (unsigned j = 0; j < 16; ++j) { const unsigned c = xb_ld(&bar[XB_XCNT(j)]); sum += c; cnt += (c > 0u) ? 1u : 0u; mine = (j == x) ? c : mine; }
        if (sum == G) break;
        __builtin_amdgcn_s_sleep(1);
        if ((++sp & 255u) == 0u) { if (xb_ld(&bar[XB_TMO])) break; if (sp > XB_SPIN_CAP) { atomicAdd(&bar[XB_TMO], 1u); break; } }
    }
    nloc = mine > 0u ? mine : 1u; nx = cnt > 0u ? cnt : 1u;
}
__device__ __forceinline__ void xcd_barrier(const XcdBarrier& b) {
    asm volatile("s_waitcnt vmcnt(0)" ::: "memory");
    __syncthreads();
    if (threadIdx.x == 0) {
        unsigned* bar = b.bar;
        __builtin_amdgcn_s_waitcnt(0);
        unsigned nloc = b.st[0], nx = b.st[1];
        if (nloc == 0u) { xcd_barrier_complete(bar, b.x, nloc, nx); b.st[0] = nloc; b.st[1] = nx; }
        const unsigned old = xb_add(&bar[XB_XSUB(b.x)], 1u);
        const unsigned gen = old / nloc;
        if (old + 1u == (gen + 1u) * nloc) {
            __builtin_amdgcn_fence(__ATOMIC_RELEASE, "agent");
            asm volatile("s_waitcnt vmcnt(0)" ::: "memory");
            const unsigned og = xb_add(&bar[XB_TOP], 1u);
            const unsigned tg = og / nx;
            if (og + 1u == (tg + 1u) * nx) xb_add(&bar[XB_TOPGEN], 1u);
            else XB_SPIN(xb_ld(&bar[XB_TOPGEN]) == tg, bar);
            __builtin_amdgcn_fence(__ATOMIC_ACQUIRE, "agent");
            xb_add(&bar[XB_XGEN(b.x)], 1u);
            asm volatile("s_waitcnt vmcnt(0)" ::: "memory");
        } else {
            XB_SPIN(xb_ld(&bar[XB_XGEN(b.x)]) == gen, bar);
            __builtin_amdgcn_fence(__ATOMIC_ACQUIRE, "agent");
            asm volatile("s_waitcnt vmcnt(0)" ::: "memory");
        }
    }
    __syncthreads();
}

namespace pg8 {
constexpr int BM = 256, BK = 64, HALF = 128, HTB = HALF * BK * 2, STAGE_BYTES = 8 * HTB, NXCD = 8, WGM = 8;
__host__ __device__ __forceinline__ int lds_byte(int r, int c) { const int st = (r >> 4) * 2 + (c >> 5), rr = r & 15, cc = c & 31, ob = rr * 64 + cc * 2; return st * 1024 + (ob ^ (((ob >> 9) & 1) << 5)); }
__host__ __device__ __forceinline__ void stage_rc(int b, int& R, int& C) { const int st = b / 1024, sb = b % 1024, swz = sb ^ (((sb >> 9) & 1) << 5); R = (st >> 1) * 16 + swz / 64; C = (st & 1) * 32 + (swz % 64) / 2; }
__host__ __device__ __forceinline__ int perm32(int rho) { const int n = rho >> 4, i = rho & 15; return 8 * (i >> 2) + 4 * n + (i & 3); }

struct Unit { int pm, pn, g; };
struct Gemm { const bf16_t* A; const bf16_t* Bt; int M, N, K; size_t gsA, gsB; };

__device__ __forceinline__ void tile_of(int wgid, int nM, int nN, int nwg, Unit& u) {
    { const int q = nwg / NXCD, r = nwg % NXCD, xcd = wgid % NXCD, off = wgid / NXCD; wgid = (xcd < r ? xcd * (q + 1) : r * (q + 1) + (xcd - r) * q) + off; }
    const int nig = WGM * nN, gid = wgid / nig, fm = gid * WGM, gsz = (nM - fm) < WGM ? (nM - fm) : WGM;
    u.pm = fm + ((wgid % nig) % gsz); u.pn = (wgid % nig) / gsz;
}
struct StaticOrder {
    int nM, nN, nwg, G, c;
    __device__ void init(int M, int N, int G_, int c_) { nM = M / BM; nN = N / BM; nwg = nM * nN; G = G_; c = c_; }
    __device__ bool next(int i, Unit& u) const {
        const long L = (long)i * G + c; if (L >= nwg) return false;
        tile_of((int)L, nM, nN, nwg, u); u.g = 0; return true;
    }
};
struct BranchOrder {
    int nM, nN, nwg, G, c;
    __device__ void init(int M, int N, int G_, int c_) { nM = M / BM; nN = N / BM; nwg = nM * nN; G = G_; c = c_; }
    __device__ bool next(int i, Unit& u) const {
        const long L = (long)(i >> 2) * G + c; if (L >= nwg) return false;
        tile_of((int)L, nM, nN, nwg, u); u.g = i & 3; return true;
    }
};

struct EpiSwiGLU {
    static constexpr bool PERM = true;
    bf16_t* O;
    __device__ __forceinline__ bool keep(const Unit&) const { return false; }
    __device__ __forceinline__ void operator()(f32x4 (&acc)[2][2][4][2], const Unit& u, int wr, int wc, int fr, int fq) const {
        const int row0 = u.pm * BM + wr * 64 + fr, col0 = u.pn * 128 + wc * 32 + 8 * fq;
#pragma unroll
        for (int ai = 0; ai < 2; ++ai)
#pragma unroll
            for (int m = 0; m < 4; ++m) {
                bf16_t* rowp = O + (size_t)(row0 + ai * HALF + m * 16) * DFF + col0;
                float v[8];
#pragma unroll
                for (int n = 0; n < 2; ++n)
#pragma unroll
                    for (int j = 0; j < 4; ++j) v[n * 4 + j] = siluf_(acc[ai][0][m][n][j]) * acc[ai][1][m][n][j];
                u32x4 w; w.x = cvt_pk_bf16(v[0], v[1]); w.y = cvt_pk_bf16(v[2], v[3]); w.z = cvt_pk_bf16(v[4], v[5]); w.w = cvt_pk_bf16(v[6], v[7]);
                *(u32x4*)rowp = w;
                __builtin_amdgcn_sched_barrier(0);
            }
    }
};
struct EpiResid {
    static constexpr bool PERM = false;
    const float* Xin; float* Xout; float scale;
    __device__ __forceinline__ bool keep(const Unit&) const { return false; }
    __device__ __forceinline__ void operator()(f32x4 (&acc)[2][2][4][2], const Unit& u, int wr, int wc, int fr, int fq) const {
        const int row0 = u.pm * BM + wr * 64 + fr, col0 = u.pn * BM + wc * 32 + 4 * fq;
#pragma unroll
        for (int ai = 0; ai < 2; ++ai)
#pragma unroll
            for (int m = 0; m < 4; ++m) {
                const size_t ro = (size_t)(row0 + ai * HALF + m * 16) * D + col0;
#pragma unroll
                for (int bj = 0; bj < 2; ++bj)
#pragma unroll
                    for (int n = 0; n < 2; ++n) { const f32x4 xi = *(const f32x4*)(Xin + ro + bj * HALF + n * 16); *(f32x4*)(Xout + ro + bj * HALF + n * 16) = xi + acc[ai][bj][m][n] * scale; }
                __builtin_amdgcn_sched_barrier(0);
            }
    }
};
struct EpiProj {
    static constexpr bool PERM = true;
    bf16_t* O; float* AB;
    __device__ __forceinline__ bool keep(const Unit&) const { return false; }
    __device__ __forceinline__ void operator()(f32x4 (&acc)[2][2][4][2], const Unit& u, int wr, int wc, int fr, int fq) const {
        const int row0 = u.pm * BM + wr * 64 + fr, col0 = u.pn * BM + wc * 32 + 8 * fq;
        const bool ab = (u.pn == PC_AB / BM) && wc == 0 && fq == 0;
#pragma unroll
        for (int ai = 0; ai < 2; ++ai)
#pragma unroll
            for (int m = 0; m < 4; ++m) {
                const int row = row0 + ai * HALF + m * 16;
                bf16_t* rowp = O + (size_t)row * PW + col0;
#pragma unroll
                for (int bj = 0; bj < 2; ++bj) {
                    const f32x4 v0 = acc[ai][bj][m][0], v1 = acc[ai][bj][m][1];
                    u32x4 w; w.x = cvt_pk_bf16(v0[0], v0[1]); w.y = cvt_pk_bf16(v0[2], v0[3]); w.z = cvt_pk_bf16(v1[0], v1[1]); w.w = cvt_pk_bf16(v1[2], v1[3]);
                    *(u32x4*)(rowp + bj * HALF) = w;
                }
                __builtin_amdgcn_sched_barrier(0);
            }
        if (ab) {
#pragma unroll
            for (int ai = 0; ai < 2; ++ai)
#pragma unroll
                for (int m = 0; m < 4; ++m) { const int row = row0 + ai * HALF + m * 16; *(f32x4*)(AB + (size_t)row * 8) = acc[ai][0][m][0]; *(f32x4*)(AB + (size_t)row * 8 + 4) = acc[ai][0][m][1]; }
        }
    }
};
struct EpiBranch {
    static constexpr bool PERM = true;
    const bf16_t* P; bf16_t* O;
    __device__ __forceinline__ bool keep(const Unit& u) const { return u.g < 3; }
    __device__ __forceinline__ void operator()(f32x4 (&acc)[2][2][4][2], const Unit& u, int wr, int wc, int fr, int fq) const {
        const int row0 = u.pm * BM + wr * 64 + fr, col0 = u.pn * BM + wc * 32 + 8 * fq;
        const bool last = (u.g == 3);
#pragma unroll
        for (int ai = 0; ai < 2; ++ai)
#pragma unroll
            for (int m = 0; m < 4; ++m) {
                const int row = row0 + ai * HALF + m * 16;
                const bf16_t* gp = P + (size_t)row * PW + PC_GATE + u.g * D + col0;
#pragma unroll
                for (int bj = 0; bj < 2; ++bj) {
                    const u32x4 g0 = *(const u32x4*)(gp + bj * HALF);
                    float f[8];
                    if (!last) {
                        const u32x4 g1 = *(const u32x4*)(gp + D + bj * HALF);
#pragma unroll
                        for (int q = 0; q < 4; ++q) {
                            f[2 * q] = (1.0f + __expf(-lo_bf(g1[q]))) * __builtin_amdgcn_rcpf(1.0f + __expf(-lo_bf(g0[q])));
                            f[2 * q + 1] = (1.0f + __expf(-hi_bf(g1[q]))) * __builtin_amdgcn_rcpf(1.0f + __expf(-hi_bf(g0[q])));
                        }
                    } else {
#pragma unroll
                        for (int q = 0; q < 4; ++q) { f[2 * q] = __builtin_amdgcn_rcpf(1.0f + __expf(-lo_bf(g0[q]))); f[2 * q + 1] = __builtin_amdgcn_rcpf(1.0f + __expf(-hi_bf(g0[q]))); }
                    }
#pragma unroll
                    for (int n = 0; n < 2; ++n)
#pragma unroll
                        for (int j = 0; j < 4; ++j) acc[ai][bj][m][n][j] *= f[n * 4 + j];
                    if (last) {
                        const f32x4 v0 = acc[ai][bj][m][0], v1 = acc[ai][bj][m][1];
                        u32x4 w; w.x = cvt_pk_bf16(v0[0], v0[1]); w.y = cvt_pk_bf16(v0[2], v0[3]); w.z = cvt_pk_bf16(v1[0], v1[1]); w.w = cvt_pk_bf16(v1[2], v1[3]);
                        *(u32x4*)(O + (size_t)row * D + col0 + bj * HALF) = w;
                    }
                    __builtin_amdgcn_sched_barrier(0);
                }
            }
    }
};

template <class Epi, class Sched>
__device__ __forceinline__ void gemm_phase(LAS unsigned char* lds, const Gemm g, const Sched& S, const Epi& E) {
    const int tid = ltid(), wid = __builtin_amdgcn_readfirstlane(tid >> 6), lane = tid & 63, wr = wid >> 2, wc = wid & 3, fr = lane & 15, fq = lane >> 4;
    const int K = g.K, nt = K / BK;
    unsigned voffA[2], voffB[2];
#pragma unroll
    for (int i = 0; i < 2; ++i) { int R, C; stage_rc(tid * 16 + i * 8192, R, C); const int Rb = Epi::PERM ? ((R & ~31) + perm32(R & 31)) : R;
        voffA[i] = (unsigned)(R * K + C) * 2u; voffB[i] = (unsigned)(Rb * K + C) * 2u; }
    const size_t kstep = (size_t)(BK * 2);
    const size_t hstep = (size_t)HALF * K * 2;
    const size_t tstep = 2 * hstep;
    const unsigned ldsw = (unsigned)wid * 1024u;
    const int aoff = lds_byte(wr * 64 + fr, fq * 8), boff = lds_byte(wc * 32 + fr, fq * 8);
#define PG8_SA(b, h) (((b) * 2 + (h)) * HTB)
#define PG8_SB(b, h) ((4 + (b) * 2 + (h)) * HTB)
#define PG8_STAGE(bufoff, gbase, voff) do { _Pragma("unroll") for (int _i = 0; _i < 2; ++_i) \
        __builtin_amdgcn_global_load_lds((const unsigned*)((const char*)(gbase) + (voff)[_i]), (LAS unsigned*)(lds + (bufoff) + ldsw + _i * 8192), 16, 0, 0); } while (0)
#define PG8_LDA(dst, b, h) do { _Pragma("unroll") for (int m = 0; m < 4; ++m) _Pragma("unroll") for (int k = 0; k < 2; ++k) dst[m][k] = *(const LAS bf16x8*)(lds + PG8_SA(b, h) + aoff + m * 2048 + k * 1024); } while (0)
#define PG8_LDB(dst, b, h) do { _Pragma("unroll") for (int n = 0; n < 2; ++n) _Pragma("unroll") for (int k = 0; k < 2; ++k) dst[n][k] = *(const LAS bf16x8*)(lds + PG8_SB(b, h) + boff + n * 2048 + k * 1024); } while (0)
#define PG8_MMA(ai, bj, At, Bt) do { __builtin_amdgcn_s_setprio(1); _Pragma("unroll") for (int m = 0; m < 4; ++m) _Pragma("unroll") for (int n = 0; n < 2; ++n) _Pragma("unroll") for (int k = 0; k < 2; ++k) \
        acc[ai][bj][m][n] = __builtin_amdgcn_mfma_f32_16x16x32_bf16(Bt[n][k], At[m][k], acc[ai][bj][m][n], 0, 0, 0); __builtin_amdgcn_s_setprio(0); } while (0)
#define PG8_WAIT_V(n) asm volatile("s_waitcnt vmcnt(" #n ")" ::: "memory")
#define PG8_WAIT_L(n) asm volatile("s_waitcnt lgkmcnt(" #n ")" ::: "memory")
#define PG8_BAR __builtin_amdgcn_s_barrier()
#define PG8_SCHED __builtin_amdgcn_sched_barrier(0)
    Unit cur, nxt; int ui = 0;
    if (!S.next(0, cur)) return;
    f32x4 acc[2][2][4][2];
#pragma unroll
    for (int a = 0; a < 2; ++a)
#pragma unroll
        for (int b = 0; b < 2; ++b)
#pragma unroll
            for (int m = 0; m < 4; ++m)
#pragma unroll
                for (int n = 0; n < 2; ++n) acc[a][b][m][n] = (f32x4){0.f, 0.f, 0.f, 0.f};
    bf16x8 At[4][2], B0[2][2], B1[2][2];
    const char* cA = (const char*)g.A + (size_t)cur.g * g.gsA + (size_t)cur.pm * tstep; const char* cB = (const char*)g.Bt + (size_t)cur.g * g.gsB + (size_t)cur.pn * tstep;
    PG8_STAGE(PG8_SB(0, 0), cB, voffB); PG8_STAGE(PG8_SA(0, 0), cA, voffA); PG8_STAGE(PG8_SB(0, 1), cB + hstep, voffB); PG8_STAGE(PG8_SA(0, 1), cA + hstep, voffA);
    if (wr == 1) PG8_BAR;
    PG8_WAIT_V(4); PG8_BAR;
    PG8_STAGE(PG8_SB(1, 0), cB + kstep, voffB); PG8_STAGE(PG8_SA(1, 0), cA + kstep, voffA); PG8_STAGE(PG8_SB(1, 1), cB + hstep + kstep, voffB);
    PG8_WAIT_V(6); PG8_BAR;
    for (;;) {
        const bool has_next = S.next(ui + 1, nxt);
        const char* nA = has_next ? (const char*)g.A + (size_t)nxt.g * g.gsA + (size_t)nxt.pm * tstep : cA; const char* nB = has_next ? (const char*)g.Bt + (size_t)nxt.g * g.gsB + (size_t)nxt.pn * tstep : cB;
        for (int t = 0; t < nt; t += 2) {
            const bool last = (t == nt - 2);
            const char* a1 = cA + (size_t)(t + 1) * kstep;
            const char* a2 = last ? nA : cA + (size_t)(t + 2) * kstep; const char* b2 = last ? nB : cB + (size_t)(t + 2) * kstep;
            const char* a3 = a2 + kstep; const char* b3 = b2 + kstep;
            PG8_LDB(B0, 0, 0); PG8_SCHED; PG8_LDA(At, 0, 0); PG8_STAGE(PG8_SA(1, 1), a1 + hstep, voffA);
            PG8_WAIT_L(8); PG8_BAR; PG8_WAIT_L(0); PG8_MMA(0, 0, At, B0); PG8_BAR; PG8_SCHED;
            PG8_LDB(B1, 0, 1); PG8_STAGE(PG8_SB(0, 0), b2, voffB);
            PG8_BAR; PG8_WAIT_L(0); PG8_MMA(0, 1, At, B1); PG8_BAR;
            PG8_LDA(At, 0, 1); PG8_STAGE(PG8_SA(0, 0), a2, voffA);
            PG8_BAR; PG8_WAIT_L(0); PG8_MMA(1, 0, At, B0); PG8_BAR; PG8_SCHED;
            PG8_STAGE(PG8_SB(0, 1), b2 + hstep, voffB);
            PG8_WAIT_V(6); PG8_BAR; PG8_MMA(1, 1, At, B1); PG8_BAR;
            PG8_LDB(B0, 1, 0); PG8_SCHED; PG8_LDA(At, 1, 0); PG8_STAGE(PG8_SA(0, 1), a2 + hstep, voffA);
            PG8_WAIT_L(8); PG8_BAR; PG8_WAIT_L(0); PG8_MMA(0, 0, At, B0); PG8_BAR; PG8_SCHED;
            PG8_LDB(B1, 1, 1); PG8_STAGE(PG8_SB(1, 0), b3, voffB);
            PG8_BAR; PG8_WAIT_L(0); PG8_MMA(0, 1, At, B1); PG8_BAR;
            PG8_LDA(At, 1, 1); PG8_STAGE(PG8_SA(1, 0), a3, voffA);
            PG8_BAR; PG8_WAIT_L(0); PG8_MMA(1, 0, At, B0); PG8_BAR; PG8_SCHED;
            PG8_STAGE(PG8_SB(1, 1), b3 + hstep, voffB);
            PG8_WAIT_V(6); PG8_BAR; PG8_MMA(1, 1, At, B1); PG8_BAR;
        }
        E(acc, cur, wr, wc, fr, fq);
        if (!has_next) break;
        if (!E.keep(cur)) {
#pragma unroll
            for (int a = 0; a < 2; ++a)
#pragma unroll
                for (int b = 0; b < 2; ++b)
#pragma unroll
                    for (int m = 0; m < 4; ++m)
#pragma unroll
                        for (int n = 0; n < 2; ++n) acc[a][b][m][n] = (f32x4){0.f, 0.f, 0.f, 0.f};
        }
        cur = nxt; cA = nA; cB = nB; ++ui;
    }
    PG8_WAIT_V(0);
    if (wr == 0) PG8_BAR;
    PG8_BAR;
#undef PG8_SA
#undef PG8_SB
#undef PG8_STAGE
#undef PG8_LDA
#undef PG8_LDB
#undef PG8_MMA
#undef PG8_WAIT_V
#undef PG8_WAIT_L
#undef PG8_BAR
#undef PG8_SCHED
}
}


#define NOINL __forceinline__
__device__ NOINL void ph_gemm_swiglu(LAS unsigned char* lds, const bf16_t* A, const bf16_t* Bt, bf16_t* O) {
    pg8::Gemm g{A, Bt, T, 2 * DFF, D, 0, 0}; pg8::StaticOrder S; S.init(g.M, g.N, lgdim(), lbid()); pg8::EpiSwiGLU E{O}; pg8::gemm_phase(lds, g, S, E);
}
__device__ NOINL void ph_gemm_resid(LAS unsigned char* lds, const bf16_t* A, const bf16_t* Bt, int M, int K, const float* Xin, float* Xout, float scale) {
    pg8::Gemm g{A, Bt, M, D, K, 0, 0}; pg8::StaticOrder S; S.init(g.M, g.N, lgdim(), lbid()); pg8::EpiResid E{Xin, Xout, scale}; pg8::gemm_phase(lds, g, S, E);
}
__device__ NOINL void ph_gemm_proj(LAS unsigned char* lds, const bf16_t* A, const bf16_t* Bt, bf16_t* O, float* AB) {
    pg8::Gemm g{A, Bt, TS, PW, D, 0, 0}; pg8::StaticOrder S; S.init(g.M, g.N, lgdim(), lbid()); pg8::EpiProj E{O, AB}; pg8::gemm_phase(lds, g, S, E);
}
__device__ NOINL void ph_gemm_branch(LAS unsigned char* lds, const bf16_t* A, const bf16_t* Bt, const bf16_t* P, bf16_t* O) {
    pg8::Gemm g{A, Bt, TS, D, 512, (size_t)TS * 512 * 2, (size_t)D * 512 * 2}; pg8::BranchOrder S; S.init(g.M, g.N, lgdim(), lbid()); pg8::EpiBranch E{P, O}; pg8::gemm_phase(lds, g, S, E);
}

struct ConvTask { const float* src0; const float* src1; bf16_t* dst; int K, Nsrc, mode, tile; };
__device__ __forceinline__ ConvTask conv_task(const Params& p, int l, int it) {
    unsigned char* ws = lptr(p.ws);
    constexpr int N1 = 16 * 88, N2 = 44 * 16, N3 = 16 * 140, N4 = 8 * 16, N5 = 16 * 16;
    ConvTask t; t.src1 = nullptr;
    int r = it;
    if (r < N1) { t.src0 = p.in[zz() + 2] + (size_t)l * D * DFF; t.src1 = p.in[zz() + 3] + (size_t)l * D * DFF; t.K = D; t.Nsrc = DFF; t.dst = (bf16_t*)(ws + WS_WGU1); t.mode = 1; t.tile = r; return t; } r -= N1;
    if (r < N2) { t.src0 = p.in[zz() + 4] + (size_t)l * DFF * D; t.K = DFF; t.Nsrc = D; t.dst = (bf16_t*)(ws + WS_WD1); t.mode = 0; t.tile = r; return t; } r -= N2;
    if (r < N3) { t.src0 = p.in[zz() + 6] + (size_t)l * D * PIN; t.K = D; t.Nsrc = PIN; t.dst = (bf16_t*)(ws + WS_WIN); t.mode = 2; t.tile = r; return t; } r -= N3;
    if (r < 4 * N4) { const int g = r / N4; t.src0 = p.in[zz() + 24] + ((size_t)l * 4 + g) * 512 * D; t.K = 512; t.Nsrc = D; t.dst = (bf16_t*)(ws + WS_WB) + (size_t)g * D * 512; t.mode = 0; t.tile = r % N4; return t; } r -= 4 * N4;
    if (r < N5) { t.src0 = p.in[zz() + 25] + (size_t)l * D * D; t.K = D; t.Nsrc = D; t.dst = (bf16_t*)(ws + WS_WOUT); t.mode = 0; t.tile = r; return t; } r -= N5;
    if (r < N1) { t.src0 = p.in[zz() + 27] + (size_t)l * D * DFF; t.src1 = p.in[zz() + 28] + (size_t)l * D * DFF; t.K = D; t.Nsrc = DFF; t.dst = (bf16_t*)(ws + WS_WGU2); t.mode = 1; t.tile = r; return t; } r -= N1;
    t.src0 = p.in[zz() + 29] + (size_t)l * DFF * D; t.K = DFF; t.Nsrc = D; t.dst = (bf16_t*)(ws + WS_WD2); t.mode = 0; t.tile = r; return t;
}
__device__ __forceinline__ void conv_load(const ConvTask& t, int tid, f32x4& a, f32x4& b) {
    const int nkt = t.K / 64, kt = t.tile % nkt, rt = t.tile / nkt, k0 = kt * 64, r0 = rt * 64;
    const int kk = tid >> 3, rr = (tid & 7) * 8, rho = r0 + rr;
    const float* src = t.src0; int col = rho;
    if (t.mode == 1) { const int pn = rho >> 8, bj = (rho >> 7) & 1, j = rho & 127; col = pn * 128 + j; src = bj ? t.src1 : t.src0; }
    else if (t.mode == 2) { col = rho < 4096 ? rho : (rho < 8704 ? rho + 8 : (rho < 8712 ? rho - 8704 + 4096 : -1)); }
    a = (f32x4){0.f, 0.f, 0.f, 0.f}; b = a;
    if (col >= 0) { const float* sp = src + (size_t)(k0 + kk) * t.Nsrc + col; a = *(const f32x4*)sp; b = *(const f32x4*)(sp + 4); }
}
__device__ __forceinline__ void conv_store(LAS float* scr, const ConvTask& t, int tid, const f32x4& a, const f32x4& b) {
    const int nkt = t.K / 64, kt = t.tile % nkt, rt = t.tile / nkt, k0 = kt * 64, r0 = rt * 64;
    { const int kk = tid >> 3, rr = (tid & 7) * 8;
#pragma unroll
        for (int e = 0; e < 4; ++e) { scr[(rr + e) * 65 + kk] = a[e]; scr[(rr + 4 + e) * 65 + kk] = b[e]; } }
    __syncthreads();
    { const int rl = tid >> 3, kc = (tid & 7) * 8;
        const LAS float* s = scr + rl * 65 + kc;
        u32x4 w; w.x = cvt_pk_bf16(s[0], s[1]); w.y = cvt_pk_bf16(s[2], s[3]); w.z = cvt_pk_bf16(s[4], s[5]); w.w = cvt_pk_bf16(s[6], s[7]);
        *(u32x4*)(t.dst + (size_t)(r0 + rl) * t.K + k0 + kc) = w; }
    __syncthreads();
}

__device__ __forceinline__ void convert_layer(LAS unsigned char* lds, const Params& p, int l) {
    LAS float* scr = (LAS float*)lds;
    unsigned char* ws = lptr(p.ws);
    constexpr int N1 = 16 * 88, N2 = 44 * 16, N3 = 16 * 140, N4 = 8 * 16, N5 = 16 * 16;
    constexpr int TOT = N1 + N2 + N3 + 4 * N4 + N5 + N1 + N2;
    const int tid = ltid(), G = lgdim();
    int it = lbid();
    if (it < TOT) {
        ConvTask cur = conv_task(p, l, it);
        f32x4 a, b; conv_load(cur, tid, a, b);
        for (;;) {
            const int nx = it + G; const bool more = nx < TOT;
            ConvTask nxt = cur; f32x4 na = a, nb = b;
            if (more) { nxt = conv_task(p, l, nx); conv_load(nxt, tid, na, nb); }
            conv_store(scr, cur, tid, a, b);
            if (!more) break;
            cur = nxt; a = na; b = nb; it = nx;
        }
    }
    bf16_t* waxt = (bf16_t*)(ws + WS_WAXT); bf16_t* pwt = (bf16_t*)(ws + WS_PWT);
    const float* wa = p.in[zz() + 13] + (size_t)l * 8 * 64 * 64; const float* wx = p.in[zz() + 15] + (size_t)l * 8 * 64 * 64; const float* pw = p.in[zz() + 22] + (size_t)l * 4 * 128 * 128;
    for (int e = lbid() * NTHR + ltid(); e < 65536; e += lgdim() * NTHR) {
        { const int h = e >> 13, jp = (e >> 6) & 127, i = e & 63; waxt[e] = f2bf(jp < 64 ? wa[(h * 64 + i) * 64 + jp] : wx[(h * 64 + i) * 64 + jp - 64]); }
        { const int g = e >> 14, d = (e >> 7) & 127, c = e & 127; pwt[e] = f2bf(pw[(g * 128 + c) * 128 + d]); }
    }
}

__device__ __forceinline__ void rms_rows_bf16(const float* X, const float* gain, bf16_t* H, int nrows) {
    const int wid = ltid() >> 6, lane = ltid() & 63;
    f32x4 gv[4];
#pragma unroll
    for (int j = 0; j < 4; ++j) gv[j] = *(const f32x4*)(gain + (lane + 64 * j) * 4);
    for (int row0 = (lbid() * 8 + wid) * 4; row0 < nrows; row0 += lgdim() * 32) {
        f32x4 v[4][4];
#pragma unroll
        for (int r = 0; r < 4; ++r) { const f32x4* xr = (const f32x4*)(X + (size_t)min(row0 + r, nrows - 1) * D) + lane;
#pragma unroll
            for (int j = 0; j < 4; ++j) v[r][j] = xr[64 * j]; }
#pragma unroll
        for (int r = 0; r < 4; ++r) {
            float s = 0.f;
#pragma unroll
            for (int j = 0; j < 4; ++j) s += (v[r][j].x * v[r][j].x + v[r][j].y * v[r][j].y) + (v[r][j].z * v[r][j].z + v[r][j].w * v[r][j].w);
            const float rs = rsqrtf(wave_sum(s) * (1.0f / D) + EPS);
            u32x2* o = (u32x2*)(H + (size_t)(row0 + r) * D) + lane;
            if (row0 + r < nrows)
#pragma unroll
            for (int j = 0; j < 4; ++j) { u32x2 w; w.x = cvt_pk_bf16(v[r][j].x * rs * gv[j].x, v[r][j].y * rs * gv[j].y); w.y = cvt_pk_bf16(v[r][j].z * rs * gv[j].z, v[r][j].w * rs * gv[j].w); o[64 * j] = w; }
        }
    }
}
__device__ __forceinline__ void rms_rows_f32_inplace(float* X, const float* gain, int nrows) {
    const int wid = ltid() >> 6, lane = ltid() & 63;
    f32x4 gv[4];
#pragma unroll
    for (int j = 0; j < 4; ++j) gv[j] = *(const f32x4*)(gain + (lane + 64 * j) * 4);
    for (int row0 = (lbid() * 8 + wid) * 4; row0 < nrows; row0 += lgdim() * 32) {
        f32x4 v[4][4];
#pragma unroll
        for (int r = 0; r < 4; ++r) { const f32x4* xr = (const f32x4*)(X + (size_t)min(row0 + r, nrows - 1) * D) + lane;
#pragma unroll
            for (int j = 0; j < 4; ++j) v[r][j] = xr[64 * j]; }
#pragma unroll
        for (int r = 0; r < 4; ++r) {
            float s = 0.f;
#pragma unroll
            for (int j = 0; j < 4; ++j) s += (v[r][j].x * v[r][j].x + v[r][j].y * v[r][j].y) + (v[r][j].z * v[r][j].z + v[r][j].w * v[r][j].w);
            const float rs = rsqrtf(wave_sum(s) * (1.0f / D) + EPS);
            f32x4* xo = (f32x4*)(X + (size_t)(row0 + r) * D) + lane;
            if (row0 + r < nrows)
#pragma unroll
            for (int j = 0; j < 4; ++j) xo[64 * j] = v[r][j] * rs * gv[j];
        }
    }
}

__device__ __forceinline__ void sgu_tile(LAS unsigned char* lds, const Params& p, int l, const bf16_t* proj, bf16_t* ya, int tile) {
    const int tid = ltid(), wid = tid >> 6, lane = tid & 63, fr = lane & 15, fq = lane >> 4;
    const int blk = tile >> 2, g = tile & 3, r0 = blk * 128;
    LAS bf16_t* Wl = (LAS bf16_t*)lds;
    LAS bf16_t* VT = (LAS bf16_t*)(lds + 34816);
    const float* lng = p.in[zz() + 7] + l * 512 + g * 128; const float* lnb = p.in[zz() + 8] + l * 512 + g * 128;
    {
        const int i = tid >> 2, qd = tid & 3;
        const bf16_t* vrow = proj + (size_t)(r0 + i) * PW + PC_AV + qd * 8;
        float s = 0.f, s2 = 0.f;
#pragma unroll 4
        for (int e8 = 0; e8 < 16; ++e8) { const u32x4 w = *(const u32x4*)(vrow + e8 * 32);
#pragma unroll
            for (int q = 0; q < 4; ++q) { const float a = geluf_(lo_bf(w[q])), b = geluf_(hi_bf(w[q])); s += a + b; s2 += a * a + b * b; } }
        s += __shfl_xor(s, 1); s += __shfl_xor(s, 2); s2 += __shfl_xor(s2, 1); s2 += __shfl_xor(s2, 2);
        const float mean = s * (1.0f / 512.0f), var = fmaxf(s2 * (1.0f / 512.0f) - mean * mean, 0.f), rstd = rsqrtf(var + EPS);
        const bf16_t* vg = proj + (size_t)(r0 + i) * PW + PC_AV + g * 128 + qd * 8;
#pragma unroll
        for (int e8 = 0; e8 < 4; ++e8) { const u32x4 w = *(const u32x4*)(vg + e8 * 32);
#pragma unroll
            for (int q = 0; q < 4; ++q) { const int c = e8 * 32 + qd * 8 + 2 * q;
                VT[c * 136 + i] = f2bf((geluf_(lo_bf(w[q])) - mean) * rstd * lng[c] + lnb[c]);
                VT[(c + 1) * 136 + i] = f2bf((geluf_(hi_bf(w[q])) - mean) * rstd * lng[c + 1] + lnb[c + 1]); } }
        const float* wsrc = p.in[zz() + 9] + (((size_t)l * 4 + g) * 128 + i) * 128 + qd * 32;
#pragma unroll
        for (int e4 = 0; e4 < 8; ++e4) { f32x4 w = *(const f32x4*)(wsrc + e4 * 4); if (i < 64 && qd >= 2) w = (f32x4){0.f, 0.f, 0.f, 0.f};
            u32x2 o; o.x = cvt_pk_bf16(w.x, w.y); o.y = cvt_pk_bf16(w.z, w.w); *(LAS u32x2*)(Wl + i * 136 + qd * 32 + e4 * 4) = o; }
    }
    __syncthreads();
    f32x4 acc[8];
#pragma unroll
    for (int n = 0; n < 8; ++n) acc[n] = (f32x4){0.f, 0.f, 0.f, 0.f};
#pragma unroll
    for (int ks = 0; ks < 4; ++ks) {
        const bf16x8 af = *(const LAS bf16x8*)(Wl + (wid * 16 + fr) * 136 + ks * 32 + fq * 8);
#pragma unroll
        for (int n = 0; n < 8; ++n) { const bf16x8 bf = *(const LAS bf16x8*)(VT + (n * 16 + fr) * 136 + ks * 32 + fq * 8); acc[n] = __builtin_amdgcn_mfma_f32_16x16x32_bf16(bf, af, acc[n], 0, 0, 0); }
    }
    {
        const int i = wid * 16 + fr; const float bias = p.in[zz() + 10][((size_t)l * 4 + g) * 128 + i];
        const bf16_t* up = proj + (size_t)(r0 + i) * PW + PC_AU + g * 128 + fq * 4;
        bf16_t* yp = ya + (size_t)(r0 + i) * 512 + g * 128 + fq * 4;
#pragma unroll
        for (int n = 0; n < 8; ++n) { const u32x2 uw = *(const u32x2*)(up + n * 16);
            u32x2 o; o.x = cvt_pk_bf16((acc[n][0] + bias) * geluf_(lo_bf(uw.x)), (acc[n][1] + bias) * geluf_(hi_bf(uw.x)));
            o.y = cvt_pk_bf16((acc[n][2] + bias) * geluf_(lo_bf(uw.y)), (acc[n][3] + bias) * geluf_(hi_bf(uw.y))); *(u32x2*)(yp + n * 16) = o; }
    }
    __syncthreads();
}

template <int WIN>
__device__ __forceinline__ void pool_rows(LAS bf16_t* Al, const bf16_t* xcol, int c, int pos0) {
    float xv[80];
#pragma unroll
    for (int k = 0; k < 80; ++k) xv[k] = (pos0 - 16 + k >= 0) ? bf2f(xcol[(long)(k - 16) * PW]) : 0.f;
    float s = 0.f;
#pragma unroll
    for (int j = 0; j < WIN; ++j) s += xv[16 - j];
#pragma unroll
    for (int tt = 0; tt < 64; ++tt) {
        const int k = tt + 16;
        const int cnt = min(pos0 + tt + 1, WIN);
        Al[tt * 520 + c] = f2bf(s / (float)cnt - xv[k]);
        if (tt < 63) s += xv[k + 1] - xv[k + 1 - WIN];
    }
}
__device__ __forceinline__ void pool_tile(LAS unsigned char* lds, const Params& p, int l, const bf16_t* proj, bf16_t* yd, bf16_t* halo, const bf16_t* pwt, int tile) {
    const int tid = ltid(), wid = tid >> 6, lane = tid & 63, fr = lane & 15, fq = lane >> 4;
    const int t0 = tile * 64, pos0 = t0 % SEQ;
    LAS bf16_t* Al = (LAS bf16_t*)lds;
    {
        const int c = tid, g = wid >> 1;
        const bf16_t* xcol = proj + (size_t)t0 * PW + PC_DX + c;
        if (g == 0) pool_rows<2>(Al, xcol, c, pos0); else if (g == 1) pool_rows<4>(Al, xcol, c, pos0); else if (g == 2) pool_rows<8>(Al, xcol, c, pos0); else pool_rows<16>(Al, xcol, c, pos0);
    }
    __syncthreads();
    {
        const int g = wid >> 1, nh = wid & 1;
        f32x4 acc[4][4];
#pragma unroll
        for (int m = 0; m < 4; ++m)
#pragma unroll
            for (int n = 0; n < 4; ++n) acc[m][n] = (f32x4){0.f, 0.f, 0.f, 0.f};
#pragma unroll
        for (int ks = 0; ks < 4; ++ks) {
            bf16x8 bfr[4];
#pragma unroll
            for (int n = 0; n < 4; ++n) bfr[n] = *(const bf16x8*)(pwt + ((size_t)(g * 128 + (nh * 4 + n) * 16 + fr)) * 128 + ks * 32 + fq * 8);
#pragma unroll
            for (int m = 0; m < 4; ++m) { const bf16x8 af = *(const LAS bf16x8*)(Al + (m * 16 + fr) * 520 + g * 128 + ks * 32 + fq * 8);
#pragma unroll
                for (int n = 0; n < 4; ++n) acc[m][n] = __builtin_amdgcn_mfma_f32_16x16x32_bf16(bfr[n], af, acc[m][n], 0, 0, 0); }
        }
        const float* sc = p.in[zz() + 23] + l * 512 + g * 128;
#pragma unroll
        for (int n = 0; n < 4; ++n) { const int d = (nh * 4 + n) * 16 + fq * 4; const f32x4 s4 = *(const f32x4*)(sc + d);
#pragma unroll
            for (int m = 0; m < 4; ++m) { u32x2 o; o.x = cvt_pk_bf16(acc[m][n][0] * s4[0], acc[m][n][1] * s4[1]); o.y = cvt_pk_bf16(acc[m][n][2] * s4[2], acc[m][n][3] * s4[3]);
                *(u32x2*)(yd + (size_t)(t0 + m * 16 + fr) * 512 + g * 128 + d) = o; } }
    }
    __syncthreads();
}

__device__ __forceinline__ void lru_tile(LAS unsigned char* lds, const Params& p, int l, const bf16_t* proj, bf16_t* yb, const bf16_t* waxt, float* Aend, float* Hend, const float* carry, int tile, int mode) {
    const int tid = ltid(), wid = tid >> 6, lane = tid & 63, fr = lane & 15, fq = lane >> 4;
    const int t0 = tile * 64, pos0 = t0 % SEQ, c = wid * 64 + lane;
    LAS bf16_t* Aw = (LAS bf16_t*)(lds + wid * 10560);
    LAS float* Xw = (LAS float*)(lds + wid * 10560 + 2304);
    bf16x8 bfr[8][2];
#pragma unroll
    for (int n = 0; n < 8; ++n)
#pragma unroll
        for (int ks = 0; ks < 2; ++ks) bfr[n][ks] = *(const bf16x8*)(waxt + ((size_t)(wid * 128 + n * 16 + fr)) * 64 + ks * 32 + fq * 8);
    const float* cwp = p.in[zz() + 11] + (size_t)l * 4 * 512 + c;
    const float cw0 = cwp[0], cw1 = cwp[512], cw2 = cwp[1024], cw3 = cwp[1536], cb = p.in[zz() + 12][l * 512 + c];
    const float ba = p.in[zz() + 14][l * 512 + c], bx = p.in[zz() + 16][l * 512 + c], sp8 = 8.0f * softplusf_(-p.in[zz() + 17][l * 512 + c]);
    const bf16_t* xcol = proj + (size_t)t0 * PW + PC_BX + c;
    float xm3 = 0.f, xm2 = 0.f, xm1 = 0.f;
    if (pos0 > 0) { xm3 = bf2f(xcol[-3L * PW]); xm2 = bf2f(xcol[-2L * PW]); xm1 = bf2f(xcol[-1L * PW]); }
    const bf16_t* gcol = proj + (size_t)t0 * PW + PC_BG + c;
    bf16_t* ycol = yb + (size_t)t0 * 512 + c;
    float h = mode ? carry[(size_t)tile * 512 + c] : 0.f, Ap = 1.f;
    for (int sub = 0; sub < 4; ++sub) {
        float xc[16];
#pragma unroll
        for (int tt = 0; tt < 16; ++tt) { const float xin = bf2f(*xcol); xcol += PW; xc[tt] = cb + cw0 * xm3 + cw1 * xm2 + cw2 * xm1 + cw3 * xin; xm3 = xm2; xm2 = xm1; xm1 = xin; Aw[tt * 72 + lane] = f2bf(xc[tt]); }
        __syncthreads();
        f32x4 acc[8];
#pragma unroll
        for (int n = 0; n < 8; ++n) acc[n] = (f32x4){0.f, 0.f, 0.f, 0.f};
#pragma unroll
        for (int ks = 0; ks < 2; ++ks) { const bf16x8 af = *(const LAS bf16x8*)(Aw + fr * 72 + ks * 32 + fq * 8);
#pragma unroll
            for (int n = 0; n < 8; ++n) acc[n] = __builtin_amdgcn_mfma_f32_16x16x32_bf16(bfr[n][ks], af, acc[n], 0, 0, 0); }
#pragma unroll
        for (int n = 0; n < 8; ++n)
#pragma unroll
            for (int j = 0; j < 4; ++j) Xw[fr * 129 + n * 16 + fq * 4 + j] = acc[n][j];
        __syncthreads();
#pragma unroll
        for (int tt = 0; tt < 16; ++tt) {
            const float r = sigmoidf_(Xw[tt * 129 + lane] + ba), ig = sigmoidf_(Xw[tt * 129 + 64 + lane] + bx);
            const float la = -sp8 * r, a = __expf(la), x2 = 2.0f * la;
            const float om = (x2 > -0.1f) ? -x2 * (1.0f + x2 * (0.5f + x2 * (0.16666667f + x2 * 0.041666668f))) : 1.0f - a * a;
            h = a * h + __builtin_amdgcn_sqrtf(om) * ig * xc[tt]; Ap *= a;
            if (mode) { const float gt = bf2f(*gcol); gcol += PW; *ycol = f2bf(h * geluf_(gt)); ycol += 512; }
        }
        __syncthreads();
    }
    if (!mode) { Aend[(size_t)tile * 512 + c] = Ap; Hend[(size_t)tile * 512 + c] = h; }
}
__device__ __forceinline__ void lru_carry(const float* Aend, const float* Hend, float* carry) {
    const int gid = lbid() * NTHR + ltid();
    if (gid < (TS / SEQ) * 512) {
        const int bl = gid >> 9, c = gid & 511; float h = 0.f;
        for (int n = 0; n < 64; ++n) { const size_t o = (size_t)(bl * 64 + n) * 512 + c; carry[o] = h; h = Aend[o] * h + Hend[o]; }
    }
}

__device__ __forceinline__ void gdn_prep(LAS unsigned char* lds, const Params& p, int l, const bf16_t* proj, const float* AB, bf16_t* GQ, bf16_t* GK, bf16_t* GU, bf16_t* GW, bf16_t* GA, float* edec, int item) {
    const int tid = ltid(), wid = tid >> 6, lane = tid & 63, fr = lane & 15, fq = lane >> 4;
    const int bl = item >> 8, n = (item & 255) >> 2, hh = item & 3, ch = bl * 64 + n, t0 = ch * 64;
    LAS bf16_t* Kl = (LAS bf16_t*)lds;
    LAS bf16_t* Ql = (LAS bf16_t*)(lds + 17408);
    LAS float* RHS = (LAS float*)(lds + 34816);
    LAS float* Am = (LAS float*)(lds + 101376);
    LAS float* gc = (LAS float*)(lds + 117760);
    LAS float* bt = (LAS float*)(lds + 118016);
    const int t = tid >> 3, d0 = (tid & 7) * 16;
    float qkv[3][16];
#pragma unroll
    for (int sec = 0; sec < 3; ++sec) {
        const int colh = sec * 512 + hh * 128 + d0;
        float a[16];
#pragma unroll
        for (int e = 0; e < 16; ++e) a[e] = 0.f;
#pragma unroll
        for (int k = 0; k < 4; ++k) {
            const int tt = t - 3 + k;
            const bf16_t* src = nullptr;
            if (tt >= 0 || n > 0) src = proj + (long)(t0 + tt) * PW + PC_CQ + colh;
            if (src) {
                const u32x4 w0 = *(const u32x4*)src, w1 = *(const u32x4*)(src + 8);
                const float* cw = p.in[zz() + 18] + ((size_t)l * 4 + k) * 1536 + colh;
#pragma unroll
                for (int q = 0; q < 4; ++q) { const f32x4 c4 = *(const f32x4*)(cw + q * 4);
                    const unsigned wa = (q < 2) ? w0[2 * q] : w1[2 * q - 4], wb = (q < 2) ? w0[2 * q + 1] : w1[2 * q - 3];
                    a[q * 4 + 0] += c4[0] * lo_bf(wa); a[q * 4 + 1] += c4[1] * hi_bf(wa); a[q * 4 + 2] += c4[2] * lo_bf(wb); a[q * 4 + 3] += c4[3] * hi_bf(wb); }
            }
        }
#pragma unroll
        for (int e = 0; e < 16; ++e) qkv[sec][e] = siluf_(a[e]);
    }
    {
        float sq = 0.f, sk = 0.f;
#pragma unroll
        for (int e = 0; e < 16; ++e) { sq += qkv[0][e] * qkv[0][e]; sk += qkv[1][e] * qkv[1][e]; }
        sq += __shfl_xor(sq, 1); sq += __shfl_xor(sq, 2); sq += __shfl_xor(sq, 4); sk += __shfl_xor(sk, 1); sk += __shfl_xor(sk, 2); sk += __shfl_xor(sk, 4);
        const float qn = rsqrtf(sq + EPS) * 0.08838834764831845f, kn = rsqrtf(sk + EPS);
#pragma unroll
        for (int e = 0; e < 16; ++e) { qkv[0][e] *= qn; qkv[1][e] *= kn; }
#pragma unroll
        for (int e = 0; e < 16; e += 2) { *(LAS unsigned*)(Ql + t * 136 + d0 + e) = cvt_pk_bf16(qkv[0][e], qkv[0][e + 1]); *(LAS unsigned*)(Kl + t * 136 + d0 + e) = cvt_pk_bf16(qkv[1][e], qkv[1][e + 1]); }
    }
    if (wid == 0) {
        const float al = AB[(size_t)(t0 + lane) * 8 + 4 + hh], be = AB[(size_t)(t0 + lane) * 8 + hh];
        float gv = -__expf(p.in[zz() + 19][l * 4 + hh]) * softplusf_(al + p.in[zz() + 20][l * 4 + hh]);
#pragma unroll
        for (int o = 1; o < 64; o <<= 1) { const float u = __shfl_up(gv, o); if (lane >= o) gv += u; }
        gc[lane] = gv; bt[lane] = sigmoidf_(be);
        if (lane == 63) edec[item] = __expf(gv);
    }
    __syncthreads();
    {
        const float bet = bt[t], gct = gc[t], eg = __expf(gct), ekd = __expf(gc[63] - gct);
#pragma unroll
        for (int e = 0; e < 16; ++e) { RHS[t * 260 + d0 + e] = qkv[2][e] * bet; RHS[t * 260 + 128 + d0 + e] = qkv[1][e] * bet * eg; }
        bf16_t* qdst = GQ + (size_t)(t0 + t) * 512 + hh * 128 + d0;
        u32x4 w0, w1;
        w0.x = cvt_pk_bf16(qkv[0][0] * eg, qkv[0][1] * eg); w0.y = cvt_pk_bf16(qkv[0][2] * eg, qkv[0][3] * eg); w0.z = cvt_pk_bf16(qkv[0][4] * eg, qkv[0][5] * eg); w0.w = cvt_pk_bf16(qkv[0][6] * eg, qkv[0][7] * eg);
        w1.x = cvt_pk_bf16(qkv[0][8] * eg, qkv[0][9] * eg); w1.y = cvt_pk_bf16(qkv[0][10] * eg, qkv[0][11] * eg); w1.z = cvt_pk_bf16(qkv[0][12] * eg, qkv[0][13] * eg); w1.w = cvt_pk_bf16(qkv[0][14] * eg, qkv[0][15] * eg);
        *(u32x4*)qdst = w0; *(u32x4*)(qdst + 8) = w1;
#pragma unroll
        for (int e = 0; e < 16; ++e) qkv[1][e] *= ekd;
    }
    {
        const int it = wid & 3, which = wid >> 2;
        LAS bf16_t* Xi = which ? Ql : Kl;
        bf16x8 af[4];
#pragma unroll
        for (int ks = 0; ks < 4; ++ks) af[ks] = *(const LAS bf16x8*)(Xi + (it * 16 + fr) * 136 + ks * 32 + fq * 8);
        const int i = it * 16 + fr; const float gci = gc[i], bti = bt[i];
#pragma unroll
        for (int jt = 0; jt < 4; ++jt) {
            f32x4 acc = (f32x4){0.f, 0.f, 0.f, 0.f};
#pragma unroll
            for (int ks = 0; ks < 4; ++ks) { const bf16x8 bf = *(const LAS bf16x8*)(Kl + (jt * 16 + fr) * 136 + ks * 32 + fq * 8); acc = __builtin_amdgcn_mfma_f32_16x16x32_bf16(bf, af[ks], acc, 0, 0, 0); }
            float v[4];
#pragma unroll
            for (int jj = 0; jj < 4; ++jj) { const int j = jt * 16 + fq * 4 + jj; const float dec = (i >= j) ? __expf(gci - gc[j]) : 0.f;
                v[jj] = which ? acc[jj] * dec : ((i > j) ? bti * acc[jj] * dec : 0.f); }
            if (which) { u32x2 o; o.x = cvt_pk_bf16(v[0], v[1]); o.y = cvt_pk_bf16(v[2], v[3]); *(u32x2*)(GA + (size_t)(t0 + i) * 256 + hh * 64 + jt * 16 + fq * 4) = o; }
            else *(LAS f32x4*)(Am + i * 64 + jt * 16 + fq * 4) = (f32x4){v[0], v[1], v[2], v[3]};
        }
    }
    __syncthreads();
    {
        LAS bf16_t* KDT = Ql;
#pragma unroll
        for (int e = 0; e < 16; ++e) KDT[(d0 + e) * 68 + t] = f2bf(qkv[1][e]);
    }
    if (tid < 256) {
        float x[64];
        int lz; asm volatile("v_mov_b32 %0, 0" : "=v"(lz));
        const LAS float* Amz = Am + lz;
#pragma unroll
        for (int i = 0; i < 64; ++i) x[i] = 0.f;
#pragma unroll
        for (int i = 0; i < 64; ++i) {
            float s = RHS[i * 260 + tid];
#pragma unroll
            for (int j4 = 0; j4 < (i + 3) / 4; ++j4) { const f32x4 a4 = *(const LAS f32x4*)(Amz + i * 64 + j4 * 4);
                s -= a4[0] * x[j4 * 4]; s -= a4[1] * x[j4 * 4 + 1]; s -= a4[2] * x[j4 * 4 + 2]; s -= a4[3] * x[j4 * 4 + 3]; }
            x[i] = s; RHS[i * 260 + tid] = s;
        }
    }
    __syncthreads();
    {
        const int seg = tid & 7;
        const LAS float* xr = RHS + t * 260 + seg * 32;
        bf16_t* dst = ((seg < 4) ? GU : GW) + (size_t)(t0 + t) * 512 + hh * 128 + (seg & 3) * 32;
#pragma unroll
        for (int q = 0; q < 4; ++q) { const f32x4 a = *(const LAS f32x4*)(xr + q * 8), b = *(const LAS f32x4*)(xr + q * 8 + 4);
            u32x4 w; w.x = cvt_pk_bf16(a[0], a[1]); w.y = cvt_pk_bf16(a[2], a[3]); w.z = cvt_pk_bf16(b[0], b[1]); w.w = cvt_pk_bf16(b[2], b[3]); *(u32x4*)(dst + q * 8) = w; }
        const LAS bf16_t* kr = Ql + (2 * t + (seg >> 2)) * 68 + (seg & 3) * 16;
        const u32x2 k0 = *(const LAS u32x2*)kr, k1 = *(const LAS u32x2*)(kr + 4), k2 = *(const LAS u32x2*)(kr + 8), k3 = *(const LAS u32x2*)(kr + 12);
        bf16_t* kdst = GK + (size_t)(t0 + t) * 512 + hh * 128 + seg * 16;
        *(u32x4*)kdst = (u32x4){k0.x, k0.y, k1.x, k1.y}; *(u32x4*)(kdst + 8) = (u32x4){k2.x, k2.y, k3.x, k3.y};
    }
    __syncthreads();
}

__device__ __forceinline__ void gdn_scan(LAS unsigned char* lds, const unsigned char* ws, float* oraw, const float* edec, int chain) {
    const int tid = ltid(), wid = __builtin_amdgcn_readfirstlane(tid >> 6), lane = tid & 63, fr = lane & 15, fq = lane >> 4;
    const int bl = chain >> 5, hh = (chain >> 3) & 3, es = chain & 7, e0 = es * 16;
    constexpr int BUF = 64512, O_W = 0, O_Q = 17408, O_KT = 34816, O_AT = 53248, O_U = 62464, O_PS = 2 * BUF, O_PV = 2 * BUF + 4096;
    const unsigned rb = (unsigned)(bl * 64) * 64u;
    const bool stager = (wid >= 2);
    int soff[10], doff[10];
    {
        const int sid = tid - 128;
#pragma unroll
        for (int s = 0; s < 10; ++s) {
            int idx = sid + 384 * s; if (idx >= 3712) idx -= 128;
            if (!stager) { soff[s] = 0; doff[s] = 0; }
            else if (idx < 1024) { const int row = idx >> 4, pc = idx & 15; soff[s] = (int)(WS_GDW + ((size_t)(rb + row) * 512 + hh * 128 + pc * 8) * 2); doff[s] = O_W + (row * 136 + pc * 8) * 2; }
            else if (idx < 2048) { const int i2 = idx - 1024, row = i2 >> 4, pc = i2 & 15; soff[s] = (int)(WS_GDQ + ((size_t)(rb + row) * 512 + hh * 128 + pc * 8) * 2); doff[s] = O_Q + (row * 136 + pc * 8) * 2; }
            else if (idx < 3072) { const int i2 = idx - 2048, row = i2 >> 4, pc = i2 & 15; soff[s] = (int)(WS_GDK + ((size_t)(rb + row) * 512 + hh * 128 + pc * 8) * 2); doff[s] = O_KT + ((2 * row + (pc >> 3)) * 72 + (pc & 7) * 8) * 2; }
            else if (idx < 3584) { const int i2 = idx - 3072, row = i2 >> 3, pc = i2 & 7; soff[s] = (int)(WS_GDA + ((size_t)(rb + row) * 256 + hh * 64 + pc * 8) * 2); doff[s] = O_AT + (row * 72 + pc * 8) * 2; }
            else { const int i2 = idx - 3584, row = i2 >> 1, pc = i2 & 1; soff[s] = (int)(WS_GDU + ((size_t)(rb + row) * 512 + hh * 128 + e0 + pc * 8) * 2); doff[s] = O_U + (row * 16 + pc * 8) * 2; }
        }
    }
    const unsigned step9 = (tid - 128 < 128) ? 32768u : 65536u;
#define SSTEP(s) ((s) < 8 ? 65536u : ((s) == 8 ? 32768u : step9))
    u32x4 stg[10];
    if (stager) {
#pragma unroll
        for (int s = 0; s < 10; ++s) stg[s] = *(const u32x4*)(ws + (unsigned)soff[s]);
#pragma unroll
        for (int s = 0; s < 10; ++s) *(LAS u32x4*)(lds + doff[s]) = stg[s];
#pragma unroll
        for (int s = 0; s < 10; ++s) stg[s] = *(const u32x4*)(ws + (unsigned)soff[s] + SSTEP(s));
    }
    if (wid == 1) {
#pragma unroll
        for (int kt = 0; kt < 4; ++kt) *(LAS u32x4*)(lds + O_PS + kt * 1024 + lane * 16) = (u32x4){0u, 0u, 0u, 0u};
    }
    const float dv = edec[bl * 256 + lane * 4 + hh];
    f32x4 Sacc[8];
#pragma unroll
    for (int d = 0; d < 8; ++d) Sacc[d] = (f32x4){0.f, 0.f, 0.f, 0.f};
    __syncthreads();
    for (int n = 0; n < 64; ++n) {
        const LAS unsigned char* B = lds + (n & 1) * BUF;
        const int t0 = (bl * 64 + n) * 64;
        f32x4 OS[4];
        bf16x8 vb[2];
        if (wid == 0) {
            f32x4 WS[4];
            bf16x8 sb[4];
#pragma unroll
            for (int kt = 0; kt < 4; ++kt) { u32x4 w; w.x = cvt_pk_bf16(Sacc[2 * kt][0], Sacc[2 * kt][1]); w.y = cvt_pk_bf16(Sacc[2 * kt][2], Sacc[2 * kt][3]);
                w.z = cvt_pk_bf16(Sacc[2 * kt + 1][0], Sacc[2 * kt + 1][1]); w.w = cvt_pk_bf16(Sacc[2 * kt + 1][2], Sacc[2 * kt + 1][3]); sb[kt] = __builtin_bit_cast(bf16x8, w); }
#pragma unroll
            for (int m = 0; m < 4; ++m) WS[m] = (f32x4){0.f, 0.f, 0.f, 0.f};
#pragma unroll
            for (int kt = 0; kt < 4; ++kt)
#pragma unroll
                for (int m = 0; m < 4; ++m) { const LAS unsigned char* wp = B + O_W + ((m * 16 + fr) * 136 + kt * 32 + fq * 4) * 2;
                    u32x4 wa; { const u32x2 lo = *(const LAS u32x2*)wp, hi = *(const LAS u32x2*)(wp + 32); wa.x = lo.x; wa.y = lo.y; wa.z = hi.x; wa.w = hi.y; }
                    WS[m] = __builtin_amdgcn_mfma_f32_16x16x32_bf16(__builtin_bit_cast(bf16x8, wa), sb[kt], WS[m], 0, 0, 0); }
#pragma unroll
            for (int m = 0; m < 4; ++m)
#pragma unroll
                for (int jj = 0; jj < 4; ++jj) WS[m][jj] = bf2f(*(const LAS bf16_t*)(B + O_U + ((m * 16 + fq * 4 + jj) * 16 + fr) * 2)) - WS[m][jj];
#pragma unroll
            for (int kc = 0; kc < 2; ++kc) { u32x4 w; w.x = cvt_pk_bf16(WS[2 * kc][0], WS[2 * kc][1]); w.y = cvt_pk_bf16(WS[2 * kc][2], WS[2 * kc][3]);
                w.z = cvt_pk_bf16(WS[2 * kc + 1][0], WS[2 * kc + 1][1]); w.w = cvt_pk_bf16(WS[2 * kc + 1][2], WS[2 * kc + 1][3]); vb[kc] = __builtin_bit_cast(bf16x8, w);
                *(LAS u32x4*)(lds + O_PV + kc * 1024 + lane * 16) = w; }
        } else if (wid == 1) {
#pragma unroll
            for (int m = 0; m < 4; ++m) OS[m] = (f32x4){0.f, 0.f, 0.f, 0.f};
#pragma unroll
            for (int kt = 0; kt < 4; ++kt) {
                const bf16x8 sbr = *(const LAS bf16x8*)(lds + O_PS + kt * 1024 + lane * 16);
#pragma unroll
                for (int m = 0; m < 4; ++m) { const LAS unsigned char* qp = B + O_Q + ((m * 16 + fr) * 136 + kt * 32 + fq * 4) * 2;
                    u32x4 qa; { const u32x2 lo = *(const LAS u32x2*)qp, hi = *(const LAS u32x2*)(qp + 32); qa.x = lo.x; qa.y = lo.y; qa.z = hi.x; qa.w = hi.y; }
                    OS[m] = __builtin_amdgcn_mfma_f32_16x16x32_bf16(__builtin_bit_cast(bf16x8, qa), sbr, OS[m], 0, 0, 0); }
            }
        }
        __syncthreads();
        if (wid == 0) {
            const float dec = __shfl(dv, n);
#pragma unroll
            for (int d = 0; d < 8; ++d) Sacc[d] *= dec;
#pragma unroll
            for (int kc = 0; kc < 2; ++kc)
#pragma unroll
                for (int d = 0; d < 8; ++d) { const LAS unsigned char* kp = B + O_KT + ((d * 16 + fr) * 72 + kc * 32 + fq * 4) * 2;
                    u32x4 a; { const u32x2 lo = *(const LAS u32x2*)kp, hi = *(const LAS u32x2*)(kp + 32); a.x = lo.x; a.y = lo.y; a.z = hi.x; a.w = hi.y; }
                    Sacc[d] = __builtin_amdgcn_mfma_f32_16x16x32_bf16(__builtin_bit_cast(bf16x8, a), vb[kc], Sacc[d], 0, 0, 0); }
#pragma unroll
            for (int kt = 0; kt < 4; ++kt) { u32x4 w; w.x = cvt_pk_bf16(Sacc[2 * kt][0], Sacc[2 * kt][1]); w.y = cvt_pk_bf16(Sacc[2 * kt][2], Sacc[2 * kt][3]);
                w.z = cvt_pk_bf16(Sacc[2 * kt + 1][0], Sacc[2 * kt + 1][1]); w.w = cvt_pk_bf16(Sacc[2 * kt + 1][2], Sacc[2 * kt + 1][3]);
                *(LAS u32x4*)(lds + O_PS + kt * 1024 + lane * 16) = w; }
        } else if (wid == 1) {
#pragma unroll
            for (int kc = 0; kc < 2; ++kc) {
                const bf16x8 vbr = *(const LAS bf16x8*)(lds + O_PV + kc * 1024 + lane * 16);
#pragma unroll
                for (int m = 0; m < 4; ++m) { const LAS unsigned char* ap = B + O_AT + ((m * 16 + fr) * 72 + kc * 32 + fq * 4) * 2;
                    u32x4 a; { const u32x2 lo = *(const LAS u32x2*)ap, hi = *(const LAS u32x2*)(ap + 32); a.x = lo.x; a.y = lo.y; a.z = hi.x; a.w = hi.y; }
                    OS[m] = __builtin_amdgcn_mfma_f32_16x16x32_bf16(__builtin_bit_cast(bf16x8, a), vbr, OS[m], 0, 0, 0); }
            }
            float* op = oraw + (size_t)(t0 + fq * 4) * 512 + hh * 128 + e0 + fr;
#pragma unroll
            for (int m = 0; m < 4; ++m)
#pragma unroll
                for (int jj = 0; jj < 4; ++jj) op[(size_t)(m * 16 + jj) * 512] = OS[m][jj];
        } else if (stager) {
            if (n + 1 < 64) { LAS unsigned char* Bn = lds + ((n + 1) & 1) * BUF;
#pragma unroll
                for (int s = 0; s < 10; ++s) *(LAS u32x4*)(Bn + doff[s]) = stg[s]; }
            if (n + 2 < 64) {
#pragma unroll
                for (int s = 0; s < 10; ++s) stg[s] = *(const u32x4*)(ws + (unsigned)soff[s] + (unsigned)(n + 2) * SSTEP(s)); }
        }
        __syncthreads();
    }
}
__device__ __forceinline__ void gdn_out(const Params& p, int l, const float* oraw, const bf16_t* proj, bf16_t* yc) {
    const int tid = ltid(), sub = tid & 15;
    const float* ng = p.in[zz() + 21] + l * 128 + sub * 8;
    const f32x4 g0 = *(const f32x4*)ng, g1 = *(const f32x4*)(ng + 4);
    for (int rowi = lbid() * 32 + (tid >> 4); rowi < TS * 4; rowi += lgdim() * 32) {
        const int t = rowi >> 2, hh = rowi & 3;
        const float* op = oraw + (size_t)t * 512 + hh * 128 + sub * 8;
        const f32x4 o0 = *(const f32x4*)op, o1 = *(const f32x4*)(op + 4);
        float ss = (o0[0] * o0[0] + o0[1] * o0[1]) + (o0[2] * o0[2] + o0[3] * o0[3]) + (o1[0] * o1[0] + o1[1] * o1[1]) + (o1[2] * o1[2] + o1[3] * o1[3]);
        ss += __shfl_xor(ss, 1); ss += __shfl_xor(ss, 2); ss += __shfl_xor(ss, 4); ss += __shfl_xor(ss, 8);
        const float rs = rsqrtf(ss * (1.0f / 128.0f) + EPS);
        const u32x4 z = *(const u32x4*)(proj + (size_t)t * PW + PC_CZ + hh * 128 + sub * 8);
        u32x4 w;
        w.x = cvt_pk_bf16(o0[0] * rs * g0[0] * siluf_(lo_bf(z.x)), o0[1] * rs * g0[1] * siluf_(hi_bf(z.x)));
        w.y = cvt_pk_bf16(o0[2] * rs * g0[2] * siluf_(lo_bf(z.y)), o0[3] * rs * g0[3] * siluf_(hi_bf(z.y)));
        w.z = cvt_pk_bf16(o1[0] * rs * g1[0] * siluf_(lo_bf(z.z)), o1[1] * rs * g1[1] * siluf_(hi_bf(z.z)));
        w.w = cvt_pk_bf16(o1[2] * rs * g1[2] * siluf_(lo_bf(z.w)), o1[3] * rs * g1[3] * siluf_(hi_bf(z.w)));
        *(u32x4*)(yc + (size_t)t * 512 + hh * 128 + sub * 8) = w;
    }
}

constexpr int PH_PER_LAYER = 22, N_PHASES = 2 * PH_PER_LAYER + 1;

__device__ __forceinline__ void run_phase(LAS unsigned char* lds, const Params& p, int ph) {
    unsigned char* ws = lptr(p.ws);
    bf16_t* hbuf = (bf16_t*)(ws + WS_H);
    bf16_t* act = (bf16_t*)(ws + WS_PROJ);
    bf16_t* proj = (bf16_t*)(ws + WS_PROJ);
    bf16_t* hslab = hbuf;
    bf16_t* merged = hbuf + (size_t)TS * D;
    float* oraw = (float*)(ws + WS_H);
    bf16_t* ys = (bf16_t*)(ws + WS_YS);
    float* AB = (float*)(ws + WS_AB);
    bf16_t* halo = (bf16_t*)(ws + WS_HALO);
    float* Aend = (float*)(ws + WS_AEND); float* Hend = (float*)(ws + WS_HEND); float* carry = (float*)(ws + WS_CARRY); float* edec = (float*)(ws + WS_EDEC);
    const bf16_t* waxt = (const bf16_t*)(ws + WS_WAXT); const bf16_t* pwt = (const bf16_t*)(ws + WS_PWT);
    const int G = lgdim(), c = lbid();
    if (ph == N_PHASES - 1) { PHON(0) rms_rows_f32_inplace(lptr(p.out), p.in[zz() + 30], T); return; }
    const int l = ph / PH_PER_LAYER, r = ph % PH_PER_LAYER;
    const float* xcur = (l == 0) ? p.in[zz() + 0] : lptr(p.out);
    if (r == 0) { PHON(1) convert_layer(lds, p, l); PHON(0) rms_rows_bf16(xcur, p.in[zz() + 1] + l * D, hbuf, T); return; }
    if (r == 1 || r == 20) { PHON(2) ph_gemm_swiglu(lds, hbuf, (const bf16_t*)(ws + (r == 1 ? WS_WGU1 : WS_WGU2)), act); return; }
    if (r == 2 || r == 21) { PHON(3) ph_gemm_resid(lds, act, (const bf16_t*)(ws + (r == 2 ? WS_WD1 : WS_WD2)), T, DFF, (r == 2) ? xcur : lptr(p.out), lptr(p.out), 0.5f); return; }
    if (r == 19) { rms_rows_bf16(lptr(p.out), p.in[zz() + 26] + l * D, hbuf, T); return; }
    const int slab = (r - 3) >> 3, q = (r - 3) & 7;
    float* xs = lptr(p.out) + (size_t)slab * TS * D;
    switch (q) {
    case 0: rms_rows_bf16(xs, p.in[zz() + 5] + l * D, hslab, TS); break;
    case 1: PHON(4) ph_gemm_proj(lds, hslab, (const bf16_t*)(ws + WS_WIN), proj, AB); break;
    case 2:
        PHON(7) for (int t = c; t < TS / 64; t += G) lru_tile(lds, p, l, proj, nullptr, waxt, Aend, Hend, carry, t, 0);
        if (G >= 256) { PHON(5) for (int t = c; t < (TS / 128) * 2; t += G) sgu_tile(lds, p, l, proj, ys, t); }
        break;
    case 3:
        PHON(8) for (int it = c; it < (TS / 64) * 4; it += G) gdn_prep(lds, p, l, proj, AB, (bf16_t*)(ws + WS_GDQ), (bf16_t*)(ws + WS_GDK), (bf16_t*)(ws + WS_GDU), (bf16_t*)(ws + WS_GDW), (bf16_t*)(ws + WS_GDA), edec, it);
        lru_carry(Aend, Hend, carry);
        break;
    case 4:
        PHON(9) if (c < 128 || G < 256) { for (int ch = c; ch < 128; ch += G) gdn_scan(lds, ws, oraw, edec, ch); }
        if (G >= 256) {
            if (c >= 128) {
                const int cc = c - 128, GG = G - 128;
                PHON(10) for (int t = cc; t < TS / 128; t += GG) lru_tile(lds, p, l, proj, ys + (size_t)TS * 512, waxt, Aend, Hend, carry, t, 1);
                PHON(5) for (int t = (TS / 128) * 2 + cc; t < (TS / 128) * 4; t += GG) sgu_tile(lds, p, l, proj, ys, t);
                PHON(6) for (int t = cc; t < TS / 64; t += GG) pool_tile(lds, p, l, proj, ys + (size_t)3 * TS * 512, halo, pwt, t);
            }
        } else {
            for (int t = c; t < TS / 64; t += G) lru_tile(lds, p, l, proj, ys + (size_t)TS * 512, waxt, Aend, Hend, carry, t, 1);
            for (int t = c; t < (TS / 128) * 4; t += G) sgu_tile(lds, p, l, proj, ys, t);
            for (int t = c; t < TS / 64; t += G) pool_tile(lds, p, l, proj, ys + (size_t)3 * TS * 512, halo, pwt, t);
        }
        break;
    case 5: if (G >= 256) { for (int t = TS / 128 + c; t < TS / 64; t += G) lru_tile(lds, p, l, proj, ys + (size_t)TS * 512, waxt, Aend, Hend, carry, t, 1); }
        PHON(11) gdn_out(p, l, oraw, proj, ys + (size_t)2 * TS * 512); break;
    case 6: PHON(12) ph_gemm_branch(lds, ys, (const bf16_t*)(ws + WS_WB), proj, merged); break;
    default: PHON(13) ph_gemm_resid(lds, merged, (const bf16_t*)(ws + WS_WOUT), TS, D, xs, xs, 1.0f); break;
    }
}

extern __shared__ __attribute__((aligned(16))) unsigned char smem_dyn[];

#ifndef DUP_TYPE
#define DUP_TYPE -1
#endif
__device__ __forceinline__ int phase_type(int ph) {
    if (ph == N_PHASES - 1) return 12;
    const int r = ph % PH_PER_LAYER;
    if (r == 0) return 0; if (r == 1 || r == 20) return 1; if (r == 2 || r == 21) return 2; if (r == 19) return 11;
    const int q = (r - 3) & 7;
    return 3 + q;
}
__global__ void __launch_bounds__(NTHR) fwd_megakernel(Params p) {
    cg::grid_group grid = cg::this_grid();
    LAS unsigned char* lds = (LAS unsigned char*)smem_dyn;
    volatile LAS unsigned* st = (volatile LAS unsigned*)(lds + LDS_BYTES - 16);
    if (threadIdx.x == 0) { st[0] = 0u; st[1] = 0u; }
    __syncthreads();
    const XcdBarrier xb = xcd_barrier_post((unsigned*)(p.ws + WS_BAR), st);
    grid.sync();
    for (int ph = p.ph_lo; ph < p.ph_hi; ++ph) {
        if (ph > p.ph_lo) xcd_barrier(xb);
        run_phase(lds, p, ph);
#if DUP_TYPE == 6
        if (phase_type(ph) == 6) { xcd_barrier(xb); run_phase(lds, p, ph - 2); xcd_barrier(xb); run_phase(lds, p, ph - 1); xcd_barrier(xb); run_phase(lds, p, ph); }
#elif DUP_TYPE >= 0
        if (phase_type(ph) == DUP_TYPE) { xcd_barrier(xb); run_phase(lds, p, ph); }
#endif
    }
}

extern "C" void kernel_launch(void* const* d_in, const int* in_sizes, int n_in, void* d_out, int out_size, void* d_ws, size_t ws_size, hipStream_t stream) {
    static int grid_blocks = 0;
    if (grid_blocks == 0) {
        if (n_in != 31 || out_size != T * D || ws_size < WS_END) { fprintf(stderr, "kernel_launch: unexpected shapes (n_in %d out %d ws %zu need %zu)\n", n_in, out_size, ws_size, (size_t)WS_END); grid_blocks = -1; return; }
        int dev = 0, cus = 0, per_cu = 0;
        hipGetDevice(&dev);
        hipDeviceGetAttribute(&cus, hipDeviceAttributeMultiprocessorCount, dev);
        if (hipFuncSetAttribute((const void*)fwd_megakernel, hipFuncAttributeMaxDynamicSharedMemorySize, LDS_BYTES) != hipSuccess) { fprintf(stderr, "kernel_launch: hipFuncSetAttribute failed\n"); grid_blocks = -1; return; }
        hipOccupancyMaxActiveBlocksPerMultiprocessor(&per_cu, (const void*)fwd_megakernel, NTHR, LDS_BYTES);
        if (per_cu < 1) { fprintf(stderr, "kernel_launch: occupancy query returned %d\n", per_cu); per_cu = 1; }
        grid_blocks = cus * per_cu;
    }
    if (grid_blocks < 0) return;
    Params p{};
    for (int i = 0; i < 31; ++i) p.in[i] = (const float*)d_in[i];
    p.out = (float*)d_out; p.ws = (unsigned char*)d_ws;
    hipMemsetAsync((unsigned char*)d_ws + WS_BAR, 0, 16384, stream);
    p.ph_lo = 0; p.ph_hi = N_PHASES;
    void* args[] = {&p};
    hipError_t e = hipLaunchCooperativeKernel((const void*)fwd_megakernel, dim3(grid_blocks), dim3(NTHR), args, LDS_BYTES, stream);
    if (e != hipSuccess) fprintf(stderr, "cooperative launch failed: %s (grid %d)\n", hipGetErrorString(e), grid_blocks);
}
```

```cpp
#include <hip/hip_runtime.h>
#include <hip/hip_cooperative_groups.h>
#include <cstdio>
namespace cg = cooperative_groups;

#ifndef MULTI_LAUNCH
#define MULTI_LAUNCH 0
#endif

#ifndef PH_MASK
#define PH_MASK 0xFFFFF
#endif
#define PHON(k) if constexpr ((PH_MASK >> (k)) & 1)
#define LAS __attribute__((address_space(3)))
typedef unsigned short bf16_t;
typedef short bf16x8 __attribute__((ext_vector_type(8)));
typedef short bf16x4 __attribute__((ext_vector_type(4)));
typedef float f32x4 __attribute__((ext_vector_type(4)));
typedef unsigned u32x4 __attribute__((ext_vector_type(4)));
typedef unsigned u32x2 __attribute__((ext_vector_type(2)));

constexpr int T = 32768, D = 1024, DFF = 2816, NSLAB = 2, TS = T / NSLAB, SEQ = 4096, PW = 8960, PIN = 8712;
constexpr int PC_AU = 0, PC_AV = 512, PC_BX = 1024, PC_BG = 1536, PC_CQ = 2048, PC_CK = 2560, PC_CV = 3072, PC_CZ = 3584, PC_DX = 4096, PC_GATE = 4608, PC_AB = 8704;
constexpr float EPS = 1e-6f;
constexpr int NTHR = 512;
constexpr int LDS_BYTES = 147456;

constexpr size_t WS_WGU1 = 0;
constexpr size_t WS_WD1 = WS_WGU1 + (size_t)5632 * 1024 * 2;
constexpr size_t WS_WIN = WS_WD1 + (size_t)1024 * 2816 * 2;
constexpr size_t WS_WB = WS_WIN + (size_t)PW * 1024 * 2;
constexpr size_t WS_WOUT = WS_WB + (size_t)4 * 1024 * 512 * 2;
constexpr size_t WS_WGU2 = WS_WOUT + (size_t)1024 * 1024 * 2;
constexpr size_t WS_WD2 = WS_WGU2 + (size_t)5632 * 1024 * 2;
constexpr size_t WS_WAXT = WS_WD2 + (size_t)1024 * 2816 * 2;
constexpr size_t WS_PWT = WS_WAXT + 131072;
constexpr size_t WS_PROJ = WS_PWT + 131072;
constexpr size_t WS_H = WS_PROJ + (size_t)TS * PW * 2;
constexpr size_t WS_YS = WS_H + (size_t)T * D * 2;
constexpr size_t WS_AB = WS_YS + (size_t)4 * TS * 512 * 2;
constexpr size_t WS_HALO = WS_AB + (size_t)TS * 8 * 4;
constexpr size_t WS_AEND = WS_HALO + (size_t)(TS / 64) * 3 * 1536 * 2;
constexpr size_t WS_HEND = WS_AEND + (size_t)(TS / 64) * 512 * 4;
constexpr size_t WS_CARRY = WS_HEND + (size_t)(TS / 64) * 512 * 4;
constexpr size_t WS_EDEC = WS_CARRY + (size_t)(TS / 64) * 512 * 4;
constexpr size_t WS_BAR = WS_EDEC + 4096;
constexpr size_t WS_GDQ = WS_H + (size_t)TS * D * 2;
constexpr size_t WS_GDK = WS_GDQ + (size_t)TS * 512 * 2;
constexpr size_t WS_GDU = WS_BAR + 16384;
constexpr size_t WS_GDW = WS_GDU + (size_t)TS * 512 * 2;
constexpr size_t WS_GDA = WS_GDW + (size_t)TS * 512 * 2;
constexpr size_t WS_END = WS_GDA + (size_t)TS * 256 * 2;
static_assert(WS_END <= (size_t)512 * 1024 * 1024, "workspace budget");

struct Params { const float* in[31]; float* out; unsigned char* ws; int ph_lo, ph_hi; };

__device__ __forceinline__ int ltid() { int t = threadIdx.x; asm volatile("" : "+v"(t)); return t; }
__device__ __forceinline__ int lbid() { int t = blockIdx.x; asm volatile("" : "+s"(t)); return t; }
__device__ __forceinline__ int lgdim() { int t = gridDim.x; asm volatile("" : "+s"(t)); return t; }
__device__ __forceinline__ int zz() { int z; asm volatile("s_mov_b32 %0, 0" : "=s"(z)); return z; }
template <class P> __device__ __forceinline__ P* lptr(P* q) { asm volatile("" : "+s"(q)); return q; }
__device__ __forceinline__ float bf2f(unsigned short b) { return __uint_as_float(((unsigned)b) << 16); }
__device__ __forceinline__ unsigned cvt_pk_bf16(float lo, float hi) { unsigned r; asm("v_cvt_pk_bf16_f32 %0, %1, %2" : "=v"(r) : "v"(lo), "v"(hi)); return r; }
__device__ __forceinline__ unsigned short f2bf(float f) { return (unsigned short)(cvt_pk_bf16(f, 0.f) & 0xffffu); }
__device__ __forceinline__ float lo_bf(unsigned w) { return __uint_as_float(w << 16); }
__device__ __forceinline__ float hi_bf(unsigned w) { return __uint_as_float(w & 0xffff0000u); }
__device__ __forceinline__ float sigmoidf_(float x) { return __builtin_amdgcn_rcpf(1.0f + __expf(-x)); }
__device__ __forceinline__ float siluf_(float x) { return x * __builtin_amdgcn_rcpf(1.0f + __expf(-x)); }
__device__ __forceinline__ float geluf_(float x) { const float u = 1.5957691216057308f * (x + 0.044715f * x * x * x); return x * __builtin_amdgcn_rcpf(1.0f + __expf(-u)); }
__device__ __forceinline__ float softplusf_(float x) { return fmaxf(x, 0.f) + log1pf(__expf(-fabsf(x))); }
__device__ __forceinline__ float wave_sum(float v) {
#pragma unroll
    for (int o = 1; o < 64; o <<= 1) v += __shfl_xor(v, o);
    return v;
}


#define XB_TMO      128
#define XB_XCNT(j)  (256  + 64 * (j))
#define XB_XSUB(j)  (1280 + 64 * (j))
#define XB_XGEN(j)  (2304 + 64 * (j))
#define XB_TOP      3328
#define XB_TOPGEN   3392
#define XCD_BAR_WORDS 3456
#define XB_SPIN_CAP (1u << 22)
__device__ __forceinline__ unsigned xb_ld(unsigned* p)              { return __hip_atomic_load(p, __ATOMIC_RELAXED, __HIP_MEMORY_SCOPE_AGENT); }
__device__ __forceinline__ unsigned xb_add(unsigned* p, unsigned v) { return __hip_atomic_fetch_add(p, v, __ATOMIC_RELAXED, __HIP_MEMORY_SCOPE_AGENT); }
__device__ __forceinline__ unsigned xb_xcc_id() { return (unsigned)__builtin_amdgcn_s_getreg((3 << 11) | 20) & 0xFu; }
#define XB_SPIN(cond, bar) do { unsigned _sp = 0; while (cond) { __builtin_amdgcn_s_sleep(1); \
    if ((++_sp & 255u) == 0u) { if (xb_ld(&(bar)[XB_TMO])) break; if (_sp > XB_SPIN_CAP) { atomicAdd(&(bar)[XB_TMO], 1u); break; } } } } while (0)
struct XcdBarrier { unsigned* bar; unsigned x; volatile LAS unsigned* st; };
__device__ __forceinline__ XcdBarrier xcd_barrier_post(unsigned* bar, volatile LAS unsigned* st) {
    XcdBarrier b; b.bar = bar; b.x = xb_xcc_id(); b.st = st;
    if (threadIdx.x == 0) (void)xb_add(&bar[XB_XCNT(b.x)], 1u);
    return b;
}
__device__ __forceinline__ void xcd_barrier_complete(unsigned* bar, unsigned x, unsigned& nloc, unsigned& nx) {
    const unsigned G = gridDim.x * gridDim.y * gridDim.z;
    unsigned sum, cnt, mine, sp = 0u;
    for (;;) {
        sum = 0u; cnt = 0u; mine = 0u;
#pragma unroll
        for (unsigned j = 0; j < 16; ++j) { const unsigned c = xb_ld(&bar[XB_XCNT(j)]); sum += c; cnt += (c > 0u) ? 1u : 0u; mine = (j == x) ? c : mine; }
        if (sum == G) break;
        __builtin_amdgcn_s_sleep(1);
        if ((++sp & 255u) == 0u) { if (xb_ld(&bar[XB_TMO])) break; if (sp > XB_SPIN_CAP) { atomicAdd(&bar[XB_TMO], 1u); break; } }
    }
    nloc = mine > 0u ? mine : 1u; nx = cnt > 0u ? cnt : 1u;
}
__device__ __forceinline__ void xcd_barrier(const XcdBarrier& b) {
    asm volatile("s_waitcnt vmcnt(0)" ::: "memory");
    __syncthreads();
    if (threadIdx.x == 0) {
        unsigned* bar = b.bar;
        __builtin_amdgcn_s_waitcnt(0);
        unsigned nloc = b.st[0], nx = b.st[1];
        if (nloc == 0u) { xcd_barrier_complete(bar, b.x, nloc, nx); b.st[0] = nloc; b.st[1] = nx; }
        const unsigned old = xb_add(&bar[XB_XSUB(b.x)], 1u);
        const unsigned gen = old / nloc;
        if (old + 1u == (gen + 1u) * nloc) {
            __builtin_amdgcn_fence(__ATOMIC_RELEASE, "agent");
            asm volatile("s_waitcnt vmcnt(0)" ::: "memory");
            const unsigned og = xb_add(&bar[XB_TOP], 1u);
            const unsigned tg = og / nx;
            if (og + 1u == (tg + 1u) * nx) xb_add(&bar[XB_TOPGEN], 1u);
            else XB_SPIN(xb_ld(&bar[XB_TOPGEN]) == tg, bar);
            __builtin_amdgcn_fence(__ATOMIC_ACQUIRE, "agent");
            xb_add(&bar[XB_XGEN(b.x)], 1u);
            asm volatile("s_waitcnt vmcnt(0)" ::: "memory");
        } else {
            XB_SPIN(xb_ld(&bar[XB_XGEN(b.x)]) == gen, bar);
            __builtin_amdgcn_fence(__ATOMIC_ACQUIRE, "agent");
            asm volatile("s_waitcnt vmcnt(0)" ::: "memory");
        }
    }
    __syncthreads();
}

namespace pg8 {
constexpr int BM = 256, BK = 64, HALF = 128, HTB = HALF * BK * 2, STAGE_BYTES = 8 * HTB, NXCD = 8, WGM = 8;
__host__ __device__ __forceinline__ int lds_byte(int r, int c) { const int st = (r >> 4) * 2 + (c >> 5), rr = r & 15, cc = c & 31, ob = rr * 64 + cc * 2; return st * 1024 + (ob ^ (((ob >> 9) & 1) << 5)); }
__host__ __device__ __forceinline__ void stage_rc(int b, int& R, int& C) { const int st = b / 1024, sb = b % 1024, swz = sb ^ (((sb >> 9) & 1) << 5); R = (st >> 1) * 16 + swz / 64; C = (st & 1) * 32 + (swz % 64) / 2; }
__host__ __device__ __forceinline__ int perm32(int rho) { const int n = rho >> 4, i = rho & 15; return 8 * (i >> 2) + 4 * n + (i & 3); }

struct Unit { int pm, pn, g; };
struct Gemm { const bf16_t* A; const bf16_t* Bt; int M, N, K; size_t gsA, gsB; };

__device__ __forceinline__ void tile_of(int wgid, int nM, int nN, int nwg, Unit& u) {
    { const int q = nwg / NXCD, r = nwg % NXCD, xcd = wgid % NXCD, off = wgid / NXCD; wgid = (xcd < r ? xcd * (q + 1) : r * (q + 1) + (xcd - r) * q) + off; }
    const int nig = WGM * nN, gid = wgid / nig, fm = gid * WGM, gsz = (nM - fm) < WGM ? (nM - fm) : WGM;
    u.pm = fm + ((wgid % nig) % gsz); u.pn = (wgid % nig) / gsz;
}
struct StaticOrder {
    int nM, nN, nwg, G, c;
    __device__ void init(int M, int N, int G_, int c_) { nM = M / BM; nN = N / BM; nwg = nM * nN; G = G_; c = c_; }
    __device__ bool next(int i, Unit& u) const {
        const long L = (long)i * G + c; if (L >= nwg) return false;
        tile_of((int)L, nM, nN, nwg, u); u.g = 0; return true;
    }
};
struct BranchOrder {
    int nM, nN, nwg, G, c;
    __device__ void init(int M, int N, int G_, int c_) { nM = M / BM; nN = N / BM; nwg = nM * nN; G = G_; c = c_; }
    __device__ bool next(int i, Unit& u) const {
        const long L = (long)(i >> 2) * G + c; if (L >= nwg) return false;
        tile_of((int)L, nM, nN, nwg, u); u.g = i & 3; return true;
    }
};

struct EpiSwiGLU {
    static constexpr bool PERM = true;
    bf16_t* O;
    __device__ __forceinline__ bool keep(const Unit&) const { return false; }
    __device__ __forceinline__ void operator()(f32x4 (&acc)[2][2][4][2], const Unit& u, int wr, int wc, int fr, int fq) const {
        const int row0 = u.pm * BM + wr * 64 + fr, col0 = u.pn * 128 + wc * 32 + 8 * fq;
#pragma unroll
        for (int ai = 0; ai < 2; ++ai)
#pragma unroll
            for (int m = 0; m < 4; ++m) {
                bf16_t* rowp = O + (size_t)(row0 + ai * HALF + m * 16) * DFF + col0;
                float v[8];
#pragma unroll
                for (int n = 0; n < 2; ++n)
#pragma unroll
                    for (int j = 0; j < 4; ++j) v[n * 4 + j] = siluf_(acc[ai][0][m][n][j]) * acc[ai][1][m][n][j];
                u32x4 w; w.x = cvt_pk_bf16(v[0], v[1]); w.y = cvt_pk_bf16(v[2], v[3]); w.z = cvt_pk_bf16(v[4], v[5]); w.w = cvt_pk_bf16(v[6], v[7]);
                *(u32x4*)rowp = w;
                __builtin_amdgcn_sched_barrier(0);
            }
    }
};
struct EpiResid {
    static constexpr bool PERM = false;
    const float* Xin; float* Xout; float scale;
    __device__ __forceinline__ bool keep(const Unit&) const { return false; }
    __device__ __forceinline__ void operator()(f32x4 (&acc)[2][2][4][2], const Unit& u, int wr, int wc, int fr, int fq) const {
        const int row0 = u.pm * BM + wr * 64 + fr, col0 = u.pn * BM + wc * 32 + 4 * fq;
#pragma unroll
        for (int ai = 0; ai < 2; ++ai) {
            f32x4 xi[4][2][2];
#pragma unroll
            for (int m = 0; m < 4; ++m) { const size_t ro = (size_t)(row0 + ai * HALF + m * 16) * D + col0;
#pragma unroll
                for (int bj = 0; bj < 2; ++bj)
#pragma unroll
                    for (int n = 0; n < 2; ++n) xi[m][bj][n] = *(const f32x4*)(Xin + ro + bj * HALF + n * 16); }
#pragma unroll
            for (int m = 0; m < 4; ++m) { const size_t ro = (size_t)(row0 + ai * HALF + m * 16) * D + col0;
#pragma unroll
                for (int bj = 0; bj < 2; ++bj)
#pragma unroll
                    for (int n = 0; n < 2; ++n) *(f32x4*)(Xout + ro + bj * HALF + n * 16) = xi[m][bj][n] + acc[ai][bj][m][n] * scale; }
            __builtin_amdgcn_sched_barrier(0);
        }
    }
};
struct EpiProj {
    static constexpr bool PERM = true;
    bf16_t* O; float* AB;
    __device__ __forceinline__ bool keep(const Unit&) const { return false; }
    __device__ __forceinline__ void operator()(f32x4 (&acc)[2][2][4][2], const Unit& u, int wr, int wc, int fr, int fq) const {
        const int row0 = u.pm * BM + wr * 64 + fr, col0 = u.pn * BM + wc * 32 + 8 * fq;
        const bool ab = (u.pn == PC_AB / BM) && wc == 0 && fq == 0;
#pragma unroll
        for (int ai = 0; ai < 2; ++ai)
#pragma unroll
            for (int m = 0; m < 4; ++m) {
                const int row = row0 + ai * HALF + m * 16;
                bf16_t* rowp = O + (size_t)row * PW + col0;
#pragma unroll
                for (int bj = 0; bj < 2; ++bj) {
                    const f32x4 v0 = acc[ai][bj][m][0], v1 = acc[ai][bj][m][1];
                    u32x4 w; w.x = cvt_pk_bf16(v0[0], v0[1]); w.y = cvt_pk_bf16(v0[2], v0[3]); w.z = cvt_pk_bf16(v1[0], v1[1]); w.w = cvt_pk_bf16(v1[2], v1[3]);
                    *(u32x4*)(rowp + bj * HALF) = w;
                }
                __builtin_amdgcn_sched_barrier(0);
            }
        if (ab) {
#pragma unroll
            for (int ai = 0; ai < 2; ++ai)
#pragma unroll
                for (int m = 0; m < 4; ++m) { const int row = row0 + ai * HALF + m * 16; *(f32x4*)(AB + (size_t)row * 8) = acc[ai][0][m][0]; *(f32x4*)(AB + (size_t)row * 8 + 4) = acc[ai][0][m][1]; }
        }
    }
};
struct EpiBranch {
    static constexpr bool PERM = true;
    const bf16_t* P; bf16_t* O;
    __device__ __forceinline__ bool keep(const Unit& u) const { return u.g < 3; }
    __device__ __forceinline__ void operator()(f32x4 (&acc)[2][2][4][2], const Unit& u, int wr, int wc, int fr, int fq) const {
        const int row0 = u.pm * BM + wr * 64 + fr, col0 = u.pn * BM + wc * 32 + 8 * fq;
        const bool last = (u.g == 3);
#pragma unroll
        for (int ai = 0; ai < 2; ++ai) {
            u32x4 g0[4][2], g1[4][2];
#pragma unroll
            for (int m = 0; m < 4; ++m) { const bf16_t* gp = P + (size_t)(row0 + ai * HALF + m * 16) * PW + PC_GATE + u.g * D + col0;
#pragma unroll
                for (int bj = 0; bj < 2; ++bj) { g0[m][bj] = *(const u32x4*)(gp + bj * HALF); g1[m][bj] = last ? g0[m][bj] : *(const u32x4*)(gp + D + bj * HALF); } }
#pragma unroll
            for (int m = 0; m < 4; ++m) {
                const int row = row0 + ai * HALF + m * 16;
#pragma unroll
                for (int bj = 0; bj < 2; ++bj) {
                    float f[8];
                    if (!last) {
#pragma unroll
                        for (int q = 0; q < 4; ++q) {
                            f[2 * q] = (1.0f + __expf(-lo_bf(g1[m][bj][q]))) * __builtin_amdgcn_rcpf(1.0f + __expf(-lo_bf(g0[m][bj][q])));
                            f[2 * q + 1] = (1.0f + __expf(-hi_bf(g1[m][bj][q]))) * __builtin_amdgcn_rcpf(1.0f + __expf(-hi_bf(g0[m][bj][q])));
                        }
                    } else {
#pragma unroll
                        for (int q = 0; q < 4; ++q) { f[2 * q] = __builtin_amdgcn_rcpf(1.0f + __expf(-lo_bf(g0[m][bj][q]))); f[2 * q + 1] = __builtin_amdgcn_rcpf(1.0f + __expf(-hi_bf(g0[m][bj][q]))); }
                    }
#pragma unroll
                    for (int n = 0; n < 2; ++n)
#pragma unroll
                        for (int j = 0; j < 4; ++j) acc[ai][bj][m][n][j] *= f[n * 4 + j];
                    if (last) {
                        const f32x4 v0 = acc[ai][bj][m][0], v1 = acc[ai][bj][m][1];
                        u32x4 w; w.x = cvt_pk_bf16(v0[0], v0[1]); w.y = cvt_pk_bf16(v0[2], v0[3]); w.z = cvt_pk_bf16(v1[0], v1[1]); w.w = cvt_pk_bf16(v1[2], v1[3]);
                        *(u32x4*)(O + (size_t)row * D + col0 + bj * HALF) = w;
                    }
                }
            }
            __builtin_amdgcn_sched_barrier(0);
        }
    }
};

template <class Epi, class Sched>
__device__ __forceinline__ void gemm_phase(LAS unsigned char* lds, const Gemm g, const Sched& S, const Epi& E) {
    const int tid = ltid(), wid = __builtin_amdgcn_readfirstlane(tid >> 6), lane = tid & 63, wr = wid >> 2, wc = wid & 3, fr = lane & 15, fq = lane >> 4;
    const int K = g.K, nt = K / BK;
    unsigned voffA[2], voffB[2];
#pragma unroll
    for (int i = 0; i < 2; ++i) { int R, C; stage_rc(tid * 16 + i * 8192, R, C); const int Rb = Epi::PERM ? ((R & ~31) + perm32(R & 31)) : R;
        voffA[i] = (unsigned)(R * K + C) * 2u; voffB[i] = (unsigned)(Rb * K + C) * 2u; }
    const size_t kstep = (size_t)(BK * 2);
    const size_t hstep = (size_t)HALF * K * 2;
    const size_t tstep = 2 * hstep;
    const unsigned ldsw = (unsigned)wid * 1024u;
    const int aoff = lds_byte(wr * 64 + fr, fq * 8), boff = lds_byte(wc * 32 + fr, fq * 8);
#define PG8_SA(b, h) (((b) * 2 + (h)) * HTB)
#define PG8_SB(b, h) ((4 + (b) * 2 + (h)) * HTB)
#define PG8_STAGE(bufoff, gbase, voff) do { _Pragma("unroll") for (int _i = 0; _i < 2; ++_i) \
        __builtin_amdgcn_global_load_lds((const unsigned*)((const char*)(gbase) + (voff)[_i]), (LAS unsigned*)(lds + (bufoff) + ldsw + _i * 8192), 16, 0, 0); } while (0)
#define PG8_LDA(dst, b, h) do { _Pragma("unroll") for (int m = 0; m < 4; ++m) _Pragma("unroll") for (int k = 0; k < 2; ++k) dst[m][k] = *(const LAS bf16x8*)(lds + PG8_SA(b, h) + aoff + m * 2048 + k * 1024); } while (0)
#define PG8_LDB(dst, b, h) do { _Pragma("unroll") for (int n = 0; n < 2; ++n) _Pragma("unroll") for (int k = 0; k < 2; ++k) dst[n][k] = *(const LAS bf16x8*)(lds + PG8_SB(b, h) + boff + n * 2048 + k * 1024); } while (0)
#define PG8_MMA(ai, bj, At, Bt) do { __builtin_amdgcn_s_setprio(1); _Pragma("unroll") for (int m = 0; m < 4; ++m) _Pragma("unroll") for (int n = 0; n < 2; ++n) _Pragma("unroll") for (int k = 0; k < 2; ++k) \
        acc[ai][bj][m][n] = __builtin_amdgcn_mfma_f32_16x16x32_bf16(Bt[n][k], At[m][k], acc[ai][bj][m][n], 0, 0, 0); __builtin_amdgcn_s_setprio(0); } while (0)
#define PG8_WAIT_V(n) asm volatile("s_waitcnt vmcnt(" #n ")" ::: "memory")
#define PG8_WAIT_L(n) asm volatile("s_waitcnt lgkmcnt(" #n ")" ::: "memory")
#define PG8_BAR __builtin_amdgcn_s_barrier()
#define PG8_SCHED __builtin_amdgcn_sched_barrier(0)
    Unit cur, nxt; int ui = 0;
    if (!S.next(0, cur)) return;
    f32x4 acc[2][2][4][2];
#pragma unroll
    for (int a = 0; a < 2; ++a)
#pragma unroll
        for (int b = 0; b < 2; ++b)
#pragma unroll
            for (int m = 0; m < 4; ++m)
#pragma unroll
                for (int n = 0; n < 2; ++n) acc[a][b][m][n] = (f32x4){0.f, 0.f, 0.f, 0.f};
    bf16x8 At[4][2], B0[2][2], B1[2][2];
    const char* cA = (const char*)g.A + (size_t)cur.g * g.gsA + (size_t)cur.pm * tstep; const char* cB = (const char*)g.Bt + (size_t)cur.g * g.gsB + (size_t)cur.pn * tstep;
    PG8_STAGE(PG8_SB(0, 0), cB, voffB); PG8_STAGE(PG8_SA(0, 0), cA, voffA); PG8_STAGE(PG8_SB(0, 1), cB + hstep, voffB); PG8_STAGE(PG8_SA(0, 1), cA + hstep, voffA);
    if (wr == 1) PG8_BAR;
    PG8_WAIT_V(4); PG8_BAR;
    PG8_STAGE(PG8_SB(1, 0), cB + kstep, voffB); PG8_STAGE(PG8_SA(1, 0), cA + kstep, voffA); PG8_STAGE(PG8_SB(1, 1), cB + hstep + kstep, voffB);
    PG8_WAIT_V(6); PG8_BAR;
    for (;;) {
        const bool has_next = S.next(ui + 1, nxt);
        const char* nA = has_next ? (const char*)g.A + (size_t)nxt.g * g.gsA + (size_t)nxt.pm * tstep : cA; const char* nB = has_next ? (const char*)g.Bt + (size_t)nxt.g * g.gsB + (size_t)nxt.pn * tstep : cB;
        for (int t = 0; t < nt; t += 2) {
            const bool last = (t == nt - 2);
            const char* a1 = cA + (size_t)(t + 1) * kstep;
            const char* a2 = last ? nA : cA + (size_t)(t + 2) * kstep; const char* b2 = last ? nB : cB + (size_t)(t + 2) * kstep;
            const char* a3 = a2 + kstep; const char* b3 = b2 + kstep;
            PG8_LDB(B0, 0, 0); PG8_SCHED; PG8_LDA(At, 0, 0); PG8_STAGE(PG8_SA(1, 1), a1 + hstep, voffA);
            PG8_WAIT_L(8); PG8_BAR; PG8_WAIT_L(0); PG8_MMA(0, 0, At, B0); PG8_BAR; PG8_SCHED;
            PG8_LDB(B1, 0, 1); PG8_STAGE(PG8_SB(0, 0), b2, voffB);
            PG8_BAR; PG8_WAIT_L(0); PG8_MMA(0, 1, At, B1); PG8_BAR;
            PG8_LDA(At, 0, 1); PG8_STAGE(PG8_SA(0, 0), a2, voffA);
            PG8_BAR; PG8_WAIT_L(0); PG8_MMA(1, 0, At, B0); PG8_BAR; PG8_SCHED;
            PG8_STAGE(PG8_SB(0, 1), b2 + hstep, voffB);
            PG8_WAIT_V(6); PG8_BAR; PG8_MMA(1, 1, At, B1); PG8_BAR;
            PG8_LDB(B0, 1, 0); PG8_SCHED; PG8_LDA(At, 1, 0); PG8_STAGE(PG8_SA(0, 1), a2 + hstep, voffA);
            PG8_WAIT_L(8); PG8_BAR; PG8_WAIT_L(0); PG8_MMA(0, 0, At, B0); PG8_BAR; PG8_SCHED;
            PG8_LDB(B1, 1, 1); PG8_STAGE(PG8_SB(1, 0), b3, voffB);
            PG8_BAR; PG8_WAIT_L(0); PG8_MMA(0, 1, At, B1); PG8_BAR;
            PG8_LDA(At, 1, 1); PG8_STAGE(PG8_SA(1, 0), a3, voffA);
            PG8_BAR; PG8_WAIT_L(0); PG8_MMA(1, 0, At, B0); PG8_BAR; PG8_SCHED;
            PG8_STAGE(PG8_SB(1, 1), b3 + hstep, voffB);
            PG8_WAIT_V(6); PG8_BAR; PG8_MMA(1, 1, At, B1); PG8_BAR;
        }
        E(acc, cur, wr, wc, fr, fq);
        if (!has_next) break;
        if (!E.keep(cur)) {
#pragma unroll
            for (int a = 0; a < 2; ++a)
#pragma unroll
                for (int b = 0; b < 2; ++b)
#pragma unroll
                    for (int m = 0; m < 4; ++m)
#pragma unroll
                        for (int n = 0; n < 2; ++n) acc[a][b][m][n] = (f32x4){0.f, 0.f, 0.f, 0.f};
        }
        cur = nxt; cA = nA; cB = nB; ++ui;
    }
    PG8_WAIT_V(0);
    if (wr == 0) PG8_BAR;
    PG8_BAR;
#undef PG8_SA
#undef PG8_SB
#undef PG8_STAGE
#undef PG8_LDA
#undef PG8_LDB
#undef PG8_MMA
#undef PG8_WAIT_V
#undef PG8_WAIT_L
#undef PG8_BAR
#undef PG8_SCHED
}
}


#define NOINL __forceinline__
__device__ NOINL void ph_gemm_swiglu(LAS unsigned char* lds, const bf16_t* A, const bf16_t* Bt, bf16_t* O) {
    pg8::Gemm g{A, Bt, T, 2 * DFF, D, 0, 0}; pg8::StaticOrder S; S.init(g.M, g.N, lgdim(), lbid()); pg8::EpiSwiGLU E{O}; pg8::gemm_phase(lds, g, S, E);
}
__device__ NOINL void ph_gemm_resid(LAS unsigned char* lds, const bf16_t* A, const bf16_t* Bt, int M, int K, const float* Xin, float* Xout, float scale) {
    pg8::Gemm g{A, Bt, M, D, K, 0, 0}; pg8::StaticOrder S; S.init(g.M, g.N, lgdim(), lbid()); pg8::EpiResid E{Xin, Xout, scale}; pg8::gemm_phase(lds, g, S, E);
}
__device__ NOINL void ph_gemm_proj(LAS unsigned char* lds, const bf16_t* A, const bf16_t* Bt, bf16_t* O, float* AB) {
    pg8::Gemm g{A, Bt, TS, PW, D, 0, 0}; pg8::StaticOrder S; S.init(g.M, g.N, lgdim(), lbid()); pg8::EpiProj E{O, AB}; pg8::gemm_phase(lds, g, S, E);
}
__device__ NOINL void ph_gemm_branch(LAS unsigned char* lds, const bf16_t* A, const bf16_t* Bt, const bf16_t* P, bf16_t* O) {
    pg8::Gemm g{A, Bt, TS, D, 512, (size_t)TS * 512 * 2, (size_t)D * 512 * 2}; pg8::BranchOrder S; S.init(g.M, g.N, lgdim(), lbid()); pg8::EpiBranch E{P, O}; pg8::gemm_phase(lds, g, S, E);
}

struct ConvTask { const float* src0; const float* src1; bf16_t* dst; int K, Nsrc, mode, tile; };
__device__ __forceinline__ ConvTask conv_task(const Params& p, int l, int it) {
    unsigned char* ws = lptr(p.ws);
    constexpr int N1 = 16 * 88, N2 = 44 * 16, N3 = 16 * 140, N4 = 8 * 16, N5 = 16 * 16;
    ConvTask t; t.src1 = nullptr;
    int r = it;
    if (r < N1) { t.src0 = p.in[zz() + 2] + (size_t)l * D * DFF; t.src1 = p.in[zz() + 3] + (size_t)l * D * DFF; t.K = D; t.Nsrc = DFF; t.dst = (bf16_t*)(ws + WS_WGU1); t.mode = 1; t.tile = r; return t; } r -= N1;
    if (r < N2) { t.src0 = p.in[zz() + 4] + (size_t)l * DFF * D; t.K = DFF; t.Nsrc = D; t.dst = (bf16_t*)(ws + WS_WD1); t.mode = 0; t.tile = r; return t; } r -= N2;
    if (r < N3) { t.src0 = p.in[zz() + 6] + (size_t)l * D * PIN; t.K = D; t.Nsrc = PIN; t.dst = (bf16_t*)(ws + WS_WIN); t.mode = 2; t.tile = r; return t; } r -= N3;
    if (r < 4 * N4) { const int g = r / N4; t.src0 = p.in[zz() + 24] + ((size_t)l * 4 + g) * 512 * D; t.K = 512; t.Nsrc = D; t.dst = (bf16_t*)(ws + WS_WB) + (size_t)g * D * 512; t.mode = 0; t.tile = r % N4; return t; } r -= 4 * N4;
    if (r < N5) { t.src0 = p.in[zz() + 25] + (size_t)l * D * D; t.K = D; t.Nsrc = D; t.dst = (bf16_t*)(ws + WS_WOUT); t.mode = 0; t.tile = r; return t; } r -= N5;
    if (r < N1) { t.src0 = p.in[zz() + 27] + (size_t)l * D * DFF; t.src1 = p.in[zz() + 28] + (size_t)l * D * DFF; t.K = D; t.Nsrc = DFF; t.dst = (bf16_t*)(ws + WS_WGU2); t.mode = 1; t.tile = r; return t; } r -= N1;
    t.src0 = p.in[zz() + 29] + (size_t)l * DFF * D; t.K = DFF; t.Nsrc = D; t.dst = (bf16_t*)(ws + WS_WD2); t.mode = 0; t.tile = r; return t;
}
__device__ __forceinline__ void conv_load(const ConvTask& t, int tid, f32x4& a, f32x4& b) {
    const int nkt = t.K / 64, kt = t.tile % nkt, rt = t.tile / nkt, k0 = kt * 64, r0 = rt * 64;
    const int kk = tid >> 3, rr = (tid & 7) * 8, rho = r0 + rr;
    const float* src = t.src0; int col = rho;
    if (t.mode == 1) { const int pn = rho >> 8, bj = (rho >> 7) & 1, j = rho & 127; col = pn * 128 + j; src = bj ? t.src1 : t.src0; }
    else if (t.mode == 2) { col = rho < 4096 ? rho : (rho < 8704 ? rho + 8 : (rho < 8712 ? rho - 8704 + 4096 : -1)); }
    a = (f32x4){0.f, 0.f, 0.f, 0.f}; b = a;
    if (col >= 0) { const float* sp = src + (size_t)(k0 + kk) * t.Nsrc + col; a = *(const f32x4*)sp; b = *(const f32x4*)(sp + 4); }
}
__device__ __forceinline__ void conv_store(LAS float* scr, const ConvTask& t, int tid, const f32x4& a, const f32x4& b) {
    const int nkt = t.K / 64, kt = t.tile % nkt, rt = t.tile / nkt, k0 = kt * 64, r0 = rt * 64;
    { const int kk = tid >> 3, rr = (tid & 7) * 8;
#pragma unroll
        for (int e = 0; e < 4; ++e) { scr[(rr + e) * 65 + kk] = a[e]; scr[(rr + 4 + e) * 65 + kk] = b[e]; } }
    __syncthreads();
    { const int rl = tid >> 3, kc = (tid & 7) * 8;
        const LAS float* s = scr + rl * 65 + kc;
        u32x4 w; w.x = cvt_pk_bf16(s[0], s[1]); w.y = cvt_pk_bf16(s[2], s[3]); w.z = cvt_pk_bf16(s[4], s[5]); w.w = cvt_pk_bf16(s[6], s[7]);
        *(u32x4*)(t.dst + (size_t)(r0 + rl) * t.K + k0 + kc) = w; }
    __syncthreads();
}

__device__ __forceinline__ void convert_layer(LAS unsigned char* lds, const Params& p, int l) {
    LAS float* scr = (LAS float*)lds;
    unsigned char* ws = lptr(p.ws);
    constexpr int N1 = 16 * 88, N2 = 44 * 16, N3 = 16 * 140, N4 = 8 * 16, N5 = 16 * 16;
    constexpr int TOT = N1 + N2 + N3 + 4 * N4 + N5 + N1 + N2;
    const int tid = ltid(), G = lgdim();
    int it = lbid();
    if (it < TOT) {
        ConvTask cur = conv_task(p, l, it);
        f32x4 a, b; conv_load(cur, tid, a, b);
        for (;;) {
            const int nx = it + G; const bool more = nx < TOT;
            ConvTask nxt = cur; f32x4 na = a, nb = b;
            if (more) { nxt = conv_task(p, l, nx); conv_load(nxt, tid, na, nb); }
            conv_store(scr, cur, tid, a, b);
            if (!more) break;
            cur = nxt; a = na; b = nb; it = nx;
        }
    }
    bf16_t* waxt = (bf16_t*)(ws + WS_WAXT); bf16_t* pwt = (bf16_t*)(ws + WS_PWT);
    const float* wa = p.in[zz() + 13] + (size_t)l * 8 * 64 * 64; const float* wx = p.in[zz() + 15] + (size_t)l * 8 * 64 * 64; const float* pw = p.in[zz() + 22] + (size_t)l * 4 * 128 * 128;
    for (int e = lbid() * NTHR + ltid(); e < 65536; e += lgdim() * NTHR) {
        { const int h = e >> 13, jp = (e >> 6) & 127, i = e & 63; waxt[e] = f2bf(jp < 64 ? wa[(h * 64 + i) * 64 + jp] : wx[(h * 64 + i) * 64 + jp - 64]); }
        { const int g = e >> 14, d = (e >> 7) & 127, c = e & 127; pwt[e] = f2bf(pw[(g * 128 + c) * 128 + d]); }
    }
}

__device__ __forceinline__ void rms_rows_bf16(const float* X, const float* gain, bf16_t* H, int nrows) {
    const int wid = ltid() >> 6, lane = ltid() & 63;
    f32x4 gv[4];
#pragma unroll
    for (int j = 0; j < 4; ++j) gv[j] = *(const f32x4*)(gain + (lane + 64 * j) * 4);
    for (int row0 = (lbid() * 8 + wid) * 4; row0 < nrows; row0 += lgdim() * 32) {
        f32x4 v[4][4];
#pragma unroll
        for (int r = 0; r < 4; ++r) { const f32x4* xr = (const f32x4*)(X + (size_t)min(row0 + r, nrows - 1) * D) + lane;
#pragma unroll
            for (int j = 0; j < 4; ++j) v[r][j] = xr[64 * j]; }
#pragma unroll
        for (int r = 0; r < 4; ++r) {
            float s = 0.f;
#pragma unroll
            for (int j = 0; j < 4; ++j) s += (v[r][j].x * v[r][j].x + v[r][j].y * v[r][j].y) + (v[r][j].z * v[r][j].z + v[r][j].w * v[r][j].w);
            const float rs = rsqrtf(wave_sum(s) * (1.0f / D) + EPS);
            u32x2* o = (u32x2*)(H + (size_t)(row0 + r) * D) + lane;
            if (row0 + r < nrows)
#pragma unroll
            for (int j = 0; j < 4; ++j) { u32x2 w; w.x = cvt_pk_bf16(v[r][j].x * rs * gv[j].x, v[r][j].y * rs * gv[j].y); w.y = cvt_pk_bf16(v[r][j].z * rs * gv[j].z, v[r][j].w * rs * gv[j].w); o[64 * j] = w; }
        }
    }
}
__device__ __forceinline__ void rms_rows_f32_inplace(float* X, const float* gain, int nrows) {
    const int wid = ltid() >> 6, lane = ltid() & 63;
    f32x4 gv[4];
#pragma unroll
    for (int j = 0; j < 4; ++j) gv[j] = *(const f32x4*)(gain + (lane + 64 * j) * 4);
    for (int row0 = (lbid() * 8 + wid) * 4; row0 < nrows; row0 += lgdim() * 32) {
        f32x4 v[4][4];
#pragma unroll
        for (int r = 0; r < 4; ++r) { const f32x4* xr = (const f32x4*)(X + (size_t)min(row0 + r, nrows - 1) * D) + lane;
#pragma unroll
            for (int j = 0; j < 4; ++j) v[r][j] = xr[64 * j]; }
#pragma unroll
        for (int r = 0; r < 4; ++r) {
            float s = 0.f;
#pragma unroll
            for (int j = 0; j < 4; ++j) s += (v[r][j].x * v[r][j].x + v[r][j].y * v[r][j].y) + (v[r][j].z * v[r][j].z + v[r][j].w * v[r][j].w);
            const float rs = rsqrtf(wave_sum(s) * (1.0f / D) + EPS);
            f32x4* xo = (f32x4*)(X + (size_t)(row0 + r) * D) + lane;
            if (row0 + r < nrows)
#pragma unroll
            for (int j = 0; j < 4; ++j) xo[64 * j] = v[r][j] * rs * gv[j];
        }
    }
}

__device__ __forceinline__ void sgu_tile(LAS unsigned char* lds, const Params& p, int l, const bf16_t* proj, bf16_t* ya, int tile) {
    const int tid = ltid(), wid = tid >> 6, lane = tid & 63, fr = lane & 15, fq = lane >> 4;
    const int blk = tile >> 2, g = tile & 3, r0 = blk * 128;
    LAS bf16_t* Wl = (LAS bf16_t*)lds;
    LAS bf16_t* VT = (LAS bf16_t*)(lds + 34816);
    const float* lng = p.in[zz() + 7] + l * 512 + g * 128; const float* lnb = p.in[zz() + 8] + l * 512 + g * 128;
    {
        const int i = tid >> 2, qd = tid & 3;
        const bf16_t* vrow = proj + (size_t)(r0 + i) * PW + PC_AV + qd * 8;
        float s = 0.f, s2 = 0.f;
#pragma unroll 4
        for (int e8 = 0; e8 < 16; ++e8) { const u32x4 w = *(const u32x4*)(vrow + e8 * 32);
#pragma unroll
            for (int q = 0; q < 4; ++q) { const float a = geluf_(lo_bf(w[q])), b = geluf_(hi_bf(w[q])); s += a + b; s2 += a * a + b * b; } }
        s += __shfl_xor(s, 1); s += __shfl_xor(s, 2); s2 += __shfl_xor(s2, 1); s2 += __shfl_xor(s2, 2);
        const float mean = s * (1.0f / 512.0f), var = fmaxf(s2 * (1.0f / 512.0f) - mean * mean, 0.f), rstd = rsqrtf(var + EPS);
        const bf16_t* vg = proj + (size_t)(r0 + i) * PW + PC_AV + g * 128 + qd * 8;
#pragma unroll
        for (int e8 = 0; e8 < 4; ++e8) { const u32x4 w = *(const u32x4*)(vg + e8 * 32);
#pragma unroll
            for (int q = 0; q < 4; ++q) { const int c = e8 * 32 + qd * 8 + 2 * q;
                VT[c * 136 + i] = f2bf((geluf_(lo_bf(w[q])) - mean) * rstd * lng[c] + lnb[c]);
                VT[(c + 1) * 136 + i] = f2bf((geluf_(hi_bf(w[q])) - mean) * rstd * lng[c + 1] + lnb[c + 1]); } }
        const float* wsrc = p.in[zz() + 9] + (((size_t)l * 4 + g) * 128 + i) * 128 + qd * 32;
#pragma unroll
        for (int e4 = 0; e4 < 8; ++e4) { f32x4 w = *(const f32x4*)(wsrc + e4 * 4); if (i < 64 && qd >= 2) w = (f32x4){0.f, 0.f, 0.f, 0.f};
            u32x2 o; o.x = cvt_pk_bf16(w.x, w.y); o.y = cvt_pk_bf16(w.z, w.w); *(LAS u32x2*)(Wl + i * 136 + qd * 32 + e4 * 4) = o; }
    }
    __syncthreads();
    f32x4 acc[8];
#pragma unroll
    for (int n = 0; n < 8; ++n) acc[n] = (f32x4){0.f, 0.f, 0.f, 0.f};
#pragma unroll
    for (int ks = 0; ks < 4; ++ks) {
        const bf16x8 af = *(const LAS bf16x8*)(Wl + (wid * 16 + fr) * 136 + ks * 32 + fq * 8);
#pragma unroll
        for (int n = 0; n < 8; ++n) { const bf16x8 bf = *(const LAS bf16x8*)(VT + (n * 16 + fr) * 136 + ks * 32 + fq * 8); acc[n] = __builtin_amdgcn_mfma_f32_16x16x32_bf16(bf, af, acc[n], 0, 0, 0); }
    }
    {
        const int i = wid * 16 + fr; const float bias = p.in[zz() + 10][((size_t)l * 4 + g) * 128 + i];
        const bf16_t* up = proj + (size_t)(r0 + i) * PW + PC_AU + g * 128 + fq * 4;
        bf16_t* yp = ya + (size_t)(r0 + i) * 512 + g * 128 + fq * 4;
#pragma unroll
        for (int n = 0; n < 8; ++n) { const u32x2 uw = *(const u32x2*)(up + n * 16);
            u32x2 o; o.x = cvt_pk_bf16((acc[n][0] + bias) * geluf_(lo_bf(uw.x)), (acc[n][1] + bias) * geluf_(hi_bf(uw.x)));
            o.y = cvt_pk_bf16((acc[n][2] + bias) * geluf_(lo_bf(uw.y)), (acc[n][3] + bias) * geluf_(hi_bf(uw.y))); *(u32x2*)(yp + n * 16) = o; }
    }
    __syncthreads();
}

template <int WIN>
__device__ __forceinline__ void pool_rows(LAS bf16_t* Al, const bf16_t* xcol, int c, int pos0) {
    float xv[80];
#pragma unroll
    for (int k = 0; k < 80; ++k) xv[k] = (pos0 - 16 + k >= 0) ? bf2f(xcol[(long)(k - 16) * PW]) : 0.f;
    float s = 0.f;
#pragma unroll
    for (int j = 0; j < WIN; ++j) s += xv[16 - j];
#pragma unroll
    for (int tt = 0; tt < 64; ++tt) {
        const int k = tt + 16;
        const int cnt = min(pos0 + tt + 1, WIN);
        Al[tt * 520 + c] = f2bf(s / (float)cnt - xv[k]);
        if (tt < 63) s += xv[k + 1] - xv[k + 1 - WIN];
    }
}
__device__ __forceinline__ void pool_tile(LAS unsigned char* lds, const Params& p, int l, const bf16_t* proj, bf16_t* yd, bf16_t* halo, const bf16_t* pwt, int tile) {
    const int tid = ltid(), wid = tid >> 6, lane = tid & 63, fr = lane & 15, fq = lane >> 4;
    const int t0 = tile * 64, pos0 = t0 % SEQ;
    LAS bf16_t* Al = (LAS bf16_t*)lds;
    {
        const int c = tid, g = wid >> 1;
        const bf16_t* xcol = proj + (size_t)t0 * PW + PC_DX + c;
        if (g == 0) pool_rows<2>(Al, xcol, c, pos0); else if (g == 1) pool_rows<4>(Al, xcol, c, pos0); else if (g == 2) pool_rows<8>(Al, xcol, c, pos0); else pool_rows<16>(Al, xcol, c, pos0);
    }
    __syncthreads();
    {
        const int g = wid >> 1, nh = wid & 1;
        f32x4 acc[4][4];
#pragma unroll
        for (int m = 0; m < 4; ++m)
#pragma unroll
            for (int n = 0; n < 4; ++n) acc[m][n] = (f32x4){0.f, 0.f, 0.f, 0.f};
#pragma unroll
        for (int ks = 0; ks < 4; ++ks) {
            bf16x8 bfr[4];
#pragma unroll
            for (int n = 0; n < 4; ++n) bfr[n] = *(const bf16x8*)(pwt + ((size_t)(g * 128 + (nh * 4 + n) * 16 + fr)) * 128 + ks * 32 + fq * 8);
#pragma unroll
            for (int m = 0; m < 4; ++m) { const bf16x8 af = *(const LAS bf16x8*)(Al + (m * 16 + fr) * 520 + g * 128 + ks * 32 + fq * 8);
#pragma unroll
                for (int n = 0; n < 4; ++n) acc[m][n] = __builtin_amdgcn_mfma_f32_16x16x32_bf16(bfr[n], af, acc[m][n], 0, 0, 0); }
        }
        const float* sc = p.in[zz() + 23] + l * 512 + g * 128;
#pragma unroll
        for (int n = 0; n < 4; ++n) { const int d = (nh * 4 + n) * 16 + fq * 4; const f32x4 s4 = *(const f32x4*)(sc + d);
#pragma unroll
            for (int m = 0; m < 4; ++m) { u32x2 o; o.x = cvt_pk_bf16(acc[m][n][0] * s4[0], acc[m][n][1] * s4[1]); o.y = cvt_pk_bf16(acc[m][n][2] * s4[2], acc[m][n][3] * s4[3]);
                *(u32x2*)(yd + (size_t)(t0 + m * 16 + fr) * 512 + g * 128 + d) = o; } }
    }
    __syncthreads();
}

__device__ __forceinline__ void lru_tile(LAS unsigned char* lds, const Params& p, int l, const bf16_t* proj, bf16_t* yb, const bf16_t* waxt, float* Aend, float* Hend, const float* carry, int tile, int mode) {
    const int tid = ltid(), wid = tid >> 6, lane = tid & 63, fr = lane & 15, fq = lane >> 4;
    const int t0 = tile * 64, pos0 = t0 % SEQ, c = wid * 64 + lane;
    LAS bf16_t* Aw = (LAS bf16_t*)(lds + wid * 10560);
    LAS float* Xw = (LAS float*)(lds + wid * 10560 + 2304);
    bf16x8 bfr[8][2];
#pragma unroll
    for (int n = 0; n < 8; ++n)
#pragma unroll
        for (int ks = 0; ks < 2; ++ks) bfr[n][ks] = *(const bf16x8*)(waxt + ((size_t)(wid * 128 + n * 16 + fr)) * 64 + ks * 32 + fq * 8);
    const float* cwp = p.in[zz() + 11] + (size_t)l * 4 * 512 + c;
    const float cw0 = cwp[0], cw1 = cwp[512], cw2 = cwp[1024], cw3 = cwp[1536], cb = p.in[zz() + 12][l * 512 + c];
    const float ba = p.in[zz() + 14][l * 512 + c], bx = p.in[zz() + 16][l * 512 + c], sp8 = 8.0f * softplusf_(-p.in[zz() + 17][l * 512 + c]);
    const bf16_t* xcol = proj + (size_t)t0 * PW + PC_BX + c;
    float xm3 = 0.f, xm2 = 0.f, xm1 = 0.f;
    if (pos0 > 0) { xm3 = bf2f(xcol[-3L * PW]); xm2 = bf2f(xcol[-2L * PW]); xm1 = bf2f(xcol[-1L * PW]); }
    const bf16_t* gcol = proj + (size_t)t0 * PW + PC_BG + c;
    bf16_t* ycol = yb + (size_t)t0 * 512 + c;
    float h = mode ? carry[(size_t)tile * 512 + c] : 0.f, Ap = 1.f;
    for (int sub = 0; sub < 4; ++sub) {
        float xc[16];
#pragma unroll
        for (int tt = 0; tt < 16; ++tt) { const float xin = bf2f(*xcol); xcol += PW; xc[tt] = cb + cw0 * xm3 + cw1 * xm2 + cw2 * xm1 + cw3 * xin; xm3 = xm2; xm2 = xm1; xm1 = xin; Aw[tt * 72 + lane] = f2bf(xc[tt]); }
        __syncthreads();
        f32x4 acc[8];
#pragma unroll
        for (int n = 0; n < 8; ++n) acc[n] = (f32x4){0.f, 0.f, 0.f, 0.f};
#pragma unroll
        for (int ks = 0; ks < 2; ++ks) { const bf16x8 af = *(const LAS bf16x8*)(Aw + fr * 72 + ks * 32 + fq * 8);
#pragma unroll
            for (int n = 0; n < 8; ++n) acc[n] = __builtin_amdgcn_mfma_f32_16x16x32_bf16(bfr[n][ks], af, acc[n], 0, 0, 0); }
#pragma unroll
        for (int n = 0; n < 8; ++n)
#pragma unroll
            for (int j = 0; j < 4; ++j) Xw[fr * 129 + n * 16 + fq * 4 + j] = acc[n][j];
        __syncthreads();
#pragma unroll
        for (int tt = 0; tt < 16; ++tt) {
            const float r = sigmoidf_(Xw[tt * 129 + lane] + ba), ig = sigmoidf_(Xw[tt * 129 + 64 + lane] + bx);
            const float la = -sp8 * r, a = __expf(la), x2 = 2.0f * la;
            const float om = (x2 > -0.1f) ? -x2 * (1.0f + x2 * (0.5f + x2 * (0.16666667f + x2 * 0.041666668f))) : 1.0f - a * a;
            h = a * h + __builtin_amdgcn_sqrtf(om) * ig * xc[tt]; Ap *= a;
            if (mode) { const float gt = bf2f(*gcol); gcol += PW; *ycol = f2bf(h * geluf_(gt)); ycol += 512; }
        }
        __syncthreads();
    }
    if (!mode) { Aend[(size_t)tile * 512 + c] = Ap; Hend[(size_t)tile * 512 + c] = h; }
}
__device__ __forceinline__ void lru_carry(const float* Aend, const float* Hend, float* carry) {
    const int gid = lbid() * NTHR + ltid();
    if (gid < (TS / SEQ) * 512) {
        const int bl = gid >> 9, c = gid & 511; float h = 0.f;
        for (int n = 0; n < 64; ++n) { const size_t o = (size_t)(bl * 64 + n) * 512 + c; carry[o] = h; h = Aend[o] * h + Hend[o]; }
    }
}

__device__ __forceinline__ void gdn_prep(LAS unsigned char* lds, const Params& p, int l, const bf16_t* proj, const float* AB, bf16_t* GQ, bf16_t* GK, bf16_t* GU, bf16_t* GW, bf16_t* GA, float* edec, int item) {
    const int tid = ltid(), wid = tid >> 6, lane = tid & 63, fr = lane & 15, fq = lane >> 4;
    const int bl = item >> 8, n = (item & 255) >> 2, hh = item & 3, ch = bl * 64 + n, t0 = ch * 64;
    LAS bf16_t* Kl = (LAS bf16_t*)lds;
    LAS bf16_t* Ql = (LAS bf16_t*)(lds + 17408);
    LAS float* RHS = (LAS float*)(lds + 34816);
    LAS float* Am = (LAS float*)(lds + 101376);
    LAS float* gc = (LAS float*)(lds + 117760);
    LAS float* bt = (LAS float*)(lds + 118016);
    const int t = tid >> 3, d0 = (tid & 7) * 16;
    float qkv[3][16];
#pragma unroll
    for (int sec = 0; sec < 3; ++sec) {
        const int colh = sec * 512 + hh * 128 + d0;
        float a[16];
#pragma unroll
        for (int e = 0; e < 16; ++e) a[e] = 0.f;
#pragma unroll
        for (int k = 0; k < 4; ++k) {
            const int tt = t - 3 + k;
            const bf16_t* src = nullptr;
            if (tt >= 0 || n > 0) src = proj + (long)(t0 + tt) * PW + PC_CQ + colh;
            if (src) {
                const u32x4 w0 = *(const u32x4*)src, w1 = *(const u32x4*)(src + 8);
                const float* cw = p.in[zz() + 18] + ((size_t)l * 4 + k) * 1536 + colh;
#pragma unroll
                for (int q = 0; q < 4; ++q) { const f32x4 c4 = *(const f32x4*)(cw + q * 4);
                    const unsigned wa = (q < 2) ? w0[2 * q] : w1[2 * q - 4], wb = (q < 2) ? w0[2 * q + 1] : w1[2 * q - 3];
                    a[q * 4 + 0] += c4[0] * lo_bf(wa); a[q * 4 + 1] += c4[1] * hi_bf(wa); a[q * 4 + 2] += c4[2] * lo_bf(wb); a[q * 4 + 3] += c4[3] * hi_bf(wb); }
            }
        }
#pragma unroll
        for (int e = 0; e < 16; ++e) qkv[sec][e] = siluf_(a[e]);
    }
    {
        float sq = 0.f, sk = 0.f;
#pragma unroll
        for (int e = 0; e < 16; ++e) { sq += qkv[0][e] * qkv[0][e]; sk += qkv[1][e] * qkv[1][e]; }
        sq += __shfl_xor(sq, 1); sq += __shfl_xor(sq, 2); sq += __shfl_xor(sq, 4); sk += __shfl_xor(sk, 1); sk += __shfl_xor(sk, 2); sk += __shfl_xor(sk, 4);
        const float qn = rsqrtf(sq + EPS) * 0.08838834764831845f, kn = rsqrtf(sk + EPS);
#pragma unroll
        for (int e = 0; e < 16; ++e) { qkv[0][e] *= qn; qkv[1][e] *= kn; }
#pragma unroll
        for (int e = 0; e < 16; e += 2) { *(LAS unsigned*)(Ql + t * 136 + d0 + e) = cvt_pk_bf16(qkv[0][e], qkv[0][e + 1]); *(LAS unsigned*)(Kl + t * 136 + d0 + e) = cvt_pk_bf16(qkv[1][e], qkv[1][e + 1]); }
    }
    if (wid == 0) {
        const float al = AB[(size_t)(t0 + lane) * 8 + 4 + hh], be = AB[(size_t)(t0 + lane) * 8 + hh];
        float gv = -__expf(p.in[zz() + 19][l * 4 + hh]) * softplusf_(al + p.in[zz() + 20][l * 4 + hh]);
#pragma unroll
        for (int o = 1; o < 64; o <<= 1) { const float u = __shfl_up(gv, o); if (lane >= o) gv += u; }
        gc[lane] = gv; bt[lane] = sigmoidf_(be);
        if (lane == 63) edec[item] = __expf(gv);
    }
    __syncthreads();
    {
        const float bet = bt[t], gct = gc[t], eg = __expf(gct), ekd = __expf(gc[63] - gct);
#pragma unroll
        for (int e = 0; e < 16; ++e) { RHS[t * 260 + d0 + e] = qkv[2][e] * bet; RHS[t * 260 + 128 + d0 + e] = qkv[1][e] * bet * eg; }
        bf16_t* qdst = GQ + (size_t)(t0 + t) * 512 + hh * 128 + d0;
        u32x4 w0, w1;
        w0.x = cvt_pk_bf16(qkv[0][0] * eg, qkv[0][1] * eg); w0.y = cvt_pk_bf16(qkv[0][2] * eg, qkv[0][3] * eg); w0.z = cvt_pk_bf16(qkv[0][4] * eg, qkv[0][5] * eg); w0.w = cvt_pk_bf16(qkv[0][6] * eg, qkv[0][7] * eg);
        w1.x = cvt_pk_bf16(qkv[0][8] * eg, qkv[0][9] * eg); w1.y = cvt_pk_bf16(qkv[0][10] * eg, qkv[0][11] * eg); w1.z = cvt_pk_bf16(qkv[0][12] * eg, qkv[0][13] * eg); w1.w = cvt_pk_bf16(qkv[0][14] * eg, qkv[0][15] * eg);
        *(u32x4*)qdst = w0; *(u32x4*)(qdst + 8) = w1;
#pragma unroll
        for (int e = 0; e < 16; ++e) qkv[1][e] *= ekd;
    }
    {
        const int it = wid & 3, which = wid >> 2;
        LAS bf16_t* Xi = which ? Ql : Kl;
        bf16x8 af[4];
#pragma unroll
        for (int ks = 0; ks < 4; ++ks) af[ks] = *(const LAS bf16x8*)(Xi + (it * 16 + fr) * 136 + ks * 32 + fq * 8);
        const int i = it * 16 + fr; const float gci = gc[i], bti = bt[i];
#pragma unroll
        for (int jt = 0; jt < 4; ++jt) {
            f32x4 acc = (f32x4){0.f, 0.f, 0.f, 0.f};
#pragma unroll
            for (int ks = 0; ks < 4; ++ks) { const bf16x8 bf = *(const LAS bf16x8*)(Kl + (jt * 16 + fr) * 136 + ks * 32 + fq * 8); acc = __builtin_amdgcn_mfma_f32_16x16x32_bf16(bf, af[ks], acc, 0, 0, 0); }
            float v[4];
#pragma unroll
            for (int jj = 0; jj < 4; ++jj) { const int j = jt * 16 + fq * 4 + jj; const float dec = (i >= j) ? __expf(gci - gc[j]) : 0.f;
                v[jj] = which ? acc[jj] * dec : ((i > j) ? bti * acc[jj] * dec : 0.f); }
            if (which) { u32x2 o; o.x = cvt_pk_bf16(v[0], v[1]); o.y = cvt_pk_bf16(v[2], v[3]); *(u32x2*)(GA + (size_t)(t0 + i) * 256 + hh * 64 + jt * 16 + fq * 4) = o; }
            else *(LAS f32x4*)(Am + i * 64 + jt * 16 + fq * 4) = (f32x4){v[0], v[1], v[2], v[3]};
        }
    }
    __syncthreads();
    {
        LAS bf16_t* KDT = Ql;
#pragma unroll
        for (int e = 0; e < 16; ++e) KDT[(d0 + e) * 68 + t] = f2bf(qkv[1][e]);
    }
    if (tid < 256) {
        float x[64];
        int lz; asm volatile("v_mov_b32 %0, 0" : "=v"(lz));
        const LAS float* Amz = Am + lz;
#pragma unroll
        for (int i = 0; i < 64; ++i) x[i] = 0.f;
#pragma unroll
        for (int i = 0; i < 64; ++i) {
            float s = RHS[i * 260 + tid];
#pragma unroll
            for (int j4 = 0; j4 < (i + 3) / 4; ++j4) { const f32x4 a4 = *(const LAS f32x4*)(Amz + i * 64 + j4 * 4);
                s -= a4[0] * x[j4 * 4]; s -= a4[1] * x[j4 * 4 + 1]; s -= a4[2] * x[j4 * 4 + 2]; s -= a4[3] * x[j4 * 4 + 3]; }
            x[i] = s; RHS[i * 260 + tid] = s;
        }
    }
    __syncthreads();
    {
        const int seg = tid & 7;
        const LAS float* xr = RHS + t * 260 + seg * 32;
        bf16_t* dst = ((seg < 4) ? GU : GW) + (size_t)(t0 + t) * 512 + hh * 128 + (seg & 3) * 32;
#pragma unroll
        for (int q = 0; q < 4; ++q) { const f32x4 a = *(const LAS f32x4*)(xr + q * 8), b = *(const LAS f32x4*)(xr + q * 8 + 4);
            u32x4 w; w.x = cvt_pk_bf16(a[0], a[1]); w.y = cvt_pk_bf16(a[2], a[3]); w.z = cvt_pk_bf16(b[0], b[1]); w.w = cvt_pk_bf16(b[2], b[3]); *(u32x4*)(dst + q * 8) = w; }
        const LAS bf16_t* kr = Ql + (2 * t + (seg >> 2)) * 68 + (seg & 3) * 16;
        const u32x2 k0 = *(const LAS u32x2*)kr, k1 = *(const LAS u32x2*)(kr + 4), k2 = *(const LAS u32x2*)(kr + 8), k3 = *(const LAS u32x2*)(kr + 12);
        bf16_t* kdst = GK + (size_t)(t0 + t) * 512 + hh * 128 + seg * 16;
        *(u32x4*)kdst = (u32x4){k0.x, k0.y, k1.x, k1.y}; *(u32x4*)(kdst + 8) = (u32x4){k2.x, k2.y, k3.x, k3.y};
    }
    __syncthreads();
}

__device__ __forceinline__ void gdn_scan(LAS unsigned char* lds, const unsigned char* ws, float* oraw, const float* edec, int chain) {
    const int tid = ltid(), wid = __builtin_amdgcn_readfirstlane(tid >> 6), lane = tid & 63, fr = lane & 15, fq = lane >> 4;
    const int bl = chain >> 5, hh = (chain >> 3) & 3, es = chain & 7, e0 = es * 16;
    constexpr int BUF = 64512, O_W = 0, O_Q = 17408, O_KT = 34816, O_AT = 53248, O_U = 62464, O_PS = 2 * BUF, O_PV = 2 * BUF + 4096;
    const unsigned rb = (unsigned)(bl * 64) * 64u;
    const bool stager = (wid >= 2);
    int soff[10], doff[10];
    {
        const int sid = tid - 128;
#pragma unroll
        for (int s = 0; s < 10; ++s) {
            int idx = sid + 384 * s; if (idx >= 3712) idx -= 128;
            if (!stager) { soff[s] = 0; doff[s] = 0; }
            else if (idx < 1024) { const int row = idx >> 4, pc = idx & 15; soff[s] = (int)(WS_GDW + ((size_t)(rb + row) * 512 + hh * 128 + pc * 8) * 2); doff[s] = O_W + (row * 136 + pc * 8) * 2; }
            else if (idx < 2048) { const int i2 = idx - 1024, row = i2 >> 4, pc = i2 & 15; soff[s] = (int)(WS_GDQ + ((size_t)(rb + row) * 512 + hh * 128 + pc * 8) * 2); doff[s] = O_Q + (row * 136 + pc * 8) * 2; }
            else if (idx < 3072) { const int i2 = idx - 2048, row = i2 >> 4, pc = i2 & 15; soff[s] = (int)(WS_GDK + ((size_t)(rb + row) * 512 + hh * 128 + pc * 8) * 2); doff[s] = O_KT + ((2 * row + (pc >> 3)) * 72 + (pc & 7) * 8) * 2; }
            else if (idx < 3584) { const int i2 = idx - 3072, row = i2 >> 3, pc = i2 & 7; soff[s] = (int)(WS_GDA + ((size_t)(rb + row) * 256 + hh * 64 + pc * 8) * 2); doff[s] = O_AT + (row * 72 + pc * 8) * 2; }
            else { const int i2 = idx - 3584, row = i2 >> 1, pc = i2 & 1; soff[s] = (int)(WS_GDU + ((size_t)(rb + row) * 512 + hh * 128 + e0 + pc * 8) * 2); doff[s] = O_U + (row * 16 + pc * 8) * 2; }
        }
    }
    const unsigned step9 = (tid - 128 < 128) ? 32768u : 65536u;
#define SSTEP(s) ((s) < 8 ? 65536u : ((s) == 8 ? 32768u : step9))
    u32x4 stg[10];
    if (stager) {
#pragma unroll
        for (int s = 0; s < 10; ++s) stg[s] = *(const u32x4*)(ws + (unsigned)soff[s]);
#pragma unroll
        for (int s = 0; s < 10; ++s) *(LAS u32x4*)(lds + doff[s]) = stg[s];
#pragma unroll
        for (int s = 0; s < 10; ++s) stg[s] = *(const u32x4*)(ws + (unsigned)soff[s] + SSTEP(s));
    }
    if (wid == 1) {
#pragma unroll
        for (int kt = 0; kt < 4; ++kt) *(LAS u32x4*)(lds + O_PS + kt * 1024 + lane * 16) = (u32x4){0u, 0u, 0u, 0u};
    }
    const float dv = edec[bl * 256 + lane * 4 + hh];
    f32x4 Sacc[8];
#pragma unroll
    for (int d = 0; d < 8; ++d) Sacc[d] = (f32x4){0.f, 0.f, 0.f, 0.f};
    __syncthreads();
    for (int n = 0; n < 64; ++n) {
        const LAS unsigned char* B = lds + (n & 1) * BUF;
        const int t0 = (bl * 64 + n) * 64;
        f32x4 OS[4];
        bf16x8 vb[2];
        if (wid == 0) {
            f32x4 WS[4];
            bf16x8 sb[4];
#pragma unroll
            for (int kt = 0; kt < 4; ++kt) { u32x4 w; w.x = cvt_pk_bf16(Sacc[2 * kt][0], Sacc[2 * kt][1]); w.y = cvt_pk_bf16(Sacc[2 * kt][2], Sacc[2 * kt][3]);
                w.z = cvt_pk_bf16(Sacc[2 * kt + 1][0], Sacc[2 * kt + 1][1]); w.w = cvt_pk_bf16(Sacc[2 * kt + 1][2], Sacc[2 * kt + 1][3]); sb[kt] = __builtin_bit_cast(bf16x8, w); }
#pragma unroll
            for (int m = 0; m < 4; ++m) WS[m] = (f32x4){0.f, 0.f, 0.f, 0.f};
#pragma unroll
            for (int kt = 0; kt < 4; ++kt)
#pragma unroll
                for (int m = 0; m < 4; ++m) { const LAS unsigned char* wp = B + O_W + ((m * 16 + fr) * 136 + kt * 32 + fq * 4) * 2;
                    u32x4 wa; { const u32x2 lo = *(const LAS u32x2*)wp, hi = *(const LAS u32x2*)(wp + 32); wa.x = lo.x; wa.y = lo.y; wa.z = hi.x; wa.w = hi.y; }
                    WS[m] = __builtin_amdgcn_mfma_f32_16x16x32_bf16(__builtin_bit_cast(bf16x8, wa), sb[kt], WS[m], 0, 0, 0); }
#pragma unroll
            for (int m = 0; m < 4; ++m)
#pragma unroll
                for (int jj = 0; jj < 4; ++jj) WS[m][jj] = bf2f(*(const LAS bf16_t*)(B + O_U + ((m * 16 + fq * 4 + jj) * 16 + fr) * 2)) - WS[m][jj];
#pragma unroll
            for (int kc = 0; kc < 2; ++kc) { u32x4 w; w.x = cvt_pk_bf16(WS[2 * kc][0], WS[2 * kc][1]); w.y = cvt_pk_bf16(WS[2 * kc][2], WS[2 * kc][3]);
                w.z = cvt_pk_bf16(WS[2 * kc + 1][0], WS[2 * kc + 1][1]); w.w = cvt_pk_bf16(WS[2 * kc + 1][2], WS[2 * kc + 1][3]); vb[kc] = __builtin_bit_cast(bf16x8, w);
                *(LAS u32x4*)(lds + O_PV + kc * 1024 + lane * 16) = w; }
        } else if (wid == 1) {
#pragma unroll
            for (int m = 0; m < 4; ++m) OS[m] = (f32x4){0.f, 0.f, 0.f, 0.f};
#pragma unroll
            for (int kt = 0; kt < 4; ++kt) {
                const bf16x8 sbr = *(const LAS bf16x8*)(lds + O_PS + kt * 1024 + lane * 16);
#pragma unroll
                for (int m = 0; m < 4; ++m) { const LAS unsigned char* qp = B + O_Q + ((m * 16 + fr) * 136 + kt * 32 + fq * 4) * 2;
                    u32x4 qa; { const u32x2 lo = *(const LAS u32x2*)qp, hi = *(const LAS u32x2*)(qp + 32); qa.x = lo.x; qa.y = lo.y; qa.z = hi.x; qa.w = hi.y; }
                    OS[m] = __builtin_amdgcn_mfma_f32_16x16x32_bf16(__builtin_bit_cast(bf16x8, qa), sbr, OS[m], 0, 0, 0); }
            }
        }
        __syncthreads();
        if (wid == 0) {
            const float dec = __shfl(dv, n);
#pragma unroll
            for (int d = 0; d < 8; ++d) Sacc[d] *= dec;
#pragma unroll
            for (int kc = 0; kc < 2; ++kc)
#pragma unroll
                for (int d = 0; d < 8; ++d) { const LAS unsigned char* kp = B + O_KT + ((d * 16 + fr) * 72 + kc * 32 + fq * 4) * 2;
                    u32x4 a; { const u32x2 lo = *(const LAS u32x2*)kp, hi = *(const LAS u32x2*)(kp + 32); a.x = lo.x; a.y = lo.y; a.z = hi.x; a.w = hi.y; }
                    Sacc[d] = __builtin_amdgcn_mfma_f32_16x16x32_bf16(__builtin_bit_cast(bf16x8, a), vb[kc], Sacc[d], 0, 0, 0); }
#pragma unroll
            for (int kt = 0; kt < 4; ++kt) { u32x4 w; w.x = cvt_pk_bf16(Sacc[2 * kt][0], Sacc[2 * kt][1]); w.y = cvt_pk_bf16(Sacc[2 * kt][2], Sacc[2 * kt][3]);
                w.z = cvt_pk_bf16(Sacc[2 * kt + 1][0], Sacc[2 * kt + 1][1]); w.w = cvt_pk_bf16(Sacc[2 * kt + 1][2], Sacc[2 * kt + 1][3]);
                *(LAS u32x4*)(lds + O_PS + kt * 1024 + lane * 16) = w; }
        } else if (wid == 1) {
#pragma unroll
            for (int kc = 0; kc < 2; ++kc) {
                const bf16x8 vbr = *(const LAS bf16x8*)(lds + O_PV + kc * 1024 + lane * 16);
#pragma unroll
                for (int m = 0; m < 4; ++m) { const LAS unsigned char* ap = B + O_AT + ((m * 16 + fr) * 72 + kc * 32 + fq * 4) * 2;
                    u32x4 a; { const u32x2 lo = *(const LAS u32x2*)ap, hi = *(const LAS u32x2*)(ap + 32); a.x = lo.x; a.y = lo.y; a.z = hi.x; a.w = hi.y; }
                    OS[m] = __builtin_amdgcn_mfma_f32_16x16x32_bf16(__builtin_bit_cast(bf16x8, a), vbr, OS[m], 0, 0, 0); }
            }
            float* op = oraw + (size_t)(t0 + fq * 4) * 512 + hh * 128 + e0 + fr;
#pragma unroll
            for (int m = 0; m < 4; ++m)
#pragma unroll
                for (int jj = 0; jj < 4; ++jj) op[(size_t)(m * 16 + jj) * 512] = OS[m][jj];
        } else if (stager) {
            if (n + 1 < 64) { LAS unsigned char* Bn = lds + ((n + 1) & 1) * BUF;
#pragma unroll
                for (int s = 0; s < 10; ++s) *(LAS u32x4*)(Bn + doff[s]) = stg[s]; }
            if (n + 2 < 64) {
#pragma unroll
                for (int s = 0; s < 10; ++s) stg[s] = *(const u32x4*)(ws + (unsigned)soff[s] + (unsigned)(n + 2) * SSTEP(s)); }
        }
        __syncthreads();
    }
}
__device__ __forceinline__ void gdn_out(const Params& p, int l, const float* oraw, const bf16_t* proj, bf16_t* yc) {
    const int tid = ltid(), sub = tid & 15;
    const float* ng = p.in[zz() + 21] + l * 128 + sub * 8;
    const f32x4 g0 = *(const f32x4*)ng, g1 = *(const f32x4*)(ng + 4);
    for (int rowi = lbid() * 32 + (tid >> 4); rowi < TS * 4; rowi += lgdim() * 32) {
        const int t = rowi >> 2, hh = rowi & 3;
        const float* op = oraw + (size_t)t * 512 + hh * 128 + sub * 8;
        const f32x4 o0 = *(const f32x4*)op, o1 = *(const f32x4*)(op + 4);
        float ss = (o0[0] * o0[0] + o0[1] * o0[1]) + (o0[2] * o0[2] + o0[3] * o0[3]) + (o1[0] * o1[0] + o1[1] * o1[1]) + (o1[2] * o1[2] + o1[3] * o1[3]);
        ss += __shfl_xor(ss, 1); ss += __shfl_xor(ss, 2); ss += __shfl_xor(ss, 4); ss += __shfl_xor(ss, 8);
        const float rs = rsqrtf(ss * (1.0f / 128.0f) + EPS);
        const u32x4 z = *(const u32x4*)(proj + (size_t)t * PW + PC_CZ + hh * 128 + sub * 8);
        u32x4 w;
        w.x = cvt_pk_bf16(o0[0] * rs * g0[0] * siluf_(lo_bf(z.x)), o0[1] * rs * g0[1] * siluf_(hi_bf(z.x)));
        w.y = cvt_pk_bf16(o0[2] * rs * g0[2] * siluf_(lo_bf(z.y)), o0[3] * rs * g0[3] * siluf_(hi_bf(z.y)));
        w.z = cvt_pk_bf16(o1[0] * rs * g1[0] * siluf_(lo_bf(z.z)), o1[1] * rs * g1[1] * siluf_(hi_bf(z.z)));
        w.w = cvt_pk_bf16(o1[2] * rs * g1[2] * siluf_(lo_bf(z.w)), o1[3] * rs * g1[3] * siluf_(hi_bf(z.w)));
        *(u32x4*)(yc + (size_t)t * 512 + hh * 128 + sub * 8) = w;
    }
}

constexpr int PH_PER_LAYER = 22, N_PHASES = 2 * PH_PER_LAYER + 1;

__device__ __forceinline__ void run_phase(LAS unsigned char* lds, const Params& p, int ph) {
    unsigned char* ws = lptr(p.ws);
    bf16_t* hbuf = (bf16_t*)(ws + WS_H);
    bf16_t* act = (bf16_t*)(ws + WS_PROJ);
    bf16_t* proj = (bf16_t*)(ws + WS_PROJ);
    bf16_t* hslab = hbuf;
    bf16_t* merged = hbuf + (size_t)TS * D;
    float* oraw = (float*)(ws + WS_H);
    bf16_t* ys = (bf16_t*)(ws + WS_YS);
    float* AB = (float*)(ws + WS_AB);
    bf16_t* halo = (bf16_t*)(ws + WS_HALO);
    float* Aend = (float*)(ws + WS_AEND); float* Hend = (float*)(ws + WS_HEND); float* carry = (float*)(ws + WS_CARRY); float* edec = (float*)(ws + WS_EDEC);
    const bf16_t* waxt = (const bf16_t*)(ws + WS_WAXT); const bf16_t* pwt = (const bf16_t*)(ws + WS_PWT);
    const int G = lgdim(), c = lbid();
    if (ph == N_PHASES - 1) { PHON(0) rms_rows_f32_inplace(lptr(p.out), p.in[zz() + 30], T); return; }
    const int l = ph / PH_PER_LAYER, r = ph % PH_PER_LAYER;
    const float* xcur = (l == 0) ? p.in[zz() + 0] : lptr(p.out);
    if (r == 0) { PHON(1) convert_layer(lds, p, l); PHON(0) rms_rows_bf16(xcur, p.in[zz() + 1] + l * D, hbuf, T); return; }
    if (r == 1 || r == 20) { PHON(2) ph_gemm_swiglu(lds, hbuf, (const bf16_t*)(ws + (r == 1 ? WS_WGU1 : WS_WGU2)), act); return; }
    if (r == 2 || r == 21) { PHON(3) ph_gemm_resid(lds, act, (const bf16_t*)(ws + (r == 2 ? WS_WD1 : WS_WD2)), T, DFF, (r == 2) ? xcur : lptr(p.out), lptr(p.out), 0.5f); return; }
    if (r == 19) { rms_rows_bf16(lptr(p.out), p.in[zz() + 26] + l * D, hbuf, T); return; }
    const int slab = (r - 3) >> 3, q = (r - 3) & 7;
    float* xs = lptr(p.out) + (size_t)slab * TS * D;
    switch (q) {
    case 0: rms_rows_bf16(xs, p.in[zz() + 5] + l * D, hslab, TS); break;
    case 1: PHON(4) ph_gemm_proj(lds, hslab, (const bf16_t*)(ws + WS_WIN), proj, AB); break;
    case 2:
        PHON(7) for (int t = c; t < TS / 64; t += G) lru_tile(lds, p, l, proj, nullptr, waxt, Aend, Hend, carry, t, 0);
        if (G >= 256) { PHON(5) for (int t = c; t < (TS / 128) * 2; t += G) sgu_tile(lds, p, l, proj, ys, t); }
        break;
    case 3:
        PHON(8) for (int it = c; it < (TS / 64) * 4; it += G) gdn_prep(lds, p, l, proj, AB, (bf16_t*)(ws + WS_GDQ), (bf16_t*)(ws + WS_GDK), (bf16_t*)(ws + WS_GDU), (bf16_t*)(ws + WS_GDW), (bf16_t*)(ws + WS_GDA), edec, it);
        lru_carry(Aend, Hend, carry);
        break;
    case 4:
        PHON(9) if (c < 128 || G < 256) { for (int ch = c; ch < 128; ch += G) gdn_scan(lds, ws, oraw, edec, ch); }
        if (G >= 256) {
            if (c >= 128) {
                const int cc = c - 128, GG = G - 128;
                PHON(10) for (int t = cc; t < TS / 128; t += GG) lru_tile(lds, p, l, proj, ys + (size_t)TS * 512, waxt, Aend, Hend, carry, t, 1);
                PHON(5) for (int t = (TS / 128) * 2 + cc; t < (TS / 128) * 4; t += GG) sgu_tile(lds, p, l, proj, ys, t);
                PHON(6) for (int t = cc; t < TS / 64; t += GG) pool_tile(lds, p, l, proj, ys + (size_t)3 * TS * 512, halo, pwt, t);
            }
        } else {
            for (int t = c; t < TS / 64; t += G) lru_tile(lds, p, l, proj, ys + (size_t)TS * 512, waxt, Aend, Hend, carry, t, 1);
            for (int t = c; t < (TS / 128) * 4; t += G) sgu_tile(lds, p, l, proj, ys, t);
            for (int t = c; t < TS / 64; t += G) pool_tile(lds, p, l, proj, ys + (size_t)3 * TS * 512, halo, pwt, t);
        }
        break;
    case 5: if (G >= 256) { for (int t = TS / 128 + c; t < TS / 64; t += G) lru_tile(lds, p, l, proj, ys + (size_t)TS * 512, waxt, Aend, Hend, carry, t, 1); }
        PHON(11) gdn_out(p, l, oraw, proj, ys + (size_t)2 * TS * 512); break;
    case 6: PHON(12) ph_gemm_branch(lds, ys, (const bf16_t*)(ws + WS_WB), proj, merged); break;
    default: PHON(13) ph_gemm_resid(lds, merged, (const bf16_t*)(ws + WS_WOUT), TS, D, xs, xs, 1.0f); break;
    }
}

extern __shared__ __attribute__((aligned(16))) unsigned char smem_dyn[];

#ifndef DUP_TYPE
#define DUP_TYPE -1
#endif
__device__ __forceinline__ int phase_type(int ph) {
    if (ph == N_PHASES - 1) return 12;
    const int r = ph % PH_PER_LAYER;
    if (r == 0) return 0; if (r == 1 || r == 20) return 1; if (r == 2 || r == 21) return 2; if (r == 19) return 11;
    const int q = (r - 3) & 7;
    return 3 + q;
}
__global__ void __launch_bounds__(NTHR) fwd_megakernel(Params p) {
    cg::grid_group grid = cg::this_grid();
    LAS unsigned char* lds = (LAS unsigned char*)smem_dyn;
    volatile LAS unsigned* st = (volatile LAS unsigned*)(lds + LDS_BYTES - 16);
    if (threadIdx.x == 0) { st[0] = 0u; st[1] = 0u; }
    __syncthreads();
    const XcdBarrier xb = xcd_barrier_post((unsigned*)(p.ws + WS_BAR), st);
    grid.sync();
    for (int ph = p.ph_lo; ph < p.ph_hi; ++ph) {
        if (ph > p.ph_lo) xcd_barrier(xb);
        run_phase(lds, p, ph);
#if DUP_TYPE == 6
        if (phase_type(ph) == 6) { xcd_barrier(xb); run_phase(lds, p, ph - 2); xcd_barrier(xb); run_phase(lds, p, ph - 1); xcd_barrier(xb); run_phase(lds, p, ph); }
#elif DUP_TYPE >= 0
        if (phase_type(ph) == DUP_TYPE) { xcd_barrier(xb); run_phase(lds, p, ph); }
#endif
    }
}

extern "C" void kernel_launch(void* const* d_in, const int* in_sizes, int n_in, void* d_out, int out_size, void* d_ws, size_t ws_size, hipStream_t stream) {
    static int grid_blocks = 0;
    if (grid_blocks == 0) {
        if (n_in != 31 || out_size != T * D || ws_size < WS_END) { fprintf(stderr, "kernel_launch: unexpected shapes (n_in %d out %d ws %zu need %zu)\n", n_in, out_size, ws_size, (size_t)WS_END); grid_blocks = -1; return; }
        int dev = 0, cus = 0, per_cu = 0;
        hipGetDevice(&dev);
        hipDeviceGetAttribute(&cus, hipDeviceAttributeMultiprocessorCount, dev);
        if (hipFuncSetAttribute((const void*)fwd_megakernel, hipFuncAttributeMaxDynamicSharedMemorySize, LDS_BYTES) != hipSuccess) { fprintf(stderr, "kernel_launch: hipFuncSetAttribute failed\n"); grid_blocks = -1; return; }
        hipOccupancyMaxActiveBlocksPerMultiprocessor(&per_cu, (const void*)fwd_megakernel, NTHR, LDS_BYTES);
        if (per_cu < 1) { fprintf(stderr, "kernel_launch: occupancy query returned %d\n", per_cu); per_cu = 1; }
        grid_blocks = cus * per_cu;
    }
    if (grid_blocks < 0) return;
    Params p{};
    for (int i = 0; i < 31; ++i) p.in[i] = (const float*)d_in[i];
    p.out = (float*)d_out; p.ws = (unsigned char*)d_ws;
    hipMemsetAsync((unsigned char*)d_ws + WS_BAR, 0, 16384, stream);
    p.ph_lo = 0; p.ph_hi = N_PHASES;
    void* args[] = {&p};
    hipError_t e = hipLaunchCooperativeKernel((const void*)fwd_megakernel, dim3(grid_blocks), dim3(NTHR), args, LDS_BYTES, stream);
    if (e != hipSuccess) fprintf(stderr, "cooperative launch failed: %s (grid %d)\n", hipGetErrorString(e), grid_blocks);
}
```

```cpp
#include <hip/hip_runtime.h>
#include <hip/hip_cooperative_groups.h>
#include <cstdio>
namespace cg = cooperative_groups;

#ifndef MULTI_LAUNCH
#define MULTI_LAUNCH 0
#endif

#ifndef PH_MASK
#define PH_MASK 0xFFFFF
#endif
#define PHON(k) if constexpr ((PH_MASK >> (k)) & 1)
#define LAS __attribute__((address_space(3)))
typedef unsigned short bf16_t;
typedef short bf16x8 __attribute__((ext_vector_type(8)));
typedef short bf16x4 __attribute__((ext_vector_type(4)));
typedef float f32x4 __attribute__((ext_vector_type(4)));
typedef unsigned u32x4 __attribute__((ext_vector_type(4)));
typedef unsigned u32x2 __attribute__((ext_vector_type(2)));

constexpr int T = 32768, D = 1024, DFF = 2816, NSLAB = 2, TS = T / NSLAB, SEQ = 4096, PW = 8960, PIN = 8712;
constexpr int PC_AU = 0, PC_AV = 512, PC_BX = 1024, PC_BG = 1536, PC_CQ = 2048, PC_CK = 2560, PC_CV = 3072, PC_CZ = 3584, PC_DX = 4096, PC_GATE = 4608, PC_AB = 8704;
constexpr float EPS = 1e-6f;
constexpr int NTHR = 512;
constexpr int LDS_BYTES = 147456;

constexpr size_t WS_WGU1 = 0;
constexpr size_t WS_WD1 = WS_WGU1 + (size_t)5632 * 1024 * 2;
constexpr size_t WS_WIN = WS_WD1 + (size_t)1024 * 2816 * 2;
constexpr size_t WS_WB = WS_WIN + (size_t)PW * 1024 * 2;
constexpr size_t WS_WOUT = WS_WB + (size_t)4 * 1024 * 512 * 2;
constexpr size_t WS_WGU2 = WS_WOUT + (size_t)1024 * 1024 * 2;
constexpr size_t WS_WD2 = WS_WGU2 + (size_t)5632 * 1024 * 2;
constexpr size_t WS_WAXT = WS_WD2 + (size_t)1024 * 2816 * 2;
constexpr size_t WS_PWT = WS_WAXT + 131072;
constexpr size_t WS_PROJ = WS_PWT + 131072;
constexpr size_t WS_H = WS_PROJ + (size_t)TS * PW * 2;
constexpr size_t WS_YS = WS_H + (size_t)T * D * 2;
constexpr size_t WS_AB = WS_YS + (size_t)4 * TS * 512 * 2;
constexpr size_t WS_HALO = WS_AB + (size_t)TS * 8 * 4;
constexpr size_t WS_AEND = WS_HALO + (size_t)(TS / 64) * 3 * 1536 * 2;
constexpr size_t WS_HEND = WS_AEND + (size_t)(TS / 64) * 512 * 4;
constexpr size_t WS_CARRY = WS_HEND + (size_t)(TS / 64) * 512 * 4;
constexpr size_t WS_EDEC = WS_CARRY + (size_t)(TS / 64) * 512 * 4;
constexpr size_t WS_BAR = WS_EDEC + 4096;
constexpr size_t WS_GDQ = WS_H + (size_t)TS * D * 2;
constexpr size_t WS_GDK = WS_GDQ + (size_t)TS * 512 * 2;
constexpr size_t WS_GDU = WS_BAR + 16384;
constexpr size_t WS_GDW = WS_GDU + (size_t)TS * 512 * 2;
constexpr size_t WS_GDA = WS_GDW + (size_t)TS * 512 * 2;
constexpr size_t WS_END = WS_GDA + (size_t)TS * 256 * 2;
static_assert(WS_END <= (size_t)512 * 1024 * 1024, "workspace budget");

struct Params { const float* in[31]; float* out; unsigned char* ws; int ph_lo, ph_hi; };

__device__ __forceinline__ int ltid() { int t = threadIdx.x; asm volatile("" : "+v"(t)); return t; }
__device__ __forceinline__ int lbid() { int t = blockIdx.x; asm volatile("" : "+s"(t)); return t; }
__device__ __forceinline__ int lgdim() { int t = gridDim.x; asm volatile("" : "+s"(t)); return t; }
__device__ __forceinline__ int zz() { int z; asm volatile("s_mov_b32 %0, 0" : "=s"(z)); return z; }
template <class P> __device__ __forceinline__ P* lptr(P* q) { asm volatile("" : "+s"(q)); return q; }
__device__ __forceinline__ float bf2f(unsigned short b) { return __uint_as_float(((unsigned)b) << 16); }
__device__ __forceinline__ unsigned cvt_pk_bf16(float lo, float hi) { unsigned r; asm("v_cvt_pk_bf16_f32 %0, %1, %2" : "=v"(r) : "v"(lo), "v"(hi)); return r; }
__device__ __forceinline__ unsigned short f2bf(float f) { return (unsigned short)(cvt_pk_bf16(f, 0.f) & 0xffffu); }
__device__ __forceinline__ float lo_bf(unsigned w) { return __uint_as_float(w << 16); }
__device__ __forceinline__ float hi_bf(unsigned w) { return __uint_as_float(w & 0xffff0000u); }
__device__ __forceinline__ float sigmoidf_(float x) { return __builtin_amdgcn_rcpf(1.0f + __expf(-x)); }
__device__ __forceinline__ float siluf_(float x) { return x * __builtin_amdgcn_rcpf(1.0f + __expf(-x)); }
__device__ __forceinline__ float geluf_(float x) { const float u = 1.5957691216057308f * (x + 0.044715f * x * x * x); return x * __builtin_amdgcn_rcpf(1.0f + __expf(-u)); }
__device__ __forceinline__ float softplusf_(float x) { return fmaxf(x, 0.f) + log1pf(__expf(-fabsf(x))); }
__device__ __forceinline__ float wave_sum(float v) {
#pragma unroll
    for (int o = 1; o < 64; o <<= 1) v += __shfl_xor(v, o);
    return v;
}


#define XB_TMO      128
#define XB_XCNT(j)  (256  + 64 * (j))
#define XB_XSUB(j)  (1280 + 64 * (j))
#define XB_XGEN(j)  (2304 + 64 * (j))
#define XB_TOP      3328
#define XB_TOPGEN   3392
#define XCD_BAR_WORDS 3456
#define XB_SPIN_CAP (1u << 22)
__device__ __forceinline__ unsigned xb_ld(unsigned* p)              { return __hip_atomic_load(p, __ATOMIC_RELAXED, __HIP_MEMORY_SCOPE_AGENT); }
__device__ __forceinline__ unsigned xb_add(unsigned* p, unsigned v) { return __hip_atomic_fetch_add(p, v, __ATOMIC_RELAXED, __HIP_MEMORY_SCOPE_AGENT); }
__device__ __forceinline__ unsigned xb_xcc_id() { return (unsigned)__builtin_amdgcn_s_getreg((3 << 11) | 20) & 0xFu; }
#define XB_SPIN(cond, bar) do { unsigned _sp = 0; while (cond) { __builtin_amdgcn_s_sleep(1); \
    if ((++_sp & 255u) == 0u) { if (xb_ld(&(bar)[XB_TMO])) break; if (_sp > XB_SPIN_CAP) { atomicAdd(&(bar)[XB_TMO], 1u); break; } } } } while (0)
struct XcdBarrier { unsigned* bar; unsigned x; volatile LAS unsigned* st; };
__device__ __forceinline__ XcdBarrier xcd_barrier_post(unsigned* bar, volatile LAS unsigned* st) {
    XcdBarrier b; b.bar = bar; b.x = xb_xcc_id(); b.st = st;
    if (threadIdx.x == 0) (void)xb_add(&bar[XB_XCNT(b.x)], 1u);
    return b;
}
__device__ __forceinline__ void xcd_barrier_complete(unsigned* bar, unsigned x, unsigned& nloc, unsigned& nx) {
    const unsigned G = gridDim.x * gridDim.y * gridDim.z;
    unsigned sum, cnt, mine, sp = 0u;
    for (;;) {
        sum = 0u; cnt = 0u; mine = 0u;
#pragma unroll
        for (unsigned j = 0; j < 16; ++j) { const unsigned c = xb_ld(&bar[XB_XCNT(j)]); sum += c; cnt += (c > 0u) ? 1u : 0u; mine = (j == x) ? c : mine; }
        if (sum == G) break;
        __builtin_amdgcn_s_sleep(1);
        if ((++sp & 255u) == 0u) { if (xb_ld(&bar[XB_TMO])) break; if (sp > XB_SPIN_CAP) { atomicAdd(&bar[XB_TMO], 1u); break; } }
    }
    nloc = mine > 0u ? mine : 1u; nx = cnt > 0u ? cnt : 1u;
}
__device__ __forceinline__ void xcd_barrier(const XcdBarrier& b) {
    asm volatile("s_waitcnt vmcnt(0)" ::: "memory");
    __syncthreads();
    if (threadIdx.x == 0) {
        unsigned* bar = b.bar;
        __builtin_amdgcn_s_waitcnt(0);
        unsigned nloc = b.st[0], nx = b.st[1];
        if (nloc == 0u) { xcd_barrier_complete(bar, b.x, nloc, nx); b.st[0] = nloc; b.st[1] = nx; }
        const unsigned old = xb_add(&bar[XB_XSUB(b.x)], 1u);
        const unsigned gen = old / nloc;
        if (old + 1u == (gen + 1u) * nloc) {
            __builtin_amdgcn_fence(__ATOMIC_RELEASE, "agent");
            asm volatile("s_waitcnt vmcnt(0)" ::: "memory");
            const unsigned og = xb_add(&bar[XB_TOP], 1u);
            const unsigned tg = og / nx;
            if (og + 1u == (tg + 1u) * nx) xb_add(&bar[XB_TOPGEN], 1u);
            else XB_SPIN(xb_ld(&bar[XB_TOPGEN]) == tg, bar);
            __builtin_amdgcn_fence(__ATOMIC_ACQUIRE, "agent");
            xb_add(&bar[XB_XGEN(b.x)], 1u);
            asm volatile("s_waitcnt vmcnt(0)" ::: "memory");
        } else {
            XB_SPIN(xb_ld(&bar[XB_XGEN(b.x)]) == gen, bar);
            __builtin_amdgcn_fence(__ATOMIC_ACQUIRE, "agent");
            asm volatile("s_waitcnt vmcnt(0)" ::: "memory");
        }
    }
    __syncthreads();
}

namespace pg8 {
constexpr int BM = 256, BK = 64, HALF = 128, HTB = HALF * BK * 2, STAGE_BYTES = 8 * HTB, NXCD = 8, WGM = 8;
__host__ __device__ __forceinline__ int lds_byte(int r, int c) { const int st = (r >> 4) * 2 + (c >> 5), rr = r & 15, cc = c & 31, ob = rr * 64 + cc * 2; return st * 1024 + (ob ^ (((ob >> 9) & 1) << 5)); }
__host__ __device__ __forceinline__ void stage_rc(int b, int& R, int& C) { const int st = b / 1024, sb = b % 1024, swz = sb ^ (((sb >> 9) & 1) << 5); R = (st >> 1) * 16 + swz / 64; C = (st & 1) * 32 + (swz % 64) / 2; }
__host__ __device__ __forceinline__ int perm32(int rho) { const int n = rho >> 4, i = rho & 15; return 8 * (i >> 2) + 4 * n + (i & 3); }

struct Unit { int pm, pn, g; };
struct Gemm { const bf16_t* A; const bf16_t* Bt; int M, N, K; size_t gsA, gsB; };

__device__ __forceinline__ void tile_of(int wgid, int nM, int nN, int nwg, Unit& u) {
    { const int q = nwg / NXCD, r = nwg % NXCD, xcd = wgid % NXCD, off = wgid / NXCD; wgid = (xcd < r ? xcd * (q + 1) : r * (q + 1) + (xcd - r) * q) + off; }
    const int nig = WGM * nN, gid = wgid / nig, fm = gid * WGM, gsz = (nM - fm) < WGM ? (nM - fm) : WGM;
    u.pm = fm + ((wgid % nig) % gsz); u.pn = (wgid % nig) / gsz;
}
struct StaticOrder {
    int nM, nN, nwg, G, c;
    __device__ void init(int M, int N, int G_, int c_) { nM = M / BM; nN = N / BM; nwg = nM * nN; G = G_; c = c_; }
    __device__ bool next(int i, Unit& u) const {
        const long L = (long)i * G + c; if (L >= nwg) return false;
        tile_of((int)L, nM, nN, nwg, u); u.g = 0; return true;
    }
};
struct BranchOrder {
    int nM, nN, nwg, G, c;
    __device__ void init(int M, int N, int G_, int c_) { nM = M / BM; nN = N / BM; nwg = nM * nN; G = G_; c = c_; }
    __device__ bool next(int i, Unit& u) const {
        const long L = (long)(i >> 2) * G + c; if (L >= nwg) return false;
        tile_of((int)L, nM, nN, nwg, u); u.g = i & 3; return true;
    }
};

struct EpiSwiGLU {
    static constexpr bool PERM = true;
    bf16_t* O;
    __device__ __forceinline__ bool keep(const Unit&) const { return false; }
    __device__ __forceinline__ void operator()(f32x4 (&acc)[2][2][4][2], const Unit& u, int wr, int wc, int fr, int fq) const {
        const int row0 = u.pm * BM + wr * 64 + fr, col0 = u.pn * 128 + wc * 32 + 8 * fq;
#pragma unroll
        for (int ai = 0; ai < 2; ++ai)
#pragma unroll
            for (int m = 0; m < 4; ++m) {
                bf16_t* rowp = O + (size_t)(row0 + ai * HALF + m * 16) * DFF + col0;
                float v[8];
#pragma unroll
                for (int n = 0; n < 2; ++n)
#pragma unroll
                    for (int j = 0; j < 4; ++j) v[n * 4 + j] = siluf_(acc[ai][0][m][n][j]) * acc[ai][1][m][n][j];
                u32x4 w; w.x = cvt_pk_bf16(v[0], v[1]); w.y = cvt_pk_bf16(v[2], v[3]); w.z = cvt_pk_bf16(v[4], v[5]); w.w = cvt_pk_bf16(v[6], v[7]);
                *(u32x4*)rowp = w;
                __builtin_amdgcn_sched_barrier(0);
            }
    }
};
struct EpiResid {
    static constexpr bool PERM = false;
    const float* Xin; float* Xout; float scale;
    __device__ __forceinline__ bool keep(const Unit&) const { return false; }
    __device__ __forceinline__ void operator()(f32x4 (&acc)[2][2][4][2], const Unit& u, int wr, int wc, int fr, int fq) const {
        const int row0 = u.pm * BM + wr * 64 + fr, col0 = u.pn * BM + wc * 32 + 4 * fq;
#pragma unroll
        for (int ai = 0; ai < 2; ++ai) {
            f32x4 xi[4][2][2];
#pragma unroll
            for (int m = 0; m < 4; ++m) { const size_t ro = (size_t)(row0 + ai * HALF + m * 16) * D + col0;
#pragma unroll
                for (int bj = 0; bj < 2; ++bj)
#pragma unroll
                    for (int n = 0; n < 2; ++n) xi[m][bj][n] = *(const f32x4*)(Xin + ro + bj * HALF + n * 16); }
#pragma unroll
            for (int m = 0; m < 4; ++m) { const size_t ro = (size_t)(row0 + ai * HALF + m * 16) * D + col0;
#pragma unroll
                for (int bj = 0; bj < 2; ++bj)
#pragma unroll
                    for (int n = 0; n < 2; ++n) *(f32x4*)(Xout + ro + bj * HALF + n * 16) = xi[m][bj][n] + acc[ai][bj][m][n] * scale; }
            __builtin_amdgcn_sched_barrier(0);
        }
    }
};
struct EpiProj {
    static constexpr bool PERM = true;
    bf16_t* O; float* AB;
    __device__ __forceinline__ bool keep(const Unit&) const { return false; }
    __device__ __forceinline__ void operator()(f32x4 (&acc)[2][2][4][2], const Unit& u, int wr, int wc, int fr, int fq) const {
        const int row0 = u.pm * BM + wr * 64 + fr, col0 = u.pn * BM + wc * 32 + 8 * fq;
        const bool ab = (u.pn == PC_AB / BM) && wc == 0 && fq == 0;
#pragma unroll
        for (int ai = 0; ai < 2; ++ai)
#pragma unroll
            for (int m = 0; m < 4; ++m) {
                const int row = row0 + ai * HALF + m * 16;
                bf16_t* rowp = O + (size_t)row * PW + col0;
#pragma unroll
                for (int bj = 0; bj < 2; ++bj) {
                    const f32x4 v0 = acc[ai][bj][m][0], v1 = acc[ai][bj][m][1];
                    u32x4 w; w.x = cvt_pk_bf16(v0[0], v0[1]); w.y = cvt_pk_bf16(v0[2], v0[3]); w.z = cvt_pk_bf16(v1[0], v1[1]); w.w = cvt_pk_bf16(v1[2], v1[3]);
                    *(u32x4*)(rowp + bj * HALF) = w;
                }
                __builtin_amdgcn_sched_barrier(0);
            }
        if (ab) {
#pragma unroll
            for (int ai = 0; ai < 2; ++ai)
#pragma unroll
                for (int m = 0; m < 4; ++m) { const int row = row0 + ai * HALF + m * 16; *(f32x4*)(AB + (size_t)row * 8) = acc[ai][0][m][0]; *(f32x4*)(AB + (size_t)row * 8 + 4) = acc[ai][0][m][1]; }
        }
    }
};
struct EpiBranch {
    static constexpr bool PERM = true;
    const bf16_t* P; bf16_t* O;
    __device__ __forceinline__ bool keep(const Unit& u) const { return u.g < 3; }
    __device__ __forceinline__ void operator()(f32x4 (&acc)[2][2][4][2], const Unit& u, int wr, int wc, int fr, int fq) const {
        const int row0 = u.pm * BM + wr * 64 + fr, col0 = u.pn * BM + wc * 32 + 8 * fq;
        const bool last = (u.g == 3);
#pragma unroll
        for (int ai = 0; ai < 2; ++ai) {
            u32x4 g0[4][2], g1[4][2];
#pragma unroll
            for (int m = 0; m < 4; ++m) { const bf16_t* gp = P + (size_t)(row0 + ai * HALF + m * 16) * PW + PC_GATE + u.g * D + col0;
#pragma unroll
                for (int bj = 0; bj < 2; ++bj) { g0[m][bj] = *(const u32x4*)(gp + bj * HALF); g1[m][bj] = last ? g0[m][bj] : *(const u32x4*)(gp + D + bj * HALF); } }
#pragma unroll
            for (int m = 0; m < 4; ++m) {
                const int row = row0 + ai * HALF + m * 16;
#pragma unroll
                for (int bj = 0; bj < 2; ++bj) {
                    float f[8];
                    if (!last) {
#pragma unroll
                        for (int q = 0; q < 4; ++q) {
                            f[2 * q] = (1.0f + __expf(-lo_bf(g1[m][bj][q]))) * __builtin_amdgcn_rcpf(1.0f + __expf(-lo_bf(g0[m][bj][q])));
                            f[2 * q + 1] = (1.0f + __expf(-hi_bf(g1[m][bj][q]))) * __builtin_amdgcn_rcpf(1.0f + __expf(-hi_bf(g0[m][bj][q])));
                        }
                    } else {
#pragma unroll
                        for (int q = 0; q < 4; ++q) { f[2 * q] = __builtin_amdgcn_rcpf(1.0f + __expf(-lo_bf(g0[m][bj][q]))); f[2 * q + 1] = __builtin_amdgcn_rcpf(1.0f + __expf(-hi_bf(g0[m][bj][q]))); }
                    }
#pragma unroll
                    for (int n = 0; n < 2; ++n)
#pragma unroll
                        for (int j = 0; j < 4; ++j) acc[ai][bj][m][n][j] *= f[n * 4 + j];
                    if (last) {
                        const f32x4 v0 = acc[ai][bj][m][0], v1 = acc[ai][bj][m][1];
                        u32x4 w; w.x = cvt_pk_bf16(v0[0], v0[1]); w.y = cvt_pk_bf16(v0[2], v0[3]); w.z = cvt_pk_bf16(v1[0], v1[1]); w.w = cvt_pk_bf16(v1[2], v1[3]);
                        *(u32x4*)(O + (size_t)row * D + col0 + bj * HALF) = w;
                    }
                }
            }
            __builtin_amdgcn_sched_barrier(0);
        }
    }
};

template <class Epi, class Sched>
__device__ __forceinline__ void gemm_phase(LAS unsigned char* lds, const Gemm g, const Sched& S, const Epi& E) {
    const int tid = ltid(), wid = __builtin_amdgcn_readfirstlane(tid >> 6), lane = tid & 63, wr = wid >> 2, wc = wid & 3, fr = lane & 15, fq = lane >> 4;
    const int K = g.K, nt = K / BK;
    unsigned voffA[2], voffB[2];
#pragma unroll
    for (int i = 0; i < 2; ++i) { int R, C; stage_rc(tid * 16 + i * 8192, R, C); const int Rb = Epi::PERM ? ((R & ~31) + perm32(R & 31)) : R;
        voffA[i] = (unsigned)(R * K + C) * 2u; voffB[i] = (unsigned)(Rb * K + C) * 2u; }
    const size_t kstep = (size_t)(BK * 2);
    const size_t hstep = (size_t)HALF * K * 2;
    const size_t tstep = 2 * hstep;
    const unsigned ldsw = (unsigned)wid * 1024u;
    const int aoff = lds_byte(wr * 64 + fr, fq * 8), boff = lds_byte(wc * 32 + fr, fq * 8);
#define PG8_SA(b, h) (((b) * 2 + (h)) * HTB)
#define PG8_SB(b, h) ((4 + (b) * 2 + (h)) * HTB)
#define PG8_STAGE(bufoff, gbase, voff) do { _Pragma("unroll") for (int _i = 0; _i < 2; ++_i) \
        __builtin_amdgcn_global_load_lds((const unsigned*)((const char*)(gbase) + (voff)[_i]), (LAS unsigned*)(lds + (bufoff) + ldsw + _i * 8192), 16, 0, 0); } while (0)
#define PG8_LDA(dst, b, h) do { _Pragma("unroll") for (int m = 0; m < 4; ++m) _Pragma("unroll") for (int k = 0; k < 2; ++k) dst[m][k] = *(const LAS bf16x8*)(lds + PG8_SA(b, h) + aoff + m * 2048 + k * 1024); } while (0)
#define PG8_LDB(dst, b, h) do { _Pragma("unroll") for (int n = 0; n < 2; ++n) _Pragma("unroll") for (int k = 0; k < 2; ++k) dst[n][k] = *(const LAS bf16x8*)(lds + PG8_SB(b, h) + boff + n * 2048 + k * 1024); } while (0)
#define PG8_MMA(ai, bj, At, Bt) do { __builtin_amdgcn_s_setprio(1); _Pragma("unroll") for (int m = 0; m < 4; ++m) _Pragma("unroll") for (int n = 0; n < 2; ++n) _Pragma("unroll") for (int k = 0; k < 2; ++k) \
        acc[ai][bj][m][n] = __builtin_amdgcn_mfma_f32_16x16x32_bf16(Bt[n][k], At[m][k], acc[ai][bj][m][n], 0, 0, 0); __builtin_amdgcn_s_setprio(0); } while (0)
#define PG8_WAIT_V(n) asm volatile("s_waitcnt vmcnt(" #n ")" ::: "memory")
#define PG8_WAIT_L(n) asm volatile("s_waitcnt lgkmcnt(" #n ")" ::: "memory")
#define PG8_BAR __builtin_amdgcn_s_barrier()
#define PG8_SCHED __builtin_amdgcn_sched_barrier(0)
    Unit cur, nxt; int ui = 0;
    if (!S.next(0, cur)) return;
    f32x4 acc[2][2][4][2];
#pragma unroll
    for (int a = 0; a < 2; ++a)
#pragma unroll
        for (int b = 0; b < 2; ++b)
#pragma unroll
            for (int m = 0; m < 4; ++m)
#pragma unroll
                for (int n = 0; n < 2; ++n) acc[a][b][m][n] = (f32x4){0.f, 0.f, 0.f, 0.f};
    bf16x8 At[4][2], B0[2][2], B1[2][2];
    const char* cA = (const char*)g.A + (size_t)cur.g * g.gsA + (size_t)cur.pm * tstep; const char* cB = (const char*)g.Bt + (size_t)cur.g * g.gsB + (size_t)cur.pn * tstep;
    PG8_STAGE(PG8_SB(0, 0), cB, voffB); PG8_STAGE(PG8_SA(0, 0), cA, voffA); PG8_STAGE(PG8_SB(0, 1), cB + hstep, voffB); PG8_STAGE(PG8_SA(0, 1), cA + hstep, voffA);
    if (wr == 1) PG8_BAR;
    PG8_WAIT_V(4); PG8_BAR;
    PG8_STAGE(PG8_SB(1, 0), cB + kstep, voffB); PG8_STAGE(PG8_SA(1, 0), cA + kstep, voffA); PG8_STAGE(PG8_SB(1, 1), cB + hstep + kstep, voffB);
    PG8_WAIT_V(6); PG8_BAR;
    for (;;) {
        const bool has_next = S.next(ui + 1, nxt);
        const char* nA = has_next ? (const char*)g.A + (size_t)nxt.g * g.gsA + (size_t)nxt.pm * tstep : cA; const char* nB = has_next ? (const char*)g.Bt + (size_t)nxt.g * g.gsB + (size_t)nxt.pn * tstep : cB;
        for (int t = 0; t < nt; t += 2) {
            const bool last = (t == nt - 2);
            const char* a1 = cA + (size_t)(t + 1) * kstep;
            const char* a2 = last ? nA : cA + (size_t)(t + 2) * kstep; const char* b2 = last ? nB : cB + (size_t)(t + 2) * kstep;
            const char* a3 = a2 + kstep; const char* b3 = b2 + kstep;
            PG8_LDB(B0, 0, 0); PG8_SCHED; PG8_LDA(At, 0, 0); PG8_STAGE(PG8_SA(1, 1), a1 + hstep, voffA);
            PG8_WAIT_L(8); PG8_BAR; PG8_WAIT_L(0); PG8_MMA(0, 0, At, B0); PG8_BAR; PG8_SCHED;
            PG8_LDB(B1, 0, 1); PG8_STAGE(PG8_SB(0, 0), b2, voffB);
            PG8_BAR; PG8_WAIT_L(0); PG8_MMA(0, 1, At, B1); PG8_BAR;
            PG8_LDA(At, 0, 1); PG8_STAGE(PG8_SA(0, 0), a2, voffA);
            PG8_BAR; PG8_WAIT_L(0); PG8_MMA(1, 0, At, B0); PG8_BAR; PG8_SCHED;
            PG8_STAGE(PG8_SB(0, 1), b2 + hstep, voffB);
            PG8_WAIT_V(6); PG8_BAR; PG8_MMA(1, 1, At, B1); PG8_BAR;
            PG8_LDB(B0, 1, 0); PG8_SCHED; PG8_LDA(At, 1, 0); PG8_STAGE(PG8_SA(0, 1), a2 + hstep, voffA);
            PG8_WAIT_L(8); PG8_BAR; PG8_WAIT_L(0); PG8_MMA(0, 0, At, B0); PG8_BAR; PG8_SCHED;
            PG8_LDB(B1, 1, 1); PG8_STAGE(PG8_SB(1, 0), b3, voffB);
            PG8_BAR; PG8_WAIT_L(0); PG8_MMA(0, 1, At, B1); PG8_BAR;
            PG8_LDA(At, 1, 1); PG8_STAGE(PG8_SA(1, 0), a3, voffA);
            PG8_BAR; PG8_WAIT_L(0); PG8_MMA(1, 0, At, B0); PG8_BAR; PG8_SCHED;
            PG8_STAGE(PG8_SB(1, 1), b3 + hstep, voffB);
            PG8_WAIT_V(6); PG8_BAR; PG8_MMA(1, 1, At, B1); PG8_BAR;
        }
        E(acc, cur, wr, wc, fr, fq);
        if (!has_next) break;
        if (!E.keep(cur)) {
#pragma unroll
            for (int a = 0; a < 2; ++a)
#pragma unroll
                for (int b = 0; b < 2; ++b)
#pragma unroll
                    for (int m = 0; m < 4; ++m)
#pragma unroll
                        for (int n = 0; n < 2; ++n) acc[a][b][m][n] = (f32x4){0.f, 0.f, 0.f, 0.f};
        }
        cur = nxt; cA = nA; cB = nB; ++ui;
    }
    PG8_WAIT_V(0);
    if (wr == 0) PG8_BAR;
    PG8_BAR;
#undef PG8_SA
#undef PG8_SB
#undef PG8_STAGE
#undef PG8_LDA
#undef PG8_LDB
#undef PG8_MMA
#undef PG8_WAIT_V
#undef PG8_WAIT_L
#undef PG8_BAR
#undef PG8_SCHED
}
}


#define NOINL __forceinline__
__device__ NOINL void ph_gemm_swiglu(LAS unsigned char* lds, const bf16_t* A, const bf16_t* Bt, bf16_t* O) {
    pg8::Gemm g{A, Bt, T, 2 * DFF, D, 0, 0}; pg8::StaticOrder S; S.init(g.M, g.N, lgdim(), lbid()); pg8::EpiSwiGLU E{O}; pg8::gemm_phase(lds, g, S, E);
}
__device__ NOINL void ph_gemm_resid(LAS unsigned char* lds, const bf16_t* A, const bf16_t* Bt, int M, int K, const float* Xin, float* Xout, float scale) {
    pg8::Gemm g{A, Bt, M, D, K, 0, 0}; pg8::StaticOrder S; S.init(g.M, g.N, lgdim(), lbid()); pg8::EpiResid E{Xin, Xout, scale}; pg8::gemm_phase(lds, g, S, E);
}
__device__ NOINL void ph_gemm_proj(LAS unsigned char* lds, const bf16_t* A, const bf16_t* Bt, bf16_t* O, float* AB) {
    pg8::Gemm g{A, Bt, TS, PW, D, 0, 0}; pg8::StaticOrder S; S.init(g.M, g.N, lgdim(), lbid()); pg8::EpiProj E{O, AB}; pg8::gemm_phase(lds, g, S, E);
}
__device__ NOINL void ph_gemm_branch(LAS unsigned char* lds, const bf16_t* A, const bf16_t* Bt, const bf16_t* P, bf16_t* O) {
    pg8::Gemm g{A, Bt, TS, D, 512, (size_t)TS * 512 * 2, (size_t)D * 512 * 2}; pg8::BranchOrder S; S.init(g.M, g.N, lgdim(), lbid()); pg8::EpiBranch E{P, O}; pg8::gemm_phase(lds, g, S, E);
}

struct ConvTask { const float* src0; const float* src1; bf16_t* dst; int K, Nsrc, mode, tile; };
__device__ __forceinline__ ConvTask conv_task(const Params& p, int l, int it) {
    unsigned char* ws = lptr(p.ws);
    constexpr int N1 = 16 * 88, N2 = 44 * 16, N3 = 16 * 140, N4 = 8 * 16, N5 = 16 * 16;
    ConvTask t; t.src1 = nullptr;
    int r = it;
    if (r < N1) { t.src0 = p.in[zz() + 2] + (size_t)l * D * DFF; t.src1 = p.in[zz() + 3] + (size_t)l * D * DFF; t.K = D; t.Nsrc = DFF; t.dst = (bf16_t*)(ws + WS_WGU1); t.mode = 1; t.tile = r; return t; } r -= N1;
    if (r < N2) { t.src0 = p.in[zz() + 4] + (size_t)l * DFF * D; t.K = DFF; t.Nsrc = D; t.dst = (bf16_t*)(ws + WS_WD1); t.mode = 0; t.tile = r; return t; } r -= N2;
    if (r < N3) { t.src0 = p.in[zz() + 6] + (size_t)l * D * PIN; t.K = D; t.Nsrc = PIN; t.dst = (bf16_t*)(ws + WS_WIN); t.mode = 2; t.tile = r; return t; } r -= N3;
    if (r < 4 * N4) { const int g = r / N4; t.src0 = p.in[zz() + 24] + ((size_t)l * 4 + g) * 512 * D; t.K = 512; t.Nsrc = D; t.dst = (bf16_t*)(ws + WS_WB) + (size_t)g * D * 512; t.mode = 0; t.tile = r % N4; return t; } r -= 4 * N4;
    if (r < N5) { t.src0 = p.in[zz() + 25] + (size_t)l * D * D; t.K = D; t.Nsrc = D; t.dst = (bf16_t*)(ws + WS_WOUT); t.mode = 0; t.tile = r; return t; } r -= N5;
    if (r < N1) { t.src0 = p.in[zz() + 27] + (size_t)l * D * DFF; t.src1 = p.in[zz() + 28] + (size_t)l * D * DFF; t.K = D; t.Nsrc = DFF; t.dst = (bf16_t*)(ws + WS_WGU2); t.mode = 1; t.tile = r; return t; } r -= N1;
    t.src0 = p.in[zz() + 29] + (size_t)l * DFF * D; t.K = DFF; t.Nsrc = D; t.dst = (bf16_t*)(ws + WS_WD2); t.mode = 0; t.tile = r; return t;
}
__device__ __forceinline__ void conv_load(const ConvTask& t, int tid, f32x4& a, f32x4& b) {
    const int nkt = t.K / 64, kt = t.tile % nkt, rt = t.tile / nkt, k0 = kt * 64, r0 = rt * 64;
    const int kk = tid >> 3, rr = (tid & 7) * 8, rho = r0 + rr;
    const float* src = t.src0; int col = rho;
    if (t.mode == 1) { const int pn = rho >> 8, bj = (rho >> 7) & 1, j = rho & 127; col = pn * 128 + j; src = bj ? t.src1 : t.src0; }
    else if (t.mode == 2) { col = rho < 4096 ? rho : (rho < 8704 ? rho + 8 : (rho < 8712 ? rho - 8704 + 4096 : -1)); }
    a = (f32x4){0.f, 0.f, 0.f, 0.f}; b = a;
    if (col >= 0) { const float* sp = src + (size_t)(k0 + kk) * t.Nsrc + col; a = *(const f32x4*)sp; b = *(const f32x4*)(sp + 4); }
}
__device__ __forceinline__ void conv_store(LAS float* scr, const ConvTask& t, int tid, const f32x4& a, const f32x4& b) {
    const int nkt = t.K / 64, kt = t.tile % nkt, rt = t.tile / nkt, k0 = kt * 64, r0 = rt * 64;
    { const int kk = tid >> 3, rr = (tid & 7) * 8;
#pragma unroll
        for (int e = 0; e < 4; ++e) { scr[(rr + e) * 65 + kk] = a[e]; scr[(rr + 4 + e) * 65 + kk] = b[e]; } }
    __syncthreads();
    { const int rl = tid >> 3, kc = (tid & 7) * 8;
        const LAS float* s = scr + rl * 65 + kc;
        u32x4 w; w.x = cvt_pk_bf16(s[0], s[1]); w.y = cvt_pk_bf16(s[2], s[3]); w.z = cvt_pk_bf16(s[4], s[5]); w.w = cvt_pk_bf16(s[6], s[7]);
        *(u32x4*)(t.dst + (size_t)(r0 + rl) * t.K + k0 + kc) = w; }
    __syncthreads();
}

__device__ __forceinline__ void convert_layer(LAS unsigned char* lds, const Params& p, int l) {
    LAS float* scr = (LAS float*)lds;
    unsigned char* ws = lptr(p.ws);
    constexpr int N1 = 16 * 88, N2 = 44 * 16, N3 = 16 * 140, N4 = 8 * 16, N5 = 16 * 16;
    constexpr int TOT = N1 + N2 + N3 + 4 * N4 + N5 + N1 + N2;
    const int tid = ltid(), G = lgdim();
    int it = lbid();
    if (it < TOT) {
        ConvTask cur = conv_task(p, l, it);
        f32x4 a, b; conv_load(cur, tid, a, b);
        for (;;) {
            const int nx = it + G; const bool more = nx < TOT;
            ConvTask nxt = cur; f32x4 na = a, nb = b;
            if (more) { nxt = conv_task(p, l, nx); conv_load(nxt, tid, na, nb); }
            conv_store(scr, cur, tid, a, b);
            if (!more) break;
            cur = nxt; a = na; b = nb; it = nx;
        }
    }
    bf16_t* waxt = (bf16_t*)(ws + WS_WAXT); bf16_t* pwt = (bf16_t*)(ws + WS_PWT);
    const float* wa = p.in[zz() + 13] + (size_t)l * 8 * 64 * 64; const float* wx = p.in[zz() + 15] + (size_t)l * 8 * 64 * 64; const float* pw = p.in[zz() + 22] + (size_t)l * 4 * 128 * 128;
    for (int e = lbid() * NTHR + ltid(); e < 65536; e += lgdim() * NTHR) {
        { const int h = e >> 13, jp = (e >> 6) & 127, i = e & 63; waxt[e] = f2bf(jp < 64 ? wa[(h * 64 + i) * 64 + jp] : wx[(h * 64 + i) * 64 + jp - 64]); }
        { const int g = e >> 14, d = (e >> 7) & 127, c = e & 127; pwt[e] = f2bf(pw[(g * 128 + c) * 128 + d]); }
    }
}

__device__ __forceinline__ void rms_rows_bf16(const float* X, const float* gain, bf16_t* H, int nrows) {
    const int wid = ltid() >> 6, lane = ltid() & 63;
    f32x4 gv[4];
#pragma unroll
    for (int j = 0; j < 4; ++j) gv[j] = *(const f32x4*)(gain + (lane + 64 * j) * 4);
    for (int row0 = (lbid() * 8 + wid) * 4; row0 < nrows; row0 += lgdim() * 32) {
        f32x4 v[4][4];
#pragma unroll
        for (int r = 0; r < 4; ++r) { const f32x4* xr = (const f32x4*)(X + (size_t)min(row0 + r, nrows - 1) * D) + lane;
#pragma unroll
            for (int j = 0; j < 4; ++j) v[r][j] = xr[64 * j]; }
#pragma unroll
        for (int r = 0; r < 4; ++r) {
            float s = 0.f;
#pragma unroll
            for (int j = 0; j < 4; ++j) s += (v[r][j].x * v[r][j].x + v[r][j].y * v[r][j].y) + (v[r][j].z * v[r][j].z + v[r][j].w * v[r][j].w);
            const float rs = rsqrtf(wave_sum(s) * (1.0f / D) + EPS);
            u32x2* o = (u32x2*)(H + (size_t)(row0 + r) * D) + lane;
            if (row0 + r < nrows)
#pragma unroll
            for (int j = 0; j < 4; ++j) { u32x2 w; w.x = cvt_pk_bf16(v[r][j].x * rs * gv[j].x, v[r][j].y * rs * gv[j].y); w.y = cvt_pk_bf16(v[r][j].z * rs * gv[j].z, v[r][j].w * rs * gv[j].w); o[64 * j] = w; }
        }
    }
}
__device__ __forceinline__ void rms_rows_f32_inplace(float* X, const float* gain, int nrows) {
    const int wid = ltid() >> 6, lane = ltid() & 63;
    f32x4 gv[4];
#pragma unroll
    for (int j = 0; j < 4; ++j) gv[j] = *(const f32x4*)(gain + (lane + 64 * j) * 4);
    for (int row0 = (lbid() * 8 + wid) * 4; row0 < nrows; row0 += lgdim() * 32) {
        f32x4 v[4][4];
#pragma unroll
        for (int r = 0; r < 4; ++r) { const f32x4* xr = (const f32x4*)(X + (size_t)min(row0 + r, nrows - 1) * D) + lane;
#pragma unroll
            for (int j = 0; j < 4; ++j) v[r][j] = xr[64 * j]; }
#pragma unroll
        for (int r = 0; r < 4; ++r) {
            float s = 0.f;
#pragma unroll
            for (int j = 0; j < 4; ++j) s += (v[r][j].x * v[r][j].x + v[r][j].y * v[r][j].y) + (v[r][j].z * v[r][j].z + v[r][j].w * v[r][j].w);
            const float rs = rsqrtf(wave_sum(s) * (1.0f / D) + EPS);
            f32x4* xo = (f32x4*)(X + (size_t)(row0 + r) * D) + lane;
            if (row0 + r < nrows)
#pragma unroll
            for (int j = 0; j < 4; ++j) xo[64 * j] = v[r][j] * rs * gv[j];
        }
    }
}

__device__ __forceinline__ void sgu_tile(LAS unsigned char* lds, const Params& p, int l, const bf16_t* proj, bf16_t* ya, int tile) {
    const int tid = ltid(), wid = tid >> 6, lane = tid & 63, fr = lane & 15, fq = lane >> 4;
    const int blk = tile >> 2, g = tile & 3, r0 = blk * 128;
    LAS bf16_t* Wl = (LAS bf16_t*)lds;
    LAS bf16_t* VT = (LAS bf16_t*)(lds + 34816);
    const float* lng = p.in[zz() + 7] + l * 512 + g * 128; const float* lnb = p.in[zz() + 8] + l * 512 + g * 128;
    {
        const int i = tid >> 2, qd = tid & 3;
        const bf16_t* vrow = proj + (size_t)(r0 + i) * PW + PC_AV + qd * 8;
        float s = 0.f, s2 = 0.f;
#pragma unroll 4
        for (int e8 = 0; e8 < 16; ++e8) { const u32x4 w = *(const u32x4*)(vrow + e8 * 32);
#pragma unroll
            for (int q = 0; q < 4; ++q) { const float a = geluf_(lo_bf(w[q])), b = geluf_(hi_bf(w[q])); s += a + b; s2 += a * a + b * b; } }
        s += __shfl_xor(s, 1); s += __shfl_xor(s, 2); s2 += __shfl_xor(s2, 1); s2 += __shfl_xor(s2, 2);
        const float mean = s * (1.0f / 512.0f), var = fmaxf(s2 * (1.0f / 512.0f) - mean * mean, 0.f), rstd = rsqrtf(var + EPS);
        const bf16_t* vg = proj + (size_t)(r0 + i) * PW + PC_AV + g * 128 + qd * 8;
#pragma unroll
        for (int e8 = 0; e8 < 4; ++e8) { const u32x4 w = *(const u32x4*)(vg + e8 * 32);
#pragma unroll
            for (int q = 0; q < 4; ++q) { const int c = e8 * 32 + qd * 8 + 2 * q;
                VT[c * 136 + i] = f2bf((geluf_(lo_bf(w[q])) - mean) * rstd * lng[c] + lnb[c]);
                VT[(c + 1) * 136 + i] = f2bf((geluf_(hi_bf(w[q])) - mean) * rstd * lng[c + 1] + lnb[c + 1]); } }
        const float* wsrc = p.in[zz() + 9] + (((size_t)l * 4 + g) * 128 + i) * 128 + qd * 32;
#pragma unroll
        for (int e4 = 0; e4 < 8; ++e4) { f32x4 w = *(const f32x4*)(wsrc + e4 * 4); if (i < 64 && qd >= 2) w = (f32x4){0.f, 0.f, 0.f, 0.f};
            u32x2 o; o.x = cvt_pk_bf16(w.x, w.y); o.y = cvt_pk_bf16(w.z, w.w); *(LAS u32x2*)(Wl + i * 136 + qd * 32 + e4 * 4) = o; }
    }
    __syncthreads();
    f32x4 acc[8];
#pragma unroll
    for (int n = 0; n < 8; ++n) acc[n] = (f32x4){0.f, 0.f, 0.f, 0.f};
#pragma unroll
    for (int ks = 0; ks < 4; ++ks) {
        const bf16x8 af = *(const LAS bf16x8*)(Wl + (wid * 16 + fr) * 136 + ks * 32 + fq * 8);
#pragma unroll
        for (int n = 0; n < 8; ++n) { const bf16x8 bf = *(const LAS bf16x8*)(VT + (n * 16 + fr) * 136 + ks * 32 + fq * 8); acc[n] = __builtin_amdgcn_mfma_f32_16x16x32_bf16(bf, af, acc[n], 0, 0, 0); }
    }
    {
        const int i = wid * 16 + fr; const float bias = p.in[zz() + 10][((size_t)l * 4 + g) * 128 + i];
        const bf16_t* up = proj + (size_t)(r0 + i) * PW + PC_AU + g * 128 + fq * 4;
        bf16_t* yp = ya + (size_t)(r0 + i) * 512 + g * 128 + fq * 4;
#pragma unroll
        for (int n = 0; n < 8; ++n) { const u32x2 uw = *(const u32x2*)(up + n * 16);
            u32x2 o; o.x = cvt_pk_bf16((acc[n][0] + bias) * geluf_(lo_bf(uw.x)), (acc[n][1] + bias) * geluf_(hi_bf(uw.x)));
            o.y = cvt_pk_bf16((acc[n][2] + bias) * geluf_(lo_bf(uw.y)), (acc[n][3] + bias) * geluf_(hi_bf(uw.y))); *(u32x2*)(yp + n * 16) = o; }
    }
    __syncthreads();
}

template <int WIN>
__device__ __forceinline__ void pool_rows(LAS bf16_t* Al, const bf16_t* xcol, int c, int pos0) {
    float xv[80];
#pragma unroll
    for (int k = 0; k < 80; ++k) xv[k] = (pos0 - 16 + k >= 0) ? bf2f(xcol[(long)(k - 16) * PW]) : 0.f;
    float s = 0.f;
#pragma unroll
    for (int j = 0; j < WIN; ++j) s += xv[16 - j];
#pragma unroll
    for (int tt = 0; tt < 64; ++tt) {
        const int k = tt + 16;
        const int cnt = min(pos0 + tt + 1, WIN);
        Al[tt * 520 + c] = f2bf(s / (float)cnt - xv[k]);
        if (tt < 63) s += xv[k + 1] - xv[k + 1 - WIN];
    }
}
__device__ __forceinline__ void pool_tile(LAS unsigned char* lds, const Params& p, int l, const bf16_t* proj, bf16_t* yd, bf16_t* halo, const bf16_t* pwt, int tile) {
    const int tid = ltid(), wid = tid >> 6, lane = tid & 63, fr = lane & 15, fq = lane >> 4;
    const int t0 = tile * 64, pos0 = t0 % SEQ;
    LAS bf16_t* Al = (LAS bf16_t*)lds;
    {
        const int c = tid, g = wid >> 1;
        const bf16_t* xcol = proj + (size_t)t0 * PW + PC_DX + c;
        if (g == 0) pool_rows<2>(Al, xcol, c, pos0); else if (g == 1) pool_rows<4>(Al, xcol, c, pos0); else if (g == 2) pool_rows<8>(Al, xcol, c, pos0); else pool_rows<16>(Al, xcol, c, pos0);
    }
    __syncthreads();
    {
        const int g = wid >> 1, nh = wid & 1;
        f32x4 acc[4][4];
#pragma unroll
        for (int m = 0; m < 4; ++m)
#pragma unroll
            for (int n = 0; n < 4; ++n) acc[m][n] = (f32x4){0.f, 0.f, 0.f, 0.f};
#pragma unroll
        for (int ks = 0; ks < 4; ++ks) {
            bf16x8 bfr[4];
#pragma unroll
            for (int n = 0; n < 4; ++n) bfr[n] = *(const bf16x8*)(pwt + ((size_t)(g * 128 + (nh * 4 + n) * 16 + fr)) * 128 + ks * 32 + fq * 8);
#pragma unroll
            for (int m = 0; m < 4; ++m) { const bf16x8 af = *(const LAS bf16x8*)(Al + (m * 16 + fr) * 520 + g * 128 + ks * 32 + fq * 8);
#pragma unroll
                for (int n = 0; n < 4; ++n) acc[m][n] = __builtin_amdgcn_mfma_f32_16x16x32_bf16(bfr[n], af, acc[m][n], 0, 0, 0); }
        }
        const float* sc = p.in[zz() + 23] + l * 512 + g * 128;
#pragma unroll
        for (int n = 0; n < 4; ++n) { const int d = (nh * 4 + n) * 16 + fq * 4; const f32x4 s4 = *(const f32x4*)(sc + d);
#pragma unroll
            for (int m = 0; m < 4; ++m) { u32x2 o; o.x = cvt_pk_bf16(acc[m][n][0] * s4[0], acc[m][n][1] * s4[1]); o.y = cvt_pk_bf16(acc[m][n][2] * s4[2], acc[m][n][3] * s4[3]);
                *(u32x2*)(yd + (size_t)(t0 + m * 16 + fr) * 512 + g * 128 + d) = o; } }
    }
    __syncthreads();
}

__device__ __forceinline__ void lru_tile(LAS unsigned char* lds, const Params& p, int l, const bf16_t* proj, bf16_t* yb, const bf16_t* waxt, float* Aend, float* Hend, const float* carry, int tile, int mode) {
    const int tid = ltid(), wid = tid >> 6, lane = tid & 63, fr = lane & 15, fq = lane >> 4;
    const int t0 = tile * 64, pos0 = t0 % SEQ, c = wid * 64 + lane;
    LAS bf16_t* Aw = (LAS bf16_t*)(lds + wid * 10560);
    LAS float* Xw = (LAS float*)(lds + wid * 10560 + 2304);
    bf16x8 bfr[8][2];
#pragma unroll
    for (int n = 0; n < 8; ++n)
#pragma unroll
        for (int ks = 0; ks < 2; ++ks) bfr[n][ks] = *(const bf16x8*)(waxt + ((size_t)(wid * 128 + n * 16 + fr)) * 64 + ks * 32 + fq * 8);
    const float* cwp = p.in[zz() + 11] + (size_t)l * 4 * 512 + c;
    const float cw0 = cwp[0], cw1 = cwp[512], cw2 = cwp[1024], cw3 = cwp[1536], cb = p.in[zz() + 12][l * 512 + c];
    const float ba = p.in[zz() + 14][l * 512 + c], bx = p.in[zz() + 16][l * 512 + c], sp8 = 8.0f * softplusf_(-p.in[zz() + 17][l * 512 + c]);
    const bf16_t* xcol = proj + (size_t)t0 * PW + PC_BX + c;
    float xm3 = 0.f, xm2 = 0.f, xm1 = 0.f;
    if (pos0 > 0) { xm3 = bf2f(xcol[-3L * PW]); xm2 = bf2f(xcol[-2L * PW]); xm1 = bf2f(xcol[-1L * PW]); }
    const bf16_t* gcol = proj + (size_t)t0 * PW + PC_BG + c;
    bf16_t* ycol = yb + (size_t)t0 * 512 + c;
    float h = mode ? carry[(size_t)tile * 512 + c] : 0.f, Ap = 1.f;
    for (int sub = 0; sub < 4; ++sub) {
        float xc[16];
#pragma unroll
        for (int tt = 0; tt < 16; ++tt) { const float xin = bf2f(*xcol); xcol += PW; xc[tt] = cb + cw0 * xm3 + cw1 * xm2 + cw2 * xm1 + cw3 * xin; xm3 = xm2; xm2 = xm1; xm1 = xin; Aw[tt * 72 + lane] = f2bf(xc[tt]); }
        __syncthreads();
        f32x4 acc[8];
#pragma unroll
        for (int n = 0; n < 8; ++n) acc[n] = (f32x4){0.f, 0.f, 0.f, 0.f};
#pragma unroll
        for (int ks = 0; ks < 2; ++ks) { const bf16x8 af = *(const LAS bf16x8*)(Aw + fr * 72 + ks * 32 + fq * 8);
#pragma unroll
            for (int n = 0; n < 8; ++n) acc[n] = __builtin_amdgcn_mfma_f32_16x16x32_bf16(bfr[n][ks], af, acc[n], 0, 0, 0); }
#pragma unroll
        for (int n = 0; n < 8; ++n)
#pragma unroll
            for (int j = 0; j < 4; ++j) Xw[fr * 129 + n * 16 + fq * 4 + j] = acc[n][j];
        __syncthreads();
#pragma unroll
        for (int tt = 0; tt < 16; ++tt) {
            const float r = sigmoidf_(Xw[tt * 129 + lane] + ba), ig = sigmoidf_(Xw[tt * 129 + 64 + lane] + bx);
            const float la = -sp8 * r, a = __expf(la), x2 = 2.0f * la;
            const float om = (x2 > -0.1f) ? -x2 * (1.0f + x2 * (0.5f + x2 * (0.16666667f + x2 * 0.041666668f))) : 1.0f - a * a;
            h = a * h + __builtin_amdgcn_sqrtf(om) * ig * xc[tt]; Ap *= a;
            if (mode) { const float gt = bf2f(*gcol); gcol += PW; *ycol = f2bf(h * geluf_(gt)); ycol += 512; }
        }
        __syncthreads();
    }
    if (!mode) { Aend[(size_t)tile * 512 + c] = Ap; Hend[(size_t)tile * 512 + c] = h; }
}
__device__ __forceinline__ void lru_carry(const float* Aend, const float* Hend, float* carry) {
    const int gid = lbid() * NTHR + ltid();
    if (gid < (TS / SEQ) * 512) {
        const int bl = gid >> 9, c = gid & 511; float h = 0.f;
        for (int n = 0; n < 64; ++n) { const size_t o = (size_t)(bl * 64 + n) * 512 + c; carry[o] = h; h = Aend[o] * h + Hend[o]; }
    }
}

__device__ __forceinline__ void gdn_prep(LAS unsigned char* lds, const Params& p, int l, const bf16_t* proj, const float* AB, bf16_t* GQ, bf16_t* GK, bf16_t* GU, bf16_t* GW, bf16_t* GA, float* edec, int item) {
    const int tid = ltid(), wid = tid >> 6, lane = tid & 63, fr = lane & 15, fq = lane >> 4;
    const int bl = item >> 8, n = (item & 255) >> 2, hh = item & 3, ch = bl * 64 + n, t0 = ch * 64;
    LAS bf16_t* Kl = (LAS bf16_t*)lds;
    LAS bf16_t* Ql = (LAS bf16_t*)(lds + 17408);
    LAS float* RHS = (LAS float*)(lds + 34816);
    LAS float* Am = (LAS float*)(lds + 101376);
    LAS float* gc = (LAS float*)(lds + 117760);
    LAS float* bt = (LAS float*)(lds + 118016);
    const int t = tid >> 3, d0 = (tid & 7) * 16;
    float qkv[3][16];
#pragma unroll
    for (int sec = 0; sec < 3; ++sec) {
        const int colh = sec * 512 + hh * 128 + d0;
        float a[16];
#pragma unroll
        for (int e = 0; e < 16; ++e) a[e] = 0.f;
#pragma unroll
        for (int k = 0; k < 4; ++k) {
            const int tt = t - 3 + k;
            const bf16_t* src = nullptr;
            if (tt >= 0 || n > 0) src = proj + (long)(t0 + tt) * PW + PC_CQ + colh;
            if (src) {
                const u32x4 w0 = *(const u32x4*)src, w1 = *(const u32x4*)(src + 8);
                const float* cw = p.in[zz() + 18] + ((size_t)l * 4 + k) * 1536 + colh;
#pragma unroll
                for (int q = 0; q < 4; ++q) { const f32x4 c4 = *(const f32x4*)(cw + q * 4);
                    const unsigned wa = (q < 2) ? w0[2 * q] : w1[2 * q - 4], wb = (q < 2) ? w0[2 * q + 1] : w1[2 * q - 3];
                    a[q * 4 + 0] += c4[0] * lo_bf(wa); a[q * 4 + 1] += c4[1] * hi_bf(wa); a[q * 4 + 2] += c4[2] * lo_bf(wb); a[q * 4 + 3] += c4[3] * hi_bf(wb); }
            }
        }
#pragma unroll
        for (int e = 0; e < 16; ++e) qkv[sec][e] = siluf_(a[e]);
    }
    {
        float sq = 0.f, sk = 0.f;
#pragma unroll
        for (int e = 0; e < 16; ++e) { sq += qkv[0][e] * qkv[0][e]; sk += qkv[1][e] * qkv[1][e]; }
        sq += __shfl_xor(sq, 1); sq += __shfl_xor(sq, 2); sq += __shfl_xor(sq, 4); sk += __shfl_xor(sk, 1); sk += __shfl_xor(sk, 2); sk += __shfl_xor(sk, 4);
        const float qn = rsqrtf(sq + EPS) * 0.08838834764831845f, kn = rsqrtf(sk + EPS);
#pragma unroll
        for (int e = 0; e < 16; ++e) { qkv[0][e] *= qn; qkv[1][e] *= kn; }
#pragma unroll
        for (int e = 0; e < 16; e += 2) { *(LAS unsigned*)(Ql + t * 136 + d0 + e) = cvt_pk_bf16(qkv[0][e], qkv[0][e + 1]); *(LAS unsigned*)(Kl + t * 136 + d0 + e) = cvt_pk_bf16(qkv[1][e], qkv[1][e + 1]); }
    }
    if (wid == 0) {
        const float al = AB[(size_t)(t0 + lane) * 8 + 4 + hh], be = AB[(size_t)(t0 + lane) * 8 + hh];
        float gv = -__expf(p.in[zz() + 19][l * 4 + hh]) * softplusf_(al + p.in[zz() + 20][l * 4 + hh]);
#pragma unroll
        for (int o = 1; o < 64; o <<= 1) { const float u = __shfl_up(gv, o); if (lane >= o) gv += u; }
        gc[lane] = gv; bt[lane] = sigmoidf_(be);
        if (lane == 63) edec[item] = __expf(gv);
    }
    __syncthreads();
    {
        const float bet = bt[t], gct = gc[t], eg = __expf(gct), ekd = __expf(gc[63] - gct);
#pragma unroll
        for (int e = 0; e < 16; ++e) { RHS[t * 260 + d0 + e] = qkv[2][e] * bet; RHS[t * 260 + 128 + d0 + e] = qkv[1][e] * bet * eg; }
        bf16_t* qdst = GQ + (size_t)(t0 + t) * 512 + hh * 128 + d0;
        u32x4 w0, w1;
        w0.x = cvt_pk_bf16(qkv[0][0] * eg, qkv[0][1] * eg); w0.y = cvt_pk_bf16(qkv[0][2] * eg, qkv[0][3] * eg); w0.z = cvt_pk_bf16(qkv[0][4] * eg, qkv[0][5] * eg); w0.w = cvt_pk_bf16(qkv[0][6] * eg, qkv[0][7] * eg);
        w1.x = cvt_pk_bf16(qkv[0][8] * eg, qkv[0][9] * eg); w1.y = cvt_pk_bf16(qkv[0][10] * eg, qkv[0][11] * eg); w1.z = cvt_pk_bf16(qkv[0][12] * eg, qkv[0][13] * eg); w1.w = cvt_pk_bf16(qkv[0][14] * eg, qkv[0][15] * eg);
        *(u32x4*)qdst = w0; *(u32x4*)(qdst + 8) = w1;
#pragma unroll
        for (int e = 0; e < 16; ++e) qkv[1][e] *= ekd;
    }
    {
        const int it = wid & 3, which = wid >> 2;
        LAS bf16_t* Xi = which ? Ql : Kl;
        bf16x8 af[4];
#pragma unroll
        for (int ks = 0; ks < 4; ++ks) af[ks] = *(const LAS bf16x8*)(Xi + (it * 16 + fr) * 136 + ks * 32 + fq * 8);
        const int i = it * 16 + fr; const float gci = gc[i], bti = bt[i];
#pragma unroll
        for (int jt = 0; jt < 4; ++jt) {
            f32x4 acc = (f32x4){0.f, 0.f, 0.f, 0.f};
#pragma unroll
            for (int ks = 0; ks < 4; ++ks) { const bf16x8 bf = *(const LAS bf16x8*)(Kl + (jt * 16 + fr) * 136 + ks * 32 + fq * 8); acc = __builtin_amdgcn_mfma_f32_16x16x32_bf16(bf, af[ks], acc, 0, 0, 0); }
            float v[4];
#pragma unroll
            for (int jj = 0; jj < 4; ++jj) { const int j = jt * 16 + fq * 4 + jj; const float dec = (i >= j) ? __expf(gci - gc[j]) : 0.f;
                v[jj] = which ? acc[jj] * dec : ((i > j) ? bti * acc[jj] * dec : 0.f); }
            if (which) { u32x2 o; o.x = cvt_pk_bf16(v[0], v[1]); o.y = cvt_pk_bf16(v[2], v[3]); *(u32x2*)(GA + (size_t)(t0 + i) * 256 + hh * 64 + jt * 16 + fq * 4) = o; }
            else *(LAS f32x4*)(Am + i * 64 + jt * 16 + fq * 4) = (f32x4){v[0], v[1], v[2], v[3]};
        }
    }
    __syncthreads();
    {
        LAS bf16_t* KDT = Ql;
#pragma unroll
        for (int e = 0; e < 16; ++e) KDT[(d0 + e) * 68 + t] = f2bf(qkv[1][e]);
    }
    if (tid < 256) {
        float x[64];
        int lz; asm volatile("v_mov_b32 %0, 0" : "=v"(lz));
        const LAS float* Amz = Am + lz;
#pragma unroll
        for (int i = 0; i < 64; ++i) x[i] = 0.f;
#pragma unroll
        for (int i = 0; i < 64; ++i) {
            float s = RHS[i * 260 + tid];
#pragma unroll
            for (int j4 = 0; j4 < (i + 3) / 4; ++j4) { const f32x4 a4 = *(const LAS f32x4*)(Amz + i * 64 + j4 * 4);
                s -= a4[0] * x[j4 * 4]; s -= a4[1] * x[j4 * 4 + 1]; s -= a4[2] * x[j4 * 4 + 2]; s -= a4[3] * x[j4 * 4 + 3]; }
            x[i] = s; RHS[i * 260 + tid] = s;
        }
    }
    __syncthreads();
    {
        const int seg = tid & 7;
        const LAS float* xr = RHS + t * 260 + seg * 32;
        bf16_t* dst = ((seg < 4) ? GU : GW) + (size_t)(t0 + t) * 512 + hh * 128 + (seg & 3) * 32;
#pragma unroll
        for (int q = 0; q < 4; ++q) { const f32x4 a = *(const LAS f32x4*)(xr + q * 8), b = *(const LAS f32x4*)(xr + q * 8 + 4);
            u32x4 w; w.x = cvt_pk_bf16(a[0], a[1]); w.y = cvt_pk_bf16(a[2], a[3]); w.z = cvt_pk_bf16(b[0], b[1]); w.w = cvt_pk_bf16(b[2], b[3]); *(u32x4*)(dst + q * 8) = w; }
        const LAS bf16_t* kr = Ql + (2 * t + (seg >> 2)) * 68 + (seg & 3) * 16;
        const u32x2 k0 = *(const LAS u32x2*)kr, k1 = *(const LAS u32x2*)(kr + 4), k2 = *(const LAS u32x2*)(kr + 8), k3 = *(const LAS u32x2*)(kr + 12);
        bf16_t* kdst = GK + (size_t)(t0 + t) * 512 + hh * 128 + seg * 16;
        *(u32x4*)kdst = (u32x4){k0.x, k0.y, k1.x, k1.y}; *(u32x4*)(kdst + 8) = (u32x4){k2.x, k2.y, k3.x, k3.y};
    }
    __syncthreads();
}

template <int OFF> __device__ __forceinline__ void dsr64(u32x2& d, unsigned addr) { asm volatile("ds_read_b64 %0, %1 offset:%2" : "=v"(d) : "v"(addr), "n"(OFF)); }
__device__ __forceinline__ void lgkm_wait8(u32x2& a, u32x2& b, u32x2& c, u32x2& d, u32x2& e, u32x2& f, u32x2& g, u32x2& h) {
    asm volatile("s_waitcnt lgkmcnt(0)" : "+v"(a), "+v"(b), "+v"(c), "+v"(d), "+v"(e), "+v"(f), "+v"(g), "+v"(h)); }
template <int RS  , int NK, int NM> struct FragSet { u32x2 lo[NK][NM], hi[NK][NM]; };
__device__ __forceinline__ void gdn_scan(LAS unsigned char* lds, const unsigned char* ws, float* oraw, const float* edec, int chain) {
    const int tid = ltid(), wid = __builtin_amdgcn_readfirstlane(tid >> 6), lane = tid & 63, fr = lane & 15, fq = lane >> 4;
    const int bl = chain >> 5, hh = (chain >> 3) & 3, es = chain & 7, e0 = es * 16;
    constexpr int BUF = 64512, O_W = 0, O_Q = 17408, O_KT = 34816, O_AT = 53248, O_U = 62464, O_PS = 2 * BUF, O_PV = 2 * BUF + 4096;
    const unsigned rb = (unsigned)(bl * 64) * 64u;
    const bool stager = (wid >= 2);
    unsigned soff[11];
#pragma unroll
    for (int i = 0; i < 11; ++i) {
        const int blk = (wid - 2) + 6 * i;
        const int q = blk * 64 + lane;
        unsigned o = 0u;
        if (stager && blk < 63) {
            if (q < 1088) { const int row = q / 17, pc = min(q % 17, 15); o = (unsigned)(WS_GDW + ((size_t)(rb + row) * 512 + hh * 128 + pc * 8) * 2); }
            else if (q < 2176) { const int q2 = q - 1088, row = q2 / 17, pc = min(q2 % 17, 15); o = (unsigned)(WS_GDQ + ((size_t)(rb + row) * 512 + hh * 128 + pc * 8) * 2); }
            else if (q < 3328) { const int q2 = q - 2176, d = q2 / 9, pc = min(q2 % 9, 7); o = (unsigned)(WS_GDK + ((size_t)(rb + (d >> 1)) * 512 + hh * 128 + (d & 1) * 64 + pc * 8) * 2); }
            else if (q < 3904) { const int q2 = q - 3328, row = q2 / 9, pc = min(q2 % 9, 7); o = (unsigned)(WS_GDA + ((size_t)(rb + row) * 256 + hh * 64 + pc * 8) * 2); }
            else { const int q2 = q - 3904, row = q2 >> 1, pc = q2 & 1; o = (unsigned)(WS_GDU + ((size_t)(rb + row) * 512 + hh * 128 + e0 + pc * 8) * 2); }
        }
        soff[i] = o;
    }
#define SCAN_DMA(chunk, bufsel) do { _Pragma("unroll") for (int i = 0; i < 11; ++i) { const int blk = (wid - 2) + 6 * i; if (blk < 63) { \
        const unsigned stp = (blk >= 52 && blk < 61) ? 32768u : 65536u; \
        __builtin_amdgcn_global_load_lds((const unsigned*)(ws + soff[i] + (unsigned)(chunk) * stp), (LAS unsigned*)(lds + (bufsel) * BUF + blk * 1024), 16, 0, 0); } } } while (0)
    if (stager) { SCAN_DMA(0, 0); asm volatile("s_waitcnt vmcnt(0)" ::: "memory"); }
    if (wid == 1) {
#pragma unroll
        for (int kt = 0; kt < 4; ++kt) *(LAS u32x4*)(lds + O_PS + kt * 1024 + lane * 16) = (u32x4){0u, 0u, 0u, 0u};
    }
    const float dv = edec[bl * 256 + lane * 4 + hh];
    f32x4 Sacc[8];
#pragma unroll
    for (int d = 0; d < 8; ++d) Sacc[d] = (f32x4){0.f, 0.f, 0.f, 0.f};
    __syncthreads();
    for (int n = 0; n < 64; ++n) {
        const LAS unsigned char* B = lds + (n & 1) * BUF;
        const int t0 = (bl * 64 + n) * 64;
        f32x4 OS[4];
        bf16x8 vb[2];
        if (stager) { if (n + 1 < 64) SCAN_DMA(n + 1, (n + 1) & 1); }
        else if (wid == 0) {
            f32x4 WS[4];
            bf16x8 sb[4];
#pragma unroll
            for (int kt = 0; kt < 4; ++kt) { u32x4 w; w.x = cvt_pk_bf16(Sacc[2 * kt][0], Sacc[2 * kt][1]); w.y = cvt_pk_bf16(Sacc[2 * kt][2], Sacc[2 * kt][3]);
                w.z = cvt_pk_bf16(Sacc[2 * kt + 1][0], Sacc[2 * kt + 1][1]); w.w = cvt_pk_bf16(Sacc[2 * kt + 1][2], Sacc[2 * kt + 1][3]); sb[kt] = __builtin_bit_cast(bf16x8, w); }
#pragma unroll
            for (int m = 0; m < 4; ++m) WS[m] = (f32x4){0.f, 0.f, 0.f, 0.f};
            {
                u32x2 wlo[4][4], whi[4][4];
                const unsigned bw = (unsigned)(unsigned long)(B + O_W + (fr * 136 + fq * 4) * 2);
                dsr64<0>(wlo[0][0], bw); dsr64<32>(whi[0][0], bw);
                dsr64<4352>(wlo[0][1], bw); dsr64<4384>(whi[0][1], bw);
                dsr64<8704>(wlo[0][2], bw); dsr64<8736>(whi[0][2], bw);
                dsr64<13056>(wlo[0][3], bw); dsr64<13088>(whi[0][3], bw);
                dsr64<64>(wlo[1][0], bw); dsr64<96>(whi[1][0], bw);
                dsr64<4416>(wlo[1][1], bw); dsr64<4448>(whi[1][1], bw);
                dsr64<8768>(wlo[1][2], bw); dsr64<8800>(whi[1][2], bw);
                dsr64<13120>(wlo[1][3], bw); dsr64<13152>(whi[1][3], bw);
                dsr64<128>(wlo[2][0], bw); dsr64<160>(whi[2][0], bw);
                dsr64<4480>(wlo[2][1], bw); dsr64<4512>(whi[2][1], bw);
                dsr64<8832>(wlo[2][2], bw); dsr64<8864>(whi[2][2], bw);
                dsr64<13184>(wlo[2][3], bw); dsr64<13216>(whi[2][3], bw);
                dsr64<192>(wlo[3][0], bw); dsr64<224>(whi[3][0], bw);
                dsr64<4544>(wlo[3][1], bw); dsr64<4576>(whi[3][1], bw);
                dsr64<8896>(wlo[3][2], bw); dsr64<8928>(whi[3][2], bw);
                dsr64<13248>(wlo[3][3], bw); dsr64<13280>(whi[3][3], bw);
                lgkm_wait8(wlo[0][0], wlo[0][1], wlo[0][2], wlo[0][3], wlo[1][0], wlo[1][1], wlo[1][2], wlo[1][3]);
                lgkm_wait8(wlo[2][0], wlo[2][1], wlo[2][2], wlo[2][3], wlo[3][0], wlo[3][1], wlo[3][2], wlo[3][3]);
                lgkm_wait8(whi[0][0], whi[0][1], whi[0][2], whi[0][3], whi[1][0], whi[1][1], whi[1][2], whi[1][3]);
                lgkm_wait8(whi[2][0], whi[2][1], whi[2][2], whi[2][3], whi[3][0], whi[3][1], whi[3][2], whi[3][3]);
#pragma unroll
                for (int kt = 0; kt < 4; ++kt)
#pragma unroll
                    for (int m = 0; m < 4; ++m) WS[m] = __builtin_amdgcn_mfma_f32_16x16x32_bf16(__builtin_bit_cast(bf16x8, (u32x4){wlo[kt][m].x, wlo[kt][m].y, whi[kt][m].x, whi[kt][m].y}), sb[kt], WS[m], 0, 0, 0);
            }
#pragma unroll
            for (int m = 0; m < 4; ++m)
#pragma unroll
                for (int jj = 0; jj < 4; ++jj) WS[m][jj] = bf2f(*(const LAS bf16_t*)(B + O_U + ((m * 16 + fq * 4 + jj) * 16 + fr) * 2)) - WS[m][jj];
#pragma unroll
            for (int kc = 0; kc < 2; ++kc) { u32x4 w; w.x = cvt_pk_bf16(WS[2 * kc][0], WS[2 * kc][1]); w.y = cvt_pk_bf16(WS[2 * kc][2], WS[2 * kc][3]);
                w.z = cvt_pk_bf16(WS[2 * kc + 1][0], WS[2 * kc + 1][1]); w.w = cvt_pk_bf16(WS[2 * kc + 1][2], WS[2 * kc + 1][3]); vb[kc] = __builtin_bit_cast(bf16x8, w);
                *(LAS u32x4*)(lds + O_PV + kc * 1024 + lane * 16) = w; }
        } else if (wid == 1) {
#pragma unroll
            for (int m = 0; m < 4; ++m) OS[m] = (f32x4){0.f, 0.f, 0.f, 0.f};
            {
                u32x2 qlo[4][4], qhi[4][4]; bf16x8 sbr[4];
#pragma unroll
                for (int kt = 0; kt < 4; ++kt) sbr[kt] = *(const LAS bf16x8*)(lds + O_PS + kt * 1024 + lane * 16);
                const unsigned bq = (unsigned)(unsigned long)(B + O_Q + (fr * 136 + fq * 4) * 2);
                dsr64<0>(qlo[0][0], bq); dsr64<32>(qhi[0][0], bq);
                dsr64<4352>(qlo[0][1], bq); dsr64<4384>(qhi[0][1], bq);
                dsr64<8704>(qlo[0][2], bq); dsr64<8736>(qhi[0][2], bq);
                dsr64<13056>(qlo[0][3], bq); dsr64<13088>(qhi[0][3], bq);
                dsr64<64>(qlo[1][0], bq); dsr64<96>(qhi[1][0], bq);
                dsr64<4416>(qlo[1][1], bq); dsr64<4448>(qhi[1][1], bq);
                dsr64<8768>(qlo[1][2], bq); dsr64<8800>(qhi[1][2], bq);
                dsr64<13120>(qlo[1][3], bq); dsr64<13152>(qhi[1][3], bq);
                dsr64<128>(qlo[2][0], bq); dsr64<160>(qhi[2][0], bq);
                dsr64<4480>(qlo[2][1], bq); dsr64<4512>(qhi[2][1], bq);
                dsr64<8832>(qlo[2][2], bq); dsr64<8864>(qhi[2][2], bq);
                dsr64<13184>(qlo[2][3], bq); dsr64<13216>(qhi[2][3], bq);
                dsr64<192>(qlo[3][0], bq); dsr64<224>(qhi[3][0], bq);
                dsr64<4544>(qlo[3][1], bq); dsr64<4576>(qhi[3][1], bq);
                dsr64<8896>(qlo[3][2], bq); dsr64<8928>(qhi[3][2], bq);
                dsr64<13248>(qlo[3][3], bq); dsr64<13280>(qhi[3][3], bq);
                lgkm_wait8(qlo[0][0], qlo[0][1], qlo[0][2], qlo[0][3], qlo[1][0], qlo[1][1], qlo[1][2], qlo[1][3]);
                lgkm_wait8(qlo[2][0], qlo[2][1], qlo[2][2], qlo[2][3], qlo[3][0], qlo[3][1], qlo[3][2], qlo[3][3]);
                lgkm_wait8(qhi[0][0], qhi[0][1], qhi[0][2], qhi[0][3], qhi[1][0], qhi[1][1], qhi[1][2], qhi[1][3]);
                lgkm_wait8(qhi[2][0], qhi[2][1], qhi[2][2], qhi[2][3], qhi[3][0], qhi[3][1], qhi[3][2], qhi[3][3]);
#pragma unroll
                for (int kt = 0; kt < 4; ++kt)
#pragma unroll
                    for (int m = 0; m < 4; ++m) OS[m] = __builtin_amdgcn_mfma_f32_16x16x32_bf16(__builtin_bit_cast(bf16x8, (u32x4){qlo[kt][m].x, qlo[kt][m].y, qhi[kt][m].x, qhi[kt][m].y}), sbr[kt], OS[m], 0, 0, 0);
            }
        }
        asm volatile("s_waitcnt lgkmcnt(0)" ::: "memory"); __builtin_amdgcn_s_barrier(); asm volatile("" ::: "memory");
        if (wid == 0) {
            const float dec = __shfl(dv, n);
#pragma unroll
            for (int d = 0; d < 8; ++d) Sacc[d] *= dec;
            {
                u32x2 klo[2][8], khi[2][8];
                const unsigned bk = (unsigned)(unsigned long)(B + O_KT + (fr * 72 + fq * 4) * 2);
                dsr64<0>(klo[0][0], bk); dsr64<32>(khi[0][0], bk);
                dsr64<2304>(klo[0][1], bk); dsr64<2336>(khi[0][1], bk);
                dsr64<4608>(klo[0][2], bk); dsr64<4640>(khi[0][2], bk);
                dsr64<6912>(klo[0][3], bk); dsr64<6944>(khi[0][3], bk);
                dsr64<9216>(klo[0][4], bk); dsr64<9248>(khi[0][4], bk);
                dsr64<11520>(klo[0][5], bk); dsr64<11552>(khi[0][5], bk);
                dsr64<13824>(klo[0][6], bk); dsr64<13856>(khi[0][6], bk);
                dsr64<16128>(klo[0][7], bk); dsr64<16160>(khi[0][7], bk);
                dsr64<64>(klo[1][0], bk); dsr64<96>(khi[1][0], bk);
                dsr64<2368>(klo[1][1], bk); dsr64<2400>(khi[1][1], bk);
                dsr64<4672>(klo[1][2], bk); dsr64<4704>(khi[1][2], bk);
                dsr64<6976>(klo[1][3], bk); dsr64<7008>(khi[1][3], bk);
                dsr64<9280>(klo[1][4], bk); dsr64<9312>(khi[1][4], bk);
                dsr64<11584>(klo[1][5], bk); dsr64<11616>(khi[1][5], bk);
                dsr64<13888>(klo[1][6], bk); dsr64<13920>(khi[1][6], bk);
                dsr64<16192>(klo[1][7], bk); dsr64<16224>(khi[1][7], bk);
                lgkm_wait8(klo[0][0], klo[0][1], klo[0][2], klo[0][3], klo[0][4], klo[0][5], klo[0][6], klo[0][7]);
                lgkm_wait8(klo[1][0], klo[1][1], klo[1][2], klo[1][3], klo[1][4], klo[1][5], klo[1][6], klo[1][7]);
                lgkm_wait8(khi[0][0], khi[0][1], khi[0][2], khi[0][3], khi[0][4], khi[0][5], khi[0][6], khi[0][7]);
                lgkm_wait8(khi[1][0], khi[1][1], khi[1][2], khi[1][3], khi[1][4], khi[1][5], khi[1][6], khi[1][7]);
#pragma unroll
                for (int kc = 0; kc < 2; ++kc)
#pragma unroll
                    for (int d = 0; d < 8; ++d) Sacc[d] = __builtin_amdgcn_mfma_f32_16x16x32_bf16(__builtin_bit_cast(bf16x8, (u32x4){klo[kc][d].x, klo[kc][d].y, khi[kc][d].x, khi[kc][d].y}), vb[kc], Sacc[d], 0, 0, 0);
            }
#pragma unroll
            for (int kt = 0; kt < 4; ++kt) { u32x4 w; w.x = cvt_pk_bf16(Sacc[2 * kt][0], Sacc[2 * kt][1]); w.y = cvt_pk_bf16(Sacc[2 * kt][2], Sacc[2 * kt][3]);
                w.z = cvt_pk_bf16(Sacc[2 * kt + 1][0], Sacc[2 * kt + 1][1]); w.w = cvt_pk_bf16(Sacc[2 * kt + 1][2], Sacc[2 * kt + 1][3]);
                *(LAS u32x4*)(lds + O_PS + kt * 1024 + lane * 16) = w; }
        } else if (wid == 1) {
            {
                u32x2 alo[2][4], ahi[2][4]; bf16x8 vbr[2];
#pragma unroll
                for (int kc = 0; kc < 2; ++kc) vbr[kc] = *(const LAS bf16x8*)(lds + O_PV + kc * 1024 + lane * 16);
                const unsigned ba = (unsigned)(unsigned long)(B + O_AT + (fr * 72 + fq * 4) * 2);
                dsr64<0>(alo[0][0], ba); dsr64<32>(ahi[0][0], ba);
                dsr64<2304>(alo[0][1], ba); dsr64<2336>(ahi[0][1], ba);
                dsr64<4608>(alo[0][2], ba); dsr64<4640>(ahi[0][2], ba);
                dsr64<6912>(alo[0][3], ba); dsr64<6944>(ahi[0][3], ba);
                dsr64<64>(alo[1][0], ba); dsr64<96>(ahi[1][0], ba);
                dsr64<2368>(alo[1][1], ba); dsr64<2400>(ahi[1][1], ba);
                dsr64<4672>(alo[1][2], ba); dsr64<4704>(ahi[1][2], ba);
                dsr64<6976>(alo[1][3], ba); dsr64<7008>(ahi[1][3], ba);
                lgkm_wait8(alo[0][0], alo[0][1], alo[0][2], alo[0][3], alo[1][0], alo[1][1], alo[1][2], alo[1][3]);
                lgkm_wait8(ahi[0][0], ahi[0][1], ahi[0][2], ahi[0][3], ahi[1][0], ahi[1][1], ahi[1][2], ahi[1][3]);
#pragma unroll
                for (int kc = 0; kc < 2; ++kc)
#pragma unroll
                    for (int m = 0; m < 4; ++m) OS[m] = __builtin_amdgcn_mfma_f32_16x16x32_bf16(__builtin_bit_cast(bf16x8, (u32x4){alo[kc][m].x, alo[kc][m].y, ahi[kc][m].x, ahi[kc][m].y}), vbr[kc], OS[m], 0, 0, 0);
            }
            float* op = oraw + (size_t)(t0 + fq * 4) * 512 + hh * 128 + e0 + fr;
#pragma unroll
            for (int m = 0; m < 4; ++m)
#pragma unroll
                for (int jj = 0; jj < 4; ++jj) op[(size_t)(m * 16 + jj) * 512] = OS[m][jj];
        } else if (stager) {
            asm volatile("s_waitcnt vmcnt(0)" ::: "memory");
        }
        __syncthreads();
    }
#undef SCAN_DMA
}
__device__ __forceinline__ void gdn_out(const Params& p, int l, const float* oraw, const bf16_t* proj, bf16_t* yc) {
    const int tid = ltid(), sub = tid & 15;
    const float* ng = p.in[zz() + 21] + l * 128 + sub * 8;
    const f32x4 g0 = *(const f32x4*)ng, g1 = *(const f32x4*)(ng + 4);
    for (int rowi = lbid() * 32 + (tid >> 4); rowi < TS * 4; rowi += lgdim() * 32) {
        const int t = rowi >> 2, hh = rowi & 3;
        const float* op = oraw + (size_t)t * 512 + hh * 128 + sub * 8;
        const f32x4 o0 = *(const f32x4*)op, o1 = *(const f32x4*)(op + 4);
        float ss = (o0[0] * o0[0] + o0[1] * o0[1]) + (o0[2] * o0[2] + o0[3] * o0[3]) + (o1[0] * o1[0] + o1[1] * o1[1]) + (o1[2] * o1[2] + o1[3] * o1[3]);
        ss += __shfl_xor(ss, 1); ss += __shfl_xor(ss, 2); ss += __shfl_xor(ss, 4); ss += __shfl_xor(ss, 8);
        const float rs = rsqrtf(ss * (1.0f / 128.0f) + EPS);
        const u32x4 z = *(const u32x4*)(proj + (size_t)t * PW + PC_CZ + hh * 128 + sub * 8);
        u32x4 w;
        w.x = cvt_pk_bf16(o0[0] * rs * g0[0] * siluf_(lo_bf(z.x)), o0[1] * rs * g0[1] * siluf_(hi_bf(z.x)));
        w.y = cvt_pk_bf16(o0[2] * rs * g0[2] * siluf_(lo_bf(z.y)), o0[3] * rs * g0[3] * siluf_(hi_bf(z.y)));
        w.z = cvt_pk_bf16(o1[0] * rs * g1[0] * siluf_(lo_bf(z.z)), o1[1] * rs * g1[1] * siluf_(hi_bf(z.z)));
        w.w = cvt_pk_bf16(o1[2] * rs * g1[2] * siluf_(lo_bf(z.w)), o1[3] * rs * g1[3] * siluf_(hi_bf(z.w)));
        *(u32x4*)(yc + (size_t)t * 512 + hh * 128 + sub * 8) = w;
    }
}

constexpr int PH_PER_LAYER = 22, N_PHASES = 2 * PH_PER_LAYER + 1;

__device__ __forceinline__ void run_phase(LAS unsigned char* lds, const Params& p, int ph) {
    unsigned char* ws = lptr(p.ws);
    bf16_t* hbuf = (bf16_t*)(ws + WS_H);
    bf16_t* act = (bf16_t*)(ws + WS_PROJ);
    bf16_t* proj = (bf16_t*)(ws + WS_PROJ);
    bf16_t* hslab = hbuf;
    bf16_t* merged = hbuf + (size_t)TS * D;
    float* oraw = (float*)(ws + WS_H);
    bf16_t* ys = (bf16_t*)(ws + WS_YS);
    float* AB = (float*)(ws + WS_AB);
    bf16_t* halo = (bf16_t*)(ws + WS_HALO);
    float* Aend = (float*)(ws + WS_AEND); float* Hend = (float*)(ws + WS_HEND); float* carry = (float*)(ws + WS_CARRY); float* edec = (float*)(ws + WS_EDEC);
    const bf16_t* waxt = (const bf16_t*)(ws + WS_WAXT); const bf16_t* pwt = (const bf16_t*)(ws + WS_PWT);
    const int G = lgdim(), c = lbid();
    if (ph == N_PHASES - 1) { PHON(0) rms_rows_f32_inplace(lptr(p.out), p.in[zz() + 30], T); return; }
    const int l = ph / PH_PER_LAYER, r = ph % PH_PER_LAYER;
    const float* xcur = (l == 0) ? p.in[zz() + 0] : lptr(p.out);
    if (r == 0) { PHON(1) convert_layer(lds, p, l); PHON(0) rms_rows_bf16(xcur, p.in[zz() + 1] + l * D, hbuf, T); return; }
    if (r == 1 || r == 20) { PHON(2) ph_gemm_swiglu(lds, hbuf, (const bf16_t*)(ws + (r == 1 ? WS_WGU1 : WS_WGU2)), act); return; }
    if (r == 2 || r == 21) { PHON(3) ph_gemm_resid(lds, act, (const bf16_t*)(ws + (r == 2 ? WS_WD1 : WS_WD2)), T, DFF, (r == 2) ? xcur : lptr(p.out), lptr(p.out), 0.5f); return; }
    if (r == 19) { rms_rows_bf16(lptr(p.out), p.in[zz() + 26] + l * D, hbuf, T); return; }
    const int slab = (r - 3) >> 3, q = (r - 3) & 7;
    float* xs = lptr(p.out) + (size_t)slab * TS * D;
    switch (q) {
    case 0: rms_rows_bf16(xs, p.in[zz() + 5] + l * D, hslab, TS); break;
    case 1: PHON(4) ph_gemm_proj(lds, hslab, (const bf16_t*)(ws + WS_WIN), proj, AB); break;
    case 2:
        PHON(7) for (int t = c; t < TS / 64; t += G) lru_tile(lds, p, l, proj, nullptr, waxt, Aend, Hend, carry, t, 0);
        if (G >= 256) { PHON(5) for (int t = c; t < (TS / 128) * 2; t += G) sgu_tile(lds, p, l, proj, ys, t); }
        break;
    case 3:
        PHON(8) for (int it = c; it < (TS / 64) * 4; it += G) gdn_prep(lds, p, l, proj, AB, (bf16_t*)(ws + WS_GDQ), (bf16_t*)(ws + WS_GDK), (bf16_t*)(ws + WS_GDU), (bf16_t*)(ws + WS_GDW), (bf16_t*)(ws + WS_GDA), edec, it);
        lru_carry(Aend, Hend, carry);
        break;
    case 4:
        PHON(9) if (c < 128 || G < 256) { for (int ch = c; ch < 128; ch += G) gdn_scan(lds, ws, oraw, edec, ch); }
        if (G >= 256 && c < 128) { PHON(6) for (int t = c; t < TS / 128; t += 128) pool_tile(lds, p, l, proj, ys + (size_t)3 * TS * 512, halo, pwt, t); }
        if (G >= 256) {
            if (c >= 128) {
                const int cc = c - 128, GG = G - 128;
                PHON(10) for (int t = cc; t < TS / 128; t += GG) lru_tile(lds, p, l, proj, ys + (size_t)TS * 512, waxt, Aend, Hend, carry, t, 1);
                PHON(5) for (int t = (TS / 128) * 2 + cc; t < (TS / 128) * 4; t += GG) sgu_tile(lds, p, l, proj, ys, t);
                PHON(6) for (int t = TS / 128 + cc; t < TS / 64; t += GG) pool_tile(lds, p, l, proj, ys + (size_t)3 * TS * 512, halo, pwt, t);
            }
        } else {
            for (int t = c; t < TS / 64; t += G) lru_tile(lds, p, l, proj, ys + (size_t)TS * 512, waxt, Aend, Hend, carry, t, 1);
            for (int t = c; t < (TS / 128) * 4; t += G) sgu_tile(lds, p, l, proj, ys, t);
            for (int t = c; t < TS / 64; t += G) pool_tile(lds, p, l, proj, ys + (size_t)3 * TS * 512, halo, pwt, t);
        }
        break;
    case 5: if (G >= 256) { for (int t = TS / 128 + c; t < TS / 64; t += G) lru_tile(lds, p, l, proj, ys + (size_t)TS * 512, waxt, Aend, Hend, carry, t, 1); }
        PHON(11) gdn_out(p, l, oraw, proj, ys + (size_t)2 * TS * 512); break;
    case 6: PHON(12) ph_gemm_branch(lds, ys, (const bf16_t*)(ws + WS_WB), proj, merged); break;
    default: PHON(13) ph_gemm_resid(lds, merged, (const bf16_t*)(ws + WS_WOUT), TS, D, xs, xs, 1.0f); break;
    }
}

extern __shared__ __attribute__((aligned(16))) unsigned char smem_dyn[];

#ifndef DUP_TYPE
#define DUP_TYPE -1
#endif
__device__ __forceinline__ int phase_type(int ph) {
    if (ph == N_PHASES - 1) return 12;
    const int r = ph % PH_PER_LAYER;
    if (r == 0) return 0; if (r == 1 || r == 20) return 1; if (r == 2 || r == 21) return 2; if (r == 19) return 11;
    const int q = (r - 3) & 7;
    return 3 + q;
}
__global__ void __launch_bounds__(NTHR) fwd_megakernel(Params p) {
    cg::grid_group grid = cg::this_grid();
    LAS unsigned char* lds = (LAS unsigned char*)smem_dyn;
    volatile LAS unsigned* st = (volatile LAS unsigned*)(lds + LDS_BYTES - 16);
    if (threadIdx.x == 0) { st[0] = 0u; st[1] = 0u; }
    __syncthreads();
    const XcdBarrier xb = xcd_barrier_post((unsigned*)(p.ws + WS_BAR), st);
    grid.sync();
    for (int ph = p.ph_lo; ph < p.ph_hi; ++ph) {
        if (ph > p.ph_lo) xcd_barrier(xb);
        run_phase(lds, p, ph);
#if DUP_TYPE == 6
        if (phase_type(ph) == 6) { xcd_barrier(xb); run_phase(lds, p, ph - 2); xcd_barrier(xb); run_phase(lds, p, ph - 1); xcd_barrier(xb); run_phase(lds, p, ph); }
#elif DUP_TYPE >= 0
        if (phase_type(ph) == DUP_TYPE) { xcd_barrier(xb); run_phase(lds, p, ph); }
#endif
    }
}

extern "C" void kernel_launch(void* const* d_in, const int* in_sizes, int n_in, void* d_out, int out_size, void* d_ws, size_t ws_size, hipStream_t stream) {
    static int grid_blocks = 0;
    if (grid_blocks == 0) {
        if (n_in != 31 || out_size != T * D || ws_size < WS_END) { fprintf(stderr, "kernel_launch: unexpected shapes (n_in %d out %d ws %zu need %zu)\n", n_in, out_size, ws_size, (size_t)WS_END); grid_blocks = -1; return; }
        int dev = 0, cus = 0, per_cu = 0;
        hipGetDevice(&dev);
        hipDeviceGetAttribute(&cus, hipDeviceAttributeMultiprocessorCount, dev);
        if (hipFuncSetAttribute((const void*)fwd_megakernel, hipFuncAttributeMaxDynamicSharedMemorySize, LDS_BYTES) != hipSuccess) { fprintf(stderr, "kernel_launch: hipFuncSetAttribute failed\n"); grid_blocks = -1; return; }
        hipOccupancyMaxActiveBlocksPerMultiprocessor(&per_cu, (const void*)fwd_megakernel, NTHR, LDS_BYTES);
        if (per_cu < 1) { fprintf(stderr, "kernel_launch: occupancy query returned %d\n", per_cu); per_cu = 1; }
        grid_blocks = cus * per_cu;
    }
    if (grid_blocks < 0) return;
    Params p{};
    for (int i = 0; i < 31; ++i) p.in[i] = (const float*)d_in[i];
    p.out = (float*)d_out; p.ws = (unsigned char*)d_ws;
    hipMemsetAsync((unsigned char*)d_ws + WS_BAR, 0, 16384, stream);
    p.ph_lo = 0; p.ph_hi = N_PHASES;
    void* args[] = {&p};
    hipError_t e = hipLaunchCooperativeKernel((const void*)fwd_megakernel, dim3(grid_blocks), dim3(NTHR), args, LDS_BYTES, stream);
    if (e != hipSuccess) fprintf(stderr, "cooperative launch failed: %s (grid %d)\n", hipGetErrorString(e), grid_blocks);
}
```

```cpp
#include <hip/hip_runtime.h>
#include <hip/hip_cooperative_groups.h>
#include <cstdio>
namespace cg = cooperative_groups;

#ifndef MULTI_LAUNCH
#define MULTI_LAUNCH 0
#endif

#ifndef PH_MASK
#define PH_MASK 0xFFFFF
#endif
#define PHON(k) if constexpr ((PH_MASK >> (k)) & 1)
#define LAS __attribute__((address_space(3)))
typedef unsigned short bf16_t;
typedef short bf16x8 __attribute__((ext_vector_type(8)));
typedef short bf16x4 __attribute__((ext_vector_type(4)));
typedef float f32x4 __attribute__((ext_vector_type(4)));
typedef unsigned u32x4 __attribute__((ext_vector_type(4)));
typedef unsigned u32x2 __attribute__((ext_vector_type(2)));

constexpr int T = 32768, D = 1024, DFF = 2816, NSLAB = 2, TS = T / NSLAB, SEQ = 4096, PW = 8960, PIN = 8712;
constexpr int PC_AU = 0, PC_AV = 512, PC_BX = 1024, PC_BG = 1536, PC_CQ = 2048, PC_CK = 2560, PC_CV = 3072, PC_CZ = 3584, PC_DX = 4096, PC_GATE = 4608, PC_AB = 8704;
constexpr float EPS = 1e-6f;
constexpr int NTHR = 512;
constexpr int LDS_BYTES = 147456;

constexpr size_t WS_WGU1 = 0;
constexpr size_t WS_WD1 = WS_WGU1 + (size_t)5632 * 1024 * 2;
constexpr size_t WS_WIN = WS_WD1 + (size_t)1024 * 2816 * 2;
constexpr size_t WS_WB = WS_WIN + (size_t)PW * 1024 * 2;
constexpr size_t WS_WOUT = WS_WB + (size_t)4 * 1024 * 512 * 2;
constexpr size_t WS_WGU2 = WS_WOUT + (size_t)1024 * 1024 * 2;
constexpr size_t WS_WD2 = WS_WGU2 + (size_t)5632 * 1024 * 2;
constexpr size_t WS_WAXT = WS_WD2 + (size_t)1024 * 2816 * 2;
constexpr size_t WS_PWT = WS_WAXT + 131072;
constexpr size_t WS_PROJ = WS_PWT + 131072;
constexpr size_t WS_H = WS_PROJ + (size_t)TS * PW * 2;
constexpr size_t WS_YS = WS_H + (size_t)T * D * 2;
constexpr size_t WS_AB = WS_YS + (size_t)4 * TS * 512 * 2;
constexpr size_t WS_HALO = WS_AB + (size_t)TS * 8 * 4;
constexpr size_t WS_AEND = WS_HALO + (size_t)(TS / 64) * 3 * 1536 * 2;
constexpr size_t WS_HEND = WS_AEND + (size_t)(TS / 64) * 512 * 4;
constexpr size_t WS_CARRY = WS_HEND + (size_t)(TS / 64) * 512 * 4;
constexpr size_t WS_EDEC = WS_CARRY + (size_t)(TS / 64) * 512 * 4;
constexpr size_t WS_BAR = WS_EDEC + 4096;
constexpr size_t WS_GDQ = WS_H + (size_t)TS * D * 2;
constexpr size_t WS_GDK = WS_GDQ + (size_t)TS * 512 * 2;
constexpr size_t WS_GDU = WS_BAR + 16384;
constexpr size_t WS_GDW = WS_GDU + (size_t)TS * 512 * 2;
constexpr size_t WS_GDA = WS_GDW + (size_t)TS * 512 * 2;
constexpr size_t WS_END = WS_GDA + (size_t)TS * 256 * 2;
static_assert(WS_END <= (size_t)512 * 1024 * 1024, "workspace budget");

struct Params { const float* in[31]; float* out; unsigned char* ws; int ph_lo, ph_hi; };

__device__ __forceinline__ int ltid() { int t = threadIdx.x; asm volatile("" : "+v"(t)); return t; }
__device__ __forceinline__ int lbid() { int t = blockIdx.x; asm volatile("" : "+s"(t)); return t; }
__device__ __forceinline__ int lgdim() { int t = gridDim.x; asm volatile("" : "+s"(t)); return t; }
__device__ __forceinline__ int zz() { int z; asm volatile("s_mov_b32 %0, 0" : "=s"(z)); return z; }
template <class P> __device__ __forceinline__ P* lptr(P* q) { asm volatile("" : "+s"(q)); return q; }
__device__ __forceinline__ float bf2f(unsigned short b) { return __uint_as_float(((unsigned)b) << 16); }
__device__ __forceinline__ unsigned cvt_pk_bf16(float lo, float hi) { unsigned r; asm("v_cvt_pk_bf16_f32 %0, %1, %2" : "=v"(r) : "v"(lo), "v"(hi)); return r; }
__device__ __forceinline__ unsigned short f2bf(float f) { return (unsigned short)(cvt_pk_bf16(f, 0.f) & 0xffffu); }
__device__ __forceinline__ float lo_bf(unsigned w) { return __uint_as_float(w << 16); }
__device__ __forceinline__ float hi_bf(unsigned w) { return __uint_as_float(w & 0xffff0000u); }
__device__ __forceinline__ float sigmoidf_(float x) { return __builtin_amdgcn_rcpf(1.0f + __expf(-x)); }
__device__ __forceinline__ float siluf_(float x) { return x * __builtin_amdgcn_rcpf(1.0f + __expf(-x)); }
__device__ __forceinline__ float geluf_(float x) { const float u = 1.5957691216057308f * (x + 0.044715f * x * x * x); return x * __builtin_amdgcn_rcpf(1.0f + __expf(-u)); }
__device__ __forceinline__ float softplusf_(float x) { return fmaxf(x, 0.f) + log1pf(__expf(-fabsf(x))); }
__device__ __forceinline__ float wave_sum(float v) {
#pragma unroll
    for (int o = 1; o < 64; o <<= 1) v += __shfl_xor(v, o);
    return v;
}


#define XB_TMO      128
#define XB_XCNT(j)  (256  + 64 * (j))
#define XB_XSUB(j)  (1280 + 64 * (j))
#define XB_XGEN(j)  (2304 + 64 * (j))
#define XB_TOP      3328
#define XB_TOPGEN   3392
#define XCD_BAR_WORDS 3456
#define XB_SPIN_CAP (1u << 22)
__device__ __forceinline__ unsigned xb_ld(unsigned* p)              { return __hip_atomic_load(p, __ATOMIC_RELAXED, __HIP_MEMORY_SCOPE_AGENT); }
__device__ __forceinline__ unsigned xb_add(unsigned* p, unsigned v) { return __hip_atomic_fetch_add(p, v, __ATOMIC_RELAXED, __HIP_MEMORY_SCOPE_AGENT); }
__device__ __forceinline__ unsigned xb_xcc_id() { return (unsigned)__builtin_amdgcn_s_getreg((3 << 11) | 20) & 0xFu; }
#define XB_SPIN(cond, bar) do { unsigned _sp = 0; while (cond) { __builtin_amdgcn_s_sleep(1); \
    if ((++_sp & 255u) == 0u) { if (xb_ld(&(bar)[XB_TMO])) break; if (_sp > XB_SPIN_CAP) { atomicAdd(&(bar)[XB_TMO], 1u); break; } } } } while (0)
struct XcdBarrier { unsigned* bar; unsigned x; volatile LAS unsigned* st; };
__device__ __forceinline__ XcdBarrier xcd_barrier_post(unsigned* bar, volatile LAS unsigned* st) {
    XcdBarrier b; b.bar = bar; b.x = xb_xcc_id(); b.st = st;
    if (threadIdx.x == 0) (void)xb_add(&bar[XB_XCNT(b.x)], 1u);
    return b;
}
__device__ __forceinline__ void xcd_barrier_complete(unsigned* bar, unsigned x, unsigned& nloc, unsigned& nx) {
    const unsigned G = gridDim.x * gridDim.y * gridDim.z;
    unsigned sum, cnt, mine, sp = 0u;
    for (;;) {
        sum = 0u; cnt = 0u; mine = 0u;
#pragma unroll
        for (unsigned j = 0; j < 16; ++j) { const unsigned c = xb_ld(&bar[XB_XCNT(j)]); sum += c; cnt += (c > 0u) ? 1u : 0u; mine = (j == x) ? c : mine; }
        if (sum == G) break;
        __builtin_amdgcn_s_sleep(1);
        if ((++sp & 255u) == 0u) { if (xb_ld(&bar[XB_TMO])) break; if (sp > XB_SPIN_CAP) { atomicAdd(&bar[XB_TMO], 1u); break; } }
    }
    nloc = mine > 0u ? mine : 1u; nx = cnt > 0u ? cnt : 1u;
}
__device__ __forceinline__ void xcd_barrier(const XcdBarrier& b) {
    asm volatile("s_waitcnt vmcnt(0)" ::: "memory");
    __syncthreads();
    if (threadIdx.x == 0) {
        unsigned* bar = b.bar;
        __builtin_amdgcn_s_waitcnt(0);
        unsigned nloc = b.st[0], nx = b.st[1];
        if (nloc == 0u) { xcd_barrier_complete(bar, b.x, nloc, nx); b.st[0] = nloc; b.st[1] = nx; }
        const unsigned old = xb_add(&bar[XB_XSUB(b.x)], 1u);
        const unsigned gen = old / nloc;
        if (old + 1u == (gen + 1u) * nloc) {
            __builtin_amdgcn_fence(__ATOMIC_RELEASE, "agent");
            asm volatile("s_waitcnt vmcnt(0)" ::: "memory");
            const unsigned og = xb_add(&bar[XB_TOP], 1u);
            const unsigned tg = og / nx;
            if (og + 1u == (tg + 1u) * nx) xb_add(&bar[XB_TOPGEN], 1u);
            else XB_SPIN(xb_ld(&bar[XB_TOPGEN]) == tg, bar);
            __builtin_amdgcn_fence(__ATOMIC_ACQUIRE, "agent");
            xb_add(&bar[XB_XGEN(b.x)], 1u);
            asm volatile("s_waitcnt vmcnt(0)" ::: "memory");
        } else {
            XB_SPIN(xb_ld(&bar[XB_XGEN(b.x)]) == gen, bar);
            __builtin_amdgcn_fence(__ATOMIC_ACQUIRE, "agent");
            asm volatile("s_waitcnt vmcnt(0)" ::: "memory");
        }
    }
    __syncthreads();
}

namespace pg8 {
constexpr int BM = 256, BK = 64, HALF = 128, HTB = HALF * BK * 2, STAGE_BYTES = 8 * HTB, NXCD = 8, WGM = 8;
__host__ __device__ __forceinline__ int lds_byte(int r, int c) { const int st = (r >> 4) * 2 + (c >> 5), rr = r & 15, cc = c & 31, ob = rr * 64 + cc * 2; return st * 1024 + (ob ^ (((ob >> 9) & 1) << 5)); }
__host__ __device__ __forceinline__ void stage_rc(int b, int& R, int& C) { const int st = b / 1024, sb = b % 1024, swz = sb ^ (((sb >> 9) & 1) << 5); R = (st >> 1) * 16 + swz / 64; C = (st & 1) * 32 + (swz % 64) / 2; }
__host__ __device__ __forceinline__ int perm32(int rho) { const int n = rho >> 4, i = rho & 15; return 8 * (i >> 2) + 4 * n + (i & 3); }

struct Unit { int pm, pn, g; };
struct Gemm { const bf16_t* A; const bf16_t* Bt; int M, N, K; size_t gsA, gsB; };

__device__ __forceinline__ void tile_of(int wgid, int nM, int nN, int nwg, Unit& u) {
    { const int q = nwg / NXCD, r = nwg % NXCD, xcd = wgid % NXCD, off = wgid / NXCD; wgid = (xcd < r ? xcd * (q + 1) : r * (q + 1) + (xcd - r) * q) + off; }
    const int nig = WGM * nN, gid = wgid / nig, fm = gid * WGM, gsz = (nM - fm) < WGM ? (nM - fm) : WGM;
    u.pm = fm + ((wgid % nig) % gsz); u.pn = (wgid % nig) / gsz;
}
struct StaticOrder {
    int nM, nN, nwg, G, c;
    __device__ void init(int M, int N, int G_, int c_) { nM = M / BM; nN = N / BM; nwg = nM * nN; G = G_; c = c_; }
    __device__ bool next(int i, Unit& u) const {
        const long L = (long)i * G + c; if (L >= nwg) return false;
        tile_of((int)L, nM, nN, nwg, u); u.g = 0; return true;
    }
};
struct BranchOrder {
    int nM, nN, nwg, G, c;
    __device__ void init(int M, int N, int G_, int c_) { nM = M / BM; nN = N / BM; nwg = nM * nN; G = G_; c = c_; }
    __device__ bool next(int i, Unit& u) const {
        const long L = (long)(i >> 2) * G + c; if (L >= nwg) return false;
        tile_of((int)L, nM, nN, nwg, u); u.g = i & 3; return true;
    }
};

struct EpiSwiGLU {
    static constexpr bool PERM = true;
    bf16_t* O;
    __device__ __forceinline__ bool keep(const Unit&) const { return false; }
    __device__ __forceinline__ void operator()(f32x4 (&acc)[2][2][4][2], const Unit& u, int wr, int wc, int fr, int fq) const {
        const int row0 = u.pm * BM + wr * 64 + fr, col0 = u.pn * 128 + wc * 32 + 8 * fq;
#pragma unroll
        for (int ai = 0; ai < 2; ++ai)
#pragma unroll
            for (int m = 0; m < 4; ++m) {
                bf16_t* rowp = O + (size_t)(row0 + ai * HALF + m * 16) * DFF + col0;
                float v[8];
#pragma unroll
                for (int n = 0; n < 2; ++n)
#pragma unroll
                    for (int j = 0; j < 4; ++j) v[n * 4 + j] = siluf_(acc[ai][0][m][n][j]) * acc[ai][1][m][n][j];
                u32x4 w; w.x = cvt_pk_bf16(v[0], v[1]); w.y = cvt_pk_bf16(v[2], v[3]); w.z = cvt_pk_bf16(v[4], v[5]); w.w = cvt_pk_bf16(v[6], v[7]);
                *(u32x4*)rowp = w;
                __builtin_amdgcn_sched_barrier(0);
            }
    }
};
struct EpiResid {
    static constexpr bool PERM = false;
    const float* Xin; float* Xout; float scale;
    __device__ __forceinline__ bool keep(const Unit&) const { return false; }
    __device__ __forceinline__ void operator()(f32x4 (&acc)[2][2][4][2], const Unit& u, int wr, int wc, int fr, int fq) const {
        const int row0 = u.pm * BM + wr * 64 + fr, col0 = u.pn * BM + wc * 32 + 4 * fq;
#pragma unroll
        for (int ai = 0; ai < 2; ++ai) {
            f32x4 xi[4][2][2];
#pragma unroll
            for (int m = 0; m < 4; ++m) { const size_t ro = (size_t)(row0 + ai * HALF + m * 16) * D + col0;
#pragma unroll
                for (int bj = 0; bj < 2; ++bj)
#pragma unroll
                    for (int n = 0; n < 2; ++n) xi[m][bj][n] = *(const f32x4*)(Xin + ro + bj * HALF + n * 16); }
#pragma unroll
            for (int m = 0; m < 4; ++m) { const size_t ro = (size_t)(row0 + ai * HALF + m * 16) * D + col0;
#pragma unroll
                for (int bj = 0; bj < 2; ++bj)
#pragma unroll
                    for (int n = 0; n < 2; ++n) *(f32x4*)(Xout + ro + bj * HALF + n * 16) = xi[m][bj][n] + acc[ai][bj][m][n] * scale; }
            __builtin_amdgcn_sched_barrier(0);
        }
    }
};
struct EpiProj {
    static constexpr bool PERM = true;
    bf16_t* O; float* AB;
    __device__ __forceinline__ bool keep(const Unit&) const { return false; }
    __device__ __forceinline__ void operator()(f32x4 (&acc)[2][2][4][2], const Unit& u, int wr, int wc, int fr, int fq) const {
        const int row0 = u.pm * BM + wr * 64 + fr, col0 = u.pn * BM + wc * 32 + 8 * fq;
        const bool ab = (u.pn == PC_AB / BM) && wc == 0 && fq == 0;
#pragma unroll
        for (int ai = 0; ai < 2; ++ai)
#pragma unroll
            for (int m = 0; m < 4; ++m) {
                const int row = row0 + ai * HALF + m * 16;
                bf16_t* rowp = O + (size_t)row * PW + col0;
#pragma unroll
                for (int bj = 0; bj < 2; ++bj) {
                    const f32x4 v0 = acc[ai][bj][m][0], v1 = acc[ai][bj][m][1];
                    u32x4 w; w.x = cvt_pk_bf16(v0[0], v0[1]); w.y = cvt_pk_bf16(v0[2], v0[3]); w.z = cvt_pk_bf16(v1[0], v1[1]); w.w = cvt_pk_bf16(v1[2], v1[3]);
                    *(u32x4*)(rowp + bj * HALF) = w;
                }
                __builtin_amdgcn_sched_barrier(0);
            }
        if (ab) {
#pragma unroll
            for (int ai = 0; ai < 2; ++ai)
#pragma unroll
                for (int m = 0; m < 4; ++m) { const int row = row0 + ai * HALF + m * 16; *(f32x4*)(AB + (size_t)row * 8) = acc[ai][0][m][0]; *(f32x4*)(AB + (size_t)row * 8 + 4) = acc[ai][0][m][1]; }
        }
    }
};
struct EpiBranch {
    static constexpr bool PERM = true;
    const bf16_t* P; bf16_t* O;
    __device__ __forceinline__ bool keep(const Unit& u) const { return u.g < 3; }
    __device__ __forceinline__ void operator()(f32x4 (&acc)[2][2][4][2], const Unit& u, int wr, int wc, int fr, int fq) const {
        const int row0 = u.pm * BM + wr * 64 + fr, col0 = u.pn * BM + wc * 32 + 8 * fq;
        const bool last = (u.g == 3);
#pragma unroll
        for (int ai = 0; ai < 2; ++ai) {
            u32x4 g0[4][2], g1[4][2];
#pragma unroll
            for (int m = 0; m < 4; ++m) { const bf16_t* gp = P + (size_t)(row0 + ai * HALF + m * 16) * PW + PC_GATE + u.g * D + col0;
#pragma unroll
                for (int bj = 0; bj < 2; ++bj) { g0[m][bj] = *(const u32x4*)(gp + bj * HALF); g1[m][bj] = last ? g0[m][bj] : *(const u32x4*)(gp + D + bj * HALF); } }
#pragma unroll
            for (int m = 0; m < 4; ++m) {
                const int row = row0 + ai * HALF + m * 16;
#pragma unroll
                for (int bj = 0; bj < 2; ++bj) {
                    float f[8];
                    if (!last) {
#pragma unroll
                        for (int q = 0; q < 4; ++q) {
                            f[2 * q] = (1.0f + __expf(-lo_bf(g1[m][bj][q]))) * __builtin_amdgcn_rcpf(1.0f + __expf(-lo_bf(g0[m][bj][q])));
                            f[2 * q + 1] = (1.0f + __expf(-hi_bf(g1[m][bj][q]))) * __builtin_amdgcn_rcpf(1.0f + __expf(-hi_bf(g0[m][bj][q])));
                        }
                    } else {
#pragma unroll
                        for (int q = 0; q < 4; ++q) { f[2 * q] = __builtin_amdgcn_rcpf(1.0f + __expf(-lo_bf(g0[m][bj][q]))); f[2 * q + 1] = __builtin_amdgcn_rcpf(1.0f + __expf(-hi_bf(g0[m][bj][q]))); }
                    }
#pragma unroll
                    for (int n = 0; n < 2; ++n)
#pragma unroll
                        for (int j = 0; j < 4; ++j) acc[ai][bj][m][n][j] *= f[n * 4 + j];
                    if (last) {
                        const f32x4 v0 = acc[ai][bj][m][0], v1 = acc[ai][bj][m][1];
                        u32x4 w; w.x = cvt_pk_bf16(v0[0], v0[1]); w.y = cvt_pk_bf16(v0[2], v0[3]); w.z = cvt_pk_bf16(v1[0], v1[1]); w.w = cvt_pk_bf16(v1[2], v1[3]);
                        *(u32x4*)(O + (size_t)row * D + col0 + bj * HALF) = w;
                    }
                }
            }
            __builtin_amdgcn_sched_barrier(0);
        }
    }
};

template <class Epi, class Sched>
__device__ __forceinline__ void gemm_phase(LAS unsigned char* lds, const Gemm g, const Sched& S, const Epi& E) {
    const int tid = ltid(), wid = __builtin_amdgcn_readfirstlane(tid >> 6), lane = tid & 63, wr = wid >> 2, wc = wid & 3, fr = lane & 15, fq = lane >> 4;
    const int K = g.K, nt = K / BK;
    unsigned voffA[2], voffB[2];
#pragma unroll
    for (int i = 0; i < 2; ++i) { int R, C; stage_rc(tid * 16 + i * 8192, R, C); const int Rb = Epi::PERM ? ((R & ~31) + perm32(R & 31)) : R;
        voffA[i] = (unsigned)(R * K + C) * 2u; voffB[i] = (unsigned)(Rb * K + C) * 2u; }
    const size_t kstep = (size_t)(BK * 2);
    const size_t hstep = (size_t)HALF * K * 2;
    const size_t tstep = 2 * hstep;
    const unsigned ldsw = (unsigned)wid * 1024u;
    const int aoff = lds_byte(wr * 64 + fr, fq * 8), boff = lds_byte(wc * 32 + fr, fq * 8);
#define PG8_SA(b, h) (((b) * 2 + (h)) * HTB)
#define PG8_SB(b, h) ((4 + (b) * 2 + (h)) * HTB)
#define PG8_STAGE(bufoff, gbase, voff) do { _Pragma("unroll") for (int _i = 0; _i < 2; ++_i) \
        __builtin_amdgcn_global_load_lds((const unsigned*)((const char*)(gbase) + (voff)[_i]), (LAS unsigned*)(lds + (bufoff) + ldsw + _i * 8192), 16, 0, 0); } while (0)
#define PG8_LDA(dst, b, h) do { _Pragma("unroll") for (int m = 0; m < 4; ++m) _Pragma("unroll") for (int k = 0; k < 2; ++k) dst[m][k] = *(const LAS bf16x8*)(lds + PG8_SA(b, h) + aoff + m * 2048 + k * 1024); } while (0)
#define PG8_LDB(dst, b, h) do { _Pragma("unroll") for (int n = 0; n < 2; ++n) _Pragma("unroll") for (int k = 0; k < 2; ++k) dst[n][k] = *(const LAS bf16x8*)(lds + PG8_SB(b, h) + boff + n * 2048 + k * 1024); } while (0)
#define PG8_MMA(ai, bj, At, Bt) do { __builtin_amdgcn_s_setprio(1); _Pragma("unroll") for (int m = 0; m < 4; ++m) _Pragma("unroll") for (int n = 0; n < 2; ++n) _Pragma("unroll") for (int k = 0; k < 2; ++k) \
        acc[ai][bj][m][n] = __builtin_amdgcn_mfma_f32_16x16x32_bf16(Bt[n][k], At[m][k], acc[ai][bj][m][n], 0, 0, 0); __builtin_amdgcn_s_setprio(0); } while (0)
#define PG8_WAIT_V(n) asm volatile("s_waitcnt vmcnt(" #n ")" ::: "memory")
#define PG8_WAIT_L(n) asm volatile("s_waitcnt lgkmcnt(" #n ")" ::: "memory")
#define PG8_BAR __builtin_amdgcn_s_barrier()
#define PG8_SCHED __builtin_amdgcn_sched_barrier(0)
    Unit cur, nxt; int ui = 0;
    if (!S.next(0, cur)) return;
    f32x4 acc[2][2][4][2];
#pragma unroll
    for (int a = 0; a < 2; ++a)
#pragma unroll
        for (int b = 0; b < 2; ++b)
#pragma unroll
            for (int m = 0; m < 4; ++m)
#pragma unroll
                for (int n = 0; n < 2; ++n) acc[a][b][m][n] = (f32x4){0.f, 0.f, 0.f, 0.f};
    bf16x8 At[4][2], B0[2][2], B1[2][2];
    const char* cA = (const char*)g.A + (size_t)cur.g * g.gsA + (size_t)cur.pm * tstep; const char* cB = (const char*)g.Bt + (size_t)cur.g * g.gsB + (size_t)cur.pn * tstep;
    PG8_STAGE(PG8_SB(0, 0), cB, voffB); PG8_STAGE(PG8_SA(0, 0), cA, voffA); PG8_STAGE(PG8_SB(0, 1), cB + hstep, voffB); PG8_STAGE(PG8_SA(0, 1), cA + hstep, voffA);
    if (wr == 1) PG8_BAR;
    PG8_WAIT_V(4); PG8_BAR;
    PG8_STAGE(PG8_SB(1, 0), cB + kstep, voffB); PG8_STAGE(PG8_SA(1, 0), cA + kstep, voffA); PG8_STAGE(PG8_SB(1, 1), cB + hstep + kstep, voffB);
    PG8_WAIT_V(6); PG8_BAR;
    for (;;) {
        const bool has_next = S.next(ui + 1, nxt);
        const char* nA = has_next ? (const char*)g.A + (size_t)nxt.g * g.gsA + (size_t)nxt.pm * tstep : cA; const char* nB = has_next ? (const char*)g.Bt + (size_t)nxt.g * g.gsB + (size_t)nxt.pn * tstep : cB;
        for (int t = 0; t < nt; t += 2) {
            const bool last = (t == nt - 2);
            const char* a1 = cA + (size_t)(t + 1) * kstep;
            const char* a2 = last ? nA : cA + (size_t)(t + 2) * kstep; const char* b2 = last ? nB : cB + (size_t)(t + 2) * kstep;
            const char* a3 = a2 + kstep; const char* b3 = b2 + kstep;
            PG8_LDB(B0, 0, 0); PG8_SCHED; PG8_LDA(At, 0, 0); PG8_STAGE(PG8_SA(1, 1), a1 + hstep, voffA);
            PG8_WAIT_L(8); PG8_BAR; PG8_WAIT_L(0); PG8_MMA(0, 0, At, B0); PG8_BAR; PG8_SCHED;
            PG8_LDB(B1, 0, 1); PG8_STAGE(PG8_SB(0, 0), b2, voffB);
            PG8_BAR; PG8_WAIT_L(0); PG8_MMA(0, 1, At, B1); PG8_BAR;
            PG8_LDA(At, 0, 1); PG8_STAGE(PG8_SA(0, 0), a2, voffA);
            PG8_BAR; PG8_WAIT_L(0); PG8_MMA(1, 0, At, B0); PG8_BAR; PG8_SCHED;
            PG8_STAGE(PG8_SB(0, 1), b2 + hstep, voffB);
            PG8_WAIT_V(6); PG8_BAR; PG8_MMA(1, 1, At, B1); PG8_BAR;
            PG8_LDB(B0, 1, 0); PG8_SCHED; PG8_LDA(At, 1, 0); PG8_STAGE(PG8_SA(0, 1), a2 + hstep, voffA);
            PG8_WAIT_L(8); PG8_BAR; PG8_WAIT_L(0); PG8_MMA(0, 0, At, B0); PG8_BAR; PG8_SCHED;
            PG8_LDB(B1, 1, 1); PG8_STAGE(PG8_SB(1, 0), b3, voffB);
            PG8_BAR; PG8_WAIT_L(0); PG8_MMA(0, 1, At, B1); PG8_BAR;
            PG8_LDA(At, 1, 1); PG8_STAGE(PG8_SA(1, 0), a3, voffA);
            PG8_BAR; PG8_WAIT_L(0); PG8_MMA(1, 0, At, B0); PG8_BAR; PG8_SCHED;
            PG8_STAGE(PG8_SB(1, 1), b3 + hstep, voffB);
            PG8_WAIT_V(6); PG8_BAR; PG8_MMA(1, 1, At, B1); PG8_BAR;
        }
        E(acc, cur, wr, wc, fr, fq);
        if (!has_next) break;
        if (!E.keep(cur)) {
#pragma unroll
            for (int a = 0; a < 2; ++a)
#pragma unroll
                for (int b = 0; b < 2; ++b)
#pragma unroll
                    for (int m = 0; m < 4; ++m)
#pragma unroll
                        for (int n = 0; n < 2; ++n) acc[a][b][m][n] = (f32x4){0.f, 0.f, 0.f, 0.f};
        }
        cur = nxt; cA = nA; cB = nB; ++ui;
    }
    PG8_WAIT_V(0);
    if (wr == 0) PG8_BAR;
    PG8_BAR;
#undef PG8_SA
#undef PG8_SB
#undef PG8_STAGE
#undef PG8_LDA
#undef PG8_LDB
#undef PG8_MMA
#undef PG8_WAIT_V
#undef PG8_WAIT_L
#undef PG8_BAR
#undef PG8_SCHED
}
}


#define NOINL __forceinline__
__device__ NOINL void ph_gemm_swiglu(LAS unsigned char* lds, const bf16_t* A, const bf16_t* Bt, bf16_t* O) {
    pg8::Gemm g{A, Bt, T, 2 * DFF, D, 0, 0}; pg8::StaticOrder S; S.init(g.M, g.N, lgdim(), lbid()); pg8::EpiSwiGLU E{O}; pg8::gemm_phase(lds, g, S, E);
}
__device__ NOINL void ph_gemm_resid(LAS unsigned char* lds, const bf16_t* A, const bf16_t* Bt, int M, int K, const float* Xin, float* Xout, float scale) {
    pg8::Gemm g{A, Bt, M, D, K, 0, 0}; pg8::StaticOrder S; S.init(g.M, g.N, lgdim(), lbid()); pg8::EpiResid E{Xin, Xout, scale}; pg8::gemm_phase(lds, g, S, E);
}
__device__ NOINL void ph_gemm_proj(LAS unsigned char* lds, const bf16_t* A, const bf16_t* Bt, bf16_t* O, float* AB) {
    pg8::Gemm g{A, Bt, TS, PW, D, 0, 0}; pg8::StaticOrder S; S.init(g.M, g.N, lgdim(), lbid()); pg8::EpiProj E{O, AB}; pg8::gemm_phase(lds, g, S, E);
}
__device__ NOINL void ph_gemm_branch(LAS unsigned char* lds, const bf16_t* A, const bf16_t* Bt, const bf16_t* P, bf16_t* O) {
    pg8::Gemm g{A, Bt, TS, D, 512, (size_t)TS * 512 * 2, (size_t)D * 512 * 2}; pg8::BranchOrder S; S.init(g.M, g.N, lgdim(), lbid()); pg8::EpiBranch E{P, O}; pg8::gemm_phase(lds, g, S, E);
}

struct ConvTask { const float* src0; const float* src1; bf16_t* dst; int K, Nsrc, mode, tile; };
__device__ __forceinline__ ConvTask conv_task(const Params& p, int l, int it) {
    unsigned char* ws = lptr(p.ws);
    constexpr int N1 = 16 * 88, N2 = 44 * 16, N3 = 16 * 140, N4 = 8 * 16, N5 = 16 * 16;
    ConvTask t; t.src1 = nullptr;
    int r = it;
    if (r < N1) { t.src0 = p.in[zz() + 2] + (size_t)l * D * DFF; t.src1 = p.in[zz() + 3] + (size_t)l * D * DFF; t.K = D; t.Nsrc = DFF; t.dst = (bf16_t*)(ws + WS_WGU1); t.mode = 1; t.tile = r; return t; } r -= N1;
    if (r < N2) { t.src0 = p.in[zz() + 4] + (size_t)l * DFF * D; t.K = DFF; t.Nsrc = D; t.dst = (bf16_t*)(ws + WS_WD1); t.mode = 0; t.tile = r; return t; } r -= N2;
    if (r < N3) { t.src0 = p.in[zz() + 6] + (size_t)l * D * PIN; t.K = D; t.Nsrc = PIN; t.dst = (bf16_t*)(ws + WS_WIN); t.mode = 2; t.tile = r; return t; } r -= N3;
    if (r < 4 * N4) { const int g = r / N4; t.src0 = p.in[zz() + 24] + ((size_t)l * 4 + g) * 512 * D; t.K = 512; t.Nsrc = D; t.dst = (bf16_t*)(ws + WS_WB) + (size_t)g * D * 512; t.mode = 0; t.tile = r % N4; return t; } r -= 4 * N4;
    if (r < N5) { t.src0 = p.in[zz() + 25] + (size_t)l * D * D; t.K = D; t.Nsrc = D; t.dst = (bf16_t*)(ws + WS_WOUT); t.mode = 0; t.tile = r; return t; } r -= N5;
    if (r < N1) { t.src0 = p.in[zz() + 27] + (size_t)l * D * DFF; t.src1 = p.in[zz() + 28] + (size_t)l * D * DFF; t.K = D; t.Nsrc = DFF; t.dst = (bf16_t*)(ws + WS_WGU2); t.mode = 1; t.tile = r; return t; } r -= N1;
    t.src0 = p.in[zz() + 29] + (size_t)l * DFF * D; t.K = DFF; t.Nsrc = D; t.dst = (bf16_t*)(ws + WS_WD2); t.mode = 0; t.tile = r; return t;
}
__device__ __forceinline__ void conv_load(const ConvTask& t, int tid, f32x4& a, f32x4& b) {
    const int nkt = t.K / 64, kt = t.tile % nkt, rt = t.tile / nkt, k0 = kt * 64, r0 = rt * 64;
    const int kk = tid >> 3, rr = (tid & 7) * 8, rho = r0 + rr;
    const float* src = t.src0; int col = rho;
    if (t.mode == 1) { const int pn = rho >> 8, bj = (rho >> 7) & 1, j = rho & 127; col = pn * 128 + j; src = bj ? t.src1 : t.src0; }
    else if (t.mode == 2) { col = rho < 4096 ? rho : (rho < 8704 ? rho + 8 : (rho < 8712 ? rho - 8704 + 4096 : -1)); }
    a = (f32x4){0.f, 0.f, 0.f, 0.f}; b = a;
    if (col >= 0) { const float* sp = src + (size_t)(k0 + kk) * t.Nsrc + col; a = *(const f32x4*)sp; b = *(const f32x4*)(sp + 4); }
}
__device__ __forceinline__ void conv_store(LAS float* scr, const ConvTask& t, int tid, const f32x4& a, const f32x4& b) {
    const int nkt = t.K / 64, kt = t.tile % nkt, rt = t.tile / nkt, k0 = kt * 64, r0 = rt * 64;
    { const int kk = tid >> 3, rr = (tid & 7) * 8;
#pragma unroll
        for (int e = 0; e < 4; ++e) { scr[(rr + e) * 65 + kk] = a[e]; scr[(rr + 4 + e) * 65 + kk] = b[e]; } }
    __syncthreads();
    { const int rl = tid >> 3, kc = (tid & 7) * 8;
        const LAS float* s = scr + rl * 65 + kc;
        u32x4 w; w.x = cvt_pk_bf16(s[0], s[1]); w.y = cvt_pk_bf16(s[2], s[3]); w.z = cvt_pk_bf16(s[4], s[5]); w.w = cvt_pk_bf16(s[6], s[7]);
        *(u32x4*)(t.dst + (size_t)(r0 + rl) * t.K + k0 + kc) = w; }
    __syncthreads();
}

__device__ __forceinline__ void convert_layer(LAS unsigned char* lds, const Params& p, int l) {
    LAS float* scr = (LAS float*)lds;
    unsigned char* ws = lptr(p.ws);
    constexpr int N1 = 16 * 88, N2 = 44 * 16, N3 = 16 * 140, N4 = 8 * 16, N5 = 16 * 16;
    constexpr int TOT = N1 + N2 + N3 + 4 * N4 + N5 + N1 + N2;
    const int tid = ltid(), G = lgdim();
    int it = lbid();
    if (it < TOT) {
        ConvTask cur = conv_task(p, l, it);
        f32x4 a, b; conv_load(cur, tid, a, b);
        for (;;) {
            const int nx = it + G; const bool more = nx < TOT;
            ConvTask nxt = cur; f32x4 na = a, nb = b;
            if (more) { nxt = conv_task(p, l, nx); conv_load(nxt, tid, na, nb); }
            conv_store(scr, cur, tid, a, b);
            if (!more) break;
            cur = nxt; a = na; b = nb; it = nx;
        }
    }
    bf16_t* waxt = (bf16_t*)(ws + WS_WAXT); bf16_t* pwt = (bf16_t*)(ws + WS_PWT);
    const float* wa = p.in[zz() + 13] + (size_t)l * 8 * 64 * 64; const float* wx = p.in[zz() + 15] + (size_t)l * 8 * 64 * 64; const float* pw = p.in[zz() + 22] + (size_t)l * 4 * 128 * 128;
    for (int e = lbid() * NTHR + ltid(); e < 65536; e += lgdim() * NTHR) {
        { const int h = e >> 13, jp = (e >> 6) & 127, i = e & 63; waxt[e] = f2bf(jp < 64 ? wa[(h * 64 + i) * 64 + jp] : wx[(h * 64 + i) * 64 + jp - 64]); }
        { const int g = e >> 14, d = (e >> 7) & 127, c = e & 127; pwt[e] = f2bf(pw[(g * 128 + c) * 128 + d]); }
    }
}

__device__ __forceinline__ void rms_rows_bf16(const float* X, const float* gain, bf16_t* H, int nrows) {
    const int wid = ltid() >> 6, lane = ltid() & 63;
    f32x4 gv[4];
#pragma unroll
    for (int j = 0; j < 4; ++j) gv[j] = *(const f32x4*)(gain + (lane + 64 * j) * 4);
    for (int row0 = (lbid() * 8 + wid) * 4; row0 < nrows; row0 += lgdim() * 32) {
        f32x4 v[4][4];
#pragma unroll
        for (int r = 0; r < 4; ++r) { const f32x4* xr = (const f32x4*)(X + (size_t)min(row0 + r, nrows - 1) * D) + lane;
#pragma unroll
            for (int j = 0; j < 4; ++j) v[r][j] = xr[64 * j]; }
#pragma unroll
        for (int r = 0; r < 4; ++r) {
            float s = 0.f;
#pragma unroll
            for (int j = 0; j < 4; ++j) s += (v[r][j].x * v[r][j].x + v[r][j].y * v[r][j].y) + (v[r][j].z * v[r][j].z + v[r][j].w * v[r][j].w);
            const float rs = rsqrtf(wave_sum(s) * (1.0f / D) + EPS);
            u32x2* o = (u32x2*)(H + (size_t)(row0 + r) * D) + lane;
            if (row0 + r < nrows)
#pragma unroll
            for (int j = 0; j < 4; ++j) { u32x2 w; w.x = cvt_pk_bf16(v[r][j].x * rs * gv[j].x, v[r][j].y * rs * gv[j].y); w.y = cvt_pk_bf16(v[r][j].z * rs * gv[j].z, v[r][j].w * rs * gv[j].w); o[64 * j] = w; }
        }
    }
}
__device__ __forceinline__ void rms_rows_f32_inplace(float* X, const float* gain, int nrows) {
    const int wid = ltid() >> 6, lane = ltid() & 63;
    f32x4 gv[4];
#pragma unroll
    for (int j = 0; j < 4; ++j) gv[j] = *(const f32x4*)(gain + (lane + 64 * j) * 4);
    for (int row0 = (lbid() * 8 + wid) * 4; row0 < nrows; row0 += lgdim() * 32) {
        f32x4 v[4][4];
#pragma unroll
        for (int r = 0; r < 4; ++r) { const f32x4* xr = (const f32x4*)(X + (size_t)min(row0 + r, nrows - 1) * D) + lane;
#pragma unroll
            for (int j = 0; j < 4; ++j) v[r][j] = xr[64 * j]; }
#pragma unroll
        for (int r = 0; r < 4; ++r) {
            float s = 0.f;
#pragma unroll
            for (int j = 0; j < 4; ++j) s += (v[r][j].x * v[r][j].x + v[r][j].y * v[r][j].y) + (v[r][j].z * v[r][j].z + v[r][j].w * v[r][j].w);
            const float rs = rsqrtf(wave_sum(s) * (1.0f / D) + EPS);
            f32x4* xo = (f32x4*)(X + (size_t)(row0 + r) * D) + lane;
            if (row0 + r < nrows)
#pragma unroll
            for (int j = 0; j < 4; ++j) xo[64 * j] = v[r][j] * rs * gv[j];
        }
    }
}

__device__ __forceinline__ void sgu_tile(LAS unsigned char* lds, const Params& p, int l, const bf16_t* proj, bf16_t* ya, int tile) {
    const int tid = ltid(), wid = tid >> 6, lane = tid & 63, fr = lane & 15, fq = lane >> 4;
    const int blk = tile >> 2, g = tile & 3, r0 = blk * 128;
    LAS bf16_t* Wl = (LAS bf16_t*)lds;
    LAS bf16_t* VT = (LAS bf16_t*)(lds + 34816);
    const float* lng = p.in[zz() + 7] + l * 512 + g * 128; const float* lnb = p.in[zz() + 8] + l * 512 + g * 128;
    {
        const int i = tid >> 2, qd = tid & 3;
        const bf16_t* vrow = proj + (size_t)(r0 + i) * PW + PC_AV + qd * 8;
        float s = 0.f, s2 = 0.f;
#pragma unroll 4
        for (int e8 = 0; e8 < 16; ++e8) { const u32x4 w = *(const u32x4*)(vrow + e8 * 32);
#pragma unroll
            for (int q = 0; q < 4; ++q) { const float a = geluf_(lo_bf(w[q])), b = geluf_(hi_bf(w[q])); s += a + b; s2 += a * a + b * b; } }
        s += __shfl_xor(s, 1); s += __shfl_xor(s, 2); s2 += __shfl_xor(s2, 1); s2 += __shfl_xor(s2, 2);
        const float mean = s * (1.0f / 512.0f), var = fmaxf(s2 * (1.0f / 512.0f) - mean * mean, 0.f), rstd = rsqrtf(var + EPS);
        const bf16_t* vg = proj + (size_t)(r0 + i) * PW + PC_AV + g * 128 + qd * 8;
#pragma unroll
        for (int e8 = 0; e8 < 4; ++e8) { const u32x4 w = *(const u32x4*)(vg + e8 * 32);
#pragma unroll
            for (int q = 0; q < 4; ++q) { const int c = e8 * 32 + qd * 8 + 2 * q;
                VT[c * 136 + i] = f2bf((geluf_(lo_bf(w[q])) - mean) * rstd * lng[c] + lnb[c]);
                VT[(c + 1) * 136 + i] = f2bf((geluf_(hi_bf(w[q])) - mean) * rstd * lng[c + 1] + lnb[c + 1]); } }
        const float* wsrc = p.in[zz() + 9] + (((size_t)l * 4 + g) * 128 + i) * 128 + qd * 32;
#pragma unroll
        for (int e4 = 0; e4 < 8; ++e4) { f32x4 w = *(const f32x4*)(wsrc + e4 * 4); if (i < 64 && qd >= 2) w = (f32x4){0.f, 0.f, 0.f, 0.f};
            u32x2 o; o.x = cvt_pk_bf16(w.x, w.y); o.y = cvt_pk_bf16(w.z, w.w); *(LAS u32x2*)(Wl + i * 136 + qd * 32 + e4 * 4) = o; }
    }
    __syncthreads();
    f32x4 acc[8];
#pragma unroll
    for (int n = 0; n < 8; ++n) acc[n] = (f32x4){0.f, 0.f, 0.f, 0.f};
#pragma unroll
    for (int ks = 0; ks < 4; ++ks) {
        const bf16x8 af = *(const LAS bf16x8*)(Wl + (wid * 16 + fr) * 136 + ks * 32 + fq * 8);
#pragma unroll
        for (int n = 0; n < 8; ++n) { const bf16x8 bf = *(const LAS bf16x8*)(VT + (n * 16 + fr) * 136 + ks * 32 + fq * 8); acc[n] = __builtin_amdgcn_mfma_f32_16x16x32_bf16(bf, af, acc[n], 0, 0, 0); }
    }
    {
        const int i = wid * 16 + fr; const float bias = p.in[zz() + 10][((size_t)l * 4 + g) * 128 + i];
        const bf16_t* up = proj + (size_t)(r0 + i) * PW + PC_AU + g * 128 + fq * 4;
        bf16_t* yp = ya + (size_t)(r0 + i) * 512 + g * 128 + fq * 4;
#pragma unroll
        for (int n = 0; n < 8; ++n) { const u32x2 uw = *(const u32x2*)(up + n * 16);
            u32x2 o; o.x = cvt_pk_bf16((acc[n][0] + bias) * geluf_(lo_bf(uw.x)), (acc[n][1] + bias) * geluf_(hi_bf(uw.x)));
            o.y = cvt_pk_bf16((acc[n][2] + bias) * geluf_(lo_bf(uw.y)), (acc[n][3] + bias) * geluf_(hi_bf(uw.y))); *(u32x2*)(yp + n * 16) = o; }
    }
    __syncthreads();
}

template <int WIN>
__device__ __forceinline__ void pool_rows(LAS bf16_t* Al, const bf16_t* xcol, int c, int pos0) {
    float xv[80];
#pragma unroll
    for (int k = 0; k < 80; ++k) xv[k] = (pos0 - 16 + k >= 0) ? bf2f(xcol[(long)(k - 16) * PW]) : 0.f;
    float s = 0.f;
#pragma unroll
    for (int j = 0; j < WIN; ++j) s += xv[16 - j];
#pragma unroll
    for (int tt = 0; tt < 64; ++tt) {
        const int k = tt + 16;
        const int cnt = min(pos0 + tt + 1, WIN);
        Al[tt * 520 + c] = f2bf(s / (float)cnt - xv[k]);
        if (tt < 63) s += xv[k + 1] - xv[k + 1 - WIN];
    }
}
__device__ __forceinline__ void pool_tile(LAS unsigned char* lds, const Params& p, int l, const bf16_t* proj, bf16_t* yd, bf16_t* halo, const bf16_t* pwt, int tile) {
    const int tid = ltid(), wid = tid >> 6, lane = tid & 63, fr = lane & 15, fq = lane >> 4;
    const int t0 = tile * 64, pos0 = t0 % SEQ;
    LAS bf16_t* Al = (LAS bf16_t*)lds;
    {
        const int c = tid, g = wid >> 1;
        const bf16_t* xcol = proj + (size_t)t0 * PW + PC_DX + c;
        if (g == 0) pool_rows<2>(Al, xcol, c, pos0); else if (g == 1) pool_rows<4>(Al, xcol, c, pos0); else if (g == 2) pool_rows<8>(Al, xcol, c, pos0); else pool_rows<16>(Al, xcol, c, pos0);
    }
    __syncthreads();
    {
        const int g = wid >> 1, nh = wid & 1;
        f32x4 acc[4][4];
#pragma unroll
        for (int m = 0; m < 4; ++m)
#pragma unroll
            for (int n = 0; n < 4; ++n) acc[m][n] = (f32x4){0.f, 0.f, 0.f, 0.f};
#pragma unroll
        for (int ks = 0; ks < 4; ++ks) {
            bf16x8 bfr[4];
#pragma unroll
            for (int n = 0; n < 4; ++n) bfr[n] = *(const bf16x8*)(pwt + ((size_t)(g * 128 + (nh * 4 + n) * 16 + fr)) * 128 + ks * 32 + fq * 8);
#pragma unroll
            for (int m = 0; m < 4; ++m) { const bf16x8 af = *(const LAS bf16x8*)(Al + (m * 16 + fr) * 520 + g * 128 + ks * 32 + fq * 8);
#pragma unroll
                for (int n = 0; n < 4; ++n) acc[m][n] = __builtin_amdgcn_mfma_f32_16x16x32_bf16(bfr[n], af, acc[m][n], 0, 0, 0); }
        }
        const float* sc = p.in[zz() + 23] + l * 512 + g * 128;
#pragma unroll
        for (int n = 0; n < 4; ++n) { const int d = (nh * 4 + n) * 16 + fq * 4; const f32x4 s4 = *(const f32x4*)(sc + d);
#pragma unroll
            for (int m = 0; m < 4; ++m) { u32x2 o; o.x = cvt_pk_bf16(acc[m][n][0] * s4[0], acc[m][n][1] * s4[1]); o.y = cvt_pk_bf16(acc[m][n][2] * s4[2], acc[m][n][3] * s4[3]);
                *(u32x2*)(yd + (size_t)(t0 + m * 16 + fr) * 512 + g * 128 + d) = o; } }
    }
    __syncthreads();
}

__device__ __forceinline__ void lru_tile(LAS unsigned char* lds, const Params& p, int l, const bf16_t* proj, bf16_t* yb, const bf16_t* waxt, float* Aend, float* Hend, const float* carry, int tile, int mode) {
    const int tid = ltid(), wid = tid >> 6, lane = tid & 63, fr = lane & 15, fq = lane >> 4;
    const int t0 = tile * 64, pos0 = t0 % SEQ, c = wid * 64 + lane;
    LAS bf16_t* Aw = (LAS bf16_t*)(lds + wid * 10560);
    LAS float* Xw = (LAS float*)(lds + wid * 10560 + 2304);
    bf16x8 bfr[8][2];
#pragma unroll
    for (int n = 0; n < 8; ++n)
#pragma unroll
        for (int ks = 0; ks < 2; ++ks) bfr[n][ks] = *(const bf16x8*)(waxt + ((size_t)(wid * 128 + n * 16 + fr)) * 64 + ks * 32 + fq * 8);
    const float* cwp = p.in[zz() + 11] + (size_t)l * 4 * 512 + c;
    const float cw0 = cwp[0], cw1 = cwp[512], cw2 = cwp[1024], cw3 = cwp[1536], cb = p.in[zz() + 12][l * 512 + c];
    const float ba = p.in[zz() + 14][l * 512 + c], bx = p.in[zz() + 16][l * 512 + c], sp8 = 8.0f * softplusf_(-p.in[zz() + 17][l * 512 + c]);
    const bf16_t* xcol = proj + (size_t)t0 * PW + PC_BX + c;
    float xm3 = 0.f, xm2 = 0.f, xm1 = 0.f;
    if (pos0 > 0) { xm3 = bf2f(xcol[-3L * PW]); xm2 = bf2f(xcol[-2L * PW]); xm1 = bf2f(xcol[-1L * PW]); }
    const bf16_t* gcol = proj + (size_t)t0 * PW + PC_BG + c;
    bf16_t* ycol = yb + (size_t)t0 * 512 + c;
    float h = mode ? carry[(size_t)tile * 512 + c] : 0.f, Ap = 1.f;
    for (int sub = 0; sub < 4; ++sub) {
        float xc[16];
#pragma unroll
        for (int tt = 0; tt < 16; ++tt) { const float xin = bf2f(*xcol); xcol += PW; xc[tt] = cb + cw0 * xm3 + cw1 * xm2 + cw2 * xm1 + cw3 * xin; xm3 = xm2; xm2 = xm1; xm1 = xin; Aw[tt * 72 + lane] = f2bf(xc[tt]); }
        __syncthreads();
        f32x4 acc[8];
#pragma unroll
        for (int n = 0; n < 8; ++n) acc[n] = (f32x4){0.f, 0.f, 0.f, 0.f};
#pragma unroll
        for (int ks = 0; ks < 2; ++ks) { const bf16x8 af = *(const LAS bf16x8*)(Aw + fr * 72 + ks * 32 + fq * 8);
#pragma unroll
            for (int n = 0; n < 8; ++n) acc[n] = __builtin_amdgcn_mfma_f32_16x16x32_bf16(bfr[n][ks], af, acc[n], 0, 0, 0); }
#pragma unroll
        for (int n = 0; n < 8; ++n)
#pragma unroll
            for (int j = 0; j < 4; ++j) Xw[fr * 129 + n * 16 + fq * 4 + j] = acc[n][j];
        __syncthreads();
#pragma unroll
        for (int tt = 0; tt < 16; ++tt) {
            const float r = sigmoidf_(Xw[tt * 129 + lane] + ba), ig = sigmoidf_(Xw[tt * 129 + 64 + lane] + bx);
            const float la = -sp8 * r, a = __expf(la), x2 = 2.0f * la;
            const float om = (x2 > -0.1f) ? -x2 * (1.0f + x2 * (0.5f + x2 * (0.16666667f + x2 * 0.041666668f))) : 1.0f - a * a;
            h = a * h + __builtin_amdgcn_sqrtf(om) * ig * xc[tt]; Ap *= a;
            if (mode) { const float gt = bf2f(*gcol); gcol += PW; *ycol = f2bf(h * geluf_(gt)); ycol += 512; }
        }
        __syncthreads();
    }
    if (!mode) { Aend[(size_t)tile * 512 + c] = Ap; Hend[(size_t)tile * 512 + c] = h; }
}
__device__ __forceinline__ void lru_carry(const float* Aend, const float* Hend, float* carry) {
    const int gid = lbid() * NTHR + ltid();
    if (gid < (TS / SEQ) * 512) {
        const int bl = gid >> 9, c = gid & 511; float h = 0.f;
        for (int n = 0; n < 64; ++n) { const size_t o = (size_t)(bl * 64 + n) * 512 + c; carry[o] = h; h = Aend[o] * h + Hend[o]; }
    }
}

__device__ __forceinline__ void gdn_prep(LAS unsigned char* lds, const Params& p, int l, const bf16_t* proj, const float* AB, bf16_t* GQ, bf16_t* GK, bf16_t* GU, bf16_t* GW, bf16_t* GA, float* edec, int item) {
    const int tid = ltid(), wid = tid >> 6, lane = tid & 63, fr = lane & 15, fq = lane >> 4;
    const int bl = item >> 8, n = (item & 255) >> 2, hh = item & 3, ch = bl * 64 + n, t0 = ch * 64;
    LAS bf16_t* Kl = (LAS bf16_t*)lds;
    LAS bf16_t* Ql = (LAS bf16_t*)(lds + 17408);
    LAS float* RHS = (LAS float*)(lds + 34816);
    LAS float* Am = (LAS float*)(lds + 101376);
    LAS float* gc = (LAS float*)(lds + 117760);
    LAS float* bt = (LAS float*)(lds + 118016);
    const int t = tid >> 3, d0 = (tid & 7) * 16;
#pragma unroll
    for (int sec = 0; sec < 3; ++sec) {
        const int colh = sec * 512 + hh * 128 + d0;
        u32x4 w0[4], w1[4]; float msk[4];
#pragma unroll
        for (int k = 0; k < 4; ++k) {
            const int tt = t - 3 + k; const bool valid = (tt >= 0) || (n > 0);
            const bf16_t* src = proj + (long)(t0 + (valid ? tt : 0)) * PW + PC_CQ + colh;
            w0[k] = *(const u32x4*)src; w1[k] = *(const u32x4*)(src + 8); msk[k] = valid ? 1.0f : 0.0f;
        }
        float a[16];
#pragma unroll
        for (int e = 0; e < 16; ++e) a[e] = 0.f;
#pragma unroll
        for (int k = 0; k < 4; ++k) {
            const float* cwp = p.in[zz() + 18] + ((size_t)l * 4 + k) * 1536 + colh;
#pragma unroll
            for (int q = 0; q < 4; ++q) { const f32x4 c4 = *(const f32x4*)(cwp + q * 4) * msk[k];
                const unsigned wa = (q < 2) ? w0[k][2 * q] : w1[k][2 * q - 4], wb = (q < 2) ? w0[k][2 * q + 1] : w1[k][2 * q - 3];
                a[q * 4 + 0] += c4[0] * lo_bf(wa); a[q * 4 + 1] += c4[1] * hi_bf(wa); a[q * 4 + 2] += c4[2] * lo_bf(wb); a[q * 4 + 3] += c4[3] * hi_bf(wb); }
        }
#pragma unroll
        for (int e = 0; e < 16; ++e) a[e] = siluf_(a[e]);
        if (sec < 2) {
            float ss = 0.f;
#pragma unroll
            for (int e = 0; e < 16; ++e) ss += a[e] * a[e];
            ss += __shfl_xor(ss, 1); ss += __shfl_xor(ss, 2); ss += __shfl_xor(ss, 4);
            const float nrm = rsqrtf(ss + EPS) * (sec == 0 ? 0.08838834764831845f : 1.0f);
#pragma unroll
            for (int e = 0; e < 16; ++e) a[e] *= nrm;
            LAS bf16_t* X = sec == 0 ? Ql : Kl;
#pragma unroll
            for (int e = 0; e < 16; e += 2) *(LAS unsigned*)(X + t * 136 + d0 + e) = cvt_pk_bf16(a[e], a[e + 1]);
        }
        if (sec >= 1) {
            LAS float* R = RHS + t * 260 + (sec == 1 ? 128 : 0) + d0;
#pragma unroll
            for (int e = 0; e < 16; e += 4) *(LAS f32x4*)(R + e) = (f32x4){a[e], a[e + 1], a[e + 2], a[e + 3]};
        }
    }
    if (wid == 0) {
        const float al = AB[(size_t)(t0 + lane) * 8 + 4 + hh], be = AB[(size_t)(t0 + lane) * 8 + hh];
        float gv = -__expf(p.in[zz() + 19][l * 4 + hh]) * softplusf_(al + p.in[zz() + 20][l * 4 + hh]);
#pragma unroll
        for (int o = 1; o < 64; o <<= 1) { const float u = __shfl_up(gv, o); if (lane >= o) gv += u; }
        gc[lane] = gv; bt[lane] = sigmoidf_(be);
        if (lane == 63) edec[item] = __expf(gv);
    }
    __syncthreads();
    float kdv[16];
    {
        const float bet = bt[t], gct = gc[t], eg = __expf(gct), ekd = __expf(gc[63] - gct);
        LAS float* Rv = RHS + t * 260 + d0; LAS float* Rk = Rv + 128;
#pragma unroll
        for (int e = 0; e < 16; e += 4) { const f32x4 v4 = *(LAS f32x4*)(Rv + e), k4 = *(LAS f32x4*)(Rk + e);
            *(LAS f32x4*)(Rv + e) = v4 * bet; *(LAS f32x4*)(Rk + e) = k4 * (bet * eg);
            kdv[e] = k4[0] * ekd; kdv[e + 1] = k4[1] * ekd; kdv[e + 2] = k4[2] * ekd; kdv[e + 3] = k4[3] * ekd; }
        unsigned qw[8];
#pragma unroll
        for (int e = 0; e < 8; ++e) { const unsigned w = *(LAS unsigned*)(Ql + t * 136 + d0 + 2 * e); qw[e] = cvt_pk_bf16(lo_bf(w) * eg, hi_bf(w) * eg); }
        bf16_t* qdst = GQ + (size_t)(t0 + t) * 512 + hh * 128 + d0;
        *(u32x4*)qdst = (u32x4){qw[0], qw[1], qw[2], qw[3]}; *(u32x4*)(qdst + 8) = (u32x4){qw[4], qw[5], qw[6], qw[7]};
    }
    {
        const int it = wid & 3, which = wid >> 2;
        LAS bf16_t* Xi = which ? Ql : Kl;
        bf16x8 af[4];
#pragma unroll
        for (int ks = 0; ks < 4; ++ks) af[ks] = *(const LAS bf16x8*)(Xi + (it * 16 + fr) * 136 + ks * 32 + fq * 8);
        const int i = it * 16 + fr; const float gci = gc[i], bti = bt[i];
#pragma unroll
        for (int jt = 0; jt < 4; ++jt) {
            f32x4 acc = (f32x4){0.f, 0.f, 0.f, 0.f};
#pragma unroll
            for (int ks = 0; ks < 4; ++ks) { const bf16x8 bf = *(const LAS bf16x8*)(Kl + (jt * 16 + fr) * 136 + ks * 32 + fq * 8); acc = __builtin_amdgcn_mfma_f32_16x16x32_bf16(bf, af[ks], acc, 0, 0, 0); }
            float v[4];
#pragma unroll
            for (int jj = 0; jj < 4; ++jj) { const int j = jt * 16 + fq * 4 + jj; const float dec = (i >= j) ? __expf(gci - gc[j]) : 0.f;
                v[jj] = which ? acc[jj] * dec : ((i > j) ? bti * acc[jj] * dec : 0.f); }
            if (which) { u32x2 o; o.x = cvt_pk_bf16(v[0], v[1]); o.y = cvt_pk_bf16(v[2], v[3]); *(u32x2*)(GA + (size_t)(t0 + i) * 256 + hh * 64 + jt * 16 + fq * 4) = o; }
            else *(LAS f32x4*)(Am + i * 64 + jt * 16 + fq * 4) = (f32x4){v[0], v[1], v[2], v[3]};
        }
    }
    __syncthreads();
    {
        LAS bf16_t* KDT = Ql;
#pragma unroll
        for (int e = 0; e < 16; ++e) KDT[(d0 + e) * 68 + t] = f2bf(kdv[e]);
    }
    if (tid < 256) {
        float x[64];
        int lz; asm volatile("v_mov_b32 %0, 0" : "=v"(lz));
        const LAS float* Amz = Am + lz;
#pragma unroll
        for (int i = 0; i < 64; ++i) x[i] = 0.f;
#pragma unroll
        for (int i = 0; i < 64; ++i) {
            float s = RHS[i * 260 + tid], s1 = 0.f, s2 = 0.f, s3 = 0.f;
#pragma unroll
            for (int j4 = 0; j4 < (i + 3) / 4; ++j4) { const f32x4 a4 = *(const LAS f32x4*)(Amz + i * 64 + j4 * 4);
                s -= a4[0] * x[j4 * 4]; s1 -= a4[1] * x[j4 * 4 + 1]; s2 -= a4[2] * x[j4 * 4 + 2]; s3 -= a4[3] * x[j4 * 4 + 3]; }
            s = (s + s1) + (s2 + s3);
            x[i] = s; RHS[i * 260 + tid] = s;
        }
    }
    __syncthreads();
    {
        const int seg = tid & 7;
        const LAS float* xr = RHS + t * 260 + seg * 32;
        bf16_t* dst = ((seg < 4) ? GU : GW) + (size_t)(t0 + t) * 512 + hh * 128 + (seg & 3) * 32;
#pragma unroll
        for (int q = 0; q < 4; ++q) { const f32x4 a = *(const LAS f32x4*)(xr + q * 8), b = *(const LAS f32x4*)(xr + q * 8 + 4);
            u32x4 w; w.x = cvt_pk_bf16(a[0], a[1]); w.y = cvt_pk_bf16(a[2], a[3]); w.z = cvt_pk_bf16(b[0], b[1]); w.w = cvt_pk_bf16(b[2], b[3]); *(u32x4*)(dst + q * 8) = w; }
        const LAS bf16_t* kr = Ql + (2 * t + (seg >> 2)) * 68 + (seg & 3) * 16;
        const u32x2 k0 = *(const LAS u32x2*)kr, k1 = *(const LAS u32x2*)(kr + 4), k2 = *(const LAS u32x2*)(kr + 8), k3 = *(const LAS u32x2*)(kr + 12);
        bf16_t* kdst = GK + (size_t)(t0 + t) * 512 + hh * 128 + seg * 16;
        *(u32x4*)kdst = (u32x4){k0.x, k0.y, k1.x, k1.y}; *(u32x4*)(kdst + 8) = (u32x4){k2.x, k2.y, k3.x, k3.y};
    }
    __syncthreads();
}

template <int OFF> __device__ __forceinline__ void dsr64(u32x2& d, unsigned addr) { asm volatile("ds_read_b64 %0, %1 offset:%2" : "=v"(d) : "v"(addr), "n"(OFF)); }
__device__ __forceinline__ void lgkm_wait8(u32x2& a, u32x2& b, u32x2& c, u32x2& d, u32x2& e, u32x2& f, u32x2& g, u32x2& h) {
    asm volatile("s_waitcnt lgkmcnt(0)" : "+v"(a), "+v"(b), "+v"(c), "+v"(d), "+v"(e), "+v"(f), "+v"(g), "+v"(h)); }
template <int RS  , int NK, int NM> struct FragSet { u32x2 lo[NK][NM], hi[NK][NM]; };
__device__ __forceinline__ void gdn_scan(LAS unsigned char* lds, const unsigned char* ws, float* oraw, const float* edec, int chain) {
    const int tid = ltid(), wid = __builtin_amdgcn_readfirstlane(tid >> 6), lane = tid & 63, fr = lane & 15, fq = lane >> 4;
    const int bl = chain >> 5, hh = (chain >> 3) & 3, es = chain & 7, e0 = es * 16;
    constexpr int BUF = 64512, O_W = 0, O_Q = 17408, O_KT = 34816, O_AT = 53248, O_U = 62464, O_PS = 2 * BUF, O_PV = 2 * BUF + 4096;
    const unsigned rb = (unsigned)(bl * 64) * 64u;
    const bool stager = (wid >= 2);
    unsigned soff[11];
#pragma unroll
    for (int i = 0; i < 11; ++i) {
        const int blk = (wid - 2) + 6 * i;
        const int q = blk * 64 + lane;
        unsigned o = 0u;
        if (stager && blk < 63) {
            if (q < 1088) { const int row = q / 17, pc = min(q % 17, 15); o = (unsigned)(WS_GDW + ((size_t)(rb + row) * 512 + hh * 128 + pc * 8) * 2); }
            else if (q < 2176) { const int q2 = q - 1088, row = q2 / 17, pc = min(q2 % 17, 15); o = (unsigned)(WS_GDQ + ((size_t)(rb + row) * 512 + hh * 128 + pc * 8) * 2); }
            else if (q < 3328) { const int q2 = q - 2176, d = q2 / 9, pc = min(q2 % 9, 7); o = (unsigned)(WS_GDK + ((size_t)(rb + (d >> 1)) * 512 + hh * 128 + (d & 1) * 64 + pc * 8) * 2); }
            else if (q < 3904) { const int q2 = q - 3328, row = q2 / 9, pc = min(q2 % 9, 7); o = (unsigned)(WS_GDA + ((size_t)(rb + row) * 256 + hh * 64 + pc * 8) * 2); }
            else { const int q2 = q - 3904, row = q2 >> 1, pc = q2 & 1; o = (unsigned)(WS_GDU + ((size_t)(rb + row) * 512 + hh * 128 + e0 + pc * 8) * 2); }
        }
        soff[i] = o;
    }
#define SCAN_DMA(chunk, bufsel) do { _Pragma("unroll") for (int i = 0; i < 11; ++i) { const int blk = (wid - 2) + 6 * i; if (blk < 63) { \
        const unsigned stp = (blk >= 52 && blk < 61) ? 32768u : 65536u; \
        __builtin_amdgcn_global_load_lds((const unsigned*)(ws + soff[i] + (unsigned)(chunk) * stp), (LAS unsigned*)(lds + (bufsel) * BUF + blk * 1024), 16, 0, 0); } } } while (0)
    if (stager) { SCAN_DMA(0, 0); asm volatile("s_waitcnt vmcnt(0)" ::: "memory"); }
    if (wid == 1) {
#pragma unroll
        for (int kt = 0; kt < 4; ++kt) *(LAS u32x4*)(lds + O_PS + kt * 1024 + lane * 16) = (u32x4){0u, 0u, 0u, 0u};
    }
    const float dv = edec[bl * 256 + lane * 4 + hh];
    f32x4 Sacc[8];
#pragma unroll
    for (int d = 0; d < 8; ++d) Sacc[d] = (f32x4){0.f, 0.f, 0.f, 0.f};
    __syncthreads();
    for (int n = 0; n < 64; ++n) {
        const LAS unsigned char* B = lds + (n & 1) * BUF;
        const int t0 = (bl * 64 + n) * 64;
        f32x4 OS[4];
        bf16x8 vb[2];
        if (stager) { if (n + 1 < 64) SCAN_DMA(n + 1, (n + 1) & 1); }
        else if (wid == 0) {
            f32x4 WS[4];
            bf16x8 sb[4];
#pragma unroll
            for (int kt = 0; kt < 4; ++kt) { u32x4 w; w.x = cvt_pk_bf16(Sacc[2 * kt][0], Sacc[2 * kt][1]); w.y = cvt_pk_bf16(Sacc[2 * kt][2], Sacc[2 * kt][3]);
                w.z = cvt_pk_bf16(Sacc[2 * kt + 1][0], Sacc[2 * kt + 1][1]); w.w = cvt_pk_bf16(Sacc[2 * kt + 1][2], Sacc[2 * kt + 1][3]); sb[kt] = __builtin_bit_cast(bf16x8, w); }
#pragma unroll
            for (int m = 0; m < 4; ++m) WS[m] = (f32x4){0.f, 0.f, 0.f, 0.f};
            {
                u32x2 wlo[4][4], whi[4][4];
                const unsigned bw = (unsigned)(unsigned long)(B + O_W + (fr * 136 + fq * 4) * 2);
                dsr64<0>(wlo[0][0], bw); dsr64<32>(whi[0][0], bw);
                dsr64<4352>(wlo[0][1], bw); dsr64<4384>(whi[0][1], bw);
                dsr64<8704>(wlo[0][2], bw); dsr64<8736>(whi[0][2], bw);
                dsr64<13056>(wlo[0][3], bw); dsr64<13088>(whi[0][3], bw);
                dsr64<64>(wlo[1][0], bw); dsr64<96>(whi[1][0], bw);
                dsr64<4416>(wlo[1][1], bw); dsr64<4448>(whi[1][1], bw);
                dsr64<8768>(wlo[1][2], bw); dsr64<8800>(whi[1][2], bw);
                dsr64<13120>(wlo[1][3], bw); dsr64<13152>(whi[1][3], bw);
                dsr64<128>(wlo[2][0], bw); dsr64<160>(whi[2][0], bw);
                dsr64<4480>(wlo[2][1], bw); dsr64<4512>(whi[2][1], bw);
                dsr64<8832>(wlo[2][2], bw); dsr64<8864>(whi[2][2], bw);
                dsr64<13184>(wlo[2][3], bw); dsr64<13216>(whi[2][3], bw);
                dsr64<192>(wlo[3][0], bw); dsr64<224>(whi[3][0], bw);
                dsr64<4544>(wlo[3][1], bw); dsr64<4576>(whi[3][1], bw);
                dsr64<8896>(wlo[3][2], bw); dsr64<8928>(whi[3][2], bw);
                dsr64<13248>(wlo[3][3], bw); dsr64<13280>(whi[3][3], bw);
                lgkm_wait8(wlo[0][0], wlo[0][1], wlo[0][2], wlo[0][3], wlo[1][0], wlo[1][1], wlo[1][2], wlo[1][3]);
                lgkm_wait8(wlo[2][0], wlo[2][1], wlo[2][2], wlo[2][3], wlo[3][0], wlo[3][1], wlo[3][2], wlo[3][3]);
                lgkm_wait8(whi[0][0], whi[0][1], whi[0][2], whi[0][3], whi[1][0], whi[1][1], whi[1][2], whi[1][3]);
                lgkm_wait8(whi[2][0], whi[2][1], whi[2][2], whi[2][3], whi[3][0], whi[3][1], whi[3][2], whi[3][3]);
#pragma unroll
                for (int kt = 0; kt < 4; ++kt)
#pragma unroll
                    for (int m = 0; m < 4; ++m) WS[m] = __builtin_amdgcn_mfma_f32_16x16x32_bf16(__builtin_bit_cast(bf16x8, (u32x4){wlo[kt][m].x, wlo[kt][m].y, whi[kt][m].x, whi[kt][m].y}), sb[kt], WS[m], 0, 0, 0);
            }
#pragma unroll
            for (int m = 0; m < 4; ++m)
#pragma unroll
                for (int jj = 0; jj < 4; ++jj) WS[m][jj] = bf2f(*(const LAS bf16_t*)(B + O_U + ((m * 16 + fq * 4 + jj) * 16 + fr) * 2)) - WS[m][jj];
#pragma unroll
            for (int kc = 0; kc < 2; ++kc) { u32x4 w; w.x = cvt_pk_bf16(WS[2 * kc][0], WS[2 * kc][1]); w.y = cvt_pk_bf16(WS[2 * kc][2], WS[2 * kc][3]);
                w.z = cvt_pk_bf16(WS[2 * kc + 1][0], WS[2 * kc + 1][1]); w.w = cvt_pk_bf16(WS[2 * kc + 1][2], WS[2 * kc + 1][3]); vb[kc] = __builtin_bit_cast(bf16x8, w);
                *(LAS u32x4*)(lds + O_PV + kc * 1024 + lane * 16) = w; }
        } else if (wid == 1) {
#pragma unroll
            for (int m = 0; m < 4; ++m) OS[m] = (f32x4){0.f, 0.f, 0.f, 0.f};
            {
                u32x2 qlo[4][4], qhi[4][4]; bf16x8 sbr[4];
#pragma unroll
                for (int kt = 0; kt < 4; ++kt) sbr[kt] = *(const LAS bf16x8*)(lds + O_PS + kt * 1024 + lane * 16);
                const unsigned bq = (unsigned)(unsigned long)(B + O_Q + (fr * 136 + fq * 4) * 2);
                dsr64<0>(qlo[0][0], bq); dsr64<32>(qhi[0][0], bq);
                dsr64<4352>(qlo[0][1], bq); dsr64<4384>(qhi[0][1], bq);
                dsr64<8704>(qlo[0][2], bq); dsr64<8736>(qhi[0][2], bq);
                dsr64<13056>(qlo[0][3], bq); dsr64<13088>(qhi[0][3], bq);
                dsr64<64>(qlo[1][0], bq); dsr64<96>(qhi[1][0], bq);
                dsr64<4416>(qlo[1][1], bq); dsr64<4448>(qhi[1][1], bq);
                dsr64<8768>(qlo[1][2], bq); dsr64<8800>(qhi[1][2], bq);
                dsr64<13120>(qlo[1][3], bq); dsr64<13152>(qhi[1][3], bq);
                dsr64<128>(qlo[2][0], bq); dsr64<160>(qhi[2][0], bq);
                dsr64<4480>(qlo[2][1], bq); dsr64<4512>(qhi[2][1], bq);
                dsr64<8832>(qlo[2][2], bq); dsr64<8864>(qhi[2][2], bq);
                dsr64<13184>(qlo[2][3], bq); dsr64<13216>(qhi[2][3], bq);
                dsr64<192>(qlo[3][0], bq); dsr64<224>(qhi[3][0], bq);
                dsr64<4544>(qlo[3][1], bq); dsr64<4576>(qhi[3][1], bq);
                dsr64<8896>(qlo[3][2], bq); dsr64<8928>(qhi[3][2], bq);
                dsr64<13248>(qlo[3][3], bq); dsr64<13280>(qhi[3][3], bq);
                lgkm_wait8(qlo[0][0], qlo[0][1], qlo[0][2], qlo[0][3], qlo[1][0], qlo[1][1], qlo[1][2], qlo[1][3]);
                lgkm_wait8(qlo[2][0], qlo[2][1], qlo[2][2], qlo[2][3], qlo[3][0], qlo[3][1], qlo[3][2], qlo[3][3]);
                lgkm_wait8(qhi[0][0], qhi[0][1], qhi[0][2], qhi[0][3], qhi[1][0], qhi[1][1], qhi[1][2], qhi[1][3]);
                lgkm_wait8(qhi[2][0], qhi[2][1], qhi[2][2], qhi[2][3], qhi[3][0], qhi[3][1], qhi[3][2], qhi[3][3]);
#pragma unroll
                for (int kt = 0; kt < 4; ++kt)
#pragma unroll
                    for (int m = 0; m < 4; ++m) OS[m] = __builtin_amdgcn_mfma_f32_16x16x32_bf16(__builtin_bit_cast(bf16x8, (u32x4){qlo[kt][m].x, qlo[kt][m].y, qhi[kt][m].x, qhi[kt][m].y}), sbr[kt], OS[m], 0, 0, 0);
            }
        }
        asm volatile("s_waitcnt lgkmcnt(0)" ::: "memory"); __builtin_amdgcn_s_barrier(); asm volatile("" ::: "memory");
        if (wid == 0) {
            const float dec = __shfl(dv, n);
#pragma unroll
            for (int d = 0; d < 8; ++d) Sacc[d] *= dec;
            {
                u32x2 klo[2][8], khi[2][8];
                const unsigned bk = (unsigned)(unsigned long)(B + O_KT + (fr * 72 + fq * 4) * 2);
                dsr64<0>(klo[0][0], bk); dsr64<32>(khi[0][0], bk);
                dsr64<2304>(klo[0][1], bk); dsr64<2336>(khi[0][1], bk);
                dsr64<4608>(klo[0][2], bk); dsr64<4640>(khi[0][2], bk);
                dsr64<6912>(klo[0][3], bk); dsr64<6944>(khi[0][3], bk);
                dsr64<9216>(klo[0][4], bk); dsr64<9248>(khi[0][4], bk);
                dsr64<11520>(klo[0][5], bk); dsr64<11552>(khi[0][5], bk);
                dsr64<13824>(klo[0][6], bk); dsr64<13856>(khi[0][6], bk);
                dsr64<16128>(klo[0][7], bk); dsr64<16160>(khi[0][7], bk);
                dsr64<64>(klo[1][0], bk); dsr64<96>(khi[1][0], bk);
                dsr64<2368>(klo[1][1], bk); dsr64<2400>(khi[1][1], bk);
                dsr64<4672>(klo[1][2], bk); dsr64<4704>(khi[1][2], bk);
                dsr64<6976>(klo[1][3], bk); dsr64<7008>(khi[1][3], bk);
                dsr64<9280>(klo[1][4], bk); dsr64<9312>(khi[1][4], bk);
                dsr64<11584>(klo[1][5], bk); dsr64<11616>(khi[1][5], bk);
                dsr64<13888>(klo[1][6], bk); dsr64<13920>(khi[1][6], bk);
                dsr64<16192>(klo[1][7], bk); dsr64<16224>(khi[1][7], bk);
                lgkm_wait8(klo[0][0], klo[0][1], klo[0][2], klo[0][3], klo[0][4], klo[0][5], klo[0][6], klo[0][7]);
                lgkm_wait8(klo[1][0], klo[1][1], klo[1][2], klo[1][3], klo[1][4], klo[1][5], klo[1][6], klo[1][7]);
                lgkm_wait8(khi[0][0], khi[0][1], khi[0][2], khi[0][3], khi[0][4], khi[0][5], khi[0][6], khi[0][7]);
                lgkm_wait8(khi[1][0], khi[1][1], khi[1][2], khi[1][3], khi[1][4], khi[1][5], khi[1][6], khi[1][7]);
#pragma unroll
                for (int kc = 0; kc < 2; ++kc)
#pragma unroll
                    for (int d = 0; d < 8; ++d) Sacc[d] = __builtin_amdgcn_mfma_f32_16x16x32_bf16(__builtin_bit_cast(bf16x8, (u32x4){klo[kc][d].x, klo[kc][d].y, khi[kc][d].x, khi[kc][d].y}), vb[kc], Sacc[d], 0, 0, 0);
            }
#pragma unroll
            for (int kt = 0; kt < 4; ++kt) { u32x4 w; w.x = cvt_pk_bf16(Sacc[2 * kt][0], Sacc[2 * kt][1]); w.y = cvt_pk_bf16(Sacc[2 * kt][2], Sacc[2 * kt][3]);
                w.z = cvt_pk_bf16(Sacc[2 * kt + 1][0], Sacc[2 * kt + 1][1]); w.w = cvt_pk_bf16(Sacc[2 * kt + 1][2], Sacc[2 * kt + 1][3]);
                *(LAS u32x4*)(lds + O_PS + kt * 1024 + lane * 16) = w; }
        } else if (wid == 1) {
            {
                u32x2 alo[2][4], ahi[2][4]; bf16x8 vbr[2];
#pragma unroll
                for (int kc = 0; kc < 2; ++kc) vbr[kc] = *(const LAS bf16x8*)(lds + O_PV + kc * 1024 + lane * 16);
                const unsigned ba = (unsigned)(unsigned long)(B + O_AT + (fr * 72 + fq * 4) * 2);
                dsr64<0>(alo[0][0], ba); dsr64<32>(ahi[0][0], ba);
                dsr64<2304>(alo[0][1], ba); dsr64<2336>(ahi[0][1], ba);
                dsr64<4608>(alo[0][2], ba); dsr64<4640>(ahi[0][2], ba);
                dsr64<6912>(alo[0][3], ba); dsr64<6944>(ahi[0][3], ba);
                dsr64<64>(alo[1][0], ba); dsr64<96>(ahi[1][0], ba);
                dsr64<2368>(alo[1][1], ba); dsr64<2400>(ahi[1][1], ba);
                dsr64<4672>(alo[1][2], ba); dsr64<4704>(ahi[1][2], ba);
                dsr64<6976>(alo[1][3], ba); dsr64<7008>(ahi[1][3], ba);
                lgkm_wait8(alo[0][0], alo[0][1], alo[0][2], alo[0][3], alo[1][0], alo[1][1], alo[1][2], alo[1][3]);
                lgkm_wait8(ahi[0][0], ahi[0][1], ahi[0][2], ahi[0][3], ahi[1][0], ahi[1][1], ahi[1][2], ahi[1][3]);
#pragma unroll
                for (int kc = 0; kc < 2; ++kc)
#pragma unroll
                    for (int m = 0; m < 4; ++m) OS[m] = __builtin_amdgcn_mfma_f32_16x16x32_bf16(__builtin_bit_cast(bf16x8, (u32x4){alo[kc][m].x, alo[kc][m].y, ahi[kc][m].x, ahi[kc][m].y}), vbr[kc], OS[m], 0, 0, 0);
            }
            float* op = oraw + (size_t)(t0 + fq * 4) * 512 + hh * 128 + e0 + fr;
#pragma unroll
            for (int m = 0; m < 4; ++m)
#pragma unroll
                for (int jj = 0; jj < 4; ++jj) op[(size_t)(m * 16 + jj) * 512] = OS[m][jj];
        } else if (stager) {
            asm volatile("s_waitcnt vmcnt(0)" ::: "memory");
        }
        __syncthreads();
    }
#undef SCAN_DMA
}
__device__ __forceinline__ void gdn_out(const Params& p, int l, const float* oraw, const bf16_t* proj, bf16_t* yc) {
    const int tid = ltid(), sub = tid & 15;
    const float* ng = p.in[zz() + 21] + l * 128 + sub * 8;
    const f32x4 g0 = *(const f32x4*)ng, g1 = *(const f32x4*)(ng + 4);
    for (int rowi = lbid() * 32 + (tid >> 4); rowi < TS * 4; rowi += lgdim() * 32) {
        const int t = rowi >> 2, hh = rowi & 3;
        const float* op = oraw + (size_t)t * 512 + hh * 128 + sub * 8;
        const f32x4 o0 = *(const f32x4*)op, o1 = *(const f32x4*)(op + 4);
        float ss = (o0[0] * o0[0] + o0[1] * o0[1]) + (o0[2] * o0[2] + o0[3] * o0[3]) + (o1[0] * o1[0] + o1[1] * o1[1]) + (o1[2] * o1[2] + o1[3] * o1[3]);
        ss += __shfl_xor(ss, 1); ss += __shfl_xor(ss, 2); ss += __shfl_xor(ss, 4); ss += __shfl_xor(ss, 8);
        const float rs = rsqrtf(ss * (1.0f / 128.0f) + EPS);
        const u32x4 z = *(const u32x4*)(proj + (size_t)t * PW + PC_CZ + hh * 128 + sub * 8);
        u32x4 w;
        w.x = cvt_pk_bf16(o0[0] * rs * g0[0] * siluf_(lo_bf(z.x)), o0[1] * rs * g0[1] * siluf_(hi_bf(z.x)));
        w.y = cvt_pk_bf16(o0[2] * rs * g0[2] * siluf_(lo_bf(z.y)), o0[3] * rs * g0[3] * siluf_(hi_bf(z.y)));
        w.z = cvt_pk_bf16(o1[0] * rs * g1[0] * siluf_(lo_bf(z.z)), o1[1] * rs * g1[1] * siluf_(hi_bf(z.z)));
        w.w = cvt_pk_bf16(o1[2] * rs * g1[2] * siluf_(lo_bf(z.w)), o1[3] * rs * g1[3] * siluf_(hi_bf(z.w)));
        *(u32x4*)(yc + (size_t)t * 512 + hh * 128 + sub * 8) = w;
    }
}

constexpr int PH_PER_LAYER = 22, N_PHASES = 2 * PH_PER_LAYER + 1;

__device__ __forceinline__ void run_phase(LAS unsigned char* lds, const Params& p, int ph) {
    unsigned char* ws = lptr(p.ws);
    bf16_t* hbuf = (bf16_t*)(ws + WS_H);
    bf16_t* act = (bf16_t*)(ws + WS_PROJ);
    bf16_t* proj = (bf16_t*)(ws + WS_PROJ);
    bf16_t* hslab = hbuf;
    bf16_t* merged = hbuf + (size_t)TS * D;
    float* oraw = (float*)(ws + WS_H);
    bf16_t* ys = (bf16_t*)(ws + WS_YS);
    float* AB = (float*)(ws + WS_AB);
    bf16_t* halo = (bf16_t*)(ws + WS_HALO);
    float* Aend = (float*)(ws + WS_AEND); float* Hend = (float*)(ws + WS_HEND); float* carry = (float*)(ws + WS_CARRY); float* edec = (float*)(ws + WS_EDEC);
    const bf16_t* waxt = (const bf16_t*)(ws + WS_WAXT); const bf16_t* pwt = (const bf16_t*)(ws + WS_PWT);
    const int G = lgdim(), c = lbid();
    if (ph == N_PHASES - 1) { PHON(0) rms_rows_f32_inplace(lptr(p.out), p.in[zz() + 30], T); return; }
    const int l = ph / PH_PER_LAYER, r = ph % PH_PER_LAYER;
    const float* xcur = (l == 0) ? p.in[zz() + 0] : lptr(p.out);
    if (r == 0) { PHON(1) convert_layer(lds, p, l); PHON(0) rms_rows_bf16(xcur, p.in[zz() + 1] + l * D, hbuf, T); return; }
    if (r == 1 || r == 20) { PHON(2) ph_gemm_swiglu(lds, hbuf, (const bf16_t*)(ws + (r == 1 ? WS_WGU1 : WS_WGU2)), act); return; }
    if (r == 2 || r == 21) { PHON(3) ph_gemm_resid(lds, act, (const bf16_t*)(ws + (r == 2 ? WS_WD1 : WS_WD2)), T, DFF, (r == 2) ? xcur : lptr(p.out), lptr(p.out), 0.5f); return; }
    if (r == 19) { rms_rows_bf16(lptr(p.out), p.in[zz() + 26] + l * D, hbuf, T); return; }
    const int slab = (r - 3) >> 3, q = (r - 3) & 7;
    float* xs = lptr(p.out) + (size_t)slab * TS * D;
    switch (q) {
    case 0: rms_rows_bf16(xs, p.in[zz() + 5] + l * D, hslab, TS); break;
    case 1: PHON(4) ph_gemm_proj(lds, hslab, (const bf16_t*)(ws + WS_WIN), proj, AB); break;
    case 2:
        PHON(7) for (int t = c; t < TS / 64; t += G) lru_tile(lds, p, l, proj, nullptr, waxt, Aend, Hend, carry, t, 0);
        if (G >= 256) { PHON(5) for (int t = c; t < (TS / 128) * 2; t += G) sgu_tile(lds, p, l, proj, ys, t); }
        break;
    case 3:
        PHON(8) for (int it = c; it < (TS / 64) * 4; it += G) gdn_prep(lds, p, l, proj, AB, (bf16_t*)(ws + WS_GDQ), (bf16_t*)(ws + WS_GDK), (bf16_t*)(ws + WS_GDU), (bf16_t*)(ws + WS_GDW), (bf16_t*)(ws + WS_GDA), edec, it);
        lru_carry(Aend, Hend, carry);
        break;
    case 4:
        PHON(9) if (c < 128 || G < 256) { for (int ch = c; ch < 128; ch += G) gdn_scan(lds, ws, oraw, edec, ch); }
        if (G >= 256 && c < 128) { PHON(6) for (int t = c; t < TS / 128; t += 128) pool_tile(lds, p, l, proj, ys + (size_t)3 * TS * 512, halo, pwt, t); }
        if (G >= 256) {
            if (c >= 128) {
                const int cc = c - 128, GG = G - 128;
                PHON(10) for (int t = cc; t < TS / 128; t += GG) lru_tile(lds, p, l, proj, ys + (size_t)TS * 512, waxt, Aend, Hend, carry, t, 1);
                PHON(5) for (int t = (TS / 128) * 2 + cc; t < (TS / 128) * 4; t += GG) sgu_tile(lds, p, l, proj, ys, t);
                PHON(6) for (int t = TS / 128 + cc; t < TS / 64; t += GG) pool_tile(lds, p, l, proj, ys + (size_t)3 * TS * 512, halo, pwt, t);
            }
        } else {
            for (int t = c; t < TS / 64; t += G) lru_tile(lds, p, l, proj, ys + (size_t)TS * 512, waxt, Aend, Hend, carry, t, 1);
            for (int t = c; t < (TS / 128) * 4; t += G) sgu_tile(lds, p, l, proj, ys, t);
            for (int t = c; t < TS / 64; t += G) pool_tile(lds, p, l, proj, ys + (size_t)3 * TS * 512, halo, pwt, t);
        }
        break;
    case 5: if (G >= 256) { for (int t = TS / 128 + c; t < TS / 64; t += G) lru_tile(lds, p, l, proj, ys + (size_t)TS * 512, waxt, Aend, Hend, carry, t, 1); }
        PHON(11) gdn_out(p, l, oraw, proj, ys + (size_t)2 * TS * 512); break;
    case 6: PHON(12) ph_gemm_branch(lds, ys, (const bf16_t*)(ws + WS_WB), proj, merged); break;
    default: PHON(13) ph_gemm_resid(lds, merged, (const bf16_t*)(ws + WS_WOUT), TS, D, xs, xs, 1.0f); break;
    }
}

extern __shared__ __attribute__((aligned(16))) unsigned char smem_dyn[];

#ifndef DUP_TYPE
#define DUP_TYPE -1
#endif
__device__ __forceinline__ int phase_type(int ph) {
    if (ph == N_PHASES - 1) return 12;
    const int r = ph % PH_PER_LAYER;
    if (r == 0) return 0; if (r == 1 || r == 20) return 1; if (r == 2 || r == 21) return 2; if (r == 19) return 11;
    const int q = (r - 3) & 7;
    return 3 + q;
}
__global__ void __launch_bounds__(NTHR) fwd_megakernel(Params p) {
    cg::grid_group grid = cg::this_grid();
    LAS unsigned char* lds = (LAS unsigned char*)smem_dyn;
    volatile LAS unsigned* st = (volatile LAS unsigned*)(lds + LDS_BYTES - 16);
    if (threadIdx.x == 0) { st[0] = 0u; st[1] = 0u; }
    __syncthreads();
    const XcdBarrier xb = xcd_barrier_post((unsigned*)(p.ws + WS_BAR), st);
    grid.sync();
    for (int ph = p.ph_lo; ph < p.ph_hi; ++ph) {
        if (ph > p.ph_lo) xcd_barrier(xb);
        run_phase(lds, p, ph);
#if DUP_TYPE == 6
        if (phase_type(ph) == 6) { xcd_barrier(xb); run_phase(lds, p, ph - 2); xcd_barrier(xb); run_phase(lds, p, ph - 1); xcd_barrier(xb); run_phase(lds, p, ph); }
#elif DUP_TYPE >= 0
        if (phase_type(ph) == DUP_TYPE) { xcd_barrier(xb); run_phase(lds, p, ph); }
#endif
    }
}

extern "C" void kernel_launch(void* const* d_in, const int* in_sizes, int n_in, void* d_out, int out_size, void* d_ws, size_t ws_size, hipStream_t stream) {
    static int grid_blocks = 0;
    if (grid_blocks == 0) {
        if (n_in != 31 || out_size != T * D || ws_size < WS_END) { fprintf(stderr, "kernel_launch: unexpected shapes (n_in %d out %d ws %zu need %zu)\n", n_in, out_size, ws_size, (size_t)WS_END); grid_blocks = -1; return; }
        int dev = 0, cus = 0, per_cu = 0;
        hipGetDevice(&dev);
        hipDeviceGetAttribute(&cus, hipDeviceAttributeMultiprocessorCount, dev);
        if (hipFuncSetAttribute((const void*)fwd_megakernel, hipFuncAttributeMaxDynamicSharedMemorySize, LDS_BYTES) != hipSuccess) { fprintf(stderr, "kernel_launch: hipFuncSetAttribute failed\n"); grid_blocks = -1; return; }
        hipOccupancyMaxActiveBlocksPerMultiprocessor(&per_cu, (const void*)fwd_megakernel, NTHR, LDS_BYTES);
        if (per_cu < 1) { fprintf(stderr, "kernel_launch: occupancy query returned %d\n", per_cu); per_cu = 1; }
        grid_blocks = cus * per_cu;
    }
    if (grid_blocks < 0) return;
    Params p{};
    for (int i = 0; i < 31; ++i) p.in[i] = (const float*)d_in[i];
    p.out = (float*)d_out; p.ws = (unsigned char*)d_ws;
    hipMemsetAsync((unsigned char*)d_ws + WS_BAR, 0, 16384, stream);
    p.ph_lo = 0; p.ph_hi = N_PHASES;
    void* args[] = {&p};
    hipError_t e = hipLaunchCooperativeKernel((const void*)fwd_megakernel, dim3(grid_blocks), dim3(NTHR), args, LDS_BYTES, stream);
    if (e != hipSuccess) fprintf(stderr, "cooperative launch failed: %s (grid %d)\n", hipGetErrorString(e), grid_blocks);
}
```

```cpp
#include <hip/hip_runtime.h>
#include <hip/hip_cooperative_groups.h>
#include <cstdio>
namespace cg = cooperative_groups;

#ifndef MULTI_LAUNCH
#define MULTI_LAUNCH 0
#endif

#ifndef PH_MASK
#define PH_MASK 0xFFFFF
#endif
#define PHON(k) if constexpr ((PH_MASK >> (k)) & 1)
#define LAS __attribute__((address_space(3)))
typedef unsigned short bf16_t;
typedef short bf16x8 __attribute__((ext_vector_type(8)));
typedef short bf16x4 __attribute__((ext_vector_type(4)));
typedef float f32x4 __attribute__((ext_vector_type(4)));
typedef unsigned u32x4 __attribute__((ext_vector_type(4)));
typedef unsigned u32x2 __attribute__((ext_vector_type(2)));

constexpr int T = 32768, D = 1024, DFF = 2816, NSLAB = 2, TS = T / NSLAB, SEQ = 4096, PW = 8960, PIN = 8712;
constexpr int PC_AU = 0, PC_AV = 512, PC_BX = 1024, PC_BG = 1536, PC_CQ = 2048, PC_CK = 2560, PC_CV = 3072, PC_CZ = 3584, PC_DX = 4096, PC_GATE = 4608, PC_AB = 8704;
constexpr float EPS = 1e-6f;
constexpr int NTHR = 512;
constexpr int LDS_BYTES = 147456;

constexpr size_t WS_WGU1 = 0;
constexpr size_t WS_WD1 = WS_WGU1 + (size_t)5632 * 1024 * 2;
constexpr size_t WS_WIN = WS_WD1 + (size_t)1024 * 2816 * 2;
constexpr size_t WS_WB = WS_WIN + (size_t)PW * 1024 * 2;
constexpr size_t WS_WOUT = WS_WB + (size_t)4 * 1024 * 512 * 2;
constexpr size_t WS_WGU2 = WS_WOUT + (size_t)1024 * 1024 * 2;
constexpr size_t WS_WD2 = WS_WGU2 + (size_t)5632 * 1024 * 2;
constexpr size_t WS_WAXT = WS_WD2 + (size_t)1024 * 2816 * 2;
constexpr size_t WS_PWT = WS_WAXT + 131072;
constexpr size_t WS_PROJ = WS_PWT + 131072;
constexpr size_t WS_H = WS_PROJ + (size_t)TS * PW * 2;
constexpr size_t WS_YS = WS_H + (size_t)T * D * 2;
constexpr size_t WS_AB = WS_YS + (size_t)4 * TS * 512 * 2;
constexpr size_t WS_HALO = WS_AB + (size_t)TS * 8 * 4;
constexpr size_t WS_AEND = WS_HALO + (size_t)(TS / 64) * 3 * 1536 * 2;
constexpr size_t WS_HEND = WS_AEND + (size_t)(TS / 64) * 512 * 4;
constexpr size_t WS_CARRY = WS_HEND + (size_t)(TS / 64) * 512 * 4;
constexpr size_t WS_EDEC = WS_CARRY + (size_t)(TS / 64) * 512 * 4;
constexpr size_t WS_BAR = WS_EDEC + 4096;
constexpr size_t WS_GDQ = WS_H + (size_t)TS * D * 2;
constexpr size_t WS_GDK = WS_GDQ + (size_t)TS * 512 * 2;
constexpr size_t WS_GDU = WS_BAR + 16384;
constexpr size_t WS_GDW = WS_GDU + (size_t)TS * 512 * 2;
constexpr size_t WS_GDA = WS_GDW + (size_t)TS * 512 * 2;
constexpr size_t WS_END = WS_GDA + (size_t)TS * 256 * 2;
static_assert(WS_END <= (size_t)512 * 1024 * 1024, "workspace budget");

struct Params { const float* in[31]; float* out; unsigned char* ws; int ph_lo, ph_hi; };

__device__ __forceinline__ int ltid() { int t = threadIdx.x; asm volatile("" : "+v"(t)); return t; }
__device__ __forceinline__ int lbid() { int t = blockIdx.x; asm volatile("" : "+s"(t)); return t; }
__device__ __forceinline__ int lgdim() { int t = gridDim.x; asm volatile("" : "+s"(t)); return t; }
__device__ __forceinline__ int zz() { int z; asm volatile("s_mov_b32 %0, 0" : "=s"(z)); return z; }
template <class P> __device__ __forceinline__ P* lptr(P* q) { asm volatile("" : "+s"(q)); return q; }
__device__ __forceinline__ float bf2f(unsigned short b) { return __uint_as_float(((unsigned)b) << 16); }
__device__ __forceinline__ unsigned cvt_pk_bf16(float lo, float hi) { unsigned r; asm("v_cvt_pk_bf16_f32 %0, %1, %2" : "=v"(r) : "v"(lo), "v"(hi)); return r; }
__device__ __forceinline__ unsigned short f2bf(float f) { return (unsigned short)(cvt_pk_bf16(f, 0.f) & 0xffffu); }
__device__ __forceinline__ float lo_bf(unsigned w) { return __uint_as_float(w << 16); }
__device__ __forceinline__ float hi_bf(unsigned w) { return __uint_as_float(w & 0xffff0000u); }
__device__ __forceinline__ float sigmoidf_(float x) { return __builtin_amdgcn_rcpf(1.0f + __expf(-x)); }
__device__ __forceinline__ float siluf_(float x) { return x * __builtin_amdgcn_rcpf(1.0f + __expf(-x)); }
__device__ __forceinline__ float geluf_(float x) { const float u = 1.5957691216057308f * (x + 0.044715f * x * x * x); return x * __builtin_amdgcn_rcpf(1.0f + __expf(-u)); }
__device__ __forceinline__ float softplusf_(float x) { return fmaxf(x, 0.f) + log1pf(__expf(-fabsf(x))); }
__device__ __forceinline__ float wave_sum(float v) {
#pragma unroll
    for (int o = 1; o < 64; o <<= 1) v += __shfl_xor(v, o);
    return v;
}


#define XB_TMO      128
#define XB_XCNT(j)  (256  + 64 * (j))
#define XB_XSUB(j)  (1280 + 64 * (j))
#define XB_XGEN(j)  (2304 + 64 * (j))
#define XB_TOP      3328
#define XB_TOPGEN   3392
#define XCD_BAR_WORDS 3456
#define XB_SPIN_CAP (1u << 22)
__device__ __forceinline__ unsigned xb_ld(unsigned* p)              { return __hip_atomic_load(p, __ATOMIC_RELAXED, __HIP_MEMORY_SCOPE_AGENT); }
__device__ __forceinline__ unsigned xb_add(unsigned* p, unsigned v) { return __hip_atomic_fetch_add(p, v, __ATOMIC_RELAXED, __HIP_MEMORY_SCOPE_AGENT); }
__device__ __forceinline__ unsigned xb_xcc_id() { return (unsigned)__builtin_amdgcn_s_getreg((3 << 11) | 20) & 0xFu; }
#define XB_SPIN(cond, bar) do { unsigned _sp = 0; while (cond) { __builtin_amdgcn_s_sleep(1); \
    if ((++_sp & 255u) == 0u) { if (xb_ld(&(bar)[XB_TMO])) break; if (_sp > XB_SPIN_CAP) { atomicAdd(&(bar)[XB_TMO], 1u); break; } } } } while (0)
struct XcdBarrier { unsigned* bar; unsigned x; volatile LAS unsigned* st; };
__device__ __forceinline__ XcdBarrier xcd_barrier_post(unsigned* bar, volatile LAS unsigned* st) {
    XcdBarrier b; b.bar = bar; b.x = xb_xcc_id(); b.st = st;
    if (threadIdx.x == 0) (void)xb_add(&bar[XB_XCNT(b.x)], 1u);
    return b;
}
__device__ __forceinline__ void xcd_barrier_complete(unsigned* bar, unsigned x, unsigned& nloc, unsigned& nx) {
    const unsigned G = gridDim.x * gridDim.y * gridDim.z;
    unsigned sum, cnt, mine, sp = 0u;
    for (;;) {
        sum = 0u; cnt = 0u; mine = 0u;
#pragma unroll
        for (unsigned j = 0; j < 16; ++j) { const unsigned c = xb_ld(&bar[XB_XCNT(j)]); sum += c; cnt += (c > 0u) ? 1u : 0u; mine = (j == x) ? c : mine; }
        if (sum == G) break;
        __builtin_amdgcn_s_sleep(1);
        if ((++sp & 255u) == 0u) { if (xb_ld(&bar[XB_TMO])) break; if (sp > XB_SPIN_CAP) { atomicAdd(&bar[XB_TMO], 1u); break; } }
    }
    nloc = mine > 0u ? mine : 1u; nx = cnt > 0u ? cnt : 1u;
}
__device__ __forceinline__ void xcd_barrier(const XcdBarrier& b) {
    asm volatile("s_waitcnt vmcnt(0)" ::: "memory");
    __syncthreads();
    if (threadIdx.x == 0) {
        unsigned* bar = b.bar;
        __builtin_amdgcn_s_waitcnt(0);
        unsigned nloc = b.st[0], nx = b.st[1];
        if (nloc == 0u) { xcd_barrier_complete(bar, b.x, nloc, nx); b.st[0] = nloc; b.st[1] = nx; }
        const unsigned old = xb_add(&bar[XB_XSUB(b.x)], 1u);
        const unsigned gen = old / nloc;
        if (old + 1u == (gen + 1u) * nloc) {
            __builtin_amdgcn_fence(__ATOMIC_RELEASE, "agent");
            asm volatile("s_waitcnt vmcnt(0)" ::: "memory");
            const unsigned og = xb_add(&bar[XB_TOP], 1u);
            const unsigned tg = og / nx;
            if (og + 1u == (tg + 1u) * nx) xb_add(&bar[XB_TOPGEN], 1u);
            else XB_SPIN(xb_ld(&bar[XB_TOPGEN]) == tg, bar);
            __builtin_amdgcn_fence(__ATOMIC_ACQUIRE, "agent");
            xb_add(&bar[XB_XGEN(b.x)], 1u);
            asm volatile("s_waitcnt vmcnt(0)" ::: "memory");
        } else {
            XB_SPIN(xb_ld(&bar[XB_XGEN(b.x)]) == gen, bar);
            __builtin_amdgcn_fence(__ATOMIC_ACQUIRE, "agent");
            asm volatile("s_waitcnt vmcnt(0)" ::: "memory");
        }
    }
    __syncthreads();
}

namespace pg8 {
constexpr int BM = 256, BK = 64, HALF = 128, HTB = HALF * BK * 2, STAGE_BYTES = 8 * HTB, NXCD = 8, WGM = 8;
__host__ __device__ __forceinline__ int lds_byte(int r, int c) { const int st = (r >> 4) * 2 + (c >> 5), rr = r & 15, cc = c & 31, ob = rr * 64 + cc * 2; return st * 1024 + (ob ^ (((ob >> 9) & 1) << 5)); }
__host__ __device__ __forceinline__ void stage_rc(int b, int& R, int& C) { const int st = b / 1024, sb = b % 1024, swz = sb ^ (((sb >> 9) & 1) << 5); R = (st >> 1) * 16 + swz / 64; C = (st & 1) * 32 + (swz % 64) / 2; }
__host__ __device__ __forceinline__ int perm32(int rho) { const int n = rho >> 4, i = rho & 15; return 8 * (i >> 2) + 4 * n + (i & 3); }

struct Unit { int pm, pn, g; };
struct Gemm { const bf16_t* A; const bf16_t* Bt; int M, N, K; size_t gsA, gsB; };

__device__ __forceinline__ void tile_of(int wgid, int nM, int nN, int nwg, Unit& u) {
    { const int q = nwg / NXCD, r = nwg % NXCD, xcd = wgid % NXCD, off = wgid / NXCD; wgid = (xcd < r ? xcd * (q + 1) : r * (q + 1) + (xcd - r) * q) + off; }
    const int nig = WGM * nN, gid = wgid / nig, fm = gid * WGM, gsz = (nM - fm) < WGM ? (nM - fm) : WGM;
    u.pm = fm + ((wgid % nig) % gsz); u.pn = (wgid % nig) / gsz;
}
struct StaticOrder {
    int nM, nN, nwg, G, c;
    __device__ void init(int M, int N, int G_, int c_) { nM = M / BM; nN = N / BM; nwg = nM * nN; G = G_; c = c_; }
    __device__ bool next(int i, Unit& u) const {
        const long L = (long)i * G + c; if (L >= nwg) return false;
        tile_of((int)L, nM, nN, nwg, u); u.g = 0; return true;
    }
};
struct BranchOrder {
    int nM, nN, nwg, G, c;
    __device__ void init(int M, int N, int G_, int c_) { nM = M / BM; nN = N / BM; nwg = nM * nN; G = G_; c = c_; }
    __device__ bool next(int i, Unit& u) const {
        const long L = (long)(i >> 2) * G + c; if (L >= nwg) return false;
        tile_of((int)L, nM, nN, nwg, u); u.g = i & 3; return true;
    }
};

struct EpiSwiGLU {
    static constexpr bool PERM = true;
    bf16_t* O;
    __device__ __forceinline__ bool keep(const Unit&) const { return false; }
    __device__ __forceinline__ void operator()(f32x4 (&acc)[2][2][4][2], const Unit& u, int wr, int wc, int fr, int fq) const {
        const int row0 = u.pm * BM + wr * 64 + fr, col0 = u.pn * 128 + wc * 32 + 8 * fq;
#pragma unroll
        for (int ai = 0; ai < 2; ++ai)
#pragma unroll
            for (int m = 0; m < 4; ++m) {
                bf16_t* rowp = O + (size_t)(row0 + ai * HALF + m * 16) * DFF + col0;
                float v[8];
#pragma unroll
                for (int n = 0; n < 2; ++n)
#pragma unroll
                    for (int j = 0; j < 4; ++j) v[n * 4 + j] = siluf_(acc[ai][0][m][n][j]) * acc[ai][1][m][n][j];
                u32x4 w; w.x = cvt_pk_bf16(v[0], v[1]); w.y = cvt_pk_bf16(v[2], v[3]); w.z = cvt_pk_bf16(v[4], v[5]); w.w = cvt_pk_bf16(v[6], v[7]);
                *(u32x4*)rowp = w;
                __builtin_amdgcn_sched_barrier(0);
            }
    }
};
struct EpiResid {
    static constexpr bool PERM = false;
    const float* Xin; float* Xout; float scale;
    __device__ __forceinline__ bool keep(const Unit&) const { return false; }
    __device__ __forceinline__ void operator()(f32x4 (&acc)[2][2][4][2], const Unit& u, int wr, int wc, int fr, int fq) const {
        const int row0 = u.pm * BM + wr * 64 + fr, col0 = u.pn * BM + wc * 32 + 4 * fq;
#pragma unroll
        for (int ai = 0; ai < 2; ++ai) {
            f32x4 xi[4][2][2];
#pragma unroll
            for (int m = 0; m < 4; ++m) { const size_t ro = (size_t)(row0 + ai * HALF + m * 16) * D + col0;
#pragma unroll
                for (int bj = 0; bj < 2; ++bj)
#pragma unroll
                    for (int n = 0; n < 2; ++n) xi[m][bj][n] = *(const f32x4*)(Xin + ro + bj * HALF + n * 16); }
#pragma unroll
            for (int m = 0; m < 4; ++m) { const size_t ro = (size_t)(row0 + ai * HALF + m * 16) * D + col0;
#pragma unroll
                for (int bj = 0; bj < 2; ++bj)
#pragma unroll
                    for (int n = 0; n < 2; ++n) *(f32x4*)(Xout + ro + bj * HALF + n * 16) = xi[m][bj][n] + acc[ai][bj][m][n] * scale; }
            __builtin_amdgcn_sched_barrier(0);
        }
    }
};
struct EpiProj {
    static constexpr bool PERM = true;
    bf16_t* O; float* AB;
    __device__ __forceinline__ bool keep(const Unit&) const { return false; }
    __device__ __forceinline__ void operator()(f32x4 (&acc)[2][2][4][2], const Unit& u, int wr, int wc, int fr, int fq) const {
        const int row0 = u.pm * BM + wr * 64 + fr, col0 = u.pn * BM + wc * 32 + 8 * fq;
        const bool ab = (u.pn == PC_AB / BM) && wc == 0 && fq == 0;
#pragma unroll
        for (int ai = 0; ai < 2; ++ai)
#pragma unroll
            for (int m = 0; m < 4; ++m) {
                const int row = row0 + ai * HALF + m * 16;
                bf16_t* rowp = O + (size_t)row * PW + col0;
#pragma unroll
                for (int bj = 0; bj < 2; ++bj) {
                    const f32x4 v0 = acc[ai][bj][m][0], v1 = acc[ai][bj][m][1];
                    u32x4 w; w.x = cvt_pk_bf16(v0[0], v0[1]); w.y = cvt_pk_bf16(v0[2], v0[3]); w.z = cvt_pk_bf16(v1[0], v1[1]); w.w = cvt_pk_bf16(v1[2], v1[3]);
                    *(u32x4*)(rowp + bj * HALF) = w;
                }
                __builtin_amdgcn_sched_barrier(0);
            }
        if (ab) {
#pragma unroll
            for (int ai = 0; ai < 2; ++ai)
#pragma unroll
                for (int m = 0; m < 4; ++m) { const int row = row0 + ai * HALF + m * 16; *(f32x4*)(AB + (size_t)row * 8) = acc[ai][0][m][0]; *(f32x4*)(AB + (size_t)row * 8 + 4) = acc[ai][0][m][1]; }
        }
    }
};
struct EpiBranch {
    static constexpr bool PERM = true;
    const bf16_t* P; bf16_t* O;
    __device__ __forceinline__ bool keep(const Unit& u) const { return u.g < 3; }
    __device__ __forceinline__ void operator()(f32x4 (&acc)[2][2][4][2], const Unit& u, int wr, int wc, int fr, int fq) const {
        const int row0 = u.pm * BM + wr * 64 + fr, col0 = u.pn * BM + wc * 32 + 8 * fq;
        const bool last = (u.g == 3);
#pragma unroll
        for (int ai = 0; ai < 2; ++ai) {
            u32x4 g0[4][2], g1[4][2];
#pragma unroll
            for (int m = 0; m < 4; ++m) { const bf16_t* gp = P + (size_t)(row0 + ai * HALF + m * 16) * PW + PC_GATE + u.g * D + col0;
#pragma unroll
                for (int bj = 0; bj < 2; ++bj) { g0[m][bj] = *(const u32x4*)(gp + bj * HALF); g1[m][bj] = last ? g0[m][bj] : *(const u32x4*)(gp + D + bj * HALF); } }
#pragma unroll
            for (int m = 0; m < 4; ++m) {
                const int row = row0 + ai * HALF + m * 16;
#pragma unroll
                for (int bj = 0; bj < 2; ++bj) {
                    float f[8];
                    if (!last) {
#pragma unroll
                        for (int q = 0; q < 4; ++q) {
                            f[2 * q] = (1.0f + __expf(-lo_bf(g1[m][bj][q]))) * __builtin_amdgcn_rcpf(1.0f + __expf(-lo_bf(g0[m][bj][q])));
                            f[2 * q + 1] = (1.0f + __expf(-hi_bf(g1[m][bj][q]))) * __builtin_amdgcn_rcpf(1.0f + __expf(-hi_bf(g0[m][bj][q])));
                        }
                    } else {
#pragma unroll
                        for (int q = 0; q < 4; ++q) { f[2 * q] = __builtin_amdgcn_rcpf(1.0f + __expf(-lo_bf(g0[m][bj][q]))); f[2 * q + 1] = __builtin_amdgcn_rcpf(1.0f + __expf(-hi_bf(g0[m][bj][q]))); }
                    }
#pragma unroll
                    for (int n = 0; n < 2; ++n)
#pragma unroll
                        for (int j = 0; j < 4; ++j) acc[ai][bj][m][n][j] *= f[n * 4 + j];
                    if (last) {
                        const f32x4 v0 = acc[ai][bj][m][0], v1 = acc[ai][bj][m][1];
                        u32x4 w; w.x = cvt_pk_bf16(v0[0], v0[1]); w.y = cvt_pk_bf16(v0[2], v0[3]); w.z = cvt_pk_bf16(v1[0], v1[1]); w.w = cvt_pk_bf16(v1[2], v1[3]);
                        *(u32x4*)(O + (size_t)row * D + col0 + bj * HALF) = w;
                    }
                }
            }
            __builtin_amdgcn_sched_barrier(0);
        }
    }
};

template <class Epi, class Sched>
__device__ __forceinline__ void gemm_phase(LAS unsigned char* lds, const Gemm g, const Sched& S, const Epi& E) {
    const int tid = ltid(), wid = __builtin_amdgcn_readfirstlane(tid >> 6), lane = tid & 63, wr = wid >> 2, wc = wid & 3, fr = lane & 15, fq = lane >> 4;
    const int K = g.K, nt = K / BK;
    unsigned voffA[2], voffB[2];
#pragma unroll
    for (int i = 0; i < 2; ++i) { int R, C; stage_rc(tid * 16 + i * 8192, R, C); const int Rb = Epi::PERM ? ((R & ~31) + perm32(R & 31)) : R;
        voffA[i] = (unsigned)(R * K + C) * 2u; voffB[i] = (unsigned)(Rb * K + C) * 2u; }
    const size_t kstep = (size_t)(BK * 2);
    const size_t hstep = (size_t)HALF * K * 2;
    const size_t tstep = 2 * hstep;
    const unsigned ldsw = (unsigned)wid * 1024u;
    const int aoff = lds_byte(wr * 64 + fr, fq * 8), boff = lds_byte(wc * 32 + fr, fq * 8);
#define PG8_SA(b, h) (((b) * 2 + (h)) * HTB)
#define PG8_SB(b, h) ((4 + (b) * 2 + (h)) * HTB)
#define PG8_STAGE(bufoff, gbase, voff) do { _Pragma("unroll") for (int _i = 0; _i < 2; ++_i) \
        __builtin_amdgcn_global_load_lds((const unsigned*)((const char*)(gbase) + (voff)[_i]), (LAS unsigned*)(lds + (bufoff) + ldsw + _i * 8192), 16, 0, 0); } while (0)
#define PG8_LDA(dst, b, h) do { _Pragma("unroll") for (int m = 0; m < 4; ++m) _Pragma("unroll") for (int k = 0; k < 2; ++k) dst[m][k] = *(const LAS bf16x8*)(lds + PG8_SA(b, h) + aoff + m * 2048 + k * 1024); } while (0)
#define PG8_LDB(dst, b, h) do { _Pragma("unroll") for (int n = 0; n < 2; ++n) _Pragma("unroll") for (int k = 0; k < 2; ++k) dst[n][k] = *(const LAS bf16x8*)(lds + PG8_SB(b, h) + boff + n * 2048 + k * 1024); } while (0)
#define PG8_MMA(ai, bj, At, Bt) do { __builtin_amdgcn_s_setprio(1); _Pragma("unroll") for (int m = 0; m < 4; ++m) _Pragma("unroll") for (int n = 0; n < 2; ++n) _Pragma("unroll") for (int k = 0; k < 2; ++k) \
        acc[ai][bj][m][n] = __builtin_amdgcn_mfma_f32_16x16x32_bf16(Bt[n][k], At[m][k], acc[ai][bj][m][n], 0, 0, 0); __builtin_amdgcn_s_setprio(0); } while (0)
#define PG8_WAIT_V(n) asm volatile("s_waitcnt vmcnt(" #n ")" ::: "memory")
#define PG8_WAIT_L(n) asm volatile("s_waitcnt lgkmcnt(" #n ")" ::: "memory")
#define PG8_BAR __builtin_amdgcn_s_barrier()
#define PG8_SCHED __builtin_amdgcn_sched_barrier(0)
    Unit cur, nxt; int ui = 0;
    if (!S.next(0, cur)) return;
    f32x4 acc[2][2][4][2];
#pragma unroll
    for (int a = 0; a < 2; ++a)
#pragma unroll
        for (int b = 0; b < 2; ++b)
#pragma unroll
            for (int m = 0; m < 4; ++m)
#pragma unroll
                for (int n = 0; n < 2; ++n) acc[a][b][m][n] = (f32x4){0.f, 0.f, 0.f, 0.f};
    bf16x8 At[4][2], B0[2][2], B1[2][2];
    const char* cA = (const char*)g.A + (size_t)cur.g * g.gsA + (size_t)cur.pm * tstep; const char* cB = (const char*)g.Bt + (size_t)cur.g * g.gsB + (size_t)cur.pn * tstep;
    PG8_STAGE(PG8_SB(0, 0), cB, voffB); PG8_STAGE(PG8_SA(0, 0), cA, voffA); PG8_STAGE(PG8_SB(0, 1), cB + hstep, voffB); PG8_STAGE(PG8_SA(0, 1), cA + hstep, voffA);
    if (wr == 1) PG8_BAR;
    PG8_WAIT_V(4); PG8_BAR;
    PG8_STAGE(PG8_SB(1, 0), cB + kstep, voffB); PG8_STAGE(PG8_SA(1, 0), cA + kstep, voffA); PG8_STAGE(PG8_SB(1, 1), cB + hstep + kstep, voffB);
    PG8_WAIT_V(6); PG8_BAR;
    for (;;) {
        const bool has_next = S.next(ui + 1, nxt);
        const char* nA = has_next ? (const char*)g.A + (size_t)nxt.g * g.gsA + (size_t)nxt.pm * tstep : cA; const char* nB = has_next ? (const char*)g.Bt + (size_t)nxt.g * g.gsB + (size_t)nxt.pn * tstep : cB;
        for (int t = 0; t < nt; t += 2) {
            const bool last = (t == nt - 2);
            const char* a1 = cA + (size_t)(t + 1) * kstep;
            const char* a2 = last ? nA : cA + (size_t)(t + 2) * kstep; const char* b2 = last ? nB : cB + (size_t)(t + 2) * kstep;
            const char* a3 = a2 + kstep; const char* b3 = b2 + kstep;
            PG8_LDB(B0, 0, 0); PG8_SCHED; PG8_LDA(At, 0, 0); PG8_STAGE(PG8_SA(1, 1), a1 + hstep, voffA);
            PG8_WAIT_L(8); PG8_BAR; PG8_WAIT_L(0); PG8_MMA(0, 0, At, B0); PG8_BAR; PG8_SCHED;
            PG8_LDB(B1, 0, 1); PG8_STAGE(PG8_SB(0, 0), b2, voffB);
            PG8_BAR; PG8_WAIT_L(0); PG8_MMA(0, 1, At, B1); PG8_BAR;
            PG8_LDA(At, 0, 1); PG8_STAGE(PG8_SA(0, 0), a2, voffA);
            PG8_BAR; PG8_WAIT_L(0); PG8_MMA(1, 0, At, B0); PG8_BAR; PG8_SCHED;
            PG8_STAGE(PG8_SB(0, 1), b2 + hstep, voffB);
            PG8_WAIT_V(6); PG8_BAR; PG8_MMA(1, 1, At, B1); PG8_BAR;
            PG8_LDB(B0, 1, 0); PG8_SCHED; PG8_LDA(At, 1, 0); PG8_STAGE(PG8_SA(0, 1), a2 + hstep, voffA);
            PG8_WAIT_L(8); PG8_BAR; PG8_WAIT_L(0); PG8_MMA(0, 0, At, B0); PG8_BAR; PG8_SCHED;
            PG8_LDB(B1, 1, 1); PG8_STAGE(PG8_SB(1, 0), b3, voffB);
            PG8_BAR; PG8_WAIT_L(0); PG8_MMA(0, 1, At, B1); PG8_BAR;
            PG8_LDA(At, 1, 1); PG8_STAGE(PG8_SA(1, 0), a3, voffA);
            PG8_BAR; PG8_WAIT_L(0); PG8_MMA(1, 0, At, B0); PG8_BAR; PG8_SCHED;
            PG8_STAGE(PG8_SB(1, 1), b3 + hstep, voffB);
            PG8_WAIT_V(6); PG8_BAR; PG8_MMA(1, 1, At, B1); PG8_BAR;
        }
        E(acc, cur, wr, wc, fr, fq);
        if (!has_next) break;
        if (!E.keep(cur)) {
#pragma unroll
            for (int a = 0; a < 2; ++a)
#pragma unroll
                for (int b = 0; b < 2; ++b)
#pragma unroll
                    for (int m = 0; m < 4; ++m)
#pragma unroll
                        for (int n = 0; n < 2; ++n) acc[a][b][m][n] = (f32x4){0.f, 0.f, 0.f, 0.f};
        }
        cur = nxt; cA = nA; cB = nB; ++ui;
    }
    PG8_WAIT_V(0);
    if (wr == 0) PG8_BAR;
    PG8_BAR;
#undef PG8_SA
#undef PG8_SB
#undef PG8_STAGE
#undef PG8_LDA
#undef PG8_LDB
#undef PG8_MMA
#undef PG8_WAIT_V
#undef PG8_WAIT_L
#undef PG8_BAR
#undef PG8_SCHED
}
}


#define NOINL __forceinline__
__device__ NOINL void ph_gemm_swiglu(LAS unsigned char* lds, const bf16_t* A, const bf16_t* Bt, bf16_t* O) {
    pg8::Gemm g{A, Bt, T, 2 * DFF, D, 0, 0}; pg8::StaticOrder S; S.init(g.M, g.N, lgdim(), lbid()); pg8::EpiSwiGLU E{O}; pg8::gemm_phase(lds, g, S, E);
}
__device__ NOINL void ph_gemm_resid(LAS unsigned char* lds, const bf16_t* A, const bf16_t* Bt, int M, int K, const float* Xin, float* Xout, float scale) {
    pg8::Gemm g{A, Bt, M, D, K, 0, 0}; pg8::StaticOrder S; S.init(g.M, g.N, lgdim(), lbid()); pg8::EpiResid E{Xin, Xout, scale}; pg8::gemm_phase(lds, g, S, E);
}
__device__ NOINL void ph_gemm_proj(LAS unsigned char* lds, const bf16_t* A, const bf16_t* Bt, bf16_t* O, float* AB) {
    pg8::Gemm g{A, Bt, TS, PW, D, 0, 0}; pg8::StaticOrder S; S.init(g.M, g.N, lgdim(), lbid()); pg8::EpiProj E{O, AB}; pg8::gemm_phase(lds, g, S, E);
}
__device__ NOINL void ph_gemm_branch(LAS unsigned char* lds, const bf16_t* A, const bf16_t* Bt, const bf16_t* P, bf16_t* O) {
    pg8::Gemm g{A, Bt, TS, D, 512, (size_t)TS * 512 * 2, (size_t)D * 512 * 2}; pg8::BranchOrder S; S.init(g.M, g.N, lgdim(), lbid()); pg8::EpiBranch E{P, O}; pg8::gemm_phase(lds, g, S, E);
}

struct ConvTask { const float* src0; const float* src1; bf16_t* dst; int K, Nsrc, mode, tile; };
__device__ __forceinline__ ConvTask conv_task(const Params& p, int l, int it) {
    unsigned char* ws = lptr(p.ws);
    constexpr int N1 = 16 * 88, N2 = 44 * 16, N3 = 16 * 140, N4 = 8 * 16, N5 = 16 * 16;
    ConvTask t; t.src1 = nullptr;
    int r = it;
    if (r < N1) { t.src0 = p.in[zz() + 2] + (size_t)l * D * DFF; t.src1 = p.in[zz() + 3] + (size_t)l * D * DFF; t.K = D; t.Nsrc = DFF; t.dst = (bf16_t*)(ws + WS_WGU1); t.mode = 1; t.tile = r; return t; } r -= N1;
    if (r < N2) { t.src0 = p.in[zz() + 4] + (size_t)l * DFF * D; t.K = DFF; t.Nsrc = D; t.dst = (bf16_t*)(ws + WS_WD1); t.mode = 0; t.tile = r; return t; } r -= N2;
    if (r < N3) { t.src0 = p.in[zz() + 6] + (size_t)l * D * PIN; t.K = D; t.Nsrc = PIN; t.dst = (bf16_t*)(ws + WS_WIN); t.mode = 2; t.tile = r; return t; } r -= N3;
    if (r < 4 * N4) { const int g = r / N4; t.src0 = p.in[zz() + 24] + ((size_t)l * 4 + g) * 512 * D; t.K = 512; t.Nsrc = D; t.dst = (bf16_t*)(ws + WS_WB) + (size_t)g * D * 512; t.mode = 0; t.tile = r % N4; return t; } r -= 4 * N4;
    if (r < N5) { t.src0 = p.in[zz() + 25] + (size_t)l * D * D; t.K = D; t.Nsrc = D; t.dst = (bf16_t*)(ws + WS_WOUT); t.mode = 0; t.tile = r; return t; } r -= N5;
    if (r < N1) { t.src0 = p.in[zz() + 27] + (size_t)l * D * DFF; t.src1 = p.in[zz() + 28] + (size_t)l * D * DFF; t.K = D; t.Nsrc = DFF; t.dst = (bf16_t*)(ws + WS_WGU2); t.mode = 1; t.tile = r; return t; } r -= N1;
    t.src0 = p.in[zz() + 29] + (size_t)l * DFF * D; t.K = DFF; t.Nsrc = D; t.dst = (bf16_t*)(ws + WS_WD2); t.mode = 0; t.tile = r; return t;
}
__device__ __forceinline__ void conv_load(const ConvTask& t, int tid, f32x4& a, f32x4& b) {
    const int nkt = t.K / 64, kt = t.tile % nkt, rt = t.tile / nkt, k0 = kt * 64, r0 = rt * 64;
    const int kk = tid >> 3, rr = (tid & 7) * 8, rho = r0 + rr;
    const float* src = t.src0; int col = rho;
    if (t.mode == 1) { const int pn = rho >> 8, bj = (rho >> 7) & 1, j = rho & 127; col = pn * 128 + j; src = bj ? t.src1 : t.src0; }
    else if (t.mode == 2) { col = rho < 4096 ? rho : (rho < 8704 ? rho + 8 : (rho < 8712 ? rho - 8704 + 4096 : -1)); }
    a = (f32x4){0.f, 0.f, 0.f, 0.f}; b = a;
    if (col >= 0) { const float* sp = src + (size_t)(k0 + kk) * t.Nsrc + col; a = *(const f32x4*)sp; b = *(const f32x4*)(sp + 4); }
}
__device__ __forceinline__ void conv_store(LAS float* scr, const ConvTask& t, int tid, const f32x4& a, const f32x4& b) {
    const int nkt = t.K / 64, kt = t.tile % nkt, rt = t.tile / nkt, k0 = kt * 64, r0 = rt * 64;
    { const int kk = tid >> 3, rr = (tid & 7) * 8;
#pragma unroll
        for (int e = 0; e < 4; ++e) { scr[(rr + e) * 65 + kk] = a[e]; scr[(rr + 4 + e) * 65 + kk] = b[e]; } }
    __syncthreads();
    { const int rl = tid >> 3, kc = (tid & 7) * 8;
        const LAS float* s = scr + rl * 65 + kc;
        u32x4 w; w.x = cvt_pk_bf16(s[0], s[1]); w.y = cvt_pk_bf16(s[2], s[3]); w.z = cvt_pk_bf16(s[4], s[5]); w.w = cvt_pk_bf16(s[6], s[7]);
        *(u32x4*)(t.dst + (size_t)(r0 + rl) * t.K + k0 + kc) = w; }
    __syncthreads();
}

__device__ __forceinline__ void convert_layer(LAS unsigned char* lds, const Params& p, int l) {
    LAS float* scr = (LAS float*)lds;
    unsigned char* ws = lptr(p.ws);
    constexpr int N1 = 16 * 88, N2 = 44 * 16, N3 = 16 * 140, N4 = 8 * 16, N5 = 16 * 16;
    constexpr int TOT = N1 + N2 + N3 + 4 * N4 + N5 + N1 + N2;
    const int tid = ltid(), G = lgdim();
    int it = lbid();
    if (it < TOT) {
        ConvTask cur = conv_task(p, l, it);
        f32x4 a, b; conv_load(cur, tid, a, b);
        for (;;) {
            const int nx = it + G; const bool more = nx < TOT;
            ConvTask nxt = cur; f32x4 na = a, nb = b;
            if (more) { nxt = conv_task(p, l, nx); conv_load(nxt, tid, na, nb); }
            conv_store(scr, cur, tid, a, b);
            if (!more) break;
            cur = nxt; a = na; b = nb; it = nx;
        }
    }
    bf16_t* waxt = (bf16_t*)(ws + WS_WAXT); bf16_t* pwt = (bf16_t*)(ws + WS_PWT);
    const float* wa = p.in[zz() + 13] + (size_t)l * 8 * 64 * 64; const float* wx = p.in[zz() + 15] + (size_t)l * 8 * 64 * 64; const float* pw = p.in[zz() + 22] + (size_t)l * 4 * 128 * 128;
    for (int e = lbid() * NTHR + ltid(); e < 65536; e += lgdim() * NTHR) {
        { const int h = e >> 13, jp = (e >> 6) & 127, i = e & 63; waxt[e] = f2bf(jp < 64 ? wa[(h * 64 + i) * 64 + jp] : wx[(h * 64 + i) * 64 + jp - 64]); }
        { const int g = e >> 14, d = (e >> 7) & 127, c = e & 127; pwt[e] = f2bf(pw[(g * 128 + c) * 128 + d]); }
    }
}

__device__ __forceinline__ void rms_rows_bf16(const float* X, const float* gain, bf16_t* H, int nrows) {
    const int wid = ltid() >> 6, lane = ltid() & 63;
    f32x4 gv[4];
#pragma unroll
    for (int j = 0; j < 4; ++j) gv[j] = *(const f32x4*)(gain + (lane + 64 * j) * 4);
    for (int row0 = (lbid() * 8 + wid) * 4; row0 < nrows; row0 += lgdim() * 32) {
        f32x4 v[4][4];
#pragma unroll
        for (int r = 0; r < 4; ++r) { const f32x4* xr = (const f32x4*)(X + (size_t)min(row0 + r, nrows - 1) * D) + lane;
#pragma unroll
            for (int j = 0; j < 4; ++j) v[r][j] = xr[64 * j]; }
#pragma unroll
        for (int r = 0; r < 4; ++r) {
            float s = 0.f;
#pragma unroll
            for (int j = 0; j < 4; ++j) s += (v[r][j].x * v[r][j].x + v[r][j].y * v[r][j].y) + (v[r][j].z * v[r][j].z + v[r][j].w * v[r][j].w);
            const float rs = rsqrtf(wave_sum(s) * (1.0f / D) + EPS);
            u32x2* o = (u32x2*)(H + (size_t)(row0 + r) * D) + lane;
            if (row0 + r < nrows)
#pragma unroll
            for (int j = 0; j < 4; ++j) { u32x2 w; w.x = cvt_pk_bf16(v[r][j].x * rs * gv[j].x, v[r][j].y * rs * gv[j].y); w.y = cvt_pk_bf16(v[r][j].z * rs * gv[j].z, v[r][j].w * rs * gv[j].w); o[64 * j] = w; }
        }
    }
}
__device__ __forceinline__ void rms_rows_f32_inplace(float* X, const float* gain, int nrows) {
    const int wid = ltid() >> 6, lane = ltid() & 63;
    f32x4 gv[4];
#pragma unroll
    for (int j = 0; j < 4; ++j) gv[j] = *(const f32x4*)(gain + (lane + 64 * j) * 4);
    for (int row0 = (lbid() * 8 + wid) * 4; row0 < nrows; row0 += lgdim() * 32) {
        f32x4 v[4][4];
#pragma unroll
        for (int r = 0; r < 4; ++r) { const f32x4* xr = (const f32x4*)(X + (size_t)min(row0 + r, nrows - 1) * D) + lane;
#pragma unroll
            for (int j = 0; j < 4; ++j) v[r][j] = xr[64 * j]; }
#pragma unroll
        for (int r = 0; r < 4; ++r) {
            float s = 0.f;
#pragma unroll
            for (int j = 0; j < 4; ++j) s += (v[r][j].x * v[r][j].x + v[r][j].y * v[r][j].y) + (v[r][j].z * v[r][j].z + v[r][j].w * v[r][j].w);
            const float rs = rsqrtf(wave_sum(s) * (1.0f / D) + EPS);
            f32x4* xo = (f32x4*)(X + (size_t)(row0 + r) * D) + lane;
            if (row0 + r < nrows)
#pragma unroll
            for (int j = 0; j < 4; ++j) xo[64 * j] = v[r][j] * rs * gv[j];
        }
    }
}

__device__ __forceinline__ void sgu_tile(LAS unsigned char* lds, const Params& p, int l, const bf16_t* proj, bf16_t* ya, int tile) {
    const int tid = ltid(), wid = tid >> 6, lane = tid & 63, fr = lane & 15, fq = lane >> 4;
    const int blk = tile >> 2, g = tile & 3, r0 = blk * 128;
    LAS bf16_t* Wl = (LAS bf16_t*)lds;
    LAS bf16_t* VT = (LAS bf16_t*)(lds + 34816);
    const float* lng = p.in[zz() + 7] + l * 512 + g * 128; const float* lnb = p.in[zz() + 8] + l * 512 + g * 128;
    {
        const int i = tid >> 2, qd = tid & 3;
        const bf16_t* vrow = proj + (size_t)(r0 + i) * PW + PC_AV + qd * 8;
        float s = 0.f, s2 = 0.f;
#pragma unroll 4
        for (int e8 = 0; e8 < 16; ++e8) { const u32x4 w = *(const u32x4*)(vrow + e8 * 32);
#pragma unroll
            for (int q = 0; q < 4; ++q) { const float a = geluf_(lo_bf(w[q])), b = geluf_(hi_bf(w[q])); s += a + b; s2 += a * a + b * b; } }
        s += __shfl_xor(s, 1); s += __shfl_xor(s, 2); s2 += __shfl_xor(s2, 1); s2 += __shfl_xor(s2, 2);
        const float mean = s * (1.0f / 512.0f), var = fmaxf(s2 * (1.0f / 512.0f) - mean * mean, 0.f), rstd = rsqrtf(var + EPS);
        const bf16_t* vg = proj + (size_t)(r0 + i) * PW + PC_AV + g * 128 + qd * 8;
#pragma unroll
        for (int e8 = 0; e8 < 4; ++e8) { const u32x4 w = *(const u32x4*)(vg + e8 * 32);
#pragma unroll
            for (int q = 0; q < 4; ++q) { const int c = e8 * 32 + qd * 8 + 2 * q;
                VT[c * 136 + i] = f2bf((geluf_(lo_bf(w[q])) - mean) * rstd * lng[c] + lnb[c]);
                VT[(c + 1) * 136 + i] = f2bf((geluf_(hi_bf(w[q])) - mean) * rstd * lng[c + 1] + lnb[c + 1]); } }
        const float* wsrc = p.in[zz() + 9] + (((size_t)l * 4 + g) * 128 + i) * 128 + qd * 32;
#pragma unroll
        for (int e4 = 0; e4 < 8; ++e4) { f32x4 w = *(const f32x4*)(wsrc + e4 * 4); if (i < 64 && qd >= 2) w = (f32x4){0.f, 0.f, 0.f, 0.f};
            u32x2 o; o.x = cvt_pk_bf16(w.x, w.y); o.y = cvt_pk_bf16(w.z, w.w); *(LAS u32x2*)(Wl + i * 136 + qd * 32 + e4 * 4) = o; }
    }
    __syncthreads();
    f32x4 acc[8];
#pragma unroll
    for (int n = 0; n < 8; ++n) acc[n] = (f32x4){0.f, 0.f, 0.f, 0.f};
#pragma unroll
    for (int ks = 0; ks < 4; ++ks) {
        const bf16x8 af = *(const LAS bf16x8*)(Wl + (wid * 16 + fr) * 136 + ks * 32 + fq * 8);
#pragma unroll
        for (int n = 0; n < 8; ++n) { const bf16x8 bf = *(const LAS bf16x8*)(VT + (n * 16 + fr) * 136 + ks * 32 + fq * 8); acc[n] = __builtin_amdgcn_mfma_f32_16x16x32_bf16(bf, af, acc[n], 0, 0, 0); }
    }
    {
        const int i = wid * 16 + fr; const float bias = p.in[zz() + 10][((size_t)l * 4 + g) * 128 + i];
        const bf16_t* up = proj + (size_t)(r0 + i) * PW + PC_AU + g * 128 + fq * 4;
        bf16_t* yp = ya + (size_t)(r0 + i) * 512 + g * 128 + fq * 4;
#pragma unroll
        for (int n = 0; n < 8; ++n) { const u32x2 uw = *(const u32x2*)(up + n * 16);
            u32x2 o; o.x = cvt_pk_bf16((acc[n][0] + bias) * geluf_(lo_bf(uw.x)), (acc[n][1] + bias) * geluf_(hi_bf(uw.x)));
            o.y = cvt_pk_bf16((acc[n][2] + bias) * geluf_(lo_bf(uw.y)), (acc[n][3] + bias) * geluf_(hi_bf(uw.y))); *(u32x2*)(yp + n * 16) = o; }
    }
    __syncthreads();
}

template <int WIN>
__device__ __forceinline__ void pool_rows(LAS bf16_t* Al, const bf16_t* xcol, int c, int pos0) {
    float xv[80];
#pragma unroll
    for (int k = 0; k < 80; ++k) xv[k] = (pos0 - 16 + k >= 0) ? bf2f(xcol[(long)(k - 16) * PW]) : 0.f;
    float s = 0.f;
#pragma unroll
    for (int j = 0; j < WIN; ++j) s += xv[16 - j];
#pragma unroll
    for (int tt = 0; tt < 64; ++tt) {
        const int k = tt + 16;
        const int cnt = min(pos0 + tt + 1, WIN);
        Al[tt * 520 + c] = f2bf(s / (float)cnt - xv[k]);
        if (tt < 63) s += xv[k + 1] - xv[k + 1 - WIN];
    }
}
__device__ __forceinline__ void pool_tile(LAS unsigned char* lds, const Params& p, int l, const bf16_t* proj, bf16_t* yd, bf16_t* halo, const bf16_t* pwt, int tile) {
    const int tid = ltid(), wid = tid >> 6, lane = tid & 63, fr = lane & 15, fq = lane >> 4;
    const int t0 = tile * 64, pos0 = t0 % SEQ;
    LAS bf16_t* Al = (LAS bf16_t*)lds;
    {
        const int c = tid, g = wid >> 1;
        const bf16_t* xcol = proj + (size_t)t0 * PW + PC_DX + c;
        if (g == 0) pool_rows<2>(Al, xcol, c, pos0); else if (g == 1) pool_rows<4>(Al, xcol, c, pos0); else if (g == 2) pool_rows<8>(Al, xcol, c, pos0); else pool_rows<16>(Al, xcol, c, pos0);
    }
    __syncthreads();
    {
        const int g = wid >> 1, nh = wid & 1;
        f32x4 acc[4][4];
#pragma unroll
        for (int m = 0; m < 4; ++m)
#pragma unroll
            for (int n = 0; n < 4; ++n) acc[m][n] = (f32x4){0.f, 0.f, 0.f, 0.f};
#pragma unroll
        for (int ks = 0; ks < 4; ++ks) {
            bf16x8 bfr[4];
#pragma unroll
            for (int n = 0; n < 4; ++n) bfr[n] = *(const bf16x8*)(pwt + ((size_t)(g * 128 + (nh * 4 + n) * 16 + fr)) * 128 + ks * 32 + fq * 8);
#pragma unroll
            for (int m = 0; m < 4; ++m) { const bf16x8 af = *(const LAS bf16x8*)(Al + (m * 16 + fr) * 520 + g * 128 + ks * 32 + fq * 8);
#pragma unroll
                for (int n = 0; n < 4; ++n) acc[m][n] = __builtin_amdgcn_mfma_f32_16x16x32_bf16(bfr[n], af, acc[m][n], 0, 0, 0); }
        }
        const float* sc = p.in[zz() + 23] + l * 512 + g * 128;
#pragma unroll
        for (int n = 0; n < 4; ++n) { const int d = (nh * 4 + n) * 16 + fq * 4; const f32x4 s4 = *(const f32x4*)(sc + d);
#pragma unroll
            for (int m = 0; m < 4; ++m) { u32x2 o; o.x = cvt_pk_bf16(acc[m][n][0] * s4[0], acc[m][n][1] * s4[1]); o.y = cvt_pk_bf16(acc[m][n][2] * s4[2], acc[m][n][3] * s4[3]);
                *(u32x2*)(yd + (size_t)(t0 + m * 16 + fr) * 512 + g * 128 + d) = o; } }
    }
    __syncthreads();
}

__device__ __forceinline__ void lru_tile(LAS unsigned char* lds, const Params& p, int l, const bf16_t* proj, bf16_t* yb, const bf16_t* waxt, float* Aend, float* Hend, const float* carry, int tile, int mode) {
    const int tid = ltid(), wid = tid >> 6, lane = tid & 63, fr = lane & 15, fq = lane >> 4;
    const int t0 = tile * 64, pos0 = t0 % SEQ, c = wid * 64 + lane;
    LAS bf16_t* Aw = (LAS bf16_t*)(lds + wid * 10560);
    LAS float* Xw = (LAS float*)(lds + wid * 10560 + 2304);
    bf16x8 bfr[8][2];
#pragma unroll
    for (int n = 0; n < 8; ++n)
#pragma unroll
        for (int ks = 0; ks < 2; ++ks) bfr[n][ks] = *(const bf16x8*)(waxt + ((size_t)(wid * 128 + n * 16 + fr)) * 64 + ks * 32 + fq * 8);
    const float* cwp = p.in[zz() + 11] + (size_t)l * 4 * 512 + c;
    const float cw0 = cwp[0], cw1 = cwp[512], cw2 = cwp[1024], cw3 = cwp[1536], cb = p.in[zz() + 12][l * 512 + c];
    const float ba = p.in[zz() + 14][l * 512 + c], bx = p.in[zz() + 16][l * 512 + c], sp8 = 8.0f * softplusf_(-p.in[zz() + 17][l * 512 + c]);
    const bf16_t* xcol = proj + (size_t)t0 * PW + PC_BX + c;
    float xm3 = 0.f, xm2 = 0.f, xm1 = 0.f;
    if (pos0 > 0) { xm3 = bf2f(xcol[-3L * PW]); xm2 = bf2f(xcol[-2L * PW]); xm1 = bf2f(xcol[-1L * PW]); }
    const bf16_t* gcol = proj + (size_t)t0 * PW + PC_BG + c;
    bf16_t* ycol = yb + (size_t)t0 * 512 + c;
    float h = mode ? carry[(size_t)tile * 512 + c] : 0.f, Ap = 1.f;
    for (int sub = 0; sub < 4; ++sub) {
        float xc[16];
#pragma unroll
        for (int tt = 0; tt < 16; ++tt) { const float xin = bf2f(*xcol); xcol += PW; xc[tt] = cb + cw0 * xm3 + cw1 * xm2 + cw2 * xm1 + cw3 * xin; xm3 = xm2; xm2 = xm1; xm1 = xin; Aw[tt * 72 + lane] = f2bf(xc[tt]); }
        __syncthreads();
        f32x4 acc[8];
#pragma unroll
        for (int n = 0; n < 8; ++n) acc[n] = (f32x4){0.f, 0.f, 0.f, 0.f};
#pragma unroll
        for (int ks = 0; ks < 2; ++ks) { const bf16x8 af = *(const LAS bf16x8*)(Aw + fr * 72 + ks * 32 + fq * 8);
#pragma unroll
            for (int n = 0; n < 8; ++n) acc[n] = __builtin_amdgcn_mfma_f32_16x16x32_bf16(bfr[n][ks], af, acc[n], 0, 0, 0); }
#pragma unroll
        for (int n = 0; n < 8; ++n)
#pragma unroll
            for (int j = 0; j < 4; ++j) Xw[fr * 129 + n * 16 + fq * 4 + j] = acc[n][j];
        __syncthreads();
#pragma unroll
        for (int tt = 0; tt < 16; ++tt) {
            const float r = sigmoidf_(Xw[tt * 129 + lane] + ba), ig = sigmoidf_(Xw[tt * 129 + 64 + lane] + bx);
            const float la = -sp8 * r, a = __expf(la), x2 = 2.0f * la;
            const float om = (x2 > -0.1f) ? -x2 * (1.0f + x2 * (0.5f + x2 * (0.16666667f + x2 * 0.041666668f))) : 1.0f - a * a;
            h = a * h + __builtin_amdgcn_sqrtf(om) * ig * xc[tt]; Ap *= a;
            if (mode) { const float gt = bf2f(*gcol); gcol += PW; *ycol = f2bf(h * geluf_(gt)); ycol += 512; }
        }
        __syncthreads();
    }
    if (!mode) { Aend[(size_t)tile * 512 + c] = Ap; Hend[(size_t)tile * 512 + c] = h; }
}
__device__ __forceinline__ void lru_carry(const float* Aend, const float* Hend, float* carry) {
    const int gid = lbid() * NTHR + ltid();
    if (gid < (TS / SEQ) * 512) {
        const int bl = gid >> 9, c = gid & 511; float h = 0.f;
        for (int n = 0; n < 64; ++n) { const size_t o = (size_t)(bl * 64 + n) * 512 + c; carry[o] = h; h = Aend[o] * h + Hend[o]; }
    }
}

__device__ __forceinline__ void gdn_prep(LAS unsigned char* lds, const Params& p, int l, const bf16_t* proj, const float* AB, bf16_t* GQ, bf16_t* GK, bf16_t* GU, bf16_t* GW, bf16_t* GA, float* edec, int item) {
    const int tid = ltid(), wid = tid >> 6, lane = tid & 63, fr = lane & 15, fq = lane >> 4;
    const int bl = item >> 8, n = (item & 255) >> 2, hh = item & 3, ch = bl * 64 + n, t0 = ch * 64;
    LAS bf16_t* Kl = (LAS bf16_t*)lds;
    LAS bf16_t* Ql = (LAS bf16_t*)(lds + 17408);
    LAS float* RHS = (LAS float*)(lds + 34816);
    LAS float* Am = (LAS float*)(lds + 101376);
    LAS float* gc = (LAS float*)(lds + 117760);
    LAS float* bt = (LAS float*)(lds + 118016);
    const int t = tid >> 3, d0 = (tid & 7) * 16;
#pragma unroll
    for (int sec = 0; sec < 3; ++sec) {
        const int colh = sec * 512 + hh * 128 + d0;
        u32x4 w0[4], w1[4]; float msk[4];
#pragma unroll
        for (int k = 0; k < 4; ++k) {
            const int tt = t - 3 + k; const bool valid = (tt >= 0) || (n > 0);
            const bf16_t* src = proj + (long)(t0 + (valid ? tt : 0)) * PW + PC_CQ + colh;
            w0[k] = *(const u32x4*)src; w1[k] = *(const u32x4*)(src + 8); msk[k] = valid ? 1.0f : 0.0f;
        }
        float a[16];
#pragma unroll
        for (int e = 0; e < 16; ++e) a[e] = 0.f;
#pragma unroll
        for (int k = 0; k < 4; ++k) {
            const float* cwp = p.in[zz() + 18] + ((size_t)l * 4 + k) * 1536 + colh;
#pragma unroll
            for (int q = 0; q < 4; ++q) { const f32x4 c4 = *(const f32x4*)(cwp + q * 4) * msk[k];
                const unsigned wa = (q < 2) ? w0[k][2 * q] : w1[k][2 * q - 4], wb = (q < 2) ? w0[k][2 * q + 1] : w1[k][2 * q - 3];
                a[q * 4 + 0] += c4[0] * lo_bf(wa); a[q * 4 + 1] += c4[1] * hi_bf(wa); a[q * 4 + 2] += c4[2] * lo_bf(wb); a[q * 4 + 3] += c4[3] * hi_bf(wb); }
        }
#pragma unroll
        for (int e = 0; e < 16; ++e) a[e] = siluf_(a[e]);
        if (sec < 2) {
            float ss = 0.f;
#pragma unroll
            for (int e = 0; e < 16; ++e) ss += a[e] * a[e];
            ss += __shfl_xor(ss, 1); ss += __shfl_xor(ss, 2); ss += __shfl_xor(ss, 4);
            const float nrm = rsqrtf(ss + EPS) * (sec == 0 ? 0.08838834764831845f : 1.0f);
#pragma unroll
            for (int e = 0; e < 16; ++e) a[e] *= nrm;
            LAS bf16_t* X = sec == 0 ? Ql : Kl;
#pragma unroll
            for (int e = 0; e < 16; e += 2) *(LAS unsigned*)(X + t * 136 + d0 + e) = cvt_pk_bf16(a[e], a[e + 1]);
        }
        if (sec >= 1) {
            LAS float* R = RHS + t * 260 + (sec == 1 ? 128 : 0) + d0;
#pragma unroll
            for (int e = 0; e < 16; e += 4) *(LAS f32x4*)(R + e) = (f32x4){a[e], a[e + 1], a[e + 2], a[e + 3]};
        }
    }
    if (wid == 0) {
        const float al = AB[(size_t)(t0 + lane) * 8 + 4 + hh], be = AB[(size_t)(t0 + lane) * 8 + hh];
        float gv = -__expf(p.in[zz() + 19][l * 4 + hh]) * softplusf_(al + p.in[zz() + 20][l * 4 + hh]);
#pragma unroll
        for (int o = 1; o < 64; o <<= 1) { const float u = __shfl_up(gv, o); if (lane >= o) gv += u; }
        gc[lane] = gv; bt[lane] = sigmoidf_(be);
        if (lane == 63) edec[item] = __expf(gv);
    }
    __syncthreads();
    float kdv[16];
    {
        const float bet = bt[t], gct = gc[t], eg = __expf(gct), ekd = __expf(gc[63] - gct);
        LAS float* Rv = RHS + t * 260 + d0; LAS float* Rk = Rv + 128;
#pragma unroll
        for (int e = 0; e < 16; e += 4) { const f32x4 v4 = *(LAS f32x4*)(Rv + e), k4 = *(LAS f32x4*)(Rk + e);
            *(LAS f32x4*)(Rv + e) = v4 * bet; *(LAS f32x4*)(Rk + e) = k4 * (bet * eg);
            kdv[e] = k4[0] * ekd; kdv[e + 1] = k4[1] * ekd; kdv[e + 2] = k4[2] * ekd; kdv[e + 3] = k4[3] * ekd; }
        unsigned qw[8];
#pragma unroll
        for (int e = 0; e < 8; ++e) { const unsigned w = *(LAS unsigned*)(Ql + t * 136 + d0 + 2 * e); qw[e] = cvt_pk_bf16(lo_bf(w) * eg, hi_bf(w) * eg); }
        bf16_t* qdst = GQ + (size_t)(t0 + t) * 512 + hh * 128 + d0;
        *(u32x4*)qdst = (u32x4){qw[0], qw[1], qw[2], qw[3]}; *(u32x4*)(qdst + 8) = (u32x4){qw[4], qw[5], qw[6], qw[7]};
    }
    {
        const int it = wid & 3, which = wid >> 2;
        LAS bf16_t* Xi = which ? Ql : Kl;
        bf16x8 af[4];
#pragma unroll
        for (int ks = 0; ks < 4; ++ks) af[ks] = *(const LAS bf16x8*)(Xi + (it * 16 + fr) * 136 + ks * 32 + fq * 8);
        const int i = it * 16 + fr; const float gci = gc[i], bti = bt[i];
#pragma unroll
        for (int jt = 0; jt < 4; ++jt) {
            f32x4 acc = (f32x4){0.f, 0.f, 0.f, 0.f};
#pragma unroll
            for (int ks = 0; ks < 4; ++ks) { const bf16x8 bf = *(const LAS bf16x8*)(Kl + (jt * 16 + fr) * 136 + ks * 32 + fq * 8); acc = __builtin_amdgcn_mfma_f32_16x16x32_bf16(bf, af[ks], acc, 0, 0, 0); }
            float v[4];
#pragma unroll
            for (int jj = 0; jj < 4; ++jj) { const int j = jt * 16 + fq * 4 + jj; const float dec = (i >= j) ? __expf(gci - gc[j]) : 0.f;
                v[jj] = which ? acc[jj] * dec : ((i > j) ? bti * acc[jj] * dec : 0.f); }
            if (which) { u32x2 o; o.x = cvt_pk_bf16(v[0], v[1]); o.y = cvt_pk_bf16(v[2], v[3]); *(u32x2*)(GA + (size_t)(t0 + i) * 256 + hh * 64 + jt * 16 + fq * 4) = o; }
            else *(LAS f32x4*)(Am + i * 64 + jt * 16 + fq * 4) = (f32x4){v[0], v[1], v[2], v[3]};
        }
    }
    __syncthreads();
    {
        LAS bf16_t* KDT = Ql;
#pragma unroll
        for (int e = 0; e < 16; ++e) KDT[(d0 + e) * 68 + t] = f2bf(kdv[e]);
    }
    if (tid < 256) {
        float x[64];
        int lz; asm volatile("v_mov_b32 %0, 0" : "=v"(lz));
        const LAS float* Amz = Am + lz;
#pragma unroll
        for (int i = 0; i < 64; ++i) x[i] = 0.f;
#pragma unroll
        for (int i = 0; i < 64; ++i) {
            float s = RHS[i * 260 + tid], s1 = 0.f, s2 = 0.f, s3 = 0.f;
#pragma unroll
            for (int j4 = 0; j4 < (i + 3) / 4; ++j4) { const f32x4 a4 = *(const LAS f32x4*)(Amz + i * 64 + j4 * 4);
                s -= a4[0] * x[j4 * 4]; s1 -= a4[1] * x[j4 * 4 + 1]; s2 -= a4[2] * x[j4 * 4 + 2]; s3 -= a4[3] * x[j4 * 4 + 3]; }
            s = (s + s1) + (s2 + s3);
            x[i] = s; RHS[i * 260 + tid] = s;
        }
    }
    __syncthreads();
    {
        const int seg = tid & 7;
        const LAS float* xr = RHS + t * 260 + seg * 32;
        bf16_t* dst = ((seg < 4) ? GU : GW) + (size_t)(t0 + t) * 512 + hh * 128 + (seg & 3) * 32;
#pragma unroll
        for (int q = 0; q < 4; ++q) { const f32x4 a = *(const LAS f32x4*)(xr + q * 8), b = *(const LAS f32x4*)(xr + q * 8 + 4);
            u32x4 w; w.x = cvt_pk_bf16(a[0], a[1]); w.y = cvt_pk_bf16(a[2], a[3]); w.z = cvt_pk_bf16(b[0], b[1]); w.w = cvt_pk_bf16(b[2], b[3]); *(u32x4*)(dst + q * 8) = w; }
        const LAS bf16_t* kr = Ql + (2 * t + (seg >> 2)) * 68 + (seg & 3) * 16;
        const u32x2 k0 = *(const LAS u32x2*)kr, k1 = *(const LAS u32x2*)(kr + 4), k2 = *(const LAS u32x2*)(kr + 8), k3 = *(const LAS u32x2*)(kr + 12);
        bf16_t* kdst = GK + (size_t)(t0 + t) * 512 + hh * 128 + seg * 16;
        *(u32x4*)kdst = (u32x4){k0.x, k0.y, k1.x, k1.y}; *(u32x4*)(kdst + 8) = (u32x4){k2.x, k2.y, k3.x, k3.y};
    }
    __syncthreads();
}

template <int OFF> __device__ __forceinline__ void dsr64(u32x2& d, unsigned addr) { asm volatile("ds_read_b64 %0, %1 offset:%2" : "=v"(d) : "v"(addr), "n"(OFF)); }
__device__ __forceinline__ void lgkm_wait8(u32x2& a, u32x2& b, u32x2& c, u32x2& d, u32x2& e, u32x2& f, u32x2& g, u32x2& h) {
    asm volatile("s_waitcnt lgkmcnt(0)" : "+v"(a), "+v"(b), "+v"(c), "+v"(d), "+v"(e), "+v"(f), "+v"(g), "+v"(h)); }
template <int RS  , int NK, int NM> struct FragSet { u32x2 lo[NK][NM], hi[NK][NM]; };
__device__ __forceinline__ void gdn_scan(LAS unsigned char* lds, const unsigned char* ws, float* oraw, const float* edec, int chain) {
    const int tid = ltid(), wid = __builtin_amdgcn_readfirstlane(tid >> 6), lane = tid & 63, fr = lane & 15, fq = lane >> 4;
    const int bl = chain >> 5, hh = (chain >> 3) & 3, es = chain & 7, e0 = es * 16;
    constexpr int BUF = 64512, O_W = 0, O_Q = 17408, O_KT = 34816, O_AT = 53248, O_U = 62464, O_PS = 2 * BUF, O_PV = 2 * BUF + 4096;
    const unsigned rb = (unsigned)(bl * 64) * 64u;
    const bool stager = (wid >= 2);
    unsigned soff[11];
#pragma unroll
    for (int i = 0; i < 11; ++i) {
        const int blk = (wid - 2) + 6 * i;
        const int q = blk * 64 + lane;
        unsigned o = 0u;
        if (stager && blk < 63) {
            if (q < 1088) { const int row = q / 17, pc = min(q % 17, 15); o = (unsigned)(WS_GDW + ((size_t)(rb + row) * 512 + hh * 128 + pc * 8) * 2); }
            else if (q < 2176) { const int q2 = q - 1088, row = q2 / 17, pc = min(q2 % 17, 15); o = (unsigned)(WS_GDQ + ((size_t)(rb + row) * 512 + hh * 128 + pc * 8) * 2); }
            else if (q < 3328) { const int q2 = q - 2176, d = q2 / 9, pc = min(q2 % 9, 7); o = (unsigned)(WS_GDK + ((size_t)(rb + (d >> 1)) * 512 + hh * 128 + (d & 1) * 64 + pc * 8) * 2); }
            else if (q < 3904) { const int q2 = q - 3328, row = q2 / 9, pc = min(q2 % 9, 7); o = (unsigned)(WS_GDA + ((size_t)(rb + row) * 256 + hh * 64 + pc * 8) * 2); }
            else { const int q2 = q - 3904, row = q2 >> 1, pc = q2 & 1; o = (unsigned)(WS_GDU + ((size_t)(rb + row) * 512 + hh * 128 + e0 + pc * 8) * 2); }
        }
        soff[i] = o;
    }
#define SCAN_DMA(chunk, bufsel) do { _Pragma("unroll") for (int i = 0; i < 11; ++i) { const int blk = (wid - 2) + 6 * i; if (blk < 63) { \
        const unsigned stp = (blk >= 52 && blk < 61) ? 32768u : 65536u; \
        __builtin_amdgcn_global_load_lds((const unsigned*)(ws + soff[i] + (unsigned)(chunk) * stp), (LAS unsigned*)(lds + (bufsel) * BUF + blk * 1024), 16, 0, 0); } } } while (0)
    if (stager) { SCAN_DMA(0, 0); asm volatile("s_waitcnt vmcnt(0)" ::: "memory"); }
    if (wid == 1) {
#pragma unroll
        for (int kt = 0; kt < 4; ++kt) *(LAS u32x4*)(lds + O_PS + kt * 1024 + lane * 16) = (u32x4){0u, 0u, 0u, 0u};
    }
    const float dv = edec[bl * 256 + lane * 4 + hh];
    f32x4 Sacc[8];
#pragma unroll
    for (int d = 0; d < 8; ++d) Sacc[d] = (f32x4){0.f, 0.f, 0.f, 0.f};
    __syncthreads();
    for (int n = 0; n < 64; ++n) {
        const LAS unsigned char* B = lds + (n & 1) * BUF;
        const int t0 = (bl * 64 + n) * 64;
        f32x4 OS[4];
        bf16x8 vb[2];
        if (stager) { if (n + 1 < 64) SCAN_DMA(n + 1, (n + 1) & 1); }
        else if (wid == 0) {
            f32x4 WS[4];
            bf16x8 sb[4];
#pragma unroll
            for (int kt = 0; kt < 4; ++kt) { u32x4 w; w.x = cvt_pk_bf16(Sacc[2 * kt][0], Sacc[2 * kt][1]); w.y = cvt_pk_bf16(Sacc[2 * kt][2], Sacc[2 * kt][3]);
                w.z = cvt_pk_bf16(Sacc[2 * kt + 1][0], Sacc[2 * kt + 1][1]); w.w = cvt_pk_bf16(Sacc[2 * kt + 1][2], Sacc[2 * kt + 1][3]); sb[kt] = __builtin_bit_cast(bf16x8, w); }
#pragma unroll
            for (int m = 0; m < 4; ++m) WS[m] = (f32x4){0.f, 0.f, 0.f, 0.f};
            {
                u32x2 wlo[4][4], whi[4][4];
                const unsigned bw = (unsigned)(unsigned long)(B + O_W + (fr * 136 + fq * 4) * 2);
                dsr64<0>(wlo[0][0], bw); dsr64<32>(whi[0][0], bw);
                dsr64<4352>(wlo[0][1], bw); dsr64<4384>(whi[0][1], bw);
                dsr64<8704>(wlo[0][2], bw); dsr64<8736>(whi[0][2], bw);
                dsr64<13056>(wlo[0][3], bw); dsr64<13088>(whi[0][3], bw);
                dsr64<64>(wlo[1][0], bw); dsr64<96>(whi[1][0], bw);
                dsr64<4416>(wlo[1][1], bw); dsr64<4448>(whi[1][1], bw);
                dsr64<8768>(wlo[1][2], bw); dsr64<8800>(whi[1][2], bw);
                dsr64<13120>(wlo[1][3], bw); dsr64<13152>(whi[1][3], bw);
                dsr64<128>(wlo[2][0], bw); dsr64<160>(whi[2][0], bw);
                dsr64<4480>(wlo[2][1], bw); dsr64<4512>(whi[2][1], bw);
                dsr64<8832>(wlo[2][2], bw); dsr64<8864>(whi[2][2], bw);
                dsr64<13184>(wlo[2][3], bw); dsr64<13216>(whi[2][3], bw);
                dsr64<192>(wlo[3][0], bw); dsr64<224>(whi[3][0], bw);
                dsr64<4544>(wlo[3][1], bw); dsr64<4576>(whi[3][1], bw);
                dsr64<8896>(wlo[3][2], bw); dsr64<8928>(whi[3][2], bw);
                dsr64<13248>(wlo[3][3], bw); dsr64<13280>(whi[3][3], bw);
                lgkm_wait8(wlo[0][0], wlo[0][1], wlo[0][2], wlo[0][3], wlo[1][0], wlo[1][1], wlo[1][2], wlo[1][3]);
                lgkm_wait8(wlo[2][0], wlo[2][1], wlo[2][2], wlo[2][3], wlo[3][0], wlo[3][1], wlo[3][2], wlo[3][3]);
                lgkm_wait8(whi[0][0], whi[0][1], whi[0][2], whi[0][3], whi[1][0], whi[1][1], whi[1][2], whi[1][3]);
                lgkm_wait8(whi[2][0], whi[2][1], whi[2][2], whi[2][3], whi[3][0], whi[3][1], whi[3][2], whi[3][3]);
#pragma unroll
                for (int kt = 0; kt < 4; ++kt)
#pragma unroll
                    for (int m = 0; m < 4; ++m) WS[m] = __builtin_amdgcn_mfma_f32_16x16x32_bf16(__builtin_bit_cast(bf16x8, (u32x4){wlo[kt][m].x, wlo[kt][m].y, whi[kt][m].x, whi[kt][m].y}), sb[kt], WS[m], 0, 0, 0);
            }
#pragma unroll
            for (int m = 0; m < 4; ++m)
#pragma unroll
                for (int jj = 0; jj < 4; ++jj) WS[m][jj] = bf2f(*(const LAS bf16_t*)(B + O_U + ((m * 16 + fq * 4 + jj) * 16 + fr) * 2)) - WS[m][jj];
#pragma unroll
            for (int kc = 0; kc < 2; ++kc) { u32x4 w; w.x = cvt_pk_bf16(WS[2 * kc][0], WS[2 * kc][1]); w.y = cvt_pk_bf16(WS[2 * kc][2], WS[2 * kc][3]);
                w.z = cvt_pk_bf16(WS[2 * kc + 1][0], WS[2 * kc + 1][1]); w.w = cvt_pk_bf16(WS[2 * kc + 1][2], WS[2 * kc + 1][3]); vb[kc] = __builtin_bit_cast(bf16x8, w);
                *(LAS u32x4*)(lds + O_PV + kc * 1024 + lane * 16) = w; }
        } else if (wid == 1) {
#pragma unroll
            for (int m = 0; m < 4; ++m) OS[m] = (f32x4){0.f, 0.f, 0.f, 0.f};
            {
                u32x2 qlo[4][4], qhi[4][4]; bf16x8 sbr[4];
#pragma unroll
                for (int kt = 0; kt < 4; ++kt) sbr[kt] = *(const LAS bf16x8*)(lds + O_PS + kt * 1024 + lane * 16);
                const unsigned bq = (unsigned)(unsigned long)(B + O_Q + (fr * 136 + fq * 4) * 2);
                dsr64<0>(qlo[0][0], bq); dsr64<32>(qhi[0][0], bq);
                dsr64<4352>(qlo[0][1], bq); dsr64<4384>(qhi[0][1], bq);
                dsr64<8704>(qlo[0][2], bq); dsr64<8736>(qhi[0][2], bq);
                dsr64<13056>(qlo[0][3], bq); dsr64<13088>(qhi[0][3], bq);
                dsr64<64>(qlo[1][0], bq); dsr64<96>(qhi[1][0], bq);
                dsr64<4416>(qlo[1][1], bq); dsr64<4448>(qhi[1][1], bq);
                dsr64<8768>(qlo[1][2], bq); dsr64<8800>(qhi[1][2], bq);
                dsr64<13120>(qlo[1][3], bq); dsr64<13152>(qhi[1][3], bq);
                dsr64<128>(qlo[2][0], bq); dsr64<160>(qhi[2][0], bq);
                dsr64<4480>(qlo[2][1], bq); dsr64<4512>(qhi[2][1], bq);
                dsr64<8832>(qlo[2][2], bq); dsr64<8864>(qhi[2][2], bq);
                dsr64<13184>(qlo[2][3], bq); dsr64<13216>(qhi[2][3], bq);
                dsr64<192>(qlo[3][0], bq); dsr64<224>(qhi[3][0], bq);
                dsr64<4544>(qlo[3][1], bq); dsr64<4576>(qhi[3][1], bq);
                dsr64<8896>(qlo[3][2], bq); dsr64<8928>(qhi[3][2], bq);
                dsr64<13248>(qlo[3][3], bq); dsr64<13280>(qhi[3][3], bq);
                lgkm_wait8(qlo[0][0], qlo[0][1], qlo[0][2], qlo[0][3], qlo[1][0], qlo[1][1], qlo[1][2], qlo[1][3]);
                lgkm_wait8(qlo[2][0], qlo[2][1], qlo[2][2], qlo[2][3], qlo[3][0], qlo[3][1], qlo[3][2], qlo[3][3]);
                lgkm_wait8(qhi[0][0], qhi[0][1], qhi[0][2], qhi[0][3], qhi[1][0], qhi[1][1], qhi[1][2], qhi[1][3]);
                lgkm_wait8(qhi[2][0], qhi[2][1], qhi[2][2], qhi[2][3], qhi[3][0], qhi[3][1], qhi[3][2], qhi[3][3]);
#pragma unroll
                for (int kt = 0; kt < 4; ++kt)
#pragma unroll
                    for (int m = 0; m < 4; ++m) OS[m] = __builtin_amdgcn_mfma_f32_16x16x32_bf16(__builtin_bit_cast(bf16x8, (u32x4){qlo[kt][m].x, qlo[kt][m].y, qhi[kt][m].x, qhi[kt][m].y}), sbr[kt], OS[m], 0, 0, 0);
            }
        }
        asm volatile("s_waitcnt lgkmcnt(0)" ::: "memory"); __builtin_amdgcn_s_barrier(); asm volatile("" ::: "memory");
        if (wid == 0) {
            const float dec = __shfl(dv, n);
#pragma unroll
            for (int d = 0; d < 8; ++d) Sacc[d] *= dec;
            {
                u32x2 klo[2][8], khi[2][8];
                const unsigned bk = (unsigned)(unsigned long)(B + O_KT + (fr * 72 + fq * 4) * 2);
                dsr64<0>(klo[0][0], bk); dsr64<32>(khi[0][0], bk);
                dsr64<2304>(klo[0][1], bk); dsr64<2336>(khi[0][1], bk);
                dsr64<4608>(klo[0][2], bk); dsr64<4640>(khi[0][2], bk);
                dsr64<6912>(klo[0][3], bk); dsr64<6944>(khi[0][3], bk);
                dsr64<9216>(klo[0][4], bk); dsr64<9248>(khi[0][4], bk);
                dsr64<11520>(klo[0][5], bk); dsr64<11552>(khi[0][5], bk);
                dsr64<13824>(klo[0][6], bk); dsr64<13856>(khi[0][6], bk);
                dsr64<16128>(klo[0][7], bk); dsr64<16160>(khi[0][7], bk);
                dsr64<64>(klo[1][0], bk); dsr64<96>(khi[1][0], bk);
                dsr64<2368>(klo[1][1], bk); dsr64<2400>(khi[1][1], bk);
                dsr64<4672>(klo[1][2], bk); dsr64<4704>(khi[1][2], bk);
                dsr64<6976>(klo[1][3], bk); dsr64<7008>(khi[1][3], bk);
                dsr64<9280>(klo[1][4], bk); dsr64<9312>(khi[1][4], bk);
                dsr64<11584>(klo[1][5], bk); dsr64<11616>(khi[1][5], bk);
                dsr64<13888>(klo[1][6], bk); dsr64<13920>(khi[1][6], bk);
                dsr64<16192>(klo[1][7], bk); dsr64<16224>(khi[1][7], bk);
                lgkm_wait8(klo[0][0], klo[0][1], klo[0][2], klo[0][3], klo[0][4], klo[0][5], klo[0][6], klo[0][7]);
                lgkm_wait8(klo[1][0], klo[1][1], klo[1][2], klo[1][3], klo[1][4], klo[1][5], klo[1][6], klo[1][7]);
                lgkm_wait8(khi[0][0], khi[0][1], khi[0][2], khi[0][3], khi[0][4], khi[0][5], khi[0][6], khi[0][7]);
                lgkm_wait8(khi[1][0], khi[1][1], khi[1][2], khi[1][3], khi[1][4], khi[1][5], khi[1][6], khi[1][7]);
#pragma unroll
                for (int kc = 0; kc < 2; ++kc)
#pragma unroll
                    for (int d = 0; d < 8; ++d) Sacc[d] = __builtin_amdgcn_mfma_f32_16x16x32_bf16(__builtin_bit_cast(bf16x8, (u32x4){klo[kc][d].x, klo[kc][d].y, khi[kc][d].x, khi[kc][d].y}), vb[kc], Sacc[d], 0, 0, 0);
            }
#pragma unroll
            for (int kt = 0; kt < 4; ++kt) { u32x4 w; w.x = cvt_pk_bf16(Sacc[2 * kt][0], Sacc[2 * kt][1]); w.y = cvt_pk_bf16(Sacc[2 * kt][2], Sacc[2 * kt][3]);
                w.z = cvt_pk_bf16(Sacc[2 * kt + 1][0], Sacc[2 * kt + 1][1]); w.w = cvt_pk_bf16(Sacc[2 * kt + 1][2], Sacc[2 * kt + 1][3]);
                *(LAS u32x4*)(lds + O_PS + kt * 1024 + lane * 16) = w; }
        } else if (wid == 1) {
            {
                u32x2 alo[2][4], ahi[2][4]; bf16x8 vbr[2];
#pragma unroll
                for (int kc = 0; kc < 2; ++kc) vbr[kc] = *(const LAS bf16x8*)(lds + O_PV + kc * 1024 + lane * 16);
                const unsigned ba = (unsigned)(unsigned long)(B + O_AT + (fr * 72 + fq * 4) * 2);
                dsr64<0>(alo[0][0], ba); dsr64<32>(ahi[0][0], ba);
                dsr64<2304>(alo[0][1], ba); dsr64<2336>(ahi[0][1], ba);
                dsr64<4608>(alo[0][2], ba); dsr64<4640>(ahi[0][2], ba);
                dsr64<6912>(alo[0][3], ba); dsr64<6944>(ahi[0][3], ba);
                dsr64<64>(alo[1][0], ba); dsr64<96>(ahi[1][0], ba);
                dsr64<2368>(alo[1][1], ba); dsr64<2400>(ahi[1][1], ba);
                dsr64<4672>(alo[1][2], ba); dsr64<4704>(ahi[1][2], ba);
                dsr64<6976>(alo[1][3], ba); dsr64<7008>(ahi[1][3], ba);
                lgkm_wait8(alo[0][0], alo[0][1], alo[0][2], alo[0][3], alo[1][0], alo[1][1], alo[1][2], alo[1][3]);
                lgkm_wait8(ahi[0][0], ahi[0][1], ahi[0][2], ahi[0][3], ahi[1][0], ahi[1][1], ahi[1][2], ahi[1][3]);
#pragma unroll
                for (int kc = 0; kc < 2; ++kc)
#pragma unroll
                    for (int m = 0; m < 4; ++m) OS[m] = __builtin_amdgcn_mfma_f32_16x16x32_bf16(__builtin_bit_cast(bf16x8, (u32x4){alo[kc][m].x, alo[kc][m].y, ahi[kc][m].x, ahi[kc][m].y}), vbr[kc], OS[m], 0, 0, 0);
            }
            float* op = oraw + (size_t)(t0 + fq * 4) * 512 + hh * 128 + e0 + fr;
#pragma unroll
            for (int m = 0; m < 4; ++m)
#pragma unroll
                for (int jj = 0; jj < 4; ++jj) op[(size_t)(m * 16 + jj) * 512] = OS[m][jj];
        } else if (stager) {
            asm volatile("s_waitcnt vmcnt(0)" ::: "memory");
        }
        __syncthreads();
    }
#undef SCAN_DMA
}
__device__ __forceinline__ void gdn_out(const Params& p, int l, const float* oraw, const bf16_t* proj, bf16_t* yc) {
    const int tid = ltid(), sub = tid & 15;
    const float* ng = p.in[zz() + 21] + l * 128 + sub * 8;
    const f32x4 g0 = *(const f32x4*)ng, g1 = *(const f32x4*)(ng + 4);
    for (int rowi = lbid() * 32 + (tid >> 4); rowi < TS * 4; rowi += lgdim() * 32) {
        const int t = rowi >> 2, hh = rowi & 3;
        const float* op = oraw + (size_t)t * 512 + hh * 128 + sub * 8;
        const f32x4 o0 = *(const f32x4*)op, o1 = *(const f32x4*)(op + 4);
        float ss = (o0[0] * o0[0] + o0[1] * o0[1]) + (o0[2] * o0[2] + o0[3] * o0[3]) + (o1[0] * o1[0] + o1[1] * o1[1]) + (o1[2] * o1[2] + o1[3] * o1[3]);
        ss += __shfl_xor(ss, 1); ss += __shfl_xor(ss, 2); ss += __shfl_xor(ss, 4); ss += __shfl_xor(ss, 8);
        const float rs = rsqrtf(ss * (1.0f / 128.0f) + EPS);
        const u32x4 z = *(const u32x4*)(proj + (size_t)t * PW + PC_CZ + hh * 128 + sub * 8);
        u32x4 w;
        w.x = cvt_pk_bf16(o0[0] * rs * g0[0] * siluf_(lo_bf(z.x)), o0[1] * rs * g0[1] * siluf_(hi_bf(z.x)));
        w.y = cvt_pk_bf16(o0[2] * rs * g0[2] * siluf_(lo_bf(z.y)), o0[3] * rs * g0[3] * siluf_(hi_bf(z.y)));
        w.z = cvt_pk_bf16(o1[0] * rs * g1[0] * siluf_(lo_bf(z.z)), o1[1] * rs * g1[1] * siluf_(hi_bf(z.z)));
        w.w = cvt_pk_bf16(o1[2] * rs * g1[2] * siluf_(lo_bf(z.w)), o1[3] * rs * g1[3] * siluf_(hi_bf(z.w)));
        *(u32x4*)(yc + (size_t)t * 512 + hh * 128 + sub * 8) = w;
    }
}

constexpr int PH_PER_LAYER = 22, N_PHASES = 2 * PH_PER_LAYER + 1;

__device__ __forceinline__ void run_phase(LAS unsigned char* lds, const Params& p, int ph) {
    unsigned char* ws = lptr(p.ws);
    bf16_t* hbuf = (bf16_t*)(ws + WS_H);
    bf16_t* act = (bf16_t*)(ws + WS_PROJ);
    bf16_t* proj = (bf16_t*)(ws + WS_PROJ);
    bf16_t* hslab = hbuf;
    bf16_t* merged = hbuf + (size_t)TS * D;
    float* oraw = (float*)(ws + WS_H);
    bf16_t* ys = (bf16_t*)(ws + WS_YS);
    float* AB = (float*)(ws + WS_AB);
    bf16_t* halo = (bf16_t*)(ws + WS_HALO);
    float* Aend = (float*)(ws + WS_AEND); float* Hend = (float*)(ws + WS_HEND); float* carry = (float*)(ws + WS_CARRY); float* edec = (float*)(ws + WS_EDEC);
    const bf16_t* waxt = (const bf16_t*)(ws + WS_WAXT); const bf16_t* pwt = (const bf16_t*)(ws + WS_PWT);
    const int G = lgdim(), c = lbid();
    if (ph == N_PHASES - 1) { PHON(0) rms_rows_f32_inplace(lptr(p.out), p.in[zz() + 30], T); return; }
    const int l = ph / PH_PER_LAYER, r = ph % PH_PER_LAYER;
    const float* xcur = (l == 0) ? p.in[zz() + 0] : lptr(p.out);
    if (r == 0) { PHON(1) convert_layer(lds, p, l); PHON(0) rms_rows_bf16(xcur, p.in[zz() + 1] + l * D, hbuf, T); return; }
    if (r == 1 || r == 20) { PHON(2) ph_gemm_swiglu(lds, hbuf, (const bf16_t*)(ws + (r == 1 ? WS_WGU1 : WS_WGU2)), act); return; }
    if (r == 2 || r == 21) { PHON(3) ph_gemm_resid(lds, act, (const bf16_t*)(ws + (r == 2 ? WS_WD1 : WS_WD2)), T, DFF, (r == 2) ? xcur : lptr(p.out), lptr(p.out), 0.5f); return; }
    if (r == 19) { rms_rows_bf16(lptr(p.out), p.in[zz() + 26] + l * D, hbuf, T); return; }
    const int slab = (r - 3) >> 3, q = (r - 3) & 7;
    float* xs = lptr(p.out) + (size_t)slab * TS * D;
    switch (q) {
    case 0: rms_rows_bf16(xs, p.in[zz() + 5] + l * D, hslab, TS); break;
    case 1: PHON(4) ph_gemm_proj(lds, hslab, (const bf16_t*)(ws + WS_WIN), proj, AB); break;
    case 2:
        PHON(7) for (int t = c; t < TS / 64; t += G) lru_tile(lds, p, l, proj, nullptr, waxt, Aend, Hend, carry, t, 0);
        if (G >= 256) { PHON(5) for (int t = c; t < (TS / 128) * 2; t += G) sgu_tile(lds, p, l, proj, ys, t); }
        break;
    case 3:
        PHON(8) for (int it = c; it < (TS / 64) * 4; it += G) gdn_prep(lds, p, l, proj, AB, (bf16_t*)(ws + WS_GDQ), (bf16_t*)(ws + WS_GDK), (bf16_t*)(ws + WS_GDU), (bf16_t*)(ws + WS_GDW), (bf16_t*)(ws + WS_GDA), edec, it);
        lru_carry(Aend, Hend, carry);
        break;
    case 4:
        PHON(9) if (c < 128 || G < 256) { for (int ch = c; ch < 128; ch += G) gdn_scan(lds, ws, oraw, edec, ch); }
        if (G >= 256 && c < 128) { PHON(6) for (int t = c; t < TS / 128; t += 128) pool_tile(lds, p, l, proj, ys + (size_t)3 * TS * 512, halo, pwt, t); }
        if (G >= 256) {
            if (c >= 128) {
                const int cc = c - 128, GG = G - 128;
                PHON(10) for (int t = cc; t < TS / 128; t += GG) lru_tile(lds, p, l, proj, ys + (size_t)TS * 512, waxt, Aend, Hend, carry, t, 1);
                PHON(5) for (int t = (TS / 128) * 2 + cc; t < (TS / 128) * 4; t += GG) sgu_tile(lds, p, l, proj, ys, t);
                PHON(6) for (int t = TS / 128 + cc; t < TS / 64; t += GG) pool_tile(lds, p, l, proj, ys + (size_t)3 * TS * 512, halo, pwt, t);
            }
        } else {
            for (int t = c; t < TS / 64; t += G) lru_tile(lds, p, l, proj, ys + (size_t)TS * 512, waxt, Aend, Hend, carry, t, 1);
            for (int t = c; t < (TS / 128) * 4; t += G) sgu_tile(lds, p, l, proj, ys, t);
            for (int t = c; t < TS / 64; t += G) pool_tile(lds, p, l, proj, ys + (size_t)3 * TS * 512, halo, pwt, t);
        }
        break;
    case 5: if (G >= 256) { for (int t = TS / 128 + c; t < TS / 64; t += G) lru_tile(lds, p, l, proj, ys + (size_t)TS * 512, waxt, Aend, Hend, carry, t, 1); }
        PHON(11) gdn_out(p, l, oraw, proj, ys + (size_t)2 * TS * 512); break;
    case 6: PHON(12) ph_gemm_branch(lds, ys, (const bf16_t*)(ws + WS_WB), proj, merged); break;
    default: PHON(13) ph_gemm_resid(lds, merged, (const bf16_t*)(ws + WS_WOUT), TS, D, xs, xs, 1.0f); break;
    }
}

extern __shared__ __attribute__((aligned(16))) unsigned char smem_dyn[];

#ifndef DUP_TYPE
#define DUP_TYPE -1
#endif
__device__ __forceinline__ int phase_type(int ph) {
    if (ph == N_PHASES - 1) return 12;
    const int r = ph % PH_PER_LAYER;
    if (r == 0) return 0; if (r == 1 || r == 20) return 1; if (r == 2 || r == 21) return 2; if (r == 19) return 11;
    const int q = (r - 3) & 7;
    return 3 + q;
}
__global__ void __launch_bounds__(NTHR) fwd_megakernel(Params p) {
    cg::grid_group grid = cg::this_grid();
    LAS unsigned char* lds = (LAS unsigned char*)smem_dyn;
    volatile LAS unsigned* st = (volatile LAS unsigned*)(lds + LDS_BYTES - 16);
    if (threadIdx.x == 0) { st[0] = 0u; st[1] = 0u; }
    __syncthreads();
    const XcdBarrier xb = xcd_barrier_post((unsigned*)(p.ws + WS_BAR), st);
    if (p.ph_hi < 0) grid.sync();
    for (int ph = p.ph_lo; ph < p.ph_hi; ++ph) {
        if (ph > p.ph_lo) xcd_barrier(xb);
        run_phase(lds, p, ph);
#if DUP_TYPE == 6
        if (phase_type(ph) == 6) { xcd_barrier(xb); run_phase(lds, p, ph - 2); xcd_barrier(xb); run_phase(lds, p, ph - 1); xcd_barrier(xb); run_phase(lds, p, ph); }
#elif DUP_TYPE >= 0
        if (phase_type(ph) == DUP_TYPE) { xcd_barrier(xb); run_phase(lds, p, ph); }
#endif
    }
}

extern "C" void kernel_launch(void* const* d_in, const int* in_sizes, int n_in, void* d_out, int out_size, void* d_ws, size_t ws_size, hipStream_t stream) {
    static int grid_blocks = 0;
    if (grid_blocks == 0) {
        if (n_in != 31 || out_size != T * D || ws_size < WS_END) { fprintf(stderr, "kernel_launch: unexpected shapes (n_in %d out %d ws %zu need %zu)\n", n_in, out_size, ws_size, (size_t)WS_END); grid_blocks = -1; return; }
        int dev = 0, cus = 0, per_cu = 0;
        hipGetDevice(&dev);
        hipDeviceGetAttribute(&cus, hipDeviceAttributeMultiprocessorCount, dev);
        if (hipFuncSetAttribute((const void*)fwd_megakernel, hipFuncAttributeMaxDynamicSharedMemorySize, LDS_BYTES) != hipSuccess) { fprintf(stderr, "kernel_launch: hipFuncSetAttribute failed\n"); grid_blocks = -1; return; }
        hipOccupancyMaxActiveBlocksPerMultiprocessor(&per_cu, (const void*)fwd_megakernel, NTHR, LDS_BYTES);
        if (per_cu < 1) { fprintf(stderr, "kernel_launch: occupancy query returned %d\n", per_cu); per_cu = 1; }
        grid_blocks = cus * per_cu;
    }
    if (grid_blocks < 0) return;
    Params p{};
    for (int i = 0; i < 31; ++i) p.in[i] = (const float*)d_in[i];
    p.out = (float*)d_out; p.ws = (unsigned char*)d_ws;
    hipMemsetAsync((unsigned char*)d_ws + WS_BAR, 0, 16384, stream);
    p.ph_lo = 0; p.ph_hi = N_PHASES;
    void* args[] = {&p};
    hipError_t e = hipLaunchCooperativeKernel((const void*)fwd_megakernel, dim3(grid_blocks), dim3(NTHR), args, LDS_BYTES, stream);
    if (e != hipSuccess) fprintf(stderr, "cooperative launch failed: %s (grid %d)\n", hipGetErrorString(e), grid_blocks);
}
```

```cpp
#include <hip/hip_runtime.h>
#include <hip/hip_cooperative_groups.h>
#include <cstdio>
namespace cg = cooperative_groups;

#ifndef MULTI_LAUNCH
#define MULTI_LAUNCH 0
#endif

#ifndef PH_MASK
#define PH_MASK 0xFFFFF
#endif
#define PHON(k) if constexpr ((PH_MASK >> (k)) & 1)
#define LAS __attribute__((address_space(3)))
typedef unsigned short bf16_t;
typedef short bf16x8 __attribute__((ext_vector_type(8)));
typedef short bf16x4 __attribute__((ext_vector_type(4)));
typedef float f32x4 __attribute__((ext_vector_type(4)));
typedef unsigned u32x4 __attribute__((ext_vector_type(4)));
typedef unsigned u32x2 __attribute__((ext_vector_type(2)));

constexpr int T = 32768, D = 1024, DFF = 2816, NSLAB = 2, TS = T / NSLAB, SEQ = 4096, PW = 8960, PIN = 8712;
constexpr int PC_AU = 0, PC_AV = 512, PC_BX = 1024, PC_BG = 1536, PC_CQ = 2048, PC_CK = 2560, PC_CV = 3072, PC_CZ = 3584, PC_DX = 4096, PC_GATE = 4608, PC_AB = 8704;
constexpr float EPS = 1e-6f;
constexpr int NTHR = 512;
constexpr int LDS_BYTES = 147456;

constexpr size_t WS_WGU1 = 0;
constexpr size_t WS_WD1 = WS_WGU1 + (size_t)5632 * 1024 * 2;
constexpr size_t WS_WIN = WS_WD1 + (size_t)1024 * 2816 * 2;
constexpr size_t WS_WB = WS_WIN + (size_t)PW * 1024 * 2;
constexpr size_t WS_WOUT = WS_WB + (size_t)4 * 1024 * 512 * 2;
constexpr size_t WS_WGU2 = WS_WOUT + (size_t)1024 * 1024 * 2;
constexpr size_t WS_WD2 = WS_WGU2 + (size_t)5632 * 1024 * 2;
constexpr size_t WS_WAXT = WS_WD2 + (size_t)1024 * 2816 * 2;
constexpr size_t WS_PWT = WS_WAXT + 131072;
constexpr size_t WS_PROJ = WS_PWT + 131072;
constexpr size_t WS_H = WS_PROJ + (size_t)TS * PW * 2;
constexpr size_t WS_YS = WS_H + (size_t)T * D * 2;
constexpr size_t WS_AB = WS_YS + (size_t)4 * TS * 512 * 2;
constexpr size_t WS_HALO = WS_AB + (size_t)TS * 8 * 4;
constexpr size_t WS_AEND = WS_HALO + (size_t)(TS / 64) * 3 * 1536 * 2;
constexpr size_t WS_HEND = WS_AEND + (size_t)(TS / 64) * 512 * 4;
constexpr size_t WS_CARRY = WS_HEND + (size_t)(TS / 64) * 512 * 4;
constexpr size_t WS_EDEC = WS_CARRY + (size_t)(TS / 64) * 512 * 4;
constexpr size_t WS_BAR = WS_EDEC + 4096;
constexpr size_t WS_GDQ = WS_H + (size_t)TS * D * 2;
constexpr size_t WS_GDK = WS_GDQ + (size_t)TS * 512 * 2;
constexpr size_t WS_GDU = WS_BAR + 16384;
constexpr size_t WS_GDW = WS_GDU + (size_t)TS * 512 * 2;
constexpr size_t WS_GDA = WS_GDW + (size_t)TS * 512 * 2;
constexpr size_t WS_END = WS_GDA + (size_t)TS * 256 * 2;
static_assert(WS_END <= (size_t)512 * 1024 * 1024, "workspace budget");

struct Params { const float* in[31]; float* out; unsigned char* ws; int ph_lo, ph_hi; };

__device__ __forceinline__ int ltid() { int t = threadIdx.x; asm volatile("" : "+v"(t)); return t; }
__device__ __forceinline__ int lbid() { int t = blockIdx.x; asm volatile("" : "+s"(t)); return t; }
__device__ __forceinline__ int lgdim() { int t = gridDim.x; asm volatile("" : "+s"(t)); return t; }
__device__ __forceinline__ int zz() { int z; asm volatile("s_mov_b32 %0, 0" : "=s"(z)); return z; }
template <class P> __device__ __forceinline__ P* lptr(P* q) { asm volatile("" : "+s"(q)); return q; }
__device__ __forceinline__ float bf2f(unsigned short b) { return __uint_as_float(((unsigned)b) << 16); }
__device__ __forceinline__ unsigned cvt_pk_bf16(float lo, float hi) { unsigned r; asm("v_cvt_pk_bf16_f32 %0, %1, %2" : "=v"(r) : "v"(lo), "v"(hi)); return r; }
__device__ __forceinline__ unsigned short f2bf(float f) { return (unsigned short)(cvt_pk_bf16(f, 0.f) & 0xffffu); }
__device__ __forceinline__ float lo_bf(unsigned w) { return __uint_as_float(w << 16); }
__device__ __forceinline__ float hi_bf(unsigned w) { return __uint_as_float(w & 0xffff0000u); }
__device__ __forceinline__ float sigmoidf_(float x) { return __builtin_amdgcn_rcpf(1.0f + __expf(-x)); }
__device__ __forceinline__ float siluf_(float x) { return x * __builtin_amdgcn_rcpf(1.0f + __expf(-x)); }
__device__ __forceinline__ float geluf_(float x) { const float u = 1.5957691216057308f * (x + 0.044715f * x * x * x); return x * __builtin_amdgcn_rcpf(1.0f + __expf(-u)); }
__device__ __forceinline__ float softplusf_(float x) { return fmaxf(x, 0.f) + log1pf(__expf(-fabsf(x))); }
__device__ __forceinline__ float wave_sum(float v) {
#pragma unroll
    for (int o = 1; o < 64; o <<= 1) v += __shfl_xor(v, o);
    return v;
}


#define XB_TMO      128
#define XB_XCNT(j)  (256  + 64 * (j))
#define XB_XSUB(j)  (1280 + 64 * (j))
#define XB_XGEN(j)  (2304 + 64 * (j))
#define XB_TOP      3328
#define XB_TOPGEN   3392
#define XCD_BAR_WORDS 3456
#define XB_SPIN_CAP (1u << 22)
__device__ __forceinline__ unsigned xb_ld(unsigned* p)              { return __hip_atomic_load(p, __ATOMIC_RELAXED, __HIP_MEMORY_SCOPE_AGENT); }
__device__ __forceinline__ unsigned xb_add(unsigned* p, unsigned v) { return __hip_atomic_fetch_add(p, v, __ATOMIC_RELAXED, __HIP_MEMORY_SCOPE_AGENT); }
__device__ __forceinline__ unsigned xb_xcc_id() { return (unsigned)__builtin_amdgcn_s_getreg((3 << 11) | 20) & 0xFu; }
#define XB_SPIN(cond, bar) do { unsigned _sp = 0; while (cond) { __builtin_amdgcn_s_sleep(1); \
    if ((++_sp & 255u) == 0u) { if (xb_ld(&(bar)[XB_TMO])) break; if (_sp > XB_SPIN_CAP) { atomicAdd(&(bar)[XB_TMO], 1u); break; } } } } while (0)
struct XcdBarrier { unsigned* bar; unsigned x; volatile LAS unsigned* st; };
__device__ __forceinline__ XcdBarrier xcd_barrier_post(unsigned* bar, volatile LAS unsigned* st) {
    XcdBarrier b; b.bar = bar; b.x = xb_xcc_id(); b.st = st;
    if (threadIdx.x == 0) (void)xb_add(&bar[XB_XCNT(b.x)], 1u);
    return b;
}
__device__ __forceinline__ void xcd_barrier_complete(unsigned* bar, unsigned x, unsigned& nloc, unsigned& nx) {
    const unsigned G = gridDim.x * gridDim.y * gridDim.z;
    unsigned sum, cnt, mine, sp = 0u;
    for (;;) {
        sum = 0u; cnt = 0u; mine = 0u;
#pragma unroll
        for (unsigned j = 0; j < 16; ++j) { const unsigned c = xb_ld(&bar[XB_XCNT(j)]); sum += c; cnt += (c > 0u) ? 1u : 0u; mine = (j == x) ? c : mine; }
        if (sum == G) break;
        __builtin_amdgcn_s_sleep(1);
        if ((++sp & 255u) == 0u) { if (xb_ld(&bar[XB_TMO])) break; if (sp > XB_SPIN_CAP) { atomicAdd(&bar[XB_TMO], 1u); break; } }
    }
    nloc = mine > 0u ? mine : 1u; nx = cnt > 0u ? cnt : 1u;
}
__device__ __forceinline__ void xcd_barrier(const XcdBarrier& b) {
    asm volatile("s_waitcnt vmcnt(0)" ::: "memory");
    __syncthreads();
    if (threadIdx.x == 0) {
        unsigned* bar = b.bar;
        __builtin_amdgcn_s_waitcnt(0);
        unsigned nloc = b.st[0], nx = b.st[1];
        if (nloc == 0u) { xcd_barrier_complete(bar, b.x, nloc, nx); b.st[0] = nloc; b.st[1] = nx; }
        const unsigned old = xb_add(&bar[XB_XSUB(b.x)], 1u);
        const unsigned gen = old / nloc;
        if (old + 1u == (gen + 1u) * nloc) {
            __builtin_amdgcn_fence(__ATOMIC_RELEASE, "agent");
            asm volatile("s_waitcnt vmcnt(0)" ::: "memory");
            const unsigned og = xb_add(&bar[XB_TOP], 1u);
            const unsigned tg = og / nx;
            if (og + 1u == (tg + 1u) * nx) xb_add(&bar[XB_TOPGEN], 1u);
            else XB_SPIN(xb_ld(&bar[XB_TOPGEN]) == tg, bar);
            __builtin_amdgcn_fence(__ATOMIC_ACQUIRE, "agent");
            xb_add(&bar[XB_XGEN(b.x)], 1u);
            asm volatile("s_waitcnt vmcnt(0)" ::: "memory");
        } else {
            XB_SPIN(xb_ld(&bar[XB_XGEN(b.x)]) == gen, bar);
            __builtin_amdgcn_fence(__ATOMIC_ACQUIRE, "agent");
            asm volatile("s_waitcnt vmcnt(0)" ::: "memory");
        }
    }
    __syncthreads();
}

namespace pg8 {
constexpr int BM = 256, BK = 64, HALF = 128, HTB = HALF * BK * 2, STAGE_BYTES = 8 * HTB, NXCD = 8, WGM = 8;
__host__ __device__ __forceinline__ int lds_byte(int r, int c) { const int st = (r >> 4) * 2 + (c >> 5), rr = r & 15, cc = c & 31, ob = rr * 64 + cc * 2; return st * 1024 + (ob ^ (((ob >> 9) & 1) << 5)); }
__host__ __device__ __forceinline__ void stage_rc(int b, int& R, int& C) { const int st = b / 1024, sb = b % 1024, swz = sb ^ (((sb >> 9) & 1) << 5); R = (st >> 1) * 16 + swz / 64; C = (st & 1) * 32 + (swz % 64) / 2; }
__host__ __device__ __forceinline__ int perm32(int rho) { const int n = rho >> 4, i = rho & 15; return 8 * (i >> 2) + 4 * n + (i & 3); }

struct Unit { int pm, pn, g; };
struct Gemm { const bf16_t* A; const bf16_t* Bt; int M, N, K; size_t gsA, gsB; };

__device__ __forceinline__ void tile_of(int wgid, int nM, int nN, int nwg, Unit& u) {
    { const int q = nwg / NXCD, r = nwg % NXCD, xcd = wgid % NXCD, off = wgid / NXCD; wgid = (xcd < r ? xcd * (q + 1) : r * (q + 1) + (xcd - r) * q) + off; }
    const int nig = WGM * nN, gid = wgid / nig, fm = gid * WGM, gsz = (nM - fm) < WGM ? (nM - fm) : WGM;
    u.pm = fm + ((wgid % nig) % gsz); u.pn = (wgid % nig) / gsz;
}
struct StaticOrder {
    int nM, nN, nwg, G, c;
    __device__ void init(int M, int N, int G_, int c_) { nM = M / BM; nN = N / BM; nwg = nM * nN; G = G_; c = c_; }
    __device__ bool next(int i, Unit& u) const {
        const long L = (long)i * G + c; if (L >= nwg) return false;
        tile_of((int)L, nM, nN, nwg, u); u.g = 0; return true;
    }
};
struct BranchOrder {
    int nM, nN, nwg, G, c;
    __device__ void init(int M, int N, int G_, int c_) { nM = M / BM; nN = N / BM; nwg = nM * nN; G = G_; c = c_; }
    __device__ bool next(int i, Unit& u) const {
        const long L = (long)(i >> 2) * G + c; if (L >= nwg) return false;
        tile_of((int)L, nM, nN, nwg, u); u.g = i & 3; return true;
    }
};

struct EpiSwiGLU {
    static constexpr bool PERM = true;
    bf16_t* O;
    __device__ __forceinline__ bool keep(const Unit&) const { return false; }
    __device__ __forceinline__ void operator()(f32x4 (&acc)[2][2][4][2], const Unit& u, int wr, int wc, int fr, int fq) const {
        const int row0 = u.pm * BM + wr * 64 + fr, col0 = u.pn * 128 + wc * 32 + 8 * fq;
#pragma unroll
        for (int ai = 0; ai < 2; ++ai)
#pragma unroll
            for (int m = 0; m < 4; ++m) {
                bf16_t* rowp = O + (size_t)(row0 + ai * HALF + m * 16) * DFF + col0;
                float v[8];
#pragma unroll
                for (int n = 0; n < 2; ++n)
#pragma unroll
                    for (int j = 0; j < 4; ++j) v[n * 4 + j] = siluf_(acc[ai][0][m][n][j]) * acc[ai][1][m][n][j];
                u32x4 w; w.x = cvt_pk_bf16(v[0], v[1]); w.y = cvt_pk_bf16(v[2], v[3]); w.z = cvt_pk_bf16(v[4], v[5]); w.w = cvt_pk_bf16(v[6], v[7]);
                *(u32x4*)rowp = w;
                __builtin_amdgcn_sched_barrier(0);
            }
    }
};
struct EpiResid {
    static constexpr bool PERM = false;
    const float* Xin; float* Xout; float scale;
    __device__ __forceinline__ bool keep(const Unit&) const { return false; }
    __device__ __forceinline__ void operator()(f32x4 (&acc)[2][2][4][2], const Unit& u, int wr, int wc, int fr, int fq) const {
        const int row0 = u.pm * BM + wr * 64 + fr, col0 = u.pn * BM + wc * 32 + 4 * fq;
#pragma unroll
        for (int ai = 0; ai < 2; ++ai) {
            f32x4 xi[4][2][2];
#pragma unroll
            for (int m = 0; m < 4; ++m) { const size_t ro = (size_t)(row0 + ai * HALF + m * 16) * D + col0;
#pragma unroll
                for (int bj = 0; bj < 2; ++bj)
#pragma unroll
                    for (int n = 0; n < 2; ++n) xi[m][bj][n] = *(const f32x4*)(Xin + ro + bj * HALF + n * 16); }
#pragma unroll
            for (int m = 0; m < 4; ++m) { const size_t ro = (size_t)(row0 + ai * HALF + m * 16) * D + col0;
#pragma unroll
                for (int bj = 0; bj < 2; ++bj)
#pragma unroll
                    for (int n = 0; n < 2; ++n) *(f32x4*)(Xout + ro + bj * HALF + n * 16) = xi[m][bj][n] + acc[ai][bj][m][n] * scale; }
            __builtin_amdgcn_sched_barrier(0);
        }
    }
};
struct EpiProj {
    static constexpr bool PERM = true;
    bf16_t* O; float* AB;
    __device__ __forceinline__ bool keep(const Unit&) const { return false; }
    __device__ __forceinline__ void operator()(f32x4 (&acc)[2][2][4][2], const Unit& u, int wr, int wc, int fr, int fq) const {
        const int row0 = u.pm * BM + wr * 64 + fr, col0 = u.pn * BM + wc * 32 + 8 * fq;
        const bool ab = (u.pn == PC_AB / BM) && wc == 0 && fq == 0;
#pragma unroll
        for (int ai = 0; ai < 2; ++ai)
#pragma unroll
            for (int m = 0; m < 4; ++m) {
                const int row = row0 + ai * HALF + m * 16;
                bf16_t* rowp = O + (size_t)row * PW + col0;
#pragma unroll
                for (int bj = 0; bj < 2; ++bj) {
                    const f32x4 v0 = acc[ai][bj][m][0], v1 = acc[ai][bj][m][1];
                    u32x4 w; w.x = cvt_pk_bf16(v0[0], v0[1]); w.y = cvt_pk_bf16(v0[2], v0[3]); w.z = cvt_pk_bf16(v1[0], v1[1]); w.w = cvt_pk_bf16(v1[2], v1[3]);
                    *(u32x4*)(rowp + bj * HALF) = w;
                }
                __builtin_amdgcn_sched_barrier(0);
            }
        if (ab) {
#pragma unroll
            for (int ai = 0; ai < 2; ++ai)
#pragma unroll
                for (int m = 0; m < 4; ++m) { const int row = row0 + ai * HALF + m * 16; *(f32x4*)(AB + (size_t)row * 8) = acc[ai][0][m][0]; *(f32x4*)(AB + (size_t)row * 8 + 4) = acc[ai][0][m][1]; }
        }
    }
};
struct EpiBranch {
    static constexpr bool PERM = true;
    const bf16_t* P; bf16_t* O;
    __device__ __forceinline__ bool keep(const Unit& u) const { return u.g < 3; }
    __device__ __forceinline__ void operator()(f32x4 (&acc)[2][2][4][2], const Unit& u, int wr, int wc, int fr, int fq) const {
        const int row0 = u.pm * BM + wr * 64 + fr, col0 = u.pn * BM + wc * 32 + 8 * fq;
        const bool last = (u.g == 3);
#pragma unroll
        for (int ai = 0; ai < 2; ++ai) {
            u32x4 g0[4][2], g1[4][2];
#pragma unroll
            for (int m = 0; m < 4; ++m) { const bf16_t* gp = P + (size_t)(row0 + ai * HALF + m * 16) * PW + PC_GATE + u.g * D + col0;
#pragma unroll
                for (int bj = 0; bj < 2; ++bj) { g0[m][bj] = *(const u32x4*)(gp + bj * HALF); g1[m][bj] = last ? g0[m][bj] : *(const u32x4*)(gp + D + bj * HALF); } }
#pragma unroll
            for (int m = 0; m < 4; ++m) {
                const int row = row0 + ai * HALF + m * 16;
#pragma unroll
                for (int bj = 0; bj < 2; ++bj) {
                    float f[8];
                    if (!last) {
#pragma unroll
                        for (int q = 0; q < 4; ++q) {
                            f[2 * q] = (1.0f + __expf(-lo_bf(g1[m][bj][q]))) * __builtin_amdgcn_rcpf(1.0f + __expf(-lo_bf(g0[m][bj][q])));
                            f[2 * q + 1] = (1.0f + __expf(-hi_bf(g1[m][bj][q]))) * __builtin_amdgcn_rcpf(1.0f + __expf(-hi_bf(g0[m][bj][q])));
                        }
                    } else {
#pragma unroll
                        for (int q = 0; q < 4; ++q) { f[2 * q] = __builtin_amdgcn_rcpf(1.0f + __expf(-lo_bf(g0[m][bj][q]))); f[2 * q + 1] = __builtin_amdgcn_rcpf(1.0f + __expf(-hi_bf(g0[m][bj][q]))); }
                    }
#pragma unroll
                    for (int n = 0; n < 2; ++n)
#pragma unroll
                        for (int j = 0; j < 4; ++j) acc[ai][bj][m][n][j] *= f[n * 4 + j];
                    if (last) {
                        const f32x4 v0 = acc[ai][bj][m][0], v1 = acc[ai][bj][m][1];
                        u32x4 w; w.x = cvt_pk_bf16(v0[0], v0[1]); w.y = cvt_pk_bf16(v0[2], v0[3]); w.z = cvt_pk_bf16(v1[0], v1[1]); w.w = cvt_pk_bf16(v1[2], v1[3]);
                        *(u32x4*)(O + (size_t)row * D + col0 + bj * HALF) = w;
                    }
                }
            }
            __builtin_amdgcn_sched_barrier(0);
        }
    }
};

template <class Epi, class Sched>
__device__ __forceinline__ void gemm_phase(LAS unsigned char* lds, const Gemm g, const Sched& S, const Epi& E) {
    const int tid = ltid(), wid = __builtin_amdgcn_readfirstlane(tid >> 6), lane = tid & 63, wr = wid >> 2, wc = wid & 3, fr = lane & 15, fq = lane >> 4;
    const int K = g.K, nt = K / BK;
    unsigned voffA[2], voffB[2];
#pragma unroll
    for (int i = 0; i < 2; ++i) { int R, C; stage_rc(tid * 16 + i * 8192, R, C); const int Rb = Epi::PERM ? ((R & ~31) + perm32(R & 31)) : R;
        voffA[i] = (unsigned)(R * K + C) * 2u; voffB[i] = (unsigned)(Rb * K + C) * 2u; }
    const size_t kstep = (size_t)(BK * 2);
    const size_t hstep = (size_t)HALF * K * 2;
    const size_t tstep = 2 * hstep;
    const unsigned ldsw = (unsigned)wid * 1024u;
    const int aoff = lds_byte(wr * 64 + fr, fq * 8), boff = lds_byte(wc * 32 + fr, fq * 8);
#define PG8_SA(b, h) (((b) * 2 + (h)) * HTB)
#define PG8_SB(b, h) ((4 + (b) * 2 + (h)) * HTB)
#define PG8_STAGE(bufoff, gbase, voff) do { _Pragma("unroll") for (int _i = 0; _i < 2; ++_i) \
        __builtin_amdgcn_global_load_lds((const unsigned*)((const char*)(gbase) + (voff)[_i]), (LAS unsigned*)(lds + (bufoff) + ldsw + _i * 8192), 16, 0, 0); } while (0)
#define PG8_LDA(dst, b, h) do { _Pragma("unroll") for (int m = 0; m < 4; ++m) _Pragma("unroll") for (int k = 0; k < 2; ++k) dst[m][k] = *(const LAS bf16x8*)(lds + PG8_SA(b, h) + aoff + m * 2048 + k * 1024); } while (0)
#define PG8_LDB(dst, b, h) do { _Pragma("unroll") for (int n = 0; n < 2; ++n) _Pragma("unroll") for (int k = 0; k < 2; ++k) dst[n][k] = *(const LAS bf16x8*)(lds + PG8_SB(b, h) + boff + n * 2048 + k * 1024); } while (0)
#define PG8_MMA(ai, bj, At, Bt) do { __builtin_amdgcn_s_setprio(1); _Pragma("unroll") for (int m = 0; m < 4; ++m) _Pragma("unroll") for (int n = 0; n < 2; ++n) _Pragma("unroll") for (int k = 0; k < 2; ++k) \
        acc[ai][bj][m][n] = __builtin_amdgcn_mfma_f32_16x16x32_bf16(Bt[n][k], At[m][k], acc[ai][bj][m][n], 0, 0, 0); __builtin_amdgcn_s_setprio(0); } while (0)
#define PG8_WAIT_V(n) asm volatile("s_waitcnt vmcnt(" #n ")" ::: "memory")
#define PG8_WAIT_L(n) asm volatile("s_waitcnt lgkmcnt(" #n ")" ::: "memory")
#define PG8_BAR __builtin_amdgcn_s_barrier()
#define PG8_SCHED __builtin_amdgcn_sched_barrier(0)
    Unit cur, nxt; int ui = 0;
    if (!S.next(0, cur)) return;
    f32x4 acc[2][2][4][2];
#pragma unroll
    for (int a = 0; a < 2; ++a)
#pragma unroll
        for (int b = 0; b < 2; ++b)
#pragma unroll
            for (int m = 0; m < 4; ++m)
#pragma unroll
                for (int n = 0; n < 2; ++n) acc[a][b][m][n] = (f32x4){0.f, 0.f, 0.f, 0.f};
    bf16x8 At[4][2], B0[2][2], B1[2][2];
    const char* cA = (const char*)g.A + (size_t)cur.g * g.gsA + (size_t)cur.pm * tstep; const char* cB = (const char*)g.Bt + (size_t)cur.g * g.gsB + (size_t)cur.pn * tstep;
    PG8_STAGE(PG8_SB(0, 0), cB, voffB); PG8_STAGE(PG8_SA(0, 0), cA, voffA); PG8_STAGE(PG8_SB(0, 1), cB + hstep, voffB); PG8_STAGE(PG8_SA(0, 1), cA + hstep, voffA);
    if (wr == 1) PG8_BAR;
    PG8_WAIT_V(4); PG8_BAR;
    PG8_STAGE(PG8_SB(1, 0), cB + kstep, voffB); PG8_STAGE(PG8_SA(1, 0), cA + kstep, voffA); PG8_STAGE(PG8_SB(1, 1), cB + hstep + kstep, voffB);
    PG8_WAIT_V(6); PG8_BAR;
    for (;;) {
        const bool has_next = S.next(ui + 1, nxt);
        const char* nA = has_next ? (const char*)g.A + (size_t)nxt.g * g.gsA + (size_t)nxt.pm * tstep : cA; const char* nB = has_next ? (const char*)g.Bt + (size_t)nxt.g * g.gsB + (size_t)nxt.pn * tstep : cB;
        for (int t = 0; t < nt; t += 2) {
            const bool last = (t == nt - 2);
            const char* a1 = cA + (size_t)(t + 1) * kstep;
            const char* a2 = last ? nA : cA + (size_t)(t + 2) * kstep; const char* b2 = last ? nB : cB + (size_t)(t + 2) * kstep;
            const char* a3 = a2 + kstep; const char* b3 = b2 + kstep;
            PG8_LDB(B0, 0, 0); PG8_SCHED; PG8_LDA(At, 0, 0); PG8_STAGE(PG8_SA(1, 1), a1 + hstep, voffA);
            PG8_WAIT_L(8); PG8_BAR; PG8_WAIT_L(0); PG8_MMA(0, 0, At, B0); PG8_BAR; PG8_SCHED;
            PG8_LDB(B1, 0, 1); PG8_STAGE(PG8_SB(0, 0), b2, voffB);
            PG8_BAR; PG8_WAIT_L(0); PG8_MMA(0, 1, At, B1); PG8_BAR;
            PG8_LDA(At, 0, 1); PG8_STAGE(PG8_SA(0, 0), a2, voffA);
            PG8_BAR; PG8_WAIT_L(0); PG8_MMA(1, 0, At, B0); PG8_BAR; PG8_SCHED;
            PG8_STAGE(PG8_SB(0, 1), b2 + hstep, voffB);
            PG8_WAIT_V(6); PG8_BAR; PG8_MMA(1, 1, At, B1); PG8_BAR;
            PG8_LDB(B0, 1, 0); PG8_SCHED; PG8_LDA(At, 1, 0); PG8_STAGE(PG8_SA(0, 1), a2 + hstep, voffA);
            PG8_WAIT_L(8); PG8_BAR; PG8_WAIT_L(0); PG8_MMA(0, 0, At, B0); PG8_BAR; PG8_SCHED;
            PG8_LDB(B1, 1, 1); PG8_STAGE(PG8_SB(1, 0), b3, voffB);
            PG8_BAR; PG8_WAIT_L(0); PG8_MMA(0, 1, At, B1); PG8_BAR;
            PG8_LDA(At, 1, 1); PG8_STAGE(PG8_SA(1, 0), a3, voffA);
            PG8_BAR; PG8_WAIT_L(0); PG8_MMA(1, 0, At, B0); PG8_BAR; PG8_SCHED;
            PG8_STAGE(PG8_SB(1, 1), b3 + hstep, voffB);
            PG8_WAIT_V(6); PG8_BAR; PG8_MMA(1, 1, At, B1); PG8_BAR;
        }
        E(acc, cur, wr, wc, fr, fq);
        if (!has_next) break;
        if (!E.keep(cur)) {
#pragma unroll
            for (int a = 0; a < 2; ++a)
#pragma unroll
                for (int b = 0; b < 2; ++b)
#pragma unroll
                    for (int m = 0; m < 4; ++m)
#pragma unroll
                        for (int n = 0; n < 2; ++n) acc[a][b][m][n] = (f32x4){0.f, 0.f, 0.f, 0.f};
        }
        cur = nxt; cA = nA; cB = nB; ++ui;
    }
    PG8_WAIT_V(0);
    if (wr == 0) PG8_BAR;
    PG8_BAR;
#undef PG8_SA
#undef PG8_SB
#undef PG8_STAGE
#undef PG8_LDA
#undef PG8_LDB
#undef PG8_MMA
#undef PG8_WAIT_V
#undef PG8_WAIT_L
#undef PG8_BAR
#undef PG8_SCHED
}
}


#define NOINL __forceinline__
__device__ NOINL void ph_gemm_swiglu(LAS unsigned char* lds, const bf16_t* A, const bf16_t* Bt, bf16_t* O) {
    pg8::Gemm g{A, Bt, T, 2 * DFF, D, 0, 0}; pg8::StaticOrder S; S.init(g.M, g.N, lgdim(), lbid()); pg8::EpiSwiGLU E{O}; pg8::gemm_phase(lds, g, S, E);
}
__device__ NOINL void ph_gemm_resid(LAS unsigned char* lds, const bf16_t* A, const bf16_t* Bt, int M, int K, const float* Xin, float* Xout, float scale) {
    pg8::Gemm g{A, Bt, M, D, K, 0, 0}; pg8::StaticOrder S; S.init(g.M, g.N, lgdim(), lbid()); pg8::EpiResid E{Xin, Xout, scale}; pg8::gemm_phase(lds, g, S, E);
}
__device__ NOINL void ph_gemm_proj(LAS unsigned char* lds, const bf16_t* A, const bf16_t* Bt, bf16_t* O, float* AB) {
    pg8::Gemm g{A, Bt, TS, PW, D, 0, 0}; pg8::StaticOrder S; S.init(g.M, g.N, lgdim(), lbid()); pg8::EpiProj E{O, AB}; pg8::gemm_phase(lds, g, S, E);
}
__device__ NOINL void ph_gemm_branch(LAS unsigned char* lds, const bf16_t* A, const bf16_t* Bt, const bf16_t* P, bf16_t* O) {
    pg8::Gemm g{A, Bt, TS, D, 512, (size_t)TS * 512 * 2, (size_t)D * 512 * 2}; pg8::BranchOrder S; S.init(g.M, g.N, lgdim(), lbid()); pg8::EpiBranch E{P, O}; pg8::gemm_phase(lds, g, S, E);
}

struct ConvTask { const float* src0; const float* src1; bf16_t* dst; int K, Nsrc, mode, tile; };
__device__ __forceinline__ ConvTask conv_task(const Params& p, int l, int it) {
    unsigned char* ws = lptr(p.ws);
    constexpr int N1 = 16 * 88, N2 = 44 * 16, N3 = 16 * 140, N4 = 8 * 16, N5 = 16 * 16;
    ConvTask t; t.src1 = nullptr;
    int r = it;
    if (r < N1) { t.src0 = p.in[zz() + 2] + (size_t)l * D * DFF; t.src1 = p.in[zz() + 3] + (size_t)l * D * DFF; t.K = D; t.Nsrc = DFF; t.dst = (bf16_t*)(ws + WS_WGU1); t.mode = 1; t.tile = r; return t; } r -= N1;
    if (r < N2) { t.src0 = p.in[zz() + 4] + (size_t)l * DFF * D; t.K = DFF; t.Nsrc = D; t.dst = (bf16_t*)(ws + WS_WD1); t.mode = 0; t.tile = r; return t; } r -= N2;
    if (r < N3) { t.src0 = p.in[zz() + 6] + (size_t)l * D * PIN; t.K = D; t.Nsrc = PIN; t.dst = (bf16_t*)(ws + WS_WIN); t.mode = 2; t.tile = r; return t; } r -= N3;
    if (r < 4 * N4) { const int g = r / N4; t.src0 = p.in[zz() + 24] + ((size_t)l * 4 + g) * 512 * D; t.K = 512; t.Nsrc = D; t.dst = (bf16_t*)(ws + WS_WB) + (size_t)g * D * 512; t.mode = 0; t.tile = r % N4; return t; } r -= 4 * N4;
    if (r < N5) { t.src0 = p.in[zz() + 25] + (size_t)l * D * D; t.K = D; t.Nsrc = D; t.dst = (bf16_t*)(ws + WS_WOUT); t.mode = 0; t.tile = r; return t; } r -= N5;
    if (r < N1) { t.src0 = p.in[zz() + 27] + (size_t)l * D * DFF; t.src1 = p.in[zz() + 28] + (size_t)l * D * DFF; t.K = D; t.Nsrc = DFF; t.dst = (bf16_t*)(ws + WS_WGU2); t.mode = 1; t.tile = r; return t; } r -= N1;
    t.src0 = p.in[zz() + 29] + (size_t)l * DFF * D; t.K = DFF; t.Nsrc = D; t.dst = (bf16_t*)(ws + WS_WD2); t.mode = 0; t.tile = r; return t;
}
__device__ __forceinline__ void conv_load(const ConvTask& t, int tid, f32x4& a, f32x4& b) {
    const int nkt = t.K / 64, kt = t.tile % nkt, rt = t.tile / nkt, k0 = kt * 64, r0 = rt * 64;
    const int kk = tid >> 3, rr = (tid & 7) * 8, rho = r0 + rr;
    const float* src = t.src0; int col = rho;
    if (t.mode == 1) { const int pn = rho >> 8, bj = (rho >> 7) & 1, j = rho & 127; col = pn * 128 + j; src = bj ? t.src1 : t.src0; }
    else if (t.mode == 2) { col = rho < 4096 ? rho : (rho < 8704 ? rho + 8 : (rho < 8712 ? rho - 8704 + 4096 : -1)); }
    a = (f32x4){0.f, 0.f, 0.f, 0.f}; b = a;
    if (col >= 0) { const float* sp = src + (size_t)(k0 + kk) * t.Nsrc + col; a = *(const f32x4*)sp; b = *(const f32x4*)(sp + 4); }
}
__device__ __forceinline__ void conv_store(LAS float* scr, const ConvTask& t, int tid, const f32x4& a, const f32x4& b) {
    const int nkt = t.K / 64, kt = t.tile % nkt, rt = t.tile / nkt, k0 = kt * 64, r0 = rt * 64;
    { const int kk = tid >> 3, rr = (tid & 7) * 8;
#pragma unroll
        for (int e = 0; e < 4; ++e) { scr[(rr + e) * 65 + kk] = a[e]; scr[(rr + 4 + e) * 65 + kk] = b[e]; } }
    __syncthreads();
    { const int rl = tid >> 3, kc = (tid & 7) * 8;
        const LAS float* s = scr + rl * 65 + kc;
        u32x4 w; w.x = cvt_pk_bf16(s[0], s[1]); w.y = cvt_pk_bf16(s[2], s[3]); w.z = cvt_pk_bf16(s[4], s[5]); w.w = cvt_pk_bf16(s[6], s[7]);
        *(u32x4*)(t.dst + (size_t)(r0 + rl) * t.K + k0 + kc) = w; }
    __syncthreads();
}

__device__ __forceinline__ void convert_layer(LAS unsigned char* lds, const Params& p, int l) {
    LAS float* scr = (LAS float*)lds;
    unsigned char* ws = lptr(p.ws);
    constexpr int N1 = 16 * 88, N2 = 44 * 16, N3 = 16 * 140, N4 = 8 * 16, N5 = 16 * 16;
    constexpr int TOT = N1 + N2 + N3 + 4 * N4 + N5 + N1 + N2;
    const int tid = ltid(), G = lgdim();
    int it = lbid();
    if (it < TOT) {
        ConvTask cur = conv_task(p, l, it);
        f32x4 a, b; conv_load(cur, tid, a, b);
        for (;;) {
            const int nx = it + G; const bool more = nx < TOT;
            ConvTask nxt = cur; f32x4 na = a, nb = b;
            if (more) { nxt = conv_task(p, l, nx); conv_load(nxt, tid, na, nb); }
            conv_store(scr, cur, tid, a, b);
            if (!more) break;
            cur = nxt; a = na; b = nb; it = nx;
        }
    }
    bf16_t* waxt = (bf16_t*)(ws + WS_WAXT); bf16_t* pwt = (bf16_t*)(ws + WS_PWT);
    const float* wa = p.in[zz() + 13] + (size_t)l * 8 * 64 * 64; const float* wx = p.in[zz() + 15] + (size_t)l * 8 * 64 * 64; const float* pw = p.in[zz() + 22] + (size_t)l * 4 * 128 * 128;
    for (int e = lbid() * NTHR + ltid(); e < 65536; e += lgdim() * NTHR) {
        { const int h = e >> 13, jp = (e >> 6) & 127, i = e & 63; waxt[e] = f2bf(jp < 64 ? wa[(h * 64 + i) * 64 + jp] : wx[(h * 64 + i) * 64 + jp - 64]); }
        { const int g = e >> 14, d = (e >> 7) & 127, c = e & 127; pwt[e] = f2bf(pw[(g * 128 + c) * 128 + d]); }
    }
}

__device__ __forceinline__ void rms_rows_bf16(const float* X, const float* gain, bf16_t* H, int nrows) {
    const int wid = ltid() >> 6, lane = ltid() & 63;
    f32x4 gv[4];
#pragma unroll
    for (int j = 0; j < 4; ++j) gv[j] = *(const f32x4*)(gain + (lane + 64 * j) * 4);
    for (int row0 = (lbid() * 8 + wid) * 4; row0 < nrows; row0 += lgdim() * 32) {
        f32x4 v[4][4];
#pragma unroll
        for (int r = 0; r < 4; ++r) { const f32x4* xr = (const f32x4*)(X + (size_t)min(row0 + r, nrows - 1) * D) + lane;
#pragma unroll
            for (int j = 0; j < 4; ++j) v[r][j] = xr[64 * j]; }
#pragma unroll
        for (int r = 0; r < 4; ++r) {
            float s = 0.f;
#pragma unroll
            for (int j = 0; j < 4; ++j) s += (v[r][j].x * v[r][j].x + v[r][j].y * v[r][j].y) + (v[r][j].z * v[r][j].z + v[r][j].w * v[r][j].w);
            const float rs = rsqrtf(wave_sum(s) * (1.0f / D) + EPS);
            u32x2* o = (u32x2*)(H + (size_t)(row0 + r) * D) + lane;
            if (row0 + r < nrows)
#pragma unroll
            for (int j = 0; j < 4; ++j) { u32x2 w; w.x = cvt_pk_bf16(v[r][j].x * rs * gv[j].x, v[r][j].y * rs * gv[j].y); w.y = cvt_pk_bf16(v[r][j].z * rs * gv[j].z, v[r][j].w * rs * gv[j].w); o[64 * j] = w; }
        }
    }
}
__device__ __forceinline__ void rms_rows_f32_inplace(float* X, const float* gain, int nrows) {
    const int wid = ltid() >> 6, lane = ltid() & 63;
    f32x4 gv[4];
#pragma unroll
    for (int j = 0; j < 4; ++j) gv[j] = *(const f32x4*)(gain + (lane + 64 * j) * 4);
    for (int row0 = (lbid() * 8 + wid) * 4; row0 < nrows; row0 += lgdim() * 32) {
        f32x4 v[4][4];
#pragma unroll
        for (int r = 0; r < 4; ++r) { const f32x4* xr = (const f32x4*)(X + (size_t)min(row0 + r, nrows - 1) * D) + lane;
#pragma unroll
            for (int j = 0; j < 4; ++j) v[r][j] = xr[64 * j]; }
#pragma unroll
        for (int r = 0; r < 4; ++r) {
            float s = 0.f;
#pragma unroll
            for (int j = 0; j < 4; ++j) s += (v[r][j].x * v[r][j].x + v[r][j].y * v[r][j].y) + (v[r][j].z * v[r][j].z + v[r][j].w * v[r][j].w);
            const float rs = rsqrtf(wave_sum(s) * (1.0f / D) + EPS);
            f32x4* xo = (f32x4*)(X + (size_t)(row0 + r) * D) + lane;
            if (row0 + r < nrows)
#pragma unroll
            for (int j = 0; j < 4; ++j) xo[64 * j] = v[r][j] * rs * gv[j];
        }
    }
}

__device__ __forceinline__ void sgu_tile(LAS unsigned char* lds, const Params& p, int l, const bf16_t* proj, bf16_t* ya, int tile) {
    const int tid = ltid(), wid = tid >> 6, lane = tid & 63, fr = lane & 15, fq = lane >> 4;
    const int blk = tile >> 2, g = tile & 3, r0 = blk * 128;
    LAS bf16_t* Wl = (LAS bf16_t*)lds;
    LAS bf16_t* VT = (LAS bf16_t*)(lds + 34816);
    const float* lng = p.in[zz() + 7] + l * 512 + g * 128; const float* lnb = p.in[zz() + 8] + l * 512 + g * 128;
    {
        const int i = tid >> 2, qd = tid & 3;
        const bf16_t* vrow = proj + (size_t)(r0 + i) * PW + PC_AV + qd * 8;
        float s = 0.f, s2 = 0.f;
#pragma unroll 4
        for (int e8 = 0; e8 < 16; ++e8) { const u32x4 w = *(const u32x4*)(vrow + e8 * 32);
#pragma unroll
            for (int q = 0; q < 4; ++q) { const float a = geluf_(lo_bf(w[q])), b = geluf_(hi_bf(w[q])); s += a + b; s2 += a * a + b * b; } }
        s += __shfl_xor(s, 1); s += __shfl_xor(s, 2); s2 += __shfl_xor(s2, 1); s2 += __shfl_xor(s2, 2);
        const float mean = s * (1.0f / 512.0f), var = fmaxf(s2 * (1.0f / 512.0f) - mean * mean, 0.f), rstd = rsqrtf(var + EPS);
        const bf16_t* vg = proj + (size_t)(r0 + i) * PW + PC_AV + g * 128 + qd * 8;
#pragma unroll
        for (int e8 = 0; e8 < 4; ++e8) { const u32x4 w = *(const u32x4*)(vg + e8 * 32);
#pragma unroll
            for (int q = 0; q < 4; ++q) { const int c = e8 * 32 + qd * 8 + 2 * q;
                VT[c * 136 + i] = f2bf((geluf_(lo_bf(w[q])) - mean) * rstd * lng[c] + lnb[c]);
                VT[(c + 1) * 136 + i] = f2bf((geluf_(hi_bf(w[q])) - mean) * rstd * lng[c + 1] + lnb[c + 1]); } }
        const float* wsrc = p.in[zz() + 9] + (((size_t)l * 4 + g) * 128 + i) * 128 + qd * 32;
#pragma unroll
        for (int e4 = 0; e4 < 8; ++e4) { f32x4 w = *(const f32x4*)(wsrc + e4 * 4); if (i < 64 && qd >= 2) w = (f32x4){0.f, 0.f, 0.f, 0.f};
            u32x2 o; o.x = cvt_pk_bf16(w.x, w.y); o.y = cvt_pk_bf16(w.z, w.w); *(LAS u32x2*)(Wl + i * 136 + qd * 32 + e4 * 4) = o; }
    }
    __syncthreads();
    f32x4 acc[8];
#pragma unroll
    for (int n = 0; n < 8; ++n) acc[n] = (f32x4){0.f, 0.f, 0.f, 0.f};
#pragma unroll
    for (int ks = 0; ks < 4; ++ks) {
        const bf16x8 af = *(const LAS bf16x8*)(Wl + (wid * 16 + fr) * 136 + ks * 32 + fq * 8);
#pragma unroll
        for (int n = 0; n < 8; ++n) { const bf16x8 bf = *(const LAS bf16x8*)(VT + (n * 16 + fr) * 136 + ks * 32 + fq * 8); acc[n] = __builtin_amdgcn_mfma_f32_16x16x32_bf16(bf, af, acc[n], 0, 0, 0); }
    }
    {
        const int i = wid * 16 + fr; const float bias = p.in[zz() + 10][((size_t)l * 4 + g) * 128 + i];
        const bf16_t* up = proj + (size_t)(r0 + i) * PW + PC_AU + g * 128 + fq * 4;
        bf16_t* yp = ya + (size_t)(r0 + i) * 512 + g * 128 + fq * 4;
#pragma unroll
        for (int n = 0; n < 8; ++n) { const u32x2 uw = *(const u32x2*)(up + n * 16);
            u32x2 o; o.x = cvt_pk_bf16((acc[n][0] + bias) * geluf_(lo_bf(uw.x)), (acc[n][1] + bias) * geluf_(hi_bf(uw.x)));
            o.y = cvt_pk_bf16((acc[n][2] + bias) * geluf_(lo_bf(uw.y)), (acc[n][3] + bias) * geluf_(hi_bf(uw.y))); *(u32x2*)(yp + n * 16) = o; }
    }
    __syncthreads();
}

template <int WIN>
__device__ __forceinline__ void pool_rows(LAS bf16_t* Al, const bf16_t* xcol, int c, int pos0) {
    float xv[80];
#pragma unroll
    for (int k = 0; k < 80; ++k) xv[k] = (pos0 - 16 + k >= 0) ? bf2f(xcol[(long)(k - 16) * PW]) : 0.f;
    float s = 0.f;
#pragma unroll
    for (int j = 0; j < WIN; ++j) s += xv[16 - j];
#pragma unroll
    for (int tt = 0; tt < 64; ++tt) {
        const int k = tt + 16;
        const int cnt = min(pos0 + tt + 1, WIN);
        Al[tt * 520 + c] = f2bf(s / (float)cnt - xv[k]);
        if (tt < 63) s += xv[k + 1] - xv[k + 1 - WIN];
    }
}
__device__ __forceinline__ void pool_tile(LAS unsigned char* lds, const Params& p, int l, const bf16_t* proj, bf16_t* yd, bf16_t* halo, const bf16_t* pwt, int tile) {
    const int tid = ltid(), wid = tid >> 6, lane = tid & 63, fr = lane & 15, fq = lane >> 4;
    const int t0 = tile * 64, pos0 = t0 % SEQ;
    LAS bf16_t* Al = (LAS bf16_t*)lds;
    {
        const int c = tid, g = wid >> 1;
        const bf16_t* xcol = proj + (size_t)t0 * PW + PC_DX + c;
        if (g == 0) pool_rows<2>(Al, xcol, c, pos0); else if (g == 1) pool_rows<4>(Al, xcol, c, pos0); else if (g == 2) pool_rows<8>(Al, xcol, c, pos0); else pool_rows<16>(Al, xcol, c, pos0);
    }
    __syncthreads();
    {
        const int g = wid >> 1, nh = wid & 1;
        f32x4 acc[4][4];
#pragma unroll
        for (int m = 0; m < 4; ++m)
#pragma unroll
            for (int n = 0; n < 4; ++n) acc[m][n] = (f32x4){0.f, 0.f, 0.f, 0.f};
#pragma unroll
        for (int ks = 0; ks < 4; ++ks) {
            bf16x8 bfr[4];
#pragma unroll
            for (int n = 0; n < 4; ++n) bfr[n] = *(const bf16x8*)(pwt + ((size_t)(g * 128 + (nh * 4 + n) * 16 + fr)) * 128 + ks * 32 + fq * 8);
#pragma unroll
            for (int m = 0; m < 4; ++m) { const bf16x8 af = *(const LAS bf16x8*)(Al + (m * 16 + fr) * 520 + g * 128 + ks * 32 + fq * 8);
#pragma unroll
                for (int n = 0; n < 4; ++n) acc[m][n] = __builtin_amdgcn_mfma_f32_16x16x32_bf16(bfr[n], af, acc[m][n], 0, 0, 0); }
        }
        const float* sc = p.in[zz() + 23] + l * 512 + g * 128;
#pragma unroll
        for (int n = 0; n < 4; ++n) { const int d = (nh * 4 + n) * 16 + fq * 4; const f32x4 s4 = *(const f32x4*)(sc + d);
#pragma unroll
            for (int m = 0; m < 4; ++m) { u32x2 o; o.x = cvt_pk_bf16(acc[m][n][0] * s4[0], acc[m][n][1] * s4[1]); o.y = cvt_pk_bf16(acc[m][n][2] * s4[2], acc[m][n][3] * s4[3]);
                *(u32x2*)(yd + (size_t)(t0 + m * 16 + fr) * 512 + g * 128 + d) = o; } }
    }
    __syncthreads();
}

__device__ __forceinline__ void lru_tile(LAS unsigned char* lds, const Params& p, int l, const bf16_t* proj, bf16_t* yb, const bf16_t* waxt, float* Aend, float* Hend, const float* carry, int tile, int mode) {
    const int tid = ltid(), wid = tid >> 6, lane = tid & 63, fr = lane & 15, fq = lane >> 4;
    const int t0 = tile * 64, pos0 = t0 % SEQ, c = wid * 64 + lane;
    LAS bf16_t* Aw = (LAS bf16_t*)(lds + wid * 10560);
    LAS float* Xw = (LAS float*)(lds + wid * 10560 + 2304);
    bf16x8 bfr[8][2];
#pragma unroll
    for (int n = 0; n < 8; ++n)
#pragma unroll
        for (int ks = 0; ks < 2; ++ks) bfr[n][ks] = *(const bf16x8*)(waxt + ((size_t)(wid * 128 + n * 16 + fr)) * 64 + ks * 32 + fq * 8);
    const float* cwp = p.in[zz() + 11] + (size_t)l * 4 * 512 + c;
    const float cw0 = cwp[0], cw1 = cwp[512], cw2 = cwp[1024], cw3 = cwp[1536], cb = p.in[zz() + 12][l * 512 + c];
    const float ba = p.in[zz() + 14][l * 512 + c], bx = p.in[zz() + 16][l * 512 + c], sp8 = 8.0f * softplusf_(-p.in[zz() + 17][l * 512 + c]);
    const bf16_t* xcol = proj + (size_t)t0 * PW + PC_BX + c;
    float xm3 = 0.f, xm2 = 0.f, xm1 = 0.f;
    if (pos0 > 0) { xm3 = bf2f(xcol[-3L * PW]); xm2 = bf2f(xcol[-2L * PW]); xm1 = bf2f(xcol[-1L * PW]); }
    const bf16_t* gcol = proj + (size_t)t0 * PW + PC_BG + c;
    bf16_t* ycol = yb + (size_t)t0 * 512 + c;
    float h = mode ? carry[(size_t)tile * 512 + c] : 0.f, Ap = 1.f;
    for (int sub = 0; sub < 4; ++sub) {
        float xc[16];
#pragma unroll
        for (int tt = 0; tt < 16; ++tt) { const float xin = bf2f(*xcol); xcol += PW; xc[tt] = cb + cw0 * xm3 + cw1 * xm2 + cw2 * xm1 + cw3 * xin; xm3 = xm2; xm2 = xm1; xm1 = xin; Aw[tt * 72 + lane] = f2bf(xc[tt]); }
        __syncthreads();
        f32x4 acc[8];
#pragma unroll
        for (int n = 0; n < 8; ++n) acc[n] = (f32x4){0.f, 0.f, 0.f, 0.f};
#pragma unroll
        for (int ks = 0; ks < 2; ++ks) { const bf16x8 af = *(const LAS bf16x8*)(Aw + fr * 72 + ks * 32 + fq * 8);
#pragma unroll
            for (int n = 0; n < 8; ++n) acc[n] = __builtin_amdgcn_mfma_f32_16x16x32_bf16(bfr[n][ks], af, acc[n], 0, 0, 0); }
#pragma unroll
        for (int n = 0; n < 8; ++n)
#pragma unroll
            for (int j = 0; j < 4; ++j) Xw[fr * 129 + n * 16 + fq * 4 + j] = acc[n][j];
        __syncthreads();
#pragma unroll
        for (int tt = 0; tt < 16; ++tt) {
            const float r = sigmoidf_(Xw[tt * 129 + lane] + ba), ig = sigmoidf_(Xw[tt * 129 + 64 + lane] + bx);
            const float la = -sp8 * r, a = __expf(la), x2 = 2.0f * la;
            const float om = (x2 > -0.1f) ? -x2 * (1.0f + x2 * (0.5f + x2 * (0.16666667f + x2 * 0.041666668f))) : 1.0f - a * a;
            h = a * h + __builtin_amdgcn_sqrtf(om) * ig * xc[tt]; Ap *= a;
            if (mode) { const float gt = bf2f(*gcol); gcol += PW; *ycol = f2bf(h * geluf_(gt)); ycol += 512; }
        }
        __syncthreads();
    }
    if (!mode) { Aend[(size_t)tile * 512 + c] = Ap; Hend[(size_t)tile * 512 + c] = h; }
}
__device__ __forceinline__ void lru_carry(const float* Aend, const float* Hend, float* carry) {
    const int gid = lbid() * NTHR + ltid();
    if (gid < (TS / SEQ) * 512) {
        const int bl = gid >> 9, c = gid & 511; float h = 0.f;
        for (int n = 0; n < 64; ++n) { const size_t o = (size_t)(bl * 64 + n) * 512 + c; carry[o] = h; h = Aend[o] * h + Hend[o]; }
    }
}

__device__ __forceinline__ void gdn_prep(LAS unsigned char* lds, const Params& p, int l, const bf16_t* proj, const float* AB, bf16_t* GQ, bf16_t* GK, bf16_t* GU, bf16_t* GW, bf16_t* GA, float* edec, int item) {
    const int tid = ltid(), wid = tid >> 6, lane = tid & 63, fr = lane & 15, fq = lane >> 4;
    const int bl = item >> 8, n = (item & 255) >> 2, hh = item & 3, ch = bl * 64 + n, t0 = ch * 64;
    LAS bf16_t* Kl = (LAS bf16_t*)lds;
    LAS bf16_t* Ql = (LAS bf16_t*)(lds + 17408);
    LAS float* RHS = (LAS float*)(lds + 34816);
    LAS float* Am = (LAS float*)(lds + 101376);
    LAS float* gc = (LAS float*)(lds + 117760);
    LAS float* bt = (LAS float*)(lds + 118016);
    const int t = tid >> 3, d0 = (tid & 7) * 16;
#pragma unroll
    for (int sec = 0; sec < 3; ++sec) {
        const int colh = sec * 512 + hh * 128 + d0;
        u32x4 w0[4], w1[4]; float msk[4];
#pragma unroll
        for (int k = 0; k < 4; ++k) {
            const int tt = t - 3 + k; const bool valid = (tt >= 0) || (n > 0);
            const bf16_t* src = proj + (long)(t0 + (valid ? tt : 0)) * PW + PC_CQ + colh;
            w0[k] = *(const u32x4*)src; w1[k] = *(const u32x4*)(src + 8); msk[k] = valid ? 1.0f : 0.0f;
        }
        float a[16];
#pragma unroll
        for (int e = 0; e < 16; ++e) a[e] = 0.f;
#pragma unroll
        for (int k = 0; k < 4; ++k) {
            const float* cwp = p.in[zz() + 18] + ((size_t)l * 4 + k) * 1536 + colh;
#pragma unroll
            for (int q = 0; q < 4; ++q) { const f32x4 c4 = *(const f32x4*)(cwp + q * 4) * msk[k];
                const unsigned wa = (q < 2) ? w0[k][2 * q] : w1[k][2 * q - 4], wb = (q < 2) ? w0[k][2 * q + 1] : w1[k][2 * q - 3];
                a[q * 4 + 0] += c4[0] * lo_bf(wa); a[q * 4 + 1] += c4[1] * hi_bf(wa); a[q * 4 + 2] += c4[2] * lo_bf(wb); a[q * 4 + 3] += c4[3] * hi_bf(wb); }
        }
#pragma unroll
        for (int e = 0; e < 16; ++e) a[e] = siluf_(a[e]);
        if (sec < 2) {
            float ss = 0.f;
#pragma unroll
            for (int e = 0; e < 16; ++e) ss += a[e] * a[e];
            ss += __shfl_xor(ss, 1); ss += __shfl_xor(ss, 2); ss += __shfl_xor(ss, 4);
            const float nrm = rsqrtf(ss + EPS) * (sec == 0 ? 0.08838834764831845f : 1.0f);
#pragma unroll
            for (int e = 0; e < 16; ++e) a[e] *= nrm;
            LAS bf16_t* X = sec == 0 ? Ql : Kl;
#pragma unroll
            for (int e = 0; e < 16; e += 2) *(LAS unsigned*)(X + t * 136 + d0 + e) = cvt_pk_bf16(a[e], a[e + 1]);
        }
        if (sec >= 1) {
            LAS float* R = RHS + t * 260 + (sec == 1 ? 128 : 0) + d0;
#pragma unroll
            for (int e = 0; e < 16; e += 4) *(LAS f32x4*)(R + e) = (f32x4){a[e], a[e + 1], a[e + 2], a[e + 3]};
        }
    }
    if (wid == 0) {
        const float al = AB[(size_t)(t0 + lane) * 8 + 4 + hh], be = AB[(size_t)(t0 + lane) * 8 + hh];
        float gv = -__expf(p.in[zz() + 19][l * 4 + hh]) * softplusf_(al + p.in[zz() + 20][l * 4 + hh]);
#pragma unroll
        for (int o = 1; o < 64; o <<= 1) { const float u = __shfl_up(gv, o); if (lane >= o) gv += u; }
        gc[lane] = gv; bt[lane] = sigmoidf_(be);
        if (lane == 63) edec[item] = __expf(gv);
    }
    __syncthreads();
    float kdv[16];
    {
        const float bet = bt[t], gct = gc[t], eg = __expf(gct), ekd = __expf(gc[63] - gct);
        LAS float* Rv = RHS + t * 260 + d0; LAS float* Rk = Rv + 128;
#pragma unroll
        for (int e = 0; e < 16; e += 4) { const f32x4 v4 = *(LAS f32x4*)(Rv + e), k4 = *(LAS f32x4*)(Rk + e);
            *(LAS f32x4*)(Rv + e) = v4 * bet; *(LAS f32x4*)(Rk + e) = k4 * (bet * eg);
            kdv[e] = k4[0] * ekd; kdv[e + 1] = k4[1] * ekd; kdv[e + 2] = k4[2] * ekd; kdv[e + 3] = k4[3] * ekd; }
        unsigned qw[8];
#pragma unroll
        for (int e = 0; e < 8; ++e) { const unsigned w = *(LAS unsigned*)(Ql + t * 136 + d0 + 2 * e); qw[e] = cvt_pk_bf16(lo_bf(w) * eg, hi_bf(w) * eg); }
        bf16_t* qdst = GQ + (size_t)(t0 + t) * 512 + hh * 128 + d0;
        *(u32x4*)qdst = (u32x4){qw[0], qw[1], qw[2], qw[3]}; *(u32x4*)(qdst + 8) = (u32x4){qw[4], qw[5], qw[6], qw[7]};
    }
    {
        const int it = wid & 3, which = wid >> 2;
        LAS bf16_t* Xi = which ? Ql : Kl;
        bf16x8 af[4];
#pragma unroll
        for (int ks = 0; ks < 4; ++ks) af[ks] = *(const LAS bf16x8*)(Xi + (it * 16 + fr) * 136 + ks * 32 + fq * 8);
        const int i = it * 16 + fr; const float gci = gc[i], bti = bt[i];
#pragma unroll
        for (int jt = 0; jt < 4; ++jt) {
            f32x4 acc = (f32x4){0.f, 0.f, 0.f, 0.f};
#pragma unroll
            for (int ks = 0; ks < 4; ++ks) { const bf16x8 bf = *(const LAS bf16x8*)(Kl + (jt * 16 + fr) * 136 + ks * 32 + fq * 8); acc = __builtin_amdgcn_mfma_f32_16x16x32_bf16(bf, af[ks], acc, 0, 0, 0); }
            float v[4];
#pragma unroll
            for (int jj = 0; jj < 4; ++jj) { const int j = jt * 16 + fq * 4 + jj; const float dec = (i >= j) ? __expf(gci - gc[j]) : 0.f;
                v[jj] = which ? acc[jj] * dec : ((i > j) ? bti * acc[jj] * dec : 0.f); }
            if (which) { u32x2 o; o.x = cvt_pk_bf16(v[0], v[1]); o.y = cvt_pk_bf16(v[2], v[3]); *(u32x2*)(GA + (size_t)(t0 + i) * 256 + hh * 64 + jt * 16 + fq * 4) = o; }
            else *(LAS f32x4*)(Am + i * 64 + jt * 16 + fq * 4) = (f32x4){v[0], v[1], v[2], v[3]};
        }
    }
    __syncthreads();
    {
        LAS bf16_t* KDT = Ql;
#pragma unroll
        for (int e = 0; e < 16; ++e) KDT[(d0 + e) * 68 + t] = f2bf(kdv[e]);
    }
    if (tid < 256) {
        float x[64];
        int lz; asm volatile("v_mov_b32 %0, 0" : "=v"(lz));
        const LAS float* Amz = Am + lz;
#pragma unroll
        for (int i = 0; i < 64; ++i) x[i] = 0.f;
#pragma unroll
        for (int i = 0; i < 64; ++i) {
            float s = RHS[i * 260 + tid], s1 = 0.f, s2 = 0.f, s3 = 0.f;
#pragma unroll
            for (int j4 = 0; j4 < (i + 3) / 4; ++j4) { const f32x4 a4 = *(const LAS f32x4*)(Amz + i * 64 + j4 * 4);
                s -= a4[0] * x[j4 * 4]; s1 -= a4[1] * x[j4 * 4 + 1]; s2 -= a4[2] * x[j4 * 4 + 2]; s3 -= a4[3] * x[j4 * 4 + 3]; }
            s = (s + s1) + (s2 + s3);
            x[i] = s; RHS[i * 260 + tid] = s;
        }
    }
    __syncthreads();
    {
        const int seg = tid & 7;
        const LAS float* xr = RHS + t * 260 + seg * 32;
        bf16_t* dst = ((seg < 4) ? GU : GW) + (size_t)(t0 + t) * 512 + hh * 128 + (seg & 3) * 32;
#pragma unroll
        for (int q = 0; q < 4; ++q) { const f32x4 a = *(const LAS f32x4*)(xr + q * 8), b = *(const LAS f32x4*)(xr + q * 8 + 4);
            u32x4 w; w.x = cvt_pk_bf16(a[0], a[1]); w.y = cvt_pk_bf16(a[2], a[3]); w.z = cvt_pk_bf16(b[0], b[1]); w.w = cvt_pk_bf16(b[2], b[3]); *(u32x4*)(dst + q * 8) = w; }
        const LAS bf16_t* kr = Ql + (2 * t + (seg >> 2)) * 68 + (seg & 3) * 16;
        const u32x2 k0 = *(const LAS u32x2*)kr, k1 = *(const LAS u32x2*)(kr + 4), k2 = *(const LAS u32x2*)(kr + 8), k3 = *(const LAS u32x2*)(kr + 12);
        bf16_t* kdst = GK + (size_t)(t0 + t) * 512 + hh * 128 + seg * 16;
        *(u32x4*)kdst = (u32x4){k0.x, k0.y, k1.x, k1.y}; *(u32x4*)(kdst + 8) = (u32x4){k2.x, k2.y, k3.x, k3.y};
    }
    __syncthreads();
}

template <int OFF> __device__ __forceinline__ void dsr64(u32x2& d, unsigned addr) { asm volatile("ds_read_b64 %0, %1 offset:%2" : "=v"(d) : "v"(addr), "n"(OFF)); }
__device__ __forceinline__ void lgkm_wait8(u32x2& a, u32x2& b, u32x2& c, u32x2& d, u32x2& e, u32x2& f, u32x2& g, u32x2& h) {
    asm volatile("s_waitcnt lgkmcnt(0)" : "+v"(a), "+v"(b), "+v"(c), "+v"(d), "+v"(e), "+v"(f), "+v"(g), "+v"(h)); }
template <int RS  , int NK, int NM> struct FragSet { u32x2 lo[NK][NM], hi[NK][NM]; };
__device__ __forceinline__ void gdn_scan(LAS unsigned char* lds, const unsigned char* ws, float* oraw, const float* edec, int chain) {
    const int tid = ltid(), wid = __builtin_amdgcn_readfirstlane(tid >> 6), lane = tid & 63, fr = lane & 15, fq = lane >> 4;
    const int bl = chain >> 5, hh = (chain >> 3) & 3, es = chain & 7, e0 = es * 16;
    constexpr int BUF = 64512, O_W = 0, O_Q = 17408, O_KT = 34816, O_AT = 53248, O_U = 62464, O_PS = 2 * BUF, O_PV = 2 * BUF + 4096;
    const unsigned rb = (unsigned)(bl * 64) * 64u;
    const bool stager = (wid >= 2);
    unsigned soff[11];
#pragma unroll
    for (int i = 0; i < 11; ++i) {
        const int blk = (wid - 2) + 6 * i;
        const int q = blk * 64 + lane;
        unsigned o = 0u;
        if (stager && blk < 63) {
            if (q < 1088) { const int row = q / 17, pc = min(q % 17, 15); o = (unsigned)(WS_GDW + ((size_t)(rb + row) * 512 + hh * 128 + pc * 8) * 2); }
            else if (q < 2176) { const int q2 = q - 1088, row = q2 / 17, pc = min(q2 % 17, 15); o = (unsigned)(WS_GDQ + ((size_t)(rb + row) * 512 + hh * 128 + pc * 8) * 2); }
            else if (q < 3328) { const int q2 = q - 2176, d = q2 / 9, pc = min(q2 % 9, 7); o = (unsigned)(WS_GDK + ((size_t)(rb + (d >> 1)) * 512 + hh * 128 + (d & 1) * 64 + pc * 8) * 2); }
            else if (q < 3904) { const int q2 = q - 3328, row = q2 / 9, pc = min(q2 % 9, 7); o = (unsigned)(WS_GDA + ((size_t)(rb + row) * 256 + hh * 64 + pc * 8) * 2); }
            else { const int q2 = q - 3904, row = q2 >> 1, pc = q2 & 1; o = (unsigned)(WS_GDU + ((size_t)(rb + row) * 512 + hh * 128 + e0 + pc * 8) * 2); }
        }
        soff[i] = o;
    }
#define SCAN_DMA(chunk, bufsel) do { _Pragma("unroll") for (int i = 0; i < 11; ++i) { const int blk = (wid - 2) + 6 * i; if (blk < 63) { \
        const unsigned stp = (blk >= 52 && blk < 61) ? 32768u : 65536u; \
        __builtin_amdgcn_global_load_lds((const unsigned*)(ws + soff[i] + (unsigned)(chunk) * stp), (LAS unsigned*)(lds + (bufsel) * BUF + blk * 1024), 16, 0, 0); } } } while (0)
    if (stager) { SCAN_DMA(0, 0); asm volatile("s_waitcnt vmcnt(0)" ::: "memory"); }
    if (wid == 1) {
#pragma unroll
        for (int kt = 0; kt < 4; ++kt) *(LAS u32x4*)(lds + O_PS + kt * 1024 + lane * 16) = (u32x4){0u, 0u, 0u, 0u};
    }
    const float dv = edec[bl * 256 + lane * 4 + hh];
    f32x4 Sacc[8];
#pragma unroll
    for (int d = 0; d < 8; ++d) Sacc[d] = (f32x4){0.f, 0.f, 0.f, 0.f};
    __syncthreads();
    for (int n = 0; n < 64; ++n) {
        const LAS unsigned char* B = lds + (n & 1) * BUF;
        const int t0 = (bl * 64 + n) * 64;
        f32x4 OS[4];
        bf16x8 vb[2];
        if (stager) { if (n + 1 < 64) SCAN_DMA(n + 1, (n + 1) & 1); }
        else if (wid == 0) {
            f32x4 WS[4];
            bf16x8 sb[4];
#pragma unroll
            for (int kt = 0; kt < 4; ++kt) { u32x4 w; w.x = cvt_pk_bf16(Sacc[2 * kt][0], Sacc[2 * kt][1]); w.y = cvt_pk_bf16(Sacc[2 * kt][2], Sacc[2 * kt][3]);
                w.z = cvt_pk_bf16(Sacc[2 * kt + 1][0], Sacc[2 * kt + 1][1]); w.w = cvt_pk_bf16(Sacc[2 * kt + 1][2], Sacc[2 * kt + 1][3]); sb[kt] = __builtin_bit_cast(bf16x8, w); }
#pragma unroll
            for (int m = 0; m < 4; ++m) WS[m] = (f32x4){0.f, 0.f, 0.f, 0.f};
            {
                u32x2 wlo[4][4], whi[4][4];
                const unsigned bw = (unsigned)(unsigned long)(B + O_W + (fr * 136 + fq * 4) * 2);
                dsr64<0>(wlo[0][0], bw); dsr64<32>(whi[0][0], bw);
                dsr64<4352>(wlo[0][1], bw); dsr64<4384>(whi[0][1], bw);
                dsr64<8704>(wlo[0][2], bw); dsr64<8736>(whi[0][2], bw);
                dsr64<13056>(wlo[0][3], bw); dsr64<13088>(whi[0][3], bw);
                dsr64<64>(wlo[1][0], bw); dsr64<96>(whi[1][0], bw);
                dsr64<4416>(wlo[1][1], bw); dsr64<4448>(whi[1][1], bw);
                dsr64<8768>(wlo[1][2], bw); dsr64<8800>(whi[1][2], bw);
                dsr64<13120>(wlo[1][3], bw); dsr64<13152>(whi[1][3], bw);
                dsr64<128>(wlo[2][0], bw); dsr64<160>(whi[2][0], bw);
                dsr64<4480>(wlo[2][1], bw); dsr64<4512>(whi[2][1], bw);
                dsr64<8832>(wlo[2][2], bw); dsr64<8864>(whi[2][2], bw);
                dsr64<13184>(wlo[2][3], bw); dsr64<13216>(whi[2][3], bw);
                dsr64<192>(wlo[3][0], bw); dsr64<224>(whi[3][0], bw);
                dsr64<4544>(wlo[3][1], bw); dsr64<4576>(whi[3][1], bw);
                dsr64<8896>(wlo[3][2], bw); dsr64<8928>(whi[3][2], bw);
                dsr64<13248>(wlo[3][3], bw); dsr64<13280>(whi[3][3], bw);
                lgkm_wait8(wlo[0][0], wlo[0][1], wlo[0][2], wlo[0][3], wlo[1][0], wlo[1][1], wlo[1][2], wlo[1][3]);
                lgkm_wait8(wlo[2][0], wlo[2][1], wlo[2][2], wlo[2][3], wlo[3][0], wlo[3][1], wlo[3][2], wlo[3][3]);
                lgkm_wait8(whi[0][0], whi[0][1], whi[0][2], whi[0][3], whi[1][0], whi[1][1], whi[1][2], whi[1][3]);
                lgkm_wait8(whi[2][0], whi[2][1], whi[2][2], whi[2][3], whi[3][0], whi[3][1], whi[3][2], whi[3][3]);
#pragma unroll
                for (int kt = 0; kt < 4; ++kt)
#pragma unroll
                    for (int m = 0; m < 4; ++m) WS[m] = __builtin_amdgcn_mfma_f32_16x16x32_bf16(__builtin_bit_cast(bf16x8, (u32x4){wlo[kt][m].x, wlo[kt][m].y, whi[kt][m].x, whi[kt][m].y}), sb[kt], WS[m], 0, 0, 0);
            }
#pragma unroll
            for (int m = 0; m < 4; ++m)
#pragma unroll
                for (int jj = 0; jj < 4; ++jj) WS[m][jj] = bf2f(*(const LAS bf16_t*)(B + O_U + ((m * 16 + fq * 4 + jj) * 16 + fr) * 2)) - WS[m][jj];
#pragma unroll
            for (int kc = 0; kc < 2; ++kc) { u32x4 w; w.x = cvt_pk_bf16(WS[2 * kc][0], WS[2 * kc][1]); w.y = cvt_pk_bf16(WS[2 * kc][2], WS[2 * kc][3]);
                w.z = cvt_pk_bf16(WS[2 * kc + 1][0], WS[2 * kc + 1][1]); w.w = cvt_pk_bf16(WS[2 * kc + 1][2], WS[2 * kc + 1][3]); vb[kc] = __builtin_bit_cast(bf16x8, w);
                *(LAS u32x4*)(lds + O_PV + kc * 1024 + lane * 16) = w; }
        } else if (wid == 1) {
#pragma unroll
            for (int m = 0; m < 4; ++m) OS[m] = (f32x4){0.f, 0.f, 0.f, 0.f};
            {
                u32x2 qlo[4][4], qhi[4][4]; bf16x8 sbr[4];
#pragma unroll
                for (int kt = 0; kt < 4; ++kt) sbr[kt] = *(const LAS bf16x8*)(lds + O_PS + kt * 1024 + lane * 16);
                const unsigned bq = (unsigned)(unsigned long)(B + O_Q + (fr * 136 + fq * 4) * 2);
                dsr64<0>(qlo[0][0], bq); dsr64<32>(qhi[0][0], bq);
                dsr64<4352>(qlo[0][1], bq); dsr64<4384>(qhi[0][1], bq);
                dsr64<8704>(qlo[0][2], bq); dsr64<8736>(qhi[0][2], bq);
                dsr64<13056>(qlo[0][3], bq); dsr64<13088>(qhi[0][3], bq);
                dsr64<64>(qlo[1][0], bq); dsr64<96>(qhi[1][0], bq);
                dsr64<4416>(qlo[1][1], bq); dsr64<4448>(qhi[1][1], bq);
                dsr64<8768>(qlo[1][2], bq); dsr64<8800>(qhi[1][2], bq);
                dsr64<13120>(qlo[1][3], bq); dsr64<13152>(qhi[1][3], bq);
                dsr64<128>(qlo[2][0], bq); dsr64<160>(qhi[2][0], bq);
                dsr64<4480>(qlo[2][1], bq); dsr64<4512>(qhi[2][1], bq);
                dsr64<8832>(qlo[2][2], bq); dsr64<8864>(qhi[2][2], bq);
                dsr64<13184>(qlo[2][3], bq); dsr64<13216>(qhi[2][3], bq);
                dsr64<192>(qlo[3][0], bq); dsr64<224>(qhi[3][0], bq);
                dsr64<4544>(qlo[3][1], bq); dsr64<4576>(qhi[3][1], bq);
                dsr64<8896>(qlo[3][2], bq); dsr64<8928>(qhi[3][2], bq);
                dsr64<13248>(qlo[3][3], bq); dsr64<13280>(qhi[3][3], bq);
                lgkm_wait8(qlo[0][0], qlo[0][1], qlo[0][2], qlo[0][3], qlo[1][0], qlo[1][1], qlo[1][2], qlo[1][3]);
                lgkm_wait8(qlo[2][0], qlo[2][1], qlo[2][2], qlo[2][3], qlo[3][0], qlo[3][1], qlo[3][2], qlo[3][3]);
                lgkm_wait8(qhi[0][0], qhi[0][1], qhi[0][2], qhi[0][3], qhi[1][0], qhi[1][1], qhi[1][2], qhi[1][3]);
                lgkm_wait8(qhi[2][0], qhi[2][1], qhi[2][2], qhi[2][3], qhi[3][0], qhi[3][1], qhi[3][2], qhi[3][3]);
#pragma unroll
                for (int kt = 0; kt < 4; ++kt)
#pragma unroll
                    for (int m = 0; m < 4; ++m) OS[m] = __builtin_amdgcn_mfma_f32_16x16x32_bf16(__builtin_bit_cast(bf16x8, (u32x4){qlo[kt][m].x, qlo[kt][m].y, qhi[kt][m].x, qhi[kt][m].y}), sbr[kt], OS[m], 0, 0, 0);
            }
        }
        asm volatile("s_waitcnt lgkmcnt(0)" ::: "memory"); __builtin_amdgcn_s_barrier(); asm volatile("" ::: "memory");
        if (wid == 0) {
            const float dec = __shfl(dv, n);
#pragma unroll
            for (int d = 0; d < 8; ++d) Sacc[d] *= dec;
            {
                u32x2 klo[2][8], khi[2][8];
                const unsigned bk = (unsigned)(unsigned long)(B + O_KT + (fr * 72 + fq * 4) * 2);
                dsr64<0>(klo[0][0], bk); dsr64<32>(khi[0][0], bk);
                dsr64<2304>(klo[0][1], bk); dsr64<2336>(khi[0][1], bk);
                dsr64<4608>(klo[0][2], bk); dsr64<4640>(khi[0][2], bk);
                dsr64<6912>(klo[0][3], bk); dsr64<6944>(khi[0][3], bk);
                dsr64<9216>(klo[0][4], bk); dsr64<9248>(khi[0][4], bk);
                dsr64<11520>(klo[0][5], bk); dsr64<11552>(khi[0][5], bk);
                dsr64<13824>(klo[0][6], bk); dsr64<13856>(khi[0][6], bk);
                dsr64<16128>(klo[0][7], bk); dsr64<16160>(khi[0][7], bk);
                dsr64<64>(klo[1][0], bk); dsr64<96>(khi[1][0], bk);
                dsr64<2368>(klo[1][1], bk); dsr64<2400>(khi[1][1], bk);
                dsr64<4672>(klo[1][2], bk); dsr64<4704>(khi[1][2], bk);
                dsr64<6976>(klo[1][3], bk); dsr64<7008>(khi[1][3], bk);
                dsr64<9280>(klo[1][4], bk); dsr64<9312>(khi[1][4], bk);
                dsr64<11584>(klo[1][5], bk); dsr64<11616>(khi[1][5], bk);
                dsr64<13888>(klo[1][6], bk); dsr64<13920>(khi[1][6], bk);
                dsr64<16192>(klo[1][7], bk); dsr64<16224>(khi[1][7], bk);
                lgkm_wait8(klo[0][0], klo[0][1], klo[0][2], klo[0][3], klo[0][4], klo[0][5], klo[0][6], klo[0][7]);
                lgkm_wait8(klo[1][0], klo[1][1], klo[1][2], klo[1][3], klo[1][4], klo[1][5], klo[1][6], klo[1][7]);
                lgkm_wait8(khi[0][0], khi[0][1], khi[0][2], khi[0][3], khi[0][4], khi[0][5], khi[0][6], khi[0][7]);
                lgkm_wait8(khi[1][0], khi[1][1], khi[1][2], khi[1][3], khi[1][4], khi[1][5], khi[1][6], khi[1][7]);
#pragma unroll
                for (int kc = 0; kc < 2; ++kc)
#pragma unroll
                    for (int d = 0; d < 8; ++d) Sacc[d] = __builtin_amdgcn_mfma_f32_16x16x32_bf16(__builtin_bit_cast(bf16x8, (u32x4){klo[kc][d].x, klo[kc][d].y, khi[kc][d].x, khi[kc][d].y}), vb[kc], Sacc[d], 0, 0, 0);
            }
#pragma unroll
            for (int kt = 0; kt < 4; ++kt) { u32x4 w; w.x = cvt_pk_bf16(Sacc[2 * kt][0], Sacc[2 * kt][1]); w.y = cvt_pk_bf16(Sacc[2 * kt][2], Sacc[2 * kt][3]);
                w.z = cvt_pk_bf16(Sacc[2 * kt + 1][0], Sacc[2 * kt + 1][1]); w.w = cvt_pk_bf16(Sacc[2 * kt + 1][2], Sacc[2 * kt + 1][3]);
                *(LAS u32x4*)(lds + O_PS + kt * 1024 + lane * 16) = w; }
        } else if (wid == 1) {
            {
                u32x2 alo[2][4], ahi[2][4]; bf16x8 vbr[2];
#pragma unroll
                for (int kc = 0; kc < 2; ++kc) vbr[kc] = *(const LAS bf16x8*)(lds + O_PV + kc * 1024 + lane * 16);
                const unsigned ba = (unsigned)(unsigned long)(B + O_AT + (fr * 72 + fq * 4) * 2);
                dsr64<0>(alo[0][0], ba); dsr64<32>(ahi[0][0], ba);
                dsr64<2304>(alo[0][1], ba); dsr64<2336>(ahi[0][1], ba);
                dsr64<4608>(alo[0][2], ba); dsr64<4640>(ahi[0][2], ba);
                dsr64<6912>(alo[0][3], ba); dsr64<6944>(ahi[0][3], ba);
                dsr64<64>(alo[1][0], ba); dsr64<96>(ahi[1][0], ba);
                dsr64<2368>(alo[1][1], ba); dsr64<2400>(ahi[1][1], ba);
                dsr64<4672>(alo[1][2], ba); dsr64<4704>(ahi[1][2], ba);
                dsr64<6976>(alo[1][3], ba); dsr64<7008>(ahi[1][3], ba);
                lgkm_wait8(alo[0][0], alo[0][1], alo[0][2], alo[0][3], alo[1][0], alo[1][1], alo[1][2], alo[1][3]);
                lgkm_wait8(ahi[0][0], ahi[0][1], ahi[0][2], ahi[0][3], ahi[1][0], ahi[1][1], ahi[1][2], ahi[1][3]);
#pragma unroll
                for (int kc = 0; kc < 2; ++kc)
#pragma unroll
                    for (int m = 0; m < 4; ++m) OS[m] = __builtin_amdgcn_mfma_f32_16x16x32_bf16(__builtin_bit_cast(bf16x8, (u32x4){alo[kc][m].x, alo[kc][m].y, ahi[kc][m].x, ahi[kc][m].y}), vbr[kc], OS[m], 0, 0, 0);
            }
            float* op = oraw + (size_t)(t0 + fq * 4) * 512 + hh * 128 + e0 + fr;
#pragma unroll
            for (int m = 0; m < 4; ++m)
#pragma unroll
                for (int jj = 0; jj < 4; ++jj) op[(size_t)(m * 16 + jj) * 512] = OS[m][jj];
        } else if (stager) {
            asm volatile("s_waitcnt vmcnt(0)" ::: "memory");
        }
        __syncthreads();
    }
#undef SCAN_DMA
}
__device__ __forceinline__ void gdn_out(const Params& p, int l, const float* oraw, const bf16_t* proj, bf16_t* yc) {
    const int tid = ltid(), sub = tid & 15;
    const float* ng = p.in[zz() + 21] + l * 128 + sub * 8;
    const f32x4 g0 = *(const f32x4*)ng, g1 = *(const f32x4*)(ng + 4);
    for (int rowi = lbid() * 32 + (tid >> 4); rowi < TS * 4; rowi += lgdim() * 32) {
        const int t = rowi >> 2, hh = rowi & 3;
        const float* op = oraw + (size_t)t * 512 + hh * 128 + sub * 8;
        const f32x4 o0 = *(const f32x4*)op, o1 = *(const f32x4*)(op + 4);
        float ss = (o0[0] * o0[0] + o0[1] * o0[1]) + (o0[2] * o0[2] + o0[3] * o0[3]) + (o1[0] * o1[0] + o1[1] * o1[1]) + (o1[2] * o1[2] + o1[3] * o1[3]);
        ss += __shfl_xor(ss, 1); ss += __shfl_xor(ss, 2); ss += __shfl_xor(ss, 4); ss += __shfl_xor(ss, 8);
        const float rs = rsqrtf(ss * (1.0f / 128.0f) + EPS);
        const u32x4 z = *(const u32x4*)(proj + (size_t)t * PW + PC_CZ + hh * 128 + sub * 8);
        u32x4 w;
        w.x = cvt_pk_bf16(o0[0] * rs * g0[0] * siluf_(lo_bf(z.x)), o0[1] * rs * g0[1] * siluf_(hi_bf(z.x)));
        w.y = cvt_pk_bf16(o0[2] * rs * g0[2] * siluf_(lo_bf(z.y)), o0[3] * rs * g0[3] * siluf_(hi_bf(z.y)));
        w.z = cvt_pk_bf16(o1[0] * rs * g1[0] * siluf_(lo_bf(z.z)), o1[1] * rs * g1[1] * siluf_(hi_bf(z.z)));
        w.w = cvt_pk_bf16(o1[2] * rs * g1[2] * siluf_(lo_bf(z.w)), o1[3] * rs * g1[3] * siluf_(hi_bf(z.w)));
        *(u32x4*)(yc + (size_t)t * 512 + hh * 128 + sub * 8) = w;
    }
}

constexpr int PH_PER_LAYER = 22, N_PHASES = 2 * PH_PER_LAYER + 1;

__device__ __forceinline__ void run_phase(LAS unsigned char* lds, const Params& p, int ph) {
    unsigned char* ws = lptr(p.ws);
    bf16_t* hbuf = (bf16_t*)(ws + WS_H);
    bf16_t* act = (bf16_t*)(ws + WS_PROJ);
    bf16_t* proj = (bf16_t*)(ws + WS_PROJ);
    bf16_t* hslab = hbuf;
    bf16_t* merged = hbuf + (size_t)TS * D;
    float* oraw = (float*)(ws + WS_H);
    bf16_t* ys = (bf16_t*)(ws + WS_YS);
    float* AB = (float*)(ws + WS_AB);
    bf16_t* halo = (bf16_t*)(ws + WS_HALO);
    float* Aend = (float*)(ws + WS_AEND); float* Hend = (float*)(ws + WS_HEND); float* carry = (float*)(ws + WS_CARRY); float* edec = (float*)(ws + WS_EDEC);
    const bf16_t* waxt = (const bf16_t*)(ws + WS_WAXT); const bf16_t* pwt = (const bf16_t*)(ws + WS_PWT);
    const int G = lgdim(), c = lbid();
    if (ph == N_PHASES - 1) { PHON(0) rms_rows_f32_inplace(lptr(p.out), p.in[zz() + 30], T); return; }
    const int l = ph / PH_PER_LAYER, r = ph % PH_PER_LAYER;
    const float* xcur = (l == 0) ? p.in[zz() + 0] : lptr(p.out);
    if (r == 0) { PHON(1) convert_layer(lds, p, l); PHON(0) rms_rows_bf16(xcur, p.in[zz() + 1] + l * D, hbuf, T); return; }
    if (r == 1 || r == 20) { PHON(2) ph_gemm_swiglu(lds, hbuf, (const bf16_t*)(ws + (r == 1 ? WS_WGU1 : WS_WGU2)), act); return; }
    if (r == 2 || r == 21) { PHON(3) ph_gemm_resid(lds, act, (const bf16_t*)(ws + (r == 2 ? WS_WD1 : WS_WD2)), T, DFF, (r == 2) ? xcur : lptr(p.out), lptr(p.out), 0.5f); return; }
    if (r == 19) { rms_rows_bf16(lptr(p.out), p.in[zz() + 26] + l * D, hbuf, T); return; }
    const int slab = (r - 3) >> 3, q = (r - 3) & 7;
    float* xs = lptr(p.out) + (size_t)slab * TS * D;
    switch (q) {
    case 0: if (slab == 0) rms_rows_bf16(xs, p.in[zz() + 5] + l * D, hslab, TS); break;
    case 1: PHON(4) ph_gemm_proj(lds, hslab, (const bf16_t*)(ws + WS_WIN), proj, AB); break;
    case 2:
        PHON(7) for (int t = c; t < TS / 64; t += G) lru_tile(lds, p, l, proj, nullptr, waxt, Aend, Hend, carry, t, 0);
        if (G >= 256) { PHON(5) for (int t = c; t < (TS / 128) * 2; t += G) sgu_tile(lds, p, l, proj, ys, t); }
        break;
    case 3:
        PHON(8) for (int it = c; it < (TS / 64) * 4; it += G) gdn_prep(lds, p, l, proj, AB, (bf16_t*)(ws + WS_GDQ), (bf16_t*)(ws + WS_GDK), (bf16_t*)(ws + WS_GDU), (bf16_t*)(ws + WS_GDW), (bf16_t*)(ws + WS_GDA), edec, it);
        lru_carry(Aend, Hend, carry);
        break;
    case 4:
        PHON(9) if (c < 128 || G < 256) { for (int ch = c; ch < 128; ch += G) gdn_scan(lds, ws, oraw, edec, ch); }
        if (G >= 256 && c < 128) { PHON(6) for (int t = c; t < TS / 128; t += 128) pool_tile(lds, p, l, proj, ys + (size_t)3 * TS * 512, halo, pwt, t); }
        if (G >= 256) {
            if (c >= 128) {
                const int cc = c - 128, GG = G - 128;
                PHON(10) for (int t = cc; t < TS / 128; t += GG) lru_tile(lds, p, l, proj, ys + (size_t)TS * 512, waxt, Aend, Hend, carry, t, 1);
                PHON(5) for (int t = (TS / 128) * 2 + cc; t < (TS / 128) * 4; t += GG) sgu_tile(lds, p, l, proj, ys, t);
                PHON(6) for (int t = TS / 128 + cc; t < TS / 64; t += GG) pool_tile(lds, p, l, proj, ys + (size_t)3 * TS * 512, halo, pwt, t);
            }
        } else {
            for (int t = c; t < TS / 64; t += G) lru_tile(lds, p, l, proj, ys + (size_t)TS * 512, waxt, Aend, Hend, carry, t, 1);
            for (int t = c; t < (TS / 128) * 4; t += G) sgu_tile(lds, p, l, proj, ys, t);
            for (int t = c; t < TS / 64; t += G) pool_tile(lds, p, l, proj, ys + (size_t)3 * TS * 512, halo, pwt, t);
        }
        break;
    case 5: if (G >= 256) { for (int t = TS / 128 + c; t < TS / 64; t += G) lru_tile(lds, p, l, proj, ys + (size_t)TS * 512, waxt, Aend, Hend, carry, t, 1); }
        PHON(11) gdn_out(p, l, oraw, proj, ys + (size_t)2 * TS * 512); break;
    case 6: PHON(12) ph_gemm_branch(lds, ys, (const bf16_t*)(ws + WS_WB), proj, merged); break;
    default: PHON(13) ph_gemm_resid(lds, merged, (const bf16_t*)(ws + WS_WOUT), TS, D, xs, xs, 1.0f);
        if (slab == 0) rms_rows_bf16(lptr(p.out) + (size_t)TS * D, p.in[zz() + 5] + l * D, hslab, TS);
        break;
    }
}

extern __shared__ __attribute__((aligned(16))) unsigned char smem_dyn[];

#ifndef DUP_TYPE
#define DUP_TYPE -1
#endif
__device__ __forceinline__ int phase_type(int ph) {
    if (ph == N_PHASES - 1) return 12;
    const int r = ph % PH_PER_LAYER;
    if (r == 0) return 0; if (r == 1 || r == 20) return 1; if (r == 2 || r == 21) return 2; if (r == 19) return 11;
    const int q = (r - 3) & 7;
    return 3 + q;
}
__global__ void __launch_bounds__(NTHR) fwd_megakernel(Params p) {
    cg::grid_group grid = cg::this_grid();
    LAS unsigned char* lds = (LAS unsigned char*)smem_dyn;
    volatile LAS unsigned* st = (volatile LAS unsigned*)(lds + LDS_BYTES - 16);
    if (threadIdx.x == 0) { st[0] = 0u; st[1] = 0u; }
    __syncthreads();
    const XcdBarrier xb = xcd_barrier_post((unsigned*)(p.ws + WS_BAR), st);
    if (p.ph_hi < 0) grid.sync();
    for (int ph = p.ph_lo; ph < p.ph_hi; ++ph) {
        if (ph != N_PHASES - 1 && ph % PH_PER_LAYER == 11) continue;
        if (ph > p.ph_lo) xcd_barrier(xb);
        run_phase(lds, p, ph);
#if DUP_TYPE == 6
        if (phase_type(ph) == 6) { xcd_barrier(xb); run_phase(lds, p, ph - 2); xcd_barrier(xb); run_phase(lds, p, ph - 1); xcd_barrier(xb); run_phase(lds, p, ph); }
#elif DUP_TYPE >= 0
        if (phase_type(ph) == DUP_TYPE) { xcd_barrier(xb); run_phase(lds, p, ph); }
#endif
    }
}

extern "C" void kernel_launch(void* const* d_in, const int* in_sizes, int n_in, void* d_out, int out_size, void* d_ws, size_t ws_size, hipStream_t stream) {
    static int grid_blocks = 0;
    if (grid_blocks == 0) {
        if (n_in != 31 || out_size != T * D || ws_size < WS_END) { fprintf(stderr, "kernel_launch: unexpected shapes (n_in %d out %d ws %zu need %zu)\n", n_in, out_size, ws_size, (size_t)WS_END); grid_blocks = -1; return; }
        int dev = 0, cus = 0, per_cu = 0;
        hipGetDevice(&dev);
        hipDeviceGetAttribute(&cus, hipDeviceAttributeMultiprocessorCount, dev);
        if (hipFuncSetAttribute((const void*)fwd_megakernel, hipFuncAttributeMaxDynamicSharedMemorySize, LDS_BYTES) != hipSuccess) { fprintf(stderr, "kernel_launch: hipFuncSetAttribute failed\n"); grid_blocks = -1; return; }
        hipOccupancyMaxActiveBlocksPerMultiprocessor(&per_cu, (const void*)fwd_megakernel, NTHR, LDS_BYTES);
        if (per_cu < 1) { fprintf(stderr, "kernel_launch: occupancy query returned %d\n", per_cu); per_cu = 1; }
        grid_blocks = cus * per_cu;
    }
    if (grid_blocks < 0) return;
    Params p{};
    for (int i = 0; i < 31; ++i) p.in[i] = (const float*)d_in[i];
    p.out = (float*)d_out; p.ws = (unsigned char*)d_ws;
    hipMemsetAsync((unsigned char*)d_ws + WS_BAR, 0, 16384, stream);
    p.ph_lo = 0; p.ph_hi = N_PHASES;
    void* args[] = {&p};
    hipError_t e = hipLaunchCooperativeKernel((const void*)fwd_megakernel, dim3(grid_blocks), dim3(NTHR), args, LDS_BYTES, stream);
    if (e != hipSuccess) fprintf(stderr, "cooperative launch failed: %s (grid %d)\n", hipGetErrorString(e), grid_blocks);
}
```

```cpp
#include <hip/hip_runtime.h>
#include <hip/hip_cooperative_groups.h>
#include <cstdio>
namespace cg = cooperative_groups;

#ifndef MULTI_LAUNCH
#define MULTI_LAUNCH 0
#endif

#ifndef PH_MASK
#define PH_MASK 0xFFFFF
#endif
#define PHON(k) if constexpr ((PH_MASK >> (k)) & 1)
#define LAS __attribute__((address_space(3)))
typedef unsigned short bf16_t;
typedef short bf16x8 __attribute__((ext_vector_type(8)));
typedef short bf16x4 __attribute__((ext_vector_type(4)));
typedef float f32x4 __attribute__((ext_vector_type(4)));
typedef unsigned u32x4 __attribute__((ext_vector_type(4)));
typedef unsigned u32x2 __attribute__((ext_vector_type(2)));

constexpr int T = 32768, D = 1024, DFF = 2816, NSLAB = 2, TS = T / NSLAB, SEQ = 4096, PW = 8960, PIN = 8712;
constexpr int PC_AU = 0, PC_AV = 512, PC_BX = 1024, PC_BG = 1536, PC_CQ = 2048, PC_CK = 2560, PC_CV = 3072, PC_CZ = 3584, PC_DX = 4096, PC_GATE = 4608, PC_AB = 8704;
constexpr float EPS = 1e-6f;
constexpr int NTHR = 512;
constexpr int LDS_BYTES = 147456;

constexpr size_t WS_WGU1 = 0;
constexpr size_t WS_WD1 = WS_WGU1 + (size_t)5632 * 1024 * 2;
constexpr size_t WS_WIN = WS_WD1 + (size_t)1024 * 2816 * 2;
constexpr size_t WS_WB = WS_WIN + (size_t)PW * 1024 * 2;
constexpr size_t WS_WOUT = WS_WB + (size_t)4 * 1024 * 512 * 2;
constexpr size_t WS_WGU2 = WS_WOUT + (size_t)1024 * 1024 * 2;
constexpr size_t WS_WD2 = WS_WGU2 + (size_t)5632 * 1024 * 2;
constexpr size_t WS_WAXT = WS_WD2 + (size_t)1024 * 2816 * 2;
constexpr size_t WS_PWT = WS_WAXT + 131072;
constexpr size_t WS_PROJ = WS_PWT + 131072;
constexpr size_t WS_H = WS_PROJ + (size_t)TS * PW * 2;
constexpr size_t WS_YS = WS_H + (size_t)T * D * 2;
constexpr size_t WS_AB = WS_YS + (size_t)4 * TS * 512 * 2;
constexpr size_t WS_HALO = WS_AB + (size_t)TS * 8 * 4;
constexpr size_t WS_AEND = WS_HALO + (size_t)(TS / 64) * 3 * 1536 * 2;
constexpr size_t WS_HEND = WS_AEND + (size_t)(TS / 64) * 512 * 4;
constexpr size_t WS_CARRY = WS_HEND + (size_t)(TS / 64) * 512 * 4;
constexpr size_t WS_EDEC = WS_CARRY + (size_t)(TS / 64) * 512 * 4;
constexpr size_t WS_BAR = WS_EDEC + 4096;
constexpr size_t WS_GDQ = WS_H + (size_t)TS * D * 2;
constexpr size_t WS_GDK = WS_GDQ + (size_t)TS * 512 * 2;
constexpr size_t WS_GDU = WS_BAR + 16384;
constexpr size_t WS_GDW = WS_GDU + (size_t)TS * 512 * 2;
constexpr size_t WS_GDA = WS_GDW + (size_t)TS * 512 * 2;
constexpr size_t WS_END = WS_GDA + (size_t)TS * 256 * 2;
static_assert(WS_END <= (size_t)512 * 1024 * 1024, "workspace budget");

struct Params { const float* in[31]; float* out; unsigned char* ws; int ph_lo, ph_hi; };

__device__ __forceinline__ int ltid() { int t = threadIdx.x; asm volatile("" : "+v"(t)); return t; }
__device__ __forceinline__ int lbid() { int t = blockIdx.x; asm volatile("" : "+s"(t)); return t; }
__device__ __forceinline__ int lgdim() { int t = gridDim.x; asm volatile("" : "+s"(t)); return t; }
__device__ __forceinline__ int zz() { int z; asm volatile("s_mov_b32 %0, 0" : "=s"(z)); return z; }
template <class P> __device__ __forceinline__ P* lptr(P* q) { asm volatile("" : "+s"(q)); return q; }
__device__ __forceinline__ float bf2f(unsigned short b) { return __uint_as_float(((unsigned)b) << 16); }
__device__ __forceinline__ unsigned cvt_pk_bf16(float lo, float hi) { unsigned r; asm("v_cvt_pk_bf16_f32 %0, %1, %2" : "=v"(r) : "v"(lo), "v"(hi)); return r; }
__device__ __forceinline__ unsigned short f2bf(float f) { return (unsigned short)(cvt_pk_bf16(f, 0.f) & 0xffffu); }
__device__ __forceinline__ float lo_bf(unsigned w) { return __uint_as_float(w << 16); }
__device__ __forceinline__ float hi_bf(unsigned w) { return __uint_as_float(w & 0xffff0000u); }
__device__ __forceinline__ float sigmoidf_(float x) { return __builtin_amdgcn_rcpf(1.0f + __expf(-x)); }
__device__ __forceinline__ float siluf_(float x) { return x * __builtin_amdgcn_rcpf(1.0f + __expf(-x)); }
__device__ __forceinline__ float geluf_(float x) { const float u = 1.5957691216057308f * (x + 0.044715f * x * x * x); return x * __builtin_amdgcn_rcpf(1.0f + __expf(-u)); }
__device__ __forceinline__ float softplusf_(float x) { return fmaxf(x, 0.f) + log1pf(__expf(-fabsf(x))); }
__device__ __forceinline__ float wave_sum(float v) {
#pragma unroll
    for (int o = 1; o < 64; o <<= 1) v += __shfl_xor(v, o);
    return v;
}


#define XB_TMO      128
#define XB_XCNT(j)  (256  + 64 * (j))
#define XB_XSUB(j)  (1280 + 64 * (j))
#define XB_XGEN(j)  (2304 + 64 * (j))
#define XB_TOP      3328
#define XB_TOPGEN   3392
#define XCD_BAR_WORDS 3456
#define XB_SPIN_CAP (1u << 22)
__device__ __forceinline__ unsigned xb_ld(unsigned* p)              { return __hip_atomic_load(p, __ATOMIC_RELAXED, __HIP_MEMORY_SCOPE_AGENT); }
__device__ __forceinline__ unsigned xb_add(unsigned* p, unsigned v) { return __hip_atomic_fetch_add(p, v, __ATOMIC_RELAXED, __HIP_MEMORY_SCOPE_AGENT); }
__device__ __forceinline__ unsigned xb_xcc_id() { return (unsigned)__builtin_amdgcn_s_getreg((3 << 11) | 20) & 0xFu; }
#define XB_SPIN(cond, bar) do { unsigned _sp = 0; while (cond) { __builtin_amdgcn_s_sleep(1); \
    if ((++_sp & 255u) == 0u) { if (xb_ld(&(bar)[XB_TMO])) break; if (_sp > XB_SPIN_CAP) { atomicAdd(&(bar)[XB_TMO], 1u); break; } } } } while (0)
struct XcdBarrier { unsigned* bar; unsigned x; volatile LAS unsigned* st; };
__device__ __forceinline__ XcdBarrier xcd_barrier_post(unsigned* bar, volatile LAS unsigned* st) {
    XcdBarrier b; b.bar = bar; b.x = xb_xcc_id(); b.st = st;
    if (threadIdx.x == 0) (void)xb_add(&bar[XB_XCNT(b.x)], 1u);
    return b;
}
__device__ __forceinline__ void xcd_barrier_complete(unsigned* bar, unsigned x, unsigned& nloc, unsigned& nx) {
    const unsigned G = gridDim.x * gridDim.y * gridDim.z;
    unsigned sum, cnt, mine, sp = 0u;
    for (;;) {
        sum = 0u; cnt = 0u; mine = 0u;
#pragma unroll
        for (unsigned j = 0; j < 16; ++j) { const unsigned c = xb_ld(&bar[XB_XCNT(j)]); sum += c; cnt += (c > 0u) ? 1u : 0u; mine = (j == x) ? c : mine; }
        if (sum == G) break;
        __builtin_amdgcn_s_sleep(1);
        if ((++sp & 255u) == 0u) { if (xb_ld(&bar[XB_TMO])) break; if (sp > XB_SPIN_CAP) { atomicAdd(&bar[XB_TMO], 1u); break; } }
    }
    nloc = mine > 0u ? mine : 1u; nx = cnt > 0u ? cnt : 1u;
}
__device__ __forceinline__ void xcd_barrier(const XcdBarrier& b) {
    asm volatile("s_waitcnt vmcnt(0)" ::: "memory");
    __syncthreads();
    if (threadIdx.x == 0) {
        unsigned* bar = b.bar;
        __builtin_amdgcn_s_waitcnt(0);
        unsigned nloc = b.st[0], nx = b.st[1];
        if (nloc == 0u) { xcd_barrier_complete(bar, b.x, nloc, nx); b.st[0] = nloc; b.st[1] = nx; }
        const unsigned old = xb_add(&bar[XB_XSUB(b.x)], 1u);
        const unsigned gen = old / nloc;
        if (old + 1u == (gen + 1u) * nloc) {
            __builtin_amdgcn_fence(__ATOMIC_RELEASE, "agent");
            asm volatile("s_waitcnt vmcnt(0)" ::: "memory");
            const unsigned og = xb_add(&bar[XB_TOP], 1u);
            const unsigned tg = og / nx;
            if (og + 1u == (tg + 1u) * nx) xb_add(&bar[XB_TOPGEN], 1u);
            else XB_SPIN(xb_ld(&bar[XB_TOPGEN]) == tg, bar);
            __builtin_amdgcn_fence(__ATOMIC_ACQUIRE, "agent");
            xb_add(&bar[XB_XGEN(b.x)], 1u);
            asm volatile("s_waitcnt vmcnt(0)" ::: "memory");
        } else {
            XB_SPIN(xb_ld(&bar[XB_XGEN(b.x)]) == gen, bar);
            __builtin_amdgcn_fence(__ATOMIC_ACQUIRE, "agent");
            asm volatile("s_waitcnt vmcnt(0)" ::: "memory");
        }
    }
    __syncthreads();
}

namespace pg8 {
constexpr int BM = 256, BK = 64, HALF = 128, HTB = HALF * BK * 2, STAGE_BYTES = 8 * HTB, NXCD = 8, WGM = 8;
__host__ __device__ __forceinline__ int lds_byte(int r, int c) { const int st = (r >> 4) * 2 + (c >> 5), rr = r & 15, cc = c & 31, ob = rr * 64 + cc * 2; return st * 1024 + (ob ^ (((ob >> 9) & 1) << 5)); }
__host__ __device__ __forceinline__ void stage_rc(int b, int& R, int& C) { const int st = b / 1024, sb = b % 1024, swz = sb ^ (((sb >> 9) & 1) << 5); R = (st >> 1) * 16 + swz / 64; C = (st & 1) * 32 + (swz % 64) / 2; }
__host__ __device__ __forceinline__ int perm32(int rho) { const int n = rho >> 4, i = rho & 15; return 8 * (i >> 2) + 4 * n + (i & 3); }

struct Unit { int pm, pn, g; };
struct Gemm { const bf16_t* A; const bf16_t* Bt; int M, N, K; size_t gsA, gsB; };

__device__ __forceinline__ void tile_of(int wgid, int nM, int nN, int nwg, Unit& u) {
    { const int q = nwg / NXCD, r = nwg % NXCD, xcd = wgid % NXCD, off = wgid / NXCD; wgid = (xcd < r ? xcd * (q + 1) : r * (q + 1) + (xcd - r) * q) + off; }
    const int nig = WGM * nN, gid = wgid / nig, fm = gid * WGM, gsz = (nM - fm) < WGM ? (nM - fm) : WGM;
    u.pm = fm + ((wgid % nig) % gsz); u.pn = (wgid % nig) / gsz;
}
struct StaticOrder {
    int nM, nN, nwg, G, c;
    __device__ void init(int M, int N, int G_, int c_) { nM = M / BM; nN = N / BM; nwg = nM * nN; G = G_; c = c_; }
    __device__ bool next(int i, Unit& u) const {
        const long L = (long)i * G + c; if (L >= nwg) return false;
        tile_of((int)L, nM, nN, nwg, u); u.g = 0; return true;
    }
};
struct BranchOrder {
    int nM, nN, nwg, G, c;
    __device__ void init(int M, int N, int G_, int c_) { nM = M / BM; nN = N / BM; nwg = nM * nN; G = G_; c = c_; }
    __device__ bool next(int i, Unit& u) const {
        const long L = (long)(i >> 2) * G + c; if (L >= nwg) return false;
        tile_of((int)L, nM, nN, nwg, u); u.g = i & 3; return true;
    }
};

struct EpiSwiGLU {
    static constexpr bool PERM = true;
    bf16_t* O;
    __device__ __forceinline__ bool keep(const Unit&) const { return false; }
    __device__ __forceinline__ void operator()(f32x4 (&acc)[2][2][4][2], const Unit& u, int wr, int wc, int fr, int fq) const {
        const int row0 = u.pm * BM + wr * 64 + fr, col0 = u.pn * 128 + wc * 32 + 8 * fq;
#pragma unroll
        for (int ai = 0; ai < 2; ++ai)
#pragma unroll
            for (int m = 0; m < 4; ++m) {
                bf16_t* rowp = O + (size_t)(row0 + ai * HALF + m * 16) * DFF + col0;
                float v[8];
#pragma unroll
                for (int n = 0; n < 2; ++n)
#pragma unroll
                    for (int j = 0; j < 4; ++j) v[n * 4 + j] = siluf_(acc[ai][0][m][n][j]) * acc[ai][1][m][n][j];
                u32x4 w; w.x = cvt_pk_bf16(v[0], v[1]); w.y = cvt_pk_bf16(v[2], v[3]); w.z = cvt_pk_bf16(v[4], v[5]); w.w = cvt_pk_bf16(v[6], v[7]);
                *(u32x4*)rowp = w;
                __builtin_amdgcn_sched_barrier(0);
            }
    }
};
struct EpiResid {
    static constexpr bool PERM = false;
    const float* Xin; float* Xout; float scale;
    __device__ __forceinline__ bool keep(const Unit&) const { return false; }
    __device__ __forceinline__ void operator()(f32x4 (&acc)[2][2][4][2], const Unit& u, int wr, int wc, int fr, int fq) const {
        const int row0 = u.pm * BM + wr * 64 + fr, col0 = u.pn * BM + wc * 32 + 4 * fq;
#pragma unroll
        for (int ai = 0; ai < 2; ++ai) {
            f32x4 xi[4][2][2];
#pragma unroll
            for (int m = 0; m < 4; ++m) { const size_t ro = (size_t)(row0 + ai * HALF + m * 16) * D + col0;
#pragma unroll
                for (int bj = 0; bj < 2; ++bj)
#pragma unroll
                    for (int n = 0; n < 2; ++n) xi[m][bj][n] = *(const f32x4*)(Xin + ro + bj * HALF + n * 16); }
#pragma unroll
            for (int m = 0; m < 4; ++m) { const size_t ro = (size_t)(row0 + ai * HALF + m * 16) * D + col0;
#pragma unroll
                for (int bj = 0; bj < 2; ++bj)
#pragma unroll
                    for (int n = 0; n < 2; ++n) *(f32x4*)(Xout + ro + bj * HALF + n * 16) = xi[m][bj][n] + acc[ai][bj][m][n] * scale; }
            __builtin_amdgcn_sched_barrier(0);
        }
    }
};
struct EpiProj {
    static constexpr bool PERM = true;
    bf16_t* O; float* AB;
    __device__ __forceinline__ bool keep(const Unit&) const { return false; }
    __device__ __forceinline__ void operator()(f32x4 (&acc)[2][2][4][2], const Unit& u, int wr, int wc, int fr, int fq) const {
        const int row0 = u.pm * BM + wr * 64 + fr, col0 = u.pn * BM + wc * 32 + 8 * fq;
        const bool ab = (u.pn == PC_AB / BM) && wc == 0 && fq == 0;
#pragma unroll
        for (int ai = 0; ai < 2; ++ai)
#pragma unroll
            for (int m = 0; m < 4; ++m) {
                const int row = row0 + ai * HALF + m * 16;
                bf16_t* rowp = O + (size_t)row * PW + col0;
#pragma unroll
                for (int bj = 0; bj < 2; ++bj) {
                    const f32x4 v0 = acc[ai][bj][m][0], v1 = acc[ai][bj][m][1];
                    u32x4 w; w.x = cvt_pk_bf16(v0[0], v0[1]); w.y = cvt_pk_bf16(v0[2], v0[3]); w.z = cvt_pk_bf16(v1[0], v1[1]); w.w = cvt_pk_bf16(v1[2], v1[3]);
                    *(u32x4*)(rowp + bj * HALF) = w;
                }
                __builtin_amdgcn_sched_barrier(0);
            }
        if (ab) {
#pragma unroll
            for (int ai = 0; ai < 2; ++ai)
#pragma unroll
                for (int m = 0; m < 4; ++m) { const int row = row0 + ai * HALF + m * 16; *(f32x4*)(AB + (size_t)row * 8) = acc[ai][0][m][0]; *(f32x4*)(AB + (size_t)row * 8 + 4) = acc[ai][0][m][1]; }
        }
    }
};
struct EpiBranch {
    static constexpr bool PERM = true;
    const bf16_t* P; bf16_t* O;
    __device__ __forceinline__ bool keep(const Unit& u) const { return u.g < 3; }
    __device__ __forceinline__ void operator()(f32x4 (&acc)[2][2][4][2], const Unit& u, int wr, int wc, int fr, int fq) const {
        const int row0 = u.pm * BM + wr * 64 + fr, col0 = u.pn * BM + wc * 32 + 8 * fq;
        const bool last = (u.g == 3);
#pragma unroll
        for (int ai = 0; ai < 2; ++ai) {
            u32x4 g0[4][2], g1[4][2];
#pragma unroll
            for (int m = 0; m < 4; ++m) { const bf16_t* gp = P + (size_t)(row0 + ai * HALF + m * 16) * PW + PC_GATE + u.g * D + col0;
#pragma unroll
                for (int bj = 0; bj < 2; ++bj) { g0[m][bj] = *(const u32x4*)(gp + bj * HALF); g1[m][bj] = last ? g0[m][bj] : *(const u32x4*)(gp + D + bj * HALF); } }
#pragma unroll
            for (int m = 0; m < 4; ++m) {
                const int row = row0 + ai * HALF + m * 16;
#pragma unroll
                for (int bj = 0; bj < 2; ++bj) {
                    float f[8];
                    if (!last) {
#pragma unroll
                        for (int q = 0; q < 4; ++q) {
                            f[2 * q] = (1.0f + __expf(-lo_bf(g1[m][bj][q]))) * __builtin_amdgcn_rcpf(1.0f + __expf(-lo_bf(g0[m][bj][q])));
                            f[2 * q + 1] = (1.0f + __expf(-hi_bf(g1[m][bj][q]))) * __builtin_amdgcn_rcpf(1.0f + __expf(-hi_bf(g0[m][bj][q])));
                        }
                    } else {
#pragma unroll
                        for (int q = 0; q < 4; ++q) { f[2 * q] = __builtin_amdgcn_rcpf(1.0f + __expf(-lo_bf(g0[m][bj][q]))); f[2 * q + 1] = __builtin_amdgcn_rcpf(1.0f + __expf(-hi_bf(g0[m][bj][q]))); }
                    }
#pragma unroll
                    for (int n = 0; n < 2; ++n)
#pragma unroll
                        for (int j = 0; j < 4; ++j) acc[ai][bj][m][n][j] *= f[n * 4 + j];
                    if (last) {
                        const f32x4 v0 = acc[ai][bj][m][0], v1 = acc[ai][bj][m][1];
                        u32x4 w; w.x = cvt_pk_bf16(v0[0], v0[1]); w.y = cvt_pk_bf16(v0[2], v0[3]); w.z = cvt_pk_bf16(v1[0], v1[1]); w.w = cvt_pk_bf16(v1[2], v1[3]);
                        *(u32x4*)(O + (size_t)row * D + col0 + bj * HALF) = w;
                    }
                }
            }
            __builtin_amdgcn_sched_barrier(0);
        }
    }
};

template <class Epi, class Sched>
__device__ __forceinline__ void gemm_phase(LAS unsigned char* lds, const Gemm g, const Sched& S, const Epi& E) {
    const int tid = ltid(), wid = __builtin_amdgcn_readfirstlane(tid >> 6), lane = tid & 63, wr = wid >> 2, wc = wid & 3, fr = lane & 15, fq = lane >> 4;
    const int K = g.K, nt = K / BK;
    unsigned voffA[2], voffB[2];
#pragma unroll
    for (int i = 0; i < 2; ++i) { int R, C; stage_rc(tid * 16 + i * 8192, R, C); const int Rb = Epi::PERM ? ((R & ~31) + perm32(R & 31)) : R;
        voffA[i] = (unsigned)(R * K + C) * 2u; voffB[i] = (unsigned)(Rb * K + C) * 2u; }
    const size_t kstep = (size_t)(BK * 2);
    const size_t hstep = (size_t)HALF * K * 2;
    const size_t tstep = 2 * hstep;
    const unsigned ldsw = (unsigned)wid * 1024u;
    const int aoff = lds_byte(wr * 64 + fr, fq * 8), boff = lds_byte(wc * 32 + fr, fq * 8);
#define PG8_SA(b, h) (((b) * 2 + (h)) * HTB)
#define PG8_SB(b, h) ((4 + (b) * 2 + (h)) * HTB)
#define PG8_STAGE(bufoff, gbase, voff) do { _Pragma("unroll") for (int _i = 0; _i < 2; ++_i) \
        __builtin_amdgcn_global_load_lds((const unsigned*)((const char*)(gbase) + (voff)[_i]), (LAS unsigned*)(lds + (bufoff) + ldsw + _i * 8192), 16, 0, 0); } while (0)
#define PG8_LDA(dst, b, h) do { _Pragma("unroll") for (int m = 0; m < 4; ++m) _Pragma("unroll") for (int k = 0; k < 2; ++k) dst[m][k] = *(const LAS bf16x8*)(lds + PG8_SA(b, h) + aoff + m * 2048 + k * 1024); } while (0)
#define PG8_LDB(dst, b, h) do { _Pragma("unroll") for (int n = 0; n < 2; ++n) _Pragma("unroll") for (int k = 0; k < 2; ++k) dst[n][k] = *(const LAS bf16x8*)(lds + PG8_SB(b, h) + boff + n * 2048 + k * 1024); } while (0)
#define PG8_MMA(ai, bj, At, Bt) do { __builtin_amdgcn_s_setprio(1); _Pragma("unroll") for (int m = 0; m < 4; ++m) _Pragma("unroll") for (int n = 0; n < 2; ++n) _Pragma("unroll") for (int k = 0; k < 2; ++k) \
        acc[ai][bj][m][n] = __builtin_amdgcn_mfma_f32_16x16x32_bf16(Bt[n][k], At[m][k], acc[ai][bj][m][n], 0, 0, 0); __builtin_amdgcn_s_setprio(0); } while (0)
#define PG8_WAIT_V(n) asm volatile("s_waitcnt vmcnt(" #n ")" ::: "memory")
#define PG8_WAIT_L(n) asm volatile("s_waitcnt lgkmcnt(" #n ")" ::: "memory")
#define PG8_BAR __builtin_amdgcn_s_barrier()
#define PG8_SCHED __builtin_amdgcn_sched_barrier(0)
    Unit cur, nxt; int ui = 0;
    if (!S.next(0, cur)) return;
    f32x4 acc[2][2][4][2];
#pragma unroll
    for (int a = 0; a < 2; ++a)
#pragma unroll
        for (int b = 0; b < 2; ++b)
#pragma unroll
            for (int m = 0; m < 4; ++m)
#pragma unroll
                for (int n = 0; n < 2; ++n) acc[a][b][m][n] = (f32x4){0.f, 0.f, 0.f, 0.f};
    bf16x8 At[4][2], B0[2][2], B1[2][2];
    const char* cA = (const char*)g.A + (size_t)cur.g * g.gsA + (size_t)cur.pm * tstep; const char* cB = (const char*)g.Bt + (size_t)cur.g * g.gsB + (size_t)cur.pn * tstep;
    PG8_STAGE(PG8_SB(0, 0), cB, voffB); PG8_STAGE(PG8_SA(0, 0), cA, voffA); PG8_STAGE(PG8_SB(0, 1), cB + hstep, voffB); PG8_STAGE(PG8_SA(0, 1), cA + hstep, voffA);
    if (wr == 1) PG8_BAR;
    PG8_WAIT_V(4); PG8_BAR;
    PG8_STAGE(PG8_SB(1, 0), cB + kstep, voffB); PG8_STAGE(PG8_SA(1, 0), cA + kstep, voffA); PG8_STAGE(PG8_SB(1, 1), cB + hstep + kstep, voffB);
    PG8_WAIT_V(6); PG8_BAR;
    for (;;) {
        const bool has_next = S.next(ui + 1, nxt);
        const char* nA = has_next ? (const char*)g.A + (size_t)nxt.g * g.gsA + (size_t)nxt.pm * tstep : cA; const char* nB = has_next ? (const char*)g.Bt + (size_t)nxt.g * g.gsB + (size_t)nxt.pn * tstep : cB;
        for (int t = 0; t < nt; t += 2) {
            const bool last = (t == nt - 2);
            const char* a1 = cA + (size_t)(t + 1) * kstep;
            const char* a2 = last ? nA : cA + (size_t)(t + 2) * kstep; const char* b2 = last ? nB : cB + (size_t)(t + 2) * kstep;
            const char* a3 = a2 + kstep; const char* b3 = b2 + kstep;
            PG8_LDB(B0, 0, 0); PG8_SCHED; PG8_LDA(At, 0, 0); PG8_STAGE(PG8_SA(1, 1), a1 + hstep, voffA);
            PG8_WAIT_L(8); PG8_BAR; PG8_WAIT_L(0); PG8_MMA(0, 0, At, B0); PG8_BAR; PG8_SCHED;
            PG8_LDB(B1, 0, 1); PG8_STAGE(PG8_SB(0, 0), b2, voffB);
            PG8_BAR; PG8_WAIT_L(0); PG8_MMA(0, 1, At, B1); PG8_BAR;
            PG8_LDA(At, 0, 1); PG8_STAGE(PG8_SA(0, 0), a2, voffA);
            PG8_BAR; PG8_WAIT_L(0); PG8_MMA(1, 0, At, B0); PG8_BAR; PG8_SCHED;
            PG8_STAGE(PG8_SB(0, 1), b2 + hstep, voffB);
            PG8_WAIT_V(6); PG8_BAR; PG8_MMA(1, 1, At, B1); PG8_BAR;
            PG8_LDB(B0, 1, 0); PG8_SCHED; PG8_LDA(At, 1, 0); PG8_STAGE(PG8_SA(0, 1), a2 + hstep, voffA);
            PG8_WAIT_L(8); PG8_BAR; PG8_WAIT_L(0); PG8_MMA(0, 0, At, B0); PG8_BAR; PG8_SCHED;
            PG8_LDB(B1, 1, 1); PG8_STAGE(PG8_SB(1, 0), b3, voffB);
            PG8_BAR; PG8_WAIT_L(0); PG8_MMA(0, 1, At, B1); PG8_BAR;
            PG8_LDA(At, 1, 1); PG8_STAGE(PG8_SA(1, 0), a3, voffA);
            PG8_BAR; PG8_WAIT_L(0); PG8_MMA(1, 0, At, B0); PG8_BAR; PG8_SCHED;
            PG8_STAGE(PG8_SB(1, 1), b3 + hstep, voffB);
            PG8_WAIT_V(6); PG8_BAR; PG8_MMA(1, 1, At, B1); PG8_BAR;
        }
        E(acc, cur, wr, wc, fr, fq);
        if (!has_next) break;
        if (!E.keep(cur)) {
#pragma unroll
            for (int a = 0; a < 2; ++a)
#pragma unroll
                for (int b = 0; b < 2; ++b)
#pragma unroll
                    for (int m = 0; m < 4; ++m)
#pragma unroll
                        for (int n = 0; n < 2; ++n) acc[a][b][m][n] = (f32x4){0.f, 0.f, 0.f, 0.f};
        }
        cur = nxt; cA = nA; cB = nB; ++ui;
    }
    PG8_WAIT_V(0);
    if (wr == 0) PG8_BAR;
    PG8_BAR;
#undef PG8_SA
#undef PG8_SB
#undef PG8_STAGE
#undef PG8_LDA
#undef PG8_LDB
#undef PG8_MMA
#undef PG8_WAIT_V
#undef PG8_WAIT_L
#undef PG8_BAR
#undef PG8_SCHED
}
}


#define NOINL __forceinline__
__device__ NOINL void ph_gemm_swiglu(LAS unsigned char* lds, const bf16_t* A, const bf16_t* Bt, bf16_t* O) {
    pg8::Gemm g{A, Bt, T, 2 * DFF, D, 0, 0}; pg8::StaticOrder S; S.init(g.M, g.N, lgdim(), lbid()); pg8::EpiSwiGLU E{O}; pg8::gemm_phase(lds, g, S, E);
}
__device__ NOINL void ph_gemm_resid(LAS unsigned char* lds, const bf16_t* A, const bf16_t* Bt, int M, int K, const float* Xin, float* Xout, float scale) {
    pg8::Gemm g{A, Bt, M, D, K, 0, 0}; pg8::StaticOrder S; S.init(g.M, g.N, lgdim(), lbid()); pg8::EpiResid E{Xin, Xout, scale}; pg8::gemm_phase(lds, g, S, E);
}
__device__ NOINL void ph_gemm_proj(LAS unsigned char* lds, const bf16_t* A, const bf16_t* Bt, bf16_t* O, float* AB) {
    pg8::Gemm g{A, Bt, TS, PW, D, 0, 0}; pg8::StaticOrder S; S.init(g.M, g.N, lgdim(), lbid()); pg8::EpiProj E{O, AB}; pg8::gemm_phase(lds, g, S, E);
}
__device__ NOINL void ph_gemm_branch(LAS unsigned char* lds, const bf16_t* A, const bf16_t* Bt, const bf16_t* P, bf16_t* O) {
    pg8::Gemm g{A, Bt, TS, D, 512, (size_t)TS * 512 * 2, (size_t)D * 512 * 2}; pg8::BranchOrder S; S.init(g.M, g.N, lgdim(), lbid()); pg8::EpiBranch E{P, O}; pg8::gemm_phase(lds, g, S, E);
}

struct ConvTask { const float* src0; const float* src1; bf16_t* dst; int K, Nsrc, mode, tile; };
__device__ __forceinline__ ConvTask conv_task(const Params& p, int l, int it) {
    unsigned char* ws = lptr(p.ws);
    constexpr int N1 = 16 * 88, N2 = 44 * 16, N3 = 16 * 140, N4 = 8 * 16, N5 = 16 * 16;
    ConvTask t; t.src1 = nullptr;
    int r = it;
    if (r < N1) { t.src0 = p.in[zz() + 2] + (size_t)l * D * DFF; t.src1 = p.in[zz() + 3] + (size_t)l * D * DFF; t.K = D; t.Nsrc = DFF; t.dst = (bf16_t*)(ws + WS_WGU1); t.mode = 1; t.tile = r; return t; } r -= N1;
    if (r < N2) { t.src0 = p.in[zz() + 4] + (size_t)l * DFF * D; t.K = DFF; t.Nsrc = D; t.dst = (bf16_t*)(ws + WS_WD1); t.mode = 0; t.tile = r; return t; } r -= N2;
    if (r < N3) { t.src0 = p.in[zz() + 6] + (size_t)l * D * PIN; t.K = D; t.Nsrc = PIN; t.dst = (bf16_t*)(ws + WS_WIN); t.mode = 2; t.tile = r; return t; } r -= N3;
    if (r < 4 * N4) { const int g = r / N4; t.src0 = p.in[zz() + 24] + ((size_t)l * 4 + g) * 512 * D; t.K = 512; t.Nsrc = D; t.dst = (bf16_t*)(ws + WS_WB) + (size_t)g * D * 512; t.mode = 0; t.tile = r % N4; return t; } r -= 4 * N4;
    if (r < N5) { t.src0 = p.in[zz() + 25] + (size_t)l * D * D; t.K = D; t.Nsrc = D; t.dst = (bf16_t*)(ws + WS_WOUT); t.mode = 0; t.tile = r; return t; } r -= N5;
    if (r < N1) { t.src0 = p.in[zz() + 27] + (size_t)l * D * DFF; t.src1 = p.in[zz() + 28] + (size_t)l * D * DFF; t.K = D; t.Nsrc = DFF; t.dst = (bf16_t*)(ws + WS_WGU2); t.mode = 1; t.tile = r; return t; } r -= N1;
    t.src0 = p.in[zz() + 29] + (size_t)l * DFF * D; t.K = DFF; t.Nsrc = D; t.dst = (bf16_t*)(ws + WS_WD2); t.mode = 0; t.tile = r; return t;
}
__device__ __forceinline__ void conv_load(const ConvTask& t, int tid, f32x4& a, f32x4& b) {
    const int nkt = t.K / 64, kt = t.tile % nkt, rt = t.tile / nkt, k0 = kt * 64, r0 = rt * 64;
    const int kk = tid >> 3, rr = (tid & 7) * 8, rho = r0 + rr;
    const float* src = t.src0; int col = rho;
    if (t.mode == 1) { const int pn = rho >> 8, bj = (rho >> 7) & 1, j = rho & 127; col = pn * 128 + j; src = bj ? t.src1 : t.src0; }
    else if (t.mode == 2) { col = rho < 4096 ? rho : (rho < 8704 ? rho + 8 : (rho < 8712 ? rho - 8704 + 4096 : -1)); }
    a = (f32x4){0.f, 0.f, 0.f, 0.f}; b = a;
    if (col >= 0) { const float* sp = src + (size_t)(k0 + kk) * t.Nsrc + col; a = *(const f32x4*)sp; b = *(const f32x4*)(sp + 4); }
}
__device__ __forceinline__ void conv_store(LAS float* scr, const ConvTask& t, int tid, const f32x4& a, const f32x4& b) {
    const int nkt = t.K / 64, kt = t.tile % nkt, rt = t.tile / nkt, k0 = kt * 64, r0 = rt * 64;
    { const int kk = tid >> 3, rr = (tid & 7) * 8;
#pragma unroll
        for (int e = 0; e < 4; ++e) { scr[(rr + e) * 65 + kk] = a[e]; scr[(rr + 4 + e) * 65 + kk] = b[e]; } }
    __syncthreads();
    { const int rl = tid >> 3, kc = (tid & 7) * 8;
        const LAS float* s = scr + rl * 65 + kc;
        u32x4 w; w.x = cvt_pk_bf16(s[0], s[1]); w.y = cvt_pk_bf16(s[2], s[3]); w.z = cvt_pk_bf16(s[4], s[5]); w.w = cvt_pk_bf16(s[6], s[7]);
        *(u32x4*)(t.dst + (size_t)(r0 + rl) * t.K + k0 + kc) = w; }
    __syncthreads();
}

__device__ __forceinline__ void convert_layer(LAS unsigned char* lds, const Params& p, int l) {
    LAS float* scr = (LAS float*)lds;
    unsigned char* ws = lptr(p.ws);
    constexpr int N1 = 16 * 88, N2 = 44 * 16, N3 = 16 * 140, N4 = 8 * 16, N5 = 16 * 16;
    constexpr int TOT = N1 + N2 + N3 + 4 * N4 + N5 + N1 + N2;
    const int tid = ltid(), G = lgdim();
    int it = lbid();
    if (it < TOT) {
        ConvTask cur = conv_task(p, l, it);
        f32x4 a, b; conv_load(cur, tid, a, b);
        for (;;) {
            const int nx = it + G; const bool more = nx < TOT;
            ConvTask nxt = cur; f32x4 na = a, nb = b;
            if (more) { nxt = conv_task(p, l, nx); conv_load(nxt, tid, na, nb); }
            conv_store(scr, cur, tid, a, b);
            if (!more) break;
            cur = nxt; a = na; b = nb; it = nx;
        }
    }
    bf16_t* waxt = (bf16_t*)(ws + WS_WAXT); bf16_t* pwt = (bf16_t*)(ws + WS_PWT);
    const float* wa = p.in[zz() + 13] + (size_t)l * 8 * 64 * 64; const float* wx = p.in[zz() + 15] + (size_t)l * 8 * 64 * 64; const float* pw = p.in[zz() + 22] + (size_t)l * 4 * 128 * 128;
    for (int e = lbid() * NTHR + ltid(); e < 65536; e += lgdim() * NTHR) {
        { const int h = e >> 13, jp = (e >> 6) & 127, i = e & 63; waxt[e] = f2bf(jp < 64 ? wa[(h * 64 + i) * 64 + jp] : wx[(h * 64 + i) * 64 + jp - 64]); }
        { const int g = e >> 14, d = (e >> 7) & 127, c = e & 127; pwt[e] = f2bf(pw[(g * 128 + c) * 128 + d]); }
    }
}

__device__ __forceinline__ void rms_rows_bf16(const float* X, const float* gain, bf16_t* H, int nrows) {
    const int wid = ltid() >> 6, lane = ltid() & 63;
    f32x4 gv[4];
#pragma unroll
    for (int j = 0; j < 4; ++j) gv[j] = *(const f32x4*)(gain + (lane + 64 * j) * 4);
    for (int row0 = (lbid() * 8 + wid) * 4; row0 < nrows; row0 += lgdim() * 32) {
        f32x4 v[4][4];
#pragma unroll
        for (int r = 0; r < 4; ++r) { const f32x4* xr = (const f32x4*)(X + (size_t)min(row0 + r, nrows - 1) * D) + lane;
#pragma unroll
            for (int j = 0; j < 4; ++j) v[r][j] = xr[64 * j]; }
#pragma unroll
        for (int r = 0; r < 4; ++r) {
            float s = 0.f;
#pragma unroll
            for (int j = 0; j < 4; ++j) s += (v[r][j].x * v[r][j].x + v[r][j].y * v[r][j].y) + (v[r][j].z * v[r][j].z + v[r][j].w * v[r][j].w);
            const float rs = rsqrtf(wave_sum(s) * (1.0f / D) + EPS);
            u32x2* o = (u32x2*)(H + (size_t)(row0 + r) * D) + lane;
            if (row0 + r < nrows)
#pragma unroll
            for (int j = 0; j < 4; ++j) { u32x2 w; w.x = cvt_pk_bf16(v[r][j].x * rs * gv[j].x, v[r][j].y * rs * gv[j].y); w.y = cvt_pk_bf16(v[r][j].z * rs * gv[j].z, v[r][j].w * rs * gv[j].w); o[64 * j] = w; }
        }
    }
}
__device__ __forceinline__ void rms_rows_f32_inplace(float* X, const float* gain, int nrows) {
    const int wid = ltid() >> 6, lane = ltid() & 63;
    f32x4 gv[4];
#pragma unroll
    for (int j = 0; j < 4; ++j) gv[j] = *(const f32x4*)(gain + (lane + 64 * j) * 4);
    for (int row0 = (lbid() * 8 + wid) * 4; row0 < nrows; row0 += lgdim() * 32) {
        f32x4 v[4][4];
#pragma unroll
        for (int r = 0; r < 4; ++r) { const f32x4* xr = (const f32x4*)(X + (size_t)min(row0 + r, nrows - 1) * D) + lane;
#pragma unroll
            for (int j = 0; j < 4; ++j) v[r][j] = xr[64 * j]; }
#pragma unroll
        for (int r = 0; r < 4; ++r) {
            float s = 0.f;
#pragma unroll
            for (int j = 0; j < 4; ++j) s += (v[r][j].x * v[r][j].x + v[r][j].y * v[r][j].y) + (v[r][j].z * v[r][j].z + v[r][j].w * v[r][j].w);
            const float rs = rsqrtf(wave_sum(s) * (1.0f / D) + EPS);
            f32x4* xo = (f32x4*)(X + (size_t)(row0 + r) * D) + lane;
            if (row0 + r < nrows)
#pragma unroll
            for (int j = 0; j < 4; ++j) xo[64 * j] = v[r][j] * rs * gv[j];
        }
    }
}

__device__ __forceinline__ void sgu_tile(LAS unsigned char* lds, const Params& p, int l, const bf16_t* proj, bf16_t* ya, int tile) {
    const int tid = ltid(), wid = tid >> 6, lane = tid & 63, fr = lane & 15, fq = lane >> 4;
    const int blk = tile >> 2, g = tile & 3, r0 = blk * 128;
    LAS bf16_t* Wl = (LAS bf16_t*)lds;
    LAS bf16_t* VT = (LAS bf16_t*)(lds + 34816);
    const float* lng = p.in[zz() + 7] + l * 512 + g * 128; const float* lnb = p.in[zz() + 8] + l * 512 + g * 128;
    {
        const int i = tid >> 2, qd = tid & 3;
        const bf16_t* vrow = proj + (size_t)(r0 + i) * PW + PC_AV + qd * 8;
        float s = 0.f, s2 = 0.f;
#pragma unroll 4
        for (int e8 = 0; e8 < 16; ++e8) { const u32x4 w = *(const u32x4*)(vrow + e8 * 32);
#pragma unroll
            for (int q = 0; q < 4; ++q) { const float a = geluf_(lo_bf(w[q])), b = geluf_(hi_bf(w[q])); s += a + b; s2 += a * a + b * b; } }
        s += __shfl_xor(s, 1); s += __shfl_xor(s, 2); s2 += __shfl_xor(s2, 1); s2 += __shfl_xor(s2, 2);
        const float mean = s * (1.0f / 512.0f), var = fmaxf(s2 * (1.0f / 512.0f) - mean * mean, 0.f), rstd = rsqrtf(var + EPS);
        const bf16_t* vg = proj + (size_t)(r0 + i) * PW + PC_AV + g * 128 + qd * 8;
#pragma unroll
        for (int e8 = 0; e8 < 4; ++e8) { const u32x4 w = *(const u32x4*)(vg + e8 * 32);
#pragma unroll
            for (int q = 0; q < 4; ++q) { const int c = e8 * 32 + qd * 8 + 2 * q;
                VT[c * 136 + i] = f2bf((geluf_(lo_bf(w[q])) - mean) * rstd * lng[c] + lnb[c]);
                VT[(c + 1) * 136 + i] = f2bf((geluf_(hi_bf(w[q])) - mean) * rstd * lng[c + 1] + lnb[c + 1]); } }
        const float* wsrc = p.in[zz() + 9] + (((size_t)l * 4 + g) * 128 + i) * 128 + qd * 32;
#pragma unroll
        for (int e4 = 0; e4 < 8; ++e4) { f32x4 w = *(const f32x4*)(wsrc + e4 * 4); if (i < 64 && qd >= 2) w = (f32x4){0.f, 0.f, 0.f, 0.f};
            u32x2 o; o.x = cvt_pk_bf16(w.x, w.y); o.y = cvt_pk_bf16(w.z, w.w); *(LAS u32x2*)(Wl + i * 136 + qd * 32 + e4 * 4) = o; }
    }
    __syncthreads();
    f32x4 acc[8];
#pragma unroll
    for (int n = 0; n < 8; ++n) acc[n] = (f32x4){0.f, 0.f, 0.f, 0.f};
#pragma unroll
    for (int ks = 0; ks < 4; ++ks) {
        const bf16x8 af = *(const LAS bf16x8*)(Wl + (wid * 16 + fr) * 136 + ks * 32 + fq * 8);
#pragma unroll
        for (int n = 0; n < 8; ++n) { const bf16x8 bf = *(const LAS bf16x8*)(VT + (n * 16 + fr) * 136 + ks * 32 + fq * 8); acc[n] = __builtin_amdgcn_mfma_f32_16x16x32_bf16(bf, af, acc[n], 0, 0, 0); }
    }
    {
        const int i = wid * 16 + fr; const float bias = p.in[zz() + 10][((size_t)l * 4 + g) * 128 + i];
        const bf16_t* up = proj + (size_t)(r0 + i) * PW + PC_AU + g * 128 + fq * 4;
        bf16_t* yp = ya + (size_t)(r0 + i) * 512 + g * 128 + fq * 4;
#pragma unroll
        for (int n = 0; n < 8; ++n) { const u32x2 uw = *(const u32x2*)(up + n * 16);
            u32x2 o; o.x = cvt_pk_bf16((acc[n][0] + bias) * geluf_(lo_bf(uw.x)), (acc[n][1] + bias) * geluf_(hi_bf(uw.x)));
            o.y = cvt_pk_bf16((acc[n][2] + bias) * geluf_(lo_bf(uw.y)), (acc[n][3] + bias) * geluf_(hi_bf(uw.y))); *(u32x2*)(yp + n * 16) = o; }
    }
    __syncthreads();
}

template <int WIN>
__device__ __forceinline__ void pool_rows(LAS bf16_t* Al, const bf16_t* xcol, int c, int pos0) {
    float xv[80];
#pragma unroll
    for (int k = 0; k < 80; ++k) xv[k] = (pos0 - 16 + k >= 0) ? bf2f(xcol[(long)(k - 16) * PW]) : 0.f;
    float s = 0.f;
#pragma unroll
    for (int j = 0; j < WIN; ++j) s += xv[16 - j];
#pragma unroll
    for (int tt = 0; tt < 64; ++tt) {
        const int k = tt + 16;
        const int cnt = min(pos0 + tt + 1, WIN);
        Al[tt * 520 + c] = f2bf(s / (float)cnt - xv[k]);
        if (tt < 63) s += xv[k + 1] - xv[k + 1 - WIN];
    }
}
__device__ __forceinline__ void pool_tile(LAS unsigned char* lds, const Params& p, int l, const bf16_t* proj, bf16_t* yd, bf16_t* halo, const bf16_t* pwt, int tile) {
    const int tid = ltid(), wid = tid >> 6, lane = tid & 63, fr = lane & 15, fq = lane >> 4;
    const int t0 = tile * 64, pos0 = t0 % SEQ;
    LAS bf16_t* Al = (LAS bf16_t*)lds;
    {
        const int c = tid, g = wid >> 1;
        const bf16_t* xcol = proj + (size_t)t0 * PW + PC_DX + c;
        if (g == 0) pool_rows<2>(Al, xcol, c, pos0); else if (g == 1) pool_rows<4>(Al, xcol, c, pos0); else if (g == 2) pool_rows<8>(Al, xcol, c, pos0); else pool_rows<16>(Al, xcol, c, pos0);
    }
    __syncthreads();
    {
        const int g = wid >> 1, nh = wid & 1;
        f32x4 acc[4][4];
#pragma unroll
        for (int m = 0; m < 4; ++m)
#pragma unroll
            for (int n = 0; n < 4; ++n) acc[m][n] = (f32x4){0.f, 0.f, 0.f, 0.f};
#pragma unroll
        for (int ks = 0; ks < 4; ++ks) {
            bf16x8 bfr[4];
#pragma unroll
            for (int n = 0; n < 4; ++n) bfr[n] = *(const bf16x8*)(pwt + ((size_t)(g * 128 + (nh * 4 + n) * 16 + fr)) * 128 + ks * 32 + fq * 8);
#pragma unroll
            for (int m = 0; m < 4; ++m) { const bf16x8 af = *(const LAS bf16x8*)(Al + (m * 16 + fr) * 520 + g * 128 + ks * 32 + fq * 8);
#pragma unroll
                for (int n = 0; n < 4; ++n) acc[m][n] = __builtin_amdgcn_mfma_f32_16x16x32_bf16(bfr[n], af, acc[m][n], 0, 0, 0); }
        }
        const float* sc = p.in[zz() + 23] + l * 512 + g * 128;
#pragma unroll
        for (int n = 0; n < 4; ++n) { const int d = (nh * 4 + n) * 16 + fq * 4; const f32x4 s4 = *(const f32x4*)(sc + d);
#pragma unroll
            for (int m = 0; m < 4; ++m) { u32x2 o; o.x = cvt_pk_bf16(acc[m][n][0] * s4[0], acc[m][n][1] * s4[1]); o.y = cvt_pk_bf16(acc[m][n][2] * s4[2], acc[m][n][3] * s4[3]);
                *(u32x2*)(yd + (size_t)(t0 + m * 16 + fr) * 512 + g * 128 + d) = o; } }
    }
    __syncthreads();
}

__device__ __forceinline__ void lru_tile(LAS unsigned char* lds, const Params& p, int l, const bf16_t* proj, bf16_t* yb, const bf16_t* waxt, float* Aend, float* Hend, const float* carry, int tile, int mode) {
    const int tid = ltid(), wid = tid >> 6, lane = tid & 63, fr = lane & 15, fq = lane >> 4;
    const int t0 = tile * 64, pos0 = t0 % SEQ, c = wid * 64 + lane;
    LAS bf16_t* Aw = (LAS bf16_t*)(lds + wid * 10560);
    LAS float* Xw = (LAS float*)(lds + wid * 10560 + 2304);
    bf16x8 bfr[8][2];
#pragma unroll
    for (int n = 0; n < 8; ++n)
#pragma unroll
        for (int ks = 0; ks < 2; ++ks) bfr[n][ks] = *(const bf16x8*)(waxt + ((size_t)(wid * 128 + n * 16 + fr)) * 64 + ks * 32 + fq * 8);
    const float* cwp = p.in[zz() + 11] + (size_t)l * 4 * 512 + c;
    const float cw0 = cwp[0], cw1 = cwp[512], cw2 = cwp[1024], cw3 = cwp[1536], cb = p.in[zz() + 12][l * 512 + c];
    const float ba = p.in[zz() + 14][l * 512 + c], bx = p.in[zz() + 16][l * 512 + c], sp8 = 8.0f * softplusf_(-p.in[zz() + 17][l * 512 + c]);
    const bf16_t* xcol = proj + (size_t)t0 * PW + PC_BX + c;
    float xm3 = 0.f, xm2 = 0.f, xm1 = 0.f;
    if (pos0 > 0) { xm3 = bf2f(xcol[-3L * PW]); xm2 = bf2f(xcol[-2L * PW]); xm1 = bf2f(xcol[-1L * PW]); }
    const bf16_t* gcol = proj + (size_t)t0 * PW + PC_BG + c;
    bf16_t* ycol = yb + (size_t)t0 * 512 + c;
    float h = mode ? carry[(size_t)tile * 512 + c] : 0.f, Ap = 1.f;
    for (int sub = 0; sub < 4; ++sub) {
        float xc[16];
#pragma unroll
        for (int tt = 0; tt < 16; ++tt) { const float xin = bf2f(*xcol); xcol += PW; xc[tt] = cb + cw0 * xm3 + cw1 * xm2 + cw2 * xm1 + cw3 * xin; xm3 = xm2; xm2 = xm1; xm1 = xin; Aw[tt * 72 + lane] = f2bf(xc[tt]); }
        __syncthreads();
        f32x4 acc[8];
#pragma unroll
        for (int n = 0; n < 8; ++n) acc[n] = (f32x4){0.f, 0.f, 0.f, 0.f};
#pragma unroll
        for (int ks = 0; ks < 2; ++ks) { const bf16x8 af = *(const LAS bf16x8*)(Aw + fr * 72 + ks * 32 + fq * 8);
#pragma unroll
            for (int n = 0; n < 8; ++n) acc[n] = __builtin_amdgcn_mfma_f32_16x16x32_bf16(bfr[n][ks], af, acc[n], 0, 0, 0); }
#pragma unroll
        for (int n = 0; n < 8; ++n)
#pragma unroll
            for (int j = 0; j < 4; ++j) Xw[fr * 129 + n * 16 + fq * 4 + j] = acc[n][j];
        __syncthreads();
#pragma unroll
        for (int tt = 0; tt < 16; ++tt) {
            const float r = sigmoidf_(Xw[tt * 129 + lane] + ba), ig = sigmoidf_(Xw[tt * 129 + 64 + lane] + bx);
            const float la = -sp8 * r, a = __expf(la), x2 = 2.0f * la;
            const float om = (x2 > -0.1f) ? -x2 * (1.0f + x2 * (0.5f + x2 * (0.16666667f + x2 * 0.041666668f))) : 1.0f - a * a;
            h = a * h + __builtin_amdgcn_sqrtf(om) * ig * xc[tt]; Ap *= a;
            if (mode) { const float gt = bf2f(*gcol); gcol += PW; *ycol = f2bf(h * geluf_(gt)); ycol += 512; }
        }
        __syncthreads();
    }
    if (!mode) { Aend[(size_t)tile * 512 + c] = Ap; Hend[(size_t)tile * 512 + c] = h; }
}
__device__ __forceinline__ void lru_carry(const float* Aend, const float* Hend, float* carry) {
    const int gid = lbid() * NTHR + ltid();
    if (gid < (TS / SEQ) * 512) {
        const int bl = gid >> 9, c = gid & 511; float h = 0.f;
        for (int n = 0; n < 64; ++n) { const size_t o = (size_t)(bl * 64 + n) * 512 + c; carry[o] = h; h = Aend[o] * h + Hend[o]; }
    }
}

__device__ __forceinline__ void gdn_prep(LAS unsigned char* lds, const Params& p, int l, const bf16_t* proj, const float* AB, bf16_t* GQ, bf16_t* GK, bf16_t* GU, bf16_t* GW, bf16_t* GA, float* edec, int item) {
    const int tid = ltid(), wid = tid >> 6, lane = tid & 63, fr = lane & 15, fq = lane >> 4;
    const int bl = item >> 8, n = (item & 255) >> 2, hh = item & 3, ch = bl * 64 + n, t0 = ch * 64;
    LAS bf16_t* Kl = (LAS bf16_t*)lds;
    LAS bf16_t* Ql = (LAS bf16_t*)(lds + 17408);
    LAS float* RHS = (LAS float*)(lds + 34816);
    LAS float* Am = (LAS float*)(lds + 101376);
    LAS float* gc = (LAS float*)(lds + 117760);
    LAS float* bt = (LAS float*)(lds + 118016);
    const int t = tid >> 3, d0 = (tid & 7) * 16;
#pragma unroll
    for (int sec = 0; sec < 3; ++sec) {
        const int colh = sec * 512 + hh * 128 + d0;
        u32x4 w0[4], w1[4]; float msk[4];
#pragma unroll
        for (int k = 0; k < 4; ++k) {
            const int tt = t - 3 + k; const bool valid = (tt >= 0) || (n > 0);
            const bf16_t* src = proj + (long)(t0 + (valid ? tt : 0)) * PW + PC_CQ + colh;
            w0[k] = *(const u32x4*)src; w1[k] = *(const u32x4*)(src + 8); msk[k] = valid ? 1.0f : 0.0f;
        }
        float a[16];
#pragma unroll
        for (int e = 0; e < 16; ++e) a[e] = 0.f;
#pragma unroll
        for (int k = 0; k < 4; ++k) {
            const float* cwp = p.in[zz() + 18] + ((size_t)l * 4 + k) * 1536 + colh;
#pragma unroll
            for (int q = 0; q < 4; ++q) { const f32x4 c4 = *(const f32x4*)(cwp + q * 4) * msk[k];
                const unsigned wa = (q < 2) ? w0[k][2 * q] : w1[k][2 * q - 4], wb = (q < 2) ? w0[k][2 * q + 1] : w1[k][2 * q - 3];
                a[q * 4 + 0] += c4[0] * lo_bf(wa); a[q * 4 + 1] += c4[1] * hi_bf(wa); a[q * 4 + 2] += c4[2] * lo_bf(wb); a[q * 4 + 3] += c4[3] * hi_bf(wb); }
        }
#pragma unroll
        for (int e = 0; e < 16; ++e) a[e] = siluf_(a[e]);
        if (sec < 2) {
            float ss = 0.f;
#pragma unroll
            for (int e = 0; e < 16; ++e) ss += a[e] * a[e];
            ss += __shfl_xor(ss, 1); ss += __shfl_xor(ss, 2); ss += __shfl_xor(ss, 4);
            const float nrm = rsqrtf(ss + EPS) * (sec == 0 ? 0.08838834764831845f : 1.0f);
#pragma unroll
            for (int e = 0; e < 16; ++e) a[e] *= nrm;
            LAS bf16_t* X = sec == 0 ? Ql : Kl;
#pragma unroll
            for (int e = 0; e < 16; e += 2) *(LAS unsigned*)(X + t * 136 + d0 + e) = cvt_pk_bf16(a[e], a[e + 1]);
        }
        if (sec >= 1) {
            LAS float* R = RHS + t * 260 + (sec == 1 ? 128 : 0) + d0;
#pragma unroll
            for (int e = 0; e < 16; e += 4) *(LAS f32x4*)(R + e) = (f32x4){a[e], a[e + 1], a[e + 2], a[e + 3]};
        }
    }
    if (wid == 0) {
        const float al = AB[(size_t)(t0 + lane) * 8 + 4 + hh], be = AB[(size_t)(t0 + lane) * 8 + hh];
        float gv = -__expf(p.in[zz() + 19][l * 4 + hh]) * softplusf_(al + p.in[zz() + 20][l * 4 + hh]);
#pragma unroll
        for (int o = 1; o < 64; o <<= 1) { const float u = __shfl_up(gv, o); if (lane >= o) gv += u; }
        gc[lane] = gv; bt[lane] = sigmoidf_(be);
        if (lane == 63) edec[item] = __expf(gv);
    }
    __syncthreads();
    float kdv[16];
    {
        const float bet = bt[t], gct = gc[t], eg = __expf(gct), ekd = __expf(gc[63] - gct);
        LAS float* Rv = RHS + t * 260 + d0; LAS float* Rk = Rv + 128;
#pragma unroll
        for (int e = 0; e < 16; e += 4) { const f32x4 v4 = *(LAS f32x4*)(Rv + e), k4 = *(LAS f32x4*)(Rk + e);
            *(LAS f32x4*)(Rv + e) = v4 * bet; *(LAS f32x4*)(Rk + e) = k4 * (bet * eg);
            kdv[e] = k4[0] * ekd; kdv[e + 1] = k4[1] * ekd; kdv[e + 2] = k4[2] * ekd; kdv[e + 3] = k4[3] * ekd; }
        unsigned qw[8];
#pragma unroll
        for (int e = 0; e < 8; ++e) { const unsigned w = *(LAS unsigned*)(Ql + t * 136 + d0 + 2 * e); qw[e] = cvt_pk_bf16(lo_bf(w) * eg, hi_bf(w) * eg); }
        bf16_t* qdst = GQ + (size_t)(t0 + t) * 512 + hh * 128 + d0;
        *(u32x4*)qdst = (u32x4){qw[0], qw[1], qw[2], qw[3]}; *(u32x4*)(qdst + 8) = (u32x4){qw[4], qw[5], qw[6], qw[7]};
    }
    {
        const int it = wid & 3, which = wid >> 2;
        LAS bf16_t* Xi = which ? Ql : Kl;
        bf16x8 af[4];
#pragma unroll
        for (int ks = 0; ks < 4; ++ks) af[ks] = *(const LAS bf16x8*)(Xi + (it * 16 + fr) * 136 + ks * 32 + fq * 8);
        const int i = it * 16 + fr; const float gci = gc[i], bti = bt[i];
#pragma unroll
        for (int jt = 0; jt < 4; ++jt) {
            f32x4 acc = (f32x4){0.f, 0.f, 0.f, 0.f};
#pragma unroll
            for (int ks = 0; ks < 4; ++ks) { const bf16x8 bf = *(const LAS bf16x8*)(Kl + (jt * 16 + fr) * 136 + ks * 32 + fq * 8); acc = __builtin_amdgcn_mfma_f32_16x16x32_bf16(bf, af[ks], acc, 0, 0, 0); }
            float v[4];
#pragma unroll
            for (int jj = 0; jj < 4; ++jj) { const int j = jt * 16 + fq * 4 + jj; const float dec = (i >= j) ? __expf(gci - gc[j]) : 0.f;
                v[jj] = which ? acc[jj] * dec : ((i > j) ? bti * acc[jj] * dec : 0.f); }
            if (which) { u32x2 o; o.x = cvt_pk_bf16(v[0], v[1]); o.y = cvt_pk_bf16(v[2], v[3]); *(u32x2*)(GA + (size_t)(t0 + i) * 256 + hh * 64 + jt * 16 + fq * 4) = o; }
            else *(LAS f32x4*)(Am + i * 64 + jt * 16 + fq * 4) = (f32x4){v[0], v[1], v[2], v[3]};
        }
    }
    __syncthreads();
    {
        LAS bf16_t* KDT = Ql;
#pragma unroll
        for (int e = 0; e < 16; ++e) KDT[(d0 + e) * 68 + t] = f2bf(kdv[e]);
    }
    if (tid < 256) {
        float x[64];
        int lz; asm volatile("v_mov_b32 %0, 0" : "=v"(lz));
        const LAS float* Amz = Am + lz;
#pragma unroll
        for (int i = 0; i < 64; ++i) x[i] = 0.f;
#pragma unroll
        for (int i = 0; i < 64; ++i) {
            float s = RHS[i * 260 + tid], s1 = 0.f, s2 = 0.f, s3 = 0.f;
#pragma unroll
            for (int j4 = 0; j4 < (i + 3) / 4; ++j4) { const f32x4 a4 = *(const LAS f32x4*)(Amz + i * 64 + j4 * 4);
                s -= a4[0] * x[j4 * 4]; s1 -= a4[1] * x[j4 * 4 + 1]; s2 -= a4[2] * x[j4 * 4 + 2]; s3 -= a4[3] * x[j4 * 4 + 3]; }
            s = (s + s1) + (s2 + s3);
            x[i] = s; RHS[i * 260 + tid] = s;
        }
    }
    __syncthreads();
    {
        const int seg = tid & 7;
        const LAS float* xr = RHS + t * 260 + seg * 32;
        bf16_t* dst = ((seg < 4) ? GU : GW) + (size_t)(t0 + t) * 512 + hh * 128 + (seg & 3) * 32;
#pragma unroll
        for (int q = 0; q < 4; ++q) { const f32x4 a = *(const LAS f32x4*)(xr + q * 8), b = *(const LAS f32x4*)(xr + q * 8 + 4);
            u32x4 w; w.x = cvt_pk_bf16(a[0], a[1]); w.y = cvt_pk_bf16(a[2], a[3]); w.z = cvt_pk_bf16(b[0], b[1]); w.w = cvt_pk_bf16(b[2], b[3]); *(u32x4*)(dst + q * 8) = w; }
        const LAS bf16_t* kr = Ql + (2 * t + (seg >> 2)) * 68 + (seg & 3) * 16;
        const u32x2 k0 = *(const LAS u32x2*)kr, k1 = *(const LAS u32x2*)(kr + 4), k2 = *(const LAS u32x2*)(kr + 8), k3 = *(const LAS u32x2*)(kr + 12);
        bf16_t* kdst = GK + (size_t)(t0 + t) * 512 + hh * 128 + seg * 16;
        *(u32x4*)kdst = (u32x4){k0.x, k0.y, k1.x, k1.y}; *(u32x4*)(kdst + 8) = (u32x4){k2.x, k2.y, k3.x, k3.y};
    }
    __syncthreads();
}

template <int OFF> __device__ __forceinline__ void dsr64(u32x2& d, unsigned addr) { asm volatile("ds_read_b64 %0, %1 offset:%2" : "=v"(d) : "v"(addr), "n"(OFF)); }
__device__ __forceinline__ void lgkm_wait8(u32x2& a, u32x2& b, u32x2& c, u32x2& d, u32x2& e, u32x2& f, u32x2& g, u32x2& h) {
    asm volatile("s_waitcnt lgkmcnt(0)" : "+v"(a), "+v"(b), "+v"(c), "+v"(d), "+v"(e), "+v"(f), "+v"(g), "+v"(h)); }
template <int RS  , int NK, int NM> struct FragSet { u32x2 lo[NK][NM], hi[NK][NM]; };
__device__ __forceinline__ void gdn_scan(LAS unsigned char* lds, const unsigned char* ws, float* oraw, const float* edec, int chain) {
    const int tid = ltid(), wid = __builtin_amdgcn_readfirstlane(tid >> 6), lane = tid & 63, fr = lane & 15, fq = lane >> 4;
    const int bl = chain >> 5, hh = (chain >> 3) & 3, es = chain & 7, e0 = es * 16;
    constexpr int BUF = 64512, O_W = 0, O_Q = 17408, O_KT = 34816, O_AT = 53248, O_U = 62464, O_PS = 2 * BUF, O_PV = 2 * BUF + 4096;
    const unsigned rb = (unsigned)(bl * 64) * 64u;
    const bool stager = (wid >= 2);
    unsigned soff[11];
#pragma unroll
    for (int i = 0; i < 11; ++i) {
        const int blk = (wid - 2) + 6 * i;
        const int q = blk * 64 + lane;
        unsigned o = 0u;
        if (stager && blk < 63) {
            if (q < 1088) { const int row = q / 17, pc = min(q % 17, 15); o = (unsigned)(WS_GDW + ((size_t)(rb + row) * 512 + hh * 128 + pc * 8) * 2); }
            else if (q < 2176) { const int q2 = q - 1088, row = q2 / 17, pc = min(q2 % 17, 15); o = (unsigned)(WS_GDQ + ((size_t)(rb + row) * 512 + hh * 128 + pc * 8) * 2); }
            else if (q < 3328) { const int q2 = q - 2176, d = q2 / 9, pc = min(q2 % 9, 7); o = (unsigned)(WS_GDK + ((size_t)(rb + (d >> 1)) * 512 + hh * 128 + (d & 1) * 64 + pc * 8) * 2); }
            else if (q < 3904) { const int q2 = q - 3328, row = q2 / 9, pc = min(q2 % 9, 7); o = (unsigned)(WS_GDA + ((size_t)(rb + row) * 256 + hh * 64 + pc * 8) * 2); }
            else { const int q2 = q - 3904, row = q2 >> 1, pc = q2 & 1; o = (unsigned)(WS_GDU + ((size_t)(rb + row) * 512 + hh * 128 + e0 + pc * 8) * 2); }
        }
        soff[i] = o;
    }
#define SCAN_DMA(chunk, bufsel) do { _Pragma("unroll") for (int i = 0; i < 11; ++i) { const int blk = (wid - 2) + 6 * i; if (blk < 63) { \
        const unsigned stp = (blk >= 52 && blk < 61) ? 32768u : 65536u; \
        __builtin_amdgcn_global_load_lds((const unsigned*)(ws + soff[i] + (unsigned)(chunk) * stp), (LAS unsigned*)(lds + (bufsel) * BUF + blk * 1024), 16, 0, 0); } } } while (0)
    if (stager) { SCAN_DMA(0, 0); asm volatile("s_waitcnt vmcnt(0)" ::: "memory"); }
    if (wid == 1) {
#pragma unroll
        for (int kt = 0; kt < 4; ++kt) *(LAS u32x4*)(lds + O_PS + kt * 1024 + lane * 16) = (u32x4){0u, 0u, 0u, 0u};
    }
    const float dv = edec[bl * 256 + lane * 4 + hh];
    f32x4 Sacc[8];
#pragma unroll
    for (int d = 0; d < 8; ++d) Sacc[d] = (f32x4){0.f, 0.f, 0.f, 0.f};
    __syncthreads();
    for (int n = 0; n < 64; ++n) {
        const LAS unsigned char* B = lds + (n & 1) * BUF;
        const int t0 = (bl * 64 + n) * 64;
        f32x4 OS[4];
        bf16x8 vb[2];
        if (stager) { if (n + 1 < 64) SCAN_DMA(n + 1, (n + 1) & 1); }
        else if (wid == 0) {
            f32x4 WS[4];
            bf16x8 sb[4];
#pragma unroll
            for (int kt = 0; kt < 4; ++kt) { u32x4 w; w.x = cvt_pk_bf16(Sacc[2 * kt][0], Sacc[2 * kt][1]); w.y = cvt_pk_bf16(Sacc[2 * kt][2], Sacc[2 * kt][3]);
                w.z = cvt_pk_bf16(Sacc[2 * kt + 1][0], Sacc[2 * kt + 1][1]); w.w = cvt_pk_bf16(Sacc[2 * kt + 1][2], Sacc[2 * kt + 1][3]); sb[kt] = __builtin_bit_cast(bf16x8, w); }
#pragma unroll
            for (int m = 0; m < 4; ++m) WS[m] = (f32x4){0.f, 0.f, 0.f, 0.f};
            {
                u32x2 wlo[4][4], whi[4][4];
                const unsigned bw = (unsigned)(unsigned long)(B + O_W + (fr * 136 + fq * 4) * 2);
                dsr64<0>(wlo[0][0], bw); dsr64<32>(whi[0][0], bw);
                dsr64<4352>(wlo[0][1], bw); dsr64<4384>(whi[0][1], bw);
                dsr64<8704>(wlo[0][2], bw); dsr64<8736>(whi[0][2], bw);
                dsr64<13056>(wlo[0][3], bw); dsr64<13088>(whi[0][3], bw);
                dsr64<64>(wlo[1][0], bw); dsr64<96>(whi[1][0], bw);
                dsr64<4416>(wlo[1][1], bw); dsr64<4448>(whi[1][1], bw);
                dsr64<8768>(wlo[1][2], bw); dsr64<8800>(whi[1][2], bw);
                dsr64<13120>(wlo[1][3], bw); dsr64<13152>(whi[1][3], bw);
                dsr64<128>(wlo[2][0], bw); dsr64<160>(whi[2][0], bw);
                dsr64<4480>(wlo[2][1], bw); dsr64<4512>(whi[2][1], bw);
                dsr64<8832>(wlo[2][2], bw); dsr64<8864>(whi[2][2], bw);
                dsr64<13184>(wlo[2][3], bw); dsr64<13216>(whi[2][3], bw);
                dsr64<192>(wlo[3][0], bw); dsr64<224>(whi[3][0], bw);
                dsr64<4544>(wlo[3][1], bw); dsr64<4576>(whi[3][1], bw);
                dsr64<8896>(wlo[3][2], bw); dsr64<8928>(whi[3][2], bw);
                dsr64<13248>(wlo[3][3], bw); dsr64<13280>(whi[3][3], bw);
                lgkm_wait8(wlo[0][0], wlo[0][1], wlo[0][2], wlo[0][3], wlo[1][0], wlo[1][1], wlo[1][2], wlo[1][3]);
                lgkm_wait8(wlo[2][0], wlo[2][1], wlo[2][2], wlo[2][3], wlo[3][0], wlo[3][1], wlo[3][2], wlo[3][3]);
                lgkm_wait8(whi[0][0], whi[0][1], whi[0][2], whi[0][3], whi[1][0], whi[1][1], whi[1][2], whi[1][3]);
                lgkm_wait8(whi[2][0], whi[2][1], whi[2][2], whi[2][3], whi[3][0], whi[3][1], whi[3][2], whi[3][3]);
#pragma unroll
                for (int kt = 0; kt < 4; ++kt)
#pragma unroll
                    for (int m = 0; m < 4; ++m) WS[m] = __builtin_amdgcn_mfma_f32_16x16x32_bf16(__builtin_bit_cast(bf16x8, (u32x4){wlo[kt][m].x, wlo[kt][m].y, whi[kt][m].x, whi[kt][m].y}), sb[kt], WS[m], 0, 0, 0);
            }
#pragma unroll
            for (int m = 0; m < 4; ++m)
#pragma unroll
                for (int jj = 0; jj < 4; ++jj) WS[m][jj] = bf2f(*(const LAS bf16_t*)(B + O_U + ((m * 16 + fq * 4 + jj) * 16 + fr) * 2)) - WS[m][jj];
#pragma unroll
            for (int kc = 0; kc < 2; ++kc) { u32x4 w; w.x = cvt_pk_bf16(WS[2 * kc][0], WS[2 * kc][1]); w.y = cvt_pk_bf16(WS[2 * kc][2], WS[2 * kc][3]);
                w.z = cvt_pk_bf16(WS[2 * kc + 1][0], WS[2 * kc + 1][1]); w.w = cvt_pk_bf16(WS[2 * kc + 1][2], WS[2 * kc + 1][3]); vb[kc] = __builtin_bit_cast(bf16x8, w);
                *(LAS u32x4*)(lds + O_PV + kc * 1024 + lane * 16) = w; }
        } else if (wid == 1) {
#pragma unroll
            for (int m = 0; m < 4; ++m) OS[m] = (f32x4){0.f, 0.f, 0.f, 0.f};
            {
                u32x2 qlo[4][4], qhi[4][4]; bf16x8 sbr[4];
#pragma unroll
                for (int kt = 0; kt < 4; ++kt) sbr[kt] = *(const LAS bf16x8*)(lds + O_PS + kt * 1024 + lane * 16);
                const unsigned bq = (unsigned)(unsigned long)(B + O_Q + (fr * 136 + fq * 4) * 2);
                dsr64<0>(qlo[0][0], bq); dsr64<32>(qhi[0][0], bq);
                dsr64<4352>(qlo[0][1], bq); dsr64<4384>(qhi[0][1], bq);
                dsr64<8704>(qlo[0][2], bq); dsr64<8736>(qhi[0][2], bq);
                dsr64<13056>(qlo[0][3], bq); dsr64<13088>(qhi[0][3], bq);
                dsr64<64>(qlo[1][0], bq); dsr64<96>(qhi[1][0], bq);
                dsr64<4416>(qlo[1][1], bq); dsr64<4448>(qhi[1][1], bq);
                dsr64<8768>(qlo[1][2], bq); dsr64<8800>(qhi[1][2], bq);
                dsr64<13120>(qlo[1][3], bq); dsr64<13152>(qhi[1][3], bq);
                dsr64<128>(qlo[2][0], bq); dsr64<160>(qhi[2][0], bq);
                dsr64<4480>(qlo[2][1], bq); dsr64<4512>(qhi[2][1], bq);
                dsr64<8832>(qlo[2][2], bq); dsr64<8864>(qhi[2][2], bq);
                dsr64<13184>(qlo[2][3], bq); dsr64<13216>(qhi[2][3], bq);
                dsr64<192>(qlo[3][0], bq); dsr64<224>(qhi[3][0], bq);
                dsr64<4544>(qlo[3][1], bq); dsr64<4576>(qhi[3][1], bq);
                dsr64<8896>(qlo[3][2], bq); dsr64<8928>(qhi[3][2], bq);
                dsr64<13248>(qlo[3][3], bq); dsr64<13280>(qhi[3][3], bq);
                lgkm_wait8(qlo[0][0], qlo[0][1], qlo[0][2], qlo[0][3], qlo[1][0], qlo[1][1], qlo[1][2], qlo[1][3]);
                lgkm_wait8(qlo[2][0], qlo[2][1], qlo[2][2], qlo[2][3], qlo[3][0], qlo[3][1], qlo[3][2], qlo[3][3]);
                lgkm_wait8(qhi[0][0], qhi[0][1], qhi[0][2], qhi[0][3], qhi[1][0], qhi[1][1], qhi[1][2], qhi[1][3]);
                lgkm_wait8(qhi[2][0], qhi[2][1], qhi[2][2], qhi[2][3], qhi[3][0], qhi[3][1], qhi[3][2], qhi[3][3]);
#pragma unroll
                for (int kt = 0; kt < 4; ++kt)
#pragma unroll
                    for (int m = 0; m < 4; ++m) OS[m] = __builtin_amdgcn_mfma_f32_16x16x32_bf16(__builtin_bit_cast(bf16x8, (u32x4){qlo[kt][m].x, qlo[kt][m].y, qhi[kt][m].x, qhi[kt][m].y}), sbr[kt], OS[m], 0, 0, 0);
            }
        }
        asm volatile("s_waitcnt lgkmcnt(0)" ::: "memory"); __builtin_amdgcn_s_barrier(); asm volatile("" ::: "memory");
        if (wid == 0) {
            const float dec = __shfl(dv, n);
#pragma unroll
            for (int d = 0; d < 8; ++d) Sacc[d] *= dec;
            {
                u32x2 klo[2][8], khi[2][8];
                const unsigned bk = (unsigned)(unsigned long)(B + O_KT + (fr * 72 + fq * 4) * 2);
                dsr64<0>(klo[0][0], bk); dsr64<32>(khi[0][0], bk);
                dsr64<2304>(klo[0][1], bk); dsr64<2336>(khi[0][1], bk);
                dsr64<4608>(klo[0][2], bk); dsr64<4640>(khi[0][2], bk);
                dsr64<6912>(klo[0][3], bk); dsr64<6944>(khi[0][3], bk);
                dsr64<9216>(klo[0][4], bk); dsr64<9248>(khi[0][4], bk);
                dsr64<11520>(klo[0][5], bk); dsr64<11552>(khi[0][5], bk);
                dsr64<13824>(klo[0][6], bk); dsr64<13856>(khi[0][6], bk);
                dsr64<16128>(klo[0][7], bk); dsr64<16160>(khi[0][7], bk);
                dsr64<64>(klo[1][0], bk); dsr64<96>(khi[1][0], bk);
                dsr64<2368>(klo[1][1], bk); dsr64<2400>(khi[1][1], bk);
                dsr64<4672>(klo[1][2], bk); dsr64<4704>(khi[1][2], bk);
                dsr64<6976>(klo[1][3], bk); dsr64<7008>(khi[1][3], bk);
                dsr64<9280>(klo[1][4], bk); dsr64<9312>(khi[1][4], bk);
                dsr64<11584>(klo[1][5], bk); dsr64<11616>(khi[1][5], bk);
                dsr64<13888>(klo[1][6], bk); dsr64<13920>(khi[1][6], bk);
                dsr64<16192>(klo[1][7], bk); dsr64<16224>(khi[1][7], bk);
                lgkm_wait8(klo[0][0], klo[0][1], klo[0][2], klo[0][3], klo[0][4], klo[0][5], klo[0][6], klo[0][7]);
                lgkm_wait8(klo[1][0], klo[1][1], klo[1][2], klo[1][3], klo[1][4], klo[1][5], klo[1][6], klo[1][7]);
                lgkm_wait8(khi[0][0], khi[0][1], khi[0][2], khi[0][3], khi[0][4], khi[0][5], khi[0][6], khi[0][7]);
                lgkm_wait8(khi[1][0], khi[1][1], khi[1][2], khi[1][3], khi[1][4], khi[1][5], khi[1][6], khi[1][7]);
#pragma unroll
                for (int kc = 0; kc < 2; ++kc)
#pragma unroll
                    for (int d = 0; d < 8; ++d) Sacc[d] = __builtin_amdgcn_mfma_f32_16x16x32_bf16(__builtin_bit_cast(bf16x8, (u32x4){klo[kc][d].x, klo[kc][d].y, khi[kc][d].x, khi[kc][d].y}), vb[kc], Sacc[d], 0, 0, 0);
            }
#pragma unroll
            for (int kt = 0; kt < 4; ++kt) { u32x4 w; w.x = cvt_pk_bf16(Sacc[2 * kt][0], Sacc[2 * kt][1]); w.y = cvt_pk_bf16(Sacc[2 * kt][2], Sacc[2 * kt][3]);
                w.z = cvt_pk_bf16(Sacc[2 * kt + 1][0], Sacc[2 * kt + 1][1]); w.w = cvt_pk_bf16(Sacc[2 * kt + 1][2], Sacc[2 * kt + 1][3]);
                *(LAS u32x4*)(lds + O_PS + kt * 1024 + lane * 16) = w; }
        } else if (wid == 1) {
            {
                u32x2 alo[2][4], ahi[2][4]; bf16x8 vbr[2];
#pragma unroll
                for (int kc = 0; kc < 2; ++kc) vbr[kc] = *(const LAS bf16x8*)(lds + O_PV + kc * 1024 + lane * 16);
                const unsigned ba = (unsigned)(unsigned long)(B + O_AT + (fr * 72 + fq * 4) * 2);
                dsr64<0>(alo[0][0], ba); dsr64<32>(ahi[0][0], ba);
                dsr64<2304>(alo[0][1], ba); dsr64<2336>(ahi[0][1], ba);
                dsr64<4608>(alo[0][2], ba); dsr64<4640>(ahi[0][2], ba);
                dsr64<6912>(alo[0][3], ba); dsr64<6944>(ahi[0][3], ba);
                dsr64<64>(alo[1][0], ba); dsr64<96>(ahi[1][0], ba);
                dsr64<2368>(alo[1][1], ba); dsr64<2400>(ahi[1][1], ba);
                dsr64<4672>(alo[1][2], ba); dsr64<4704>(ahi[1][2], ba);
                dsr64<6976>(alo[1][3], ba); dsr64<7008>(ahi[1][3], ba);
                lgkm_wait8(alo[0][0], alo[0][1], alo[0][2], alo[0][3], alo[1][0], alo[1][1], alo[1][2], alo[1][3]);
                lgkm_wait8(ahi[0][0], ahi[0][1], ahi[0][2], ahi[0][3], ahi[1][0], ahi[1][1], ahi[1][2], ahi[1][3]);
#pragma unroll
                for (int kc = 0; kc < 2; ++kc)
#pragma unroll
                    for (int m = 0; m < 4; ++m) OS[m] = __builtin_amdgcn_mfma_f32_16x16x32_bf16(__builtin_bit_cast(bf16x8, (u32x4){alo[kc][m].x, alo[kc][m].y, ahi[kc][m].x, ahi[kc][m].y}), vbr[kc], OS[m], 0, 0, 0);
            }
            float* op = oraw + (size_t)(t0 + fq * 4) * 512 + hh * 128 + e0 + fr;
#pragma unroll
            for (int m = 0; m < 4; ++m)
#pragma unroll
                for (int jj = 0; jj < 4; ++jj) op[(size_t)(m * 16 + jj) * 512] = OS[m][jj];
        } else if (stager) {
            asm volatile("s_waitcnt vmcnt(0)" ::: "memory");
        }
        __syncthreads();
    }
#undef SCAN_DMA
}
__device__ __forceinline__ void gdn_out(const Params& p, int l, const float* oraw, const bf16_t* proj, bf16_t* yc) {
    const int tid = ltid(), sub = tid & 15;
    const float* ng = p.in[zz() + 21] + l * 128 + sub * 8;
    const f32x4 g0 = *(const f32x4*)ng, g1 = *(const f32x4*)(ng + 4);
    for (int rowi = lbid() * 32 + (tid >> 4); rowi < TS * 4; rowi += lgdim() * 32) {
        const int t = rowi >> 2, hh = rowi & 3;
        const float* op = oraw + (size_t)t * 512 + hh * 128 + sub * 8;
        const f32x4 o0 = *(const f32x4*)op, o1 = *(const f32x4*)(op + 4);
        float ss = (o0[0] * o0[0] + o0[1] * o0[1]) + (o0[2] * o0[2] + o0[3] * o0[3]) + (o1[0] * o1[0] + o1[1] * o1[1]) + (o1[2] * o1[2] + o1[3] * o1[3]);
        ss += __shfl_xor(ss, 1); ss += __shfl_xor(ss, 2); ss += __shfl_xor(ss, 4); ss += __shfl_xor(ss, 8);
        const float rs = rsqrtf(ss * (1.0f / 128.0f) + EPS);
        const u32x4 z = *(const u32x4*)(proj + (size_t)t * PW + PC_CZ + hh * 128 + sub * 8);
        u32x4 w;
        w.x = cvt_pk_bf16(o0[0] * rs * g0[0] * siluf_(lo_bf(z.x)), o0[1] * rs * g0[1] * siluf_(hi_bf(z.x)));
        w.y = cvt_pk_bf16(o0[2] * rs * g0[2] * siluf_(lo_bf(z.y)), o0[3] * rs * g0[3] * siluf_(hi_bf(z.y)));
        w.z = cvt_pk_bf16(o1[0] * rs * g1[0] * siluf_(lo_bf(z.z)), o1[1] * rs * g1[1] * siluf_(hi_bf(z.z)));
        w.w = cvt_pk_bf16(o1[2] * rs * g1[2] * siluf_(lo_bf(z.w)), o1[3] * rs * g1[3] * siluf_(hi_bf(z.w)));
        *(u32x4*)(yc + (size_t)t * 512 + hh * 128 + sub * 8) = w;
    }
}

constexpr int PH_PER_LAYER = 22, N_PHASES = 2 * PH_PER_LAYER + 1;

__device__ __forceinline__ void run_phase(LAS unsigned char* lds, const Params& p, int ph) {
    unsigned char* ws = lptr(p.ws);
    bf16_t* hbuf = (bf16_t*)(ws + WS_H);
    bf16_t* act = (bf16_t*)(ws + WS_PROJ);
    bf16_t* proj = (bf16_t*)(ws + WS_PROJ);
    bf16_t* hslab = hbuf;
    bf16_t* merged = hbuf + (size_t)TS * D;
    float* oraw = (float*)(ws + WS_H);
    bf16_t* ys = (bf16_t*)(ws + WS_YS);
    float* AB = (float*)(ws + WS_AB);
    bf16_t* halo = (bf16_t*)(ws + WS_HALO);
    float* Aend = (float*)(ws + WS_AEND); float* Hend = (float*)(ws + WS_HEND); float* carry = (float*)(ws + WS_CARRY); float* edec = (float*)(ws + WS_EDEC);
    const bf16_t* waxt = (const bf16_t*)(ws + WS_WAXT); const bf16_t* pwt = (const bf16_t*)(ws + WS_PWT);
    const int G = lgdim(), c = lbid();
    if (ph == N_PHASES - 1) { PHON(0) rms_rows_f32_inplace(lptr(p.out), p.in[zz() + 30], T); return; }
    const int l = ph / PH_PER_LAYER, r = ph % PH_PER_LAYER;
    const float* xcur = (l == 0) ? p.in[zz() + 0] : lptr(p.out);
    if (r == 0) { PHON(1) convert_layer(lds, p, l); PHON(0) rms_rows_bf16(xcur, p.in[zz() + 1] + l * D, hbuf, T); return; }
    if (r == 1 || r == 20) { PHON(2) ph_gemm_swiglu(lds, hbuf, (const bf16_t*)(ws + (r == 1 ? WS_WGU1 : WS_WGU2)), act); return; }
    if (r == 2 || r == 21) { PHON(3) ph_gemm_resid(lds, act, (const bf16_t*)(ws + (r == 2 ? WS_WD1 : WS_WD2)), T, DFF, (r == 2) ? xcur : lptr(p.out), lptr(p.out), 0.5f); return; }
    if (r == 19) { rms_rows_bf16(lptr(p.out), p.in[zz() + 26] + l * D, hbuf, T); return; }
    const int slab = (r - 3) >> 3, q = (r - 3) & 7;
    float* xs = lptr(p.out) + (size_t)slab * TS * D;
    switch (q) {
    case 0: if (slab == 0) rms_rows_bf16(xs, p.in[zz() + 5] + l * D, hslab, TS); break;
    case 1: PHON(4) ph_gemm_proj(lds, hslab, (const bf16_t*)(ws + WS_WIN), proj, AB); break;
    case 2:
        PHON(7) for (int t = c; t < TS / 64; t += G) lru_tile(lds, p, l, proj, nullptr, waxt, Aend, Hend, carry, t, 0);
        if (G >= 256) { PHON(5) for (int t = c; t < (TS / 128) * 2; t += G) sgu_tile(lds, p, l, proj, ys, t); }
        break;
    case 3:
        PHON(8) for (int it = c; it < (TS / 64) * 4; it += G) gdn_prep(lds, p, l, proj, AB, (bf16_t*)(ws + WS_GDQ), (bf16_t*)(ws + WS_GDK), (bf16_t*)(ws + WS_GDU), (bf16_t*)(ws + WS_GDW), (bf16_t*)(ws + WS_GDA), edec, it);
        lru_carry(Aend, Hend, carry);
        break;
    case 4: {
        if (c < 128) { PHON(9) gdn_scan(lds, ws, oraw, edec, c); }
        unsigned* qc = (unsigned*)(ws + WS_BAR + 14336) + (l * 2 + slab) * 16;
        volatile LAS unsigned* slot = (volatile LAS unsigned*)(lds + LDS_BYTES - 32);
        const bool t0 = (ltid() == 0);
        constexpr int NQ_LRU = TS / 64, NQ_SGU = (TS / 128) * 2, NQ_POOL = TS / 64, NQ = NQ_LRU + NQ_SGU + NQ_POOL;
        unsigned nxt = 0u;
        if (t0) nxt = __hip_atomic_fetch_add(qc, 1u, __ATOMIC_RELAXED, __HIP_MEMORY_SCOPE_AGENT);
        for (;;) {
            if (t0) *slot = nxt;
            __syncthreads();
            const int it = __builtin_amdgcn_readfirstlane((int)*slot);
            __syncthreads();
            if (it >= NQ) break;
            if (t0) nxt = __hip_atomic_fetch_add(qc, 1u, __ATOMIC_RELAXED, __HIP_MEMORY_SCOPE_AGENT);
            if (it < NQ_LRU) { PHON(10) lru_tile(lds, p, l, proj, ys + (size_t)TS * 512, waxt, Aend, Hend, carry, it, 1); }
            else if (it < NQ_LRU + NQ_SGU) { PHON(5) sgu_tile(lds, p, l, proj, ys, (TS / 128) * 2 + (it - NQ_LRU)); }
            else { PHON(6) pool_tile(lds, p, l, proj, ys + (size_t)3 * TS * 512, halo, pwt, it - NQ_LRU - NQ_SGU); }
        }
        } break;
    case 5: PHON(11) gdn_out(p, l, oraw, proj, ys + (size_t)2 * TS * 512); break;
    case 6: PHON(12) ph_gemm_branch(lds, ys, (const bf16_t*)(ws + WS_WB), proj, merged); break;
    default: PHON(13) ph_gemm_resid(lds, merged, (const bf16_t*)(ws + WS_WOUT), TS, D, xs, xs, 1.0f);
        if (slab == 0) rms_rows_bf16(lptr(p.out) + (size_t)TS * D, p.in[zz() + 5] + l * D, hslab, TS);
        break;
    }
}

extern __shared__ __attribute__((aligned(16))) unsigned char smem_dyn[];

#ifndef DUP_TYPE
#define DUP_TYPE -1
#endif
__device__ __forceinline__ int phase_type(int ph) {
    if (ph == N_PHASES - 1) return 12;
    const int r = ph % PH_PER_LAYER;
    if (r == 0) return 0; if (r == 1 || r == 20) return 1; if (r == 2 || r == 21) return 2; if (r == 19) return 11;
    const int q = (r - 3) & 7;
    return 3 + q;
}
__global__ void __launch_bounds__(NTHR) fwd_megakernel(Params p) {
    cg::grid_group grid = cg::this_grid();
    LAS unsigned char* lds = (LAS unsigned char*)smem_dyn;
    volatile LAS unsigned* st = (volatile LAS unsigned*)(lds + LDS_BYTES - 16);
    if (threadIdx.x == 0) { st[0] = 0u; st[1] = 0u; }
    __syncthreads();
    const XcdBarrier xb = xcd_barrier_post((unsigned*)(p.ws + WS_BAR), st);
    if (p.ph_hi < 0) grid.sync();
    for (int ph = p.ph_lo; ph < p.ph_hi; ++ph) {
        if (ph != N_PHASES - 1 && ph % PH_PER_LAYER == 11) continue;
        if (ph > p.ph_lo) xcd_barrier(xb);
        run_phase(lds, p, ph);
#if DUP_TYPE == 6
        if (phase_type(ph) == 6) { xcd_barrier(xb); run_phase(lds, p, ph - 2); xcd_barrier(xb); run_phase(lds, p, ph - 1); xcd_barrier(xb); run_phase(lds, p, ph); }
#elif DUP_TYPE >= 0
        if (phase_type(ph) == DUP_TYPE) { xcd_barrier(xb); run_phase(lds, p, ph); }
#endif
    }
}

extern "C" void kernel_launch(void* const* d_in, const int* in_sizes, int n_in, void* d_out, int out_size, void* d_ws, size_t ws_size, hipStream_t stream) {
    static int grid_blocks = 0;
    if (grid_blocks == 0) {
        if (n_in != 31 || out_size != T * D || ws_size < WS_END) { fprintf(stderr, "kernel_launch: unexpected shapes (n_in %d out %d ws %zu need %zu)\n", n_in, out_size, ws_size, (size_t)WS_END); grid_blocks = -1; return; }
        int dev = 0, cus = 0, per_cu = 0;
        hipGetDevice(&dev);
        hipDeviceGetAttribute(&cus, hipDeviceAttributeMultiprocessorCount, dev);
        if (hipFuncSetAttribute((const void*)fwd_megakernel, hipFuncAttributeMaxDynamicSharedMemorySize, LDS_BYTES) != hipSuccess) { fprintf(stderr, "kernel_launch: hipFuncSetAttribute failed\n"); grid_blocks = -1; return; }
        hipOccupancyMaxActiveBlocksPerMultiprocessor(&per_cu, (const void*)fwd_megakernel, NTHR, LDS_BYTES);
        if (per_cu < 1) { fprintf(stderr, "kernel_launch: occupancy query returned %d\n", per_cu); per_cu = 1; }
        grid_blocks = cus * per_cu;
        if (grid_blocks < 256) { fprintf(stderr, "kernel_launch: the phase program needs >= 256 co-resident workgroups, got %d\n", grid_blocks); grid_blocks = -1; return; }
    }
    if (grid_blocks < 0) return;
    Params p{};
    for (int i = 0; i < 31; ++i) p.in[i] = (const float*)d_in[i];
    p.out = (float*)d_out; p.ws = (unsigned char*)d_ws;
    hipMemsetAsync((unsigned char*)d_ws + WS_BAR, 0, 16384, stream);
    p.ph_lo = 0; p.ph_hi = N_PHASES;
    void* args[] = {&p};
    hipError_t e = hipLaunchCooperativeKernel((const void*)fwd_megakernel, dim3(grid_blocks), dim3(NTHR), args, LDS_BYTES, stream);
    if (e != hipSuccess) fprintf(stderr, "cooperative launch failed: %s (grid %d)\n", hipGetErrorString(e), grid_blocks);
}
```

```cpp
#include <hip/hip_runtime.h>
#include <hip/hip_cooperative_groups.h>
#include <cstdio>
namespace cg = cooperative_groups;

#ifndef MULTI_LAUNCH
#define MULTI_LAUNCH 0
#endif

#ifndef PH_MASK
#define PH_MASK 0xFFFFF
#endif
#define PHON(k) if constexpr ((PH_MASK >> (k)) & 1)
#define LAS __attribute__((address_space(3)))
typedef unsigned short bf16_t;
typedef short bf16x8 __attribute__((ext_vector_type(8)));
typedef short bf16x4 __attribute__((ext_vector_type(4)));
typedef float f32x4 __attribute__((ext_vector_type(4)));
typedef unsigned u32x4 __attribute__((ext_vector_type(4)));
typedef unsigned u32x2 __attribute__((ext_vector_type(2)));

constexpr int T = 32768, D = 1024, DFF = 2816, NSLAB = 2, TS = T / NSLAB, SEQ = 4096, PW = 8960, PIN = 8712;
constexpr int PC_AU = 0, PC_AV = 512, PC_BX = 1024, PC_BG = 1536, PC_CQ = 2048, PC_CK = 2560, PC_CV = 3072, PC_CZ = 3584, PC_DX = 4096, PC_GATE = 4608, PC_AB = 8704;
constexpr float EPS = 1e-6f;
constexpr int NTHR = 512;
constexpr int LDS_BYTES = 147456;

constexpr size_t WS_WGU1 = 0;
constexpr size_t WS_WD1 = WS_WGU1 + (size_t)5632 * 1024 * 2;
constexpr size_t WS_WIN = WS_WD1 + (size_t)1024 * 2816 * 2;
constexpr size_t WS_WB = WS_WIN + (size_t)PW * 1024 * 2;
constexpr size_t WS_WOUT = WS_WB + (size_t)4 * 1024 * 512 * 2;
constexpr size_t WS_WGU2 = WS_WOUT + (size_t)1024 * 1024 * 2;
constexpr size_t WS_WD2 = WS_WGU2 + (size_t)5632 * 1024 * 2;
constexpr size_t WS_WAXT = WS_WD2 + (size_t)1024 * 2816 * 2;
constexpr size_t WS_PWT = WS_WAXT + 131072;
constexpr size_t WS_PROJ = WS_PWT + 131072;
constexpr size_t WS_H = WS_PROJ + (size_t)TS * PW * 2;
constexpr size_t WS_YS = WS_H + (size_t)T * D * 2;
constexpr size_t WS_AB = WS_YS + (size_t)4 * TS * 512 * 2;
constexpr size_t WS_HALO = WS_AB + (size_t)TS * 8 * 4;
constexpr size_t WS_AEND = WS_HALO + (size_t)(TS / 64) * 3 * 1536 * 2;
constexpr size_t WS_HEND = WS_AEND + (size_t)(TS / 64) * 512 * 4;
constexpr size_t WS_CARRY = WS_HEND + (size_t)(TS / 64) * 512 * 4;
constexpr size_t WS_EDEC = WS_CARRY + (size_t)(TS / 64) * 512 * 4;
constexpr size_t WS_BAR = WS_EDEC + 4096;
constexpr size_t WS_GDQ = WS_H + (size_t)TS * D * 2;
constexpr size_t WS_GDK = WS_GDQ + (size_t)TS * 512 * 2;
constexpr size_t WS_GDU = WS_BAR + 16384;
constexpr size_t WS_GDW = WS_GDU + (size_t)TS * 512 * 2;
constexpr size_t WS_GDA = WS_GDW + (size_t)TS * 512 * 2;
constexpr size_t WS_END = WS_GDA + (size_t)TS * 256 * 2;
static_assert(WS_END <= (size_t)512 * 1024 * 1024, "workspace budget");

struct Params { const float* in[31]; float* out; unsigned char* ws; int ph_lo, ph_hi; };

__device__ __forceinline__ int ltid() { int t = threadIdx.x; asm volatile("" : "+v"(t)); return t; }
__device__ __forceinline__ int lbid() { int t = blockIdx.x; asm volatile("" : "+s"(t)); return t; }
__device__ __forceinline__ int lgdim() { int t = gridDim.x; asm volatile("" : "+s"(t)); return t; }
__device__ __forceinline__ int zz() { int z; asm volatile("s_mov_b32 %0, 0" : "=s"(z)); return z; }
template <class P> __device__ __forceinline__ P* lptr(P* q) { asm volatile("" : "+s"(q)); return q; }
__device__ __forceinline__ float bf2f(unsigned short b) { return __uint_as_float(((unsigned)b) << 16); }
__device__ __forceinline__ unsigned cvt_pk_bf16(float lo, float hi) { unsigned r; asm("v_cvt_pk_bf16_f32 %0, %1, %2" : "=v"(r) : "v"(lo), "v"(hi)); return r; }
__device__ __forceinline__ unsigned short f2bf(float f) { return (unsigned short)(cvt_pk_bf16(f, 0.f) & 0xffffu); }
__device__ __forceinline__ float lo_bf(unsigned w) { return __uint_as_float(w << 16); }
__device__ __forceinline__ float hi_bf(unsigned w) { return __uint_as_float(w & 0xffff0000u); }
__device__ __forceinline__ float sigmoidf_(float x) { return __builtin_amdgcn_rcpf(1.0f + __expf(-x)); }
__device__ __forceinline__ float siluf_(float x) { return x * __builtin_amdgcn_rcpf(1.0f + __expf(-x)); }
__device__ __forceinline__ float geluf_(float x) { const float u = 1.5957691216057308f * (x + 0.044715f * x * x * x); return x * __builtin_amdgcn_rcpf(1.0f + __expf(-u)); }
__device__ __forceinline__ float softplusf_(float x) { return fmaxf(x, 0.f) + log1pf(__expf(-fabsf(x))); }
__device__ __forceinline__ float wave_sum(float v) {
#pragma unroll
    for (int o = 1; o < 64; o <<= 1) v += __shfl_xor(v, o);
    return v;
}


#define XB_TMO      128
#define XB_XCNT(j)  (256  + 64 * (j))
#define XB_XSUB(j)  (1280 + 64 * (j))
#define XB_XGEN(j)  (2304 + 64 * (j))
#define XB_TOP      3328
#define XB_TOPGEN   3392
#define XCD_BAR_WORDS 3456
#define XB_SPIN_CAP (1u << 22)
__device__ __forceinline__ unsigned xb_ld(unsigned* p)              { return __hip_atomic_load(p, __ATOMIC_RELAXED, __HIP_MEMORY_SCOPE_AGENT); }
__device__ __forceinline__ unsigned xb_add(unsigned* p, unsigned v) { return __hip_atomic_fetch_add(p, v, __ATOMIC_RELAXED, __HIP_MEMORY_SCOPE_AGENT); }
__device__ __forceinline__ unsigned xb_xcc_id() { return (unsigned)__builtin_amdgcn_s_getreg((3 << 11) | 20) & 0xFu; }
#define XB_SPIN(cond, bar) do { unsigned _sp = 0; while (cond) { __builtin_amdgcn_s_sleep(1); \
    if ((++_sp & 255u) == 0u) { if (xb_ld(&(bar)[XB_TMO])) break; if (_sp > XB_SPIN_CAP) { atomicAdd(&(bar)[XB_TMO], 1u); break; } } } } while (0)
struct XcdBarrier { unsigned* bar; unsigned x; volatile LAS unsigned* st; };
__device__ __forceinline__ XcdBarrier xcd_barrier_post(unsigned* bar, volatile LAS unsigned* st) {
    XcdBarrier b; b.bar = bar; b.x = xb_xcc_id(); b.st = st;
    if (threadIdx.x == 0) (void)xb_add(&bar[XB_XCNT(b.x)], 1u);
    return b;
}
__device__ __forceinline__ void xcd_barrier_complete(unsigned* bar, unsigned x, unsigned& nloc, unsigned& nx) {
    const unsigned G = gridDim.x * gridDim.y * gridDim.z;
    unsigned sum, cnt, mine, sp = 0u;
    for (;;) {
        sum = 0u; cnt = 0u; mine = 0u;
#pragma unroll
        for (unsigned j = 0; j < 16; ++j) { const unsigned c = xb_ld(&bar[XB_XCNT(j)]); sum += c; cnt += (c > 0u) ? 1u : 0u; mine = (j == x) ? c : mine; }
        if (sum == G) break;
        __builtin_amdgcn_s_sleep(1);
        if ((++sp & 255u) == 0u) { if (xb_ld(&bar[XB_TMO])) break; if (sp > XB_SPIN_CAP) { atomicAdd(&bar[XB_TMO], 1u); break; } }
    }
    nloc = mine > 0u ? mine : 1u; nx = cnt > 0u ? cnt : 1u;
}
__device__ __forceinline__ void xcd_barrier(const XcdBarrier& b) {
    asm volatile("s_waitcnt vmcnt(0)" ::: "memory");
    __syncthreads();
    if (threadIdx.x == 0) {
        unsigned* bar = b.bar;
        __builtin_amdgcn_s_waitcnt(0);
        unsigned nloc = b.st[0], nx = b.st[1];
        if (nloc == 0u) { xcd_barrier_complete(bar, b.x, nloc, nx); b.st[0] = nloc; b.st[1] = nx; }
        const unsigned old = xb_add(&bar[XB_XSUB(b.x)], 1u);
        const unsigned gen = old / nloc;
        if (old + 1u == (gen + 1u) * nloc) {
            __builtin_amdgcn_fence(__ATOMIC_RELEASE, "agent");
            asm volatile("s_waitcnt vmcnt(0)" ::: "memory");
            const unsigned og = xb_add(&bar[XB_TOP], 1u);
            const unsigned tg = og / nx;
            if (og + 1u == (tg + 1u) * nx) xb_add(&bar[XB_TOPGEN], 1u);
            else XB_SPIN(xb_ld(&bar[XB_TOPGEN]) == tg, bar);
            __builtin_amdgcn_fence(__ATOMIC_ACQUIRE, "agent");
            xb_add(&bar[XB_XGEN(b.x)], 1u);
            asm volatile("s_waitcnt vmcnt(0)" ::: "memory");
        } else {
            XB_SPIN(xb_ld(&bar[XB_XGEN(b.x)]) == gen, bar);
            __builtin_amdgcn_fence(__ATOMIC_ACQUIRE, "agent");
            asm volatile("s_waitcnt vmcnt(0)" ::: "memory");
        }
    }
    __syncthreads();
}

namespace pg8 {
constexpr int BM = 256, BK = 64, HALF = 128, HTB = HALF * BK * 2, STAGE_BYTES = 8 * HTB, NXCD = 8, WGM = 8;
__host__ __device__ __forceinline__ int lds_byte(int r, int c) { const int st = (r >> 4) * 2 + (c >> 5), rr = r & 15, cc = c & 31, ob = rr * 64 + cc * 2; return st * 1024 + (ob ^ (((ob >> 9) & 1) << 5)); }
__host__ __device__ __forceinline__ void stage_rc(int b, int& R, int& C) { const int st = b / 1024, sb = b % 1024, swz = sb ^ (((sb >> 9) & 1) << 5); R = (st >> 1) * 16 + swz / 64; C = (st & 1) * 32 + (swz % 64) / 2; }
__host__ __device__ __forceinline__ int perm32(int rho) { const int n = rho >> 4, i = rho & 15; return 8 * (i >> 2) + 4 * n + (i & 3); }

struct Unit { int pm, pn, g; };
struct Gemm { const bf16_t* A; const bf16_t* Bt; int M, N, K; size_t gsA, gsB; };

__device__ __forceinline__ void tile_of(int wgid, int nM, int nN, int nwg, Unit& u) {
    { const int q = nwg / NXCD, r = nwg % NXCD, xcd = wgid % NXCD, off = wgid / NXCD; wgid = (xcd < r ? xcd * (q + 1) : r * (q + 1) + (xcd - r) * q) + off; }
    const int nig = WGM * nN, gid = wgid / nig, fm = gid * WGM, gsz = (nM - fm) < WGM ? (nM - fm) : WGM;
    u.pm = fm + ((wgid % nig) % gsz); u.pn = (wgid % nig) / gsz;
}
struct StaticOrder {
    int nM, nN, nwg, G, c;
    __device__ void init(int M, int N, int G_, int c_) { nM = M / BM; nN = N / BM; nwg = nM * nN; G = G_; c = c_; }
    __device__ bool next(int i, Unit& u) const {
        const long L = (long)i * G + c; if (L >= nwg) return false;
        tile_of((int)L, nM, nN, nwg, u); u.g = 0; return true;
    }
};
struct BranchOrder {
    int nM, nN, nwg, G, c;
    __device__ void init(int M, int N, int G_, int c_) { nM = M / BM; nN = N / BM; nwg = nM * nN; G = G_; c = c_; }
    __device__ bool next(int i, Unit& u) const {
        const long L = (long)(i >> 2) * G + c; if (L >= nwg) return false;
        tile_of((int)L, nM, nN, nwg, u); u.g = i & 3; return true;
    }
};

struct EpiSwiGLU {
    static constexpr bool PERM = true;
    bf16_t* O;
    __device__ __forceinline__ bool keep(const Unit&) const { return false; }
    __device__ __forceinline__ void operator()(f32x4 (&acc)[2][2][4][2], const Unit& u, int wr, int wc, int fr, int fq) const {
        const int row0 = u.pm * BM + wr * 64 + fr, col0 = u.pn * 128 + wc * 32 + 8 * fq;
#pragma unroll
        for (int ai = 0; ai < 2; ++ai)
#pragma unroll
            for (int m = 0; m < 4; ++m) {
                bf16_t* rowp = O + (size_t)(row0 + ai * HALF + m * 16) * DFF + col0;
                float v[8];
#pragma unroll
                for (int n = 0; n < 2; ++n)
#pragma unroll
                    for (int j = 0; j < 4; ++j) v[n * 4 + j] = siluf_(acc[ai][0][m][n][j]) * acc[ai][1][m][n][j];
                u32x4 w; w.x = cvt_pk_bf16(v[0], v[1]); w.y = cvt_pk_bf16(v[2], v[3]); w.z = cvt_pk_bf16(v[4], v[5]); w.w = cvt_pk_bf16(v[6], v[7]);
                *(u32x4*)rowp = w;
                __builtin_amdgcn_sched_barrier(0);
            }
    }
};
struct EpiResid {
    static constexpr bool PERM = false;
    const float* Xin; float* Xout; float scale;
    __device__ __forceinline__ bool keep(const Unit&) const { return false; }
    __device__ __forceinline__ void operator()(f32x4 (&acc)[2][2][4][2], const Unit& u, int wr, int wc, int fr, int fq) const {
        const int row0 = u.pm * BM + wr * 64 + fr, col0 = u.pn * BM + wc * 32 + 4 * fq;
#pragma unroll
        for (int ai = 0; ai < 2; ++ai) {
            f32x4 xi[4][2][2];
#pragma unroll
            for (int m = 0; m < 4; ++m) { const size_t ro = (size_t)(row0 + ai * HALF + m * 16) * D + col0;
#pragma unroll
                for (int bj = 0; bj < 2; ++bj)
#pragma unroll
                    for (int n = 0; n < 2; ++n) xi[m][bj][n] = *(const f32x4*)(Xin + ro + bj * HALF + n * 16); }
#pragma unroll
            for (int m = 0; m < 4; ++m) { const size_t ro = (size_t)(row0 + ai * HALF + m * 16) * D + col0;
#pragma unroll
                for (int bj = 0; bj < 2; ++bj)
#pragma unroll
                    for (int n = 0; n < 2; ++n) *(f32x4*)(Xout + ro + bj * HALF + n * 16) = xi[m][bj][n] + acc[ai][bj][m][n] * scale; }
            __builtin_amdgcn_sched_barrier(0);
        }
    }
};
struct EpiProj {
    static constexpr bool PERM = true;
    bf16_t* O; float* AB;
    __device__ __forceinline__ bool keep(const Unit&) const { return false; }
    __device__ __forceinline__ void operator()(f32x4 (&acc)[2][2][4][2], const Unit& u, int wr, int wc, int fr, int fq) const {
        const int row0 = u.pm * BM + wr * 64 + fr, col0 = u.pn * BM + wc * 32 + 8 * fq;
        const bool ab = (u.pn == PC_AB / BM) && wc == 0 && fq == 0;
#pragma unroll
        for (int ai = 0; ai < 2; ++ai)
#pragma unroll
            for (int m = 0; m < 4; ++m) {
                const int row = row0 + ai * HALF + m * 16;
                bf16_t* rowp = O + (size_t)row * PW + col0;
#pragma unroll
                for (int bj = 0; bj < 2; ++bj) {
                    const f32x4 v0 = acc[ai][bj][m][0], v1 = acc[ai][bj][m][1];
                    u32x4 w; w.x = cvt_pk_bf16(v0[0], v0[1]); w.y = cvt_pk_bf16(v0[2], v0[3]); w.z = cvt_pk_bf16(v1[0], v1[1]); w.w = cvt_pk_bf16(v1[2], v1[3]);
                    *(u32x4*)(rowp + bj * HALF) = w;
                }
                __builtin_amdgcn_sched_barrier(0);
            }
        if (ab) {
#pragma unroll
            for (int ai = 0; ai < 2; ++ai)
#pragma unroll
                for (int m = 0; m < 4; ++m) { const int row = row0 + ai * HALF + m * 16; *(f32x4*)(AB + (size_t)row * 8) = acc[ai][0][m][0]; *(f32x4*)(AB + (size_t)row * 8 + 4) = acc[ai][0][m][1]; }
        }
    }
};
struct EpiBranch {
    static constexpr bool PERM = true;
    const bf16_t* P; bf16_t* O;
    __device__ __forceinline__ bool keep(const Unit& u) const { return u.g < 3; }
    __device__ __forceinline__ void operator()(f32x4 (&acc)[2][2][4][2], const Unit& u, int wr, int wc, int fr, int fq) const {
        const int row0 = u.pm * BM + wr * 64 + fr, col0 = u.pn * BM + wc * 32 + 8 * fq;
        const bool last = (u.g == 3);
#pragma unroll
        for (int ai = 0; ai < 2; ++ai) {
            u32x4 g0[4][2], g1[4][2];
#pragma unroll
            for (int m = 0; m < 4; ++m) { const bf16_t* gp = P + (size_t)(row0 + ai * HALF + m * 16) * PW + PC_GATE + u.g * D + col0;
#pragma unroll
                for (int bj = 0; bj < 2; ++bj) { g0[m][bj] = *(const u32x4*)(gp + bj * HALF); g1[m][bj] = last ? g0[m][bj] : *(const u32x4*)(gp + D + bj * HALF); } }
#pragma unroll
            for (int m = 0; m < 4; ++m) {
                const int row = row0 + ai * HALF + m * 16;
#pragma unroll
                for (int bj = 0; bj < 2; ++bj) {
                    float f[8];
                    if (!last) {
#pragma unroll
                        for (int q = 0; q < 4; ++q) {
                            f[2 * q] = (1.0f + __expf(-lo_bf(g1[m][bj][q]))) * __builtin_amdgcn_rcpf(1.0f + __expf(-lo_bf(g0[m][bj][q])));
                            f[2 * q + 1] = (1.0f + __expf(-hi_bf(g1[m][bj][q]))) * __builtin_amdgcn_rcpf(1.0f + __expf(-hi_bf(g0[m][bj][q])));
                        }
                    } else {
#pragma unroll
                        for (int q = 0; q < 4; ++q) { f[2 * q] = __builtin_amdgcn_rcpf(1.0f + __expf(-lo_bf(g0[m][bj][q]))); f[2 * q + 1] = __builtin_amdgcn_rcpf(1.0f + __expf(-hi_bf(g0[m][bj][q]))); }
                    }
#pragma unroll
                    for (int n = 0; n < 2; ++n)
#pragma unroll
                        for (int j = 0; j < 4; ++j) acc[ai][bj][m][n][j] *= f[n * 4 + j];
                    if (last) {
                        const f32x4 v0 = acc[ai][bj][m][0], v1 = acc[ai][bj][m][1];
                        u32x4 w; w.x = cvt_pk_bf16(v0[0], v0[1]); w.y = cvt_pk_bf16(v0[2], v0[3]); w.z = cvt_pk_bf16(v1[0], v1[1]); w.w = cvt_pk_bf16(v1[2], v1[3]);
                        *(u32x4*)(O + (size_t)row * D + col0 + bj * HALF) = w;
                    }
                }
            }
            __builtin_amdgcn_sched_barrier(0);
        }
    }
};

template <class Epi, class Sched>
__device__ __forceinline__ void gemm_phase(LAS unsigned char* lds, const Gemm g, const Sched& S, const Epi& E) {
    const int tid = ltid(), wid = __builtin_amdgcn_readfirstlane(tid >> 6), lane = tid & 63, wr = wid >> 2, wc = wid & 3, fr = lane & 15, fq = lane >> 4;
    const int K = g.K, nt = K / BK;
    unsigned voffA[2], voffB[2];
#pragma unroll
    for (int i = 0; i < 2; ++i) { int R, C; stage_rc(tid * 16 + i * 8192, R, C); const int Rb = Epi::PERM ? ((R & ~31) + perm32(R & 31)) : R;
        voffA[i] = (unsigned)(R * K + C) * 2u; voffB[i] = (unsigned)(Rb * K + C) * 2u; }
    const size_t kstep = (size_t)(BK * 2);
    const size_t hstep = (size_t)HALF * K * 2;
    const size_t tstep = 2 * hstep;
    const unsigned ldsw = (unsigned)wid * 1024u;
    const int aoff = lds_byte(wr * 64 + fr, fq * 8), boff = lds_byte(wc * 32 + fr, fq * 8);
#define PG8_SA(b, h) (((b) * 2 + (h)) * HTB)
#define PG8_SB(b, h) ((4 + (b) * 2 + (h)) * HTB)
#define PG8_STAGE(bufoff, gbase, voff) do { _Pragma("unroll") for (int _i = 0; _i < 2; ++_i) \
        __builtin_amdgcn_global_load_lds((const unsigned*)((const char*)(gbase) + (voff)[_i]), (LAS unsigned*)(lds + (bufoff) + ldsw + _i * 8192), 16, 0, 0); } while (0)
#define PG8_LDA(dst, b, h) do { _Pragma("unroll") for (int m = 0; m < 4; ++m) _Pragma("unroll") for (int k = 0; k < 2; ++k) dst[m][k] = *(const LAS bf16x8*)(lds + PG8_SA(b, h) + aoff + m * 2048 + k * 1024); } while (0)
#define PG8_LDB(dst, b, h) do { _Pragma("unroll") for (int n = 0; n < 2; ++n) _Pragma("unroll") for (int k = 0; k < 2; ++k) dst[n][k] = *(const LAS bf16x8*)(lds + PG8_SB(b, h) + boff + n * 2048 + k * 1024); } while (0)
#define PG8_MMA(ai, bj, At, Bt) do { __builtin_amdgcn_s_setprio(1); _Pragma("unroll") for (int m = 0; m < 4; ++m) _Pragma("unroll") for (int n = 0; n < 2; ++n) _Pragma("unroll") for (int k = 0; k < 2; ++k) \
        acc[ai][bj][m][n] = __builtin_amdgcn_mfma_f32_16x16x32_bf16(Bt[n][k], At[m][k], acc[ai][bj][m][n], 0, 0, 0); __builtin_amdgcn_s_setprio(0); } while (0)
#define PG8_WAIT_V(n) asm volatile("s_waitcnt vmcnt(" #n ")" ::: "memory")
#define PG8_WAIT_L(n) asm volatile("s_waitcnt lgkmcnt(" #n ")" ::: "memory")
#define PG8_BAR __builtin_amdgcn_s_barrier()
#define PG8_SCHED __builtin_amdgcn_sched_barrier(0)
    Unit cur, nxt; int ui = 0;
    if (!S.next(0, cur)) return;
    f32x4 acc[2][2][4][2];
#pragma unroll
    for (int a = 0; a < 2; ++a)
#pragma unroll
        for (int b = 0; b < 2; ++b)
#pragma unroll
            for (int m = 0; m < 4; ++m)
#pragma unroll
                for (int n = 0; n < 2; ++n) acc[a][b][m][n] = (f32x4){0.f, 0.f, 0.f, 0.f};
    bf16x8 At[4][2], B0[2][2], B1[2][2];
    const char* cA = (const char*)g.A + (size_t)cur.g * g.gsA + (size_t)cur.pm * tstep; const char* cB = (const char*)g.Bt + (size_t)cur.g * g.gsB + (size_t)cur.pn * tstep;
    PG8_STAGE(PG8_SB(0, 0), cB, voffB); PG8_STAGE(PG8_SA(0, 0), cA, voffA); PG8_STAGE(PG8_SB(0, 1), cB + hstep, voffB); PG8_STAGE(PG8_SA(0, 1), cA + hstep, voffA);
    if (wr == 1) PG8_BAR;
    PG8_WAIT_V(4); PG8_BAR;
    PG8_STAGE(PG8_SB(1, 0), cB + kstep, voffB); PG8_STAGE(PG8_SA(1, 0), cA + kstep, voffA); PG8_STAGE(PG8_SB(1, 1), cB + hstep + kstep, voffB);
    PG8_WAIT_V(6); PG8_BAR;
    for (;;) {
        const bool has_next = S.next(ui + 1, nxt);
        const char* nA = has_next ? (const char*)g.A + (size_t)nxt.g * g.gsA + (size_t)nxt.pm * tstep : cA; const char* nB = has_next ? (const char*)g.Bt + (size_t)nxt.g * g.gsB + (size_t)nxt.pn * tstep : cB;
        for (int t = 0; t < nt; t += 2) {
            const bool last = (t == nt - 2);
            const char* a1 = cA + (size_t)(t + 1) * kstep;
            const char* a2 = last ? nA : cA + (size_t)(t + 2) * kstep; const char* b2 = last ? nB : cB + (size_t)(t + 2) * kstep;
            const char* a3 = a2 + kstep; const char* b3 = b2 + kstep;
            PG8_LDB(B0, 0, 0); PG8_SCHED; PG8_LDA(At, 0, 0); PG8_STAGE(PG8_SA(1, 1), a1 + hstep, voffA);
            PG8_WAIT_L(8); PG8_BAR; PG8_WAIT_L(0); PG8_MMA(0, 0, At, B0); PG8_BAR; PG8_SCHED;
            PG8_LDB(B1, 0, 1); PG8_STAGE(PG8_SB(0, 0), b2, voffB);
            PG8_BAR; PG8_WAIT_L(0); PG8_MMA(0, 1, At, B1); PG8_BAR;
            PG8_LDA(At, 0, 1); PG8_STAGE(PG8_SA(0, 0), a2, voffA);
            PG8_BAR; PG8_WAIT_L(0); PG8_MMA(1, 0, At, B0); PG8_BAR; PG8_SCHED;
            PG8_STAGE(PG8_SB(0, 1), b2 + hstep, voffB);
            PG8_WAIT_V(6); PG8_BAR; PG8_MMA(1, 1, At, B1); PG8_BAR;
            PG8_LDB(B0, 1, 0); PG8_SCHED; PG8_LDA(At, 1, 0); PG8_STAGE(PG8_SA(0, 1), a2 + hstep, voffA);
            PG8_WAIT_L(8); PG8_BAR; PG8_WAIT_L(0); PG8_MMA(0, 0, At, B0); PG8_BAR; PG8_SCHED;
            PG8_LDB(B1, 1, 1); PG8_STAGE(PG8_SB(1, 0), b3, voffB);
            PG8_BAR; PG8_WAIT_L(0); PG8_MMA(0, 1, At, B1); PG8_BAR;
            PG8_LDA(At, 1, 1); PG8_STAGE(PG8_SA(1, 0), a3, voffA);
            PG8_BAR; PG8_WAIT_L(0); PG8_MMA(1, 0, At, B0); PG8_BAR; PG8_SCHED;
            PG8_STAGE(PG8_SB(1, 1), b3 + hstep, voffB);
            PG8_WAIT_V(6); PG8_BAR; PG8_MMA(1, 1, At, B1); PG8_BAR;
        }
        E(acc, cur, wr, wc, fr, fq);
        if (!has_next) break;
        if (!E.keep(cur)) {
#pragma unroll
            for (int a = 0; a < 2; ++a)
#pragma unroll
                for (int b = 0; b < 2; ++b)
#pragma unroll
                    for (int m = 0; m < 4; ++m)
#pragma unroll
                        for (int n = 0; n < 2; ++n) acc[a][b][m][n] = (f32x4){0.f, 0.f, 0.f, 0.f};
        }
        cur = nxt; cA = nA; cB = nB; ++ui;
    }
    PG8_WAIT_V(0);
    if (wr == 0) PG8_BAR;
    PG8_BAR;
#undef PG8_SA
#undef PG8_SB
#undef PG8_STAGE
#undef PG8_LDA
#undef PG8_LDB
#undef PG8_MMA
#undef PG8_WAIT_V
#undef PG8_WAIT_L
#undef PG8_BAR
#undef PG8_SCHED
}
}


#define NOINL __forceinline__
__device__ NOINL void ph_gemm_swiglu(LAS unsigned char* lds, const bf16_t* A, const bf16_t* Bt, bf16_t* O) {
    pg8::Gemm g{A, Bt, T, 2 * DFF, D, 0, 0}; pg8::StaticOrder S; S.init(g.M, g.N, lgdim(), lbid()); pg8::EpiSwiGLU E{O}; pg8::gemm_phase(lds, g, S, E);
}
__device__ NOINL void ph_gemm_resid(LAS unsigned char* lds, const bf16_t* A, const bf16_t* Bt, int M, int K, const float* Xin, float* Xout, float scale) {
    pg8::Gemm g{A, Bt, M, D, K, 0, 0}; pg8::StaticOrder S; S.init(g.M, g.N, lgdim(), lbid()); pg8::EpiResid E{Xin, Xout, scale}; pg8::gemm_phase(lds, g, S, E);
}
__device__ NOINL void ph_gemm_proj(LAS unsigned char* lds, const bf16_t* A, const bf16_t* Bt, bf16_t* O, float* AB) {
    pg8::Gemm g{A, Bt, TS, PW, D, 0, 0}; pg8::StaticOrder S; S.init(g.M, g.N, lgdim(), lbid()); pg8::EpiProj E{O, AB}; pg8::gemm_phase(lds, g, S, E);
}
__device__ NOINL void ph_gemm_branch(LAS unsigned char* lds, const bf16_t* A, const bf16_t* Bt, const bf16_t* P, bf16_t* O) {
    pg8::Gemm g{A, Bt, TS, D, 512, (size_t)TS * 512 * 2, (size_t)D * 512 * 2}; pg8::BranchOrder S; S.init(g.M, g.N, lgdim(), lbid()); pg8::EpiBranch E{P, O}; pg8::gemm_phase(lds, g, S, E);
}

struct ConvTask { const float* src0; const float* src1; bf16_t* dst; int K, Nsrc, mode, tile; };
__device__ __forceinline__ ConvTask conv_task(const Params& p, int l, int it) {
    unsigned char* ws = lptr(p.ws);
    constexpr int N1 = 16 * 88, N2 = 44 * 16, N3 = 16 * 140, N4 = 8 * 16, N5 = 16 * 16;
    ConvTask t; t.src1 = nullptr;
    int r = it;
    if (r < N1) { t.src0 = p.in[zz() + 2] + (size_t)l * D * DFF; t.src1 = p.in[zz() + 3] + (size_t)l * D * DFF; t.K = D; t.Nsrc = DFF; t.dst = (bf16_t*)(ws + WS_WGU1); t.mode = 1; t.tile = r; return t; } r -= N1;
    if (r < N2) { t.src0 = p.in[zz() + 4] + (size_t)l * DFF * D; t.K = DFF; t.Nsrc = D; t.dst = (bf16_t*)(ws + WS_WD1); t.mode = 0; t.tile = r; return t; } r -= N2;
    if (r < N3) { t.src0 = p.in[zz() + 6] + (size_t)l * D * PIN; t.K = D; t.Nsrc = PIN; t.dst = (bf16_t*)(ws + WS_WIN); t.mode = 2; t.tile = r; return t; } r -= N3;
    if (r < 4 * N4) { const int g = r / N4; t.src0 = p.in[zz() + 24] + ((size_t)l * 4 + g) * 512 * D; t.K = 512; t.Nsrc = D; t.dst = (bf16_t*)(ws + WS_WB) + (size_t)g * D * 512; t.mode = 0; t.tile = r % N4; return t; } r -= 4 * N4;
    if (r < N5) { t.src0 = p.in[zz() + 25] + (size_t)l * D * D; t.K = D; t.Nsrc = D; t.dst = (bf16_t*)(ws + WS_WOUT); t.mode = 0; t.tile = r; return t; } r -= N5;
    if (r < N1) { t.src0 = p.in[zz() + 27] + (size_t)l * D * DFF; t.src1 = p.in[zz() + 28] + (size_t)l * D * DFF; t.K = D; t.Nsrc = DFF; t.dst = (bf16_t*)(ws + WS_WGU2); t.mode = 1; t.tile = r; return t; } r -= N1;
    t.src0 = p.in[zz() + 29] + (size_t)l * DFF * D; t.K = DFF; t.Nsrc = D; t.dst = (bf16_t*)(ws + WS_WD2); t.mode = 0; t.tile = r; return t;
}
__device__ __forceinline__ void conv_load(const ConvTask& t, int tid, f32x4& a, f32x4& b) {
    const int nkt = t.K / 64, kt = t.tile % nkt, rt = t.tile / nkt, k0 = kt * 64, r0 = rt * 64;
    const int kk = tid >> 3, rr = (tid & 7) * 8, rho = r0 + rr;
    const float* src = t.src0; int col = rho;
    if (t.mode == 1) { const int pn = rho >> 8, bj = (rho >> 7) & 1, j = rho & 127; col = pn * 128 + j; src = bj ? t.src1 : t.src0; }
    else if (t.mode == 2) { col = rho < 4096 ? rho : (rho < 8704 ? rho + 8 : (rho < 8712 ? rho - 8704 + 4096 : -1)); }
    a = (f32x4){0.f, 0.f, 0.f, 0.f}; b = a;
    if (col >= 0) { const float* sp = src + (size_t)(k0 + kk) * t.Nsrc + col; a = *(const f32x4*)sp; b = *(const f32x4*)(sp + 4); }
}
__device__ __forceinline__ void conv_store(LAS float* scr, const ConvTask& t, int tid, const f32x4& a, const f32x4& b) {
    const int nkt = t.K / 64, kt = t.tile % nkt, rt = t.tile / nkt, k0 = kt * 64, r0 = rt * 64;
    { const int kk = tid >> 3, rr = (tid & 7) * 8;
#pragma unroll
        for (int e = 0; e < 4; ++e) { scr[(rr + e) * 65 + kk] = a[e]; scr[(rr + 4 + e) * 65 + kk] = b[e]; } }
    __syncthreads();
    { const int rl = tid >> 3, kc = (tid & 7) * 8;
        const LAS float* s = scr + rl * 65 + kc;
        u32x4 w; w.x = cvt_pk_bf16(s[0], s[1]); w.y = cvt_pk_bf16(s[2], s[3]); w.z = cvt_pk_bf16(s[4], s[5]); w.w = cvt_pk_bf16(s[6], s[7]);
        *(u32x4*)(t.dst + (size_t)(r0 + rl) * t.K + k0 + kc) = w; }
    __syncthreads();
}

__device__ __forceinline__ void convert_layer(LAS unsigned char* lds, const Params& p, int l) {
    LAS float* scr = (LAS float*)lds;
    unsigned char* ws = lptr(p.ws);
    constexpr int N1 = 16 * 88, N2 = 44 * 16, N3 = 16 * 140, N4 = 8 * 16, N5 = 16 * 16;
    constexpr int TOT = N1 + N2 + N3 + 4 * N4 + N5 + N1 + N2;
    const int tid = ltid(), G = lgdim();
    int it = lbid();
    if (it < TOT) {
        ConvTask cur = conv_task(p, l, it);
        f32x4 a, b; conv_load(cur, tid, a, b);
        for (;;) {
            const int nx = it + G; const bool more = nx < TOT;
            ConvTask nxt = cur; f32x4 na = a, nb = b;
            if (more) { nxt = conv_task(p, l, nx); conv_load(nxt, tid, na, nb); }
            conv_store(scr, cur, tid, a, b);
            if (!more) break;
            cur = nxt; a = na; b = nb; it = nx;
        }
    }
    bf16_t* waxt = (bf16_t*)(ws + WS_WAXT); bf16_t* pwt = (bf16_t*)(ws + WS_PWT);
    const float* wa = p.in[zz() + 13] + (size_t)l * 8 * 64 * 64; const float* wx = p.in[zz() + 15] + (size_t)l * 8 * 64 * 64; const float* pw = p.in[zz() + 22] + (size_t)l * 4 * 128 * 128;
    for (int e = lbid() * NTHR + ltid(); e < 65536; e += lgdim() * NTHR) {
        { const int h = e >> 13, jp = (e >> 6) & 127, i = e & 63; waxt[e] = f2bf(jp < 64 ? wa[(h * 64 + i) * 64 + jp] : wx[(h * 64 + i) * 64 + jp - 64]); }
        { const int g = e >> 14, d = (e >> 7) & 127, c = e & 127; pwt[e] = f2bf(pw[(g * 128 + c) * 128 + d]); }
    }
}

__device__ __forceinline__ void rms_rows_bf16(const float* X, const float* gain, bf16_t* H, int nrows) {
    const int wid = ltid() >> 6, lane = ltid() & 63;
    f32x4 gv[4];
#pragma unroll
    for (int j = 0; j < 4; ++j) gv[j] = *(const f32x4*)(gain + (lane + 64 * j) * 4);
    for (int row0 = (lbid() * 8 + wid) * 4; row0 < nrows; row0 += lgdim() * 32) {
        f32x4 v[4][4];
#pragma unroll
        for (int r = 0; r < 4; ++r) { const f32x4* xr = (const f32x4*)(X + (size_t)min(row0 + r, nrows - 1) * D) + lane;
#pragma unroll
            for (int j = 0; j < 4; ++j) v[r][j] = xr[64 * j]; }
#pragma unroll
        for (int r = 0; r < 4; ++r) {
            float s = 0.f;
#pragma unroll
            for (int j = 0; j < 4; ++j) s += (v[r][j].x * v[r][j].x + v[r][j].y * v[r][j].y) + (v[r][j].z * v[r][j].z + v[r][j].w * v[r][j].w);
            const float rs = rsqrtf(wave_sum(s) * (1.0f / D) + EPS);
            u32x2* o = (u32x2*)(H + (size_t)(row0 + r) * D) + lane;
            if (row0 + r < nrows)
#pragma unroll
            for (int j = 0; j < 4; ++j) { u32x2 w; w.x = cvt_pk_bf16(v[r][j].x * rs * gv[j].x, v[r][j].y * rs * gv[j].y); w.y = cvt_pk_bf16(v[r][j].z * rs * gv[j].z, v[r][j].w * rs * gv[j].w); o[64 * j] = w; }
        }
    }
}
__device__ __forceinline__ void rms_rows_f32_inplace(float* X, const float* gain, int nrows) {
    const int wid = ltid() >> 6, lane = ltid() & 63;
    f32x4 gv[4];
#pragma unroll
    for (int j = 0; j < 4; ++j) gv[j] = *(const f32x4*)(gain + (lane + 64 * j) * 4);
    for (int row0 = (lbid() * 8 + wid) * 4; row0 < nrows; row0 += lgdim() * 32) {
        f32x4 v[4][4];
#pragma unroll
        for (int r = 0; r < 4; ++r) { const f32x4* xr = (const f32x4*)(X + (size_t)min(row0 + r, nrows - 1) * D) + lane;
#pragma unroll
            for (int j = 0; j < 4; ++j) v[r][j] = xr[64 * j]; }
#pragma unroll
        for (int r = 0; r < 4; ++r) {
            float s = 0.f;
#pragma unroll
            for (int j = 0; j < 4; ++j) s += (v[r][j].x * v[r][j].x + v[r][j].y * v[r][j].y) + (v[r][j].z * v[r][j].z + v[r][j].w * v[r][j].w);
            const float rs = rsqrtf(wave_sum(s) * (1.0f / D) + EPS);
            f32x4* xo = (f32x4*)(X + (size_t)(row0 + r) * D) + lane;
            if (row0 + r < nrows)
#pragma unroll
            for (int j = 0; j < 4; ++j) xo[64 * j] = v[r][j] * rs * gv[j];
        }
    }
}

__device__ __forceinline__ void sgu_tile(LAS unsigned char* lds, const Params& p, int l, const bf16_t* proj, bf16_t* ya, int tile) {
    const int tid = ltid(), wid = tid >> 6, lane = tid & 63, fr = lane & 15, fq = lane >> 4;
    const int blk = tile >> 2, g = tile & 3, r0 = blk * 128;
    LAS bf16_t* Wl = (LAS bf16_t*)lds;
    LAS bf16_t* VT = (LAS bf16_t*)(lds + 34816);
    const float* lng = p.in[zz() + 7] + l * 512 + g * 128; const float* lnb = p.in[zz() + 8] + l * 512 + g * 128;
    {
        const int i = tid >> 2, qd = tid & 3;
        const bf16_t* vrow = proj + (size_t)(r0 + i) * PW + PC_AV + qd * 8;
        float s = 0.f, s2 = 0.f;
#pragma unroll 4
        for (int e8 = 0; e8 < 16; ++e8) { const u32x4 w = *(const u32x4*)(vrow + e8 * 32);
#pragma unroll
            for (int q = 0; q < 4; ++q) { const float a = geluf_(lo_bf(w[q])), b = geluf_(hi_bf(w[q])); s += a + b; s2 += a * a + b * b; } }
        s += __shfl_xor(s, 1); s += __shfl_xor(s, 2); s2 += __shfl_xor(s2, 1); s2 += __shfl_xor(s2, 2);
        const float mean = s * (1.0f / 512.0f), var = fmaxf(s2 * (1.0f / 512.0f) - mean * mean, 0.f), rstd = rsqrtf(var + EPS);
        const bf16_t* vg = proj + (size_t)(r0 + i) * PW + PC_AV + g * 128 + qd * 8;
#pragma unroll
        for (int e8 = 0; e8 < 4; ++e8) { const u32x4 w = *(const u32x4*)(vg + e8 * 32);
#pragma unroll
            for (int q = 0; q < 4; ++q) { const int c = e8 * 32 + qd * 8 + 2 * q;
                VT[c * 136 + i] = f2bf((geluf_(lo_bf(w[q])) - mean) * rstd * lng[c] + lnb[c]);
                VT[(c + 1) * 136 + i] = f2bf((geluf_(hi_bf(w[q])) - mean) * rstd * lng[c + 1] + lnb[c + 1]); } }
        const float* wsrc = p.in[zz() + 9] + (((size_t)l * 4 + g) * 128 + i) * 128 + qd * 32;
#pragma unroll
        for (int e4 = 0; e4 < 8; ++e4) { f32x4 w = *(const f32x4*)(wsrc + e4 * 4); if (i < 64 && qd >= 2) w = (f32x4){0.f, 0.f, 0.f, 0.f};
            u32x2 o; o.x = cvt_pk_bf16(w.x, w.y); o.y = cvt_pk_bf16(w.z, w.w); *(LAS u32x2*)(Wl + i * 136 + qd * 32 + e4 * 4) = o; }
    }
    __syncthreads();
    f32x4 acc[8];
#pragma unroll
    for (int n = 0; n < 8; ++n) acc[n] = (f32x4){0.f, 0.f, 0.f, 0.f};
#pragma unroll
    for (int ks = 0; ks < 4; ++ks) {
        const bf16x8 af = *(const LAS bf16x8*)(Wl + (wid * 16 + fr) * 136 + ks * 32 + fq * 8);
#pragma unroll
        for (int n = 0; n < 8; ++n) { const bf16x8 bf = *(const LAS bf16x8*)(VT + (n * 16 + fr) * 136 + ks * 32 + fq * 8); acc[n] = __builtin_amdgcn_mfma_f32_16x16x32_bf16(bf, af, acc[n], 0, 0, 0); }
    }
    {
        const int i = wid * 16 + fr; const float bias = p.in[zz() + 10][((size_t)l * 4 + g) * 128 + i];
        const bf16_t* up = proj + (size_t)(r0 + i) * PW + PC_AU + g * 128 + fq * 4;
        bf16_t* yp = ya + (size_t)(r0 + i) * 512 + g * 128 + fq * 4;
#pragma unroll
        for (int n = 0; n < 8; ++n) { const u32x2 uw = *(const u32x2*)(up + n * 16);
            u32x2 o; o.x = cvt_pk_bf16((acc[n][0] + bias) * geluf_(lo_bf(uw.x)), (acc[n][1] + bias) * geluf_(hi_bf(uw.x)));
            o.y = cvt_pk_bf16((acc[n][2] + bias) * geluf_(lo_bf(uw.y)), (acc[n][3] + bias) * geluf_(hi_bf(uw.y))); *(u32x2*)(yp + n * 16) = o; }
    }
    __syncthreads();
}

template <int WIN>
__device__ __forceinline__ void pool_rows(LAS bf16_t* Al, const bf16_t* xcol, int c, int pos0) {
    float xv[80];
#pragma unroll
    for (int k = 0; k < 80; ++k) xv[k] = (pos0 - 16 + k >= 0) ? bf2f(xcol[(long)(k - 16) * PW]) : 0.f;
    float s = 0.f;
#pragma unroll
    for (int j = 0; j < WIN; ++j) s += xv[16 - j];
#pragma unroll
    for (int tt = 0; tt < 64; ++tt) {
        const int k = tt + 16;
        const int cnt = min(pos0 + tt + 1, WIN);
        Al[tt * 520 + c] = f2bf(s / (float)cnt - xv[k]);
        if (tt < 63) s += xv[k + 1] - xv[k + 1 - WIN];
    }
}
__device__ __forceinline__ void pool_tile(LAS unsigned char* lds, const Params& p, int l, const bf16_t* proj, bf16_t* yd, bf16_t* halo, const bf16_t* pwt, int tile) {
    const int tid = ltid(), wid = tid >> 6, lane = tid & 63, fr = lane & 15, fq = lane >> 4;
    const int t0 = tile * 64, pos0 = t0 % SEQ;
    LAS bf16_t* Al = (LAS bf16_t*)lds;
    {
        const int c = tid, g = wid >> 1;
        const bf16_t* xcol = proj + (size_t)t0 * PW + PC_DX + c;
        if (g == 0) pool_rows<2>(Al, xcol, c, pos0); else if (g == 1) pool_rows<4>(Al, xcol, c, pos0); else if (g == 2) pool_rows<8>(Al, xcol, c, pos0); else pool_rows<16>(Al, xcol, c, pos0);
    }
    __syncthreads();
    {
        const int g = wid >> 1, nh = wid & 1;
        f32x4 acc[4][4];
#pragma unroll
        for (int m = 0; m < 4; ++m)
#pragma unroll
            for (int n = 0; n < 4; ++n) acc[m][n] = (f32x4){0.f, 0.f, 0.f, 0.f};
#pragma unroll
        for (int ks = 0; ks < 4; ++ks) {
            bf16x8 bfr[4];
#pragma unroll
            for (int n = 0; n < 4; ++n) bfr[n] = *(const bf16x8*)(pwt + ((size_t)(g * 128 + (nh * 4 + n) * 16 + fr)) * 128 + ks * 32 + fq * 8);
#pragma unroll
            for (int m = 0; m < 4; ++m) { const bf16x8 af = *(const LAS bf16x8*)(Al + (m * 16 + fr) * 520 + g * 128 + ks * 32 + fq * 8);
#pragma unroll
                for (int n = 0; n < 4; ++n) acc[m][n] = __builtin_amdgcn_mfma_f32_16x16x32_bf16(bfr[n], af, acc[m][n], 0, 0, 0); }
        }
        const float* sc = p.in[zz() + 23] + l * 512 + g * 128;
#pragma unroll
        for (int n = 0; n < 4; ++n) { const int d = (nh * 4 + n) * 16 + fq * 4; const f32x4 s4 = *(const f32x4*)(sc + d);
#pragma unroll
            for (int m = 0; m < 4; ++m) { u32x2 o; o.x = cvt_pk_bf16(acc[m][n][0] * s4[0], acc[m][n][1] * s4[1]); o.y = cvt_pk_bf16(acc[m][n][2] * s4[2], acc[m][n][3] * s4[3]);
                *(u32x2*)(yd + (size_t)(t0 + m * 16 + fr) * 512 + g * 128 + d) = o; } }
    }
    __syncthreads();
}

__device__ __forceinline__ void lru_tile(LAS unsigned char* lds, const Params& p, int l, const bf16_t* proj, bf16_t* yb, const bf16_t* waxt, float* Aend, float* Hend, const float* carry, int tile, int mode) {
    const int tid = ltid(), wid = tid >> 6, lane = tid & 63, fr = lane & 15, fq = lane >> 4;
    const int t0 = tile * 64, pos0 = t0 % SEQ, c = wid * 64 + lane;
    LAS bf16_t* Aw = (LAS bf16_t*)(lds + wid * 10560);
    LAS float* Xw = (LAS float*)(lds + wid * 10560 + 2304);
    bf16x8 bfr[8][2];
#pragma unroll
    for (int n = 0; n < 8; ++n)
#pragma unroll
        for (int ks = 0; ks < 2; ++ks) bfr[n][ks] = *(const bf16x8*)(waxt + ((size_t)(wid * 128 + n * 16 + fr)) * 64 + ks * 32 + fq * 8);
    const float* cwp = p.in[zz() + 11] + (size_t)l * 4 * 512 + c;
    const float cw0 = cwp[0], cw1 = cwp[512], cw2 = cwp[1024], cw3 = cwp[1536], cb = p.in[zz() + 12][l * 512 + c];
    const float ba = p.in[zz() + 14][l * 512 + c], bx = p.in[zz() + 16][l * 512 + c], sp8 = 8.0f * softplusf_(-p.in[zz() + 17][l * 512 + c]);
    const bf16_t* xcol = proj + (size_t)t0 * PW + PC_BX + c;
    float xm3 = 0.f, xm2 = 0.f, xm1 = 0.f;
    if (pos0 > 0) { xm3 = bf2f(xcol[-3L * PW]); xm2 = bf2f(xcol[-2L * PW]); xm1 = bf2f(xcol[-1L * PW]); }
    const bf16_t* gcol = proj + (size_t)t0 * PW + PC_BG + c;
    bf16_t* ycol = yb + (size_t)t0 * 512 + c;
    float h = mode ? carry[(size_t)tile * 512 + c] : 0.f, Ap = 1.f;
    for (int sub = 0; sub < 4; ++sub) {
        float xc[16];
#pragma unroll
        for (int tt = 0; tt < 16; ++tt) { const float xin = bf2f(*xcol); xcol += PW; xc[tt] = cb + cw0 * xm3 + cw1 * xm2 + cw2 * xm1 + cw3 * xin; xm3 = xm2; xm2 = xm1; xm1 = xin; Aw[tt * 72 + lane] = f2bf(xc[tt]); }
        __syncthreads();
        f32x4 acc[8];
#pragma unroll
        for (int n = 0; n < 8; ++n) acc[n] = (f32x4){0.f, 0.f, 0.f, 0.f};
#pragma unroll
        for (int ks = 0; ks < 2; ++ks) { const bf16x8 af = *(const LAS bf16x8*)(Aw + fr * 72 + ks * 32 + fq * 8);
#pragma unroll
            for (int n = 0; n < 8; ++n) acc[n] = __builtin_amdgcn_mfma_f32_16x16x32_bf16(bfr[n][ks], af, acc[n], 0, 0, 0); }
#pragma unroll
        for (int n = 0; n < 8; ++n)
#pragma unroll
            for (int j = 0; j < 4; ++j) Xw[fr * 129 + n * 16 + fq * 4 + j] = acc[n][j];
        __syncthreads();
#pragma unroll
        for (int tt = 0; tt < 16; ++tt) {
            const float r = sigmoidf_(Xw[tt * 129 + lane] + ba), ig = sigmoidf_(Xw[tt * 129 + 64 + lane] + bx);
            const float la = -sp8 * r, a = __expf(la), x2 = 2.0f * la;
            const float om = (x2 > -0.1f) ? -x2 * (1.0f + x2 * (0.5f + x2 * (0.16666667f + x2 * 0.041666668f))) : 1.0f - a * a;
            h = a * h + __builtin_amdgcn_sqrtf(om) * ig * xc[tt]; Ap *= a;
            if (mode) { const float gt = bf2f(*gcol); gcol += PW; *ycol = f2bf(h * geluf_(gt)); ycol += 512; }
        }
        __syncthreads();
    }
    if (!mode) { Aend[(size_t)tile * 512 + c] = Ap; Hend[(size_t)tile * 512 + c] = h; }
}
__device__ __forceinline__ void lru_carry(const float* Aend, const float* Hend, float* carry) {
    const int gid = lbid() * NTHR + ltid();
    if (gid < (TS / SEQ) * 512) {
        const int bl = gid >> 9, c = gid & 511; float h = 0.f;
        for (int n = 0; n < 64; ++n) { const size_t o = (size_t)(bl * 64 + n) * 512 + c; carry[o] = h; h = Aend[o] * h + Hend[o]; }
    }
}

__device__ __forceinline__ void gdn_prep(LAS unsigned char* lds, const Params& p, int l, const bf16_t* proj, const float* AB, bf16_t* GQ, bf16_t* GK, bf16_t* GU, bf16_t* GW, bf16_t* GA, float* edec, int item) {
    const int tid = ltid(), wid = tid >> 6, lane = tid & 63, fr = lane & 15, fq = lane >> 4;
    const int bl = item >> 8, n = (item & 255) >> 2, hh = item & 3, ch = bl * 64 + n, t0 = ch * 64;
    LAS bf16_t* Kl = (LAS bf16_t*)lds;
    LAS bf16_t* Ql = (LAS bf16_t*)(lds + 17408);
    LAS float* RHS = (LAS float*)(lds + 34816);
    LAS float* Am = (LAS float*)(lds + 101376);
    LAS float* gc = (LAS float*)(lds + 117760);
    LAS float* bt = (LAS float*)(lds + 118016);
    const int t = tid >> 3, d0 = (tid & 7) * 16;
#pragma unroll
    for (int sec = 0; sec < 3; ++sec) {
        const int colh = sec * 512 + hh * 128 + d0;
        u32x4 w0[4], w1[4]; float msk[4];
#pragma unroll
        for (int k = 0; k < 4; ++k) {
            const int tt = t - 3 + k; const bool valid = (tt >= 0) || (n > 0);
            const bf16_t* src = proj + (long)(t0 + (valid ? tt : 0)) * PW + PC_CQ + colh;
            w0[k] = *(const u32x4*)src; w1[k] = *(const u32x4*)(src + 8); msk[k] = valid ? 1.0f : 0.0f;
        }
        float a[16];
#pragma unroll
        for (int e = 0; e < 16; ++e) a[e] = 0.f;
#pragma unroll
        for (int k = 0; k < 4; ++k) {
            const float* cwp = p.in[zz() + 18] + ((size_t)l * 4 + k) * 1536 + colh;
#pragma unroll
            for (int q = 0; q < 4; ++q) { const f32x4 c4 = *(const f32x4*)(cwp + q * 4) * msk[k];
                const unsigned wa = (q < 2) ? w0[k][2 * q] : w1[k][2 * q - 4], wb = (q < 2) ? w0[k][2 * q + 1] : w1[k][2 * q - 3];
                a[q * 4 + 0] += c4[0] * lo_bf(wa); a[q * 4 + 1] += c4[1] * hi_bf(wa); a[q * 4 + 2] += c4[2] * lo_bf(wb); a[q * 4 + 3] += c4[3] * hi_bf(wb); }
        }
#pragma unroll
        for (int e = 0; e < 16; ++e) a[e] = siluf_(a[e]);
        if (sec < 2) {
            float ss = 0.f;
#pragma unroll
            for (int e = 0; e < 16; ++e) ss += a[e] * a[e];
            ss += __shfl_xor(ss, 1); ss += __shfl_xor(ss, 2); ss += __shfl_xor(ss, 4);
            const float nrm = rsqrtf(ss + EPS) * (sec == 0 ? 0.08838834764831845f : 1.0f);
#pragma unroll
            for (int e = 0; e < 16; ++e) a[e] *= nrm;
            LAS bf16_t* X = sec == 0 ? Ql : Kl;
#pragma unroll
            for (int e = 0; e < 16; e += 2) *(LAS unsigned*)(X + t * 136 + d0 + e) = cvt_pk_bf16(a[e], a[e + 1]);
        }
        if (sec >= 1) {
            LAS float* R = RHS + t * 260 + (sec == 1 ? 128 : 0) + d0;
#pragma unroll
            for (int e = 0; e < 16; e += 4) *(LAS f32x4*)(R + e) = (f32x4){a[e], a[e + 1], a[e + 2], a[e + 3]};
        }
    }
    if (wid == 0) {
        const float al = AB[(size_t)(t0 + lane) * 8 + 4 + hh], be = AB[(size_t)(t0 + lane) * 8 + hh];
        float gv = -__expf(p.in[zz() + 19][l * 4 + hh]) * softplusf_(al + p.in[zz() + 20][l * 4 + hh]);
#pragma unroll
        for (int o = 1; o < 64; o <<= 1) { const float u = __shfl_up(gv, o); if (lane >= o) gv += u; }
        gc[lane] = gv; bt[lane] = sigmoidf_(be);
        if (lane == 63) edec[item] = __expf(gv);
    }
    __syncthreads();
    float kdv[16];
    {
        const float bet = bt[t], gct = gc[t], eg = __expf(gct), ekd = __expf(gc[63] - gct);
        LAS float* Rv = RHS + t * 260 + d0; LAS float* Rk = Rv + 128;
#pragma unroll
        for (int e = 0; e < 16; e += 4) { const f32x4 v4 = *(LAS f32x4*)(Rv + e), k4 = *(LAS f32x4*)(Rk + e);
            *(LAS f32x4*)(Rv + e) = v4 * bet; *(LAS f32x4*)(Rk + e) = k4 * (bet * eg);
            kdv[e] = k4[0] * ekd; kdv[e + 1] = k4[1] * ekd; kdv[e + 2] = k4[2] * ekd; kdv[e + 3] = k4[3] * ekd; }
        unsigned qw[8];
#pragma unroll
        for (int e = 0; e < 8; ++e) { const unsigned w = *(LAS unsigned*)(Ql + t * 136 + d0 + 2 * e); qw[e] = cvt_pk_bf16(lo_bf(w) * eg, hi_bf(w) * eg); }
        bf16_t* qdst = GQ + (size_t)(t0 + t) * 512 + hh * 128 + d0;
        *(u32x4*)qdst = (u32x4){qw[0], qw[1], qw[2], qw[3]}; *(u32x4*)(qdst + 8) = (u32x4){qw[4], qw[5], qw[6], qw[7]};
    }
    {
        const int it = wid & 3, which = wid >> 2;
        LAS bf16_t* Xi = which ? Ql : Kl;
        bf16x8 af[4];
#pragma unroll
        for (int ks = 0; ks < 4; ++ks) af[ks] = *(const LAS bf16x8*)(Xi + (it * 16 + fr) * 136 + ks * 32 + fq * 8);
        const int i = it * 16 + fr; const float gci = gc[i], bti = bt[i];
#pragma unroll
        for (int jt = 0; jt < 4; ++jt) {
            f32x4 acc = (f32x4){0.f, 0.f, 0.f, 0.f};
#pragma unroll
            for (int ks = 0; ks < 4; ++ks) { const bf16x8 bf = *(const LAS bf16x8*)(Kl + (jt * 16 + fr) * 136 + ks * 32 + fq * 8); acc = __builtin_amdgcn_mfma_f32_16x16x32_bf16(bf, af[ks], acc, 0, 0, 0); }
            float v[4];
#pragma unroll
            for (int jj = 0; jj < 4; ++jj) { const int j = jt * 16 + fq * 4 + jj; const float dec = (i >= j) ? __expf(gci - gc[j]) : 0.f;
                v[jj] = which ? acc[jj] * dec : ((i > j) ? bti * acc[jj] * dec : 0.f); }
            if (which) { u32x2 o; o.x = cvt_pk_bf16(v[0], v[1]); o.y = cvt_pk_bf16(v[2], v[3]); *(u32x2*)(GA + (size_t)(t0 + i) * 256 + hh * 64 + jt * 16 + fq * 4) = o; }
            else *(LAS f32x4*)(Am + i * 64 + jt * 16 + fq * 4) = (f32x4){v[0], v[1], v[2], v[3]};
        }
    }
    __syncthreads();
    {
        LAS bf16_t* KDT = Ql;
#pragma unroll
        for (int e = 0; e < 16; ++e) KDT[(d0 + e) * 68 + t] = f2bf(kdv[e]);
    }
    if (tid < 256) {
        float x[64];
        int lz; asm volatile("v_mov_b32 %0, 0" : "=v"(lz));
        const LAS float* Amz = Am + lz;
#pragma unroll
        for (int i = 0; i < 64; ++i) x[i] = 0.f;
#pragma unroll
        for (int i = 0; i < 64; ++i) {
            float s = RHS[i * 260 + tid], s1 = 0.f, s2 = 0.f, s3 = 0.f;
#pragma unroll
            for (int j4 = 0; j4 < (i + 3) / 4; ++j4) { const f32x4 a4 = *(const LAS f32x4*)(Amz + i * 64 + j4 * 4);
                s -= a4[0] * x[j4 * 4]; s1 -= a4[1] * x[j4 * 4 + 1]; s2 -= a4[2] * x[j4 * 4 + 2]; s3 -= a4[3] * x[j4 * 4 + 3]; }
            s = (s + s1) + (s2 + s3);
            x[i] = s; RHS[i * 260 + tid] = s;
        }
    }
    __syncthreads();
    {
        const int seg = tid & 7;
        const LAS float* xr = RHS + t * 260 + seg * 32;
        bf16_t* dst = ((seg < 4) ? GU : GW) + (size_t)(t0 + t) * 512 + hh * 128 + (seg & 3) * 32;
#pragma unroll
        for (int q = 0; q < 4; ++q) { const f32x4 a = *(const LAS f32x4*)(xr + q * 8), b = *(const LAS f32x4*)(xr + q * 8 + 4);
            u32x4 w; w.x = cvt_pk_bf16(a[0], a[1]); w.y = cvt_pk_bf16(a[2], a[3]); w.z = cvt_pk_bf16(b[0], b[1]); w.w = cvt_pk_bf16(b[2], b[3]); *(u32x4*)(dst + q * 8) = w; }
        const LAS bf16_t* kr = Ql + (2 * t + (seg >> 2)) * 68 + (seg & 3) * 16;
        const u32x2 k0 = *(const LAS u32x2*)kr, k1 = *(const LAS u32x2*)(kr + 4), k2 = *(const LAS u32x2*)(kr + 8), k3 = *(const LAS u32x2*)(kr + 12);
        bf16_t* kdst = GK + (size_t)(t0 + t) * 512 + hh * 128 + seg * 16;
        *(u32x4*)kdst = (u32x4){k0.x, k0.y, k1.x, k1.y}; *(u32x4*)(kdst + 8) = (u32x4){k2.x, k2.y, k3.x, k3.y};
    }
    __syncthreads();
}

template <int OFF> __device__ __forceinline__ void dsr64(u32x2& d, unsigned addr) { asm volatile("ds_read_b64 %0, %1 offset:%2" : "=v"(d) : "v"(addr), "n"(OFF)); }
__device__ __forceinline__ void lgkm_wait8(u32x2& a, u32x2& b, u32x2& c, u32x2& d, u32x2& e, u32x2& f, u32x2& g, u32x2& h) {
    asm volatile("s_waitcnt lgkmcnt(0)" : "+v"(a), "+v"(b), "+v"(c), "+v"(d), "+v"(e), "+v"(f), "+v"(g), "+v"(h)); }
template <int RS  , int NK, int NM> struct FragSet { u32x2 lo[NK][NM], hi[NK][NM]; };
__device__ __forceinline__ void gdn_scan(LAS unsigned char* lds, const unsigned char* ws, float* oraw, const float* edec, int chain) {
    const int tid = ltid(), wid = __builtin_amdgcn_readfirstlane(tid >> 6), lane = tid & 63, fr = lane & 15, fq = lane >> 4;
    const int bl = chain >> 5, hh = (chain >> 3) & 3, es = chain & 7, e0 = es * 16;
    constexpr int BUF = 64512, O_W = 0, O_Q = 17408, O_KT = 34816, O_AT = 53248, O_U = 62464, O_PS = 2 * BUF, O_PV = 2 * BUF + 4096;
    const unsigned rb = (unsigned)(bl * 64) * 64u;
    const bool stager = (wid >= 2);
    unsigned soff[11];
#pragma unroll
    for (int i = 0; i < 11; ++i) {
        const int blk = (wid - 2) + 6 * i;
        const int q = blk * 64 + lane;
        unsigned o = 0u;
        if (stager && blk < 63) {
            if (q < 1088) { const int row = q / 17, pc = min(q % 17, 15); o = (unsigned)(WS_GDW + ((size_t)(rb + row) * 512 + hh * 128 + pc * 8) * 2); }
            else if (q < 2176) { const int q2 = q - 1088, row = q2 / 17, pc = min(q2 % 17, 15); o = (unsigned)(WS_GDQ + ((size_t)(rb + row) * 512 + hh * 128 + pc * 8) * 2); }
            else if (q < 3328) { const int q2 = q - 2176, d = q2 / 9, pc = min(q2 % 9, 7); o = (unsigned)(WS_GDK + ((size_t)(rb + (d >> 1)) * 512 + hh * 128 + (d & 1) * 64 + pc * 8) * 2); }
            else if (q < 3904) { const int q2 = q - 3328, row = q2 / 9, pc = min(q2 % 9, 7); o = (unsigned)(WS_GDA + ((size_t)(rb + row) * 256 + hh * 64 + pc * 8) * 2); }
            else { const int q2 = q - 3904, row = q2 >> 1, pc = q2 & 1; o = (unsigned)(WS_GDU + ((size_t)(rb + row) * 512 + hh * 128 + e0 + pc * 8) * 2); }
        }
        soff[i] = o;
    }
#define SCAN_DMA(chunk, bufsel) do { _Pragma("unroll") for (int i = 0; i < 11; ++i) { const int blk = (wid - 2) + 6 * i; if (blk < 63) { \
        const unsigned stp = (blk >= 52 && blk < 61) ? 32768u : 65536u; \
        __builtin_amdgcn_global_load_lds((const unsigned*)(ws + soff[i] + (unsigned)(chunk) * stp), (LAS unsigned*)(lds + (bufsel) * BUF + blk * 1024), 16, 0, 0); } } } while (0)
    if (stager) { SCAN_DMA(0, 0); asm volatile("s_waitcnt vmcnt(0)" ::: "memory"); }
    if (wid == 1) {
#pragma unroll
        for (int kt = 0; kt < 4; ++kt) *(LAS u32x4*)(lds + O_PS + kt * 1024 + lane * 16) = (u32x4){0u, 0u, 0u, 0u};
    }
    const float dv = edec[bl * 256 + lane * 4 + hh];
    f32x4 Sacc[8];
#pragma unroll
    for (int d = 0; d < 8; ++d) Sacc[d] = (f32x4){0.f, 0.f, 0.f, 0.f};
    __syncthreads();
    for (int n = 0; n < 64; ++n) {
        const LAS unsigned char* B = lds + (n & 1) * BUF;
        const int t0 = (bl * 64 + n) * 64;
        f32x4 OS[4];
        bf16x8 vb[2];
        if (stager) { if (n + 1 < 64) SCAN_DMA(n + 1, (n + 1) & 1); }
        else if (wid == 0) {
            f32x4 WS[4];
            bf16x8 sb[4];
#pragma unroll
            for (int kt = 0; kt < 4; ++kt) { u32x4 w; w.x = cvt_pk_bf16(Sacc[2 * kt][0], Sacc[2 * kt][1]); w.y = cvt_pk_bf16(Sacc[2 * kt][2], Sacc[2 * kt][3]);
                w.z = cvt_pk_bf16(Sacc[2 * kt + 1][0], Sacc[2 * kt + 1][1]); w.w = cvt_pk_bf16(Sacc[2 * kt + 1][2], Sacc[2 * kt + 1][3]); sb[kt] = __builtin_bit_cast(bf16x8, w); }
#pragma unroll
            for (int m = 0; m < 4; ++m) WS[m] = (f32x4){0.f, 0.f, 0.f, 0.f};
            {
                u32x2 wlo[4][4], whi[4][4];
                const unsigned bw = (unsigned)(unsigned long)(B + O_W + (fr * 136 + fq * 4) * 2);
                dsr64<0>(wlo[0][0], bw); dsr64<32>(whi[0][0], bw);
                dsr64<4352>(wlo[0][1], bw); dsr64<4384>(whi[0][1], bw);
                dsr64<8704>(wlo[0][2], bw); dsr64<8736>(whi[0][2], bw);
                dsr64<13056>(wlo[0][3], bw); dsr64<13088>(whi[0][3], bw);
                dsr64<64>(wlo[1][0], bw); dsr64<96>(whi[1][0], bw);
                dsr64<4416>(wlo[1][1], bw); dsr64<4448>(whi[1][1], bw);
                dsr64<8768>(wlo[1][2], bw); dsr64<8800>(whi[1][2], bw);
                dsr64<13120>(wlo[1][3], bw); dsr64<13152>(whi[1][3], bw);
                dsr64<128>(wlo[2][0], bw); dsr64<160>(whi[2][0], bw);
                dsr64<4480>(wlo[2][1], bw); dsr64<4512>(whi[2][1], bw);
                dsr64<8832>(wlo[2][2], bw); dsr64<8864>(whi[2][2], bw);
                dsr64<13184>(wlo[2][3], bw); dsr64<13216>(whi[2][3], bw);
                dsr64<192>(wlo[3][0], bw); dsr64<224>(whi[3][0], bw);
                dsr64<4544>(wlo[3][1], bw); dsr64<4576>(whi[3][1], bw);
                dsr64<8896>(wlo[3][2], bw); dsr64<8928>(whi[3][2], bw);
                dsr64<13248>(wlo[3][3], bw); dsr64<13280>(whi[3][3], bw);
                lgkm_wait8(wlo[0][0], wlo[0][1], wlo[0][2], wlo[0][3], wlo[1][0], wlo[1][1], wlo[1][2], wlo[1][3]);
                lgkm_wait8(wlo[2][0], wlo[2][1], wlo[2][2], wlo[2][3], wlo[3][0], wlo[3][1], wlo[3][2], wlo[3][3]);
                lgkm_wait8(whi[0][0], whi[0][1], whi[0][2], whi[0][3], whi[1][0], whi[1][1], whi[1][2], whi[1][3]);
                lgkm_wait8(whi[2][0], whi[2][1], whi[2][2], whi[2][3], whi[3][0], whi[3][1], whi[3][2], whi[3][3]);
#pragma unroll
                for (int kt = 0; kt < 4; ++kt)
#pragma unroll
                    for (int m = 0; m < 4; ++m) WS[m] = __builtin_amdgcn_mfma_f32_16x16x32_bf16(__builtin_bit_cast(bf16x8, (u32x4){wlo[kt][m].x, wlo[kt][m].y, whi[kt][m].x, whi[kt][m].y}), sb[kt], WS[m], 0, 0, 0);
            }
#pragma unroll
            for (int m = 0; m < 4; ++m)
#pragma unroll
                for (int jj = 0; jj < 4; ++jj) WS[m][jj] = bf2f(*(const LAS bf16_t*)(B + O_U + ((m * 16 + fq * 4 + jj) * 16 + fr) * 2)) - WS[m][jj];
#pragma unroll
            for (int kc = 0; kc < 2; ++kc) { u32x4 w; w.x = cvt_pk_bf16(WS[2 * kc][0], WS[2 * kc][1]); w.y = cvt_pk_bf16(WS[2 * kc][2], WS[2 * kc][3]);
                w.z = cvt_pk_bf16(WS[2 * kc + 1][0], WS[2 * kc + 1][1]); w.w = cvt_pk_bf16(WS[2 * kc + 1][2], WS[2 * kc + 1][3]); vb[kc] = __builtin_bit_cast(bf16x8, w);
                *(LAS u32x4*)(lds + O_PV + kc * 1024 + lane * 16) = w; }
        } else if (wid == 1) {
#pragma unroll
            for (int m = 0; m < 4; ++m) OS[m] = (f32x4){0.f, 0.f, 0.f, 0.f};
            {
                u32x2 qlo[4][4], qhi[4][4]; bf16x8 sbr[4];
#pragma unroll
                for (int kt = 0; kt < 4; ++kt) sbr[kt] = *(const LAS bf16x8*)(lds + O_PS + kt * 1024 + lane * 16);
                const unsigned bq = (unsigned)(unsigned long)(B + O_Q + (fr * 136 + fq * 4) * 2);
                dsr64<0>(qlo[0][0], bq); dsr64<32>(qhi[0][0], bq);
                dsr64<4352>(qlo[0][1], bq); dsr64<4384>(qhi[0][1], bq);
                dsr64<8704>(qlo[0][2], bq); dsr64<8736>(qhi[0][2], bq);
                dsr64<13056>(qlo[0][3], bq); dsr64<13088>(qhi[0][3], bq);
                dsr64<64>(qlo[1][0], bq); dsr64<96>(qhi[1][0], bq);
                dsr64<4416>(qlo[1][1], bq); dsr64<4448>(qhi[1][1], bq);
                dsr64<8768>(qlo[1][2], bq); dsr64<8800>(qhi[1][2], bq);
                dsr64<13120>(qlo[1][3], bq); dsr64<13152>(qhi[1][3], bq);
                dsr64<128>(qlo[2][0], bq); dsr64<160>(qhi[2][0], bq);
                dsr64<4480>(qlo[2][1], bq); dsr64<4512>(qhi[2][1], bq);
                dsr64<8832>(qlo[2][2], bq); dsr64<8864>(qhi[2][2], bq);
                dsr64<13184>(qlo[2][3], bq); dsr64<13216>(qhi[2][3], bq);
                dsr64<192>(qlo[3][0], bq); dsr64<224>(qhi[3][0], bq);
                dsr64<4544>(qlo[3][1], bq); dsr64<4576>(qhi[3][1], bq);
                dsr64<8896>(qlo[3][2], bq); dsr64<8928>(qhi[3][2], bq);
                dsr64<13248>(qlo[3][3], bq); dsr64<13280>(qhi[3][3], bq);
                lgkm_wait8(qlo[0][0], qlo[0][1], qlo[0][2], qlo[0][3], qlo[1][0], qlo[1][1], qlo[1][2], qlo[1][3]);
                lgkm_wait8(qlo[2][0], qlo[2][1], qlo[2][2], qlo[2][3], qlo[3][0], qlo[3][1], qlo[3][2], qlo[3][3]);
                lgkm_wait8(qhi[0][0], qhi[0][1], qhi[0][2], qhi[0][3], qhi[1][0], qhi[1][1], qhi[1][2], qhi[1][3]);
                lgkm_wait8(qhi[2][0], qhi[2][1], qhi[2][2], qhi[2][3], qhi[3][0], qhi[3][1], qhi[3][2], qhi[3][3]);
#pragma unroll
                for (int kt = 0; kt < 4; ++kt)
#pragma unroll
                    for (int m = 0; m < 4; ++m) OS[m] = __builtin_amdgcn_mfma_f32_16x16x32_bf16(__builtin_bit_cast(bf16x8, (u32x4){qlo[kt][m].x, qlo[kt][m].y, qhi[kt][m].x, qhi[kt][m].y}), sbr[kt], OS[m], 0, 0, 0);
            }
        }
        asm volatile("s_waitcnt lgkmcnt(0)" ::: "memory"); __builtin_amdgcn_s_barrier(); asm volatile("" ::: "memory");
        if (wid == 0) {
            const float dec = __shfl(dv, n);
#pragma unroll
            for (int d = 0; d < 8; ++d) Sacc[d] *= dec;
            {
                u32x2 klo[2][8], khi[2][8];
                const unsigned bk = (unsigned)(unsigned long)(B + O_KT + (fr * 72 + fq * 4) * 2);
                dsr64<0>(klo[0][0], bk); dsr64<32>(khi[0][0], bk);
                dsr64<2304>(klo[0][1], bk); dsr64<2336>(khi[0][1], bk);
                dsr64<4608>(klo[0][2], bk); dsr64<4640>(khi[0][2], bk);
                dsr64<6912>(klo[0][3], bk); dsr64<6944>(khi[0][3], bk);
                dsr64<9216>(klo[0][4], bk); dsr64<9248>(khi[0][4], bk);
                dsr64<11520>(klo[0][5], bk); dsr64<11552>(khi[0][5], bk);
                dsr64<13824>(klo[0][6], bk); dsr64<13856>(khi[0][6], bk);
                dsr64<16128>(klo[0][7], bk); dsr64<16160>(khi[0][7], bk);
                dsr64<64>(klo[1][0], bk); dsr64<96>(khi[1][0], bk);
                dsr64<2368>(klo[1][1], bk); dsr64<2400>(khi[1][1], bk);
                dsr64<4672>(klo[1][2], bk); dsr64<4704>(khi[1][2], bk);
                dsr64<6976>(klo[1][3], bk); dsr64<7008>(khi[1][3], bk);
                dsr64<9280>(klo[1][4], bk); dsr64<9312>(khi[1][4], bk);
                dsr64<11584>(klo[1][5], bk); dsr64<11616>(khi[1][5], bk);
                dsr64<13888>(klo[1][6], bk); dsr64<13920>(khi[1][6], bk);
                dsr64<16192>(klo[1][7], bk); dsr64<16224>(khi[1][7], bk);
                lgkm_wait8(klo[0][0], klo[0][1], klo[0][2], klo[0][3], klo[0][4], klo[0][5], klo[0][6], klo[0][7]);
                lgkm_wait8(klo[1][0], klo[1][1], klo[1][2], klo[1][3], klo[1][4], klo[1][5], klo[1][6], klo[1][7]);
                lgkm_wait8(khi[0][0], khi[0][1], khi[0][2], khi[0][3], khi[0][4], khi[0][5], khi[0][6], khi[0][7]);
                lgkm_wait8(khi[1][0], khi[1][1], khi[1][2], khi[1][3], khi[1][4], khi[1][5], khi[1][6], khi[1][7]);
#pragma unroll
                for (int kc = 0; kc < 2; ++kc)
#pragma unroll
                    for (int d = 0; d < 8; ++d) Sacc[d] = __builtin_amdgcn_mfma_f32_16x16x32_bf16(__builtin_bit_cast(bf16x8, (u32x4){klo[kc][d].x, klo[kc][d].y, khi[kc][d].x, khi[kc][d].y}), vb[kc], Sacc[d], 0, 0, 0);
            }
#pragma unroll
            for (int kt = 0; kt < 4; ++kt) { u32x4 w; w.x = cvt_pk_bf16(Sacc[2 * kt][0], Sacc[2 * kt][1]); w.y = cvt_pk_bf16(Sacc[2 * kt][2], Sacc[2 * kt][3]);
                w.z = cvt_pk_bf16(Sacc[2 * kt + 1][0], Sacc[2 * kt + 1][1]); w.w = cvt_pk_bf16(Sacc[2 * kt + 1][2], Sacc[2 * kt + 1][3]);
                *(LAS u32x4*)(lds + O_PS + kt * 1024 + lane * 16) = w; }
        } else if (wid == 1) {
            {
                u32x2 alo[2][4], ahi[2][4]; bf16x8 vbr[2];
#pragma unroll
                for (int kc = 0; kc < 2; ++kc) vbr[kc] = *(const LAS bf16x8*)(lds + O_PV + kc * 1024 + lane * 16);
                const unsigned ba = (unsigned)(unsigned long)(B + O_AT + (fr * 72 + fq * 4) * 2);
                dsr64<0>(alo[0][0], ba); dsr64<32>(ahi[0][0], ba);
                dsr64<2304>(alo[0][1], ba); dsr64<2336>(ahi[0][1], ba);
                dsr64<4608>(alo[0][2], ba); dsr64<4640>(ahi[0][2], ba);
                dsr64<6912>(alo[0][3], ba); dsr64<6944>(ahi[0][3], ba);
                dsr64<64>(alo[1][0], ba); dsr64<96>(ahi[1][0], ba);
                dsr64<2368>(alo[1][1], ba); dsr64<2400>(ahi[1][1], ba);
                dsr64<4672>(alo[1][2], ba); dsr64<4704>(ahi[1][2], ba);
                dsr64<6976>(alo[1][3], ba); dsr64<7008>(ahi[1][3], ba);
                lgkm_wait8(alo[0][0], alo[0][1], alo[0][2], alo[0][3], alo[1][0], alo[1][1], alo[1][2], alo[1][3]);
                lgkm_wait8(ahi[0][0], ahi[0][1], ahi[0][2], ahi[0][3], ahi[1][0], ahi[1][1], ahi[1][2], ahi[1][3]);
#pragma unroll
                for (int kc = 0; kc < 2; ++kc)
#pragma unroll
                    for (int m = 0; m < 4; ++m) OS[m] = __builtin_amdgcn_mfma_f32_16x16x32_bf16(__builtin_bit_cast(bf16x8, (u32x4){alo[kc][m].x, alo[kc][m].y, ahi[kc][m].x, ahi[kc][m].y}), vbr[kc], OS[m], 0, 0, 0);
            }
            float* op = oraw + (size_t)(t0 + fq * 4) * 512 + hh * 128 + e0 + fr;
#pragma unroll
            for (int m = 0; m < 4; ++m)
#pragma unroll
                for (int jj = 0; jj < 4; ++jj) op[(size_t)(m * 16 + jj) * 512] = OS[m][jj];
        } else if (stager) {
            asm volatile("s_waitcnt vmcnt(0)" ::: "memory");
        }
        __syncthreads();
    }
#undef SCAN_DMA
}
__device__ __forceinline__ void gdn_out(const Params& p, int l, const float* oraw, const bf16_t* proj, bf16_t* yc) {
    const int tid = ltid(), sub = tid & 15;
    const float* ng = p.in[zz() + 21] + l * 128 + sub * 8;
    const f32x4 g0 = *(const f32x4*)ng, g1 = *(const f32x4*)(ng + 4);
    for (int rowi = lbid() * 32 + (tid >> 4); rowi < TS * 4; rowi += lgdim() * 32) {
        const int t = rowi >> 2, hh = rowi & 3;
        const float* op = oraw + (size_t)t * 512 + hh * 128 + sub * 8;
        const f32x4 o0 = *(const f32x4*)op, o1 = *(const f32x4*)(op + 4);
        float ss = (o0[0] * o0[0] + o0[1] * o0[1]) + (o0[2] * o0[2] + o0[3] * o0[3]) + (o1[0] * o1[0] + o1[1] * o1[1]) + (o1[2] * o1[2] + o1[3] * o1[3]);
        ss += __shfl_xor(ss, 1); ss += __shfl_xor(ss, 2); ss += __shfl_xor(ss, 4); ss += __shfl_xor(ss, 8);
        const float rs = rsqrtf(ss * (1.0f / 128.0f) + EPS);
        const u32x4 z = *(const u32x4*)(proj + (size_t)t * PW + PC_CZ + hh * 128 + sub * 8);
        u32x4 w;
        w.x = cvt_pk_bf16(o0[0] * rs * g0[0] * siluf_(lo_bf(z.x)), o0[1] * rs * g0[1] * siluf_(hi_bf(z.x)));
        w.y = cvt_pk_bf16(o0[2] * rs * g0[2] * siluf_(lo_bf(z.y)), o0[3] * rs * g0[3] * siluf_(hi_bf(z.y)));
        w.z = cvt_pk_bf16(o1[0] * rs * g1[0] * siluf_(lo_bf(z.z)), o1[1] * rs * g1[1] * siluf_(hi_bf(z.z)));
        w.w = cvt_pk_bf16(o1[2] * rs * g1[2] * siluf_(lo_bf(z.w)), o1[3] * rs * g1[3] * siluf_(hi_bf(z.w)));
        *(u32x4*)(yc + (size_t)t * 512 + hh * 128 + sub * 8) = w;
    }
}

__device__ __forceinline__ void gdn_out_part(const Params& p, int l, const float* oraw, const bf16_t* proj, bf16_t* yc, int row0, int nrows, int hh) {
    const int tid = ltid(), sub = tid & 15;
    const float* ng = p.in[zz() + 21] + l * 128 + sub * 8;
    const f32x4 g0 = *(const f32x4*)ng, g1 = *(const f32x4*)(ng + 4);
    for (int t = row0 + (tid >> 4); t < row0 + nrows; t += 32) {
        const float* op = oraw + (size_t)t * 512 + hh * 128 + sub * 8;
        const f32x4 o0 = *(const f32x4*)op, o1 = *(const f32x4*)(op + 4);
        float ss = (o0[0] * o0[0] + o0[1] * o0[1]) + (o0[2] * o0[2] + o0[3] * o0[3]) + (o1[0] * o1[0] + o1[1] * o1[1]) + (o1[2] * o1[2] + o1[3] * o1[3]);
        ss += __shfl_xor(ss, 1); ss += __shfl_xor(ss, 2); ss += __shfl_xor(ss, 4); ss += __shfl_xor(ss, 8);
        const float rs = rsqrtf(ss * (1.0f / 128.0f) + EPS);
        const u32x4 z = *(const u32x4*)(proj + (size_t)t * PW + PC_CZ + hh * 128 + sub * 8);
        u32x4 w;
        w.x = cvt_pk_bf16(o0[0] * rs * g0[0] * siluf_(lo_bf(z.x)), o0[1] * rs * g0[1] * siluf_(hi_bf(z.x)));
        w.y = cvt_pk_bf16(o0[2] * rs * g0[2] * siluf_(lo_bf(z.y)), o0[3] * rs * g0[3] * siluf_(hi_bf(z.y)));
        w.z = cvt_pk_bf16(o1[0] * rs * g1[0] * siluf_(lo_bf(z.z)), o1[1] * rs * g1[1] * siluf_(hi_bf(z.z)));
        w.w = cvt_pk_bf16(o1[2] * rs * g1[2] * siluf_(lo_bf(z.w)), o1[3] * rs * g1[3] * siluf_(hi_bf(z.w)));
        *(u32x4*)(yc + (size_t)t * 512 + hh * 128 + sub * 8) = w;
    }
}

constexpr int PH_PER_LAYER = 22, N_PHASES = 2 * PH_PER_LAYER + 1;

__device__ __forceinline__ void run_phase(LAS unsigned char* lds, const Params& p, int ph) {
    unsigned char* ws = lptr(p.ws);
    bf16_t* hbuf = (bf16_t*)(ws + WS_H);
    bf16_t* act = (bf16_t*)(ws + WS_PROJ);
    bf16_t* proj = (bf16_t*)(ws + WS_PROJ);
    bf16_t* hslab = hbuf;
    bf16_t* merged = hbuf + (size_t)TS * D;
    float* oraw = (float*)(ws + WS_H);
    bf16_t* ys = (bf16_t*)(ws + WS_YS);
    float* AB = (float*)(ws + WS_AB);
    bf16_t* halo = (bf16_t*)(ws + WS_HALO);
    float* Aend = (float*)(ws + WS_AEND); float* Hend = (float*)(ws + WS_HEND); float* carry = (float*)(ws + WS_CARRY); float* edec = (float*)(ws + WS_EDEC);
    const bf16_t* waxt = (const bf16_t*)(ws + WS_WAXT); const bf16_t* pwt = (const bf16_t*)(ws + WS_PWT);
    const int G = lgdim(), c = lbid();
    if (ph == N_PHASES - 1) { PHON(0) rms_rows_f32_inplace(lptr(p.out), p.in[zz() + 30], T); return; }
    const int l = ph / PH_PER_LAYER, r = ph % PH_PER_LAYER;
    const float* xcur = (l == 0) ? p.in[zz() + 0] : lptr(p.out);
    if (r == 0) { PHON(1) convert_layer(lds, p, l); PHON(0) rms_rows_bf16(xcur, p.in[zz() + 1] + l * D, hbuf, T); return; }
    if (r == 1 || r == 20) { PHON(2) ph_gemm_swiglu(lds, hbuf, (const bf16_t*)(ws + (r == 1 ? WS_WGU1 : WS_WGU2)), act); return; }
    if (r == 2 || r == 21) { PHON(3) ph_gemm_resid(lds, act, (const bf16_t*)(ws + (r == 2 ? WS_WD1 : WS_WD2)), T, DFF, (r == 2) ? xcur : lptr(p.out), lptr(p.out), 0.5f); return; }
    if (r == 19) { rms_rows_bf16(lptr(p.out), p.in[zz() + 26] + l * D, hbuf, T); return; }
    const int slab = (r - 3) >> 3, q = (r - 3) & 7;
    float* xs = lptr(p.out) + (size_t)slab * TS * D;
    switch (q) {
    case 0: if (slab == 0) rms_rows_bf16(xs, p.in[zz() + 5] + l * D, hslab, TS); break;
    case 1: PHON(4) ph_gemm_proj(lds, hslab, (const bf16_t*)(ws + WS_WIN), proj, AB); break;
    case 2:
        PHON(7) for (int t = c; t < TS / 64; t += G) lru_tile(lds, p, l, proj, nullptr, waxt, Aend, Hend, carry, t, 0);
        if (G >= 256) { PHON(5) for (int t = c; t < (TS / 128) * 2; t += G) sgu_tile(lds, p, l, proj, ys, t); }
        break;
    case 3:
        PHON(8) for (int it = c; it < (TS / 64) * 4; it += G) gdn_prep(lds, p, l, proj, AB, (bf16_t*)(ws + WS_GDQ), (bf16_t*)(ws + WS_GDK), (bf16_t*)(ws + WS_GDU), (bf16_t*)(ws + WS_GDW), (bf16_t*)(ws + WS_GDA), edec, it);
        lru_carry(Aend, Hend, carry);
        break;
    case 4: {
        unsigned* qc = (unsigned*)(ws + WS_BAR + 14336) + (l * 2 + slab) * 16;
        unsigned* dn = (unsigned*)(ws + WS_BAR + 14336) + 64 + (l * 2 + slab) * 16;
        if (c < 128) {
            PHON(9) gdn_scan(lds, ws, oraw, edec, c);
            asm volatile("s_waitcnt vmcnt(0)" ::: "memory");
            __syncthreads();
            if (ltid() == 0) { __builtin_amdgcn_fence(__ATOMIC_RELEASE, "agent"); asm volatile("s_waitcnt vmcnt(0)" ::: "memory"); __hip_atomic_fetch_add(dn + (c >> 3), 1u, __ATOMIC_RELAXED, __HIP_MEMORY_SCOPE_AGENT); }
        }
        volatile LAS unsigned* slot = (volatile LAS unsigned*)(lds + LDS_BYTES - 32);
        const bool t0 = (ltid() == 0);
        constexpr int NQ_LRU = TS / 64, NQ_SGU = (TS / 128) * 2, NQ_POOL = TS / 64, NQ_OUT = 16 * 4, NQ = NQ_LRU + NQ_SGU + NQ_POOL + NQ_OUT;
        unsigned nxt = 0u;
        if (t0) nxt = __hip_atomic_fetch_add(qc, 1u, __ATOMIC_RELAXED, __HIP_MEMORY_SCOPE_AGENT);
        for (;;) {
            if (t0) *slot = nxt;
            __syncthreads();
            const int it = __builtin_amdgcn_readfirstlane((int)*slot);
            __syncthreads();
            if (it >= NQ) break;
            if (t0) nxt = __hip_atomic_fetch_add(qc, 1u, __ATOMIC_RELAXED, __HIP_MEMORY_SCOPE_AGENT);
            if (it < NQ_LRU) { PHON(10) lru_tile(lds, p, l, proj, ys + (size_t)TS * 512, waxt, Aend, Hend, carry, it, 1); }
            else if (it < NQ_LRU + NQ_SGU) { PHON(5) sgu_tile(lds, p, l, proj, ys, (TS / 128) * 2 + (it - NQ_LRU)); }
            else if (it < NQ_LRU + NQ_SGU + NQ_POOL) { PHON(6) pool_tile(lds, p, l, proj, ys + (size_t)3 * TS * 512, halo, pwt, it - NQ_LRU - NQ_SGU); }
            else {
                const int oi = it - (NQ_LRU + NQ_SGU + NQ_POOL), bh = oi >> 2, part = oi & 3;
                if (t0) { unsigned sp = 0u; while (__hip_atomic_load(dn + bh, __ATOMIC_RELAXED, __HIP_MEMORY_SCOPE_AGENT) < 8u && ++sp < (1u << 24)) __builtin_amdgcn_s_sleep(2);
                    __builtin_amdgcn_fence(__ATOMIC_ACQUIRE, "agent"); asm volatile("s_waitcnt vmcnt(0)" ::: "memory"); }
                __syncthreads();
                PHON(11) gdn_out_part(p, l, oraw, proj, ys + (size_t)2 * TS * 512, (bh >> 2) * SEQ + part * (SEQ / 4), SEQ / 4, bh & 3);
            }
        }
        } break;
    case 5: break;
    case 6: PHON(12) ph_gemm_branch(lds, ys, (const bf16_t*)(ws + WS_WB), proj, merged); break;
    default: PHON(13) ph_gemm_resid(lds, merged, (const bf16_t*)(ws + WS_WOUT), TS, D, xs, xs, 1.0f);
        if (slab == 0) rms_rows_bf16(lptr(p.out) + (size_t)TS * D, p.in[zz() + 5] + l * D, hslab, TS);
        break;
    }
}

extern __shared__ __attribute__((aligned(16))) unsigned char smem_dyn[];

#ifndef DUP_TYPE
#define DUP_TYPE -1
#endif
__device__ __forceinline__ int phase_type(int ph) {
    if (ph == N_PHASES - 1) return 12;
    const int r = ph % PH_PER_LAYER;
    if (r == 0) return 0; if (r == 1 || r == 20) return 1; if (r == 2 || r == 21) return 2; if (r == 19) return 11;
    const int q = (r - 3) & 7;
    return 3 + q;
}
__global__ void __launch_bounds__(NTHR) fwd_megakernel(Params p) {
    cg::grid_group grid = cg::this_grid();
    LAS unsigned char* lds = (LAS unsigned char*)smem_dyn;
    volatile LAS unsigned* st = (volatile LAS unsigned*)(lds + LDS_BYTES - 16);
    if (threadIdx.x == 0) { st[0] = 0u; st[1] = 0u; }
    __syncthreads();
    const XcdBarrier xb = xcd_barrier_post((unsigned*)(p.ws + WS_BAR), st);
    if (p.ph_hi < 0) grid.sync();
    for (int ph = p.ph_lo; ph < p.ph_hi; ++ph) {
        if (ph != N_PHASES - 1 && (ph % PH_PER_LAYER == 11 || ph % PH_PER_LAYER == 8 || ph % PH_PER_LAYER == 16)) continue;
        if (ph > p.ph_lo) xcd_barrier(xb);
        run_phase(lds, p, ph);
#if DUP_TYPE == 6
        if (phase_type(ph) == 6) { xcd_barrier(xb); run_phase(lds, p, ph - 2); xcd_barrier(xb); run_phase(lds, p, ph - 1); xcd_barrier(xb); run_phase(lds, p, ph); }
#elif DUP_TYPE >= 0
        if (phase_type(ph) == DUP_TYPE) { xcd_barrier(xb); run_phase(lds, p, ph); }
#endif
    }
}

extern "C" void kernel_launch(void* const* d_in, const int* in_sizes, int n_in, void* d_out, int out_size, void* d_ws, size_t ws_size, hipStream_t stream) {
    static int grid_blocks = 0;
    if (grid_blocks == 0) {
        if (n_in != 31 || out_size != T * D || ws_size < WS_END) { fprintf(stderr, "kernel_launch: unexpected shapes (n_in %d out %d ws %zu need %zu)\n", n_in, out_size, ws_size, (size_t)WS_END); grid_blocks = -1; return; }
        int dev = 0, cus = 0, per_cu = 0;
        hipGetDevice(&dev);
        hipDeviceGetAttribute(&cus, hipDeviceAttributeMultiprocessorCount, dev);
        if (hipFuncSetAttribute((const void*)fwd_megakernel, hipFuncAttributeMaxDynamicSharedMemorySize, LDS_BYTES) != hipSuccess) { fprintf(stderr, "kernel_launch: hipFuncSetAttribute failed\n"); grid_blocks = -1; return; }
        hipOccupancyMaxActiveBlocksPerMultiprocessor(&per_cu, (const void*)fwd_megakernel, NTHR, LDS_BYTES);
        if (per_cu < 1) { fprintf(stderr, "kernel_launch: occupancy query returned %d\n", per_cu); per_cu = 1; }
        grid_blocks = cus * per_cu;
        if (grid_blocks < 256) { fprintf(stderr, "kernel_launch: the phase program needs >= 256 co-resident workgroups, got %d\n", grid_blocks); grid_blocks = -1; return; }
    }
    if (grid_blocks < 0) return;
    Params p{};
    for (int i = 0; i < 31; ++i) p.in[i] = (const float*)d_in[i];
    p.out = (float*)d_out; p.ws = (unsigned char*)d_ws;
    hipMemsetAsync((unsigned char*)d_ws + WS_BAR, 0, 16384, stream);
    p.ph_lo = 0; p.ph_hi = N_PHASES;
    void* args[] = {&p};
    hipError_t e = hipLaunchCooperativeKernel((const void*)fwd_megakernel, dim3(grid_blocks), dim3(NTHR), args, LDS_BYTES, stream);
    if (e != hipSuccess) fprintf(stderr, "cooperative launch failed: %s (grid %d)\n", hipGetErrorString(e), grid_blocks);
}
```
